# Optimizing an MI355X kernel written in HIP

```python
import math
import jax, jax.numpy as jnp
from jax import lax
import numpy as np

D_MODEL = 1024
BATCH = 8
SEQ = 4096
DEPTH = 1

CHUNK = 64
Q_BLOCK = 128
EPS = 1e-6

MLA_HEADS = 8
MLA_NOPE = 64
MLA_ROPE = 32
MLA_V = 64
MLA_QK = MLA_NOPE + MLA_ROPE
Q_LORA = 768
KV_LORA = 256
ROPE_THETA = 10000.0
MLA_WIDTH = MLA_HEADS * MLA_V

HG_HEADS = 8
HG_DK = 64
HG_DV = 64
HG_KEY_WIDTH = HG_HEADS * HG_DK
HG_WIDTH = HG_HEADS * HG_DV
HG_BLOCK = 32

N_BRANCH = 2
IN_SPLITS = (Q_LORA, KV_LORA, MLA_ROPE, MLA_WIDTH,
             HG_KEY_WIDTH, HG_KEY_WIDTH, HG_WIDTH, HG_WIDTH,
             N_BRANCH * D_MODEL)
D_IN = sum(IN_SPLITS)

kernel_name = "hybrid_mla_hgrn2_gated_merge"


def rmsnorm(x, g):
    xf = x.astype(jnp.float32)
    y = xf * lax.rsqrt(jnp.mean(xf * xf, axis=-1, keepdims=True) + EPS)
    return (y * g.astype(jnp.float32)).astype(x.dtype)


def rope_tables(seq):
    inv = ROPE_THETA ** (-jnp.arange(0, MLA_ROPE, 2, dtype=jnp.float32) / MLA_ROPE)
    ang = jnp.arange(seq, dtype=jnp.float32)[:, None] * inv[None, :]
    return jnp.cos(ang), jnp.sin(ang)


def apply_rope(x, cos, sin):
    half = MLA_ROPE // 2
    xf = x.astype(jnp.float32)
    x1, x2 = xf[..., :half], xf[..., half:]
    c = cos[None, :, None, :]
    s = sin[None, :, None, :]
    return jnp.concatenate([x1 * c - x2 * s, x1 * s + x2 * c], axis=-1).astype(x.dtype)


def chunk_causal_attention(q, k, v):
    b, h, s, dq = q.shape
    nqb = s // Q_BLOCK
    qb = q.reshape(b, h, nqb, Q_BLOCK, dq).transpose(2, 0, 1, 3, 4)
    key_chunk = jnp.arange(s) // CHUNK
    q_chunk = (jnp.arange(s) // CHUNK).reshape(nqb, Q_BLOCK)
    scale = 1.0 / math.sqrt(dq)

    def one_block(args):
        qi, qc = args
        sc = jnp.einsum('bhqd,bhkd->bhqk', qi, k).astype(jnp.float32) * scale
        mask = key_chunk[None, :] <= qc[:, None]
        sc = jnp.where(mask, sc, -jnp.inf)
        p = jax.nn.softmax(sc, axis=-1).astype(v.dtype)
        return jnp.einsum('bhqk,bhkd->bhqd', p, v)

    out = lax.map(one_block, (qb, q_chunk))
    return out.transpose(1, 2, 0, 3, 4).reshape(b, h, s, -1)


def hgrn2_chunkwise(q, k, v, log_f):
    b, s, h, dk = q.shape
    dv = v.shape[-1]
    n = s // HG_BLOCK

    def blocks(t):
        return t.astype(jnp.float32).reshape(b, n, HG_BLOCK, h, -1).transpose(0, 3, 1, 2, 4)

    qc, kc, vc, gc = blocks(q), blocks(k), blocks(v), blocks(log_f)
    cum = jnp.cumsum(gc, axis=3)
    last = cum[..., -1:, :]
    q_dec = qc * jnp.exp(cum)
    k_inv = kc * jnp.exp(-cum)
    k_end = kc * jnp.exp(last - cum)
    causal = jnp.tril(jnp.ones((HG_BLOCK, HG_BLOCK), dtype=bool))
    a = jnp.where(causal, jnp.einsum('bhntk,bhnsk->bhnts', q_dec, k_inv), 0.0)
    o_intra = jnp.einsum('bhnts,bhnsv->bhntv', a, vc)
    upd = jnp.einsum('bhnsk,bhnsv->bhnkv', k_end, vc)
    decay = jnp.exp(last[..., 0, :])

    def step(state, xs):
        d, u = xs
        return d[..., None] * state + u, state

    init = jnp.zeros((b, h, dk, dv), jnp.float32)
    _, s_prev = lax.scan(step, init, (jnp.moveaxis(decay, 2, 0), jnp.moveaxis(upd, 2, 0)))
    s_prev = jnp.moveaxis(s_prev, 0, 2)
    o_inter = jnp.einsum('bhntk,bhnkv->bhntv', q_dec, s_prev)
    return (o_intra + o_inter).transpose(0, 2, 3, 1, 4).reshape(b, s, h, dv)


def setup_inputs(seed: int = 0) -> dict:
    key = jax.random.key(seed)
    ks = jax.random.split(key, 14)

    def nrm(k, shape, fan_in):
        return jax.random.normal(k, shape, jnp.float32) * (fan_in ** -0.5)

    def gain(k, shape):
        return 1.0 + 0.02 * jax.random.normal(k, shape, jnp.float32)

    return {
        "x": jax.random.normal(ks[0], (BATCH, SEQ, D_MODEL), jnp.float32),
        "g_pre": gain(ks[1], (DEPTH, D_MODEL)),
        "w_in": nrm(ks[2], (DEPTH, D_MODEL, D_IN), D_MODEL),
        "b_gate": 0.01 * jax.random.normal(ks[3], (DEPTH, N_BRANCH * D_MODEL), jnp.float32),
        "g_q": gain(ks[4], (DEPTH, Q_LORA)),
        "w_uq": nrm(ks[5], (DEPTH, Q_LORA, MLA_HEADS * MLA_QK), Q_LORA),
        "g_kv": gain(ks[6], (DEPTH, KV_LORA)),
        "w_ukv": nrm(ks[7], (DEPTH, KV_LORA, MLA_HEADS * (MLA_NOPE + MLA_V)), KV_LORA),
        "lb_logits": 0.1 * jax.random.normal(ks[8], (DEPTH + 1, HG_KEY_WIDTH), jnp.float32),
        "g_hgrn": gain(ks[9], (DEPTH, HG_DV)),
        "w_branch_a": nrm(ks[10], (DEPTH, MLA_WIDTH, D_MODEL), MLA_WIDTH),
        "w_branch_b": nrm(ks[11], (DEPTH, HG_WIDTH, D_MODEL), HG_WIDTH),
        "w_out": nrm(ks[12], (DEPTH, D_MODEL, D_MODEL), D_MODEL),
        "g_post": gain(ks[13], (DEPTH, D_MODEL)),
    }


def reference(x, g_pre, w_in, b_gate, g_q, w_uq, g_kv, w_ukv, lb_logits,
              g_hgrn, w_branch_a, w_branch_b, w_out, g_post):
    b, s, _ = x.shape
    cos, sin = rope_tables(s)
    split_at = [int(o) for o in np.cumsum(IN_SPLITS)[:-1]]
    lower_bounds = jnp.cumsum(jax.nn.softmax(lb_logits.astype(jnp.float32), axis=0), axis=0)

    for l in range(DEPTH):
        h = rmsnorm(x, g_pre[l])
        proj = h @ w_in[l]
        (c_q, c_kv, k_pe, gate_a, hq, hf, hi, gate_b, merge_logits) = jnp.split(proj, split_at, axis=-1)

        q = (rmsnorm(c_q, g_q[l]) @ w_uq[l]).reshape(b, s, MLA_HEADS, MLA_QK)
        q_nope, q_pe = q[..., :MLA_NOPE], apply_rope(q[..., MLA_NOPE:], cos, sin)
        kv = (rmsnorm(c_kv, g_kv[l]) @ w_ukv[l]).reshape(b, s, MLA_HEADS, MLA_NOPE + MLA_V)
        k_nope, v = kv[..., :MLA_NOPE], kv[..., MLA_NOPE:]
        k_pe = jnp.broadcast_to(apply_rope(k_pe[:, :, None, :], cos, sin), (b, s, MLA_HEADS, MLA_ROPE))
        qf = jnp.concatenate([q_nope, q_pe], axis=-1).transpose(0, 2, 1, 3)
        kf = jnp.concatenate([k_nope, k_pe], axis=-1).transpose(0, 2, 1, 3)
        vf = v.transpose(0, 2, 1, 3)
        attn = chunk_causal_attention(qf, kf, vf).transpose(0, 2, 1, 3).reshape(b, s, MLA_WIDTH)
        y_a = (attn * jax.nn.silu(gate_a)) @ w_branch_a[l]

        lb = lower_bounds[l]
        f = lb + (1.0 - lb) * jax.nn.sigmoid(hf.astype(jnp.float32))
        log_f = jnp.log(f).reshape(b, s, HG_HEADS, HG_DK)
        k_in = (1.0 - f).reshape(b, s, HG_HEADS, HG_DK)
        o = hgrn2_chunkwise(hq.reshape(b, s, HG_HEADS, HG_DK), k_in,
                            hi.reshape(b, s, HG_HEADS, HG_DV), log_f)
        o = rmsnorm(o, g_hgrn[l]).astype(x.dtype).reshape(b, s, HG_WIDTH)
        y_b = (o * jax.nn.silu(gate_b)) @ w_branch_b[l]

        gates = jax.nn.sigmoid((merge_logits + b_gate[l]).astype(jnp.float32)).astype(x.dtype)
        m = gates[..., :D_MODEL] * y_a + gates[..., D_MODEL:] * y_b
        y = m @ w_out[l]
        x = x + rmsnorm(y, g_post[l])
    return x
```

```cpp
#include <hip/hip_runtime.h>
#include <hip/hip_cooperative_groups.h>
#include <cstdio>
namespace cg = cooperative_groups;

#define DI __device__ __forceinline__
typedef unsigned short u16;
typedef unsigned int u32;
typedef __attribute__((ext_vector_type(8))) short bf16x8;
typedef __attribute__((ext_vector_type(4))) short s16x4;
typedef __attribute__((ext_vector_type(16))) float f32x16;
typedef __attribute__((ext_vector_type(2))) __bf16 bf2_t;
typedef __attribute__((ext_vector_type(2))) float f2_t;
typedef __attribute__((ext_vector_type(4))) unsigned int u4v;
typedef __attribute__((ext_vector_type(2))) unsigned int u2v;
typedef __attribute__((ext_vector_type(4))) float f4v;
typedef __attribute__((ext_vector_type(2))) float f2v;
#define MFMA(a, b, c) __builtin_amdgcn_mfma_f32_32x32x16_bf16((a), (b), (c), 0, 0, 0)

#ifndef ONE_LAUNCH
#define ONE_LAUNCH 0
#endif

constexpr int T = 32768;
constexpr int SEQ = 4096;
constexpr int DIN = 5664;
constexpr int NP = 5760;
constexpr float EPS = 1e-6f;
constexpr float QSCALE = 1.4426950408889634f * 0.10206207261596575f;

constexpr size_t SZ_WIN = (size_t)NP * 1024 * 2;
constexpr size_t OFF_WIN = 0;
constexpr size_t OFF_WUQ = OFF_WIN + SZ_WIN;
constexpr size_t OFF_WUKV = OFF_WUQ + (size_t)768 * 768 * 2;
constexpr size_t OFF_WA = OFF_WUKV + (size_t)1024 * 256 * 2;
constexpr size_t OFF_WB = OFF_WA + (size_t)1024 * 512 * 2;
constexpr size_t OFF_WO = OFF_WB + (size_t)1024 * 512 * 2;
constexpr size_t OFF_ROPE = OFF_WO + (size_t)1024 * 1024 * 2;
constexpr size_t OFF_SSQ = OFF_ROPE + (size_t)4096 * 16 * 2 * 4;
constexpr size_t OFF_DECAY = OFF_SSQ + (size_t)(3 * T + 64) * 4;
constexpr size_t OFF_H = OFF_DECAY + (size_t)64 * 128 * 64 * 4;
constexpr size_t OFF_UPD = OFF_H;
constexpr size_t OFF_CQ = OFF_H + (size_t)T * 1024 * 2;
constexpr size_t OFF_YA = OFF_CQ;
constexpr size_t OFF_CKV = OFF_CQ + (size_t)T * 768 * 2;
constexpr size_t OFF_KPE = OFF_CKV + (size_t)T * 256 * 2;
constexpr size_t OFF_SGA = OFF_KPE + (size_t)T * 32 * 4;
constexpr size_t OFF_SGB = OFF_SGA + (size_t)T * 512 * 2;
constexpr size_t OFF_QDEC = OFF_SGB + (size_t)T * 512 * 2;
constexpr size_t OFF_KINV = OFF_QDEC + (size_t)T * 512 * 2;
constexpr size_t OFF_KINVT = OFF_KINV + (size_t)T * 512 * 2;
constexpr size_t OFF_YB = OFF_KINVT;
constexpr size_t OFF_VT = OFF_KINVT + (size_t)T * 512 * 2;
constexpr size_t OFF_Q = OFF_VT + (size_t)T * 512 * 2;
constexpr size_t OFF_M = OFF_Q;
constexpr size_t OFF_K = OFF_Q + (size_t)T * 768 * 2;
constexpr size_t OFF_VTT = OFF_K + (size_t)T * 768 * 2;
constexpr size_t WS_NEED = OFF_VTT + (size_t)T * 512 * 2;

constexpr int LDS_BYTES = 2 * 2 * 128 * 72 * 2 + 64;
constexpr int SST = 132;

struct Params {
  const float *x, *g_pre, *w_in, *b_gate, *g_q, *w_uq, *g_kv, *w_ukv, *lb_logits, *g_hgrn, *w_a, *w_b, *w_out, *g_post;
  float* out;
  unsigned char* ws;
  int ph_lo, ph_hi;
};

DI u32 pk2(float a, float b) { f2_t v = {a, b}; bf2_t r = __builtin_convertvector(v, bf2_t); return __builtin_bit_cast(u32, r); }
DI float bflo(u32 u) { return __uint_as_float(u << 16); }
DI float bfhi(u32 u) { return __uint_as_float(u & 0xffff0000u); }
DI u4v pk8(f4v a, f4v b) { u4v r; r.x = pk2(a.x, a.y); r.y = pk2(a.z, a.w); r.z = pk2(b.x, b.y); r.w = pk2(b.z, b.w); return r; }
DI float rcpf(float x) { return __builtin_amdgcn_rcpf(x); }
DI float sigmoidf_(float x) { return rcpf(1.f + __expf(-x)); }
DI float siluf_(float x) { return x * sigmoidf_(x); }
DI int crow(int reg, int h) { return (reg & 3) + 8 * (reg >> 2) + 4 * h; }
DI f32x16 zero16() { f32x16 z;
#pragma unroll
  for (int i = 0; i < 16; ++i) z[i] = 0.f; return z; }

__constant__ float c_invfreq[16] = {1.0f, 0.5623413324356079f, 0.3162277638912201f, 0.17782793939113617f, 0.10000000149011612f,
  0.05623413249850273f, 0.03162277489900589f, 0.017782794311642647f, 0.009999999776482582f, 0.005623413249850273f,
  0.003162277629598975f, 0.0017782794311642647f, 0.0010000000474974513f, 0.000562341301701963f, 0.0003162277571391314f,
  0.00017782794020604342f};

DI void sincos_d(double a, float& sn, float& cs) {
  const double k = rint(a * 0.63661977236758134308);
  const double y = a - k * 1.57079632679489661923;
  const double y2 = y * y;
  const double s = y * (1.0 + y2 * (-1.0 / 6 + y2 * (1.0 / 120 + y2 * (-1.0 / 5040 + y2 * (1.0 / 362880 + y2 * (-1.0 / 39916800 + y2 * (1.0 / 6227020800.0)))))));
  const double c = 1.0 + y2 * (-0.5 + y2 * (1.0 / 24 + y2 * (-1.0 / 720 + y2 * (1.0 / 40320 + y2 * (-1.0 / 3628800 + y2 * (1.0 / 479001600.0 + y2 * (-1.0 / 87178291200.0)))))));
  const int q = ((int)k) & 3;
  const double ss = (q == 0) ? s : (q == 1) ? c : (q == 2) ? -s : -c;
  const double cc = (q == 0) ? c : (q == 1) ? -s : (q == 2) ? -c : s;
  sn = (float)ss; cs = (float)cc;
}

template <int KIND>
DI int colmap(int n) {
  if (KIND == 0) {
    if (n < 1024) return n;
    if (n < 1536) return 1056 + (n - 1024);
    if (n < 2560) { int i = n - 1536; int hh = i >> 7, c = i & 127; return (c < 64) ? (1568 + hh * 64 + c) : (2080 + hh * 64 + (c - 64)); }
    if (n < 3072) return 2592 + (n - 2560);
    if (n < 3584) return 3104 + (n - 3072);
    if (n < 5632) return 3616 + (n - 3584);
    if (n < 5664) return 1024 + (n - 5632);
    return -1;
  } else if (KIND == 1) {
    if (n < 512) return (n >> 6) * 96 + (n & 63);
    int i = n - 512; return (i >> 5) * 96 + 64 + (i & 31);
  } else return n;
}
template <int KIND>
DI void conv_weight(u16* dst, const float* src, int ldw, int ncount, int K, const float* gain, int gmask, int gtid, int gthreads) {
  const int total = ncount * (K >> 3);
  for (int it = gtid; it < total; it += gthreads) {
    const int n = it % ncount, kc = it / ncount;
    const int sc = colmap<KIND>(n);
    float v[8];
#pragma unroll
    for (int i = 0; i < 8; ++i) {
      const int k = kc * 8 + i;
      float x = (sc >= 0) ? src[(size_t)k * ldw + sc] : 0.f;
      if (gain) x *= gain[k & gmask];
      v[i] = x;
    }
    u4v o; o.x = pk2(v[0], v[1]); o.y = pk2(v[2], v[3]); o.z = pk2(v[4], v[5]); o.w = pk2(v[6], v[7]);
    *(u4v*)(dst + (size_t)n * K + kc * 8) = o;
  }
}

DI void phase0(const Params& p) {
  unsigned char* ws = p.ws;
  const int gtid = blockIdx.x * blockDim.x + threadIdx.x, gthreads = gridDim.x * blockDim.x;
  float* ssq = (float*)(ws + OFF_SSQ);
  for (int i = gtid; i < 3 * T + 64; i += gthreads) ssq[i] = 0.f;
  float* rope = (float*)(ws + OFF_ROPE);
  for (int i = gtid; i < 4096 * 16; i += gthreads) {
    const int pos = i >> 4, j = i & 15;
    const float ang = (float)pos * c_invfreq[j];
    float sn, cs; sincos_d((double)ang, sn, cs);
    rope[i] = cs; rope[65536 + i] = sn;
  }
  conv_weight<0>((u16*)(ws + OFF_WIN), p.w_in, DIN, NP, 1024, nullptr, 0, gtid, gthreads);
  conv_weight<1>((u16*)(ws + OFF_WUQ), p.w_uq, 768, 768, 768, p.g_q, 1023, gtid, gthreads);
  conv_weight<2>((u16*)(ws + OFF_WUKV), p.w_ukv, 1024, 1024, 256, p.g_kv, 255, gtid, gthreads);
  conv_weight<2>((u16*)(ws + OFF_WA), p.w_a, 1024, 1024, 512, nullptr, 0, gtid, gthreads);
  conv_weight<2>((u16*)(ws + OFF_WB), p.w_b, 1024, 1024, 512, p.g_hgrn, 63, gtid, gthreads);
  conv_weight<2>((u16*)(ws + OFF_WO), p.w_out, 1024, 1024, 1024, nullptr, 0, gtid, gthreads);
  u16* H = (u16*)(ws + OFF_H);
  const int lane = threadIdx.x & 63;
  const int gw = gtid >> 6, nw = gthreads >> 6;
  for (int row = gw; row < T; row += nw) {
    const f4v* xr = (const f4v*)(p.x + (size_t)row * 1024);
    f4v v[4];
    float ss = 0.f;
#pragma unroll
    for (int i = 0; i < 4; ++i) { v[i] = xr[lane * 4 + i]; ss += v[i].x * v[i].x + v[i].y * v[i].y + v[i].z * v[i].z + v[i].w * v[i].w; }
#pragma unroll
    for (int o = 32; o >= 1; o >>= 1) ss += __shfl_xor(ss, o);
    const float rs = rsqrtf(ss * (1.f / 1024.f) + EPS);
    const f4v* gp = (const f4v*)(p.g_pre);
    f4v g[4];
#pragma unroll
    for (int i = 0; i < 4; ++i) { g[i] = gp[lane * 4 + i]; v[i].x *= rs * g[i].x; v[i].y *= rs * g[i].y; v[i].z *= rs * g[i].z; v[i].w *= rs * g[i].w; }
    u4v* hr = (u4v*)(H + (size_t)row * 1024 + lane * 16);
    hr[0] = pk8(v[0], v[1]); hr[1] = pk8(v[2], v[3]);
  }
}

constexpr int TS = 128 * 72;
DI void gemm_core(const u16* __restrict__ A, int lda, const u16* __restrict__ B, int ldb, int K, u16* lds, f32x16 (&acc)[2][2], int tid) {
  const int lane = tid & 63, w = tid >> 6, wm = w >> 1, wn = w & 1, r = lane & 31, h = lane >> 5;
  const int lc = tid & 7, lr = tid >> 3;
  const u16* ga = A + (size_t)lr * lda + lc * 8;
  const u16* gb = B + (size_t)lr * ldb + lc * 8;
  u4v ra[4], rb[4];
#pragma unroll
  for (int i = 0; i < 4; ++i) { ra[i] = *(const u4v*)(ga + (size_t)(32 * i) * lda); rb[i] = *(const u4v*)(gb + (size_t)(32 * i) * ldb); }
#pragma unroll
  for (int i = 0; i < 2; ++i)
#pragma unroll
    for (int j = 0; j < 2; ++j) acc[i][j] = zero16();
  __syncthreads();
  {
    u16* sa = lds; u16* sb = lds + TS;
#pragma unroll
    for (int i = 0; i < 4; ++i) { *(u4v*)(sa + (lr + 32 * i) * 72 + lc * 8) = ra[i]; *(u4v*)(sb + (lr + 32 * i) * 72 + lc * 8) = rb[i]; }
  }
  __syncthreads();
  const int nk = K >> 6;
  for (int kt = 0; kt < nk; ++kt) {
    const int cur = kt & 1;
    if (kt + 1 < nk) {
      const int ko = (kt + 1) * 64;
#pragma unroll
      for (int i = 0; i < 4; ++i) { ra[i] = *(const u4v*)(ga + (size_t)(32 * i) * lda + ko); rb[i] = *(const u4v*)(gb + (size_t)(32 * i) * ldb + ko); }
    }
    const u16* sa = lds + cur * 2 * TS + (wm * 64 + r) * 72 + h * 8;
    const u16* sb = lds + cur * 2 * TS + TS + (wn * 64 + r) * 72 + h * 8;
#pragma unroll
    for (int ks = 0; ks < 4; ++ks) {
      const bf16x8 a0 = *(const bf16x8*)(sa + ks * 16);
      const bf16x8 a1 = *(const bf16x8*)(sa + 32 * 72 + ks * 16);
      const bf16x8 b0 = *(const bf16x8*)(sb + ks * 16);
      const bf16x8 b1 = *(const bf16x8*)(sb + 32 * 72 + ks * 16);
      acc[0][0] = MFMA(a0, b0, acc[0][0]);
      acc[0][1] = MFMA(a0, b1, acc[0][1]);
      acc[1][0] = MFMA(a1, b0, acc[1][0]);
      acc[1][1] = MFMA(a1, b1, acc[1][1]);
    }
    if (kt + 1 < nk) {
      u16* da = lds + (cur ^ 1) * 2 * TS; u16* db = da + TS;
#pragma unroll
      for (int i = 0; i < 4; ++i) { *(u4v*)(da + (lr + 32 * i) * 72 + lc * 8) = ra[i]; *(u4v*)(db + (lr + 32 * i) * 72 + lc * 8) = rb[i]; }
    }
    __syncthreads();
  }
}

DI void stage_pass(const f32x16 (&acc)[2][2], float* stage, int p, int tid) {
  const int lane = tid & 63, w = tid >> 6, wm = w >> 1, wn = w & 1, r = lane & 31, h = lane >> 5;
  __syncthreads();
  if (wm == p) {
#pragma unroll
    for (int i = 0; i < 2; ++i)
#pragma unroll
      for (int j = 0; j < 2; ++j)
#pragma unroll
        for (int reg = 0; reg < 16; ++reg) stage[(i * 32 + crow(reg, h)) * SST + wn * 64 + j * 32 + r] = acc[i][j][reg];
  }
  __syncthreads();
}

DI void phase1(const Params& p, u16* lds) {
  unsigned char* ws = p.ws;
  const int tid = threadIdx.x;
  const u16* H = (const u16*)(ws + OFF_H);
  const u16* W = (const u16*)(ws + OFF_WIN);
  float* stage = (float*)lds;
  float* ssq_q = (float*)(ws + OFF_SSQ);
  float* ssq_kv = ssq_q + T;
  for (int t = blockIdx.x; t < 256 * 45; t += gridDim.x) {
    const int x8 = t & 7, j = t >> 3;
    const int mt = 32 * x8 + 8 * (j / 360) + (j & 7);
    const int nt = (j % 360) >> 3;
    f32x16 acc[2][2];
    gemm_core(H + (size_t)mt * 128 * 1024, 1024, W + (size_t)nt * 128 * 1024, 1024, 1024, lds, acc, tid);
    const int row0 = mt * 128;
    const int b = row0 >> 12, spos0 = row0 & 4095;
#pragma unroll 1
    for (int ps = 0; ps < 2; ++ps) {
      stage_pass(acc, stage, ps, tid);
      const int prow0 = row0 + ps * 64;
      if (nt < 12 || (nt >= 24 && nt < 44)) {
#pragma unroll
        for (int it = 0; it < 4; ++it) {
          const int item = tid + 256 * it, rr = item >> 4, cc = (item & 15) * 8;
          f4v a = *(const f4v*)(stage + rr * SST + cc), c = *(const f4v*)(stage + rr * SST + cc + 4);
          const int grow = prow0 + rr;
          if (nt < 8) {
            float ss = a.x * a.x + a.y * a.y + a.z * a.z + a.w * a.w + c.x * c.x + c.y * c.y + c.z * c.z + c.w * c.w;
            ss += __shfl_xor(ss, 1); ss += __shfl_xor(ss, 2); ss += __shfl_xor(ss, 4); ss += __shfl_xor(ss, 8);
            if ((tid & 15) == 0) atomicAdd((nt < 6 ? ssq_q : ssq_kv) + grow, ss);
            if (nt < 6) *(u4v*)((u16*)(ws + OFF_CQ) + (size_t)grow * 768 + nt * 128 + cc) = pk8(a, c);
            else *(u4v*)((u16*)(ws + OFF_CKV) + (size_t)grow * 256 + (nt - 6) * 128 + cc) = pk8(a, c);
          } else if (nt < 28) {
            a.x = siluf_(a.x); a.y = siluf_(a.y); a.z = siluf_(a.z); a.w = siluf_(a.w);
            c.x = siluf_(c.x); c.y = siluf_(c.y); c.z = siluf_(c.z); c.w = siluf_(c.w);
            u16* dst = (nt < 12) ? (u16*)(ws + OFF_SGA) + (size_t)grow * 512 + (nt - 8) * 128 + cc
                                 : (u16*)(ws + OFF_SGB) + (size_t)grow * 512 + (nt - 24) * 128 + cc;
            *(u4v*)dst = pk8(a, c);
          } else {
            const int col = (nt - 28) * 128 + cc;
            const f4v b0 = *(const f4v*)(p.b_gate + col), b1 = *(const f4v*)(p.b_gate + col + 4);
            a.x = sigmoidf_(a.x + b0.x); a.y = sigmoidf_(a.y + b0.y); a.z = sigmoidf_(a.z + b0.z); a.w = sigmoidf_(a.w + b0.w);
            c.x = sigmoidf_(c.x + b1.x); c.y = sigmoidf_(c.y + b1.y); c.z = sigmoidf_(c.z + b1.z); c.w = sigmoidf_(c.w + b1.w);
            *(u4v*)((u16*)p.out + (size_t)grow * 2048 + col) = pk8(a, c);
          }
        }
      } else if (nt < 20) {
        const int hh = nt - 12;
        const int bh = b * 8 + hh;
        const int nblk0 = (spos0 + ps * 64) >> 5;
        if (tid < 128) {
          const int c = tid & 63, blk = tid >> 6;
          const float l0 = p.lb_logits[hh * 64 + c], l1 = p.lb_logits[512 + hh * 64 + c];
          const float lbv = 1.f / (1.f + expf(l1 - l0));
          float cum = 0.f;
          for (int rr = 0; rr < 32; ++rr) {
            float* sp = stage + (blk * 32 + rr) * SST + c;
            const float q = sp[0], hf = sp[64];
            const float sg = 1.f / (1.f + expf(-hf));
            const float f = lbv + (1.f - lbv) * sg;
            cum += logf(f);
            const float e = expf(cum);
            sp[0] = q * e;
            sp[64] = (1.f - f) / e;
          }
          ((float*)(ws + OFF_DECAY))[((size_t)bh * 128 + nblk0 + blk) * 64 + c] = expf(cum);
        }
        __syncthreads();
#pragma unroll
        for (int it = 0; it < 2; ++it) {
          const int item = tid + 256 * it, rr = item >> 3, cc = (item & 7) * 8;
          const f4v a = *(const f4v*)(stage + rr * SST + cc), c = *(const f4v*)(stage + rr * SST + cc + 4);
          const f4v d = *(const f4v*)(stage + rr * SST + 64 + cc), e = *(const f4v*)(stage + rr * SST + 64 + cc + 4);
          const size_t o = (size_t)(prow0 + rr) * 512 + hh * 64 + cc;
          *(u4v*)((u16*)(ws + OFF_QDEC) + o) = pk8(a, c);
          *(u4v*)((u16*)(ws + OFF_KINV) + o) = pk8(d, e);
        }
#pragma unroll
        for (int it = 0; it < 2; ++it) {
          const int item = tid + 256 * it, sc = item & 3, k = (item >> 2) & 63, blk = item >> 8;
          float v[8];
#pragma unroll
          for (int i = 0; i < 8; ++i) v[i] = stage[(blk * 32 + sc * 8 + i) * SST + 64 + k];
          u4v o; o.x = pk2(v[0], v[1]); o.y = pk2(v[2], v[3]); o.z = pk2(v[4], v[5]); o.w = pk2(v[6], v[7]);
          *(u4v*)((u16*)(ws + OFF_KINVT) + (((size_t)bh * 128 + nblk0 + blk) * 64 + k) * 32 + sc * 8) = o;
        }
      } else if (nt < 24) {
        const int nblk0 = (spos0 + ps * 64) >> 5;
#pragma unroll
        for (int it = 0; it < 4; ++it) {
          const int item = tid + 256 * it, sc = item & 3, col = (item >> 2) & 127, blk = item >> 9;
          float v[8];
#pragma unroll
          for (int i = 0; i < 8; ++i) v[i] = stage[(blk * 32 + sc * 8 + i) * SST + col];
          u4v o; o.x = pk2(v[0], v[1]); o.y = pk2(v[2], v[3]); o.z = pk2(v[4], v[5]); o.w = pk2(v[6], v[7]);
          const int bh = b * 8 + (nt - 20) * 2 + (col >> 6);
          *(u4v*)((u16*)(ws + OFF_VT) + (((size_t)bh * 128 + nblk0 + blk) * 64 + (col & 63)) * 32 + sc * 8) = o;
        }
      } else {
#pragma unroll
        for (int it = 0; it < 4; ++it) {
          const int item = tid + 256 * it, rr = item >> 4, cc = (item & 15) * 8;
          if (cc < 32) {
            const f4v a = *(const f4v*)(stage + rr * SST + cc), c = *(const f4v*)(stage + rr * SST + cc + 4);
            float* dst = (float*)(ws + OFF_KPE) + (size_t)(prow0 + rr) * 32 + cc;
            *(f4v*)dst = a; *(f4v*)(dst + 4) = c;
          }
        }
      }
    }
  }
}

DI void rope8(const float* x1, const float* x2, const float* rope, int spos, int j0, bool first, float scale, float (&o)[8]) {
  const f4v c0 = *(const f4v*)(rope + spos * 16 + j0), c1 = *(const f4v*)(rope + spos * 16 + j0 + 4);
  const f4v s0 = *(const f4v*)(rope + 65536 + spos * 16 + j0), s1 = *(const f4v*)(rope + 65536 + spos * 16 + j0 + 4);
  const float cs[8] = {c0.x, c0.y, c0.z, c0.w, c1.x, c1.y, c1.z, c1.w};
  const float sn[8] = {s0.x, s0.y, s0.z, s0.w, s1.x, s1.y, s1.z, s1.w};
#pragma unroll
  for (int i = 0; i < 8; ++i) o[i] = scale * (first ? (x1[i] * cs[i] - x2[i] * sn[i]) : (x1[i] * sn[i] + x2[i] * cs[i]));
}

DI void phase2(const Params& p, u16* lds) {
  unsigned char* ws = p.ws;
  const int tid = threadIdx.x;
  float* stage = (float*)lds;
  const float* ssq_q = (const float*)(ws + OFF_SSQ);
  const float* ssq_kv = ssq_q + T;
  const float* rope = (const float*)(ws + OFF_ROPE);
  u16* Qo = (u16*)(ws + OFF_Q);
  u16* Ko = (u16*)(ws + OFF_K);
  u16* Vo = (u16*)(ws + OFF_VTT);
  constexpr int NQ = 256 * 6, NKV = 256 * 8, NH1 = 2048;
  for (int t = blockIdx.x; t < NQ + NKV + NH1; t += gridDim.x) {
    if (t < NQ) {
      const int mt = t / 6, nt = t % 6;
      f32x16 acc[2][2];
      gemm_core((const u16*)(ws + OFF_CQ) + (size_t)mt * 128 * 768, 768, (const u16*)(ws + OFF_WUQ) + (size_t)nt * 128 * 768, 768, 768, lds, acc, tid);
      const int row0 = mt * 128, b = row0 >> 12, spos0 = row0 & 4095;
#pragma unroll 1
      for (int ps = 0; ps < 2; ++ps) {
        stage_pass(acc, stage, ps, tid);
#pragma unroll
        for (int it = 0; it < 4; ++it) {
          const int item = tid + 256 * it, rr = item >> 4, cc = (item & 15) * 8;
          const int grow = row0 + ps * 64 + rr, spos = spos0 + ps * 64 + rr;
          const float sc = rsqrtf(ssq_q[grow] * (1.f / 768.f) + EPS) * QSCALE;
          if (nt < 4) {
            f4v a = *(const f4v*)(stage + rr * SST + cc), c = *(const f4v*)(stage + rr * SST + cc + 4);
            a.x *= sc; a.y *= sc; a.z *= sc; a.w *= sc; c.x *= sc; c.y *= sc; c.z *= sc; c.w *= sc;
            const int head = nt * 2 + (cc >> 6), d = cc & 63;
            *(u4v*)(Qo + ((size_t)(b * 8 + head) * 4096 + spos) * 96 + d) = pk8(a, c);
          } else {
            const int head = (nt - 4) * 4 + (cc >> 5), wv = cc & 31, j0 = wv & 15, cb = cc - wv;
            float x1[8], x2[8], o[8];
#pragma unroll
            for (int i = 0; i < 8; ++i) { x1[i] = stage[rr * SST + cb + j0 + i]; x2[i] = stage[rr * SST + cb + 16 + j0 + i]; }
            rope8(x1, x2, rope, spos, j0, wv < 16, sc, o);
            u4v ov; ov.x = pk2(o[0], o[1]); ov.y = pk2(o[2], o[3]); ov.z = pk2(o[4], o[5]); ov.w = pk2(o[6], o[7]);
            *(u4v*)(Qo + ((size_t)(b * 8 + head) * 4096 + spos) * 96 + 64 + wv) = ov;
          }
        }
      }
    } else if (t < NQ + NKV) {
      const int tt = t - NQ;
      const int mt = tt >> 3, head = tt & 7;
      f32x16 acc[2][2];
      gemm_core((const u16*)(ws + OFF_CKV) + (size_t)mt * 128 * 256, 256, (const u16*)(ws + OFF_WUKV) + (size_t)head * 128 * 256, 256, 256, lds, acc, tid);
      const int row0 = mt * 128, b = row0 >> 12, spos0 = row0 & 4095;
      const int bh = b * 8 + head;
#pragma unroll 1
      for (int ps = 0; ps < 2; ++ps) {
        stage_pass(acc, stage, ps, tid);
        const int prow0 = row0 + ps * 64, pspos0 = spos0 + ps * 64;
#pragma unroll
        for (int it = 0; it < 2; ++it) {
          const int item = tid + 256 * it, rr = item >> 3, cc = (item & 7) * 8;
          const float sc = rsqrtf(ssq_kv[prow0 + rr] * (1.f / 256.f) + EPS);
          f4v a = *(const f4v*)(stage + rr * SST + cc), c = *(const f4v*)(stage + rr * SST + cc + 4);
          a.x *= sc; a.y *= sc; a.z *= sc; a.w *= sc; c.x *= sc; c.y *= sc; c.z *= sc; c.w *= sc;
          *(u4v*)(Ko + ((size_t)bh * 4096 + pspos0 + rr) * 96 + cc) = pk8(a, c);
        }
#pragma unroll
        for (int it = 0; it < 2; ++it) {
          const int item = tid + 256 * it, sc8 = item & 7, dv = item >> 3;
          const f4v q0 = *(const f4v*)(ssq_kv + prow0 + sc8 * 8), q1 = *(const f4v*)(ssq_kv + prow0 + sc8 * 8 + 4);
          const float qs[8] = {q0.x, q0.y, q0.z, q0.w, q1.x, q1.y, q1.z, q1.w};
          float v[8];
#pragma unroll
          for (int i = 0; i < 8; ++i) v[i] = stage[(sc8 * 8 + i) * SST + 64 + dv] * rsqrtf(qs[i] * (1.f / 256.f) + EPS);
          u4v o; o.x = pk2(v[0], v[1]); o.y = pk2(v[2], v[3]); o.z = pk2(v[4], v[5]); o.w = pk2(v[6], v[7]);
          *(u4v*)(Vo + ((size_t)bh * 64 + dv) * 4096 + pspos0 + sc8 * 8) = o;
        }
        {
          const int rr = tid >> 2, wv = (tid & 3) * 8, j0 = wv & 15;
          const float* kp = (const float*)(ws + OFF_KPE) + (size_t)(prow0 + rr) * 32;
          const f4v a0 = *(const f4v*)(kp + j0), a1 = *(const f4v*)(kp + j0 + 4);
          const f4v b0 = *(const f4v*)(kp + 16 + j0), b1 = *(const f4v*)(kp + 16 + j0 + 4);
          const float x1[8] = {a0.x, a0.y, a0.z, a0.w, a1.x, a1.y, a1.z, a1.w};
          const float x2[8] = {b0.x, b0.y, b0.z, b0.w, b1.x, b1.y, b1.z, b1.w};
          float o[8];
          rope8(x1, x2, rope, pspos0 + rr, j0, wv < 16, 1.f, o);
          u4v ov; ov.x = pk2(o[0], o[1]); ov.y = pk2(o[2], o[3]); ov.z = pk2(o[4], o[5]); ov.w = pk2(o[6], o[7]);
          *(u4v*)(Ko + ((size_t)bh * 4096 + pspos0 + rr) * 96 + 64 + wv) = ov;
        }
      }
    } else {
      const int idx = t - NQ - NKV;
      const int bh = idx >> 5, n = (idx & 31) * 4 + (tid >> 6);
      const int lane = tid & 63, r = lane & 31, h = lane >> 5;
      const u16* kt = (const u16*)(ws + OFF_KINVT) + ((size_t)bh * 128 + n) * 64 * 32;
      const u16* vt = (const u16*)(ws + OFF_VT) + ((size_t)bh * 128 + n) * 64 * 32;
      bf16x8 a[2][2], bb[2][2];
#pragma unroll
      for (int i = 0; i < 2; ++i)
#pragma unroll
        for (int ks = 0; ks < 2; ++ks) {
          a[i][ks] = *(const bf16x8*)(kt + (i * 32 + r) * 32 + ks * 16 + h * 8);
          bb[i][ks] = *(const bf16x8*)(vt + (i * 32 + r) * 32 + ks * 16 + h * 8);
        }
      u16* up = (u16*)(ws + OFF_UPD) + ((size_t)bh * 128 + n) * 4096;
#pragma unroll
      for (int kb = 0; kb < 2; ++kb)
#pragma unroll
        for (int vb = 0; vb < 2; ++vb) {
          f32x16 c = zero16();
          c = MFMA(a[kb][0], bb[vb][0], c);
          c = MFMA(a[kb][1], bb[vb][1], c);
#pragma unroll
          for (int g = 0; g < 4; ++g) {
            u2v o; o.x = pk2(c[4 * g], c[4 * g + 1]); o.y = pk2(c[4 * g + 2], c[4 * g + 3]);
            *(u2v*)(up + (vb * 32 + r) * 64 + kb * 32 + 8 * g + 4 * h) = o;
          }
        }
    }
  }
}

constexpr int KST = 104, VST = 72;
constexpr int ATT_BUF = 64 * KST + 64 * VST;

DI void attn_item(const Params& p, u16* lds, int bh, int qt) {
  unsigned char* ws = p.ws;
  const int tid = threadIdx.x, lane = tid & 63, w = tid >> 6, r = lane & 31, h = lane >> 5;
  const u16* Qp = (const u16*)(ws + OFF_Q) + (size_t)bh * 4096 * 96;
  const u16* Kp = (const u16*)(ws + OFF_K) + (size_t)bh * 4096 * 96;
  const u16* Vp = (const u16*)(ws + OFF_VTT) + (size_t)bh * 64 * 4096;
  const int q0 = qt * 128 + w * 32;
  bf16x8 qf[6];
#pragma unroll
  for (int ks = 0; ks < 6; ++ks) qf[ks] = *(const bf16x8*)(Qp + (size_t)(q0 + r) * 96 + ks * 16 + h * 8);
  f32x16 o[2]; o[0] = zero16(); o[1] = zero16();
  float m = -1e30f, l = 0.f;
  const int jmax = 2 * qt + 1, jw = 2 * qt + (w >> 1);
  int kr[3], kc[3];
#pragma unroll
  for (int i = 0; i < 3; ++i) { const int idx = tid + 256 * i; kr[i] = idx / 12; kc[i] = idx % 12; }
  const int vr0 = tid >> 3, vc = tid & 7;
  u4v rk[3], rv[2];
#pragma unroll
  for (int i = 0; i < 3; ++i) rk[i] = *(const u4v*)(Kp + (size_t)kr[i] * 96 + kc[i] * 8);
#pragma unroll
  for (int i = 0; i < 2; ++i) rv[i] = *(const u4v*)(Vp + (size_t)(vr0 + 32 * i) * 4096 + vc * 8);
  __syncthreads();
  {
#pragma unroll
    for (int i = 0; i < 3; ++i) *(u4v*)(lds + kr[i] * KST + kc[i] * 8) = rk[i];
#pragma unroll
    for (int i = 0; i < 2; ++i) *(u4v*)(lds + 64 * KST + (vr0 + 32 * i) * VST + vc * 8) = rv[i];
  }
  __syncthreads();
  for (int j = 0; j <= jmax; ++j) {
    const int cur = j & 1;
    if (j < jmax) {
#pragma unroll
      for (int i = 0; i < 3; ++i) rk[i] = *(const u4v*)(Kp + (size_t)((j + 1) * 64 + kr[i]) * 96 + kc[i] * 8);
#pragma unroll
      for (int i = 0; i < 2; ++i) rv[i] = *(const u4v*)(Vp + (size_t)(vr0 + 32 * i) * 4096 + (j + 1) * 64 + vc * 8);
    }
    if (j <= jw) {
      const u16* sk = lds + cur * ATT_BUF + r * KST + h * 8;
      const u16* sv = lds + cur * ATT_BUF + 64 * KST + r * VST + 4 * h;
      f32x16 st[2]; st[0] = zero16(); st[1] = zero16();
#pragma unroll
      for (int kb = 0; kb < 2; ++kb)
#pragma unroll
        for (int ks = 0; ks < 6; ++ks) {
          const bf16x8 kf = *(const bf16x8*)(sk + kb * 32 * KST + ks * 16);
          st[kb] = MFMA(kf, qf[ks], st[kb]);
        }
      float mx = st[0][0];
#pragma unroll
      for (int i = 1; i < 16; ++i) mx = fmaxf(mx, st[0][i]);
#pragma unroll
      for (int i = 0; i < 16; ++i) mx = fmaxf(mx, st[1][i]);
      mx = fmaxf(mx, __shfl_xor(mx, 32));
      const float mn = fmaxf(m, mx);
      const float alpha = __builtin_amdgcn_exp2f(m - mn);
      m = mn;
      float psum = 0.f;
#pragma unroll
      for (int kb = 0; kb < 2; ++kb)
#pragma unroll
        for (int i = 0; i < 16; ++i) { const float pv = __builtin_amdgcn_exp2f(st[kb][i] - mn); st[kb][i] = pv; psum += pv; }
      l = l * alpha + psum;
#pragma unroll
      for (int i = 0; i < 16; ++i) { o[0][i] *= alpha; o[1][i] *= alpha; }
#pragma unroll
      for (int s4 = 0; s4 < 4; ++s4) {
        const int kb = s4 >> 1, rb = 8 * (s4 & 1);
        u4v pu; pu.x = pk2(st[kb][rb], st[kb][rb + 1]); pu.y = pk2(st[kb][rb + 2], st[kb][rb + 3]);
        pu.z = pk2(st[kb][rb + 4], st[kb][rb + 5]); pu.w = pk2(st[kb][rb + 6], st[kb][rb + 7]);
        const bf16x8 pb = __builtin_bit_cast(bf16x8, pu);
#pragma unroll
        for (int db = 0; db < 2; ++db) {
          const s16x4 lo = *(const s16x4*)(sv + db * 32 * VST + 16 * s4);
          const s16x4 hi = *(const s16x4*)(sv + db * 32 * VST + 16 * s4 + 8);
          const bf16x8 vf = __builtin_shufflevector(lo, hi, 0, 1, 2, 3, 4, 5, 6, 7);
          o[db] = MFMA(vf, pb, o[db]);
        }
      }
    }
    if (j < jmax) {
      u16* d = lds + (cur ^ 1) * ATT_BUF;
#pragma unroll
      for (int i = 0; i < 3; ++i) *(u4v*)(d + kr[i] * KST + kc[i] * 8) = rk[i];
#pragma unroll
      for (int i = 0; i < 2; ++i) *(u4v*)(d + 64 * KST + (vr0 + 32 * i) * VST + vc * 8) = rv[i];
    }
    __syncthreads();
  }
  l += __shfl_xor(l, 32);
  const float inv = 1.f / l;
  const int b = bh >> 3, head = bh & 7;
  const size_t tok = (size_t)b * 4096 + q0 + r;
  const u16* sga = (const u16*)(ws + OFF_SGA) + tok * 512 + head * 64;
  u16* ya = (u16*)(ws + OFF_YA) + tok * 512 + head * 64;
#pragma unroll
  for (int db = 0; db < 2; ++db)
#pragma unroll
    for (int g = 0; g < 4; ++g) {
      const int dv0 = db * 32 + 8 * g + 4 * h;
      const u2v gt = *(const u2v*)(sga + dv0);
      u2v ov;
      ov.x = pk2(o[db][4 * g] * inv * bflo(gt.x), o[db][4 * g + 1] * inv * bfhi(gt.x));
      ov.y = pk2(o[db][4 * g + 2] * inv * bflo(gt.y), o[db][4 * g + 3] * inv * bfhi(gt.y));
      *(u2v*)(ya + dv0) = ov;
    }
}

DI void scan_item(const Params& p, int i) {
  unsigned char* ws = p.ws;
  const int tid = threadIdx.x;
  const int bh = i >> 3, part = i & 7;
  const int e = part * 512 + tid * 2, k = e & 63;
  u32* U = (u32*)((u16*)(ws + OFF_UPD) + (size_t)bh * 128 * 4096 + e);
  const f2v* Dc = (const f2v*)((const float*)(ws + OFF_DECAY) + (size_t)bh * 128 * 64 + k);
  float s0 = 0.f, s1 = 0.f;
  for (int n0 = 0; n0 < 128; n0 += 8) {
    u32 u[8]; f2v d[8];
#pragma unroll
    for (int q = 0; q < 8; ++q) { u[q] = U[(size_t)(n0 + q) * 2048]; d[q] = Dc[(n0 + q) * 32]; }
#pragma unroll
    for (int q = 0; q < 8; ++q) {
      U[(size_t)(n0 + q) * 2048] = pk2(s0, s1);
      s0 = d[q].x * (s0 + bflo(u[q]));
      s1 = d[q].y * (s1 + bfhi(u[q]));
    }
  }
}

DI void phase3(const Params& p, u16* lds) {
  int* s_item = (int*)((unsigned char*)lds + LDS_BYTES - 64);
  int* ctr = (int*)(p.ws + OFF_SSQ + (size_t)3 * T * 4);
  constexpr int NSCAN = 512, NATT = 2048;
  for (;;) {
    __syncthreads();
    if (threadIdx.x == 0) *s_item = atomicAdd(ctr, 1);
    __syncthreads();
    const int item = *s_item;
    if (item >= NSCAN + NATT) break;
    if (item < NSCAN) scan_item(p, item);
    else { const int idx = item - NSCAN; attn_item(p, lds, idx & 63, 31 - (idx >> 6)); }
  }
}

DI void phase4(const Params& p) {
  unsigned char* ws = p.ws;
  const int tid = threadIdx.x, lane = tid & 63, w = tid >> 6, r = lane & 31, h = lane >> 5;
  for (int t = blockIdx.x; t < 2048; t += gridDim.x) {
    const int bh = t >> 5, n = (t & 31) * 4 + w;
    const int b = bh >> 3, head = bh & 7;
    const size_t tok0 = (size_t)b * 4096 + n * 32;
    const u16* qd = (const u16*)(ws + OFF_QDEC) + (tok0 + r) * 512 + head * 64 + h * 8;
    const u16* ki = (const u16*)(ws + OFF_KINV) + (tok0 + r) * 512 + head * 64 + h * 8;
    const u16* vt = (const u16*)(ws + OFF_VT) + ((size_t)bh * 128 + n) * 64 * 32;
    const u16* sp = (const u16*)(ws + OFF_UPD) + ((size_t)bh * 128 + n) * 4096;
    bf16x8 qf[4], kf[4];
#pragma unroll
    for (int ks = 0; ks < 4; ++ks) { qf[ks] = *(const bf16x8*)(qd + ks * 16); kf[ks] = *(const bf16x8*)(ki + ks * 16); }
    f32x16 at = zero16();
#pragma unroll
    for (int ks = 0; ks < 4; ++ks) at = MFMA(kf[ks], qf[ks], at);
#pragma unroll
    for (int i = 0; i < 16; ++i) if (crow(i, h) > r) at[i] = 0.f;
    f32x16 o[2]; o[0] = zero16(); o[1] = zero16();
#pragma unroll
    for (int s2 = 0; s2 < 2; ++s2) {
      u4v pu; pu.x = pk2(at[8 * s2], at[8 * s2 + 1]); pu.y = pk2(at[8 * s2 + 2], at[8 * s2 + 3]);
      pu.z = pk2(at[8 * s2 + 4], at[8 * s2 + 5]); pu.w = pk2(at[8 * s2 + 6], at[8 * s2 + 7]);
      const bf16x8 pb = __builtin_bit_cast(bf16x8, pu);
#pragma unroll
      for (int vb = 0; vb < 2; ++vb) {
        const s16x4 lo = *(const s16x4*)(vt + (vb * 32 + r) * 32 + 16 * s2 + 4 * h);
        const s16x4 hi = *(const s16x4*)(vt + (vb * 32 + r) * 32 + 16 * s2 + 8 + 4 * h);
        const bf16x8 vf = __builtin_shufflevector(lo, hi, 0, 1, 2, 3, 4, 5, 6, 7);
        o[vb] = MFMA(vf, pb, o[vb]);
      }
    }
#pragma unroll
    for (int vb = 0; vb < 2; ++vb)
#pragma unroll
      for (int ks = 0; ks < 4; ++ks) {
        const bf16x8 sf = *(const bf16x8*)(sp + (vb * 32 + r) * 64 + ks * 16 + h * 8);
        o[vb] = MFMA(sf, qf[ks], o[vb]);
      }
    float ss = 0.f;
#pragma unroll
    for (int i = 0; i < 16; ++i) ss += o[0][i] * o[0][i] + o[1][i] * o[1][i];
    ss += __shfl_xor(ss, 32);
    const float rs = rsqrtf(ss * (1.f / 64.f) + EPS);
    const u16* sgb = (const u16*)(ws + OFF_SGB) + (tok0 + r) * 512 + head * 64;
    u16* yb = (u16*)(ws + OFF_YB) + (tok0 + r) * 512 + head * 64;
#pragma unroll
    for (int vb = 0; vb < 2; ++vb)
#pragma unroll
      for (int g = 0; g < 4; ++g) {
        const int v0 = vb * 32 + 8 * g + 4 * h;
        const u2v gt = *(const u2v*)(sgb + v0);
        u2v ov;
        ov.x = pk2(o[vb][4 * g] * rs * bflo(gt.x), o[vb][4 * g + 1] * rs * bfhi(gt.x));
        ov.y = pk2(o[vb][4 * g + 2] * rs * bflo(gt.y), o[vb][4 * g + 3] * rs * bfhi(gt.y));
        *(u2v*)(yb + v0) = ov;
      }
  }
}

DI void phase5(const Params& p, u16* lds) {
  unsigned char* ws = p.ws;
  const int tid = threadIdx.x;
  float* stage = (float*)lds;
  const u16* MG = (const u16*)p.out;
  u16* Mo = (u16*)(ws + OFF_M);
  for (int t = blockIdx.x; t < 2048; t += gridDim.x) {
    const int mt = t >> 3, nt = t & 7;
    const int row0 = mt * 128;
    float* tmp = (float*)(ws + OFF_VTT) + (size_t)blockIdx.x * 16384 + tid * 8;
    {
      f32x16 acc[2][2];
      gemm_core((const u16*)(ws + OFF_YA) + (size_t)row0 * 512, 512, (const u16*)(ws + OFF_WA) + (size_t)nt * 128 * 512, 512, 512, lds, acc, tid);
#pragma unroll
      for (int ps = 0; ps < 2; ++ps) {
        stage_pass(acc, stage, ps, tid);
#pragma unroll
        for (int it = 0; it < 4; ++it) {
          const int item = tid + 256 * it, rr = item >> 4, cc = (item & 15) * 8;
          const u4v g = *(const u4v*)(MG + (size_t)(row0 + ps * 64 + rr) * 2048 + nt * 128 + cc);
          const f4v a = *(const f4v*)(stage + rr * SST + cc), c = *(const f4v*)(stage + rr * SST + cc + 4);
          *(f4v*)(tmp + (ps * 4 + it) * 2048) = f4v{a.x * bflo(g.x), a.y * bfhi(g.x), a.z * bflo(g.y), a.w * bfhi(g.y)};
          *(f4v*)(tmp + (ps * 4 + it) * 2048 + 4) = f4v{c.x * bflo(g.z), c.y * bfhi(g.z), c.z * bflo(g.w), c.w * bfhi(g.w)};
        }
      }
    }
    {
      f32x16 acc[2][2];
      gemm_core((const u16*)(ws + OFF_YB) + (size_t)row0 * 512, 512, (const u16*)(ws + OFF_WB) + (size_t)nt * 128 * 512, 512, 512, lds, acc, tid);
#pragma unroll
      for (int ps = 0; ps < 2; ++ps) {
        stage_pass(acc, stage, ps, tid);
#pragma unroll
        for (int it = 0; it < 4; ++it) {
          const int item = tid + 256 * it, rr = item >> 4, cc = (item & 15) * 8;
          const u4v g = *(const u4v*)(MG + (size_t)(row0 + ps * 64 + rr) * 2048 + 1024 + nt * 128 + cc);
          const f4v a = *(const f4v*)(stage + rr * SST + cc), c = *(const f4v*)(stage + rr * SST + cc + 4);
          f4v k0 = *(const f4v*)(tmp + (ps * 4 + it) * 2048), k1 = *(const f4v*)(tmp + (ps * 4 + it) * 2048 + 4);
          k0.x += a.x * bflo(g.x); k0.y += a.y * bfhi(g.x); k0.z += a.z * bflo(g.y); k0.w += a.w * bfhi(g.y);
          k1.x += c.x * bflo(g.z); k1.y += c.y * bfhi(g.z); k1.z += c.z * bflo(g.w); k1.w += c.w * bfhi(g.w);
          *(u4v*)(Mo + (size_t)(row0 + ps * 64 + rr) * 1024 + nt * 128 + cc) = pk8(k0, k1);
        }
      }
    }
  }
}

DI void phase6(const Params& p, u16* lds) {
  unsigned char* ws = p.ws;
  const int tid = threadIdx.x;
  float* stage = (float*)lds;
  float* ssq_y = (float*)(ws + OFF_SSQ) + 2 * T;
  for (int t = blockIdx.x; t < 2048; t += gridDim.x) {
    const int mt = t >> 3, nt = t & 7;
    const int row0 = mt * 128;
    f32x16 acc[2][2];
    gemm_core((const u16*)(ws + OFF_M) + (size_t)row0 * 1024, 1024, (const u16*)(ws + OFF_WO) + (size_t)nt * 128 * 1024, 1024, 1024, lds, acc, tid);
#pragma unroll 1
    for (int ps = 0; ps < 2; ++ps) {
      stage_pass(acc, stage, ps, tid);
#pragma unroll
      for (int it = 0; it < 4; ++it) {
        const int item = tid + 256 * it, rr = item >> 4, cc = (item & 15) * 8;
        const int grow = row0 + ps * 64 + rr;
        const f4v a = *(const f4v*)(stage + rr * SST + cc), c = *(const f4v*)(stage + rr * SST + cc + 4);
        float ss = a.x * a.x + a.y * a.y + a.z * a.z + a.w * a.w + c.x * c.x + c.y * c.y + c.z * c.z + c.w * c.w;
        ss += __shfl_xor(ss, 1); ss += __shfl_xor(ss, 2); ss += __shfl_xor(ss, 4); ss += __shfl_xor(ss, 8);
        if ((tid & 15) == 0) atomicAdd(ssq_y + grow, ss);
        float* dst = p.out + (size_t)grow * 1024 + nt * 128 + cc;
        *(f4v*)dst = a; *(f4v*)(dst + 4) = c;
      }
    }
  }
}

DI void phase7(const Params& p) {
  const float* ssq_y = (const float*)(p.ws + OFF_SSQ) + 2 * T;
  const int gtid = blockIdx.x * blockDim.x + threadIdx.x, gthreads = gridDim.x * blockDim.x;
  for (int i = gtid; i < T * 256; i += gthreads) {
    const int row = i >> 8, c4 = i & 255;
    const float rs = rsqrtf(ssq_y[row] * (1.f / 1024.f) + EPS);
    const f4v y = ((const f4v*)p.out)[i];
    const f4v xv = ((const f4v*)p.x)[i];
    const f4v g = ((const f4v*)p.g_post)[c4];
    f4v o;
    o.x = xv.x + y.x * rs * g.x; o.y = xv.y + y.y * rs * g.y; o.z = xv.z + y.z * rs * g.z; o.w = xv.w + y.w * rs * g.w;
    ((f4v*)p.out)[i] = o;
  }
}

__global__ void __launch_bounds__(256, 2) fwd_megakernel(Params p) {
  extern __shared__ __attribute__((aligned(16))) unsigned char smem[];
  u16* lds = (u16*)smem;
  cg::grid_group grid = cg::this_grid();
#define RUN_PHASE(N, CALL) if (p.ph_lo <= N && N < p.ph_hi) { if (N > p.ph_lo) grid.sync(); CALL; }
  RUN_PHASE(0, phase0(p))
  RUN_PHASE(1, phase1(p, lds))
  RUN_PHASE(2, phase2(p, lds))
  RUN_PHASE(3, phase3(p, lds))
  RUN_PHASE(4, phase4(p))
  RUN_PHASE(5, phase5(p, lds))
  RUN_PHASE(6, phase6(p, lds))
  RUN_PHASE(7, phase7(p))
}

extern "C" void kernel_launch(void* const* d_in, const int* in_sizes, int n_in, void* d_out, int out_size, void* d_ws, size_t ws_size,
                              hipStream_t stream) {
  static int grid_blocks = 0;
  if (!grid_blocks) {
    int dev = 0, cus = 0, per_cu = 0;
    hipGetDevice(&dev);
    hipDeviceGetAttribute(&cus, hipDeviceAttributeMultiprocessorCount, dev);
    hipFuncSetAttribute((const void*)fwd_megakernel, hipFuncAttributeMaxDynamicSharedMemorySize, LDS_BYTES);
    hipOccupancyMaxActiveBlocksPerMultiprocessor(&per_cu, (const void*)fwd_megakernel, 256, LDS_BYTES);
    if (per_cu < 1) per_cu = 1;
    if (per_cu > 2) per_cu = 2;
    grid_blocks = cus * per_cu;
    if (ws_size < WS_NEED) fprintf(stderr, "kernel_launch: workspace too small: %zu < %zu\n", ws_size, (size_t)WS_NEED);
  }
  if (ws_size < WS_NEED) return;
  Params p{};
  p.x = (const float*)d_in[0]; p.g_pre = (const float*)d_in[1]; p.w_in = (const float*)d_in[2]; p.b_gate = (const float*)d_in[3];
  p.g_q = (const float*)d_in[4]; p.w_uq = (const float*)d_in[5]; p.g_kv = (const float*)d_in[6]; p.w_ukv = (const float*)d_in[7];
  p.lb_logits = (const float*)d_in[8]; p.g_hgrn = (const float*)d_in[9]; p.w_a = (const float*)d_in[10]; p.w_b = (const float*)d_in[11];
  p.w_out = (const float*)d_in[12]; p.g_post = (const float*)d_in[13];
  p.out = (float*)d_out; p.ws = (unsigned char*)d_ws;
#if ONE_LAUNCH
  p.ph_lo = 0; p.ph_hi = 8;
  void* args[] = {&p};
  hipError_t e = hipLaunchCooperativeKernel((const void*)fwd_megakernel, dim3(grid_blocks), dim3(256), args, LDS_BYTES, stream);
  if (e != hipSuccess) fprintf(stderr, "cooperative launch failed: %s (grid %d)\n", hipGetErrorString(e), grid_blocks);
#else
  for (int ph = 0; ph < 8; ++ph) {
    p.ph_lo = ph; p.ph_hi = ph + 1;
    void* args[] = {&p};
    hipError_t e = hipLaunchCooperativeKernel((const void*)fwd_megakernel, dim3(grid_blocks), dim3(256), args, LDS_BYTES, stream);
    if (e != hipSuccess) fprintf(stderr, "cooperative launch failed: %s (grid %d)\n", hipGetErrorString(e), grid_blocks);
  }
#endif
}
```

```cpp
#include <hip/hip_runtime.h>
#include <hip/hip_cooperative_groups.h>
#include <cstdio>
namespace cg = cooperative_groups;

#define DI __device__ __forceinline__
typedef unsigned short u16;
typedef unsigned int u32;
typedef __attribute__((ext_vector_type(8))) short bf16x8;
typedef __attribute__((ext_vector_type(4))) short s16x4;
typedef __attribute__((ext_vector_type(16))) float f32x16;
typedef __attribute__((ext_vector_type(2))) __bf16 bf2_t;
typedef __attribute__((ext_vector_type(2))) float f2_t;
typedef __attribute__((ext_vector_type(4))) unsigned int u4v;
typedef __attribute__((ext_vector_type(2))) unsigned int u2v;
typedef __attribute__((ext_vector_type(4))) float f4v;
typedef __attribute__((ext_vector_type(2))) float f2v;
#define MFMA(a, b, c) __builtin_amdgcn_mfma_f32_32x32x16_bf16((a), (b), (c), 0, 0, 0)

#ifndef ONE_LAUNCH
#define ONE_LAUNCH 1
#endif

constexpr int T = 32768;
constexpr int SEQ = 4096;
constexpr int DIN = 5664;
constexpr int NP = 5760;
constexpr float EPS = 1e-6f;
constexpr float QSCALE = 1.4426950408889634f * 0.10206207261596575f;

constexpr size_t SZ_WIN = (size_t)NP * 1024 * 2;
constexpr size_t OFF_WIN = 0;
constexpr size_t OFF_WUQ = OFF_WIN + SZ_WIN;
constexpr size_t OFF_WUKV = OFF_WUQ + (size_t)768 * 768 * 2;
constexpr size_t OFF_WA = OFF_WUKV + (size_t)1024 * 256 * 2;
constexpr size_t OFF_WB = OFF_WA + (size_t)1024 * 512 * 2;
constexpr size_t OFF_WO = OFF_WB + (size_t)1024 * 512 * 2;
constexpr size_t OFF_ROPE = OFF_WO + (size_t)1024 * 1024 * 2;
constexpr size_t OFF_SSQ = OFF_ROPE + (size_t)4096 * 16 * 2 * 4;
constexpr size_t OFF_DECAY = OFF_SSQ + (size_t)(3 * T + 64) * 4;
constexpr size_t OFF_H = OFF_DECAY + (size_t)64 * 128 * 64 * 4;
constexpr size_t OFF_UPD = OFF_H;
constexpr size_t OFF_CQ = OFF_H + (size_t)T * 1024 * 2;
constexpr size_t OFF_YA = OFF_CQ;
constexpr size_t OFF_CKV = OFF_CQ + (size_t)T * 768 * 2;
constexpr size_t OFF_KPE = OFF_CKV + (size_t)T * 256 * 2;
constexpr size_t OFF_SGA = OFF_KPE + (size_t)T * 32 * 4;
constexpr size_t OFF_SGB = OFF_SGA + (size_t)T * 512 * 2;
constexpr size_t OFF_QDEC = OFF_SGB + (size_t)T * 512 * 2;
constexpr size_t OFF_KINV = OFF_QDEC + (size_t)T * 512 * 2;
constexpr size_t OFF_KINVT = OFF_KINV + (size_t)T * 512 * 2;
constexpr size_t OFF_YB = OFF_KINVT;
constexpr size_t OFF_VT = OFF_KINVT + (size_t)T * 512 * 2;
constexpr size_t OFF_Q = OFF_VT + (size_t)T * 512 * 2;
constexpr size_t OFF_M = OFF_Q;
constexpr size_t OFF_K = OFF_Q + (size_t)T * 768 * 2;
constexpr size_t OFF_VTT = OFF_K + (size_t)T * 768 * 2;
constexpr size_t WS_NEED = OFF_VTT + (size_t)T * 512 * 2;

constexpr int LDS_BYTES = 2 * 2 * 128 * 72 * 2 + 64;
constexpr int SST = 132;

struct Params {
  const float *x, *g_pre, *w_in, *b_gate, *g_q, *w_uq, *g_kv, *w_ukv, *lb_logits, *g_hgrn, *w_a, *w_b, *w_out, *g_post;
  float* out;
  unsigned char* ws;
  int ph_lo, ph_hi;
};

DI u32 pk2(float a, float b) { f2_t v = {a, b}; bf2_t r = __builtin_convertvector(v, bf2_t); return __builtin_bit_cast(u32, r); }
DI float bflo(u32 u) { return __uint_as_float(u << 16); }
DI float bfhi(u32 u) { return __uint_as_float(u & 0xffff0000u); }
DI u4v pk8(f4v a, f4v b) { u4v r; r.x = pk2(a.x, a.y); r.y = pk2(a.z, a.w); r.z = pk2(b.x, b.y); r.w = pk2(b.z, b.w); return r; }
DI float rcpf(float x) { return __builtin_amdgcn_rcpf(x); }
DI float sigmoidf_(float x) { return rcpf(1.f + __expf(-x)); }
DI float siluf_(float x) { return x * sigmoidf_(x); }
DI int crow(int reg, int h) { return (reg & 3) + 8 * (reg >> 2) + 4 * h; }
DI f32x16 zero16() { f32x16 z;
#pragma unroll
  for (int i = 0; i < 16; ++i) z[i] = 0.f; return z; }

__constant__ float c_invfreq[16] = {1.0f, 0.5623413324356079f, 0.3162277638912201f, 0.17782793939113617f, 0.10000000149011612f,
  0.05623413249850273f, 0.03162277489900589f, 0.017782794311642647f, 0.009999999776482582f, 0.005623413249850273f,
  0.003162277629598975f, 0.0017782794311642647f, 0.0010000000474974513f, 0.000562341301701963f, 0.0003162277571391314f,
  0.00017782794020604342f};

DI void sincos_d(double a, float& sn, float& cs) {
  const double k = rint(a * 0.63661977236758134308);
  const double y = a - k * 1.57079632679489661923;
  const double y2 = y * y;
  const double s = y * (1.0 + y2 * (-1.0 / 6 + y2 * (1.0 / 120 + y2 * (-1.0 / 5040 + y2 * (1.0 / 362880 + y2 * (-1.0 / 39916800 + y2 * (1.0 / 6227020800.0)))))));
  const double c = 1.0 + y2 * (-0.5 + y2 * (1.0 / 24 + y2 * (-1.0 / 720 + y2 * (1.0 / 40320 + y2 * (-1.0 / 3628800 + y2 * (1.0 / 479001600.0 + y2 * (-1.0 / 87178291200.0)))))));
  const int q = ((int)k) & 3;
  const double ss = (q == 0) ? s : (q == 1) ? c : (q == 2) ? -s : -c;
  const double cc = (q == 0) ? c : (q == 1) ? -s : (q == 2) ? -c : s;
  sn = (float)ss; cs = (float)cc;
}

template <int KIND>
DI int colmap(int n) {
  if (KIND == 0) {
    if (n < 1024) return n;
    if (n < 1536) return 1056 + (n - 1024);
    if (n < 2560) { int i = n - 1536; int hh = i >> 7, c = i & 127; return (c < 64) ? (1568 + hh * 64 + c) : (2080 + hh * 64 + (c - 64)); }
    if (n < 3072) return 2592 + (n - 2560);
    if (n < 3584) return 3104 + (n - 3072);
    if (n < 5632) return 3616 + (n - 3584);
    if (n < 5664) return 1024 + (n - 5632);
    return -1;
  } else if (KIND == 1) {
    if (n < 512) return (n >> 6) * 96 + (n & 63);
    int i = n - 512; return (i >> 5) * 96 + 64 + (i & 31);
  } else return n;
}
template <int KIND>
DI void conv_weight(u16* dst, const float* src, int ldw, int ncount, int K, const float* gain, int gmask, int gtid, int gthreads) {
  const int total = ncount * (K >> 3);
  for (int it = gtid; it < total; it += gthreads) {
    const int n = it % ncount, kc = it / ncount;
    const int sc = colmap<KIND>(n);
    float v[8];
#pragma unroll
    for (int i = 0; i < 8; ++i) {
      const int k = kc * 8 + i;
      float x = (sc >= 0) ? src[(size_t)k * ldw + sc] : 0.f;
      if (gain) x *= gain[k & gmask];
      v[i] = x;
    }
    u4v o; o.x = pk2(v[0], v[1]); o.y = pk2(v[2], v[3]); o.z = pk2(v[4], v[5]); o.w = pk2(v[6], v[7]);
    *(u4v*)(dst + (size_t)n * K + kc * 8) = o;
  }
}

DI void phase0(const Params& p) {
  unsigned char* ws = p.ws;
  const int gtid = blockIdx.x * blockDim.x + threadIdx.x, gthreads = gridDim.x * blockDim.x;
  float* ssq = (float*)(ws + OFF_SSQ);
  for (int i = gtid; i < 3 * T + 64; i += gthreads) ssq[i] = 0.f;
  float* rope = (float*)(ws + OFF_ROPE);
  for (int i = gtid; i < 4096 * 16; i += gthreads) {
    const int pos = i >> 4, j = i & 15;
    const float ang = (float)pos * c_invfreq[j];
    float sn, cs; sincos_d((double)ang, sn, cs);
    rope[i] = cs; rope[65536 + i] = sn;
  }
  conv_weight<0>((u16*)(ws + OFF_WIN), p.w_in, DIN, NP, 1024, nullptr, 0, gtid, gthreads);
  conv_weight<1>((u16*)(ws + OFF_WUQ), p.w_uq, 768, 768, 768, p.g_q, 1023, gtid, gthreads);
  conv_weight<2>((u16*)(ws + OFF_WUKV), p.w_ukv, 1024, 1024, 256, p.g_kv, 255, gtid, gthreads);
  conv_weight<2>((u16*)(ws + OFF_WA), p.w_a, 1024, 1024, 512, nullptr, 0, gtid, gthreads);
  conv_weight<2>((u16*)(ws + OFF_WB), p.w_b, 1024, 1024, 512, p.g_hgrn, 63, gtid, gthreads);
  conv_weight<2>((u16*)(ws + OFF_WO), p.w_out, 1024, 1024, 1024, nullptr, 0, gtid, gthreads);
  u16* H = (u16*)(ws + OFF_H);
  const int lane = threadIdx.x & 63;
  const int gw = gtid >> 6, nw = gthreads >> 6;
  for (int row = gw; row < T; row += nw) {
    const f4v* xr = (const f4v*)(p.x + (size_t)row * 1024);
    f4v v[4];
    float ss = 0.f;
#pragma unroll
    for (int i = 0; i < 4; ++i) { v[i] = xr[lane * 4 + i]; ss += v[i].x * v[i].x + v[i].y * v[i].y + v[i].z * v[i].z + v[i].w * v[i].w; }
#pragma unroll
    for (int o = 32; o >= 1; o >>= 1) ss += __shfl_xor(ss, o);
    const float rs = rsqrtf(ss * (1.f / 1024.f) + EPS);
    const f4v* gp = (const f4v*)(p.g_pre);
    f4v g[4];
#pragma unroll
    for (int i = 0; i < 4; ++i) { g[i] = gp[lane * 4 + i]; v[i].x *= rs * g[i].x; v[i].y *= rs * g[i].y; v[i].z *= rs * g[i].z; v[i].w *= rs * g[i].w; }
    u4v* hr = (u4v*)(H + (size_t)row * 1024 + lane * 16);
    hr[0] = pk8(v[0], v[1]); hr[1] = pk8(v[2], v[3]);
  }
}

constexpr int TS = 128 * 72;
DI void gemm_core(const u16* __restrict__ A, int lda, const u16* __restrict__ B, int ldb, int K, u16* lds, f32x16 (&acc)[2][2], int tid) {
  const int lane = tid & 63, w = tid >> 6, wm = w >> 1, wn = w & 1, r = lane & 31, h = lane >> 5;
  const int lc = tid & 7, lr = tid >> 3;
  const u16* ga = A + (size_t)lr * lda + lc * 8;
  const u16* gb = B + (size_t)lr * ldb + lc * 8;
  u4v ra[4], rb[4];
#pragma unroll
  for (int i = 0; i < 4; ++i) { ra[i] = *(const u4v*)(ga + (size_t)(32 * i) * lda); rb[i] = *(const u4v*)(gb + (size_t)(32 * i) * ldb); }
#pragma unroll
  for (int i = 0; i < 2; ++i)
#pragma unroll
    for (int j = 0; j < 2; ++j) acc[i][j] = zero16();
  __syncthreads();
  {
    u16* sa = lds; u16* sb = lds + TS;
#pragma unroll
    for (int i = 0; i < 4; ++i) { *(u4v*)(sa + (lr + 32 * i) * 72 + lc * 8) = ra[i]; *(u4v*)(sb + (lr + 32 * i) * 72 + lc * 8) = rb[i]; }
  }
  __syncthreads();
  const int nk = K >> 6;
  for (int kt = 0; kt < nk; ++kt) {
    const int cur = kt & 1;
    if (kt + 1 < nk) {
      const int ko = (kt + 1) * 64;
#pragma unroll
      for (int i = 0; i < 4; ++i) { ra[i] = *(const u4v*)(ga + (size_t)(32 * i) * lda + ko); rb[i] = *(const u4v*)(gb + (size_t)(32 * i) * ldb + ko); }
    }
    const u16* sa = lds + cur * 2 * TS + (wm * 64 + r) * 72 + h * 8;
    const u16* sb = lds + cur * 2 * TS + TS + (wn * 64 + r) * 72 + h * 8;
#pragma unroll
    for (int ks = 0; ks < 4; ++ks) {
      const bf16x8 a0 = *(const bf16x8*)(sa + ks * 16);
      const bf16x8 a1 = *(const bf16x8*)(sa + 32 * 72 + ks * 16);
      const bf16x8 b0 = *(const bf16x8*)(sb + ks * 16);
      const bf16x8 b1 = *(const bf16x8*)(sb + 32 * 72 + ks * 16);
      acc[0][0] = MFMA(a0, b0, acc[0][0]);
      acc[0][1] = MFMA(a0, b1, acc[0][1]);
      acc[1][0] = MFMA(a1, b0, acc[1][0]);
      acc[1][1] = MFMA(a1, b1, acc[1][1]);
    }
    if (kt + 1 < nk) {
      u16* da = lds + (cur ^ 1) * 2 * TS; u16* db = da + TS;
#pragma unroll
      for (int i = 0; i < 4; ++i) { *(u4v*)(da + (lr + 32 * i) * 72 + lc * 8) = ra[i]; *(u4v*)(db + (lr + 32 * i) * 72 + lc * 8) = rb[i]; }
    }
    __syncthreads();
  }
}

DI void stage_pass(const f32x16 (&acc)[2][2], float* stage, int p, int tid) {
  const int lane = tid & 63, w = tid >> 6, wm = w >> 1, wn = w & 1, r = lane & 31, h = lane >> 5;
  __syncthreads();
  if (wm == p) {
#pragma unroll
    for (int i = 0; i < 2; ++i)
#pragma unroll
      for (int j = 0; j < 2; ++j)
#pragma unroll
        for (int reg = 0; reg < 16; ++reg) stage[(i * 32 + crow(reg, h)) * SST + wn * 64 + j * 32 + r] = acc[i][j][reg];
  }
  __syncthreads();
}

DI void phase1(const Params& p, u16* lds) {
  unsigned char* ws = p.ws;
  const int tid = threadIdx.x;
  const u16* H = (const u16*)(ws + OFF_H);
  const u16* W = (const u16*)(ws + OFF_WIN);
  float* stage = (float*)lds;
  float* ssq_q = (float*)(ws + OFF_SSQ);
  float* ssq_kv = ssq_q + T;
  for (int t = blockIdx.x; t < 256 * 45; t += gridDim.x) {
    const int x8 = t & 7, j = t >> 3;
    const int mt = 32 * x8 + 8 * (j / 360) + (j & 7);
    const int nt = (j % 360) >> 3;
    f32x16 acc[2][2];
    gemm_core(H + (size_t)mt * 128 * 1024, 1024, W + (size_t)nt * 128 * 1024, 1024, 1024, lds, acc, tid);
    const int row0 = mt * 128;
    const int b = row0 >> 12, spos0 = row0 & 4095;
#pragma unroll 1
    for (int ps = 0; ps < 2; ++ps) {
      stage_pass(acc, stage, ps, tid);
      const int prow0 = row0 + ps * 64;
      if (nt < 12 || (nt >= 24 && nt < 44)) {
#pragma unroll
        for (int it = 0; it < 4; ++it) {
          const int item = tid + 256 * it, rr = item >> 4, cc = (item & 15) * 8;
          f4v a = *(const f4v*)(stage + rr * SST + cc), c = *(const f4v*)(stage + rr * SST + cc + 4);
          const int grow = prow0 + rr;
          if (nt < 8) {
            float ss = a.x * a.x + a.y * a.y + a.z * a.z + a.w * a.w + c.x * c.x + c.y * c.y + c.z * c.z + c.w * c.w;
            ss += __shfl_xor(ss, 1); ss += __shfl_xor(ss, 2); ss += __shfl_xor(ss, 4); ss += __shfl_xor(ss, 8);
            if ((tid & 15) == 0) atomicAdd((nt < 6 ? ssq_q : ssq_kv) + grow, ss);
            if (nt < 6) *(u4v*)((u16*)(ws + OFF_CQ) + (size_t)grow * 768 + nt * 128 + cc) = pk8(a, c);
            else *(u4v*)((u16*)(ws + OFF_CKV) + (size_t)grow * 256 + (nt - 6) * 128 + cc) = pk8(a, c);
          } else if (nt < 28) {
            a.x = siluf_(a.x); a.y = siluf_(a.y); a.z = siluf_(a.z); a.w = siluf_(a.w);
            c.x = siluf_(c.x); c.y = siluf_(c.y); c.z = siluf_(c.z); c.w = siluf_(c.w);
            u16* dst = (nt < 12) ? (u16*)(ws + OFF_SGA) + (size_t)grow * 512 + (nt - 8) * 128 + cc
                                 : (u16*)(ws + OFF_SGB) + (size_t)grow * 512 + (nt - 24) * 128 + cc;
            *(u4v*)dst = pk8(a, c);
          } else {
            const int col = (nt - 28) * 128 + cc;
            const f4v b0 = *(const f4v*)(p.b_gate + col), b1 = *(const f4v*)(p.b_gate + col + 4);
            a.x = sigmoidf_(a.x + b0.x); a.y = sigmoidf_(a.y + b0.y); a.z = sigmoidf_(a.z + b0.z); a.w = sigmoidf_(a.w + b0.w);
            c.x = sigmoidf_(c.x + b1.x); c.y = sigmoidf_(c.y + b1.y); c.z = sigmoidf_(c.z + b1.z); c.w = sigmoidf_(c.w + b1.w);
            *(u4v*)((u16*)p.out + (size_t)grow * 2048 + col) = pk8(a, c);
          }
        }
      } else if (nt < 20) {
        const int hh = nt - 12;
        const int bh = b * 8 + hh;
        const int nblk0 = (spos0 + ps * 64) >> 5;
        if (tid < 128) {
          const int c = tid & 63, blk = tid >> 6;
          const float l0 = p.lb_logits[hh * 64 + c], l1 = p.lb_logits[512 + hh * 64 + c];
          const float lbv = 1.f / (1.f + expf(l1 - l0));
          float cum = 0.f;
          for (int rr = 0; rr < 32; ++rr) {
            float* sp = stage + (blk * 32 + rr) * SST + c;
            const float q = sp[0], hf = sp[64];
            const float sg = 1.f / (1.f + expf(-hf));
            const float f = lbv + (1.f - lbv) * sg;
            cum += logf(f);
            const float e = expf(cum);
            sp[0] = q * e;
            sp[64] = (1.f - f) / e;
          }
          ((float*)(ws + OFF_DECAY))[((size_t)bh * 128 + nblk0 + blk) * 64 + c] = expf(cum);
        }
        __syncthreads();
#pragma unroll
        for (int it = 0; it < 2; ++it) {
          const int item = tid + 256 * it, rr = item >> 3, cc = (item & 7) * 8;
          const f4v a = *(const f4v*)(stage + rr * SST + cc), c = *(const f4v*)(stage + rr * SST + cc + 4);
          const f4v d = *(const f4v*)(stage + rr * SST + 64 + cc), e = *(const f4v*)(stage + rr * SST + 64 + cc + 4);
          const size_t o = (size_t)(prow0 + rr) * 512 + hh * 64 + cc;
          *(u4v*)((u16*)(ws + OFF_QDEC) + o) = pk8(a, c);
          *(u4v*)((u16*)(ws + OFF_KINV) + o) = pk8(d, e);
        }
#pragma unroll
        for (int it = 0; it < 2; ++it) {
          const int item = tid + 256 * it, sc = item & 3, k = (item >> 2) & 63, blk = item >> 8;
          float v[8];
#pragma unroll
          for (int i = 0; i < 8; ++i) v[i] = stage[(blk * 32 + sc * 8 + i) * SST + 64 + k];
          u4v o; o.x = pk2(v[0], v[1]); o.y = pk2(v[2], v[3]); o.z = pk2(v[4], v[5]); o.w = pk2(v[6], v[7]);
          *(u4v*)((u16*)(ws + OFF_KINVT) + (((size_t)bh * 128 + nblk0 + blk) * 64 + k) * 32 + sc * 8) = o;
        }
      } else if (nt < 24) {
        const int nblk0 = (spos0 + ps * 64) >> 5;
#pragma unroll
        for (int it = 0; it < 4; ++it) {
          const int item = tid + 256 * it, sc = item & 3, col = (item >> 2) & 127, blk = item >> 9;
          float v[8];
#pragma unroll
          for (int i = 0; i < 8; ++i) v[i] = stage[(blk * 32 + sc * 8 + i) * SST + col];
          u4v o; o.x = pk2(v[0], v[1]); o.y = pk2(v[2], v[3]); o.z = pk2(v[4], v[5]); o.w = pk2(v[6], v[7]);
          const int bh = b * 8 + (nt - 20) * 2 + (col >> 6);
          *(u4v*)((u16*)(ws + OFF_VT) + (((size_t)bh * 128 + nblk0 + blk) * 64 + (col & 63)) * 32 + sc * 8) = o;
        }
      } else {
#pragma unroll
        for (int it = 0; it < 4; ++it) {
          const int item = tid + 256 * it, rr = item >> 4, cc = (item & 15) * 8;
          if (cc < 32) {
            const f4v a = *(const f4v*)(stage + rr * SST + cc), c = *(const f4v*)(stage + rr * SST + cc + 4);
            float* dst = (float*)(ws + OFF_KPE) + (size_t)(prow0 + rr) * 32 + cc;
            *(f4v*)dst = a; *(f4v*)(dst + 4) = c;
          }
        }
      }
    }
  }
}

DI void rope8(const float* x1, const float* x2, const float* rope, int spos, int j0, bool first, float scale, float (&o)[8]) {
  const f4v c0 = *(const f4v*)(rope + spos * 16 + j0), c1 = *(const f4v*)(rope + spos * 16 + j0 + 4);
  const f4v s0 = *(const f4v*)(rope + 65536 + spos * 16 + j0), s1 = *(const f4v*)(rope + 65536 + spos * 16 + j0 + 4);
  const float cs[8] = {c0.x, c0.y, c0.z, c0.w, c1.x, c1.y, c1.z, c1.w};
  const float sn[8] = {s0.x, s0.y, s0.z, s0.w, s1.x, s1.y, s1.z, s1.w};
#pragma unroll
  for (int i = 0; i < 8; ++i) o[i] = scale * (first ? (x1[i] * cs[i] - x2[i] * sn[i]) : (x1[i] * sn[i] + x2[i] * cs[i]));
}

DI void phase2(const Params& p, u16* lds) {
  unsigned char* ws = p.ws;
  const int tid = threadIdx.x;
  float* stage = (float*)lds;
  const float* ssq_q = (const float*)(ws + OFF_SSQ);
  const float* ssq_kv = ssq_q + T;
  const float* rope = (const float*)(ws + OFF_ROPE);
  u16* Qo = (u16*)(ws + OFF_Q);
  u16* Ko = (u16*)(ws + OFF_K);
  u16* Vo = (u16*)(ws + OFF_VTT);
  constexpr int NQ = 256 * 6, NKV = 256 * 8, NH1 = 2048;
  for (int t = blockIdx.x; t < NQ + NKV + NH1; t += gridDim.x) {
    if (t < NQ) {
      const int mt = t / 6, nt = t % 6;
      f32x16 acc[2][2];
      gemm_core((const u16*)(ws + OFF_CQ) + (size_t)mt * 128 * 768, 768, (const u16*)(ws + OFF_WUQ) + (size_t)nt * 128 * 768, 768, 768, lds, acc, tid);
      const int row0 = mt * 128, b = row0 >> 12, spos0 = row0 & 4095;
#pragma unroll 1
      for (int ps = 0; ps < 2; ++ps) {
        stage_pass(acc, stage, ps, tid);
#pragma unroll
        for (int it = 0; it < 4; ++it) {
          const int item = tid + 256 * it, rr = item >> 4, cc = (item & 15) * 8;
          const int grow = row0 + ps * 64 + rr, spos = spos0 + ps * 64 + rr;
          const float sc = rsqrtf(ssq_q[grow] * (1.f / 768.f) + EPS) * QSCALE;
          if (nt < 4) {
            f4v a = *(const f4v*)(stage + rr * SST + cc), c = *(const f4v*)(stage + rr * SST + cc + 4);
            a.x *= sc; a.y *= sc; a.z *= sc; a.w *= sc; c.x *= sc; c.y *= sc; c.z *= sc; c.w *= sc;
            const int head = nt * 2 + (cc >> 6), d = cc & 63;
            *(u4v*)(Qo + ((size_t)(b * 8 + head) * 4096 + spos) * 96 + d) = pk8(a, c);
          } else {
            const int head = (nt - 4) * 4 + (cc >> 5), wv = cc & 31, j0 = wv & 15, cb = cc - wv;
            float x1[8], x2[8], o[8];
#pragma unroll
            for (int i = 0; i < 8; ++i) { x1[i] = stage[rr * SST + cb + j0 + i]; x2[i] = stage[rr * SST + cb + 16 + j0 + i]; }
            rope8(x1, x2, rope, spos, j0, wv < 16, sc, o);
            u4v ov; ov.x = pk2(o[0], o[1]); ov.y = pk2(o[2], o[3]); ov.z = pk2(o[4], o[5]); ov.w = pk2(o[6], o[7]);
            *(u4v*)(Qo + ((size_t)(b * 8 + head) * 4096 + spos) * 96 + 64 + wv) = ov;
          }
        }
      }
    } else if (t < NQ + NKV) {
      const int tt = t - NQ;
      const int mt = tt >> 3, head = tt & 7;
      f32x16 acc[2][2];
      gemm_core((const u16*)(ws + OFF_CKV) + (size_t)mt * 128 * 256, 256, (const u16*)(ws + OFF_WUKV) + (size_t)head * 128 * 256, 256, 256, lds, acc, tid);
      const int row0 = mt * 128, b = row0 >> 12, spos0 = row0 & 4095;
      const int bh = b * 8 + head;
#pragma unroll 1
      for (int ps = 0; ps < 2; ++ps) {
        stage_pass(acc, stage, ps, tid);
        const int prow0 = row0 + ps * 64, pspos0 = spos0 + ps * 64;
#pragma unroll
        for (int it = 0; it < 2; ++it) {
          const int item = tid + 256 * it, rr = item >> 3, cc = (item & 7) * 8;
          const float sc = rsqrtf(ssq_kv[prow0 + rr] * (1.f / 256.f) + EPS);
          f4v a = *(const f4v*)(stage + rr * SST + cc), c = *(const f4v*)(stage + rr * SST + cc + 4);
          a.x *= sc; a.y *= sc; a.z *= sc; a.w *= sc; c.x *= sc; c.y *= sc; c.z *= sc; c.w *= sc;
          *(u4v*)(Ko + ((size_t)bh * 4096 + pspos0 + rr) * 96 + cc) = pk8(a, c);
        }
#pragma unroll
        for (int it = 0; it < 2; ++it) {
          const int item = tid + 256 * it, sc8 = item & 7, dv = item >> 3;
          const f4v q0 = *(const f4v*)(ssq_kv + prow0 + sc8 * 8), q1 = *(const f4v*)(ssq_kv + prow0 + sc8 * 8 + 4);
          const float qs[8] = {q0.x, q0.y, q0.z, q0.w, q1.x, q1.y, q1.z, q1.w};
          float v[8];
#pragma unroll
          for (int i = 0; i < 8; ++i) v[i] = stage[(sc8 * 8 + i) * SST + 64 + dv] * rsqrtf(qs[i] * (1.f / 256.f) + EPS);
          u4v o; o.x = pk2(v[0], v[1]); o.y = pk2(v[2], v[3]); o.z = pk2(v[4], v[5]); o.w = pk2(v[6], v[7]);
          *(u4v*)(Vo + ((size_t)bh * 64 + dv) * 4096 + pspos0 + sc8 * 8) = o;
        }
        {
          const int rr = tid >> 2, wv = (tid & 3) * 8, j0 = wv & 15;
          const float* kp = (const float*)(ws + OFF_KPE) + (size_t)(prow0 + rr) * 32;
          const f4v a0 = *(const f4v*)(kp + j0), a1 = *(const f4v*)(kp + j0 + 4);
          const f4v b0 = *(const f4v*)(kp + 16 + j0), b1 = *(const f4v*)(kp + 16 + j0 + 4);
          const float x1[8] = {a0.x, a0.y, a0.z, a0.w, a1.x, a1.y, a1.z, a1.w};
          const float x2[8] = {b0.x, b0.y, b0.z, b0.w, b1.x, b1.y, b1.z, b1.w};
          float o[8];
          rope8(x1, x2, rope, pspos0 + rr, j0, wv < 16, 1.f, o);
          u4v ov; ov.x = pk2(o[0], o[1]); ov.y = pk2(o[2], o[3]); ov.z = pk2(o[4], o[5]); ov.w = pk2(o[6], o[7]);
          *(u4v*)(Ko + ((size_t)bh * 4096 + pspos0 + rr) * 96 + 64 + wv) = ov;
        }
      }
    } else {
      const int idx = t - NQ - NKV;
      const int bh = idx >> 5, n = (idx & 31) * 4 + (tid >> 6);
      const int lane = tid & 63, r = lane & 31, h = lane >> 5;
      const u16* kt = (const u16*)(ws + OFF_KINVT) + ((size_t)bh * 128 + n) * 64 * 32;
      const u16* vt = (const u16*)(ws + OFF_VT) + ((size_t)bh * 128 + n) * 64 * 32;
      bf16x8 a[2][2], bb[2][2];
#pragma unroll
      for (int i = 0; i < 2; ++i)
#pragma unroll
        for (int ks = 0; ks < 2; ++ks) {
          a[i][ks] = *(const bf16x8*)(kt + (i * 32 + r) * 32 + ks * 16 + h * 8);
          bb[i][ks] = *(const bf16x8*)(vt + (i * 32 + r) * 32 + ks * 16 + h * 8);
        }
      u16* up = (u16*)(ws + OFF_UPD) + ((size_t)bh * 128 + n) * 4096;
#pragma unroll
      for (int kb = 0; kb < 2; ++kb)
#pragma unroll
        for (int vb = 0; vb < 2; ++vb) {
          f32x16 c = zero16();
          c = MFMA(a[kb][0], bb[vb][0], c);
          c = MFMA(a[kb][1], bb[vb][1], c);
#pragma unroll
          for (int g = 0; g < 4; ++g) {
            u2v o; o.x = pk2(c[4 * g], c[4 * g + 1]); o.y = pk2(c[4 * g + 2], c[4 * g + 3]);
            *(u2v*)(up + (vb * 32 + r) * 64 + kb * 32 + 8 * g + 4 * h) = o;
          }
        }
    }
  }
}

constexpr int KST = 104, VST = 72;
constexpr int ATT_BUF = 64 * KST + 64 * VST;

DI void attn_item(const Params& p, u16* lds, int bh, int qt) {
  unsigned char* ws = p.ws;
  const int tid = threadIdx.x, lane = tid & 63, w = tid >> 6, r = lane & 31, h = lane >> 5;
  const u16* Qp = (const u16*)(ws + OFF_Q) + (size_t)bh * 4096 * 96;
  const u16* Kp = (const u16*)(ws + OFF_K) + (size_t)bh * 4096 * 96;
  const u16* Vp = (const u16*)(ws + OFF_VTT) + (size_t)bh * 64 * 4096;
  const int q0 = qt * 128 + w * 32;
  bf16x8 qf[6];
#pragma unroll
  for (int ks = 0; ks < 6; ++ks) qf[ks] = *(const bf16x8*)(Qp + (size_t)(q0 + r) * 96 + ks * 16 + h * 8);
  f32x16 o[2]; o[0] = zero16(); o[1] = zero16();
  float m = -1e30f, l = 0.f;
  const int jmax = 2 * qt + 1, jw = 2 * qt + (w >> 1);
  int kr[3], kc[3];
#pragma unroll
  for (int i = 0; i < 3; ++i) { const int idx = tid + 256 * i; kr[i] = idx / 12; kc[i] = idx % 12; }
  const int vr0 = tid >> 3, vc = tid & 7;
  u4v rk[3], rv[2];
#pragma unroll
  for (int i = 0; i < 3; ++i) rk[i] = *(const u4v*)(Kp + (size_t)kr[i] * 96 + kc[i] * 8);
#pragma unroll
  for (int i = 0; i < 2; ++i) rv[i] = *(const u4v*)(Vp + (size_t)(vr0 + 32 * i) * 4096 + vc * 8);
  __syncthreads();
  {
#pragma unroll
    for (int i = 0; i < 3; ++i) *(u4v*)(lds + kr[i] * KST + kc[i] * 8) = rk[i];
#pragma unroll
    for (int i = 0; i < 2; ++i) *(u4v*)(lds + 64 * KST + (vr0 + 32 * i) * VST + vc * 8) = rv[i];
  }
  __syncthreads();
  for (int j = 0; j <= jmax; ++j) {
    const int cur = j & 1;
    if (j < jmax) {
#pragma unroll
      for (int i = 0; i < 3; ++i) rk[i] = *(const u4v*)(Kp + (size_t)((j + 1) * 64 + kr[i]) * 96 + kc[i] * 8);
#pragma unroll
      for (int i = 0; i < 2; ++i) rv[i] = *(const u4v*)(Vp + (size_t)(vr0 + 32 * i) * 4096 + (j + 1) * 64 + vc * 8);
    }
    if (j <= jw) {
      const u16* sk = lds + cur * ATT_BUF + r * KST + h * 8;
      const u16* sv = lds + cur * ATT_BUF + 64 * KST + r * VST + 4 * h;
      f32x16 st[2]; st[0] = zero16(); st[1] = zero16();
#pragma unroll
      for (int kb = 0; kb < 2; ++kb)
#pragma unroll
        for (int ks = 0; ks < 6; ++ks) {
          const bf16x8 kf = *(const bf16x8*)(sk + kb * 32 * KST + ks * 16);
          st[kb] = MFMA(kf, qf[ks], st[kb]);
        }
      float mx = st[0][0];
#pragma unroll
      for (int i = 1; i < 16; ++i) mx = fmaxf(mx, st[0][i]);
#pragma unroll
      for (int i = 0; i < 16; ++i) mx = fmaxf(mx, st[1][i]);
      mx = fmaxf(mx, __shfl_xor(mx, 32));
      const float mn = fmaxf(m, mx);
      const float alpha = __builtin_amdgcn_exp2f(m - mn);
      m = mn;
      float psum = 0.f;
#pragma unroll
      for (int kb = 0; kb < 2; ++kb)
#pragma unroll
        for (int i = 0; i < 16; ++i) { const float pv = __builtin_amdgcn_exp2f(st[kb][i] - mn); st[kb][i] = pv; psum += pv; }
      l = l * alpha + psum;
#pragma unroll
      for (int i = 0; i < 16; ++i) { o[0][i] *= alpha; o[1][i] *= alpha; }
#pragma unroll
      for (int s4 = 0; s4 < 4; ++s4) {
        const int kb = s4 >> 1, rb = 8 * (s4 & 1);
        u4v pu; pu.x = pk2(st[kb][rb], st[kb][rb + 1]); pu.y = pk2(st[kb][rb + 2], st[kb][rb + 3]);
        pu.z = pk2(st[kb][rb + 4], st[kb][rb + 5]); pu.w = pk2(st[kb][rb + 6], st[kb][rb + 7]);
        const bf16x8 pb = __builtin_bit_cast(bf16x8, pu);
#pragma unroll
        for (int db = 0; db < 2; ++db) {
          const s16x4 lo = *(const s16x4*)(sv + db * 32 * VST + 16 * s4);
          const s16x4 hi = *(const s16x4*)(sv + db * 32 * VST + 16 * s4 + 8);
          const bf16x8 vf = __builtin_shufflevector(lo, hi, 0, 1, 2, 3, 4, 5, 6, 7);
          o[db] = MFMA(vf, pb, o[db]);
        }
      }
    }
    if (j < jmax) {
      u16* d = lds + (cur ^ 1) * ATT_BUF;
#pragma unroll
      for (int i = 0; i < 3; ++i) *(u4v*)(d + kr[i] * KST + kc[i] * 8) = rk[i];
#pragma unroll
      for (int i = 0; i < 2; ++i) *(u4v*)(d + 64 * KST + (vr0 + 32 * i) * VST + vc * 8) = rv[i];
    }
    __syncthreads();
  }
  l += __shfl_xor(l, 32);
  const float inv = 1.f / l;
  const int b = bh >> 3, head = bh & 7;
  const size_t tok = (size_t)b * 4096 + q0 + r;
  const u16* sga = (const u16*)(ws + OFF_SGA) + tok * 512 + head * 64;
  u16* ya = (u16*)(ws + OFF_YA) + tok * 512 + head * 64;
#pragma unroll
  for (int db = 0; db < 2; ++db)
#pragma unroll
    for (int g = 0; g < 4; ++g) {
      const int dv0 = db * 32 + 8 * g + 4 * h;
      const u2v gt = *(const u2v*)(sga + dv0);
      u2v ov;
      ov.x = pk2(o[db][4 * g] * inv * bflo(gt.x), o[db][4 * g + 1] * inv * bfhi(gt.x));
      ov.y = pk2(o[db][4 * g + 2] * inv * bflo(gt.y), o[db][4 * g + 3] * inv * bfhi(gt.y));
      *(u2v*)(ya + dv0) = ov;
    }
}

DI void scan_item(const Params& p, int i) {
  unsigned char* ws = p.ws;
  const int tid = threadIdx.x;
  const int bh = i >> 3, part = i & 7;
  const int e = part * 512 + tid * 2, k = e & 63;
  u32* U = (u32*)((u16*)(ws + OFF_UPD) + (size_t)bh * 128 * 4096 + e);
  const f2v* Dc = (const f2v*)((const float*)(ws + OFF_DECAY) + (size_t)bh * 128 * 64 + k);
  float s0 = 0.f, s1 = 0.f;
  for (int n0 = 0; n0 < 128; n0 += 8) {
    u32 u[8]; f2v d[8];
#pragma unroll
    for (int q = 0; q < 8; ++q) { u[q] = U[(size_t)(n0 + q) * 2048]; d[q] = Dc[(n0 + q) * 32]; }
#pragma unroll
    for (int q = 0; q < 8; ++q) {
      U[(size_t)(n0 + q) * 2048] = pk2(s0, s1);
      s0 = d[q].x * (s0 + bflo(u[q]));
      s1 = d[q].y * (s1 + bfhi(u[q]));
    }
  }
}

DI void phase3(const Params& p, u16* lds) {
  int* s_item = (int*)((unsigned char*)lds + LDS_BYTES - 64);
  int* ctr = (int*)(p.ws + OFF_SSQ + (size_t)3 * T * 4);
  constexpr int NSCAN = 512, NATT = 2048;
  for (;;) {
    __syncthreads();
    if (threadIdx.x == 0) *s_item = atomicAdd(ctr, 1);
    __syncthreads();
    const int item = *s_item;
    if (item >= NSCAN + NATT) break;
    if (item < NSCAN) scan_item(p, item);
    else { const int idx = item - NSCAN; attn_item(p, lds, idx & 63, 31 - (idx >> 6)); }
  }
}

DI void phase4(const Params& p) {
  unsigned char* ws = p.ws;
  const int tid = threadIdx.x, lane = tid & 63, w = tid >> 6, r = lane & 31, h = lane >> 5;
  for (int t = blockIdx.x; t < 2048; t += gridDim.x) {
    const int bh = t >> 5, n = (t & 31) * 4 + w;
    const int b = bh >> 3, head = bh & 7;
    const size_t tok0 = (size_t)b * 4096 + n * 32;
    const u16* qd = (const u16*)(ws + OFF_QDEC) + (tok0 + r) * 512 + head * 64 + h * 8;
    const u16* ki = (const u16*)(ws + OFF_KINV) + (tok0 + r) * 512 + head * 64 + h * 8;
    const u16* vt = (const u16*)(ws + OFF_VT) + ((size_t)bh * 128 + n) * 64 * 32;
    const u16* sp = (const u16*)(ws + OFF_UPD) + ((size_t)bh * 128 + n) * 4096;
    bf16x8 qf[4], kf[4];
#pragma unroll
    for (int ks = 0; ks < 4; ++ks) { qf[ks] = *(const bf16x8*)(qd + ks * 16); kf[ks] = *(const bf16x8*)(ki + ks * 16); }
    f32x16 at = zero16();
#pragma unroll
    for (int ks = 0; ks < 4; ++ks) at = MFMA(kf[ks], qf[ks], at);
#pragma unroll
    for (int i = 0; i < 16; ++i) if (crow(i, h) > r) at[i] = 0.f;
    f32x16 o[2]; o[0] = zero16(); o[1] = zero16();
#pragma unroll
    for (int s2 = 0; s2 < 2; ++s2) {
      u4v pu; pu.x = pk2(at[8 * s2], at[8 * s2 + 1]); pu.y = pk2(at[8 * s2 + 2], at[8 * s2 + 3]);
      pu.z = pk2(at[8 * s2 + 4], at[8 * s2 + 5]); pu.w = pk2(at[8 * s2 + 6], at[8 * s2 + 7]);
      const bf16x8 pb = __builtin_bit_cast(bf16x8, pu);
#pragma unroll
      for (int vb = 0; vb < 2; ++vb) {
        const s16x4 lo = *(const s16x4*)(vt + (vb * 32 + r) * 32 + 16 * s2 + 4 * h);
        const s16x4 hi = *(const s16x4*)(vt + (vb * 32 + r) * 32 + 16 * s2 + 8 + 4 * h);
        const bf16x8 vf = __builtin_shufflevector(lo, hi, 0, 1, 2, 3, 4, 5, 6, 7);
        o[vb] = MFMA(vf, pb, o[vb]);
      }
    }
#pragma unroll
    for (int vb = 0; vb < 2; ++vb)
#pragma unroll
      for (int ks = 0; ks < 4; ++ks) {
        const bf16x8 sf = *(const bf16x8*)(sp + (vb * 32 + r) * 64 + ks * 16 + h * 8);
        o[vb] = MFMA(sf, qf[ks], o[vb]);
      }
    float ss = 0.f;
#pragma unroll
    for (int i = 0; i < 16; ++i) ss += o[0][i] * o[0][i] + o[1][i] * o[1][i];
    ss += __shfl_xor(ss, 32);
    const float rs = rsqrtf(ss * (1.f / 64.f) + EPS);
    const u16* sgb = (const u16*)(ws + OFF_SGB) + (tok0 + r) * 512 + head * 64;
    u16* yb = (u16*)(ws + OFF_YB) + (tok0 + r) * 512 + head * 64;
#pragma unroll
    for (int vb = 0; vb < 2; ++vb)
#pragma unroll
      for (int g = 0; g < 4; ++g) {
        const int v0 = vb * 32 + 8 * g + 4 * h;
        const u2v gt = *(const u2v*)(sgb + v0);
        u2v ov;
        ov.x = pk2(o[vb][4 * g] * rs * bflo(gt.x), o[vb][4 * g + 1] * rs * bfhi(gt.x));
        ov.y = pk2(o[vb][4 * g + 2] * rs * bflo(gt.y), o[vb][4 * g + 3] * rs * bfhi(gt.y));
        *(u2v*)(yb + v0) = ov;
      }
  }
}

DI void phase5(const Params& p, u16* lds) {
  unsigned char* ws = p.ws;
  const int tid = threadIdx.x;
  float* stage = (float*)lds;
  const u16* MG = (const u16*)p.out;
  u16* Mo = (u16*)(ws + OFF_M);
  for (int t = blockIdx.x; t < 2048; t += gridDim.x) {
    const int mt = t >> 3, nt = t & 7;
    const int row0 = mt * 128;
    float* tmp = (float*)(ws + OFF_VTT) + (size_t)blockIdx.x * 16384 + tid * 8;
    {
      f32x16 acc[2][2];
      gemm_core((const u16*)(ws + OFF_YA) + (size_t)row0 * 512, 512, (const u16*)(ws + OFF_WA) + (size_t)nt * 128 * 512, 512, 512, lds, acc, tid);
#pragma unroll
      for (int ps = 0; ps < 2; ++ps) {
        stage_pass(acc, stage, ps, tid);
#pragma unroll
        for (int it = 0; it < 4; ++it) {
          const int item = tid + 256 * it, rr = item >> 4, cc = (item & 15) * 8;
          const u4v g = *(const u4v*)(MG + (size_t)(row0 + ps * 64 + rr) * 2048 + nt * 128 + cc);
          const f4v a = *(const f4v*)(stage + rr * SST + cc), c = *(const f4v*)(stage + rr * SST + cc + 4);
          *(f4v*)(tmp + (ps * 4 + it) * 2048) = f4v{a.x * bflo(g.x), a.y * bfhi(g.x), a.z * bflo(g.y), a.w * bfhi(g.y)};
          *(f4v*)(tmp + (ps * 4 + it) * 2048 + 4) = f4v{c.x * bflo(g.z), c.y * bfhi(g.z), c.z * bflo(g.w), c.w * bfhi(g.w)};
        }
      }
    }
    {
      f32x16 acc[2][2];
      gemm_core((const u16*)(ws + OFF_YB) + (size_t)row0 * 512, 512, (const u16*)(ws + OFF_WB) + (size_t)nt * 128 * 512, 512, 512, lds, acc, tid);
#pragma unroll
      for (int ps = 0; ps < 2; ++ps) {
        stage_pass(acc, stage, ps, tid);
#pragma unroll
        for (int it = 0; it < 4; ++it) {
          const int item = tid + 256 * it, rr = item >> 4, cc = (item & 15) * 8;
          const u4v g = *(const u4v*)(MG + (size_t)(row0 + ps * 64 + rr) * 2048 + 1024 + nt * 128 + cc);
          const f4v a = *(const f4v*)(stage + rr * SST + cc), c = *(const f4v*)(stage + rr * SST + cc + 4);
          f4v k0 = *(const f4v*)(tmp + (ps * 4 + it) * 2048), k1 = *(const f4v*)(tmp + (ps * 4 + it) * 2048 + 4);
          k0.x += a.x * bflo(g.x); k0.y += a.y * bfhi(g.x); k0.z += a.z * bflo(g.y); k0.w += a.w * bfhi(g.y);
          k1.x += c.x * bflo(g.z); k1.y += c.y * bfhi(g.z); k1.z += c.z * bflo(g.w); k1.w += c.w * bfhi(g.w);
          *(u4v*)(Mo + (size_t)(row0 + ps * 64 + rr) * 1024 + nt * 128 + cc) = pk8(k0, k1);
        }
      }
    }
  }
}

DI void phase6(const Params& p, u16* lds) {
  unsigned char* ws = p.ws;
  const int tid = threadIdx.x;
  float* stage = (float*)lds;
  float* ssq_y = (float*)(ws + OFF_SSQ) + 2 * T;
  for (int t = blockIdx.x; t < 2048; t += gridDim.x) {
    const int mt = t >> 3, nt = t & 7;
    const int row0 = mt * 128;
    f32x16 acc[2][2];
    gemm_core((const u16*)(ws + OFF_M) + (size_t)row0 * 1024, 1024, (const u16*)(ws + OFF_WO) + (size_t)nt * 128 * 1024, 1024, 1024, lds, acc, tid);
#pragma unroll 1
    for (int ps = 0; ps < 2; ++ps) {
      stage_pass(acc, stage, ps, tid);
#pragma unroll
      for (int it = 0; it < 4; ++it) {
        const int item = tid + 256 * it, rr = item >> 4, cc = (item & 15) * 8;
        const int grow = row0 + ps * 64 + rr;
        const f4v a = *(const f4v*)(stage + rr * SST + cc), c = *(const f4v*)(stage + rr * SST + cc + 4);
        float ss = a.x * a.x + a.y * a.y + a.z * a.z + a.w * a.w + c.x * c.x + c.y * c.y + c.z * c.z + c.w * c.w;
        ss += __shfl_xor(ss, 1); ss += __shfl_xor(ss, 2); ss += __shfl_xor(ss, 4); ss += __shfl_xor(ss, 8);
        if ((tid & 15) == 0) atomicAdd(ssq_y + grow, ss);
        float* dst = p.out + (size_t)grow * 1024 + nt * 128 + cc;
        *(f4v*)dst = a; *(f4v*)(dst + 4) = c;
      }
    }
  }
}

DI void phase7(const Params& p) {
  const float* ssq_y = (const float*)(p.ws + OFF_SSQ) + 2 * T;
  const int gtid = blockIdx.x * blockDim.x + threadIdx.x, gthreads = gridDim.x * blockDim.x;
  for (int i = gtid; i < T * 256; i += gthreads) {
    const int row = i >> 8, c4 = i & 255;
    const float rs = rsqrtf(ssq_y[row] * (1.f / 1024.f) + EPS);
    const f4v y = ((const f4v*)p.out)[i];
    const f4v xv = ((const f4v*)p.x)[i];
    const f4v g = ((const f4v*)p.g_post)[c4];
    f4v o;
    o.x = xv.x + y.x * rs * g.x; o.y = xv.y + y.y * rs * g.y; o.z = xv.z + y.z * rs * g.z; o.w = xv.w + y.w * rs * g.w;
    ((f4v*)p.out)[i] = o;
  }
}

__global__ void __launch_bounds__(256, 2) fwd_megakernel(Params p) {
  extern __shared__ __attribute__((aligned(16))) unsigned char smem[];
  u16* lds = (u16*)smem;
  cg::grid_group grid = cg::this_grid();
#define RUN_PHASE(N, CALL) if (p.ph_lo <= N && N < p.ph_hi) { if (N > p.ph_lo) grid.sync(); CALL; }
  RUN_PHASE(0, phase0(p))
  RUN_PHASE(1, phase1(p, lds))
  RUN_PHASE(2, phase2(p, lds))
  RUN_PHASE(3, phase3(p, lds))
  RUN_PHASE(4, phase4(p))
  RUN_PHASE(5, phase5(p, lds))
  RUN_PHASE(6, phase6(p, lds))
  RUN_PHASE(7, phase7(p))
}

extern "C" void kernel_launch(void* const* d_in, const int* in_sizes, int n_in, void* d_out, int out_size, void* d_ws, size_t ws_size,
                              hipStream_t stream) {
  static int grid_blocks = 0;
  if (!grid_blocks) {
    int dev = 0, cus = 0, per_cu = 0;
    hipGetDevice(&dev);
    hipDeviceGetAttribute(&cus, hipDeviceAttributeMultiprocessorCount, dev);
    hipFuncSetAttribute((const void*)fwd_megakernel, hipFuncAttributeMaxDynamicSharedMemorySize, LDS_BYTES);
    hipOccupancyMaxActiveBlocksPerMultiprocessor(&per_cu, (const void*)fwd_megakernel, 256, LDS_BYTES);
    if (per_cu < 1) per_cu = 1;
    if (per_cu > 2) per_cu = 2;
    grid_blocks = cus * per_cu;
    if (ws_size < WS_NEED) fprintf(stderr, "kernel_launch: workspace too small: %zu < %zu\n", ws_size, (size_t)WS_NEED);
  }
  if (ws_size < WS_NEED) return;
  Params p{};
  p.x = (const float*)d_in[0]; p.g_pre = (const float*)d_in[1]; p.w_in = (const float*)d_in[2]; p.b_gate = (const float*)d_in[3];
  p.g_q = (const float*)d_in[4]; p.w_uq = (const float*)d_in[5]; p.g_kv = (const float*)d_in[6]; p.w_ukv = (const float*)d_in[7];
  p.lb_logits = (const float*)d_in[8]; p.g_hgrn = (const float*)d_in[9]; p.w_a = (const float*)d_in[10]; p.w_b = (const float*)d_in[11];
  p.w_out = (const float*)d_in[12]; p.g_post = (const float*)d_in[13];
  p.out = (float*)d_out; p.ws = (unsigned char*)d_ws;
#if ONE_LAUNCH
  p.ph_lo = 0; p.ph_hi = 8;
  void* args[] = {&p};
  hipError_t e = hipLaunchCooperativeKernel((const void*)fwd_megakernel, dim3(grid_blocks), dim3(256), args, LDS_BYTES, stream);
  if (e != hipSuccess) fprintf(stderr, "cooperative launch failed: %s (grid %d)\n", hipGetErrorString(e), grid_blocks);
#else
  for (int ph = 0; ph < 8; ++ph) {
    p.ph_lo = ph; p.ph_hi = ph + 1;
    void* args[] = {&p};
    hipError_t e = hipLaunchCooperativeKernel((const void*)fwd_megakernel, dim3(grid_blocks), dim3(256), args, LDS_BYTES, stream);
    if (e != hipSuccess) fprintf(stderr, "cooperative launch failed: %s (grid %d)\n", hipGetErrorString(e), grid_blocks);
  }
#endif
}
```

```cpp
#include <hip/hip_runtime.h>
#include <hip/hip_cooperative_groups.h>
#include <cstdio>
namespace cg = cooperative_groups;

#define DI __device__ __forceinline__
typedef unsigned short u16;
typedef unsigned int u32;
typedef __attribute__((ext_vector_type(8))) short bf16x8;
typedef __attribute__((ext_vector_type(4))) short s16x4;
typedef __attribute__((ext_vector_type(16))) float f32x16;
typedef __attribute__((ext_vector_type(2))) __bf16 bf2_t;
typedef __attribute__((ext_vector_type(2))) float f2_t;
typedef __attribute__((ext_vector_type(4))) unsigned int u4v;
typedef __attribute__((ext_vector_type(2))) unsigned int u2v;
typedef __attribute__((ext_vector_type(4))) float f4v;
typedef __attribute__((ext_vector_type(2))) float f2v;
#define MFMA(a, b, c) __builtin_amdgcn_mfma_f32_32x32x16_bf16((a), (b), (c), 0, 0, 0)

#ifndef ONE_LAUNCH
#define ONE_LAUNCH 1
#endif

constexpr int T = 32768;
constexpr int SEQ = 4096;
constexpr int DIN = 5664;
constexpr int NP = 5760;
constexpr float EPS = 1e-6f;
constexpr float QSCALE = 1.4426950408889634f * 0.10206207261596575f;

constexpr size_t SZ_WIN = (size_t)NP * 1024 * 2;
constexpr size_t OFF_WIN = 0;
constexpr size_t OFF_WUQ = OFF_WIN + SZ_WIN;
constexpr size_t OFF_WUKV = OFF_WUQ + (size_t)768 * 768 * 2;
constexpr size_t OFF_WA = OFF_WUKV + (size_t)1024 * 256 * 2;
constexpr size_t OFF_WB = OFF_WA + (size_t)1024 * 512 * 2;
constexpr size_t OFF_WO = OFF_WB + (size_t)1024 * 512 * 2;
constexpr size_t OFF_ROPE = OFF_WO + (size_t)1024 * 1024 * 2;
constexpr size_t OFF_SSQ = OFF_ROPE + (size_t)4096 * 16 * 2 * 4;
constexpr size_t OFF_DECAY = OFF_SSQ + (size_t)(3 * T + 64) * 4;
constexpr size_t OFF_H = OFF_DECAY + (size_t)64 * 128 * 64 * 4;
constexpr size_t OFF_UPD = OFF_H;
constexpr size_t OFF_CQ = OFF_H + (size_t)T * 1024 * 2;
constexpr size_t OFF_YA = OFF_CQ;
constexpr size_t OFF_CKV = OFF_CQ + (size_t)T * 768 * 2;
constexpr size_t OFF_KPE = OFF_CKV + (size_t)T * 256 * 2;
constexpr size_t OFF_SGA = OFF_KPE + (size_t)T * 32 * 4;
constexpr size_t OFF_SGB = OFF_SGA + (size_t)T * 512 * 2;
constexpr size_t OFF_QDEC = OFF_SGB + (size_t)T * 512 * 2;
constexpr size_t OFF_KINV = OFF_QDEC + (size_t)T * 512 * 2;
constexpr size_t OFF_KINVT = OFF_KINV + (size_t)T * 512 * 2;
constexpr size_t OFF_YB = OFF_KINVT;
constexpr size_t OFF_VT = OFF_KINVT + (size_t)T * 512 * 2;
constexpr size_t OFF_Q = OFF_VT + (size_t)T * 512 * 2;
constexpr size_t OFF_M = OFF_Q;
constexpr size_t OFF_K = OFF_Q + (size_t)T * 768 * 2;
constexpr size_t OFF_VTT = OFF_K + (size_t)T * 768 * 2;
constexpr size_t OFF_BAR = OFF_VTT + (size_t)T * 512 * 2;
constexpr size_t WS_NEED = OFF_BAR + 16384;

constexpr int LDS_BYTES = 2 * 2 * 128 * 72 * 2 + 64;
constexpr int SST = 132;

struct Params {
  const float *x, *g_pre, *w_in, *b_gate, *g_q, *w_uq, *g_kv, *w_ukv, *lb_logits, *g_hgrn, *w_a, *w_b, *w_out, *g_post;
  float* out;
  unsigned char* ws;
  int ph_lo, ph_hi;
};

DI u32 pk2(float a, float b) { f2_t v = {a, b}; bf2_t r = __builtin_convertvector(v, bf2_t); return __builtin_bit_cast(u32, r); }
DI float bflo(u32 u) { return __uint_as_float(u << 16); }
DI float bfhi(u32 u) { return __uint_as_float(u & 0xffff0000u); }
DI u4v pk8(f4v a, f4v b) { u4v r; r.x = pk2(a.x, a.y); r.y = pk2(a.z, a.w); r.z = pk2(b.x, b.y); r.w = pk2(b.z, b.w); return r; }
DI float rcpf(float x) { return __builtin_amdgcn_rcpf(x); }
DI float sigmoidf_(float x) { return rcpf(1.f + __expf(-x)); }
DI float siluf_(float x) { return x * sigmoidf_(x); }
DI int crow(int reg, int h) { return (reg & 3) + 8 * (reg >> 2) + 4 * h; }
DI f32x16 zero16() { f32x16 z;
#pragma unroll
  for (int i = 0; i < 16; ++i) z[i] = 0.f; return z; }

__constant__ float c_invfreq[16] = {1.0f, 0.5623413324356079f, 0.3162277638912201f, 0.17782793939113617f, 0.10000000149011612f,
  0.05623413249850273f, 0.03162277489900589f, 0.017782794311642647f, 0.009999999776482582f, 0.005623413249850273f,
  0.003162277629598975f, 0.0017782794311642647f, 0.0010000000474974513f, 0.000562341301701963f, 0.0003162277571391314f,
  0.00017782794020604342f};

DI void sincos_d(double a, float& sn, float& cs) {
  const double k = rint(a * 0.63661977236758134308);
  const double y = a - k * 1.57079632679489661923;
  const double y2 = y * y;
  const double s = y * (1.0 + y2 * (-1.0 / 6 + y2 * (1.0 / 120 + y2 * (-1.0 / 5040 + y2 * (1.0 / 362880 + y2 * (-1.0 / 39916800 + y2 * (1.0 / 6227020800.0)))))));
  const double c = 1.0 + y2 * (-0.5 + y2 * (1.0 / 24 + y2 * (-1.0 / 720 + y2 * (1.0 / 40320 + y2 * (-1.0 / 3628800 + y2 * (1.0 / 479001600.0 + y2 * (-1.0 / 87178291200.0)))))));
  const int q = ((int)k) & 3;
  const double ss = (q == 0) ? s : (q == 1) ? c : (q == 2) ? -s : -c;
  const double cc = (q == 0) ? c : (q == 1) ? -s : (q == 2) ? -c : s;
  sn = (float)ss; cs = (float)cc;
}

#define XB_TMO      128
#define XB_XCNT(j)  (256  + 64 * (j))
#define XB_XSUB(j)  (1280 + 64 * (j))
#define XB_XGEN(j)  (2304 + 64 * (j))
#define XB_TOP      3328
#define XB_TOPGEN   3392
#define XCD_BAR_WORDS 3456
#define XB_SPIN_CAP (1u << 22)
#define LAS __attribute__((address_space(3)))
DI unsigned xb_ld(unsigned* p)              { return __hip_atomic_load(p, __ATOMIC_RELAXED, __HIP_MEMORY_SCOPE_AGENT); }
DI unsigned xb_add(unsigned* p, unsigned v) { return __hip_atomic_fetch_add(p, v, __ATOMIC_RELAXED, __HIP_MEMORY_SCOPE_AGENT); }
DI unsigned xb_xcc_id() { return (unsigned)__builtin_amdgcn_s_getreg((3 << 11) | 20) & 0xFu; }
#define XB_SPIN(cond, bar) do { unsigned _sp = 0; while (cond) { __builtin_amdgcn_s_sleep(1); \
    if ((++_sp & 255u) == 0u) { if (xb_ld(&(bar)[XB_TMO])) break; if (_sp > XB_SPIN_CAP) { atomicAdd(&(bar)[XB_TMO], 1u); break; } } } } while (0)
struct XcdBarrier { unsigned* bar; unsigned x; volatile LAS unsigned* st; };
DI XcdBarrier xcd_barrier_post(unsigned* bar, volatile LAS unsigned* st) {
  XcdBarrier b; b.bar = bar; b.x = xb_xcc_id(); b.st = st;
  if (threadIdx.x == 0) (void)xb_add(&bar[XB_XCNT(b.x)], 1u);
  return b;
}
DI void xcd_barrier_complete(unsigned* bar, unsigned x, unsigned& nloc, unsigned& nx) {
  const unsigned G = gridDim.x * gridDim.y * gridDim.z;
  unsigned sum, cnt, mine, sp = 0u;
  for (;;) {
    sum = 0u; cnt = 0u; mine = 0u;
#pragma unroll
    for (unsigned j = 0; j < 16; ++j) { const unsigned c = xb_ld(&bar[XB_XCNT(j)]); sum += c; cnt += (c > 0u) ? 1u : 0u; mine = (j == x) ? c : mine; }
    if (sum == G) break;
    __builtin_amdgcn_s_sleep(1);
    if ((++sp & 255u) == 0u) { if (xb_ld(&bar[XB_TMO])) break; if (sp > XB_SPIN_CAP) { atomicAdd(&bar[XB_TMO], 1u); break; } }
  }
  nloc = mine > 0u ? mine : 1u; nx = cnt > 0u ? cnt : 1u;
}
DI void xcd_barrier(const XcdBarrier& b) {
  asm volatile("s_waitcnt vmcnt(0)" ::: "memory");
  __syncthreads();
  if (threadIdx.x == 0) {
    unsigned* bar = b.bar;
    __builtin_amdgcn_s_waitcnt(0);
    unsigned nloc = b.st[0], nx = b.st[1];
    if (nloc == 0u) { xcd_barrier_complete(bar, b.x, nloc, nx); b.st[0] = nloc; b.st[1] = nx; }
    const unsigned old = xb_add(&bar[XB_XSUB(b.x)], 1u);
    const unsigned gen = old / nloc;
    if (old + 1u == (gen + 1u) * nloc) {
      __builtin_amdgcn_fence(__ATOMIC_RELEASE, "agent");
      asm volatile("s_waitcnt vmcnt(0)" ::: "memory");
      const unsigned og = xb_add(&bar[XB_TOP], 1u);
      const unsigned tg = og / nx;
      if (og + 1u == (tg + 1u) * nx) xb_add(&bar[XB_TOPGEN], 1u);
      else XB_SPIN(xb_ld(&bar[XB_TOPGEN]) == tg, bar);
      __builtin_amdgcn_fence(__ATOMIC_ACQUIRE, "agent");
      xb_add(&bar[XB_XGEN(b.x)], 1u);
      asm volatile("s_waitcnt vmcnt(0)" ::: "memory");
    } else {
      XB_SPIN(xb_ld(&bar[XB_XGEN(b.x)]) == gen, bar);
      __builtin_amdgcn_fence(__ATOMIC_ACQUIRE, "agent");
      asm volatile("s_waitcnt vmcnt(0)" ::: "memory");
    }
  }
  __syncthreads();
}

template <int KIND>
DI int colmap(int n) {
  if (KIND == 0) {
    if (n < 1024) return n;
    if (n < 1536) return 1056 + (n - 1024);
    if (n < 2560) { int i = n - 1536; int hh = i >> 7, c = i & 127; return (c < 64) ? (1568 + hh * 64 + c) : (2080 + hh * 64 + (c - 64)); }
    if (n < 3072) return 2592 + (n - 2560);
    if (n < 3584) return 3104 + (n - 3072);
    if (n < 5632) return 3616 + (n - 3584);
    if (n < 5664) return 1024 + (n - 5632);
    return -1;
  } else if (KIND == 1) {
    if (n < 512) return (n >> 6) * 96 + (n & 63);
    int i = n - 512; return (i >> 5) * 96 + 64 + (i & 31);
  } else return n;
}
template <int KIND>
DI void conv_weight(u16* dst, const float* src, int ldw, int ncount, int K, const float* gain, int gmask, int gtid, int gthreads) {
  const int total = ncount * (K >> 3);
  for (int it = gtid; it < total; it += gthreads) {
    const int n = it % ncount, kc = it / ncount;
    const int sc = colmap<KIND>(n);
    float v[8];
#pragma unroll
    for (int i = 0; i < 8; ++i) {
      const int k = kc * 8 + i;
      float x = (sc >= 0) ? src[(size_t)k * ldw + sc] : 0.f;
      if (gain) x *= gain[k & gmask];
      v[i] = x;
    }
    u4v o; o.x = pk2(v[0], v[1]); o.y = pk2(v[2], v[3]); o.z = pk2(v[4], v[5]); o.w = pk2(v[6], v[7]);
    *(u4v*)(dst + (size_t)n * K + kc * 8) = o;
  }
}

DI void phase0(const Params& p) {
  unsigned char* ws = p.ws;
  const int gtid = blockIdx.x * blockDim.x + threadIdx.x, gthreads = gridDim.x * blockDim.x;
  float* ssq = (float*)(ws + OFF_SSQ);
  for (int i = gtid; i < 3 * T + 64; i += gthreads) ssq[i] = 0.f;
  float* rope = (float*)(ws + OFF_ROPE);
  for (int i = gtid; i < 4096 * 16; i += gthreads) {
    const int pos = i >> 4, j = i & 15;
    const float ang = (float)pos * c_invfreq[j];
    float sn, cs; sincos_d((double)ang, sn, cs);
    rope[i] = cs; rope[65536 + i] = sn;
  }
  conv_weight<0>((u16*)(ws + OFF_WIN), p.w_in, DIN, NP, 1024, nullptr, 0, gtid, gthreads);
  conv_weight<1>((u16*)(ws + OFF_WUQ), p.w_uq, 768, 768, 768, p.g_q, 1023, gtid, gthreads);
  conv_weight<2>((u16*)(ws + OFF_WUKV), p.w_ukv, 1024, 1024, 256, p.g_kv, 255, gtid, gthreads);
  conv_weight<2>((u16*)(ws + OFF_WA), p.w_a, 1024, 1024, 512, nullptr, 0, gtid, gthreads);
  conv_weight<2>((u16*)(ws + OFF_WB), p.w_b, 1024, 1024, 512, p.g_hgrn, 63, gtid, gthreads);
  conv_weight<2>((u16*)(ws + OFF_WO), p.w_out, 1024, 1024, 1024, nullptr, 0, gtid, gthreads);
  u16* H = (u16*)(ws + OFF_H);
  const int lane = threadIdx.x & 63;
  const int gw = gtid >> 6, nw = gthreads >> 6;
  for (int row = gw; row < T; row += nw) {
    const f4v* xr = (const f4v*)(p.x + (size_t)row * 1024);
    f4v v[4];
    float ss = 0.f;
#pragma unroll
    for (int i = 0; i < 4; ++i) { v[i] = xr[lane * 4 + i]; ss += v[i].x * v[i].x + v[i].y * v[i].y + v[i].z * v[i].z + v[i].w * v[i].w; }
#pragma unroll
    for (int o = 32; o >= 1; o >>= 1) ss += __shfl_xor(ss, o);
    const float rs = rsqrtf(ss * (1.f / 1024.f) + EPS);
    const f4v* gp = (const f4v*)(p.g_pre);
    f4v g[4];
#pragma unroll
    for (int i = 0; i < 4; ++i) { g[i] = gp[lane * 4 + i]; v[i].x *= rs * g[i].x; v[i].y *= rs * g[i].y; v[i].z *= rs * g[i].z; v[i].w *= rs * g[i].w; }
    u4v* hr = (u4v*)(H + (size_t)row * 1024 + lane * 16);
    hr[0] = pk8(v[0], v[1]); hr[1] = pk8(v[2], v[3]);
  }
}

constexpr int TS = 128 * 72;
DI void gemm_core(const u16* __restrict__ A, int lda, const u16* __restrict__ B, int ldb, int K, u16* lds, f32x16 (&acc)[2][2], int tid) {
  const int lane = tid & 63, w = tid >> 6, wm = w >> 1, wn = w & 1, r = lane & 31, h = lane >> 5;
  const int lc = tid & 7, lr = tid >> 3;
  const u16* ga = A + (size_t)lr * lda + lc * 8;
  const u16* gb = B + (size_t)lr * ldb + lc * 8;
  u4v ra[4], rb[4];
#pragma unroll
  for (int i = 0; i < 4; ++i) { ra[i] = *(const u4v*)(ga + (size_t)(32 * i) * lda); rb[i] = *(const u4v*)(gb + (size_t)(32 * i) * ldb); }
#pragma unroll
  for (int i = 0; i < 2; ++i)
#pragma unroll
    for (int j = 0; j < 2; ++j) acc[i][j] = zero16();
  __syncthreads();
  {
    u16* sa = lds; u16* sb = lds + TS;
#pragma unroll
    for (int i = 0; i < 4; ++i) { *(u4v*)(sa + (lr + 32 * i) * 72 + lc * 8) = ra[i]; *(u4v*)(sb + (lr + 32 * i) * 72 + lc * 8) = rb[i]; }
  }
  __syncthreads();
  const int nk = K >> 6;
  for (int kt = 0; kt < nk; ++kt) {
    const int cur = kt & 1;
    if (kt + 1 < nk) {
      const int ko = (kt + 1) * 64;
#pragma unroll
      for (int i = 0; i < 4; ++i) { ra[i] = *(const u4v*)(ga + (size_t)(32 * i) * lda + ko); rb[i] = *(const u4v*)(gb + (size_t)(32 * i) * ldb + ko); }
    }
    const u16* sa = lds + cur * 2 * TS + (wm * 64 + r) * 72 + h * 8;
    const u16* sb = lds + cur * 2 * TS + TS + (wn * 64 + r) * 72 + h * 8;
#pragma unroll
    for (int ks = 0; ks < 4; ++ks) {
      const bf16x8 a0 = *(const bf16x8*)(sa + ks * 16);
      const bf16x8 a1 = *(const bf16x8*)(sa + 32 * 72 + ks * 16);
      const bf16x8 b0 = *(const bf16x8*)(sb + ks * 16);
      const bf16x8 b1 = *(const bf16x8*)(sb + 32 * 72 + ks * 16);
      acc[0][0] = MFMA(a0, b0, acc[0][0]);
      acc[0][1] = MFMA(a0, b1, acc[0][1]);
      acc[1][0] = MFMA(a1, b0, acc[1][0]);
      acc[1][1] = MFMA(a1, b1, acc[1][1]);
    }
    if (kt + 1 < nk) {
      u16* da = lds + (cur ^ 1) * 2 * TS; u16* db = da + TS;
#pragma unroll
      for (int i = 0; i < 4; ++i) { *(u4v*)(da + (lr + 32 * i) * 72 + lc * 8) = ra[i]; *(u4v*)(db + (lr + 32 * i) * 72 + lc * 8) = rb[i]; }
    }
    __syncthreads();
  }
}

DI void stage_pass(const f32x16 (&acc)[2][2], float* stage, int p, int tid) {
  const int lane = tid & 63, w = tid >> 6, wm = w >> 1, wn = w & 1, r = lane & 31, h = lane >> 5;
  __syncthreads();
  if (wm == p) {
#pragma unroll
    for (int i = 0; i < 2; ++i)
#pragma unroll
      for (int j = 0; j < 2; ++j)
#pragma unroll
        for (int reg = 0; reg < 16; ++reg) stage[(i * 32 + crow(reg, h)) * SST + wn * 64 + j * 32 + r] = acc[i][j][reg];
  }
  __syncthreads();
}

DI void phase1(const Params& p, u16* lds) {
  unsigned char* ws = p.ws;
  const int tid = threadIdx.x;
  const u16* H = (const u16*)(ws + OFF_H);
  const u16* W = (const u16*)(ws + OFF_WIN);
  float* stage = (float*)lds;
  float* ssq_q = (float*)(ws + OFF_SSQ);
  float* ssq_kv = ssq_q + T;
  for (int t = blockIdx.x; t < 256 * 45; t += gridDim.x) {
    const int x8 = t & 7, j = t >> 3;
    const int mt = 32 * x8 + 8 * (j / 360) + (j & 7);
    const int nt = (j % 360) >> 3;
    f32x16 acc[2][2];
    gemm_core(H + (size_t)mt * 128 * 1024, 1024, W + (size_t)nt * 128 * 1024, 1024, 1024, lds, acc, tid);
    const int row0 = mt * 128;
    const int b = row0 >> 12, spos0 = row0 & 4095;
#pragma unroll 1
    for (int ps = 0; ps < 2; ++ps) {
      stage_pass(acc, stage, ps, tid);
      const int prow0 = row0 + ps * 64;
      if (nt < 12 || (nt >= 24 && nt < 44)) {
#pragma unroll
        for (int it = 0; it < 4; ++it) {
          const int item = tid + 256 * it, rr = item >> 4, cc = (item & 15) * 8;
          f4v a = *(const f4v*)(stage + rr * SST + cc), c = *(const f4v*)(stage + rr * SST + cc + 4);
          const int grow = prow0 + rr;
          if (nt < 8) {
            float ss = a.x * a.x + a.y * a.y + a.z * a.z + a.w * a.w + c.x * c.x + c.y * c.y + c.z * c.z + c.w * c.w;
            ss += __shfl_xor(ss, 1); ss += __shfl_xor(ss, 2); ss += __shfl_xor(ss, 4); ss += __shfl_xor(ss, 8);
            if ((tid & 15) == 0) atomicAdd((nt < 6 ? ssq_q : ssq_kv) + grow, ss);
            if (nt < 6) *(u4v*)((u16*)(ws + OFF_CQ) + (size_t)grow * 768 + nt * 128 + cc) = pk8(a, c);
            else *(u4v*)((u16*)(ws + OFF_CKV) + (size_t)grow * 256 + (nt - 6) * 128 + cc) = pk8(a, c);
          } else if (nt < 28) {
            a.x = siluf_(a.x); a.y = siluf_(a.y); a.z = siluf_(a.z); a.w = siluf_(a.w);
            c.x = siluf_(c.x); c.y = siluf_(c.y); c.z = siluf_(c.z); c.w = siluf_(c.w);
            u16* dst = (nt < 12) ? (u16*)(ws + OFF_SGA) + (size_t)grow * 512 + (nt - 8) * 128 + cc
                                 : (u16*)(ws + OFF_SGB) + (size_t)grow * 512 + (nt - 24) * 128 + cc;
            *(u4v*)dst = pk8(a, c);
          } else {
            const int col = (nt - 28) * 128 + cc;
            const f4v b0 = *(const f4v*)(p.b_gate + col), b1 = *(const f4v*)(p.b_gate + col + 4);
            a.x = sigmoidf_(a.x + b0.x); a.y = sigmoidf_(a.y + b0.y); a.z = sigmoidf_(a.z + b0.z); a.w = sigmoidf_(a.w + b0.w);
            c.x = sigmoidf_(c.x + b1.x); c.y = sigmoidf_(c.y + b1.y); c.z = sigmoidf_(c.z + b1.z); c.w = sigmoidf_(c.w + b1.w);
            *(u4v*)((u16*)p.out + (size_t)grow * 2048 + col) = pk8(a, c);
          }
        }
      } else if (nt < 20) {
        const int hh = nt - 12;
        const int bh = b * 8 + hh;
        const int nblk0 = (spos0 + ps * 64) >> 5;
        if (tid < 128) {
          const int c = tid & 63, blk = tid >> 6;
          const float l0 = p.lb_logits[hh * 64 + c], l1 = p.lb_logits[512 + hh * 64 + c];
          const float lbv = 1.f / (1.f + expf(l1 - l0));
          float cum = 0.f;
          for (int rr = 0; rr < 32; ++rr) {
            float* sp = stage + (blk * 32 + rr) * SST + c;
            const float q = sp[0], hf = sp[64];
            const float sg = 1.f / (1.f + expf(-hf));
            const float f = lbv + (1.f - lbv) * sg;
            cum += logf(f);
            const float e = expf(cum);
            sp[0] = q * e;
            sp[64] = (1.f - f) / e;
          }
          ((float*)(ws + OFF_DECAY))[((size_t)bh * 128 + nblk0 + blk) * 64 + c] = expf(cum);
        }
        __syncthreads();
#pragma unroll
        for (int it = 0; it < 2; ++it) {
          const int item = tid + 256 * it, rr = item >> 3, cc = (item & 7) * 8;
          const f4v a = *(const f4v*)(stage + rr * SST + cc), c = *(const f4v*)(stage + rr * SST + cc + 4);
          const f4v d = *(const f4v*)(stage + rr * SST + 64 + cc), e = *(const f4v*)(stage + rr * SST + 64 + cc + 4);
          const size_t o = (size_t)(prow0 + rr) * 512 + hh * 64 + cc;
          *(u4v*)((u16*)(ws + OFF_QDEC) + o) = pk8(a, c);
          *(u4v*)((u16*)(ws + OFF_KINV) + o) = pk8(d, e);
        }
#pragma unroll
        for (int it = 0; it < 2; ++it) {
          const int item = tid + 256 * it, sc = item & 3, k = (item >> 2) & 63, blk = item >> 8;
          float v[8];
#pragma unroll
          for (int i = 0; i < 8; ++i) v[i] = stage[(blk * 32 + sc * 8 + i) * SST + 64 + k];
          u4v o; o.x = pk2(v[0], v[1]); o.y = pk2(v[2], v[3]); o.z = pk2(v[4], v[5]); o.w = pk2(v[6], v[7]);
          *(u4v*)((u16*)(ws + OFF_KINVT) + (((size_t)bh * 128 + nblk0 + blk) * 64 + k) * 32 + sc * 8) = o;
        }
      } else if (nt < 24) {
        const int nblk0 = (spos0 + ps * 64) >> 5;
#pragma unroll
        for (int it = 0; it < 4; ++it) {
          const int item = tid + 256 * it, sc = item & 3, col = (item >> 2) & 127, blk = item >> 9;
          float v[8];
#pragma unroll
          for (int i = 0; i < 8; ++i) v[i] = stage[(blk * 32 + sc * 8 + i) * SST + col];
          u4v o; o.x = pk2(v[0], v[1]); o.y = pk2(v[2], v[3]); o.z = pk2(v[4], v[5]); o.w = pk2(v[6], v[7]);
          const int bh = b * 8 + (nt - 20) * 2 + (col >> 6);
          *(u4v*)((u16*)(ws + OFF_VT) + (((size_t)bh * 128 + nblk0 + blk) * 64 + (col & 63)) * 32 + sc * 8) = o;
        }
      } else {
#pragma unroll
        for (int it = 0; it < 4; ++it) {
          const int item = tid + 256 * it, rr = item >> 4, cc = (item & 15) * 8;
          if (cc < 32) {
            const f4v a = *(const f4v*)(stage + rr * SST + cc), c = *(const f4v*)(stage + rr * SST + cc + 4);
            float* dst = (float*)(ws + OFF_KPE) + (size_t)(prow0 + rr) * 32 + cc;
            *(f4v*)dst = a; *(f4v*)(dst + 4) = c;
          }
        }
      }
    }
  }
}

DI void rope8(const float* x1, const float* x2, const float* rope, int spos, int j0, bool first, float scale, float (&o)[8]) {
  const f4v c0 = *(const f4v*)(rope + spos * 16 + j0), c1 = *(const f4v*)(rope + spos * 16 + j0 + 4);
  const f4v s0 = *(const f4v*)(rope + 65536 + spos * 16 + j0), s1 = *(const f4v*)(rope + 65536 + spos * 16 + j0 + 4);
  const float cs[8] = {c0.x, c0.y, c0.z, c0.w, c1.x, c1.y, c1.z, c1.w};
  const float sn[8] = {s0.x, s0.y, s0.z, s0.w, s1.x, s1.y, s1.z, s1.w};
#pragma unroll
  for (int i = 0; i < 8; ++i) o[i] = scale * (first ? (x1[i] * cs[i] - x2[i] * sn[i]) : (x1[i] * sn[i] + x2[i] * cs[i]));
}

DI void phase2(const Params& p, u16* lds) {
  unsigned char* ws = p.ws;
  const int tid = threadIdx.x;
  float* stage = (float*)lds;
  const float* ssq_q = (const float*)(ws + OFF_SSQ);
  const float* ssq_kv = ssq_q + T;
  const float* rope = (const float*)(ws + OFF_ROPE);
  u16* Qo = (u16*)(ws + OFF_Q);
  u16* Ko = (u16*)(ws + OFF_K);
  u16* Vo = (u16*)(ws + OFF_VTT);
  constexpr int NQ = 256 * 6, NKV = 256 * 8, NH1 = 2048;
  for (int t = blockIdx.x; t < NQ + NKV + NH1; t += gridDim.x) {
    if (t < NQ) {
      const int mt = t / 6, nt = t % 6;
      f32x16 acc[2][2];
      gemm_core((const u16*)(ws + OFF_CQ) + (size_t)mt * 128 * 768, 768, (const u16*)(ws + OFF_WUQ) + (size_t)nt * 128 * 768, 768, 768, lds, acc, tid);
      const int row0 = mt * 128, b = row0 >> 12, spos0 = row0 & 4095;
#pragma unroll 1
      for (int ps = 0; ps < 2; ++ps) {
        stage_pass(acc, stage, ps, tid);
#pragma unroll
        for (int it = 0; it < 4; ++it) {
          const int item = tid + 256 * it, rr = item >> 4, cc = (item & 15) * 8;
          const int grow = row0 + ps * 64 + rr, spos = spos0 + ps * 64 + rr;
          const float sc = rsqrtf(ssq_q[grow] * (1.f / 768.f) + EPS) * QSCALE;
          if (nt < 4) {
            f4v a = *(const f4v*)(stage + rr * SST + cc), c = *(const f4v*)(stage + rr * SST + cc + 4);
            a.x *= sc; a.y *= sc; a.z *= sc; a.w *= sc; c.x *= sc; c.y *= sc; c.z *= sc; c.w *= sc;
            const int head = nt * 2 + (cc >> 6), d = cc & 63;
            *(u4v*)(Qo + ((size_t)(b * 8 + head) * 4096 + spos) * 96 + d) = pk8(a, c);
          } else {
            const int head = (nt - 4) * 4 + (cc >> 5), wv = cc & 31, j0 = wv & 15, cb = cc - wv;
            float x1[8], x2[8], o[8];
#pragma unroll
            for (int i = 0; i < 8; ++i) { x1[i] = stage[rr * SST + cb + j0 + i]; x2[i] = stage[rr * SST + cb + 16 + j0 + i]; }
            rope8(x1, x2, rope, spos, j0, wv < 16, sc, o);
            u4v ov; ov.x = pk2(o[0], o[1]); ov.y = pk2(o[2], o[3]); ov.z = pk2(o[4], o[5]); ov.w = pk2(o[6], o[7]);
            *(u4v*)(Qo + ((size_t)(b * 8 + head) * 4096 + spos) * 96 + 64 + wv) = ov;
          }
        }
      }
    } else if (t < NQ + NKV) {
      const int tt = t - NQ;
      const int mt = tt >> 3, head = tt & 7;
      f32x16 acc[2][2];
      gemm_core((const u16*)(ws + OFF_CKV) + (size_t)mt * 128 * 256, 256, (const u16*)(ws + OFF_WUKV) + (size_t)head * 128 * 256, 256, 256, lds, acc, tid);
      const int row0 = mt * 128, b = row0 >> 12, spos0 = row0 & 4095;
      const int bh = b * 8 + head;
#pragma unroll 1
      for (int ps = 0; ps < 2; ++ps) {
        stage_pass(acc, stage, ps, tid);
        const int prow0 = row0 + ps * 64, pspos0 = spos0 + ps * 64;
#pragma unroll
        for (int it = 0; it < 2; ++it) {
          const int item = tid + 256 * it, rr = item >> 3, cc = (item & 7) * 8;
          const float sc = rsqrtf(ssq_kv[prow0 + rr] * (1.f / 256.f) + EPS);
          f4v a = *(const f4v*)(stage + rr * SST + cc), c = *(const f4v*)(stage + rr * SST + cc + 4);
          a.x *= sc; a.y *= sc; a.z *= sc; a.w *= sc; c.x *= sc; c.y *= sc; c.z *= sc; c.w *= sc;
          *(u4v*)(Ko + ((size_t)bh * 4096 + pspos0 + rr) * 96 + cc) = pk8(a, c);
        }
#pragma unroll
        for (int it = 0; it < 2; ++it) {
          const int item = tid + 256 * it, sc8 = item & 7, dv = item >> 3;
          const f4v q0 = *(const f4v*)(ssq_kv + prow0 + sc8 * 8), q1 = *(const f4v*)(ssq_kv + prow0 + sc8 * 8 + 4);
          const float qs[8] = {q0.x, q0.y, q0.z, q0.w, q1.x, q1.y, q1.z, q1.w};
          float v[8];
#pragma unroll
          for (int i = 0; i < 8; ++i) v[i] = stage[(sc8 * 8 + i) * SST + 64 + dv] * rsqrtf(qs[i] * (1.f / 256.f) + EPS);
          u4v o; o.x = pk2(v[0], v[1]); o.y = pk2(v[2], v[3]); o.z = pk2(v[4], v[5]); o.w = pk2(v[6], v[7]);
          *(u4v*)(Vo + ((size_t)bh * 64 + dv) * 4096 + pspos0 + sc8 * 8) = o;
        }
        {
          const int rr = tid >> 2, wv = (tid & 3) * 8, j0 = wv & 15;
          const float* kp = (const float*)(ws + OFF_KPE) + (size_t)(prow0 + rr) * 32;
          const f4v a0 = *(const f4v*)(kp + j0), a1 = *(const f4v*)(kp + j0 + 4);
          const f4v b0 = *(const f4v*)(kp + 16 + j0), b1 = *(const f4v*)(kp + 16 + j0 + 4);
          const float x1[8] = {a0.x, a0.y, a0.z, a0.w, a1.x, a1.y, a1.z, a1.w};
          const float x2[8] = {b0.x, b0.y, b0.z, b0.w, b1.x, b1.y, b1.z, b1.w};
          float o[8];
          rope8(x1, x2, rope, pspos0 + rr, j0, wv < 16, 1.f, o);
          u4v ov; ov.x = pk2(o[0], o[1]); ov.y = pk2(o[2], o[3]); ov.z = pk2(o[4], o[5]); ov.w = pk2(o[6], o[7]);
          *(u4v*)(Ko + ((size_t)bh * 4096 + pspos0 + rr) * 96 + 64 + wv) = ov;
        }
      }
    } else {
      const int idx = t - NQ - NKV;
      const int bh = idx >> 5, n = (idx & 31) * 4 + (tid >> 6);
      const int lane = tid & 63, r = lane & 31, h = lane >> 5;
      const u16* kt = (const u16*)(ws + OFF_KINVT) + ((size_t)bh * 128 + n) * 64 * 32;
      const u16* vt = (const u16*)(ws + OFF_VT) + ((size_t)bh * 128 + n) * 64 * 32;
      bf16x8 a[2][2], bb[2][2];
#pragma unroll
      for (int i = 0; i < 2; ++i)
#pragma unroll
        for (int ks = 0; ks < 2; ++ks) {
          a[i][ks] = *(const bf16x8*)(kt + (i * 32 + r) * 32 + ks * 16 + h * 8);
          bb[i][ks] = *(const bf16x8*)(vt + (i * 32 + r) * 32 + ks * 16 + h * 8);
        }
      u16* up = (u16*)(ws + OFF_UPD) + ((size_t)bh * 128 + n) * 4096;
#pragma unroll
      for (int kb = 0; kb < 2; ++kb)
#pragma unroll
        for (int vb = 0; vb < 2; ++vb) {
          f32x16 c = zero16();
          c = MFMA(a[kb][0], bb[vb][0], c);
          c = MFMA(a[kb][1], bb[vb][1], c);
#pragma unroll
          for (int g = 0; g < 4; ++g) {
            u2v o; o.x = pk2(c[4 * g], c[4 * g + 1]); o.y = pk2(c[4 * g + 2], c[4 * g + 3]);
            *(u2v*)(up + (vb * 32 + r) * 64 + kb * 32 + 8 * g + 4 * h) = o;
          }
        }
    }
  }
}

constexpr int KST = 104, VST = 72;
constexpr int ATT_BUF = 64 * KST + 64 * VST;

DI void attn_item(const Params& p, u16* lds, int bh, int qt) {
  unsigned char* ws = p.ws;
  const int tid = threadIdx.x, lane = tid & 63, w = tid >> 6, r = lane & 31, h = lane >> 5;
  const u16* Qp = (const u16*)(ws + OFF_Q) + (size_t)bh * 4096 * 96;
  const u16* Kp = (const u16*)(ws + OFF_K) + (size_t)bh * 4096 * 96;
  const u16* Vp = (const u16*)(ws + OFF_VTT) + (size_t)bh * 64 * 4096;
  const int q0 = qt * 128 + w * 32;
  bf16x8 qf[6];
#pragma unroll
  for (int ks = 0; ks < 6; ++ks) qf[ks] = *(const bf16x8*)(Qp + (size_t)(q0 + r) * 96 + ks * 16 + h * 8);
  f32x16 o[2]; o[0] = zero16(); o[1] = zero16();
  float m = -1e30f, l = 0.f;
  const int jmax = 2 * qt + 1, jw = 2 * qt + (w >> 1);
  int kr[3], kc[3];
#pragma unroll
  for (int i = 0; i < 3; ++i) { const int idx = tid + 256 * i; kr[i] = idx / 12; kc[i] = idx % 12; }
  const int vr0 = tid >> 3, vc = tid & 7;
  u4v rk[3], rv[2];
#pragma unroll
  for (int i = 0; i < 3; ++i) rk[i] = *(const u4v*)(Kp + (size_t)kr[i] * 96 + kc[i] * 8);
#pragma unroll
  for (int i = 0; i < 2; ++i) rv[i] = *(const u4v*)(Vp + (size_t)(vr0 + 32 * i) * 4096 + vc * 8);
  __syncthreads();
  {
#pragma unroll
    for (int i = 0; i < 3; ++i) *(u4v*)(lds + kr[i] * KST + kc[i] * 8) = rk[i];
#pragma unroll
    for (int i = 0; i < 2; ++i) *(u4v*)(lds + 64 * KST + (vr0 + 32 * i) * VST + vc * 8) = rv[i];
  }
  __syncthreads();
  for (int j = 0; j <= jmax; ++j) {
    const int cur = j & 1;
    if (j < jmax) {
#pragma unroll
      for (int i = 0; i < 3; ++i) rk[i] = *(const u4v*)(Kp + (size_t)((j + 1) * 64 + kr[i]) * 96 + kc[i] * 8);
#pragma unroll
      for (int i = 0; i < 2; ++i) rv[i] = *(const u4v*)(Vp + (size_t)(vr0 + 32 * i) * 4096 + (j + 1) * 64 + vc * 8);
    }
    if (j <= jw) {
      const u16* sk = lds + cur * ATT_BUF + r * KST + h * 8;
      const u16* sv = lds + cur * ATT_BUF + 64 * KST + r * VST + 4 * h;
      f32x16 st[2]; st[0] = zero16(); st[1] = zero16();
#pragma unroll
      for (int kb = 0; kb < 2; ++kb)
#pragma unroll
        for (int ks = 0; ks < 6; ++ks) {
          const bf16x8 kf = *(const bf16x8*)(sk + kb * 32 * KST + ks * 16);
          st[kb] = MFMA(kf, qf[ks], st[kb]);
        }
      float mx = st[0][0];
#pragma unroll
      for (int i = 1; i < 16; ++i) mx = fmaxf(mx, st[0][i]);
#pragma unroll
      for (int i = 0; i < 16; ++i) mx = fmaxf(mx, st[1][i]);
      mx = fmaxf(mx, __shfl_xor(mx, 32));
      const float mn = fmaxf(m, mx);
      const float alpha = __builtin_amdgcn_exp2f(m - mn);
      m = mn;
      float psum = 0.f;
#pragma unroll
      for (int kb = 0; kb < 2; ++kb)
#pragma unroll
        for (int i = 0; i < 16; ++i) { const float pv = __builtin_amdgcn_exp2f(st[kb][i] - mn); st[kb][i] = pv; psum += pv; }
      l = l * alpha + psum;
#pragma unroll
      for (int i = 0; i < 16; ++i) { o[0][i] *= alpha; o[1][i] *= alpha; }
#pragma unroll
      for (int s4 = 0; s4 < 4; ++s4) {
        const int kb = s4 >> 1, rb = 8 * (s4 & 1);
        u4v pu; pu.x = pk2(st[kb][rb], st[kb][rb + 1]); pu.y = pk2(st[kb][rb + 2], st[kb][rb + 3]);
        pu.z = pk2(st[kb][rb + 4], st[kb][rb + 5]); pu.w = pk2(st[kb][rb + 6], st[kb][rb + 7]);
        const bf16x8 pb = __builtin_bit_cast(bf16x8, pu);
#pragma unroll
        for (int db = 0; db < 2; ++db) {
          const s16x4 lo = *(const s16x4*)(sv + db * 32 * VST + 16 * s4);
          const s16x4 hi = *(const s16x4*)(sv + db * 32 * VST + 16 * s4 + 8);
          const bf16x8 vf = __builtin_shufflevector(lo, hi, 0, 1, 2, 3, 4, 5, 6, 7);
          o[db] = MFMA(vf, pb, o[db]);
        }
      }
    }
    if (j < jmax) {
      u16* d = lds + (cur ^ 1) * ATT_BUF;
#pragma unroll
      for (int i = 0; i < 3; ++i) *(u4v*)(d + kr[i] * KST + kc[i] * 8) = rk[i];
#pragma unroll
      for (int i = 0; i < 2; ++i) *(u4v*)(d + 64 * KST + (vr0 + 32 * i) * VST + vc * 8) = rv[i];
    }
    __syncthreads();
  }
  l += __shfl_xor(l, 32);
  const float inv = 1.f / l;
  const int b = bh >> 3, head = bh & 7;
  const size_t tok = (size_t)b * 4096 + q0 + r;
  const u16* sga = (const u16*)(ws + OFF_SGA) + tok * 512 + head * 64;
  u16* ya = (u16*)(ws + OFF_YA) + tok * 512 + head * 64;
#pragma unroll
  for (int db = 0; db < 2; ++db)
#pragma unroll
    for (int g = 0; g < 4; ++g) {
      const int dv0 = db * 32 + 8 * g + 4 * h;
      const u2v gt = *(const u2v*)(sga + dv0);
      u2v ov;
      ov.x = pk2(o[db][4 * g] * inv * bflo(gt.x), o[db][4 * g + 1] * inv * bfhi(gt.x));
      ov.y = pk2(o[db][4 * g + 2] * inv * bflo(gt.y), o[db][4 * g + 3] * inv * bfhi(gt.y));
      *(u2v*)(ya + dv0) = ov;
    }
}

DI void scan_item(const Params& p, int i) {
  unsigned char* ws = p.ws;
  const int tid = threadIdx.x;
  const int bh = i >> 3, part = i & 7;
  const int e = part * 512 + tid * 2, k = e & 63;
  u32* U = (u32*)((u16*)(ws + OFF_UPD) + (size_t)bh * 128 * 4096 + e);
  const f2v* Dc = (const f2v*)((const float*)(ws + OFF_DECAY) + (size_t)bh * 128 * 64 + k);
  float s0 = 0.f, s1 = 0.f;
  for (int n0 = 0; n0 < 128; n0 += 8) {
    u32 u[8]; f2v d[8];
#pragma unroll
    for (int q = 0; q < 8; ++q) { u[q] = U[(size_t)(n0 + q) * 2048]; d[q] = Dc[(n0 + q) * 32]; }
#pragma unroll
    for (int q = 0; q < 8; ++q) {
      U[(size_t)(n0 + q) * 2048] = pk2(s0, s1);
      s0 = d[q].x * (s0 + bflo(u[q]));
      s1 = d[q].y * (s1 + bfhi(u[q]));
    }
  }
}

DI void phase3(const Params& p, u16* lds) {
  int* s_item = (int*)((unsigned char*)lds + LDS_BYTES - 64);
  int* ctr = (int*)(p.ws + OFF_SSQ + (size_t)3 * T * 4);
  constexpr int NSCAN = 512, NATT = 2048;
  for (;;) {
    __syncthreads();
    if (threadIdx.x == 0) *s_item = atomicAdd(ctr, 1);
    __syncthreads();
    const int item = *s_item;
    if (item >= NSCAN + NATT) break;
    if (item < NSCAN) scan_item(p, item);
    else { const int idx = item - NSCAN; attn_item(p, lds, idx & 63, 31 - (idx >> 6)); }
  }
}

DI void phase4(const Params& p) {
  unsigned char* ws = p.ws;
  const int tid = threadIdx.x, lane = tid & 63, w = tid >> 6, r = lane & 31, h = lane >> 5;
  for (int t = blockIdx.x; t < 2048; t += gridDim.x) {
    const int bh = t >> 5, n = (t & 31) * 4 + w;
    const int b = bh >> 3, head = bh & 7;
    const size_t tok0 = (size_t)b * 4096 + n * 32;
    const u16* qd = (const u16*)(ws + OFF_QDEC) + (tok0 + r) * 512 + head * 64 + h * 8;
    const u16* ki = (const u16*)(ws + OFF_KINV) + (tok0 + r) * 512 + head * 64 + h * 8;
    const u16* vt = (const u16*)(ws + OFF_VT) + ((size_t)bh * 128 + n) * 64 * 32;
    const u16* sp = (const u16*)(ws + OFF_UPD) + ((size_t)bh * 128 + n) * 4096;
    bf16x8 qf[4], kf[4];
#pragma unroll
    for (int ks = 0; ks < 4; ++ks) { qf[ks] = *(const bf16x8*)(qd + ks * 16); kf[ks] = *(const bf16x8*)(ki + ks * 16); }
    f32x16 at = zero16();
#pragma unroll
    for (int ks = 0; ks < 4; ++ks) at = MFMA(kf[ks], qf[ks], at);
#pragma unroll
    for (int i = 0; i < 16; ++i) if (crow(i, h) > r) at[i] = 0.f;
    f32x16 o[2]; o[0] = zero16(); o[1] = zero16();
#pragma unroll
    for (int s2 = 0; s2 < 2; ++s2) {
      u4v pu; pu.x = pk2(at[8 * s2], at[8 * s2 + 1]); pu.y = pk2(at[8 * s2 + 2], at[8 * s2 + 3]);
      pu.z = pk2(at[8 * s2 + 4], at[8 * s2 + 5]); pu.w = pk2(at[8 * s2 + 6], at[8 * s2 + 7]);
      const bf16x8 pb = __builtin_bit_cast(bf16x8, pu);
#pragma unroll
      for (int vb = 0; vb < 2; ++vb) {
        const s16x4 lo = *(const s16x4*)(vt + (vb * 32 + r) * 32 + 16 * s2 + 4 * h);
        const s16x4 hi = *(const s16x4*)(vt + (vb * 32 + r) * 32 + 16 * s2 + 8 + 4 * h);
        const bf16x8 vf = __builtin_shufflevector(lo, hi, 0, 1, 2, 3, 4, 5, 6, 7);
        o[vb] = MFMA(vf, pb, o[vb]);
      }
    }
#pragma unroll
    for (int vb = 0; vb < 2; ++vb)
#pragma unroll
      for (int ks = 0; ks < 4; ++ks) {
        const bf16x8 sf = *(const bf16x8*)(sp + (vb * 32 + r) * 64 + ks * 16 + h * 8);
        o[vb] = MFMA(sf, qf[ks], o[vb]);
      }
    float ss = 0.f;
#pragma unroll
    for (int i = 0; i < 16; ++i) ss += o[0][i] * o[0][i] + o[1][i] * o[1][i];
    ss += __shfl_xor(ss, 32);
    const float rs = rsqrtf(ss * (1.f / 64.f) + EPS);
    const u16* sgb = (const u16*)(ws + OFF_SGB) + (tok0 + r) * 512 + head * 64;
    u16* yb = (u16*)(ws + OFF_YB) + (tok0 + r) * 512 + head * 64;
#pragma unroll
    for (int vb = 0; vb < 2; ++vb)
#pragma unroll
      for (int g = 0; g < 4; ++g) {
        const int v0 = vb * 32 + 8 * g + 4 * h;
        const u2v gt = *(const u2v*)(sgb + v0);
        u2v ov;
        ov.x = pk2(o[vb][4 * g] * rs * bflo(gt.x), o[vb][4 * g + 1] * rs * bfhi(gt.x));
        ov.y = pk2(o[vb][4 * g + 2] * rs * bflo(gt.y), o[vb][4 * g + 3] * rs * bfhi(gt.y));
        *(u2v*)(yb + v0) = ov;
      }
  }
}

DI void phase5(const Params& p, u16* lds) {
  unsigned char* ws = p.ws;
  const int tid = threadIdx.x;
  float* stage = (float*)lds;
  const u16* MG = (const u16*)p.out;
  u16* Mo = (u16*)(ws + OFF_M);
  for (int t = blockIdx.x; t < 2048; t += gridDim.x) {
    const int mt = t >> 3, nt = t & 7;
    const int row0 = mt * 128;
    float* tmp = (float*)(ws + OFF_VTT) + (size_t)blockIdx.x * 16384 + tid * 8;
    {
      f32x16 acc[2][2];
      gemm_core((const u16*)(ws + OFF_YA) + (size_t)row0 * 512, 512, (const u16*)(ws + OFF_WA) + (size_t)nt * 128 * 512, 512, 512, lds, acc, tid);
#pragma unroll
      for (int ps = 0; ps < 2; ++ps) {
        stage_pass(acc, stage, ps, tid);
#pragma unroll
        for (int it = 0; it < 4; ++it) {
          const int item = tid + 256 * it, rr = item >> 4, cc = (item & 15) * 8;
          const u4v g = *(const u4v*)(MG + (size_t)(row0 + ps * 64 + rr) * 2048 + nt * 128 + cc);
          const f4v a = *(const f4v*)(stage + rr * SST + cc), c = *(const f4v*)(stage + rr * SST + cc + 4);
          *(f4v*)(tmp + (ps * 4 + it) * 2048) = f4v{a.x * bflo(g.x), a.y * bfhi(g.x), a.z * bflo(g.y), a.w * bfhi(g.y)};
          *(f4v*)(tmp + (ps * 4 + it) * 2048 + 4) = f4v{c.x * bflo(g.z), c.y * bfhi(g.z), c.z * bflo(g.w), c.w * bfhi(g.w)};
        }
      }
    }
    {
      f32x16 acc[2][2];
      gemm_core((const u16*)(ws + OFF_YB) + (size_t)row0 * 512, 512, (const u16*)(ws + OFF_WB) + (size_t)nt * 128 * 512, 512, 512, lds, acc, tid);
#pragma unroll
      for (int ps = 0; ps < 2; ++ps) {
        stage_pass(acc, stage, ps, tid);
#pragma unroll
        for (int it = 0; it < 4; ++it) {
          const int item = tid + 256 * it, rr = item >> 4, cc = (item & 15) * 8;
          const u4v g = *(const u4v*)(MG + (size_t)(row0 + ps * 64 + rr) * 2048 + 1024 + nt * 128 + cc);
          const f4v a = *(const f4v*)(stage + rr * SST + cc), c = *(const f4v*)(stage + rr * SST + cc + 4);
          f4v k0 = *(const f4v*)(tmp + (ps * 4 + it) * 2048), k1 = *(const f4v*)(tmp + (ps * 4 + it) * 2048 + 4);
          k0.x += a.x * bflo(g.x); k0.y += a.y * bfhi(g.x); k0.z += a.z * bflo(g.y); k0.w += a.w * bfhi(g.y);
          k1.x += c.x * bflo(g.z); k1.y += c.y * bfhi(g.z); k1.z += c.z * bflo(g.w); k1.w += c.w * bfhi(g.w);
          *(u4v*)(Mo + (size_t)(row0 + ps * 64 + rr) * 1024 + nt * 128 + cc) = pk8(k0, k1);
        }
      }
    }
  }
}

DI void phase6(const Params& p, u16* lds) {
  unsigned char* ws = p.ws;
  const int tid = threadIdx.x;
  float* stage = (float*)lds;
  float* ssq_y = (float*)(ws + OFF_SSQ) + 2 * T;
  for (int t = blockIdx.x; t < 2048; t += gridDim.x) {
    const int mt = t >> 3, nt = t & 7;
    const int row0 = mt * 128;
    f32x16 acc[2][2];
    gemm_core((const u16*)(ws + OFF_M) + (size_t)row0 * 1024, 1024, (const u16*)(ws + OFF_WO) + (size_t)nt * 128 * 1024, 1024, 1024, lds, acc, tid);
#pragma unroll 1
    for (int ps = 0; ps < 2; ++ps) {
      stage_pass(acc, stage, ps, tid);
#pragma unroll
      for (int it = 0; it < 4; ++it) {
        const int item = tid + 256 * it, rr = item >> 4, cc = (item & 15) * 8;
        const int grow = row0 + ps * 64 + rr;
        const f4v a = *(const f4v*)(stage + rr * SST + cc), c = *(const f4v*)(stage + rr * SST + cc + 4);
        float ss = a.x * a.x + a.y * a.y + a.z * a.z + a.w * a.w + c.x * c.x + c.y * c.y + c.z * c.z + c.w * c.w;
        ss += __shfl_xor(ss, 1); ss += __shfl_xor(ss, 2); ss += __shfl_xor(ss, 4); ss += __shfl_xor(ss, 8);
        if ((tid & 15) == 0) atomicAdd(ssq_y + grow, ss);
        float* dst = p.out + (size_t)grow * 1024 + nt * 128 + cc;
        *(f4v*)dst = a; *(f4v*)(dst + 4) = c;
      }
    }
  }
}

DI void phase7(const Params& p) {
  const float* ssq_y = (const float*)(p.ws + OFF_SSQ) + 2 * T;
  const int gtid = blockIdx.x * blockDim.x + threadIdx.x, gthreads = gridDim.x * blockDim.x;
  for (int i = gtid; i < T * 256; i += gthreads) {
    const int row = i >> 8, c4 = i & 255;
    const float rs = rsqrtf(ssq_y[row] * (1.f / 1024.f) + EPS);
    const f4v y = ((const f4v*)p.out)[i];
    const f4v xv = ((const f4v*)p.x)[i];
    const f4v g = ((const f4v*)p.g_post)[c4];
    f4v o;
    o.x = xv.x + y.x * rs * g.x; o.y = xv.y + y.y * rs * g.y; o.z = xv.z + y.z * rs * g.z; o.w = xv.w + y.w * rs * g.w;
    ((f4v*)p.out)[i] = o;
  }
}

__global__ void __launch_bounds__(256, 2) fwd_megakernel(Params p) {
  extern __shared__ __attribute__((aligned(16))) unsigned char smem[];
  u16* lds = (u16*)smem;
  cg::grid_group grid = cg::this_grid();
  volatile LAS unsigned* xst = (volatile LAS unsigned*)(smem + LDS_BYTES - 48);
  if (threadIdx.x == 0) { xst[0] = 0u; xst[1] = 0u; }
  __syncthreads();
  XcdBarrier xb = xcd_barrier_post((unsigned*)(p.ws + OFF_BAR), xst);
  if (p.ph_hi > 1000) grid.sync();
#define RUN_PHASE(N, CALL) if (p.ph_lo <= N && N < p.ph_hi) { if (N > p.ph_lo) xcd_barrier(xb); CALL; }
  RUN_PHASE(0, phase0(p))
  RUN_PHASE(1, phase1(p, lds))
  RUN_PHASE(2, phase2(p, lds))
  RUN_PHASE(3, phase3(p, lds))
  RUN_PHASE(4, phase4(p))
  RUN_PHASE(5, phase5(p, lds))
  RUN_PHASE(6, phase6(p, lds))
  RUN_PHASE(7, phase7(p))
}

extern "C" void kernel_launch(void* const* d_in, const int* in_sizes, int n_in, void* d_out, int out_size, void* d_ws, size_t ws_size,
                              hipStream_t stream) {
  static int grid_blocks = 0;
  if (!grid_blocks) {
    int dev = 0, cus = 0, per_cu = 0;
    hipGetDevice(&dev);
    hipDeviceGetAttribute(&cus, hipDeviceAttributeMultiprocessorCount, dev);
    hipFuncSetAttribute((const void*)fwd_megakernel, hipFuncAttributeMaxDynamicSharedMemorySize, LDS_BYTES);
    hipOccupancyMaxActiveBlocksPerMultiprocessor(&per_cu, (const void*)fwd_megakernel, 256, LDS_BYTES);
    if (per_cu < 1) per_cu = 1;
    if (per_cu > 2) per_cu = 2;
    grid_blocks = cus * per_cu;
    if (ws_size < WS_NEED) fprintf(stderr, "kernel_launch: workspace too small: %zu < %zu\n", ws_size, (size_t)WS_NEED);
  }
  if (ws_size < WS_NEED) return;
  Params p{};
  p.x = (const float*)d_in[0]; p.g_pre = (const float*)d_in[1]; p.w_in = (const float*)d_in[2]; p.b_gate = (const float*)d_in[3];
  p.g_q = (const float*)d_in[4]; p.w_uq = (const float*)d_in[5]; p.g_kv = (const float*)d_in[6]; p.w_ukv = (const float*)d_in[7];
  p.lb_logits = (const float*)d_in[8]; p.g_hgrn = (const float*)d_in[9]; p.w_a = (const float*)d_in[10]; p.w_b = (const float*)d_in[11];
  p.w_out = (const float*)d_in[12]; p.g_post = (const float*)d_in[13];
  p.out = (float*)d_out; p.ws = (unsigned char*)d_ws;
#if ONE_LAUNCH
  p.ph_lo = 0; p.ph_hi = 8;
  (void)hipMemsetAsync((unsigned char*)d_ws + OFF_BAR, 0, 16384, stream);
  void* args[] = {&p};
  hipError_t e = hipLaunchCooperativeKernel((const void*)fwd_megakernel, dim3(grid_blocks), dim3(256), args, LDS_BYTES, stream);
  if (e != hipSuccess) fprintf(stderr, "cooperative launch failed: %s (grid %d)\n", hipGetErrorString(e), grid_blocks);
#else
  for (int ph = 0; ph < 8; ++ph) {
    p.ph_lo = ph; p.ph_hi = ph + 1;
    (void)hipMemsetAsync((unsigned char*)d_ws + OFF_BAR, 0, 16384, stream);
    void* args[] = {&p};
    hipError_t e = hipLaunchCooperativeKernel((const void*)fwd_megakernel, dim3(grid_blocks), dim3(256), args, LDS_BYTES, stream);
    if (e != hipSuccess) fprintf(stderr, "cooperative launch failed: %s (grid %d)\n", hipGetErrorString(e), grid_blocks);
  }
#endif
}
```

```cpp
#include <hip/hip_runtime.h>
#include <hip/hip_cooperative_groups.h>
#include <cstdio>
namespace cg = cooperative_groups;

#define DI __device__ __forceinline__
#define VTID ((int)(threadIdx.x & 255))
#define VBID ((int)(blockIdx.x * 2 + (threadIdx.x >> 8)))
#define VBN ((int)(gridDim.x * 2))
typedef unsigned short u16;
typedef unsigned int u32;
typedef __attribute__((ext_vector_type(8))) short bf16x8;
typedef __attribute__((ext_vector_type(4))) short s16x4;
typedef __attribute__((ext_vector_type(16))) float f32x16;
typedef __attribute__((ext_vector_type(2))) __bf16 bf2_t;
typedef __attribute__((ext_vector_type(2))) float f2_t;
typedef __attribute__((ext_vector_type(4))) unsigned int u4v;
typedef __attribute__((ext_vector_type(2))) unsigned int u2v;
typedef __attribute__((ext_vector_type(4))) float f4v;
typedef __attribute__((ext_vector_type(2))) float f2v;
#define MFMA(a, b, c) __builtin_amdgcn_mfma_f32_32x32x16_bf16((a), (b), (c), 0, 0, 0)

#ifndef DUP_PH
#define DUP_PH -1
#endif
#ifndef ONE_LAUNCH
#define ONE_LAUNCH 1
#endif

constexpr int T = 32768;
constexpr int SEQ = 4096;
constexpr int DIN = 5664;
constexpr int NP = 5760;
constexpr float EPS = 1e-6f;
constexpr float QSCALE = 1.4426950408889634f * 0.10206207261596575f;

constexpr size_t SZ_WIN = (size_t)NP * 1024 * 2;
constexpr size_t OFF_WIN = 0;
constexpr size_t OFF_WUQ = OFF_WIN + SZ_WIN;
constexpr size_t OFF_WUKV = OFF_WUQ + (size_t)768 * 768 * 2;
constexpr size_t OFF_WA = OFF_WUKV + (size_t)1024 * 256 * 2;
constexpr size_t OFF_WB = OFF_WA + (size_t)1024 * 512 * 2;
constexpr size_t OFF_WO = OFF_WB + (size_t)1024 * 512 * 2;
constexpr size_t OFF_ROPE = OFF_WO + (size_t)1024 * 1024 * 2;
constexpr size_t OFF_SSQ = OFF_ROPE + (size_t)4096 * 16 * 2 * 4;
constexpr size_t OFF_DECAY = OFF_SSQ + (size_t)(3 * T + 64) * 4;
constexpr size_t OFF_H = OFF_DECAY + (size_t)64 * 128 * 64 * 4;
constexpr size_t OFF_UPD = OFF_H;
constexpr size_t OFF_CQ = OFF_H + (size_t)T * 1024 * 2;
constexpr size_t OFF_YA = OFF_CQ;
constexpr size_t OFF_CKV = OFF_CQ + (size_t)T * 768 * 2;
constexpr size_t OFF_KPE = OFF_CKV + (size_t)T * 256 * 2;
constexpr size_t OFF_SGA = OFF_KPE + (size_t)T * 32 * 4;
constexpr size_t OFF_SGB = OFF_SGA + (size_t)T * 512 * 2;
constexpr size_t OFF_QDEC = OFF_SGB + (size_t)T * 512 * 2;
constexpr size_t OFF_KINV = OFF_QDEC + (size_t)T * 512 * 2;
constexpr size_t OFF_KINVT = OFF_KINV + (size_t)T * 512 * 2;
constexpr size_t OFF_YB = OFF_KINVT;
constexpr size_t OFF_VT = OFF_KINVT + (size_t)T * 512 * 2;
constexpr size_t OFF_Q = OFF_VT + (size_t)T * 512 * 2;
constexpr size_t OFF_M = OFF_Q;
constexpr size_t OFF_K = OFF_Q + (size_t)T * 768 * 2;
constexpr size_t OFF_VTT = OFF_K + (size_t)T * 768 * 2;
constexpr size_t OFF_BAR = OFF_VTT + (size_t)T * 512 * 2;
constexpr size_t WS_NEED = OFF_BAR + 16384;

constexpr int VLDS = 2 * 2 * 128 * 72 * 2;
constexpr int LDS_BYTES = 2 * VLDS + 64;
constexpr int SST = 132;

struct Params {
  const float *x, *g_pre, *w_in, *b_gate, *g_q, *w_uq, *g_kv, *w_ukv, *lb_logits, *g_hgrn, *w_a, *w_b, *w_out, *g_post;
  float* out;
  unsigned char* ws;
  int ph_lo, ph_hi;
};

DI u32 pk2(float a, float b) { f2_t v = {a, b}; bf2_t r = __builtin_convertvector(v, bf2_t); return __builtin_bit_cast(u32, r); }
DI float bflo(u32 u) { return __uint_as_float(u << 16); }
DI float bfhi(u32 u) { return __uint_as_float(u & 0xffff0000u); }
DI u4v pk8(f4v a, f4v b) { u4v r; r.x = pk2(a.x, a.y); r.y = pk2(a.z, a.w); r.z = pk2(b.x, b.y); r.w = pk2(b.z, b.w); return r; }
DI float rcpf(float x) { return __builtin_amdgcn_rcpf(x); }
DI float sigmoidf_(float x) { return rcpf(1.f + __expf(-x)); }
DI float siluf_(float x) { return x * sigmoidf_(x); }
DI int crow(int reg, int h) { return (reg & 3) + 8 * (reg >> 2) + 4 * h; }
DI f32x16 zero16() { f32x16 z;
#pragma unroll
  for (int i = 0; i < 16; ++i) z[i] = 0.f; return z; }

__constant__ float c_invfreq[16] = {1.0f, 0.5623413324356079f, 0.3162277638912201f, 0.17782793939113617f, 0.10000000149011612f,
  0.05623413249850273f, 0.03162277489900589f, 0.017782794311642647f, 0.009999999776482582f, 0.005623413249850273f,
  0.003162277629598975f, 0.0017782794311642647f, 0.0010000000474974513f, 0.000562341301701963f, 0.0003162277571391314f,
  0.00017782794020604342f};

DI void sincos_d(double a, float& sn, float& cs) {
  const double k = rint(a * 0.63661977236758134308);
  const double y = a - k * 1.57079632679489661923;
  const double y2 = y * y;
  const double s = y * (1.0 + y2 * (-1.0 / 6 + y2 * (1.0 / 120 + y2 * (-1.0 / 5040 + y2 * (1.0 / 362880 + y2 * (-1.0 / 39916800 + y2 * (1.0 / 6227020800.0)))))));
  const double c = 1.0 + y2 * (-0.5 + y2 * (1.0 / 24 + y2 * (-1.0 / 720 + y2 * (1.0 / 40320 + y2 * (-1.0 / 3628800 + y2 * (1.0 / 479001600.0 + y2 * (-1.0 / 87178291200.0)))))));
  const int q = ((int)k) & 3;
  const double ss = (q == 0) ? s : (q == 1) ? c : (q == 2) ? -s : -c;
  const double cc = (q == 0) ? c : (q == 1) ? -s : (q == 2) ? -c : s;
  sn = (float)ss; cs = (float)cc;
}

#define XB_TMO      128
#define XB_XCNT(j)  (256  + 64 * (j))
#define XB_XSUB(j)  (1280 + 64 * (j))
#define XB_XGEN(j)  (2304 + 64 * (j))
#define XB_TOP      3328
#define XB_TOPGEN   3392
#define XCD_BAR_WORDS 3456
#define XB_SPIN_CAP (1u << 22)
#define LAS __attribute__((address_space(3)))
DI unsigned xb_ld(unsigned* p)              { return __hip_atomic_load(p, __ATOMIC_RELAXED, __HIP_MEMORY_SCOPE_AGENT); }
DI unsigned xb_add(unsigned* p, unsigned v) { return __hip_atomic_fetch_add(p, v, __ATOMIC_RELAXED, __HIP_MEMORY_SCOPE_AGENT); }
DI unsigned xb_xcc_id() { return (unsigned)__builtin_amdgcn_s_getreg((3 << 11) | 20) & 0xFu; }
#define XB_SPIN(cond, bar) do { unsigned _sp = 0; while (cond) { __builtin_amdgcn_s_sleep(1); \
    if ((++_sp & 255u) == 0u) { if (xb_ld(&(bar)[XB_TMO])) break; if (_sp > XB_SPIN_CAP) { atomicAdd(&(bar)[XB_TMO], 1u); break; } } } } while (0)
struct XcdBarrier { unsigned* bar; unsigned x; volatile LAS unsigned* st; };
DI XcdBarrier xcd_barrier_post(unsigned* bar, volatile LAS unsigned* st) {
  XcdBarrier b; b.bar = bar; b.x = xb_xcc_id(); b.st = st;
  if (threadIdx.x == 0) (void)xb_add(&bar[XB_XCNT(b.x)], 1u);
  return b;
}
DI void xcd_barrier_complete(unsigned* bar, unsigned x, unsigned& nloc, unsigned& nx) {
  const unsigned G = gridDim.x * gridDim.y * gridDim.z;
  unsigned sum, cnt, mine, sp = 0u;
  for (;;) {
    sum = 0u; cnt = 0u; mine = 0u;
#pragma unroll
    for (unsigned j = 0; j < 16; ++j) { const unsigned c = xb_ld(&bar[XB_XCNT(j)]); sum += c; cnt += (c > 0u) ? 1u : 0u; mine = (j == x) ? c : mine; }
    if (sum == G) break;
    __builtin_amdgcn_s_sleep(1);
    if ((++sp & 255u) == 0u) { if (xb_ld(&bar[XB_TMO])) break; if (sp > XB_SPIN_CAP) { atomicAdd(&bar[XB_TMO], 1u); break; } }
  }
  nloc = mine > 0u ? mine : 1u; nx = cnt > 0u ? cnt : 1u;
}
DI void xcd_barrier(const XcdBarrier& b) {
  asm volatile("s_waitcnt vmcnt(0)" ::: "memory");
  __syncthreads();
  if (threadIdx.x == 0) {
    unsigned* bar = b.bar;
    __builtin_amdgcn_s_waitcnt(0);
    unsigned nloc = b.st[0], nx = b.st[1];
    if (nloc == 0u) { xcd_barrier_complete(bar, b.x, nloc, nx); b.st[0] = nloc; b.st[1] = nx; }
    const unsigned old = xb_add(&bar[XB_XSUB(b.x)], 1u);
    const unsigned gen = old / nloc;
    if (old + 1u == (gen + 1u) * nloc) {
      __builtin_amdgcn_fence(__ATOMIC_RELEASE, "agent");
      asm volatile("s_waitcnt vmcnt(0)" ::: "memory");
      const unsigned og = xb_add(&bar[XB_TOP], 1u);
      const unsigned tg = og / nx;
      if (og + 1u == (tg + 1u) * nx) xb_add(&bar[XB_TOPGEN], 1u);
      else XB_SPIN(xb_ld(&bar[XB_TOPGEN]) == tg, bar);
      __builtin_amdgcn_fence(__ATOMIC_ACQUIRE, "agent");
      xb_add(&bar[XB_XGEN(b.x)], 1u);
      asm volatile("s_waitcnt vmcnt(0)" ::: "memory");
    } else {
      XB_SPIN(xb_ld(&bar[XB_XGEN(b.x)]) == gen, bar);
      __builtin_amdgcn_fence(__ATOMIC_ACQUIRE, "agent");
      asm volatile("s_waitcnt vmcnt(0)" ::: "memory");
    }
  }
  __syncthreads();
}

template <int KIND>
DI int colmap(int n) {
  if (KIND == 0) {
    if (n < 1024) return n;
    if (n < 1536) return 1056 + (n - 1024);
    if (n < 2048) return 3104 + (n - 1536);
    if (n < 4096) return 3616 + (n - 2048);
    if (n < 5120) { int i = n - 4096; int hh = i >> 7, c = i & 127; return (c < 64) ? (1568 + hh * 64 + c) : (2080 + hh * 64 + (c - 64)); }
    if (n < 5632) return 2592 + (n - 5120);
    if (n < 5664) return 1024 + (n - 5632);
    return -1;
  } else if (KIND == 1) {
    if (n < 512) return (n >> 6) * 96 + (n & 63);
    int i = n - 512; int w = i & 31, g = w >> 3, e = w & 7; return (i >> 5) * 96 + 64 + ((e < 4) ? (4 * g + e) : (16 + 4 * g + (e - 4)));
  } else return n;
}
template <int KIND>
DI void conv_weight(u16* dst, const float* src, int ldw, int ncount, int K, const float* gain, int gmask, int gtid, int gthreads) {
  const int total = ncount * (K >> 3);
  for (int it = gtid; it < total; it += gthreads) {
    const int n = it % ncount, kc = it / ncount;
    const int sc = colmap<KIND>(n);
    float v[8];
#pragma unroll
    for (int i = 0; i < 8; ++i) {
      const int k = kc * 8 + i;
      float x = (sc >= 0) ? src[(size_t)k * ldw + sc] : 0.f;
      if (gain) x *= gain[k & gmask];
      v[i] = x;
    }
    u4v o; o.x = pk2(v[0], v[1]); o.y = pk2(v[2], v[3]); o.z = pk2(v[4], v[5]); o.w = pk2(v[6], v[7]);
    *(u4v*)(dst + (size_t)n * K + kc * 8) = o;
  }
}

DI void phase0(const Params& p) {
  unsigned char* ws = p.ws;
  const int gtid = blockIdx.x * blockDim.x + threadIdx.x, gthreads = gridDim.x * blockDim.x;
  float* ssq = (float*)(ws + OFF_SSQ);
  for (int i = gtid; i < 3 * T + 64; i += gthreads) ssq[i] = 0.f;
  float* rope = (float*)(ws + OFF_ROPE);
  for (int i = gtid; i < 4096 * 16; i += gthreads) {
    const int pos = i >> 4, j = i & 15;
    const float ang = (float)pos * c_invfreq[j];
    float sn, cs; sincos_d((double)ang, sn, cs);
    rope[i] = cs; rope[65536 + i] = sn;
  }
  conv_weight<0>((u16*)(ws + OFF_WIN), p.w_in, DIN, NP, 1024, nullptr, 0, gtid, gthreads);
  conv_weight<1>((u16*)(ws + OFF_WUQ), p.w_uq, 768, 768, 768, p.g_q, 1023, gtid, gthreads);
  conv_weight<2>((u16*)(ws + OFF_WUKV), p.w_ukv, 1024, 1024, 256, p.g_kv, 255, gtid, gthreads);
  conv_weight<2>((u16*)(ws + OFF_WA), p.w_a, 1024, 1024, 512, nullptr, 0, gtid, gthreads);
  conv_weight<2>((u16*)(ws + OFF_WB), p.w_b, 1024, 1024, 512, p.g_hgrn, 63, gtid, gthreads);
  conv_weight<2>((u16*)(ws + OFF_WO), p.w_out, 1024, 1024, 1024, nullptr, 0, gtid, gthreads);
  u16* H = (u16*)(ws + OFF_H);
  const int lane = threadIdx.x & 63;
  const int gw = gtid >> 6, nw = gthreads >> 6;
  for (int row = gw; row < T; row += nw) {
    const f4v* xr = (const f4v*)(p.x + (size_t)row * 1024);
    f4v v[4];
    float ss = 0.f;
#pragma unroll
    for (int i = 0; i < 4; ++i) { v[i] = xr[lane * 4 + i]; ss += v[i].x * v[i].x + v[i].y * v[i].y + v[i].z * v[i].z + v[i].w * v[i].w; }
#pragma unroll
    for (int o = 32; o >= 1; o >>= 1) ss += __shfl_xor(ss, o);
    const float rs = rsqrtf(ss * (1.f / 1024.f) + EPS);
    const f4v* gp = (const f4v*)(p.g_pre);
    f4v g[4];
#pragma unroll
    for (int i = 0; i < 4; ++i) { g[i] = gp[lane * 4 + i]; v[i].x *= rs * g[i].x; v[i].y *= rs * g[i].y; v[i].z *= rs * g[i].z; v[i].w *= rs * g[i].w; }
    u4v* hr = (u4v*)(H + (size_t)row * 1024 + lane * 16);
    hr[0] = pk8(v[0], v[1]); hr[1] = pk8(v[2], v[3]);
  }
}

constexpr int TS = 128 * 72;
DI void gemm_ld(u4v (&ra)[4], u4v (&rb)[4], const u16* ga, const u16* gb, int lda, int ldb, int ko) {
#pragma unroll
  for (int i = 0; i < 4; ++i) { ra[i] = *(const u4v*)(ga + (size_t)(32 * i) * lda + ko); rb[i] = *(const u4v*)(gb + (size_t)(32 * i) * ldb + ko); }
}
DI void gemm_st(const u4v (&ra)[4], const u4v (&rb)[4], u16* buf, int lr, int lc) {
  u16* sa = buf; u16* sb = buf + TS;
#pragma unroll
  for (int i = 0; i < 4; ++i) { *(u4v*)(sa + (lr + 32 * i) * 72 + lc * 8) = ra[i]; *(u4v*)(sb + (lr + 32 * i) * 72 + lc * 8) = rb[i]; }
}
DI void gemm_mma(const u16* buf, f32x16 (&acc)[2][2], int wm, int wn, int r, int h) {
  const u16* sa = buf + (wm * 64 + r) * 72 + h * 8;
  const u16* sb = buf + TS + (wn * 64 + r) * 72 + h * 8;
#pragma unroll
  for (int ks = 0; ks < 4; ++ks) {
    const bf16x8 a0 = *(const bf16x8*)(sa + ks * 16);
    const bf16x8 a1 = *(const bf16x8*)(sa + 32 * 72 + ks * 16);
    const bf16x8 b0 = *(const bf16x8*)(sb + ks * 16);
    const bf16x8 b1 = *(const bf16x8*)(sb + 32 * 72 + ks * 16);
    acc[0][0] = MFMA(a0, b0, acc[0][0]);
    acc[0][1] = MFMA(a0, b1, acc[0][1]);
    acc[1][0] = MFMA(a1, b0, acc[1][0]);
    acc[1][1] = MFMA(a1, b1, acc[1][1]);
  }
}
DI void gemm_core(const u16* __restrict__ A, int lda, const u16* __restrict__ B, int ldb, int K, u16* lds, f32x16 (&acc)[2][2], int tid) {
  const int lane = tid & 63, w = tid >> 6, wm = w >> 1, wn = w & 1, r = lane & 31, h = lane >> 5;
  const int lc = tid & 7, lr = tid >> 3;
  const u16* ga = A + (size_t)lr * lda + lc * 8;
  const u16* gb = B + (size_t)lr * ldb + lc * 8;
  u4v ra0[4], rb0[4], ra1[4], rb1[4];
  gemm_ld(ra0, rb0, ga, gb, lda, ldb, 0);
  gemm_ld(ra1, rb1, ga, gb, lda, ldb, 64);
#pragma unroll
  for (int i = 0; i < 2; ++i)
#pragma unroll
    for (int j = 0; j < 2; ++j) acc[i][j] = zero16();
  u16* L0 = lds; u16* L1 = lds + 2 * TS;
  __syncthreads();
  gemm_st(ra0, rb0, L0, lr, lc);
  __syncthreads();
  const int nk = K >> 6;
  int kt = 0;
  for (; kt + 2 < nk; kt += 2) {
    gemm_ld(ra0, rb0, ga, gb, lda, ldb, (kt + 2) * 64);
    __builtin_amdgcn_sched_barrier(0);
    gemm_mma(L0, acc, wm, wn, r, h);
    gemm_st(ra1, rb1, L1, lr, lc);
    __syncthreads();
    gemm_ld(ra1, rb1, ga, gb, lda, ldb, (kt + 3) * 64);
    __builtin_amdgcn_sched_barrier(0);
    gemm_mma(L1, acc, wm, wn, r, h);
    gemm_st(ra0, rb0, L0, lr, lc);
    __syncthreads();
  }
  gemm_mma(L0, acc, wm, wn, r, h);
  gemm_st(ra1, rb1, L1, lr, lc);
  __syncthreads();
  gemm_mma(L1, acc, wm, wn, r, h);
  __syncthreads();
}

DI void stage_pass(const f32x16 (&acc)[2][2], float* stage, int p, int tid) {
  const int lane = tid & 63, w = tid >> 6, wm = w >> 1, wn = w & 1, r = lane & 31, h = lane >> 5;
  __syncthreads();
  if (wm == p) {
#pragma unroll
    for (int i = 0; i < 2; ++i)
#pragma unroll
      for (int j = 0; j < 2; ++j)
#pragma unroll
        for (int reg = 0; reg < 16; ++reg) stage[(i * 32 + crow(reg, h)) * SST + wn * 64 + j * 32 + r] = acc[i][j][reg];
  }
  __syncthreads();
}

namespace pg8 {
#define PG8_LAS __attribute__((address_space(3)))
typedef unsigned short bf16_t;
typedef short bf16x8 __attribute__((ext_vector_type(8)));
typedef float f32x4 __attribute__((ext_vector_type(4)));
typedef unsigned u32x4 __attribute__((ext_vector_type(4)));
constexpr int BM = 256, BK = 64, HALF = 128, HTB = HALF * BK * 2  , STAGE_BYTES = 8 * HTB, NXCD = 8, WGM = 8;

__host__ __device__ __forceinline__ int lds_byte(int r, int c) { const int st = (r >> 4) * 2 + (c >> 5), rr = r & 15, cc = c & 31, ob = rr * 64 + cc * 2; return st * 1024 + (ob ^ (((ob >> 9) & 1) << 5)); }
__host__ __device__ __forceinline__ void stage_rc(int b, int& R, int& C) { const int st = b / 1024, sb = b % 1024, swz = sb ^ (((sb >> 9) & 1) << 5); R = (st >> 1) * 16 + swz / 64; C = (st & 1) * 32 + (swz % 64) / 2; }
__host__ __device__ __forceinline__ int perm32(int rho) { const int n = rho >> 4, i = rho & 15; return 8 * (i >> 2) + 4 * n + (i & 3); }

struct Unit { int pm, pn; };
struct Gemm { const bf16_t* A; const bf16_t* Bt; int M, N, K; };

struct StaticOrder {
    int nM, nN, nwg, G, c;
    __host__ __device__ void init(int M, int N, int G_, int c_) { nM = M / BM; nN = N / BM; nwg = nM * nN; G = G_; c = c_; }
    __host__ __device__ bool next(int i, Unit& u) const {
        const long L = (long)i * G + c; if (L >= nwg) return false;
        int wgid = (int)L; { const int q = nwg / NXCD, r = nwg % NXCD, xcd = wgid % NXCD, off = wgid / NXCD; wgid = (xcd < r ? xcd * (q + 1) : r * (q + 1) + (xcd - r) * q) + off; }
        const int nig = WGM * nN, gid = wgid / nig, fm = gid * WGM, gsz = (nM - fm) < WGM ? (nM - fm) : WGM;
        u.pm = fm + ((wgid % nig) % gsz); u.pn = (wgid % nig) / gsz; return true;
    }
    __device__ __forceinline__ void a_ready(const Unit&) const {}
    __device__ __forceinline__ void done(const Unit&) const {}
};
template <class Epi, class Sched, bool STAMP = false>
__device__ __forceinline__ void gemm_phase(PG8_LAS unsigned char* lds, const Gemm g, const Sched& S, const Epi& E, unsigned long long* stamps) {
    const int tid = threadIdx.x, wid = __builtin_amdgcn_readfirstlane(tid >> 6), lane = tid & 63, wr = wid >> 2, wc = wid & 3, fr = lane & 15, fq = lane >> 4;
    const int K = g.K, nt = K / BK;
    int ts_lo = 0, ts_hi = 0, nts = 0; const unsigned long long rt_entry = STAMP ? (unsigned long long)wall_clock64() : 0ull;
#define PG8_STAMP() do { if (STAMP && wid == 0 && nts < 64) { const unsigned long long _c = (unsigned long long)clock64(); \
        ts_lo = (lane == nts) ? (int)(unsigned)_c : ts_lo; ts_hi = (lane == nts) ? (int)(unsigned)(_c >> 32) : ts_hi; ++nts; } } while (0)
    PG8_STAMP();
    unsigned voffA[2], voffB[2];
#pragma unroll
    for (int i = 0; i < 2; ++i) { int R, C; stage_rc(tid * 16 + i * 8192, R, C); const int Rb = Epi::PERM ? ((R & ~31) + perm32(R & 31)) : R;
        voffA[i] = (unsigned)(R * K + C) * 2u; voffB[i] = (unsigned)(Rb * K + C) * 2u; }
    const size_t kstep = (size_t)(BK * 2);
    const size_t hstep = (size_t)HALF * K * 2;
    const size_t tstep = 2 * hstep;
    const unsigned ldsw = (unsigned)wid * 1024u;
    const int aoff = lds_byte(wr * 64 + fr, fq * 8), boff = lds_byte(wc * 32 + fr, fq * 8);
#define PG8_SA(b, h) (((b) * 2 + (h)) * HTB)
#define PG8_SB(b, h) ((4 + (b) * 2 + (h)) * HTB)
#define PG8_STAGE(bufoff, gbase, voff) do { _Pragma("unroll") for (int _i = 0; _i < 2; ++_i) \
        __builtin_amdgcn_global_load_lds((const unsigned*)((const char*)(gbase) + (voff)[_i]), (PG8_LAS unsigned*)(lds + (bufoff) + ldsw + _i * 8192), 16, 0, 0); } while (0)
#define PG8_LDA(dst, b, h) do { _Pragma("unroll") for (int m = 0; m < 4; ++m) _Pragma("unroll") for (int k = 0; k < 2; ++k) dst[m][k] = *(const PG8_LAS bf16x8*)(lds + PG8_SA(b, h) + aoff + m * 2048 + k * 1024); } while (0)
#define PG8_LDB(dst, b, h) do { _Pragma("unroll") for (int n = 0; n < 2; ++n) _Pragma("unroll") for (int k = 0; k < 2; ++k) dst[n][k] = *(const PG8_LAS bf16x8*)(lds + PG8_SB(b, h) + boff + n * 2048 + k * 1024); } while (0)
#define PG8_MMA(ai, bj, At, Bt) do { __builtin_amdgcn_s_setprio(1); _Pragma("unroll") for (int m = 0; m < 4; ++m) _Pragma("unroll") for (int n = 0; n < 2; ++n) _Pragma("unroll") for (int k = 0; k < 2; ++k) \
        acc[ai][bj][m][n] = __builtin_amdgcn_mfma_f32_16x16x32_bf16(Bt[n][k], At[m][k], acc[ai][bj][m][n], 0, 0, 0); __builtin_amdgcn_s_setprio(0); } while (0)
#define PG8_WAIT_V(n) asm volatile("s_waitcnt vmcnt(" #n ")" ::: "memory")
#define PG8_WAIT_L(n) asm volatile("s_waitcnt lgkmcnt(" #n ")" ::: "memory")
#define PG8_BAR __builtin_amdgcn_s_barrier()
#define PG8_SCHED __builtin_amdgcn_sched_barrier(0)
    Unit cur, nxt; int ui = 0;
    if (!S.next(0, cur)) return;
    f32x4 acc[2][2][4][2];
#pragma unroll
    for (int a = 0; a < 2; ++a)
#pragma unroll
        for (int b = 0; b < 2; ++b)
#pragma unroll
            for (int m = 0; m < 4; ++m)
#pragma unroll
                for (int n = 0; n < 2; ++n) acc[a][b][m][n] = (f32x4){0.f, 0.f, 0.f, 0.f};
    bf16x8 At[4][2], B0[2][2], B1[2][2];
    const char* cA = (const char*)g.A + (size_t)cur.pm * tstep; const char* cB = (const char*)g.Bt + (size_t)cur.pn * tstep;
    S.a_ready(cur);
    PG8_STAGE(PG8_SB(0, 0), cB, voffB); PG8_STAGE(PG8_SA(0, 0), cA, voffA); PG8_STAGE(PG8_SB(0, 1), cB + hstep, voffB); PG8_STAGE(PG8_SA(0, 1), cA + hstep, voffA);
    if (wr == 1) PG8_BAR;
    PG8_WAIT_V(4); PG8_BAR;
    PG8_STAGE(PG8_SB(1, 0), cB + kstep, voffB); PG8_STAGE(PG8_SA(1, 0), cA + kstep, voffA); PG8_STAGE(PG8_SB(1, 1), cB + hstep + kstep, voffB);
    PG8_WAIT_V(6); PG8_BAR;
    PG8_STAMP();
    for (;;) {
        const bool has_next = S.next(ui + 1, nxt);
        const char* nA = has_next ? (const char*)g.A + (size_t)nxt.pm * tstep : cA; const char* nB = has_next ? (const char*)g.Bt + (size_t)nxt.pn * tstep : cB;
        for (int t = 0; t < nt; t += 2) {
            const bool last = (t == nt - 2);
            const char* a1 = cA + (size_t)(t + 1) * kstep;
            const char* a2 = last ? nA : cA + (size_t)(t + 2) * kstep; const char* b2 = last ? nB : cB + (size_t)(t + 2) * kstep;
            const char* a3 = a2 + kstep; const char* b3 = b2 + kstep;
            if (last && has_next) S.a_ready(nxt);
            PG8_LDB(B0, 0, 0); PG8_SCHED; PG8_LDA(At, 0, 0); PG8_STAGE(PG8_SA(1, 1), a1 + hstep, voffA);
            PG8_WAIT_L(8); PG8_BAR; PG8_WAIT_L(0); PG8_MMA(0, 0, At, B0); PG8_BAR; PG8_SCHED;
            PG8_LDB(B1, 0, 1); PG8_STAGE(PG8_SB(0, 0), b2, voffB);
            PG8_BAR; PG8_WAIT_L(0); PG8_MMA(0, 1, At, B1); PG8_BAR;
            PG8_LDA(At, 0, 1); PG8_STAGE(PG8_SA(0, 0), a2, voffA);
            PG8_BAR; PG8_WAIT_L(0); PG8_MMA(1, 0, At, B0); PG8_BAR; PG8_SCHED;
            PG8_STAGE(PG8_SB(0, 1), b2 + hstep, voffB);
            PG8_WAIT_V(6); PG8_BAR; PG8_MMA(1, 1, At, B1); PG8_BAR;
            PG8_LDB(B0, 1, 0); PG8_SCHED; PG8_LDA(At, 1, 0); PG8_STAGE(PG8_SA(0, 1), a2 + hstep, voffA);
            PG8_WAIT_L(8); PG8_BAR; PG8_WAIT_L(0); PG8_MMA(0, 0, At, B0); PG8_BAR; PG8_SCHED;
            PG8_LDB(B1, 1, 1); PG8_STAGE(PG8_SB(1, 0), b3, voffB);
            PG8_BAR; PG8_WAIT_L(0); PG8_MMA(0, 1, At, B1); PG8_BAR;
            PG8_LDA(At, 1, 1); PG8_STAGE(PG8_SA(1, 0), a3, voffA);
            PG8_BAR; PG8_WAIT_L(0); PG8_MMA(1, 0, At, B0); PG8_BAR; PG8_SCHED;
            PG8_STAGE(PG8_SB(1, 1), b3 + hstep, voffB);
            PG8_WAIT_V(6); PG8_BAR; PG8_MMA(1, 1, At, B1); PG8_BAR;
        }
        PG8_STAMP();
        if constexpr (!Epi::AFTER_DRAIN) { E(acc, cur, wr, wc, fr, fq); S.done(cur); }
        PG8_STAMP();
        if (!has_next) break;
#pragma unroll
        for (int a = 0; a < 2; ++a)
#pragma unroll
            for (int b = 0; b < 2; ++b)
#pragma unroll
                for (int m = 0; m < 4; ++m)
#pragma unroll
                    for (int n = 0; n < 2; ++n) acc[a][b][m][n] = (f32x4){0.f, 0.f, 0.f, 0.f};
        cur = nxt; cA = nA; cB = nB; ++ui;
    }
    PG8_WAIT_V(0);
    if (wr == 0) PG8_BAR;
    PG8_BAR;
    if constexpr (Epi::AFTER_DRAIN) { E.fused(acc, cur, wr, wc, fr, fq, lds, wid, lane); S.done(cur); }
    PG8_STAMP();
    if (STAMP && wid == 0) { stamps[lane] = lane < nts ? (((unsigned long long)(unsigned)ts_hi << 32) | (unsigned)ts_lo) : 0ull;
        if (lane == 62) stamps[62] = rt_entry; if (lane == 63) stamps[63] = (unsigned long long)wall_clock64(); }
#undef PG8_STAMP
#undef PG8_SA
#undef PG8_SB
#undef PG8_STAGE
#undef PG8_LDA
#undef PG8_LDB
#undef PG8_MMA
#undef PG8_WAIT_V
#undef PG8_WAIT_L
#undef PG8_BAR
#undef PG8_SCHED
}
}

struct Epi1 {
  static constexpr bool PERM = true, AFTER_DRAIN = false;
  unsigned char* ws; u16* mg; const float* b_gate; bool dup;
  DI void operator()(const pg8::f32x4 (&acc)[2][2][4][2], const pg8::Unit& u, int wr, int wc, int fr, int fq) const {
    const int pn = u.pn;
    const int rowb = u.pm * 256 + wr * 64 + fr;
    const int colu = wc * 32 + 8 * fq;
    if (pn < 4) {
      u16* dst = (pn < 3) ? (u16*)(ws + OFF_CQ) + pn * 256 : (u16*)(ws + OFF_CKV);
      const int ld = (pn < 3) ? 768 : 256;
      float* ssq = (float*)(ws + OFF_SSQ) + ((pn < 3) ? 0 : T);
#pragma unroll
      for (int ai = 0; ai < 2; ++ai)
#pragma unroll
        for (int m = 0; m < 4; ++m) {
          const int row = rowb + ai * 128 + m * 16;
          float ss = 0.f;
#pragma unroll
          for (int bj = 0; bj < 2; ++bj) {
            const pg8::f32x4 v0 = acc[ai][bj][m][0], v1 = acc[ai][bj][m][1];
            ss += v0[0] * v0[0] + v0[1] * v0[1] + v0[2] * v0[2] + v0[3] * v0[3] + v1[0] * v1[0] + v1[1] * v1[1] + v1[2] * v1[2] + v1[3] * v1[3];
            u4v o; o.x = pk2(v0[0], v0[1]); o.y = pk2(v0[2], v0[3]); o.z = pk2(v1[0], v1[1]); o.w = pk2(v1[2], v1[3]);
            *(u4v*)(dst + (size_t)row * ld + bj * 128 + colu) = o;
          }
          ss += __shfl_xor(ss, 16); ss += __shfl_xor(ss, 32);
          if (fq == 0 && !dup) atomicAdd(ssq + row, ss);
        }
    } else if (pn < 8) {
      u16* dst = (u16*)(ws + ((pn < 6) ? OFF_SGA : OFF_SGB)) + (pn & 1) * 256;
#pragma unroll
      for (int ai = 0; ai < 2; ++ai)
#pragma unroll
        for (int m = 0; m < 4; ++m) {
          const int row = rowb + ai * 128 + m * 16;
#pragma unroll
          for (int bj = 0; bj < 2; ++bj) {
            const pg8::f32x4 v0 = acc[ai][bj][m][0], v1 = acc[ai][bj][m][1];
            u4v o; o.x = pk2(siluf_(v0[0]), siluf_(v0[1])); o.y = pk2(siluf_(v0[2]), siluf_(v0[3]));
            o.z = pk2(siluf_(v1[0]), siluf_(v1[1])); o.w = pk2(siluf_(v1[2]), siluf_(v1[3]));
            *(u4v*)(dst + (size_t)row * 512 + bj * 128 + colu) = o;
          }
        }
    } else {
      const int cb = (pn - 8) * 256 + colu;
      f4v b0[2], b1[2];
#pragma unroll
      for (int bj = 0; bj < 2; ++bj) { b0[bj] = *(const f4v*)(b_gate + cb + bj * 128); b1[bj] = *(const f4v*)(b_gate + cb + bj * 128 + 4); }
#pragma unroll
      for (int ai = 0; ai < 2; ++ai)
#pragma unroll
        for (int m = 0; m < 4; ++m) {
          const int row = rowb + ai * 128 + m * 16;
#pragma unroll
          for (int bj = 0; bj < 2; ++bj) {
            const pg8::f32x4 v0 = acc[ai][bj][m][0], v1 = acc[ai][bj][m][1];
            u4v o; o.x = pk2(sigmoidf_(v0[0] + b0[bj].x), sigmoidf_(v0[1] + b0[bj].y)); o.y = pk2(sigmoidf_(v0[2] + b0[bj].z), sigmoidf_(v0[3] + b0[bj].w));
            o.z = pk2(sigmoidf_(v1[0] + b1[bj].x), sigmoidf_(v1[1] + b1[bj].y)); o.w = pk2(sigmoidf_(v1[2] + b1[bj].z), sigmoidf_(v1[3] + b1[bj].w));
            *(u4v*)(mg + (size_t)row * 2048 + cb + bj * 128) = o;
          }
        }
    }
  }
};


struct Epi6 {
  static constexpr bool PERM = true, AFTER_DRAIN = false;
  float* out; float* ssq; bool dup;
  DI void operator()(const pg8::f32x4 (&acc)[2][2][4][2], const pg8::Unit& u, int wr, int wc, int fr, int fq) const {
    const int rowb = u.pm * 256 + wr * 64 + fr;
    const int colb = u.pn * 256 + wc * 32 + 8 * fq;
#pragma unroll
    for (int ai = 0; ai < 2; ++ai)
#pragma unroll
      for (int m = 0; m < 4; ++m) {
        const int row = rowb + ai * 128 + m * 16;
        float ss = 0.f;
#pragma unroll
        for (int bj = 0; bj < 2; ++bj) {
          const pg8::f32x4 v0 = acc[ai][bj][m][0], v1 = acc[ai][bj][m][1];
          ss += v0[0] * v0[0] + v0[1] * v0[1] + v0[2] * v0[2] + v0[3] * v0[3] + v1[0] * v1[0] + v1[1] * v1[1] + v1[2] * v1[2] + v1[3] * v1[3];
          float* dst = out + (size_t)row * 1024 + colb + bj * 128;
          *(pg8::f32x4*)dst = v0; *(pg8::f32x4*)(dst + 4) = v1;
        }
        ss += __shfl_xor(ss, 16); ss += __shfl_xor(ss, 32);
        if (fq == 0 && !dup) atomicAdd(ssq + row, ss);
      }
  }
};
template <bool SECOND> struct Epi5 {
  static constexpr bool PERM = true, AFTER_DRAIN = false;
  const u16* mg; u16* mo;
  DI void operator()(const pg8::f32x4 (&acc)[2][2][4][2], const pg8::Unit& u, int wr, int wc, int fr, int fq) const {
    const int rowb = u.pm * 256 + wr * 64 + fr;
    const int colb = u.pn * 256 + wc * 32 + 8 * fq;
#pragma unroll
    for (int ai = 0; ai < 2; ++ai)
#pragma unroll
      for (int m = 0; m < 4; ++m) {
        const int row = rowb + ai * 128 + m * 16;
#pragma unroll
        for (int bj = 0; bj < 2; ++bj) {
          const pg8::f32x4 v0 = acc[ai][bj][m][0], v1 = acc[ai][bj][m][1];
          const int col = colb + bj * 128;
          const u4v g = *(const u4v*)(mg + (size_t)row * 2048 + (SECOND ? 1024 : 0) + col);
          float r0 = v0[0] * bflo(g.x), r1 = v0[1] * bfhi(g.x), r2 = v0[2] * bflo(g.y), r3 = v0[3] * bfhi(g.y);
          float r4 = v1[0] * bflo(g.z), r5 = v1[1] * bfhi(g.z), r6 = v1[2] * bflo(g.w), r7 = v1[3] * bfhi(g.w);
          u16* mp = mo + (size_t)row * 1024 + col;
          if (SECOND) {
            const u4v pm = *(const u4v*)mp;
            r0 += bflo(pm.x); r1 += bfhi(pm.x); r2 += bflo(pm.y); r3 += bfhi(pm.y); r4 += bflo(pm.z); r5 += bfhi(pm.z); r6 += bflo(pm.w); r7 += bfhi(pm.w);
          }
          u4v o; o.x = pk2(r0, r1); o.y = pk2(r2, r3); o.z = pk2(r4, r5); o.w = pk2(r6, r7);
          *(u4v*)mp = o;
        }
      }
  }
};
struct EpiQ {
  static constexpr bool PERM = true, AFTER_DRAIN = false;
  const float* ssq_q; const float* rope; u16* Qo;
  DI void operator()(const pg8::f32x4 (&acc)[2][2][4][2], const pg8::Unit& u, int wr, int wc, int fr, int fq) const {
    const int rowb = u.pm * 256 + wr * 64 + fr;
    const int colu = wc * 32 + 8 * fq;
#pragma unroll
    for (int ai = 0; ai < 2; ++ai)
#pragma unroll
      for (int m = 0; m < 4; ++m) {
        const int row = rowb + ai * 128 + m * 16;
        const int b = row >> 12, spos = row & 4095;
        const float sc = rsqrtf(ssq_q[row] * (1.f / 768.f) + EPS) * QSCALE;
#pragma unroll
        for (int bj = 0; bj < 2; ++bj) {
          const pg8::f32x4 v0 = acc[ai][bj][m][0], v1 = acc[ai][bj][m][1];
          if (u.pn < 2) {
            const int head = u.pn * 4 + bj * 2 + (colu >> 6), d = colu & 63;
            u4v o; o.x = pk2(v0[0] * sc, v0[1] * sc); o.y = pk2(v0[2] * sc, v0[3] * sc); o.z = pk2(v1[0] * sc, v1[1] * sc); o.w = pk2(v1[2] * sc, v1[3] * sc);
            *(u4v*)(Qo + ((size_t)(b * 8 + head) * 4096 + spos) * 96 + d) = o;
          } else {
            const int head = bj * 4 + wc;
            const f4v cs = *(const f4v*)(rope + spos * 16 + 4 * fq), sn = *(const f4v*)(rope + 65536 + spos * 16 + 4 * fq);
            u2v o1, o2;
            o1.x = pk2((v0[0] * cs.x - v1[0] * sn.x) * sc, (v0[1] * cs.y - v1[1] * sn.y) * sc);
            o1.y = pk2((v0[2] * cs.z - v1[2] * sn.z) * sc, (v0[3] * cs.w - v1[3] * sn.w) * sc);
            o2.x = pk2((v0[0] * sn.x + v1[0] * cs.x) * sc, (v0[1] * sn.y + v1[1] * cs.y) * sc);
            o2.y = pk2((v0[2] * sn.z + v1[2] * cs.z) * sc, (v0[3] * sn.w + v1[3] * cs.w) * sc);
            u16* qp = Qo + ((size_t)(b * 8 + head) * 4096 + spos) * 96 + 64 + 4 * fq;
            *(u2v*)qp = o1; *(u2v*)(qp + 16) = o2;
          }
        }
      }
  }
};

DI void phase1(const Params& p, unsigned char* smem, u16* lds, bool dup = false) {
  unsigned char* ws = p.ws;
  const int tid = VTID;
  const u16* H = (const u16*)(ws + OFF_H);
  const u16* W = (const u16*)(ws + OFF_WIN);
  float* stage = (float*)lds;
  float* ssq_q = (float*)(ws + OFF_SSQ);
  float* ssq_kv = ssq_q + T;
  {
    pg8::Gemm g{H, W, T, 4096, 1024};
    pg8::StaticOrder S; S.init(T, 4096, (int)gridDim.x, (int)blockIdx.x);
    Epi1 E{ws, (u16*)p.out, p.b_gate, dup};
    pg8::gemm_phase<Epi1, pg8::StaticOrder, false>((PG8_LAS unsigned char*)smem, g, S, E, nullptr);
  }
  for (int t = VBID; t < 256 * 13; t += VBN) {
    int mt, nt;
    if (t < 2048) { mt = t >> 3; nt = 32 + (t & 7); }
    else if (t < 3072) { mt = (t - 2048) >> 2; nt = 40 + ((t - 2048) & 3); }
    else { mt = t - 3072; nt = 44; }
    f32x16 acc[2][2];
    gemm_core(H + (size_t)mt * 128 * 1024, 1024, W + (size_t)nt * 128 * 1024, 1024, 1024, lds, acc, tid);
    const int row0 = mt * 128;
    const int b = row0 >> 12, spos0 = row0 & 4095;
#pragma unroll 1
    for (int ps = 0; ps < 2; ++ps) {
      stage_pass(acc, stage, ps, tid);
      const int prow0 = row0 + ps * 64;
      if (nt < 40) {
        const int hh = nt - 32;
        const int bh = b * 8 + hh;
        const int nblk0 = (spos0 + ps * 64) >> 5;
        if (tid < 128) {
          const int c = tid & 63, blk = tid >> 6;
          const float l0 = p.lb_logits[hh * 64 + c], l1 = p.lb_logits[512 + hh * 64 + c];
          const float lbv = 1.f / (1.f + expf(l1 - l0));
          float cum = 0.f;
          for (int rr = 0; rr < 32; ++rr) {
            float* sp = stage + (blk * 32 + rr) * SST + c;
            const float q = sp[0], hf = sp[64];
            const float sg = 1.f / (1.f + expf(-hf));
            const float f = lbv + (1.f - lbv) * sg;
            cum += logf(f);
            const float e = expf(cum);
            sp[0] = q * e;
            sp[64] = (1.f - f) / e;
          }
          ((float*)(ws + OFF_DECAY))[((size_t)bh * 128 + nblk0 + blk) * 64 + c] = expf(cum);
        }
        __syncthreads();
#pragma unroll
        for (int it = 0; it < 2; ++it) {
          const int item = tid + 256 * it, rr = item >> 3, cc = (item & 7) * 8;
          const f4v a = *(const f4v*)(stage + rr * SST + cc), c = *(const f4v*)(stage + rr * SST + cc + 4);
          const f4v d = *(const f4v*)(stage + rr * SST + 64 + cc), e = *(const f4v*)(stage + rr * SST + 64 + cc + 4);
          const size_t o = (size_t)(prow0 + rr) * 512 + hh * 64 + cc;
          *(u4v*)((u16*)(ws + OFF_QDEC) + o) = pk8(a, c);
          *(u4v*)((u16*)(ws + OFF_KINV) + o) = pk8(d, e);
        }
#pragma unroll
        for (int it = 0; it < 2; ++it) {
          const int item = tid + 256 * it, sc = item & 3, k = (item >> 2) & 63, blk = item >> 8;
          float v[8];
#pragma unroll
          for (int i = 0; i < 8; ++i) v[i] = stage[(blk * 32 + sc * 8 + i) * SST + 64 + k];
          u4v o; o.x = pk2(v[0], v[1]); o.y = pk2(v[2], v[3]); o.z = pk2(v[4], v[5]); o.w = pk2(v[6], v[7]);
          *(u4v*)((u16*)(ws + OFF_KINVT) + (((size_t)bh * 128 + nblk0 + blk) * 64 + k) * 32 + sc * 8) = o;
        }
      } else if (nt < 44) {
        const int nblk0 = (spos0 + ps * 64) >> 5;
#pragma unroll
        for (int it = 0; it < 4; ++it) {
          const int item = tid + 256 * it, sc = item & 3, col = (item >> 2) & 127, blk = item >> 9;
          float v[8];
#pragma unroll
          for (int i = 0; i < 8; ++i) v[i] = stage[(blk * 32 + sc * 8 + i) * SST + col];
          u4v o; o.x = pk2(v[0], v[1]); o.y = pk2(v[2], v[3]); o.z = pk2(v[4], v[5]); o.w = pk2(v[6], v[7]);
          const int bh = b * 8 + (nt - 40) * 2 + (col >> 6);
          *(u4v*)((u16*)(ws + OFF_VT) + (((size_t)bh * 128 + nblk0 + blk) * 64 + (col & 63)) * 32 + sc * 8) = o;
        }
      } else {
#pragma unroll
        for (int it = 0; it < 4; ++it) {
          const int item = tid + 256 * it, rr = item >> 4, cc = (item & 15) * 8;
          if (cc < 32) {
            const f4v a = *(const f4v*)(stage + rr * SST + cc), c = *(const f4v*)(stage + rr * SST + cc + 4);
            float* dst = (float*)(ws + OFF_KPE) + (size_t)(prow0 + rr) * 32 + cc;
            *(f4v*)dst = a; *(f4v*)(dst + 4) = c;
          }
        }
      }
    }
  }
}

DI void rope8(const float* x1, const float* x2, const float* rope, int spos, int j0, bool first, float scale, float (&o)[8]) {
  const f4v c0 = *(const f4v*)(rope + spos * 16 + j0), c1 = *(const f4v*)(rope + spos * 16 + j0 + 4);
  const f4v s0 = *(const f4v*)(rope + 65536 + spos * 16 + j0), s1 = *(const f4v*)(rope + 65536 + spos * 16 + j0 + 4);
  const float cs[8] = {c0.x, c0.y, c0.z, c0.w, c1.x, c1.y, c1.z, c1.w};
  const float sn[8] = {s0.x, s0.y, s0.z, s0.w, s1.x, s1.y, s1.z, s1.w};
#pragma unroll
  for (int i = 0; i < 8; ++i) o[i] = scale * (first ? (x1[i] * cs[i] - x2[i] * sn[i]) : (x1[i] * sn[i] + x2[i] * cs[i]));
}

DI void phase2(const Params& p, unsigned char* smem, u16* lds) {
  unsigned char* ws = p.ws;
  const int tid = VTID;
  float* stage = (float*)lds;
  const float* ssq_q = (const float*)(ws + OFF_SSQ);
  const float* ssq_kv = ssq_q + T;
  const float* rope = (const float*)(ws + OFF_ROPE);
  u16* Qo = (u16*)(ws + OFF_Q);
  u16* Ko = (u16*)(ws + OFF_K);
  u16* Vo = (u16*)(ws + OFF_VTT);
  {
    pg8::Gemm g{(const u16*)(ws + OFF_CQ), (const u16*)(ws + OFF_WUQ), T, 768, 768};
    pg8::StaticOrder S; S.init(T, 768, (int)gridDim.x, (int)blockIdx.x);
    EpiQ E{ssq_q, rope, Qo};
    pg8::gemm_phase<EpiQ, pg8::StaticOrder, false>((PG8_LAS unsigned char*)smem, g, S, E, nullptr);
  }
  constexpr int NQ = 0, NKV = 256 * 8, NH1 = 2048;
  for (int t = VBID; t < NQ + NKV + NH1; t += VBN) {
    if (t < NQ) {
      const int mt = t / 6, nt = t % 6;
      f32x16 acc[2][2];
      gemm_core((const u16*)(ws + OFF_CQ) + (size_t)mt * 128 * 768, 768, (const u16*)(ws + OFF_WUQ) + (size_t)nt * 128 * 768, 768, 768, lds, acc, tid);
      const int row0 = mt * 128, b = row0 >> 12, spos0 = row0 & 4095;
#pragma unroll 1
      for (int ps = 0; ps < 2; ++ps) {
        stage_pass(acc, stage, ps, tid);
#pragma unroll
        for (int it = 0; it < 4; ++it) {
          const int item = tid + 256 * it, rr = item >> 4, cc = (item & 15) * 8;
          const int grow = row0 + ps * 64 + rr, spos = spos0 + ps * 64 + rr;
          const float sc = rsqrtf(ssq_q[grow] * (1.f / 768.f) + EPS) * QSCALE;
          if (nt < 4) {
            f4v a = *(const f4v*)(stage + rr * SST + cc), c = *(const f4v*)(stage + rr * SST + cc + 4);
            a.x *= sc; a.y *= sc; a.z *= sc; a.w *= sc; c.x *= sc; c.y *= sc; c.z *= sc; c.w *= sc;
            const int head = nt * 2 + (cc >> 6), d = cc & 63;
            *(u4v*)(Qo + ((size_t)(b * 8 + head) * 4096 + spos) * 96 + d) = pk8(a, c);
          } else {
            const int head = (nt - 4) * 4 + (cc >> 5), wv = cc & 31, j0 = wv & 15, cb = cc - wv;
            float x1[8], x2[8], o[8];
#pragma unroll
            for (int i = 0; i < 8; ++i) { x1[i] = stage[rr * SST + cb + j0 + i]; x2[i] = stage[rr * SST + cb + 16 + j0 + i]; }
            rope8(x1, x2, rope, spos, j0, wv < 16, sc, o);
            u4v ov; ov.x = pk2(o[0], o[1]); ov.y = pk2(o[2], o[3]); ov.z = pk2(o[4], o[5]); ov.w = pk2(o[6], o[7]);
            *(u4v*)(Qo + ((size_t)(b * 8 + head) * 4096 + spos) * 96 + 64 + wv) = ov;
          }
        }
      }
    } else if (t < NQ + NKV) {
      const int tt = t - NQ;
      const int mt = tt >> 3, head = tt & 7;
      f32x16 acc[2][2];
      gemm_core((const u16*)(ws + OFF_CKV) + (size_t)mt * 128 * 256, 256, (const u16*)(ws + OFF_WUKV) + (size_t)head * 128 * 256, 256, 256, lds, acc, tid);
      const int row0 = mt * 128, b = row0 >> 12, spos0 = row0 & 4095;
      const int bh = b * 8 + head;
#pragma unroll 1
      for (int ps = 0; ps < 2; ++ps) {
        stage_pass(acc, stage, ps, tid);
        const int prow0 = row0 + ps * 64, pspos0 = spos0 + ps * 64;
#pragma unroll
        for (int it = 0; it < 2; ++it) {
          const int item = tid + 256 * it, rr = item >> 3, cc = (item & 7) * 8;
          const float sc = rsqrtf(ssq_kv[prow0 + rr] * (1.f / 256.f) + EPS);
          f4v a = *(const f4v*)(stage + rr * SST + cc), c = *(const f4v*)(stage + rr * SST + cc + 4);
          a.x *= sc; a.y *= sc; a.z *= sc; a.w *= sc; c.x *= sc; c.y *= sc; c.z *= sc; c.w *= sc;
          *(u4v*)(Ko + ((size_t)bh * 4096 + pspos0 + rr) * 96 + cc) = pk8(a, c);
        }
#pragma unroll
        for (int it = 0; it < 2; ++it) {
          const int item = tid + 256 * it, sc8 = item & 7, dv = item >> 3;
          const f4v q0 = *(const f4v*)(ssq_kv + prow0 + sc8 * 8), q1 = *(const f4v*)(ssq_kv + prow0 + sc8 * 8 + 4);
          const float qs[8] = {q0.x, q0.y, q0.z, q0.w, q1.x, q1.y, q1.z, q1.w};
          float v[8];
#pragma unroll
          for (int i = 0; i < 8; ++i) v[i] = stage[(sc8 * 8 + i) * SST + 64 + dv] * rsqrtf(qs[i] * (1.f / 256.f) + EPS);
          u4v o; o.x = pk2(v[0], v[1]); o.y = pk2(v[2], v[3]); o.z = pk2(v[4], v[5]); o.w = pk2(v[6], v[7]);
          *(u4v*)(Vo + ((size_t)bh * 64 + dv) * 4096 + pspos0 + sc8 * 8) = o;
        }
        {
          const int rr = tid >> 2, wv = (tid & 3) * 8, j0 = wv & 15;
          const float* kp = (const float*)(ws + OFF_KPE) + (size_t)(prow0 + rr) * 32;
          const f4v a0 = *(const f4v*)(kp + j0), a1 = *(const f4v*)(kp + j0 + 4);
          const f4v b0 = *(const f4v*)(kp + 16 + j0), b1 = *(const f4v*)(kp + 16 + j0 + 4);
          const float x1[8] = {a0.x, a0.y, a0.z, a0.w, a1.x, a1.y, a1.z, a1.w};
          const float x2[8] = {b0.x, b0.y, b0.z, b0.w, b1.x, b1.y, b1.z, b1.w};
          float o[8];
          rope8(x1, x2, rope, pspos0 + rr, j0, wv < 16, 1.f, o);
          u4v ov; ov.x = pk2(o[0], o[1]); ov.y = pk2(o[2], o[3]); ov.z = pk2(o[4], o[5]); ov.w = pk2(o[6], o[7]);
          *(u4v*)(Ko + ((size_t)bh * 4096 + pspos0 + rr) * 96 + 64 + wv) = ov;
        }
      }
    } else {
      const int idx = t - NQ - NKV;
      const int bh = idx >> 5, n = (idx & 31) * 4 + (tid >> 6);
      const int lane = tid & 63, r = lane & 31, h = lane >> 5;
      const u16* kt = (const u16*)(ws + OFF_KINVT) + ((size_t)bh * 128 + n) * 64 * 32;
      const u16* vt = (const u16*)(ws + OFF_VT) + ((size_t)bh * 128 + n) * 64 * 32;
      bf16x8 a[2][2], bb[2][2];
#pragma unroll
      for (int i = 0; i < 2; ++i)
#pragma unroll
        for (int ks = 0; ks < 2; ++ks) {
          a[i][ks] = *(const bf16x8*)(kt + (i * 32 + r) * 32 + ks * 16 + h * 8);
          bb[i][ks] = *(const bf16x8*)(vt + (i * 32 + r) * 32 + ks * 16 + h * 8);
        }
      u16* up = (u16*)(ws + OFF_UPD) + ((size_t)bh * 128 + n) * 4096;
#pragma unroll
      for (int kb = 0; kb < 2; ++kb)
#pragma unroll
        for (int vb = 0; vb < 2; ++vb) {
          f32x16 c = zero16();
          c = MFMA(a[kb][0], bb[vb][0], c);
          c = MFMA(a[kb][1], bb[vb][1], c);
#pragma unroll
          for (int g = 0; g < 4; ++g) {
            u2v o; o.x = pk2(c[4 * g], c[4 * g + 1]); o.y = pk2(c[4 * g + 2], c[4 * g + 3]);
            *(u2v*)(up + (vb * 32 + r) * 64 + kb * 32 + 8 * g + 4 * h) = o;
          }
        }
    }
  }
}

constexpr int KST = 104, VST = 72;
constexpr int ATT_BUF = 64 * KST + 64 * VST;

DI void attn_item(const Params& p, u16* lds, int bh, int qt) {
  unsigned char* ws = p.ws;
  const int tid = VTID, lane = tid & 63, w = tid >> 6, r = lane & 31, h = lane >> 5;
  const u16* Qp = (const u16*)(ws + OFF_Q) + (size_t)bh * 4096 * 96;
  const u16* Kp = (const u16*)(ws + OFF_K) + (size_t)bh * 4096 * 96;
  const u16* Vp = (const u16*)(ws + OFF_VTT) + (size_t)bh * 64 * 4096;
  const int q0 = qt * 128 + w * 32;
  bf16x8 qf[6];
#pragma unroll
  for (int ks = 0; ks < 6; ++ks) qf[ks] = *(const bf16x8*)(Qp + (size_t)(q0 + r) * 96 + ks * 16 + h * 8);
  f32x16 o[2]; o[0] = zero16(); o[1] = zero16();
  float m = -1e30f, l = 0.f;
  const int jmax = 2 * qt + 1, jw = 2 * qt + (w >> 1);
  int kr[3], kc[3];
#pragma unroll
  for (int i = 0; i < 3; ++i) { const int idx = tid + 256 * i; kr[i] = idx / 12; kc[i] = idx % 12; }
  const int vr0 = tid >> 3, vc = tid & 7;
  u4v rk[3], rv[2];
#pragma unroll
  for (int i = 0; i < 3; ++i) rk[i] = *(const u4v*)(Kp + (size_t)kr[i] * 96 + kc[i] * 8);
#pragma unroll
  for (int i = 0; i < 2; ++i) rv[i] = *(const u4v*)(Vp + (size_t)(vr0 + 32 * i) * 4096 + vc * 8);
  __syncthreads();
  {
#pragma unroll
    for (int i = 0; i < 3; ++i) *(u4v*)(lds + kr[i] * KST + kc[i] * 8) = rk[i];
#pragma unroll
    for (int i = 0; i < 2; ++i) *(u4v*)(lds + 64 * KST + (vr0 + 32 * i) * VST + vc * 8) = rv[i];
  }
  __syncthreads();
  for (int j = 0; j <= jmax; ++j) {
    const int cur = j & 1;
    if (j < jmax) {
#pragma unroll
      for (int i = 0; i < 3; ++i) rk[i] = *(const u4v*)(Kp + (size_t)((j + 1) * 64 + kr[i]) * 96 + kc[i] * 8);
#pragma unroll
      for (int i = 0; i < 2; ++i) rv[i] = *(const u4v*)(Vp + (size_t)(vr0 + 32 * i) * 4096 + (j + 1) * 64 + vc * 8);
    }
    if (j <= jw) {
      const u16* sk = lds + cur * ATT_BUF + r * KST + h * 8;
      const u16* sv = lds + cur * ATT_BUF + 64 * KST + r * VST + 4 * h;
      f32x16 st[2]; st[0] = zero16(); st[1] = zero16();
#pragma unroll
      for (int kb = 0; kb < 2; ++kb)
#pragma unroll
        for (int ks = 0; ks < 6; ++ks) {
          const bf16x8 kf = *(const bf16x8*)(sk + kb * 32 * KST + ks * 16);
          st[kb] = MFMA(kf, qf[ks], st[kb]);
        }
      float mx = st[0][0];
#pragma unroll
      for (int i = 1; i < 16; ++i) mx = fmaxf(mx, st[0][i]);
#pragma unroll
      for (int i = 0; i < 16; ++i) mx = fmaxf(mx, st[1][i]);
      mx = fmaxf(mx, __shfl_xor(mx, 32));
      const float mn = fmaxf(m, mx);
      const float alpha = __builtin_amdgcn_exp2f(m - mn);
      m = mn;
      float psum = 0.f;
#pragma unroll
      for (int kb = 0; kb < 2; ++kb)
#pragma unroll
        for (int i = 0; i < 16; ++i) { const float pv = __builtin_amdgcn_exp2f(st[kb][i] - mn); st[kb][i] = pv; psum += pv; }
      l = l * alpha + psum;
#pragma unroll
      for (int i = 0; i < 16; ++i) { o[0][i] *= alpha; o[1][i] *= alpha; }
#pragma unroll
      for (int s4 = 0; s4 < 4; ++s4) {
        const int kb = s4 >> 1, rb = 8 * (s4 & 1);
        u4v pu; pu.x = pk2(st[kb][rb], st[kb][rb + 1]); pu.y = pk2(st[kb][rb + 2], st[kb][rb + 3]);
        pu.z = pk2(st[kb][rb + 4], st[kb][rb + 5]); pu.w = pk2(st[kb][rb + 6], st[kb][rb + 7]);
        const bf16x8 pb = __builtin_bit_cast(bf16x8, pu);
#pragma unroll
        for (int db = 0; db < 2; ++db) {
          const s16x4 lo = *(const s16x4*)(sv + db * 32 * VST + 16 * s4);
          const s16x4 hi = *(const s16x4*)(sv + db * 32 * VST + 16 * s4 + 8);
          const bf16x8 vf = __builtin_shufflevector(lo, hi, 0, 1, 2, 3, 4, 5, 6, 7);
          o[db] = MFMA(vf, pb, o[db]);
        }
      }
    }
    if (j < jmax) {
      u16* d = lds + (cur ^ 1) * ATT_BUF;
#pragma unroll
      for (int i = 0; i < 3; ++i) *(u4v*)(d + kr[i] * KST + kc[i] * 8) = rk[i];
#pragma unroll
      for (int i = 0; i < 2; ++i) *(u4v*)(d + 64 * KST + (vr0 + 32 * i) * VST + vc * 8) = rv[i];
    }
    __syncthreads();
  }
  l += __shfl_xor(l, 32);
  const float inv = 1.f / l;
  const int b = bh >> 3, head = bh & 7;
  const size_t tok = (size_t)b * 4096 + q0 + r;
  const u16* sga = (const u16*)(ws + OFF_SGA) + tok * 512 + head * 64;
  u16* ya = (u16*)(ws + OFF_YA) + tok * 512 + head * 64;
#pragma unroll
  for (int db = 0; db < 2; ++db)
#pragma unroll
    for (int g = 0; g < 4; ++g) {
      const int dv0 = db * 32 + 8 * g + 4 * h;
      const u2v gt = *(const u2v*)(sga + dv0);
      u2v ov;
      ov.x = pk2(o[db][4 * g] * inv * bflo(gt.x), o[db][4 * g + 1] * inv * bfhi(gt.x));
      ov.y = pk2(o[db][4 * g + 2] * inv * bflo(gt.y), o[db][4 * g + 3] * inv * bfhi(gt.y));
      *(u2v*)(ya + dv0) = ov;
    }
}

DI void scan_item(const Params& p, int i) {
  unsigned char* ws = p.ws;
  const int tid = VTID;
  const int bh = i >> 3, part = i & 7;
  const int e = part * 512 + tid * 2, k = e & 63;
  u32* U = (u32*)((u16*)(ws + OFF_UPD) + (size_t)bh * 128 * 4096 + e);
  const f2v* Dc = (const f2v*)((const float*)(ws + OFF_DECAY) + (size_t)bh * 128 * 64 + k);
  float s0 = 0.f, s1 = 0.f;
  for (int n0 = 0; n0 < 128; n0 += 8) {
    u32 u[8]; f2v d[8];
#pragma unroll
    for (int q = 0; q < 8; ++q) { u[q] = U[(size_t)(n0 + q) * 2048]; d[q] = Dc[(n0 + q) * 32]; }
#pragma unroll
    for (int q = 0; q < 8; ++q) {
      U[(size_t)(n0 + q) * 2048] = pk2(s0, s1);
      s0 = d[q].x * (s0 + bflo(u[q]));
      s1 = d[q].y * (s1 + bfhi(u[q]));
    }
  }
}

DI void phase3(const Params& p, u16* lds, bool dup = false) {
  int* s_item = (int*)((unsigned char*)lds - (threadIdx.x >> 8) * VLDS + LDS_BYTES - 64);
  int* ctr = (int*)(p.ws + OFF_SSQ + (size_t)3 * T * 4) + (dup ? 1 : 0);
  constexpr int NSCAN = 512, NATT = 2048;
  for (;;) {
    __syncthreads();
    if (threadIdx.x == 0) *s_item = atomicAdd(ctr, 2);
    __syncthreads();
    const int item = *s_item + (int)(threadIdx.x >> 8);
    if (item >= NSCAN + NATT) break;
    if (item < NSCAN) { if (!dup) scan_item(p, item); }
    else { const int idx = item - NSCAN; attn_item(p, lds, idx & 63, 31 - (idx >> 6)); }
  }
}

DI void phase4(const Params& p) {
  unsigned char* ws = p.ws;
  const int tid = VTID, lane = tid & 63, w = tid >> 6, r = lane & 31, h = lane >> 5;
  for (int t = VBID; t < 2048; t += VBN) {
    const int bh = t >> 5, n = (t & 31) * 4 + w;
    const int b = bh >> 3, head = bh & 7;
    const size_t tok0 = (size_t)b * 4096 + n * 32;
    const u16* qd = (const u16*)(ws + OFF_QDEC) + (tok0 + r) * 512 + head * 64 + h * 8;
    const u16* ki = (const u16*)(ws + OFF_KINV) + (tok0 + r) * 512 + head * 64 + h * 8;
    const u16* vt = (const u16*)(ws + OFF_VT) + ((size_t)bh * 128 + n) * 64 * 32;
    const u16* sp = (const u16*)(ws + OFF_UPD) + ((size_t)bh * 128 + n) * 4096;
    bf16x8 qf[4], kf[4];
#pragma unroll
    for (int ks = 0; ks < 4; ++ks) { qf[ks] = *(const bf16x8*)(qd + ks * 16); kf[ks] = *(const bf16x8*)(ki + ks * 16); }
    f32x16 at = zero16();
#pragma unroll
    for (int ks = 0; ks < 4; ++ks) at = MFMA(kf[ks], qf[ks], at);
#pragma unroll
    for (int i = 0; i < 16; ++i) if (crow(i, h) > r) at[i] = 0.f;
    f32x16 o[2]; o[0] = zero16(); o[1] = zero16();
#pragma unroll
    for (int s2 = 0; s2 < 2; ++s2) {
      u4v pu; pu.x = pk2(at[8 * s2], at[8 * s2 + 1]); pu.y = pk2(at[8 * s2 + 2], at[8 * s2 + 3]);
      pu.z = pk2(at[8 * s2 + 4], at[8 * s2 + 5]); pu.w = pk2(at[8 * s2 + 6], at[8 * s2 + 7]);
      const bf16x8 pb = __builtin_bit_cast(bf16x8, pu);
#pragma unroll
      for (int vb = 0; vb < 2; ++vb) {
        const s16x4 lo = *(const s16x4*)(vt + (vb * 32 + r) * 32 + 16 * s2 + 4 * h);
        const s16x4 hi = *(const s16x4*)(vt + (vb * 32 + r) * 32 + 16 * s2 + 8 + 4 * h);
        const bf16x8 vf = __builtin_shufflevector(lo, hi, 0, 1, 2, 3, 4, 5, 6, 7);
        o[vb] = MFMA(vf, pb, o[vb]);
      }
    }
#pragma unroll
    for (int vb = 0; vb < 2; ++vb)
#pragma unroll
      for (int ks = 0; ks < 4; ++ks) {
        const bf16x8 sf = *(const bf16x8*)(sp + (vb * 32 + r) * 64 + ks * 16 + h * 8);
        o[vb] = MFMA(sf, qf[ks], o[vb]);
      }
    float ss = 0.f;
#pragma unroll
    for (int i = 0; i < 16; ++i) ss += o[0][i] * o[0][i] + o[1][i] * o[1][i];
    ss += __shfl_xor(ss, 32);
    const float rs = rsqrtf(ss * (1.f / 64.f) + EPS);
    const u16* sgb = (const u16*)(ws + OFF_SGB) + (tok0 + r) * 512 + head * 64;
    u16* yb = (u16*)(ws + OFF_YB) + (tok0 + r) * 512 + head * 64;
#pragma unroll
    for (int vb = 0; vb < 2; ++vb)
#pragma unroll
      for (int g = 0; g < 4; ++g) {
        const int v0 = vb * 32 + 8 * g + 4 * h;
        const u2v gt = *(const u2v*)(sgb + v0);
        u2v ov;
        ov.x = pk2(o[vb][4 * g] * rs * bflo(gt.x), o[vb][4 * g + 1] * rs * bfhi(gt.x));
        ov.y = pk2(o[vb][4 * g + 2] * rs * bflo(gt.y), o[vb][4 * g + 3] * rs * bfhi(gt.y));
        *(u2v*)(yb + v0) = ov;
      }
  }
}

DI void phase5(const Params& p, unsigned char* smem) {
  unsigned char* ws = p.ws;
  pg8::StaticOrder S; S.init(T, 1024, (int)gridDim.x, (int)blockIdx.x);
  {
    pg8::Gemm g{(const u16*)(ws + OFF_YA), (const u16*)(ws + OFF_WA), T, 1024, 512};
    Epi5<false> E{(const u16*)p.out, (u16*)(ws + OFF_M)};
    pg8::gemm_phase<Epi5<false>, pg8::StaticOrder, false>((PG8_LAS unsigned char*)smem, g, S, E, nullptr);
  }
  {
    pg8::Gemm g{(const u16*)(ws + OFF_YB), (const u16*)(ws + OFF_WB), T, 1024, 512};
    Epi5<true> E{(const u16*)p.out, (u16*)(ws + OFF_M)};
    pg8::gemm_phase<Epi5<true>, pg8::StaticOrder, false>((PG8_LAS unsigned char*)smem, g, S, E, nullptr);
  }
}

DI void phase6(const Params& p, unsigned char* smem, bool dup = false) {
  unsigned char* ws = p.ws;
  pg8::Gemm g{(const u16*)(ws + OFF_M), (const u16*)(ws + OFF_WO), T, 1024, 1024};
  pg8::StaticOrder S; S.init(T, 1024, (int)gridDim.x, (int)blockIdx.x);
  Epi6 E{p.out, (float*)(ws + OFF_SSQ) + 2 * T, dup};
  pg8::gemm_phase<Epi6, pg8::StaticOrder, false>((PG8_LAS unsigned char*)smem, g, S, E, nullptr);
}

DI void phase7(const Params& p) {
  const float* ssq_y = (const float*)(p.ws + OFF_SSQ) + 2 * T;
  const int gtid = blockIdx.x * blockDim.x + threadIdx.x, gthreads = gridDim.x * blockDim.x;
  for (int i = gtid; i < T * 256; i += gthreads) {
    const int row = i >> 8, c4 = i & 255;
    const float rs = rsqrtf(ssq_y[row] * (1.f / 1024.f) + EPS);
    const f4v y = ((const f4v*)p.out)[i];
    const f4v xv = ((const f4v*)p.x)[i];
    const f4v g = ((const f4v*)p.g_post)[c4];
    f4v o;
    o.x = xv.x + y.x * rs * g.x; o.y = xv.y + y.y * rs * g.y; o.z = xv.z + y.z * rs * g.z; o.w = xv.w + y.w * rs * g.w;
    ((f4v*)p.out)[i] = o;
  }
}

__global__ void __launch_bounds__(512, 2) fwd_megakernel(Params p) {
  extern __shared__ __attribute__((aligned(16))) unsigned char smem[];
  u16* lds = (u16*)(smem + (threadIdx.x >> 8) * VLDS);
  cg::grid_group grid = cg::this_grid();
  volatile LAS unsigned* xst = (volatile LAS unsigned*)(smem + LDS_BYTES - 48);
  if (threadIdx.x == 0) { xst[0] = 0u; xst[1] = 0u; }
  __syncthreads();
  XcdBarrier xb = xcd_barrier_post((unsigned*)(p.ws + OFF_BAR), xst);
  if (p.ph_hi > 1000) grid.sync();
#define RUN_PHASE(N, CALL) if (p.ph_lo <= N && N < p.ph_hi) { if (N > p.ph_lo) xcd_barrier(xb); CALL; }
#define DUP_PHASE(N, CALL) if (DUP_PH == N) { xcd_barrier(xb); CALL; }
  RUN_PHASE(0, phase0(p))
  DUP_PHASE(0, phase0(p))
  RUN_PHASE(1, phase1(p, smem, lds))
  DUP_PHASE(1, phase1(p, smem, lds, true))
  RUN_PHASE(2, phase2(p, smem, lds))
  DUP_PHASE(2, phase2(p, smem, lds))
  RUN_PHASE(3, phase3(p, lds))
  DUP_PHASE(3, phase3(p, lds, true))
  RUN_PHASE(4, phase4(p))
  DUP_PHASE(4, phase4(p))
  RUN_PHASE(5, phase5(p, smem))
  DUP_PHASE(5, phase5(p, smem))
  RUN_PHASE(6, phase6(p, smem))
  DUP_PHASE(6, phase6(p, smem, true))
  RUN_PHASE(7, phase7(p))
}

extern "C" void kernel_launch(void* const* d_in, const int* in_sizes, int n_in, void* d_out, int out_size, void* d_ws, size_t ws_size,
                              hipStream_t stream) {
  static int grid_blocks = 0;
  if (!grid_blocks) {
    int dev = 0, cus = 0, per_cu = 0;
    hipGetDevice(&dev);
    hipDeviceGetAttribute(&cus, hipDeviceAttributeMultiprocessorCount, dev);
    hipFuncSetAttribute((const void*)fwd_megakernel, hipFuncAttributeMaxDynamicSharedMemorySize, LDS_BYTES);
    hipOccupancyMaxActiveBlocksPerMultiprocessor(&per_cu, (const void*)fwd_megakernel, 512, LDS_BYTES);
    if (per_cu < 1) per_cu = 1;
    if (per_cu > 1) per_cu = 1;
    grid_blocks = cus * per_cu;
    if (ws_size < WS_NEED) fprintf(stderr, "kernel_launch: workspace too small: %zu < %zu\n", ws_size, (size_t)WS_NEED);
  }
  if (ws_size < WS_NEED) return;
  Params p{};
  p.x = (const float*)d_in[0]; p.g_pre = (const float*)d_in[1]; p.w_in = (const float*)d_in[2]; p.b_gate = (const float*)d_in[3];
  p.g_q = (const float*)d_in[4]; p.w_uq = (const float*)d_in[5]; p.g_kv = (const float*)d_in[6]; p.w_ukv = (const float*)d_in[7];
  p.lb_logits = (const float*)d_in[8]; p.g_hgrn = (const float*)d_in[9]; p.w_a = (const float*)d_in[10]; p.w_b = (const float*)d_in[11];
  p.w_out = (const float*)d_in[12]; p.g_post = (const float*)d_in[13];
  p.out = (float*)d_out; p.ws = (unsigned char*)d_ws;
#if ONE_LAUNCH
  p.ph_lo = 0; p.ph_hi = 8;
  (void)hipMemsetAsync((unsigned char*)d_ws + OFF_BAR, 0, 16384, stream);
  void* args[] = {&p};
  hipError_t e = hipLaunchCooperativeKernel((const void*)fwd_megakernel, dim3(grid_blocks), dim3(512), args, LDS_BYTES, stream);
  if (e != hipSuccess) fprintf(stderr, "cooperative launch failed: %s (grid %d)\n", hipGetErrorString(e), grid_blocks);
#else
  for (int ph = 0; ph < 8; ++ph) {
    p.ph_lo = ph; p.ph_hi = ph + 1;
    (void)hipMemsetAsync((unsigned char*)d_ws + OFF_BAR, 0, 16384, stream);
    void* args[] = {&p};
    hipError_t e = hipLaunchCooperativeKernel((const void*)fwd_megakernel, dim3(grid_blocks), dim3(512), args, LDS_BYTES, stream);
    if (e != hipSuccess) fprintf(stderr, "cooperative launch failed: %s (grid %d)\n", hipGetErrorString(e), grid_blocks);
  }
#endif
}
```

```cpp
#include <hip/hip_runtime.h>
#include <hip/hip_cooperative_groups.h>
#include <cstdio>
namespace cg = cooperative_groups;

#define DI __device__ __forceinline__
#define VTID ((int)(threadIdx.x & 255))
#define VBID ((int)(blockIdx.x * 2 + (threadIdx.x >> 8)))
#define VBN ((int)(gridDim.x * 2))
typedef unsigned short u16;
typedef unsigned int u32;
typedef __attribute__((ext_vector_type(8))) short bf16x8;
typedef __attribute__((ext_vector_type(4))) short s16x4;
typedef __attribute__((ext_vector_type(16))) float f32x16;
typedef __attribute__((ext_vector_type(2))) __bf16 bf2_t;
typedef __attribute__((ext_vector_type(2))) float f2_t;
typedef __attribute__((ext_vector_type(4))) unsigned int u4v;
typedef __attribute__((ext_vector_type(2))) unsigned int u2v;
typedef __attribute__((ext_vector_type(4))) float f4v;
typedef __attribute__((ext_vector_type(2))) float f2v;
#define MFMA(a, b, c) __builtin_amdgcn_mfma_f32_32x32x16_bf16((a), (b), (c), 0, 0, 0)

#ifndef DUP_PH
#define DUP_PH -1
#endif
#ifndef ONE_LAUNCH
#define ONE_LAUNCH 1
#endif

constexpr int T = 32768;
constexpr int SEQ = 4096;
constexpr int DIN = 5664;
constexpr int NP = 5888;
constexpr float EPS = 1e-6f;
constexpr float QSCALE = 1.4426950408889634f * 0.10206207261596575f;

constexpr size_t SZ_WIN = (size_t)NP * 1024 * 2;
constexpr size_t OFF_WIN = 0;
constexpr size_t OFF_WUQ = OFF_WIN + SZ_WIN;
constexpr size_t OFF_WUKV = OFF_WUQ + (size_t)768 * 768 * 2;
constexpr size_t OFF_WA = OFF_WUKV + (size_t)1024 * 256 * 2;
constexpr size_t OFF_WB = OFF_WA + (size_t)1024 * 512 * 2;
constexpr size_t OFF_WO = OFF_WB + (size_t)1024 * 512 * 2;
constexpr size_t OFF_ROPE = OFF_WO + (size_t)1024 * 1024 * 2;
constexpr size_t OFF_SSQ = OFF_ROPE + (size_t)4096 * 16 * 2 * 4;
constexpr size_t OFF_DECAY = OFF_SSQ + (size_t)(3 * T + 64) * 4;
constexpr size_t OFF_H = OFF_DECAY + (size_t)64 * 128 * 64 * 4;
constexpr size_t OFF_Q = OFF_H;
constexpr size_t OFF_CQ = OFF_H + (size_t)T * 1024 * 2;
constexpr size_t OFF_YA = OFF_CQ;
constexpr size_t OFF_CKV = OFF_CQ + (size_t)T * 768 * 2;
constexpr size_t OFF_KPE = OFF_CKV + (size_t)T * 256 * 2;
constexpr size_t OFF_SGA = OFF_KPE + (size_t)T * 32 * 4;
constexpr size_t OFF_SGB = OFF_SGA + (size_t)T * 512 * 2;
constexpr size_t OFF_HQ = OFF_SGB + (size_t)T * 512 * 2;
constexpr size_t OFF_UPD = OFF_HQ;
constexpr size_t OFF_HF = OFF_HQ + (size_t)T * 512 * 2;
constexpr size_t OFF_HI = OFF_HF + (size_t)T * 512 * 2;
constexpr size_t OFF_YB = OFF_HI;
constexpr size_t OFF_QDEC = OFF_HI + (size_t)T * 512 * 2;
constexpr size_t OFF_KINV = OFF_QDEC + (size_t)T * 512 * 2;
constexpr size_t OFF_VT = OFF_KINV + (size_t)T * 512 * 2;
constexpr size_t OFF_K = OFF_VT + (size_t)T * 512 * 2;
constexpr size_t OFF_M = OFF_K;
constexpr size_t OFF_VTT = OFF_K + (size_t)T * 768 * 2;
constexpr size_t OFF_BAR = OFF_VTT + (size_t)T * 512 * 2;
constexpr size_t WS_NEED = OFF_BAR + 16384;

constexpr int VLDS = 2 * 2 * 128 * 72 * 2;
constexpr int LDS_BYTES = 2 * VLDS + 64;
constexpr int SST = 132;

struct Params {
  const float *x, *g_pre, *w_in, *b_gate, *g_q, *w_uq, *g_kv, *w_ukv, *lb_logits, *g_hgrn, *w_a, *w_b, *w_out, *g_post;
  float* out;
  unsigned char* ws;
  int ph_lo, ph_hi;
};

DI u32 pk2(float a, float b) { f2_t v = {a, b}; bf2_t r = __builtin_convertvector(v, bf2_t); return __builtin_bit_cast(u32, r); }
DI float bflo(u32 u) { return __uint_as_float(u << 16); }
DI float bfhi(u32 u) { return __uint_as_float(u & 0xffff0000u); }
DI u4v pk8(f4v a, f4v b) { u4v r; r.x = pk2(a.x, a.y); r.y = pk2(a.z, a.w); r.z = pk2(b.x, b.y); r.w = pk2(b.z, b.w); return r; }
DI float rcpf(float x) { return __builtin_amdgcn_rcpf(x); }
DI float sigmoidf_(float x) { return rcpf(1.f + __expf(-x)); }
DI float siluf_(float x) { return x * sigmoidf_(x); }
DI int crow(int reg, int h) { return (reg & 3) + 8 * (reg >> 2) + 4 * h; }
DI f32x16 zero16() { f32x16 z;
#pragma unroll
  for (int i = 0; i < 16; ++i) z[i] = 0.f; return z; }

__constant__ float c_invfreq[16] = {1.0f, 0.5623413324356079f, 0.3162277638912201f, 0.17782793939113617f, 0.10000000149011612f,
  0.05623413249850273f, 0.03162277489900589f, 0.017782794311642647f, 0.009999999776482582f, 0.005623413249850273f,
  0.003162277629598975f, 0.0017782794311642647f, 0.0010000000474974513f, 0.000562341301701963f, 0.0003162277571391314f,
  0.00017782794020604342f};

DI void sincos_d(double a, float& sn, float& cs) {
  const double k = rint(a * 0.63661977236758134308);
  const double y = a - k * 1.57079632679489661923;
  const double y2 = y * y;
  const double s = y * (1.0 + y2 * (-1.0 / 6 + y2 * (1.0 / 120 + y2 * (-1.0 / 5040 + y2 * (1.0 / 362880 + y2 * (-1.0 / 39916800 + y2 * (1.0 / 6227020800.0)))))));
  const double c = 1.0 + y2 * (-0.5 + y2 * (1.0 / 24 + y2 * (-1.0 / 720 + y2 * (1.0 / 40320 + y2 * (-1.0 / 3628800 + y2 * (1.0 / 479001600.0 + y2 * (-1.0 / 87178291200.0)))))));
  const int q = ((int)k) & 3;
  const double ss = (q == 0) ? s : (q == 1) ? c : (q == 2) ? -s : -c;
  const double cc = (q == 0) ? c : (q == 1) ? -s : (q == 2) ? -c : s;
  sn = (float)ss; cs = (float)cc;
}

#define XB_TMO      128
#define XB_XCNT(j)  (256  + 64 * (j))
#define XB_XSUB(j)  (1280 + 64 * (j))
#define XB_XGEN(j)  (2304 + 64 * (j))
#define XB_TOP      3328
#define XB_TOPGEN   3392
#define XCD_BAR_WORDS 3456
#define XB_SPIN_CAP (1u << 22)
#define LAS __attribute__((address_space(3)))
DI unsigned xb_ld(unsigned* p)              { return __hip_atomic_load(p, __ATOMIC_RELAXED, __HIP_MEMORY_SCOPE_AGENT); }
DI unsigned xb_add(unsigned* p, unsigned v) { return __hip_atomic_fetch_add(p, v, __ATOMIC_RELAXED, __HIP_MEMORY_SCOPE_AGENT); }
DI unsigned xb_xcc_id() { return (unsigned)__builtin_amdgcn_s_getreg((3 << 11) | 20) & 0xFu; }
#define XB_SPIN(cond, bar) do { unsigned _sp = 0; while (cond) { __builtin_amdgcn_s_sleep(1); \
    if ((++_sp & 255u) == 0u) { if (xb_ld(&(bar)[XB_TMO])) break; if (_sp > XB_SPIN_CAP) { atomicAdd(&(bar)[XB_TMO], 1u); break; } } } } while (0)
struct XcdBarrier { unsigned* bar; unsigned x; volatile LAS unsigned* st; };
DI XcdBarrier xcd_barrier_post(unsigned* bar, volatile LAS unsigned* st) {
  XcdBarrier b; b.bar = bar; b.x = xb_xcc_id(); b.st = st;
  if (threadIdx.x == 0) (void)xb_add(&bar[XB_XCNT(b.x)], 1u);
  return b;
}
DI void xcd_barrier_complete(unsigned* bar, unsigned x, unsigned& nloc, unsigned& nx) {
  const unsigned G = gridDim.x * gridDim.y * gridDim.z;
  unsigned sum, cnt, mine, sp = 0u;
  for (;;) {
    sum = 0u; cnt = 0u; mine = 0u;
#pragma unroll
    for (unsigned j = 0; j < 16; ++j) { const unsigned c = xb_ld(&bar[XB_XCNT(j)]); sum += c; cnt += (c > 0u) ? 1u : 0u; mine = (j == x) ? c : mine; }
    if (sum == G) break;
    __builtin_amdgcn_s_sleep(1);
    if ((++sp & 255u) == 0u) { if (xb_ld(&bar[XB_TMO])) break; if (sp > XB_SPIN_CAP) { atomicAdd(&bar[XB_TMO], 1u); break; } }
  }
  nloc = mine > 0u ? mine : 1u; nx = cnt > 0u ? cnt : 1u;
}
DI void xcd_barrier(const XcdBarrier& b) {
  asm volatile("s_waitcnt vmcnt(0)" ::: "memory");
  __syncthreads();
  if (threadIdx.x == 0) {
    unsigned* bar = b.bar;
    __builtin_amdgcn_s_waitcnt(0);
    unsigned nloc = b.st[0], nx = b.st[1];
    if (nloc == 0u) { xcd_barrier_complete(bar, b.x, nloc, nx); b.st[0] = nloc; b.st[1] = nx; }
    const unsigned old = xb_add(&bar[XB_XSUB(b.x)], 1u);
    const unsigned gen = old / nloc;
    if (old + 1u == (gen + 1u) * nloc) {
      __builtin_amdgcn_fence(__ATOMIC_RELEASE, "agent");
      asm volatile("s_waitcnt vmcnt(0)" ::: "memory");
      const unsigned og = xb_add(&bar[XB_TOP], 1u);
      const unsigned tg = og / nx;
      if (og + 1u == (tg + 1u) * nx) xb_add(&bar[XB_TOPGEN], 1u);
      else XB_SPIN(xb_ld(&bar[XB_TOPGEN]) == tg, bar);
      __builtin_amdgcn_fence(__ATOMIC_ACQUIRE, "agent");
      xb_add(&bar[XB_XGEN(b.x)], 1u);
      asm volatile("s_waitcnt vmcnt(0)" ::: "memory");
    } else {
      XB_SPIN(xb_ld(&bar[XB_XGEN(b.x)]) == gen, bar);
      __builtin_amdgcn_fence(__ATOMIC_ACQUIRE, "agent");
      asm volatile("s_waitcnt vmcnt(0)" ::: "memory");
    }
  }
  __syncthreads();
}

template <int KIND>
DI int colmap(int n) {
  if (KIND == 0) {
    if (n < 1024) return n;
    if (n < 1536) return 1056 + (n - 1024);
    if (n < 2048) return 3104 + (n - 1536);
    if (n < 4096) return 3616 + (n - 2048);
    if (n < 4608) return 1568 + (n - 4096);
    if (n < 5120) return 2080 + (n - 4608);
    if (n < 5632) return 2592 + (n - 5120);
    if (n < 5664) return 1024 + (n - 5632);
    return -1;
  } else if (KIND == 1) {
    if (n < 512) return (n >> 6) * 96 + (n & 63);
    int i = n - 512; int w = i & 31, g = w >> 3, e = w & 7; return (i >> 5) * 96 + 64 + ((e < 4) ? (4 * g + e) : (16 + 4 * g + (e - 4)));
  } else if (KIND == 3) {
    if (n < 512) return (n >> 6) * 128 + (n & 63);
    int i = n - 512; return (i >> 6) * 128 + 64 + (i & 63);
  } else return n;
}
template <int KIND>
DI void conv_weight(u16* dst, const float* src, int ldw, int ncount, int K, const float* gain, int gmask, int gtid, int gthreads) {
  const int total = ncount * (K >> 3);
  for (int it = gtid; it < total; it += gthreads) {
    const int n = it % ncount, kc = it / ncount;
    const int sc = colmap<KIND>(n);
    float v[8];
#pragma unroll
    for (int i = 0; i < 8; ++i) {
      const int k = kc * 8 + i;
      float x = (sc >= 0) ? src[(size_t)k * ldw + sc] : 0.f;
      if (gain) x *= gain[k & gmask];
      v[i] = x;
    }
    u4v o; o.x = pk2(v[0], v[1]); o.y = pk2(v[2], v[3]); o.z = pk2(v[4], v[5]); o.w = pk2(v[6], v[7]);
    *(u4v*)(dst + (size_t)n * K + kc * 8) = o;
  }
}

DI void phase0(const Params& p) {
  unsigned char* ws = p.ws;
  const int gtid = blockIdx.x * blockDim.x + threadIdx.x, gthreads = gridDim.x * blockDim.x;
  float* ssq = (float*)(ws + OFF_SSQ);
  for (int i = gtid; i < 3 * T + 64; i += gthreads) ssq[i] = 0.f;
  float* rope = (float*)(ws + OFF_ROPE);
  for (int i = gtid; i < 4096 * 16; i += gthreads) {
    const int pos = i >> 4, j = i & 15;
    const float ang = (float)pos * c_invfreq[j];
    float sn, cs; sincos_d((double)ang, sn, cs);
    rope[i] = cs; rope[65536 + i] = sn;
  }
  conv_weight<0>((u16*)(ws + OFF_WIN), p.w_in, DIN, NP, 1024, nullptr, 0, gtid, gthreads);
  conv_weight<1>((u16*)(ws + OFF_WUQ), p.w_uq, 768, 768, 768, p.g_q, 1023, gtid, gthreads);
  conv_weight<3>((u16*)(ws + OFF_WUKV), p.w_ukv, 1024, 1024, 256, p.g_kv, 255, gtid, gthreads);
  conv_weight<2>((u16*)(ws + OFF_WA), p.w_a, 1024, 1024, 512, nullptr, 0, gtid, gthreads);
  conv_weight<2>((u16*)(ws + OFF_WB), p.w_b, 1024, 1024, 512, p.g_hgrn, 63, gtid, gthreads);
  conv_weight<2>((u16*)(ws + OFF_WO), p.w_out, 1024, 1024, 1024, nullptr, 0, gtid, gthreads);
  u16* H = (u16*)(ws + OFF_H);
  const int lane = threadIdx.x & 63;
  const int gw = gtid >> 6, nw = gthreads >> 6;
  for (int row = gw; row < T; row += nw) {
    const f4v* xr = (const f4v*)(p.x + (size_t)row * 1024);
    f4v v[4];
    float ss = 0.f;
#pragma unroll
    for (int i = 0; i < 4; ++i) { v[i] = xr[lane * 4 + i]; ss += v[i].x * v[i].x + v[i].y * v[i].y + v[i].z * v[i].z + v[i].w * v[i].w; }
#pragma unroll
    for (int o = 32; o >= 1; o >>= 1) ss += __shfl_xor(ss, o);
    const float rs = rsqrtf(ss * (1.f / 1024.f) + EPS);
    const f4v* gp = (const f4v*)(p.g_pre);
    f4v g[4];
#pragma unroll
    for (int i = 0; i < 4; ++i) { g[i] = gp[lane * 4 + i]; v[i].x *= rs * g[i].x; v[i].y *= rs * g[i].y; v[i].z *= rs * g[i].z; v[i].w *= rs * g[i].w; }
    u4v* hr = (u4v*)(H + (size_t)row * 1024 + lane * 16);
    hr[0] = pk8(v[0], v[1]); hr[1] = pk8(v[2], v[3]);
  }
}

constexpr int TS = 128 * 72;
DI void gemm_ld(u4v (&ra)[4], u4v (&rb)[4], const u16* ga, const u16* gb, int lda, int ldb, int ko) {
#pragma unroll
  for (int i = 0; i < 4; ++i) { ra[i] = *(const u4v*)(ga + (size_t)(32 * i) * lda + ko); rb[i] = *(const u4v*)(gb + (size_t)(32 * i) * ldb + ko); }
}
DI void gemm_st(const u4v (&ra)[4], const u4v (&rb)[4], u16* buf, int lr, int lc) {
  u16* sa = buf; u16* sb = buf + TS;
#pragma unroll
  for (int i = 0; i < 4; ++i) { *(u4v*)(sa + (lr + 32 * i) * 72 + lc * 8) = ra[i]; *(u4v*)(sb + (lr + 32 * i) * 72 + lc * 8) = rb[i]; }
}
DI void gemm_mma(const u16* buf, f32x16 (&acc)[2][2], int wm, int wn, int r, int h) {
  const u16* sa = buf + (wm * 64 + r) * 72 + h * 8;
  const u16* sb = buf + TS + (wn * 64 + r) * 72 + h * 8;
#pragma unroll
  for (int ks = 0; ks < 4; ++ks) {
    const bf16x8 a0 = *(const bf16x8*)(sa + ks * 16);
    const bf16x8 a1 = *(const bf16x8*)(sa + 32 * 72 + ks * 16);
    const bf16x8 b0 = *(const bf16x8*)(sb + ks * 16);
    const bf16x8 b1 = *(const bf16x8*)(sb + 32 * 72 + ks * 16);
    acc[0][0] = MFMA(a0, b0, acc[0][0]);
    acc[0][1] = MFMA(a0, b1, acc[0][1]);
    acc[1][0] = MFMA(a1, b0, acc[1][0]);
    acc[1][1] = MFMA(a1, b1, acc[1][1]);
  }
}
DI void gemm_core(const u16* __restrict__ A, int lda, const u16* __restrict__ B, int ldb, int K, u16* lds, f32x16 (&acc)[2][2], int tid) {
  const int lane = tid & 63, w = tid >> 6, wm = w >> 1, wn = w & 1, r = lane & 31, h = lane >> 5;
  const int lc = tid & 7, lr = tid >> 3;
  const u16* ga = A + (size_t)lr * lda + lc * 8;
  const u16* gb = B + (size_t)lr * ldb + lc * 8;
  u4v ra0[4], rb0[4], ra1[4], rb1[4];
  gemm_ld(ra0, rb0, ga, gb, lda, ldb, 0);
  gemm_ld(ra1, rb1, ga, gb, lda, ldb, 64);
#pragma unroll
  for (int i = 0; i < 2; ++i)
#pragma unroll
    for (int j = 0; j < 2; ++j) acc[i][j] = zero16();
  u16* L0 = lds; u16* L1 = lds + 2 * TS;
  __syncthreads();
  gemm_st(ra0, rb0, L0, lr, lc);
  __syncthreads();
  const int nk = K >> 6;
  int kt = 0;
  for (; kt + 2 < nk; kt += 2) {
    gemm_ld(ra0, rb0, ga, gb, lda, ldb, (kt + 2) * 64);
    __builtin_amdgcn_sched_barrier(0);
    gemm_mma(L0, acc, wm, wn, r, h);
    gemm_st(ra1, rb1, L1, lr, lc);
    __syncthreads();
    gemm_ld(ra1, rb1, ga, gb, lda, ldb, (kt + 3) * 64);
    __builtin_amdgcn_sched_barrier(0);
    gemm_mma(L1, acc, wm, wn, r, h);
    gemm_st(ra0, rb0, L0, lr, lc);
    __syncthreads();
  }
  gemm_mma(L0, acc, wm, wn, r, h);
  gemm_st(ra1, rb1, L1, lr, lc);
  __syncthreads();
  gemm_mma(L1, acc, wm, wn, r, h);
  __syncthreads();
}

DI void stage_pass(const f32x16 (&acc)[2][2], float* stage, int p, int tid) {
  const int lane = tid & 63, w = tid >> 6, wm = w >> 1, wn = w & 1, r = lane & 31, h = lane >> 5;
  __syncthreads();
  if (wm == p) {
#pragma unroll
    for (int i = 0; i < 2; ++i)
#pragma unroll
      for (int j = 0; j < 2; ++j)
#pragma unroll
        for (int reg = 0; reg < 16; ++reg) stage[(i * 32 + crow(reg, h)) * SST + wn * 64 + j * 32 + r] = acc[i][j][reg];
  }
  __syncthreads();
}

namespace pg8 {
#define PG8_LAS __attribute__((address_space(3)))
typedef unsigned short bf16_t;
typedef short bf16x8 __attribute__((ext_vector_type(8)));
typedef float f32x4 __attribute__((ext_vector_type(4)));
typedef unsigned u32x4 __attribute__((ext_vector_type(4)));
constexpr int BM = 256, BK = 64, HALF = 128, HTB = HALF * BK * 2  , STAGE_BYTES = 8 * HTB, NXCD = 8, WGM = 8;

__host__ __device__ __forceinline__ int lds_byte(int r, int c) { const int st = (r >> 4) * 2 + (c >> 5), rr = r & 15, cc = c & 31, ob = rr * 64 + cc * 2; return st * 1024 + (ob ^ (((ob >> 9) & 1) << 5)); }
__host__ __device__ __forceinline__ void stage_rc(int b, int& R, int& C) { const int st = b / 1024, sb = b % 1024, swz = sb ^ (((sb >> 9) & 1) << 5); R = (st >> 1) * 16 + swz / 64; C = (st & 1) * 32 + (swz % 64) / 2; }
__host__ __device__ __forceinline__ int perm32(int rho) { const int n = rho >> 4, i = rho & 15; return 8 * (i >> 2) + 4 * n + (i & 3); }

struct Unit { int pm, pn; };
struct Gemm { const bf16_t* A; const bf16_t* Bt; int M, N, K; };

struct StaticOrder {
    int nM, nN, nwg, G, c;
    __host__ __device__ void init(int M, int N, int G_, int c_) { nM = M / BM; nN = N / BM; nwg = nM * nN; G = G_; c = c_; }
    __host__ __device__ bool next(int i, Unit& u) const {
        const long L = (long)i * G + c; if (L >= nwg) return false;
        int wgid = (int)L; { const int q = nwg / NXCD, r = nwg % NXCD, xcd = wgid % NXCD, off = wgid / NXCD; wgid = (xcd < r ? xcd * (q + 1) : r * (q + 1) + (xcd - r) * q) + off; }
        const int nig = WGM * nN, gid = wgid / nig, fm = gid * WGM, gsz = (nM - fm) < WGM ? (nM - fm) : WGM;
        u.pm = fm + ((wgid % nig) % gsz); u.pn = (wgid % nig) / gsz; return true;
    }
    __device__ __forceinline__ void a_ready(const Unit&) const {}
    __device__ __forceinline__ void done(const Unit&) const {}
};
template <class Epi, class Sched, bool STAMP = false, bool SWAP = false>
__device__ __forceinline__ void gemm_phase(PG8_LAS unsigned char* lds, const Gemm g, const Sched& S, const Epi& E, unsigned long long* stamps) {
    const int tid = threadIdx.x, wid = __builtin_amdgcn_readfirstlane(tid >> 6), lane = tid & 63, wr = wid >> 2, wc = wid & 3, fr = lane & 15, fq = lane >> 4;
    const int K = g.K, nt = K / BK;
    int ts_lo = 0, ts_hi = 0, nts = 0; const unsigned long long rt_entry = STAMP ? (unsigned long long)wall_clock64() : 0ull;
#define PG8_STAMP() do { if (STAMP && wid == 0 && nts < 64) { const unsigned long long _c = (unsigned long long)clock64(); \
        ts_lo = (lane == nts) ? (int)(unsigned)_c : ts_lo; ts_hi = (lane == nts) ? (int)(unsigned)(_c >> 32) : ts_hi; ++nts; } } while (0)
    PG8_STAMP();
    unsigned voffA[2], voffB[2];
#pragma unroll
    for (int i = 0; i < 2; ++i) { int R, C; stage_rc(tid * 16 + i * 8192, R, C); const int Rb = Epi::PERM ? ((R & ~31) + perm32(R & 31)) : R;
        voffA[i] = (unsigned)(R * K + C) * 2u; voffB[i] = (unsigned)(Rb * K + C) * 2u; }
    const size_t kstep = (size_t)(BK * 2);
    const size_t hstep = (size_t)HALF * K * 2;
    const size_t tstep = 2 * hstep;
    const unsigned ldsw = (unsigned)wid * 1024u;
    const int aoff = lds_byte(wr * 64 + fr, fq * 8), boff = lds_byte(wc * 32 + fr, fq * 8);
#define PG8_SA(b, h) (((b) * 2 + (h)) * HTB)
#define PG8_SB(b, h) ((4 + (b) * 2 + (h)) * HTB)
#define PG8_STAGE(bufoff, gbase, voff) do { _Pragma("unroll") for (int _i = 0; _i < 2; ++_i) \
        __builtin_amdgcn_global_load_lds((const unsigned*)((const char*)(gbase) + (voff)[_i]), (PG8_LAS unsigned*)(lds + (bufoff) + ldsw + _i * 8192), 16, 0, 0); } while (0)
#define PG8_LDA(dst, b, h) do { _Pragma("unroll") for (int m = 0; m < 4; ++m) _Pragma("unroll") for (int k = 0; k < 2; ++k) dst[m][k] = *(const PG8_LAS bf16x8*)(lds + PG8_SA(b, h) + aoff + m * 2048 + k * 1024); } while (0)
#define PG8_LDB(dst, b, h) do { _Pragma("unroll") for (int n = 0; n < 2; ++n) _Pragma("unroll") for (int k = 0; k < 2; ++k) dst[n][k] = *(const PG8_LAS bf16x8*)(lds + PG8_SB(b, h) + boff + n * 2048 + k * 1024); } while (0)
#define PG8_MMA(ai, bj, At, Bt) do { __builtin_amdgcn_s_setprio(1); _Pragma("unroll") for (int m = 0; m < 4; ++m) _Pragma("unroll") for (int n = 0; n < 2; ++n) _Pragma("unroll") for (int k = 0; k < 2; ++k) \
        acc[ai][bj][m][n] = SWAP ? __builtin_amdgcn_mfma_f32_16x16x32_bf16(At[m][k], Bt[n][k], acc[ai][bj][m][n], 0, 0, 0) : __builtin_amdgcn_mfma_f32_16x16x32_bf16(Bt[n][k], At[m][k], acc[ai][bj][m][n], 0, 0, 0); __builtin_amdgcn_s_setprio(0); } while (0)
#define PG8_WAIT_V(n) asm volatile("s_waitcnt vmcnt(" #n ")" ::: "memory")
#define PG8_WAIT_L(n) asm volatile("s_waitcnt lgkmcnt(" #n ")" ::: "memory")
#define PG8_BAR __builtin_amdgcn_s_barrier()
#define PG8_SCHED __builtin_amdgcn_sched_barrier(0)
    Unit cur, nxt; int ui = 0;
    if (!S.next(0, cur)) return;
    f32x4 acc[2][2][4][2];
#pragma unroll
    for (int a = 0; a < 2; ++a)
#pragma unroll
        for (int b = 0; b < 2; ++b)
#pragma unroll
            for (int m = 0; m < 4; ++m)
#pragma unroll
                for (int n = 0; n < 2; ++n) acc[a][b][m][n] = (f32x4){0.f, 0.f, 0.f, 0.f};
    bf16x8 At[4][2], B0[2][2], B1[2][2];
    const char* cA = (const char*)g.A + (size_t)cur.pm * tstep; const char* cB = (const char*)g.Bt + (size_t)cur.pn * tstep;
    S.a_ready(cur);
    PG8_STAGE(PG8_SB(0, 0), cB, voffB); PG8_STAGE(PG8_SA(0, 0), cA, voffA); PG8_STAGE(PG8_SB(0, 1), cB + hstep, voffB); PG8_STAGE(PG8_SA(0, 1), cA + hstep, voffA);
    if (wr == 1) PG8_BAR;
    PG8_WAIT_V(4); PG8_BAR;
    PG8_STAGE(PG8_SB(1, 0), cB + kstep, voffB); PG8_STAGE(PG8_SA(1, 0), cA + kstep, voffA); PG8_STAGE(PG8_SB(1, 1), cB + hstep + kstep, voffB);
    PG8_WAIT_V(6); PG8_BAR;
    PG8_STAMP();
    for (;;) {
        const bool has_next = S.next(ui + 1, nxt);
        const char* nA = has_next ? (const char*)g.A + (size_t)nxt.pm * tstep : cA; const char* nB = has_next ? (const char*)g.Bt + (size_t)nxt.pn * tstep : cB;
        for (int t = 0; t < nt; t += 2) {
            const bool last = (t == nt - 2);
            const char* a1 = cA + (size_t)(t + 1) * kstep;
            const char* a2 = last ? nA : cA + (size_t)(t + 2) * kstep; const char* b2 = last ? nB : cB + (size_t)(t + 2) * kstep;
            const char* a3 = a2 + kstep; const char* b3 = b2 + kstep;
            if (last && has_next) S.a_ready(nxt);
            PG8_LDB(B0, 0, 0); PG8_SCHED; PG8_LDA(At, 0, 0); PG8_STAGE(PG8_SA(1, 1), a1 + hstep, voffA);
            PG8_WAIT_L(8); PG8_BAR; PG8_WAIT_L(0); PG8_MMA(0, 0, At, B0); PG8_BAR; PG8_SCHED;
            PG8_LDB(B1, 0, 1); PG8_STAGE(PG8_SB(0, 0), b2, voffB);
            PG8_BAR; PG8_WAIT_L(0); PG8_MMA(0, 1, At, B1); PG8_BAR;
            PG8_LDA(At, 0, 1); PG8_STAGE(PG8_SA(0, 0), a2, voffA);
            PG8_BAR; PG8_WAIT_L(0); PG8_MMA(1, 0, At, B0); PG8_BAR; PG8_SCHED;
            PG8_STAGE(PG8_SB(0, 1), b2 + hstep, voffB);
            PG8_WAIT_V(6); PG8_BAR; PG8_MMA(1, 1, At, B1); PG8_BAR;
            PG8_LDB(B0, 1, 0); PG8_SCHED; PG8_LDA(At, 1, 0); PG8_STAGE(PG8_SA(0, 1), a2 + hstep, voffA);
            PG8_WAIT_L(8); PG8_BAR; PG8_WAIT_L(0); PG8_MMA(0, 0, At, B0); PG8_BAR; PG8_SCHED;
            PG8_LDB(B1, 1, 1); PG8_STAGE(PG8_SB(1, 0), b3, voffB);
            PG8_BAR; PG8_WAIT_L(0); PG8_MMA(0, 1, At, B1); PG8_BAR;
            PG8_LDA(At, 1, 1); PG8_STAGE(PG8_SA(1, 0), a3, voffA);
            PG8_BAR; PG8_WAIT_L(0); PG8_MMA(1, 0, At, B0); PG8_BAR; PG8_SCHED;
            PG8_STAGE(PG8_SB(1, 1), b3 + hstep, voffB);
            PG8_WAIT_V(6); PG8_BAR; PG8_MMA(1, 1, At, B1); PG8_BAR;
        }
        PG8_STAMP();
        if constexpr (!Epi::AFTER_DRAIN) { E(acc, cur, wr, wc, fr, fq); S.done(cur); }
        PG8_STAMP();
        if (!has_next) break;
#pragma unroll
        for (int a = 0; a < 2; ++a)
#pragma unroll
            for (int b = 0; b < 2; ++b)
#pragma unroll
                for (int m = 0; m < 4; ++m)
#pragma unroll
                    for (int n = 0; n < 2; ++n) acc[a][b][m][n] = (f32x4){0.f, 0.f, 0.f, 0.f};
        cur = nxt; cA = nA; cB = nB; ++ui;
    }
    PG8_WAIT_V(0);
    if (wr == 0) PG8_BAR;
    PG8_BAR;
    if constexpr (Epi::AFTER_DRAIN) { E.fused(acc, cur, wr, wc, fr, fq, lds, wid, lane); S.done(cur); }
    PG8_STAMP();
    if (STAMP && wid == 0) { stamps[lane] = lane < nts ? (((unsigned long long)(unsigned)ts_hi << 32) | (unsigned)ts_lo) : 0ull;
        if (lane == 62) stamps[62] = rt_entry; if (lane == 63) stamps[63] = (unsigned long long)wall_clock64(); }
#undef PG8_STAMP
#undef PG8_SA
#undef PG8_SB
#undef PG8_STAGE
#undef PG8_LDA
#undef PG8_LDB
#undef PG8_MMA
#undef PG8_WAIT_V
#undef PG8_WAIT_L
#undef PG8_BAR
#undef PG8_SCHED
}
}

struct Epi1 {
  static constexpr bool PERM = true, AFTER_DRAIN = false;
  unsigned char* ws; u16* mg; const float* b_gate; bool dup;
  DI void operator()(const pg8::f32x4 (&acc)[2][2][4][2], const pg8::Unit& u, int wr, int wc, int fr, int fq) const {
    const int pn = u.pn;
    const int rowb = u.pm * 256 + wr * 64 + fr;
    const int colu = wc * 32 + 8 * fq;
    if (pn < 4) {
      u16* dst = (pn < 3) ? (u16*)(ws + OFF_CQ) + pn * 256 : (u16*)(ws + OFF_CKV);
      const int ld = (pn < 3) ? 768 : 256;
      float* ssq = (float*)(ws + OFF_SSQ) + ((pn < 3) ? 0 : T);
#pragma unroll
      for (int ai = 0; ai < 2; ++ai)
#pragma unroll
        for (int m = 0; m < 4; ++m) {
          const int row = rowb + ai * 128 + m * 16;
          float ss = 0.f;
#pragma unroll
          for (int bj = 0; bj < 2; ++bj) {
            const pg8::f32x4 v0 = acc[ai][bj][m][0], v1 = acc[ai][bj][m][1];
            ss += v0[0] * v0[0] + v0[1] * v0[1] + v0[2] * v0[2] + v0[3] * v0[3] + v1[0] * v1[0] + v1[1] * v1[1] + v1[2] * v1[2] + v1[3] * v1[3];
            u4v o; o.x = pk2(v0[0], v0[1]); o.y = pk2(v0[2], v0[3]); o.z = pk2(v1[0], v1[1]); o.w = pk2(v1[2], v1[3]);
            *(u4v*)(dst + (size_t)row * ld + bj * 128 + colu) = o;
          }
          ss += __shfl_xor(ss, 16); ss += __shfl_xor(ss, 32);
          if (fq == 0 && !dup) atomicAdd(ssq + row, ss);
        }
    } else if (pn < 8) {
      u16* dst = (u16*)(ws + ((pn < 6) ? OFF_SGA : OFF_SGB)) + (pn & 1) * 256;
#pragma unroll
      for (int ai = 0; ai < 2; ++ai)
#pragma unroll
        for (int m = 0; m < 4; ++m) {
          const int row = rowb + ai * 128 + m * 16;
#pragma unroll
          for (int bj = 0; bj < 2; ++bj) {
            const pg8::f32x4 v0 = acc[ai][bj][m][0], v1 = acc[ai][bj][m][1];
            u4v o; o.x = pk2(siluf_(v0[0]), siluf_(v0[1])); o.y = pk2(siluf_(v0[2]), siluf_(v0[3]));
            o.z = pk2(siluf_(v1[0]), siluf_(v1[1])); o.w = pk2(siluf_(v1[2]), siluf_(v1[3]));
            *(u4v*)(dst + (size_t)row * 512 + bj * 128 + colu) = o;
          }
        }
    } else if (pn >= 16) {
      if (pn < 22) {
        u16* dst = (u16*)(ws + ((pn < 18) ? OFF_HQ : (pn < 20) ? OFF_HF : OFF_HI)) + (pn & 1) * 256;
#pragma unroll
        for (int ai = 0; ai < 2; ++ai)
#pragma unroll
          for (int m = 0; m < 4; ++m) {
            const int row = rowb + ai * 128 + m * 16;
#pragma unroll
            for (int bj = 0; bj < 2; ++bj) {
              const pg8::f32x4 v0 = acc[ai][bj][m][0], v1 = acc[ai][bj][m][1];
              u4v o; o.x = pk2(v0[0], v0[1]); o.y = pk2(v0[2], v0[3]); o.z = pk2(v1[0], v1[1]); o.w = pk2(v1[2], v1[3]);
              *(u4v*)(dst + (size_t)row * 512 + bj * 128 + colu) = o;
            }
          }
      } else if (colu < 32) {
        float* dst = (float*)(ws + OFF_KPE);
#pragma unroll
        for (int ai = 0; ai < 2; ++ai)
#pragma unroll
          for (int m = 0; m < 4; ++m) {
            const int row = rowb + ai * 128 + m * 16;
            *(pg8::f32x4*)(dst + (size_t)row * 32 + colu) = acc[ai][0][m][0];
            *(pg8::f32x4*)(dst + (size_t)row * 32 + colu + 4) = acc[ai][0][m][1];
          }
      }
    } else {
      const int cb = (pn - 8) * 256 + colu;
      f4v b0[2], b1[2];
#pragma unroll
      for (int bj = 0; bj < 2; ++bj) { b0[bj] = *(const f4v*)(b_gate + cb + bj * 128); b1[bj] = *(const f4v*)(b_gate + cb + bj * 128 + 4); }
#pragma unroll
      for (int ai = 0; ai < 2; ++ai)
#pragma unroll
        for (int m = 0; m < 4; ++m) {
          const int row = rowb + ai * 128 + m * 16;
#pragma unroll
          for (int bj = 0; bj < 2; ++bj) {
            const pg8::f32x4 v0 = acc[ai][bj][m][0], v1 = acc[ai][bj][m][1];
            u4v o; o.x = pk2(sigmoidf_(v0[0] + b0[bj].x), sigmoidf_(v0[1] + b0[bj].y)); o.y = pk2(sigmoidf_(v0[2] + b0[bj].z), sigmoidf_(v0[3] + b0[bj].w));
            o.z = pk2(sigmoidf_(v1[0] + b1[bj].x), sigmoidf_(v1[1] + b1[bj].y)); o.w = pk2(sigmoidf_(v1[2] + b1[bj].z), sigmoidf_(v1[3] + b1[bj].w));
            *(u4v*)(mg + ((((size_t)(u.pm * 8 + (pn - 8)) * 8 + (wr * 4 + wc)) * 16 + (ai * 8 + m * 2 + bj)) * 64 + (fq * 16 + fr)) * 8) = o;
          }
        }
    }
  }
};


struct Epi6 {
  static constexpr bool PERM = true, AFTER_DRAIN = false;
  float* out; float* ssq; bool dup;
  DI void operator()(const pg8::f32x4 (&acc)[2][2][4][2], const pg8::Unit& u, int wr, int wc, int fr, int fq) const {
    const int rowb = u.pm * 256 + wr * 64 + fr;
    const int colb = u.pn * 256 + wc * 32 + 8 * fq;
#pragma unroll
    for (int ai = 0; ai < 2; ++ai)
#pragma unroll
      for (int m = 0; m < 4; ++m) {
        const int row = rowb + ai * 128 + m * 16;
        float ss = 0.f;
#pragma unroll
        for (int bj = 0; bj < 2; ++bj) {
          const pg8::f32x4 v0 = acc[ai][bj][m][0], v1 = acc[ai][bj][m][1];
          ss += v0[0] * v0[0] + v0[1] * v0[1] + v0[2] * v0[2] + v0[3] * v0[3] + v1[0] * v1[0] + v1[1] * v1[1] + v1[2] * v1[2] + v1[3] * v1[3];
          float* dst = out + (size_t)row * 1024 + colb + bj * 128;
          *(pg8::f32x4*)dst = v0; *(pg8::f32x4*)(dst + 4) = v1;
        }
        ss += __shfl_xor(ss, 16); ss += __shfl_xor(ss, 32);
        if (fq == 0 && !dup) atomicAdd(ssq + row, ss);
      }
  }
};
template <bool SECOND> struct Epi5 {
  static constexpr bool PERM = true, AFTER_DRAIN = false;
  const u16* mg; u16* mi; u16* mo;
  DI void operator()(const pg8::f32x4 (&acc)[2][2][4][2], const pg8::Unit& u, int wr, int wc, int fr, int fq) const {
    const int rowb = u.pm * 256 + wr * 64 + fr;
    const int colb = u.pn * 256 + wc * 32 + 8 * fq;
    const size_t gbase = (((size_t)(u.pm * 8 + u.pn + (SECOND ? 4 : 0)) * 8 + (wr * 4 + wc)) * 16) * 64 + (fq * 16 + fr);
    const size_t ibase = (((size_t)(u.pm * 4 + u.pn) * 8 + (wr * 4 + wc)) * 16) * 64 + (fq * 16 + fr);
#pragma unroll
    for (int ai = 0; ai < 2; ++ai)
#pragma unroll
      for (int m = 0; m < 4; ++m) {
        const int row = rowb + ai * 128 + m * 16;
#pragma unroll
        for (int bj = 0; bj < 2; ++bj) {
          const pg8::f32x4 v0 = acc[ai][bj][m][0], v1 = acc[ai][bj][m][1];
          const int f = ai * 8 + m * 2 + bj;
          const u4v g = *(const u4v*)(mg + (gbase + (size_t)f * 64) * 8);
          float r0 = v0[0] * bflo(g.x), r1 = v0[1] * bfhi(g.x), r2 = v0[2] * bflo(g.y), r3 = v0[3] * bfhi(g.y);
          float r4 = v1[0] * bflo(g.z), r5 = v1[1] * bfhi(g.z), r6 = v1[2] * bflo(g.w), r7 = v1[3] * bfhi(g.w);
          if (SECOND) {
            const u4v pm = *(const u4v*)(mi + (ibase + (size_t)f * 64) * 8);
            r0 += bflo(pm.x); r1 += bfhi(pm.x); r2 += bflo(pm.y); r3 += bfhi(pm.y); r4 += bflo(pm.z); r5 += bfhi(pm.z); r6 += bflo(pm.w); r7 += bfhi(pm.w);
          }
          u4v o; o.x = pk2(r0, r1); o.y = pk2(r2, r3); o.z = pk2(r4, r5); o.w = pk2(r6, r7);
          if (SECOND) *(u4v*)(mo + (size_t)row * 1024 + colb + bj * 128) = o;
          else *(u4v*)(mi + (ibase + (size_t)f * 64) * 8) = o;
        }
      }
  }
};
struct EpiQ {
  static constexpr bool PERM = true, AFTER_DRAIN = false;
  const float* ssq_q; const float* rope; u16* Qo;
  DI void operator()(const pg8::f32x4 (&acc)[2][2][4][2], const pg8::Unit& u, int wr, int wc, int fr, int fq) const {
    const int rowb = u.pm * 256 + wr * 64 + fr;
    const int colu = wc * 32 + 8 * fq;
#pragma unroll
    for (int ai = 0; ai < 2; ++ai)
#pragma unroll
      for (int m = 0; m < 4; ++m) {
        const int row = rowb + ai * 128 + m * 16;
        const int b = row >> 12, spos = row & 4095;
        const float sc = rsqrtf(ssq_q[row] * (1.f / 768.f) + EPS) * QSCALE;
#pragma unroll
        for (int bj = 0; bj < 2; ++bj) {
          const pg8::f32x4 v0 = acc[ai][bj][m][0], v1 = acc[ai][bj][m][1];
          if (u.pn < 2) {
            const int head = u.pn * 4 + bj * 2 + (colu >> 6), d = colu & 63;
            u4v o; o.x = pk2(v0[0] * sc, v0[1] * sc); o.y = pk2(v0[2] * sc, v0[3] * sc); o.z = pk2(v1[0] * sc, v1[1] * sc); o.w = pk2(v1[2] * sc, v1[3] * sc);
            *(u4v*)(Qo + ((size_t)(b * 8 + head) * 4096 + spos) * 96 + d) = o;
          } else {
            const int head = bj * 4 + wc;
            const f4v cs = *(const f4v*)(rope + spos * 16 + 4 * fq), sn = *(const f4v*)(rope + 65536 + spos * 16 + 4 * fq);
            u2v o1, o2;
            o1.x = pk2((v0[0] * cs.x - v1[0] * sn.x) * sc, (v0[1] * cs.y - v1[1] * sn.y) * sc);
            o1.y = pk2((v0[2] * cs.z - v1[2] * sn.z) * sc, (v0[3] * cs.w - v1[3] * sn.w) * sc);
            o2.x = pk2((v0[0] * sn.x + v1[0] * cs.x) * sc, (v0[1] * sn.y + v1[1] * cs.y) * sc);
            o2.y = pk2((v0[2] * sn.z + v1[2] * cs.z) * sc, (v0[3] * sn.w + v1[3] * cs.w) * sc);
            u16* qp = Qo + ((size_t)(b * 8 + head) * 4096 + spos) * 96 + 64 + 4 * fq;
            *(u2v*)qp = o1; *(u2v*)(qp + 16) = o2;
          }
        }
      }
  }
};


struct EpiK {
  static constexpr bool PERM = true, AFTER_DRAIN = false;
  const float* ssq_kv; u16* Ko;
  DI void operator()(const pg8::f32x4 (&acc)[2][2][4][2], const pg8::Unit& u, int wr, int wc, int fr, int fq) const {
    const int rowb = u.pm * 256 + wr * 64 + fr;
#pragma unroll
    for (int ai = 0; ai < 2; ++ai)
#pragma unroll
      for (int m = 0; m < 4; ++m) {
        const int row = rowb + ai * 128 + m * 16;
        const int b = row >> 12, spos = row & 4095;
        const float sc = rsqrtf(ssq_kv[row] * (1.f / 256.f) + EPS);
#pragma unroll
        for (int bj = 0; bj < 2; ++bj) {
          const pg8::f32x4 v0 = acc[ai][bj][m][0], v1 = acc[ai][bj][m][1];
          const int col = u.pn * 256 + bj * 128 + wc * 32 + 8 * fq;
          const int head = col >> 6, d = col & 63;
          u4v o; o.x = pk2(v0[0] * sc, v0[1] * sc); o.y = pk2(v0[2] * sc, v0[3] * sc); o.z = pk2(v1[0] * sc, v1[1] * sc); o.w = pk2(v1[2] * sc, v1[3] * sc);
          *(u4v*)(Ko + ((size_t)(b * 8 + head) * 4096 + spos) * 96 + d) = o;
        }
      }
  }
};
struct EpiV {
  static constexpr bool PERM = false, AFTER_DRAIN = false;
  const float* ssq_kv; u16* Vo;
  DI void operator()(const pg8::f32x4 (&acc)[2][2][4][2], const pg8::Unit& u, int wr, int wc, int fr, int fq) const {
#pragma unroll
    for (int ai = 0; ai < 2; ++ai)
#pragma unroll
      for (int m = 0; m < 4; ++m) {
        const int row4 = u.pm * 256 + ai * 128 + wr * 64 + m * 16 + 4 * fq;
        const int b = row4 >> 12, spos = row4 & 4095;
        const f4v q = *(const f4v*)(ssq_kv + row4);
        const float s0 = rsqrtf(q.x * (1.f / 256.f) + EPS), s1 = rsqrtf(q.y * (1.f / 256.f) + EPS), s2 = rsqrtf(q.z * (1.f / 256.f) + EPS), s3 = rsqrtf(q.w * (1.f / 256.f) + EPS);
#pragma unroll
        for (int bj = 0; bj < 2; ++bj)
#pragma unroll
          for (int n = 0; n < 2; ++n) {
            const pg8::f32x4 v = acc[ai][bj][m][n];
            const int col = u.pn * 256 + bj * 128 + wc * 32 + n * 16 + fr;
            const int head = col >> 6, dv = col & 63;
            u2v o; o.x = pk2(v[0] * s0, v[1] * s1); o.y = pk2(v[2] * s2, v[3] * s3);
            *(u2v*)(Vo + ((size_t)(b * 8 + head) * 64 + dv) * 4096 + spos) = o;
          }
        __builtin_amdgcn_sched_barrier(0);
      }
  }
};
DI void phase1(const Params& p, unsigned char* smem, bool dup = false) {
  unsigned char* ws = p.ws;
  pg8::Gemm g{(const u16*)(ws + OFF_H), (const u16*)(ws + OFF_WIN), T, NP, 1024};
  pg8::StaticOrder S; S.init(T, NP, (int)gridDim.x, (int)blockIdx.x);
  Epi1 E{ws, (u16*)p.out, p.b_gate, dup};
  pg8::gemm_phase<Epi1, pg8::StaticOrder, false>((PG8_LAS unsigned char*)smem, g, S, E, nullptr);
}

DI void hgrn_prep_tile(const Params& p, float* stage, int tid, int b, int hh, int prow0, int nblk0) {
  unsigned char* ws = p.ws;
  const int bh = b * 8 + hh;
  if (tid < 128) {
    const int c = tid & 63, blk = tid >> 6;
    const float l0 = p.lb_logits[hh * 64 + c], l1 = p.lb_logits[512 + hh * 64 + c];
    const float lbv = 1.f / (1.f + expf(l1 - l0));
    float cum = 0.f;
    for (int rr = 0; rr < 32; ++rr) {
      float* sp = stage + (blk * 32 + rr) * SST + c;
      const float q = sp[0], hf = sp[64];
      const float sg = 1.f / (1.f + expf(-hf));
      const float f = lbv + (1.f - lbv) * sg;
      cum += logf(f);
      const float e = expf(cum);
      sp[0] = q * e;
      sp[64] = (1.f - f) / e;
    }
    ((float*)(ws + OFF_DECAY))[((size_t)bh * 128 + nblk0 + blk) * 64 + c] = expf(cum);
  }
  __syncthreads();
#pragma unroll
  for (int it = 0; it < 2; ++it) {
    const int item = tid + 256 * it, rr = item >> 3, cc = (item & 7) * 8;
    const f4v a = *(const f4v*)(stage + rr * SST + cc), c = *(const f4v*)(stage + rr * SST + cc + 4);
    const f4v d = *(const f4v*)(stage + rr * SST + 64 + cc), e = *(const f4v*)(stage + rr * SST + 64 + cc + 4);
    const size_t o = (size_t)(prow0 + rr) * 512 + hh * 64 + cc;
    *(u4v*)((u16*)(ws + OFF_QDEC) + o) = pk8(a, c);
    *(u4v*)((u16*)(ws + OFF_KINV) + o) = pk8(d, e);
  }
}
DI void hi_vt_tile(const Params& p, float* stage, int tid, int b, int q2, int nblk0) {
  unsigned char* ws = p.ws;
#pragma unroll
        for (int it = 0; it < 4; ++it) {
          const int item = tid + 256 * it, sc = item & 3, col = (item >> 2) & 127, blk = item >> 9;
          float v[8];
#pragma unroll
          for (int i = 0; i < 8; ++i) v[i] = stage[(blk * 32 + sc * 8 + i) * SST + col];
          u4v o; o.x = pk2(v[0], v[1]); o.y = pk2(v[2], v[3]); o.z = pk2(v[4], v[5]); o.w = pk2(v[6], v[7]);
          const int bh = b * 8 + q2 * 2 + (col >> 6);
          *(u4v*)((u16*)(ws + OFF_VT) + (((size_t)bh * 128 + nblk0 + blk) * 64 + (col & 63)) * 32 + sc * 8) = o;
        }
}
DI void stage_load64(float* stage, const u16* src, int coff, int tid) {
#pragma unroll
  for (int it = 0; it < 2; ++it) {
    const int item = tid + 256 * it, rr = item >> 3, ch = item & 7;
    const u4v v = *(const u4v*)(src + (size_t)rr * 512 + ch * 8);
    float* d = stage + rr * SST + coff + ch * 8;
    *(f4v*)d = f4v{bflo(v.x), bfhi(v.x), bflo(v.y), bfhi(v.y)};
    *(f4v*)(d + 4) = f4v{bflo(v.z), bfhi(v.z), bflo(v.w), bfhi(v.w)};
  }
}


constexpr int PST = 68;
DI void hgrn_prep_native(const Params& p, float* pl, int rb, int hh) {
  unsigned char* ws = p.ws;
  const int tid = threadIdx.x;
  float* Qp = pl; float* G = pl + 128 * PST; float* Kn = pl + 2 * 128 * PST;
  const int prow0 = rb * 128, b = prow0 >> 12, bh = b * 8 + hh, nblk0 = (prow0 & 4095) >> 5;
  const int ch = tid & 7;
  float lbv[8];
  {
    const f4v a0 = *(const f4v*)(p.lb_logits + hh * 64 + ch * 8), a1 = *(const f4v*)(p.lb_logits + hh * 64 + ch * 8 + 4);
    const f4v b0 = *(const f4v*)(p.lb_logits + 512 + hh * 64 + ch * 8), b1 = *(const f4v*)(p.lb_logits + 512 + hh * 64 + ch * 8 + 4);
    const float l0[8] = {a0.x, a0.y, a0.z, a0.w, a1.x, a1.y, a1.z, a1.w}, l1[8] = {b0.x, b0.y, b0.z, b0.w, b1.x, b1.y, b1.z, b1.w};
#pragma unroll
    for (int i = 0; i < 8; ++i) lbv[i] = 1.f / (1.f + expf(l1[i] - l0[i]));
  }
  __syncthreads();
#pragma unroll
  for (int it = 0; it < 2; ++it) {
    const int rr = (tid + 512 * it) >> 3;
    const size_t go = (size_t)(prow0 + rr) * 512 + hh * 64 + ch * 8;
    const u4v qv = *(const u4v*)((const u16*)(ws + OFF_HQ) + go), fv = *(const u4v*)((const u16*)(ws + OFF_HF) + go);
    const float q[8] = {bflo(qv.x), bfhi(qv.x), bflo(qv.y), bfhi(qv.y), bflo(qv.z), bfhi(qv.z), bflo(qv.w), bfhi(qv.w)};
    const float hf[8] = {bflo(fv.x), bfhi(fv.x), bflo(fv.y), bfhi(fv.y), bflo(fv.z), bfhi(fv.z), bflo(fv.w), bfhi(fv.w)};
    float g[8], kn[8];
#pragma unroll
    for (int i = 0; i < 8; ++i) {
      const float sg = rcpf(1.f + __builtin_amdgcn_exp2f(-1.4426950408889634f * hf[i]));
      const float f = lbv[i] + (1.f - lbv[i]) * sg;
      g[i] = __builtin_amdgcn_logf(f);
      kn[i] = 1.f - f;
    }
    float* d = Qp + rr * PST + ch * 8;
    *(f4v*)d = f4v{q[0], q[1], q[2], q[3]}; *(f4v*)(d + 4) = f4v{q[4], q[5], q[6], q[7]};
    d = G + rr * PST + ch * 8;
    *(f4v*)d = f4v{g[0], g[1], g[2], g[3]}; *(f4v*)(d + 4) = f4v{g[4], g[5], g[6], g[7]};
    d = Kn + rr * PST + ch * 8;
    *(f4v*)d = f4v{kn[0], kn[1], kn[2], kn[3]}; *(f4v*)(d + 4) = f4v{kn[4], kn[5], kn[6], kn[7]};
  }
  __syncthreads();
  if (tid < 256) {
    const int c = tid & 63, blk = tid >> 6;
    float* gp = G + (blk * 32) * PST + c;
    float v[32];
#pragma unroll
    for (int r2 = 0; r2 < 32; ++r2) v[r2] = gp[r2 * PST];
    float cum = 0.f;
#pragma unroll
    for (int r2 = 0; r2 < 32; ++r2) { cum += v[r2]; gp[r2 * PST] = cum; }
    ((float*)(ws + OFF_DECAY))[((size_t)bh * 128 + nblk0 + blk) * 64 + c] = __builtin_amdgcn_exp2f(cum);
  }
  __syncthreads();
#pragma unroll
  for (int it = 0; it < 2; ++it) {
    const int rr = (tid + 512 * it) >> 3;
    const float* s0 = Qp + rr * PST + ch * 8; const float* s1 = G + rr * PST + ch * 8; const float* s2 = Kn + rr * PST + ch * 8;
    const f4v q0 = *(const f4v*)s0, q1 = *(const f4v*)(s0 + 4), c0 = *(const f4v*)s1, c1 = *(const f4v*)(s1 + 4), k0 = *(const f4v*)s2, k1 = *(const f4v*)(s2 + 4);
    const float q[8] = {q0.x, q0.y, q0.z, q0.w, q1.x, q1.y, q1.z, q1.w}, cm[8] = {c0.x, c0.y, c0.z, c0.w, c1.x, c1.y, c1.z, c1.w}, kn[8] = {k0.x, k0.y, k0.z, k0.w, k1.x, k1.y, k1.z, k1.w};
    float qd[8], ki[8];
#pragma unroll
    for (int i = 0; i < 8; ++i) { qd[i] = q[i] * __builtin_amdgcn_exp2f(cm[i]); ki[i] = kn[i] * __builtin_amdgcn_exp2f(-cm[i]); }
    const size_t go = (size_t)(prow0 + rr) * 512 + hh * 64 + ch * 8;
    u4v o; o.x = pk2(qd[0], qd[1]); o.y = pk2(qd[2], qd[3]); o.z = pk2(qd[4], qd[5]); o.w = pk2(qd[6], qd[7]);
    *(u4v*)((u16*)(ws + OFF_QDEC) + go) = o;
    o.x = pk2(ki[0], ki[1]); o.y = pk2(ki[2], ki[3]); o.z = pk2(ki[4], ki[5]); o.w = pk2(ki[6], ki[7]);
    *(u4v*)((u16*)(ws + OFF_KINV) + go) = o;
  }
}
constexpr int VTS = 136;
DI void hi_vt_native(const Params& p, u16* img, int rb, int q2) {
  unsigned char* ws = p.ws;
  const int tid = threadIdx.x;
  const int prow0 = rb * 128, b = prow0 >> 12, nblk0 = (prow0 & 4095) >> 5;
  __syncthreads();
#pragma unroll
  for (int it = 0; it < 4; ++it) {
    const int item = tid + 512 * it, rr = item >> 4, c16 = item & 15;
    *(u4v*)(img + rr * VTS + c16 * 8) = *(const u4v*)((const u16*)(ws + OFF_HI) + (size_t)(prow0 + rr) * 512 + q2 * 128 + c16 * 8);
  }
  __syncthreads();
#pragma unroll
  for (int it = 0; it < 4; ++it) {
    const int item = tid + 512 * it, sc = item & 3, col = (item >> 2) & 127, blk = item >> 9;
    u32 w[4];
#pragma unroll
    for (int i = 0; i < 4; ++i) {
      const u32 lo = img[(blk * 32 + sc * 8 + 2 * i) * VTS + col], hi = img[(blk * 32 + sc * 8 + 2 * i + 1) * VTS + col];
      w[i] = lo | (hi << 16);
    }
    const int bh = b * 8 + q2 * 2 + (col >> 6);
    *(u4v*)((u16*)(ws + OFF_VT) + (((size_t)bh * 128 + nblk0 + blk) * 64 + (col & 63)) * 32 + sc * 8) = u4v{w[0], w[1], w[2], w[3]};
  }
}

DI void rope8(const float* x1, const float* x2, const float* rope, int spos, int j0, bool first, float scale, float (&o)[8]) {
  const f4v c0 = *(const f4v*)(rope + spos * 16 + j0), c1 = *(const f4v*)(rope + spos * 16 + j0 + 4);
  const f4v s0 = *(const f4v*)(rope + 65536 + spos * 16 + j0), s1 = *(const f4v*)(rope + 65536 + spos * 16 + j0 + 4);
  const float cs[8] = {c0.x, c0.y, c0.z, c0.w, c1.x, c1.y, c1.z, c1.w};
  const float sn[8] = {s0.x, s0.y, s0.z, s0.w, s1.x, s1.y, s1.z, s1.w};
#pragma unroll
  for (int i = 0; i < 8; ++i) o[i] = scale * (first ? (x1[i] * cs[i] - x2[i] * sn[i]) : (x1[i] * sn[i] + x2[i] * cs[i]));
}

DI void phase2(const Params& p, unsigned char* smem, u16* lds) {
  unsigned char* ws = p.ws;
  const int tid = VTID;
  float* stage = (float*)lds;
  const float* ssq_q = (const float*)(ws + OFF_SSQ);
  const float* ssq_kv = ssq_q + T;
  const float* rope = (const float*)(ws + OFF_ROPE);
  u16* Qo = (u16*)(ws + OFF_Q);
  u16* Ko = (u16*)(ws + OFF_K);
  u16* Vo = (u16*)(ws + OFF_VTT);
  {
    pg8::Gemm g{(const u16*)(ws + OFF_CQ), (const u16*)(ws + OFF_WUQ), T, 768, 768};
    pg8::StaticOrder S; S.init(T, 768, (int)gridDim.x, (int)blockIdx.x);
    EpiQ E{ssq_q, rope, Qo};
    pg8::gemm_phase<EpiQ, pg8::StaticOrder, false>((PG8_LAS unsigned char*)smem, g, S, E, nullptr);
  }
  {
    pg8::StaticOrder S; S.init(T, 512, (int)gridDim.x, (int)blockIdx.x);
    {
      int kk = 256; asm volatile("" : "+s"(kk));
      pg8::Gemm g{(const u16*)(ws + OFF_CKV), (const u16*)(ws + OFF_WUKV), T, 512, kk};
      EpiK E{ssq_kv, Ko};
      pg8::gemm_phase<EpiK, pg8::StaticOrder, false>((PG8_LAS unsigned char*)smem, g, S, E, nullptr);
    }
  }
  {
    const int gtid = blockIdx.x * blockDim.x + threadIdx.x, gthreads = gridDim.x * blockDim.x;
    for (int idx = gtid; idx < T * 4; idx += gthreads) {
      const int tok = idx >> 2, wv = (idx & 3) * 8, j0 = wv & 15;
      const int b = tok >> 12, spos = tok & 4095;
      const float* kp = (const float*)(ws + OFF_KPE) + (size_t)tok * 32;
      const f4v a0 = *(const f4v*)(kp + j0), a1 = *(const f4v*)(kp + j0 + 4);
      const f4v b0 = *(const f4v*)(kp + 16 + j0), b1 = *(const f4v*)(kp + 16 + j0 + 4);
      const float x1[8] = {a0.x, a0.y, a0.z, a0.w, a1.x, a1.y, a1.z, a1.w};
      const float x2[8] = {b0.x, b0.y, b0.z, b0.w, b1.x, b1.y, b1.z, b1.w};
      float o[8];
      rope8(x1, x2, rope, spos, j0, wv < 16, 1.f, o);
      u4v ov; ov.x = pk2(o[0], o[1]); ov.y = pk2(o[2], o[3]); ov.z = pk2(o[4], o[5]); ov.w = pk2(o[6], o[7]);
#pragma unroll
      for (int head = 0; head < 8; ++head) *(u4v*)(Ko + ((size_t)(b * 8 + head) * 4096 + spos) * 96 + 64 + wv) = ov;
    }
  }
  for (int t = blockIdx.x; t < 2048 + 1024; t += gridDim.x) {
    if (t < 2048) hgrn_prep_native(p, (float*)smem, t >> 3, t & 7);
    else hi_vt_native(p, (u16*)smem, (t - 2048) >> 2, (t - 2048) & 3);
  }
}

DI void phase2b(const Params& p, unsigned char* smem) {
  unsigned char* ws = p.ws;
  const int tid = VTID;
  {
    pg8::StaticOrder S; S.init(T, 512, (int)gridDim.x, (int)blockIdx.x);
    int kk = 256; asm volatile("" : "+s"(kk));
    pg8::Gemm g{(const u16*)(ws + OFF_CKV), (const u16*)(ws + OFF_WUKV) + (size_t)512 * 256, T, 512, kk};
    EpiV E{(const float*)(ws + OFF_SSQ) + T, (u16*)(ws + OFF_VTT)};
    pg8::gemm_phase<EpiV, pg8::StaticOrder, false, true>((PG8_LAS unsigned char*)smem, g, S, E, nullptr);
  }
  for (int t = VBID; t < 2048; t += VBN) {
    {
      const int idx = t;
      const int bh = idx >> 5, n = (idx & 31) * 4 + (tid >> 6);
      const int lane = tid & 63, r = lane & 31, h = lane >> 5;
      const u16* kn = (const u16*)(ws + OFF_KINV) + ((size_t)(bh >> 3) * 4096 + n * 32) * 512 + (bh & 7) * 64;
      const u16* vt = (const u16*)(ws + OFF_VT) + ((size_t)bh * 128 + n) * 64 * 32;
      bf16x8 a[2][2], bb[2][2];
#pragma unroll
      for (int i = 0; i < 2; ++i)
#pragma unroll
        for (int ks = 0; ks < 2; ++ks) {
          {
            bf16x8 av;
#pragma unroll
            for (int j = 0; j < 8; ++j) av[j] = (short)kn[(size_t)(ks * 16 + h * 8 + j) * 512 + i * 32 + r];
            a[i][ks] = av;
          }
          bb[i][ks] = *(const bf16x8*)(vt + (i * 32 + r) * 32 + ks * 16 + h * 8);
        }
      u16* up = (u16*)(ws + OFF_UPD) + ((size_t)bh * 128 + n) * 4096;
#pragma unroll
      for (int kb = 0; kb < 2; ++kb)
#pragma unroll
        for (int vb = 0; vb < 2; ++vb) {
          f32x16 c = zero16();
          c = MFMA(a[kb][0], bb[vb][0], c);
          c = MFMA(a[kb][1], bb[vb][1], c);
#pragma unroll
          for (int g = 0; g < 4; ++g) {
            u2v o; o.x = pk2(c[4 * g], c[4 * g + 1]); o.y = pk2(c[4 * g + 2], c[4 * g + 3]);
            *(u2v*)(up + (vb * 32 + r) * 64 + kb * 32 + 8 * g + 4 * h) = o;
          }
        }
    }
  }
}

constexpr int KST = 104, VST = 72;
constexpr int ATT_BUF = 64 * KST + 64 * VST;

DI void attn8_item(const Params& p, u16* lds, int bh, int qt) {
  unsigned char* ws = p.ws;
  const int tid = threadIdx.x, lane = tid & 63, w = tid >> 6, r = lane & 31, h = lane >> 5;
  const u16* Qp = (const u16*)(ws + OFF_Q) + (size_t)bh * 4096 * 96;
  const u16* Kp = (const u16*)(ws + OFF_K) + (size_t)bh * 4096 * 96;
  const u16* Vp = (const u16*)(ws + OFF_VTT) + (size_t)bh * 64 * 4096;
  const int q0 = qt * 256 + w * 32;
  bf16x8 qf[6];
#pragma unroll
  for (int ks = 0; ks < 6; ++ks) qf[ks] = *(const bf16x8*)(Qp + (size_t)(q0 + r) * 96 + ks * 16 + h * 8);
  f32x16 o[2]; o[0] = zero16(); o[1] = zero16();
  float mref = 0.f, l = 0.f;
  const int jmax = 4 * qt + 3, jw = 4 * qt + (w >> 1);
  const int kr0 = tid / 12, kc0 = tid % 12, kr1 = (tid + 512) / 12, kc1 = (tid + 512) % 12;
  const bool k1 = tid < 256;
  const int vr = tid >> 3, vc = tid & 7;
  u4v rk0, rk1 = u4v{0u, 0u, 0u, 0u}, rv;
  rk0 = *(const u4v*)(Kp + (size_t)kr0 * 96 + kc0 * 8);
  if (k1) rk1 = *(const u4v*)(Kp + (size_t)kr1 * 96 + kc1 * 8);
  rv = *(const u4v*)(Vp + (size_t)vr * 4096 + vc * 8);
  __syncthreads();
  *(u4v*)(lds + kr0 * KST + kc0 * 8) = rk0;
  if (k1) *(u4v*)(lds + kr1 * KST + kc1 * 8) = rk1;
  *(u4v*)(lds + 64 * KST + vr * VST + vc * 8) = rv;
  __syncthreads();
  for (int j = 0; j <= jmax; ++j) {
    const int cur = j & 1;
    if (j < jmax) {
      rk0 = *(const u4v*)(Kp + (size_t)((j + 1) * 64 + kr0) * 96 + kc0 * 8);
      if (k1) rk1 = *(const u4v*)(Kp + (size_t)((j + 1) * 64 + kr1) * 96 + kc1 * 8);
      rv = *(const u4v*)(Vp + (size_t)vr * 4096 + (j + 1) * 64 + vc * 8);
    }
    if (j <= jw) {
      const u16* sk = lds + cur * ATT_BUF + r * KST + h * 8;
      const u16* sv = lds + cur * ATT_BUF + 64 * KST + r * VST + 4 * h;
      f32x16 st[2];
      const float nm = -mref;
#pragma unroll
      for (int i = 0; i < 16; ++i) { st[0][i] = nm; st[1][i] = nm; }
#pragma unroll
      for (int kb = 0; kb < 2; ++kb)
#pragma unroll
        for (int ks = 0; ks < 6; ++ks) {
          const bf16x8 kf = *(const bf16x8*)(sk + kb * 32 * KST + ks * 16);
          st[kb] = MFMA(kf, qf[ks], st[kb]);
        }
      float mx = st[0][0];
#pragma unroll
      for (int i = 1; i < 16; ++i) mx = fmaxf(mx, st[0][i]);
#pragma unroll
      for (int i = 0; i < 16; ++i) mx = fmaxf(mx, st[1][i]);
      mx = fmaxf(mx, __shfl_xor(mx, 32));
      float psum = 0.f;
      if (j == 0 || __builtin_amdgcn_ballot_w64(mx > 8.f) != 0ull) {
        const float shift = (j == 0) ? mx : fmaxf(mx, 0.f);
        const float alpha = (j == 0) ? 0.f : __builtin_amdgcn_exp2f(-shift);
        mref += shift;
#pragma unroll
        for (int kb = 0; kb < 2; ++kb)
#pragma unroll
          for (int i = 0; i < 16; ++i) { const float pv = __builtin_amdgcn_exp2f(st[kb][i] - shift); st[kb][i] = pv; psum += pv; }
        l = l * alpha + psum;
#pragma unroll
        for (int i = 0; i < 16; ++i) { o[0][i] *= alpha; o[1][i] *= alpha; }
      } else {
#pragma unroll
        for (int kb = 0; kb < 2; ++kb)
#pragma unroll
          for (int i = 0; i < 16; ++i) { const float pv = __builtin_amdgcn_exp2f(st[kb][i]); st[kb][i] = pv; psum += pv; }
        l += psum;
      }
#pragma unroll
      for (int s4 = 0; s4 < 4; ++s4) {
        const int kb = s4 >> 1, rb = 8 * (s4 & 1);
        u4v pu; pu.x = pk2(st[kb][rb], st[kb][rb + 1]); pu.y = pk2(st[kb][rb + 2], st[kb][rb + 3]);
        pu.z = pk2(st[kb][rb + 4], st[kb][rb + 5]); pu.w = pk2(st[kb][rb + 6], st[kb][rb + 7]);
        const bf16x8 pb = __builtin_bit_cast(bf16x8, pu);
#pragma unroll
        for (int db = 0; db < 2; ++db) {
          const s16x4 lo = *(const s16x4*)(sv + db * 32 * VST + 16 * s4);
          const s16x4 hi = *(const s16x4*)(sv + db * 32 * VST + 16 * s4 + 8);
          const bf16x8 vf = __builtin_shufflevector(lo, hi, 0, 1, 2, 3, 4, 5, 6, 7);
          o[db] = MFMA(vf, pb, o[db]);
        }
      }
    }
    if (j < jmax) {
      u16* d = lds + (cur ^ 1) * ATT_BUF;
      *(u4v*)(d + kr0 * KST + kc0 * 8) = rk0;
      if (k1) *(u4v*)(d + kr1 * KST + kc1 * 8) = rk1;
      *(u4v*)(d + 64 * KST + vr * VST + vc * 8) = rv;
    }
    __syncthreads();
  }
  l += __shfl_xor(l, 32);
  const float inv = 1.f / l;
  const int b = bh >> 3, head = bh & 7;
  const size_t tok = (size_t)b * 4096 + q0 + r;
  const u16* sga = (const u16*)(ws + OFF_SGA) + tok * 512 + head * 64;
  u16* ya = (u16*)(ws + OFF_YA) + tok * 512 + head * 64;
#pragma unroll
  for (int db = 0; db < 2; ++db)
#pragma unroll
    for (int g = 0; g < 4; ++g) {
      const int dv0 = db * 32 + 8 * g + 4 * h;
      const u2v gt = *(const u2v*)(sga + dv0);
      u2v ov;
      ov.x = pk2(o[db][4 * g] * inv * bflo(gt.x), o[db][4 * g + 1] * inv * bfhi(gt.x));
      ov.y = pk2(o[db][4 * g + 2] * inv * bflo(gt.y), o[db][4 * g + 3] * inv * bfhi(gt.y));
      *(u2v*)(ya + dv0) = ov;
    }
}

DI void scan_item(const Params& p, int i) {
  unsigned char* ws = p.ws;
  const int tid = threadIdx.x;
  const int bh = i >> 2, part = i & 3;
  const int e = part * 1024 + tid * 2, k = e & 63;
  u32* U = (u32*)((u16*)(ws + OFF_UPD) + (size_t)bh * 128 * 4096 + e);
  const f2v* Dc = (const f2v*)((const float*)(ws + OFF_DECAY) + (size_t)bh * 128 * 64 + k);
  float s0 = 0.f, s1 = 0.f;
  for (int n0 = 0; n0 < 128; n0 += 32) {
    u32 u[32]; f2v d[32];
#pragma unroll
    for (int q = 0; q < 32; ++q) { u[q] = U[(size_t)(n0 + q) * 2048]; d[q] = Dc[(n0 + q) * 32]; }
#pragma unroll
    for (int q = 0; q < 32; ++q) {
      U[(size_t)(n0 + q) * 2048] = pk2(s0, s1);
      s0 = d[q].x * (s0 + bflo(u[q]));
      s1 = d[q].y * (s1 + bfhi(u[q]));
    }
  }
}

DI void phase3(const Params& p, unsigned char* smem, bool dup = false) {
  int* s_item = (int*)(smem + LDS_BYTES - 64);
  int* ctr = (int*)(p.ws + OFF_SSQ + (size_t)3 * T * 4) + (dup ? 1 : 0);
  constexpr int NSCAN = 256, NATT = 1024;
  for (;;) {
    __syncthreads();
    if (threadIdx.x == 0) *s_item = atomicAdd(ctr, 1);
    __syncthreads();
    const int item = *s_item;
    if (item >= NSCAN + NATT) break;
    if (item < NSCAN) { if (!dup) scan_item(p, item); }
    else { const int idx = item - NSCAN; attn8_item(p, (u16*)smem, idx & 63, 15 - (idx >> 6)); }
  }
}

DI void phase4(const Params& p) {
  unsigned char* ws = p.ws;
  const int tid = VTID, lane = tid & 63, w = tid >> 6, r = lane & 31, h = lane >> 5;
  for (int t = VBID; t < 2048; t += VBN) {
    const int bh = t >> 5, n = (t & 31) * 4 + w;
    const int b = bh >> 3, head = bh & 7;
    const size_t tok0 = (size_t)b * 4096 + n * 32;
    const u16* qd = (const u16*)(ws + OFF_QDEC) + (tok0 + r) * 512 + head * 64 + h * 8;
    const u16* ki = (const u16*)(ws + OFF_KINV) + (tok0 + r) * 512 + head * 64 + h * 8;
    const u16* vt = (const u16*)(ws + OFF_VT) + ((size_t)bh * 128 + n) * 64 * 32;
    const u16* sp = (const u16*)(ws + OFF_UPD) + ((size_t)bh * 128 + n) * 4096;
    bf16x8 qf[4], kf[4];
#pragma unroll
    for (int ks = 0; ks < 4; ++ks) { qf[ks] = *(const bf16x8*)(qd + ks * 16); kf[ks] = *(const bf16x8*)(ki + ks * 16); }
    f32x16 at = zero16();
#pragma unroll
    for (int ks = 0; ks < 4; ++ks) at = MFMA(kf[ks], qf[ks], at);
#pragma unroll
    for (int i = 0; i < 16; ++i) if (crow(i, h) > r) at[i] = 0.f;
    f32x16 o[2]; o[0] = zero16(); o[1] = zero16();
#pragma unroll
    for (int s2 = 0; s2 < 2; ++s2) {
      u4v pu; pu.x = pk2(at[8 * s2], at[8 * s2 + 1]); pu.y = pk2(at[8 * s2 + 2], at[8 * s2 + 3]);
      pu.z = pk2(at[8 * s2 + 4], at[8 * s2 + 5]); pu.w = pk2(at[8 * s2 + 6], at[8 * s2 + 7]);
      const bf16x8 pb = __builtin_bit_cast(bf16x8, pu);
#pragma unroll
      for (int vb = 0; vb < 2; ++vb) {
        const s16x4 lo = *(const s16x4*)(vt + (vb * 32 + r) * 32 + 16 * s2 + 4 * h);
        const s16x4 hi = *(const s16x4*)(vt + (vb * 32 + r) * 32 + 16 * s2 + 8 + 4 * h);
        const bf16x8 vf = __builtin_shufflevector(lo, hi, 0, 1, 2, 3, 4, 5, 6, 7);
        o[vb] = MFMA(vf, pb, o[vb]);
      }
    }
#pragma unroll
    for (int vb = 0; vb < 2; ++vb)
#pragma unroll
      for (int ks = 0; ks < 4; ++ks) {
        const bf16x8 sf = *(const bf16x8*)(sp + (vb * 32 + r) * 64 + ks * 16 + h * 8);
        o[vb] = MFMA(sf, qf[ks], o[vb]);
      }
    float ss = 0.f;
#pragma unroll
    for (int i = 0; i < 16; ++i) ss += o[0][i] * o[0][i] + o[1][i] * o[1][i];
    ss += __shfl_xor(ss, 32);
    const float rs = rsqrtf(ss * (1.f / 64.f) + EPS);
    const u16* sgb = (const u16*)(ws + OFF_SGB) + (tok0 + r) * 512 + head * 64;
    u16* yb = (u16*)(ws + OFF_YB) + (tok0 + r) * 512 + head * 64;
#pragma unroll
    for (int vb = 0; vb < 2; ++vb)
#pragma unroll
      for (int g = 0; g < 4; ++g) {
        const int v0 = vb * 32 + 8 * g + 4 * h;
        const u2v gt = *(const u2v*)(sgb + v0);
        u2v ov;
        ov.x = pk2(o[vb][4 * g] * rs * bflo(gt.x), o[vb][4 * g + 1] * rs * bfhi(gt.x));
        ov.y = pk2(o[vb][4 * g + 2] * rs * bflo(gt.y), o[vb][4 * g + 3] * rs * bfhi(gt.y));
        *(u2v*)(yb + v0) = ov;
      }
  }
}

DI void phase5(const Params& p, unsigned char* smem) {
  unsigned char* ws = p.ws;
  pg8::StaticOrder S; S.init(T, 1024, (int)gridDim.x, (int)blockIdx.x);
  {
    pg8::Gemm g{(const u16*)(ws + OFF_YA), (const u16*)(ws + OFF_WA), T, 1024, 512};
    Epi5<false> E{(const u16*)p.out, (u16*)(ws + OFF_H), (u16*)(ws + OFF_M)};
    pg8::gemm_phase<Epi5<false>, pg8::StaticOrder, false>((PG8_LAS unsigned char*)smem, g, S, E, nullptr);
  }
  {
    pg8::Gemm g{(const u16*)(ws + OFF_YB), (const u16*)(ws + OFF_WB), T, 1024, 512};
    Epi5<true> E{(const u16*)p.out, (u16*)(ws + OFF_H), (u16*)(ws + OFF_M)};
    pg8::gemm_phase<Epi5<true>, pg8::StaticOrder, false>((PG8_LAS unsigned char*)smem, g, S, E, nullptr);
  }
}

DI void phase6(const Params& p, unsigned char* smem, bool dup = false) {
  unsigned char* ws = p.ws;
  pg8::Gemm g{(const u16*)(ws + OFF_M), (const u16*)(ws + OFF_WO), T, 1024, 1024};
  pg8::StaticOrder S; S.init(T, 1024, (int)gridDim.x, (int)blockIdx.x);
  Epi6 E{p.out, (float*)(ws + OFF_SSQ) + 2 * T, dup};
  pg8::gemm_phase<Epi6, pg8::StaticOrder, false>((PG8_LAS unsigned char*)smem, g, S, E, nullptr);
}

DI void phase7(const Params& p) {
  const float* ssq_y = (const float*)(p.ws + OFF_SSQ) + 2 * T;
  const int gtid = blockIdx.x * blockDim.x + threadIdx.x, gthreads = gridDim.x * blockDim.x;
  for (int i = gtid; i < T * 256; i += gthreads) {
    const int row = i >> 8, c4 = i & 255;
    const float rs = rsqrtf(ssq_y[row] * (1.f / 1024.f) + EPS);
    const f4v y = ((const f4v*)p.out)[i];
    const f4v xv = ((const f4v*)p.x)[i];
    const f4v g = ((const f4v*)p.g_post)[c4];
    f4v o;
    o.x = xv.x + y.x * rs * g.x; o.y = xv.y + y.y * rs * g.y; o.z = xv.z + y.z * rs * g.z; o.w = xv.w + y.w * rs * g.w;
    ((f4v*)p.out)[i] = o;
  }
}

__global__ void __launch_bounds__(512, 2) fwd_megakernel(Params p) {
  extern __shared__ __attribute__((aligned(16))) unsigned char smem[];
  u16* lds = (u16*)(smem + (threadIdx.x >> 8) * VLDS);
  cg::grid_group grid = cg::this_grid();
  volatile LAS unsigned* xst = (volatile LAS unsigned*)(smem + LDS_BYTES - 48);
  if (threadIdx.x == 0) { xst[0] = 0u; xst[1] = 0u; }
  __syncthreads();
  XcdBarrier xb = xcd_barrier_post((unsigned*)(p.ws + OFF_BAR), xst);
  if (p.ph_hi > 1000) grid.sync();
#define RUN_PHASE(N, CALL) if (p.ph_lo <= N && N < p.ph_hi) { if (N > p.ph_lo) xcd_barrier(xb); CALL; }
#define DUP_PHASE(N, CALL) if (DUP_PH == N) { xcd_barrier(xb); CALL; }
  RUN_PHASE(0, phase0(p))
  DUP_PHASE(0, phase0(p))
  if (p.ph_lo <= 1 && 1 < p.ph_hi) for (int rep = 0; rep < (DUP_PH == 1 ? 2 : 1); ++rep) { if (rep > 0 || 1 > p.ph_lo) xcd_barrier(xb); phase1(p, smem, rep > 0); }
  if (p.ph_lo <= 2 && 2 < p.ph_hi) for (int rep = 0; rep < (DUP_PH == 2 ? 2 : 1); ++rep) { if (rep > 0 || 2 > p.ph_lo) xcd_barrier(xb); phase2(p, smem, lds); }
  RUN_PHASE(3, phase2b(p, smem))
  DUP_PHASE(3, phase2b(p, smem))
  RUN_PHASE(4, phase3(p, smem))
  DUP_PHASE(4, phase3(p, smem, true))
  RUN_PHASE(5, phase4(p))
  DUP_PHASE(5, phase4(p))
  RUN_PHASE(6, phase5(p, smem))
  DUP_PHASE(6, phase5(p, smem))
  RUN_PHASE(7, phase6(p, smem))
  DUP_PHASE(7, phase6(p, smem, true))
  RUN_PHASE(8, phase7(p))
}

extern "C" void kernel_launch(void* const* d_in, const int* in_sizes, int n_in, void* d_out, int out_size, void* d_ws, size_t ws_size,
                              hipStream_t stream) {
  static int grid_blocks = 0;
  if (!grid_blocks) {
    int dev = 0, cus = 0, per_cu = 0;
    hipGetDevice(&dev);
    hipDeviceGetAttribute(&cus, hipDeviceAttributeMultiprocessorCount, dev);
    hipFuncSetAttribute((const void*)fwd_megakernel, hipFuncAttributeMaxDynamicSharedMemorySize, LDS_BYTES);
    hipOccupancyMaxActiveBlocksPerMultiprocessor(&per_cu, (const void*)fwd_megakernel, 512, LDS_BYTES);
    if (per_cu < 1) per_cu = 1;
    if (per_cu > 1) per_cu = 1;
    grid_blocks = cus * per_cu;
    if (ws_size < WS_NEED) fprintf(stderr, "kernel_launch: workspace too small: %zu < %zu\n", ws_size, (size_t)WS_NEED);
  }
  if (ws_size < WS_NEED) return;
  Params p{};
  p.x = (const float*)d_in[0]; p.g_pre = (const float*)d_in[1]; p.w_in = (const float*)d_in[2]; p.b_gate = (const float*)d_in[3];
  p.g_q = (const float*)d_in[4]; p.w_uq = (const float*)d_in[5]; p.g_kv = (const float*)d_in[6]; p.w_ukv = (const float*)d_in[7];
  p.lb_logits = (const float*)d_in[8]; p.g_hgrn = (const float*)d_in[9]; p.w_a = (const float*)d_in[10]; p.w_b = (const float*)d_in[11];
  p.w_out = (const float*)d_in[12]; p.g_post = (const float*)d_in[13];
  p.out = (float*)d_out; p.ws = (unsigned char*)d_ws;
#if ONE_LAUNCH
  p.ph_lo = 0; p.ph_hi = 9;
  (void)hipMemsetAsync((unsigned char*)d_ws + OFF_BAR, 0, 16384, stream);
  void* args[] = {&p};
  hipError_t e = hipLaunchCooperativeKernel((const void*)fwd_megakernel, dim3(grid_blocks), dim3(512), args, LDS_BYTES, stream);
  if (e != hipSuccess) fprintf(stderr, "cooperative launch failed: %s (grid %d)\n", hipGetErrorString(e), grid_blocks);
#else
  for (int ph = 0; ph < 9; ++ph) {
    p.ph_lo = ph; p.ph_hi = ph + 1;
    (void)hipMemsetAsync((unsigned char*)d_ws + OFF_BAR, 0, 16384, stream);
    void* args[] = {&p};
    hipError_t e = hipLaunchCooperativeKernel((const void*)fwd_megakernel, dim3(grid_blocks), dim3(512), args, LDS_BYTES, stream);
    if (e != hipSuccess) fprintf(stderr, "cooperative launch failed: %s (grid %d)\n", hipGetErrorString(e), grid_blocks);
  }
#endif
}
```

```cpp
#include <hip/hip_runtime.h>
#include <hip/hip_cooperative_groups.h>
#include <cstdio>
namespace cg = cooperative_groups;

#define DI __device__ __forceinline__
#define VTID ((int)(threadIdx.x & 255))
#define VBID ((int)(blockIdx.x * 2 + (threadIdx.x >> 8)))
#define VBN ((int)(gridDim.x * 2))
typedef unsigned short u16;
typedef unsigned int u32;
typedef __attribute__((ext_vector_type(8))) short bf16x8;
typedef __attribute__((ext_vector_type(4))) short s16x4;
typedef __attribute__((ext_vector_type(16))) float f32x16;
typedef __attribute__((ext_vector_type(2))) __bf16 bf2_t;
typedef __attribute__((ext_vector_type(2))) float f2_t;
typedef __attribute__((ext_vector_type(4))) unsigned int u4v;
typedef __attribute__((ext_vector_type(2))) unsigned int u2v;
typedef __attribute__((ext_vector_type(4))) float f4v;
typedef __attribute__((ext_vector_type(2))) float f2v;
#define MFMA(a, b, c) __builtin_amdgcn_mfma_f32_32x32x16_bf16((a), (b), (c), 0, 0, 0)

#ifndef DUP_PH
#define DUP_PH -1
#endif
#ifndef ONE_LAUNCH
#define ONE_LAUNCH 1
#endif

constexpr int T = 32768;
constexpr int SEQ = 4096;
constexpr int DIN = 5664;
constexpr int NP = 5888;
constexpr float EPS = 1e-6f;
constexpr float QSCALE = 1.4426950408889634f * 0.10206207261596575f;

constexpr size_t SZ_WIN = (size_t)NP * 1024 * 2;
constexpr size_t OFF_WIN = 0;
constexpr size_t OFF_WUQ = OFF_WIN + SZ_WIN;
constexpr size_t OFF_WUKV = OFF_WUQ + (size_t)768 * 768 * 2;
constexpr size_t OFF_WA = OFF_WUKV + (size_t)1024 * 256 * 2;
constexpr size_t OFF_WB = OFF_WA + (size_t)1024 * 512 * 2;
constexpr size_t OFF_WO = OFF_WB + (size_t)1024 * 512 * 2;
constexpr size_t OFF_ROPE = OFF_WO + (size_t)1024 * 1024 * 2;
constexpr size_t OFF_SSQ = OFF_ROPE + (size_t)4096 * 16 * 2 * 4;
constexpr size_t OFF_DECAY = OFF_SSQ + (size_t)(3 * T + 64) * 4;
constexpr size_t OFF_H = OFF_DECAY + (size_t)64 * 128 * 64 * 4;
constexpr size_t OFF_Q = OFF_H;
constexpr size_t OFF_CQ = OFF_H + (size_t)T * 1024 * 2;
constexpr size_t OFF_YA = OFF_CQ;
constexpr size_t OFF_CKV = OFF_CQ + (size_t)T * 768 * 2;
constexpr size_t OFF_KPE = OFF_CKV + (size_t)T * 256 * 2;
constexpr size_t OFF_SGA = OFF_KPE + (size_t)T * 32 * 4;
constexpr size_t OFF_SGB = OFF_SGA + (size_t)T * 512 * 2;
constexpr size_t OFF_HQ = OFF_SGB + (size_t)T * 512 * 2;
constexpr size_t OFF_UPD = OFF_HQ;
constexpr size_t OFF_HF = OFF_HQ + (size_t)T * 512 * 2;
constexpr size_t OFF_HI = OFF_HF + (size_t)T * 512 * 2;
constexpr size_t OFF_YB = OFF_HI;
constexpr size_t OFF_QDEC = OFF_HI + (size_t)T * 512 * 2;
constexpr size_t OFF_KINV = OFF_QDEC + (size_t)T * 512 * 2;
constexpr size_t OFF_VT = OFF_KINV + (size_t)T * 512 * 2;
constexpr size_t OFF_K = OFF_VT + (size_t)T * 512 * 2;
constexpr size_t OFF_M = OFF_K;
constexpr size_t OFF_VTT = OFF_K + (size_t)T * 768 * 2;
constexpr size_t OFF_BAR = OFF_VTT + (size_t)T * 512 * 2;
constexpr size_t WS_NEED = OFF_BAR + 16384;

constexpr int VLDS = 2 * 2 * 128 * 72 * 2;
constexpr int LDS_BYTES = 2 * VLDS + 64;
constexpr int SST = 132;

struct Params {
  const float *x, *g_pre, *w_in, *b_gate, *g_q, *w_uq, *g_kv, *w_ukv, *lb_logits, *g_hgrn, *w_a, *w_b, *w_out, *g_post;
  float* out;
  unsigned char* ws;
  int ph_lo, ph_hi;
};

DI u32 pk2(float a, float b) { f2_t v = {a, b}; bf2_t r = __builtin_convertvector(v, bf2_t); return __builtin_bit_cast(u32, r); }
DI float bflo(u32 u) { return __uint_as_float(u << 16); }
DI float bfhi(u32 u) { return __uint_as_float(u & 0xffff0000u); }
DI u4v pk8(f4v a, f4v b) { u4v r; r.x = pk2(a.x, a.y); r.y = pk2(a.z, a.w); r.z = pk2(b.x, b.y); r.w = pk2(b.z, b.w); return r; }
DI float rcpf(float x) { return __builtin_amdgcn_rcpf(x); }
DI float sigmoidf_(float x) { return rcpf(1.f + __expf(-x)); }
DI float siluf_(float x) { return x * sigmoidf_(x); }
DI float xor32_max(float x) { const unsigned u = __float_as_uint(x); auto r = __builtin_amdgcn_permlane32_swap(u, u, false, false); return fmaxf(__uint_as_float(r[0]), __uint_as_float(r[1])); }
DI float xor32_add(float x) { const unsigned u = __float_as_uint(x); auto r = __builtin_amdgcn_permlane32_swap(u, u, false, false); return __uint_as_float(r[0]) + __uint_as_float(r[1]); }
DI float xor16_add(float x) { const unsigned u = __float_as_uint(x); auto r = __builtin_amdgcn_permlane16_swap(u, u, false, false); return __uint_as_float(r[0]) + __uint_as_float(r[1]); }
DI int crow(int reg, int h) { return (reg & 3) + 8 * (reg >> 2) + 4 * h; }
DI f32x16 zero16() { f32x16 z;
#pragma unroll
  for (int i = 0; i < 16; ++i) z[i] = 0.f; return z; }

__constant__ float c_invfreq[16] = {1.0f, 0.5623413324356079f, 0.3162277638912201f, 0.17782793939113617f, 0.10000000149011612f,
  0.05623413249850273f, 0.03162277489900589f, 0.017782794311642647f, 0.009999999776482582f, 0.005623413249850273f,
  0.003162277629598975f, 0.0017782794311642647f, 0.0010000000474974513f, 0.000562341301701963f, 0.0003162277571391314f,
  0.00017782794020604342f};

DI void sincos_d(double a, float& sn, float& cs) {
  const double k = rint(a * 0.63661977236758134308);
  const double y = a - k * 1.57079632679489661923;
  const double y2 = y * y;
  const double s = y * (1.0 + y2 * (-1.0 / 6 + y2 * (1.0 / 120 + y2 * (-1.0 / 5040 + y2 * (1.0 / 362880 + y2 * (-1.0 / 39916800 + y2 * (1.0 / 6227020800.0)))))));
  const double c = 1.0 + y2 * (-0.5 + y2 * (1.0 / 24 + y2 * (-1.0 / 720 + y2 * (1.0 / 40320 + y2 * (-1.0 / 3628800 + y2 * (1.0 / 479001600.0 + y2 * (-1.0 / 87178291200.0)))))));
  const int q = ((int)k) & 3;
  const double ss = (q == 0) ? s : (q == 1) ? c : (q == 2) ? -s : -c;
  const double cc = (q == 0) ? c : (q == 1) ? -s : (q == 2) ? -c : s;
  sn = (float)ss; cs = (float)cc;
}

#define XB_TMO      128
#define XB_XCNT(j)  (256  + 64 * (j))
#define XB_XSUB(j)  (1280 + 64 * (j))
#define XB_XGEN(j)  (2304 + 64 * (j))
#define XB_TOP      3328
#define XB_TOPGEN   3392
#define XCD_BAR_WORDS 3456
#define XB_SPIN_CAP (1u << 22)
#define LAS __attribute__((address_space(3)))
DI unsigned xb_ld(unsigned* p)              { return __hip_atomic_load(p, __ATOMIC_RELAXED, __HIP_MEMORY_SCOPE_AGENT); }
DI unsigned xb_add(unsigned* p, unsigned v) { return __hip_atomic_fetch_add(p, v, __ATOMIC_RELAXED, __HIP_MEMORY_SCOPE_AGENT); }
DI unsigned xb_xcc_id() { return (unsigned)__builtin_amdgcn_s_getreg((3 << 11) | 20) & 0xFu; }
#define XB_SPIN(cond, bar) do { unsigned _sp = 0; while (cond) { __builtin_amdgcn_s_sleep(1); \
    if ((++_sp & 255u) == 0u) { if (xb_ld(&(bar)[XB_TMO])) break; if (_sp > XB_SPIN_CAP) { atomicAdd(&(bar)[XB_TMO], 1u); break; } } } } while (0)
struct XcdBarrier { unsigned* bar; unsigned x; volatile LAS unsigned* st; };
DI XcdBarrier xcd_barrier_post(unsigned* bar, volatile LAS unsigned* st) {
  XcdBarrier b; b.bar = bar; b.x = xb_xcc_id(); b.st = st;
  if (threadIdx.x == 0) (void)xb_add(&bar[XB_XCNT(b.x)], 1u);
  return b;
}
DI void xcd_barrier_complete(unsigned* bar, unsigned x, unsigned& nloc, unsigned& nx) {
  const unsigned G = gridDim.x * gridDim.y * gridDim.z;
  unsigned sum, cnt, mine, sp = 0u;
  for (;;) {
    sum = 0u; cnt = 0u; mine = 0u;
#pragma unroll
    for (unsigned j = 0; j < 16; ++j) { const unsigned c = xb_ld(&bar[XB_XCNT(j)]); sum += c; cnt += (c > 0u) ? 1u : 0u; mine = (j == x) ? c : mine; }
    if (sum == G) break;
    __builtin_amdgcn_s_sleep(1);
    if ((++sp & 255u) == 0u) { if (xb_ld(&bar[XB_TMO])) break; if (sp > XB_SPIN_CAP) { atomicAdd(&bar[XB_TMO], 1u); break; } }
  }
  nloc = mine > 0u ? mine : 1u; nx = cnt > 0u ? cnt : 1u;
}
DI void xcd_barrier(const XcdBarrier& b) {
  asm volatile("s_waitcnt vmcnt(0)" ::: "memory");
  __syncthreads();
  if (threadIdx.x == 0) {
    unsigned* bar = b.bar;
    __builtin_amdgcn_s_waitcnt(0);
    unsigned nloc = b.st[0], nx = b.st[1];
    if (nloc == 0u) { xcd_barrier_complete(bar, b.x, nloc, nx); b.st[0] = nloc; b.st[1] = nx; }
    const unsigned old = xb_add(&bar[XB_XSUB(b.x)], 1u);
    const unsigned gen = old / nloc;
    if (old + 1u == (gen + 1u) * nloc) {
      __builtin_amdgcn_fence(__ATOMIC_RELEASE, "agent");
      asm volatile("s_waitcnt vmcnt(0)" ::: "memory");
      const unsigned og = xb_add(&bar[XB_TOP], 1u);
      const unsigned tg = og / nx;
      if (og + 1u == (tg + 1u) * nx) xb_add(&bar[XB_TOPGEN], 1u);
      else XB_SPIN(xb_ld(&bar[XB_TOPGEN]) == tg, bar);
      __builtin_amdgcn_fence(__ATOMIC_ACQUIRE, "agent");
      xb_add(&bar[XB_XGEN(b.x)], 1u);
      asm volatile("s_waitcnt vmcnt(0)" ::: "memory");
    } else {
      XB_SPIN(xb_ld(&bar[XB_XGEN(b.x)]) == gen, bar);
      __builtin_amdgcn_fence(__ATOMIC_ACQUIRE, "agent");
      asm volatile("s_waitcnt vmcnt(0)" ::: "memory");
    }
  }
  __syncthreads();
}

template <int KIND>
DI int colmap(int n) {
  if (KIND == 0) {
    if (n < 1024) return n;
    if (n < 1536) return 1056 + (n - 1024);
    if (n < 2048) return 3104 + (n - 1536);
    if (n < 4096) return 3616 + (n - 2048);
    if (n < 4608) return 1568 + (n - 4096);
    if (n < 5120) return 2080 + (n - 4608);
    if (n < 5632) return 2592 + (n - 5120);
    if (n < 5664) return 1024 + (n - 5632);
    return -1;
  } else if (KIND == 1) {
    if (n < 512) return (n >> 6) * 96 + (n & 63);
    int i = n - 512; int w = i & 31, g = w >> 3, e = w & 7; return (i >> 5) * 96 + 64 + ((e < 4) ? (4 * g + e) : (16 + 4 * g + (e - 4)));
  } else if (KIND == 3) {
    if (n < 512) return (n >> 6) * 128 + (n & 63);
    int i = n - 512; return (i >> 6) * 128 + 64 + (i & 63);
  } else return n;
}
template <int KIND>
DI void conv_weight(u16* dst, const float* src, int ldw, int ncount, int K, const float* gain, int gmask, int gtid, int gthreads) {
  const int total = ncount * (K >> 3);
  for (int it = gtid; it < total; it += gthreads) {
    const int n = it % ncount, kc = it / ncount;
    const int sc = colmap<KIND>(n);
    float v[8];
#pragma unroll
    for (int i = 0; i < 8; ++i) {
      const int k = kc * 8 + i;
      float x = (sc >= 0) ? src[(size_t)k * ldw + sc] : 0.f;
      if (gain) x *= gain[k & gmask];
      v[i] = x;
    }
    u4v o; o.x = pk2(v[0], v[1]); o.y = pk2(v[2], v[3]); o.z = pk2(v[4], v[5]); o.w = pk2(v[6], v[7]);
    *(u4v*)(dst + (size_t)n * K + kc * 8) = o;
  }
}

DI void phase0(const Params& p) {
  unsigned char* ws = p.ws;
  const int gtid = blockIdx.x * blockDim.x + threadIdx.x, gthreads = gridDim.x * blockDim.x;
  float* ssq = (float*)(ws + OFF_SSQ);
  for (int i = gtid; i < 3 * T + 64; i += gthreads) ssq[i] = 0.f;
  float* rope = (float*)(ws + OFF_ROPE);
  for (int i = gtid; i < 4096 * 16; i += gthreads) {
    const int pos = i >> 4, j = i & 15;
    const float ang = (float)pos * c_invfreq[j];
    float sn, cs; sincos_d((double)ang, sn, cs);
    rope[i] = cs; rope[65536 + i] = sn;
  }
  conv_weight<0>((u16*)(ws + OFF_WIN), p.w_in, DIN, NP, 1024, nullptr, 0, gtid, gthreads);
  conv_weight<1>((u16*)(ws + OFF_WUQ), p.w_uq, 768, 768, 768, p.g_q, 1023, gtid, gthreads);
  conv_weight<3>((u16*)(ws + OFF_WUKV), p.w_ukv, 1024, 1024, 256, p.g_kv, 255, gtid, gthreads);
  conv_weight<2>((u16*)(ws + OFF_WA), p.w_a, 1024, 1024, 512, nullptr, 0, gtid, gthreads);
  conv_weight<2>((u16*)(ws + OFF_WB), p.w_b, 1024, 1024, 512, p.g_hgrn, 63, gtid, gthreads);
  conv_weight<2>((u16*)(ws + OFF_WO), p.w_out, 1024, 1024, 1024, nullptr, 0, gtid, gthreads);
  u16* H = (u16*)(ws + OFF_H);
  const int lane = threadIdx.x & 63;
  const int gw = gtid >> 6, nw = gthreads >> 6;
  for (int row = gw; row < T; row += nw) {
    const f4v* xr = (const f4v*)(p.x + (size_t)row * 1024);
    f4v v[4];
    float ss = 0.f;
#pragma unroll
    for (int i = 0; i < 4; ++i) { v[i] = xr[lane * 4 + i]; ss += v[i].x * v[i].x + v[i].y * v[i].y + v[i].z * v[i].z + v[i].w * v[i].w; }
#pragma unroll
    for (int o = 32; o >= 1; o >>= 1) ss += __shfl_xor(ss, o);
    const float rs = rsqrtf(ss * (1.f / 1024.f) + EPS);
    const f4v* gp = (const f4v*)(p.g_pre);
    f4v g[4];
#pragma unroll
    for (int i = 0; i < 4; ++i) { g[i] = gp[lane * 4 + i]; v[i].x *= rs * g[i].x; v[i].y *= rs * g[i].y; v[i].z *= rs * g[i].z; v[i].w *= rs * g[i].w; }
    u4v* hr = (u4v*)(H + (size_t)row * 1024 + lane * 16);
    hr[0] = pk8(v[0], v[1]); hr[1] = pk8(v[2], v[3]);
  }
}

constexpr int TS = 128 * 72;
DI void gemm_ld(u4v (&ra)[4], u4v (&rb)[4], const u16* ga, const u16* gb, int lda, int ldb, int ko) {
#pragma unroll
  for (int i = 0; i < 4; ++i) { ra[i] = *(const u4v*)(ga + (size_t)(32 * i) * lda + ko); rb[i] = *(const u4v*)(gb + (size_t)(32 * i) * ldb + ko); }
}
DI void gemm_st(const u4v (&ra)[4], const u4v (&rb)[4], u16* buf, int lr, int lc) {
  u16* sa = buf; u16* sb = buf + TS;
#pragma unroll
  for (int i = 0; i < 4; ++i) { *(u4v*)(sa + (lr + 32 * i) * 72 + lc * 8) = ra[i]; *(u4v*)(sb + (lr + 32 * i) * 72 + lc * 8) = rb[i]; }
}
DI void gemm_mma(const u16* buf, f32x16 (&acc)[2][2], int wm, int wn, int r, int h) {
  const u16* sa = buf + (wm * 64 + r) * 72 + h * 8;
  const u16* sb = buf + TS + (wn * 64 + r) * 72 + h * 8;
#pragma unroll
  for (int ks = 0; ks < 4; ++ks) {
    const bf16x8 a0 = *(const bf16x8*)(sa + ks * 16);
    const bf16x8 a1 = *(const bf16x8*)(sa + 32 * 72 + ks * 16);
    const bf16x8 b0 = *(const bf16x8*)(sb + ks * 16);
    const bf16x8 b1 = *(const bf16x8*)(sb + 32 * 72 + ks * 16);
    acc[0][0] = MFMA(a0, b0, acc[0][0]);
    acc[0][1] = MFMA(a0, b1, acc[0][1]);
    acc[1][0] = MFMA(a1, b0, acc[1][0]);
    acc[1][1] = MFMA(a1, b1, acc[1][1]);
  }
}
DI void gemm_core(const u16* __restrict__ A, int lda, const u16* __restrict__ B, int ldb, int K, u16* lds, f32x16 (&acc)[2][2], int tid) {
  const int lane = tid & 63, w = tid >> 6, wm = w >> 1, wn = w & 1, r = lane & 31, h = lane >> 5;
  const int lc = tid & 7, lr = tid >> 3;
  const u16* ga = A + (size_t)lr * lda + lc * 8;
  const u16* gb = B + (size_t)lr * ldb + lc * 8;
  u4v ra0[4], rb0[4], ra1[4], rb1[4];
  gemm_ld(ra0, rb0, ga, gb, lda, ldb, 0);
  gemm_ld(ra1, rb1, ga, gb, lda, ldb, 64);
#pragma unroll
  for (int i = 0; i < 2; ++i)
#pragma unroll
    for (int j = 0; j < 2; ++j) acc[i][j] = zero16();
  u16* L0 = lds; u16* L1 = lds + 2 * TS;
  __syncthreads();
  gemm_st(ra0, rb0, L0, lr, lc);
  __syncthreads();
  const int nk = K >> 6;
  int kt = 0;
  for (; kt + 2 < nk; kt += 2) {
    gemm_ld(ra0, rb0, ga, gb, lda, ldb, (kt + 2) * 64);
    __builtin_amdgcn_sched_barrier(0);
    gemm_mma(L0, acc, wm, wn, r, h);
    gemm_st(ra1, rb1, L1, lr, lc);
    __syncthreads();
    gemm_ld(ra1, rb1, ga, gb, lda, ldb, (kt + 3) * 64);
    __builtin_amdgcn_sched_barrier(0);
    gemm_mma(L1, acc, wm, wn, r, h);
    gemm_st(ra0, rb0, L0, lr, lc);
    __syncthreads();
  }
  gemm_mma(L0, acc, wm, wn, r, h);
  gemm_st(ra1, rb1, L1, lr, lc);
  __syncthreads();
  gemm_mma(L1, acc, wm, wn, r, h);
  __syncthreads();
}

DI void stage_pass(const f32x16 (&acc)[2][2], float* stage, int p, int tid) {
  const int lane = tid & 63, w = tid >> 6, wm = w >> 1, wn = w & 1, r = lane & 31, h = lane >> 5;
  __syncthreads();
  if (wm == p) {
#pragma unroll
    for (int i = 0; i < 2; ++i)
#pragma unroll
      for (int j = 0; j < 2; ++j)
#pragma unroll
        for (int reg = 0; reg < 16; ++reg) stage[(i * 32 + crow(reg, h)) * SST + wn * 64 + j * 32 + r] = acc[i][j][reg];
  }
  __syncthreads();
}

namespace pg8 {
#define PG8_LAS __attribute__((address_space(3)))
typedef unsigned short bf16_t;
typedef short bf16x8 __attribute__((ext_vector_type(8)));
typedef float f32x4 __attribute__((ext_vector_type(4)));
typedef unsigned u32x4 __attribute__((ext_vector_type(4)));
constexpr int BM = 256, BK = 64, HALF = 128, HTB = HALF * BK * 2  , STAGE_BYTES = 8 * HTB, NXCD = 8, WGM = 8;

__host__ __device__ __forceinline__ int lds_byte(int r, int c) { const int st = (r >> 4) * 2 + (c >> 5), rr = r & 15, cc = c & 31, ob = rr * 64 + cc * 2; return st * 1024 + (ob ^ (((ob >> 9) & 1) << 5)); }
__host__ __device__ __forceinline__ void stage_rc(int b, int& R, int& C) { const int st = b / 1024, sb = b % 1024, swz = sb ^ (((sb >> 9) & 1) << 5); R = (st >> 1) * 16 + swz / 64; C = (st & 1) * 32 + (swz % 64) / 2; }
__host__ __device__ __forceinline__ int perm32(int rho) { const int n = rho >> 4, i = rho & 15; return 8 * (i >> 2) + 4 * n + (i & 3); }

struct Unit { int pm, pn; };
struct Gemm { const bf16_t* A; const bf16_t* Bt; int M, N, K; };

struct StaticOrder {
    int nM, nN, nwg, G, c;
    __host__ __device__ void init(int M, int N, int G_, int c_) { nM = M / BM; nN = N / BM; nwg = nM * nN; G = G_; c = c_; }
    __host__ __device__ bool next(int i, Unit& u) const {
        const long L = (long)i * G + c; if (L >= nwg) return false;
        int wgid = (int)L; { const int q = nwg / NXCD, r = nwg % NXCD, xcd = wgid % NXCD, off = wgid / NXCD; wgid = (xcd < r ? xcd * (q + 1) : r * (q + 1) + (xcd - r) * q) + off; }
        const int nig = WGM * nN, gid = wgid / nig, fm = gid * WGM, gsz = (nM - fm) < WGM ? (nM - fm) : WGM;
        u.pm = fm + ((wgid % nig) % gsz); u.pn = (wgid % nig) / gsz; return true;
    }
    __device__ __forceinline__ void a_ready(const Unit&) const {}
    __device__ __forceinline__ void done(const Unit&) const {}
};
template <class Epi, class Sched, bool STAMP = false, bool SWAP = false>
__device__ __forceinline__ void gemm_phase(PG8_LAS unsigned char* lds, const Gemm g, const Sched& S, const Epi& E, unsigned long long* stamps) {
    const int tid = threadIdx.x, wid = __builtin_amdgcn_readfirstlane(tid >> 6), lane = tid & 63, wr = wid >> 2, wc = wid & 3, fr = lane & 15, fq = lane >> 4;
    const int K = g.K, nt = K / BK;
    int ts_lo = 0, ts_hi = 0, nts = 0; const unsigned long long rt_entry = STAMP ? (unsigned long long)wall_clock64() : 0ull;
#define PG8_STAMP() do { if (STAMP && wid == 0 && nts < 64) { const unsigned long long _c = (unsigned long long)clock64(); \
        ts_lo = (lane == nts) ? (int)(unsigned)_c : ts_lo; ts_hi = (lane == nts) ? (int)(unsigned)(_c >> 32) : ts_hi; ++nts; } } while (0)
    PG8_STAMP();
    unsigned voffA[2], voffB[2];
#pragma unroll
    for (int i = 0; i < 2; ++i) { int R, C; stage_rc(tid * 16 + i * 8192, R, C); const int Rb = Epi::PERM ? ((R & ~31) + perm32(R & 31)) : R;
        voffA[i] = (unsigned)(R * K + C) * 2u; voffB[i] = (unsigned)(Rb * K + C) * 2u; }
    const size_t kstep = (size_t)(BK * 2);
    const size_t hstep = (size_t)HALF * K * 2;
    const size_t tstep = 2 * hstep;
    const unsigned ldsw = (unsigned)wid * 1024u;
    const int aoff = lds_byte(wr * 64 + fr, fq * 8), boff = lds_byte(wc * 32 + fr, fq * 8);
#define PG8_SA(b, h) (((b) * 2 + (h)) * HTB)
#define PG8_SB(b, h) ((4 + (b) * 2 + (h)) * HTB)
#define PG8_STAGE(bufoff, gbase, voff) do { _Pragma("unroll") for (int _i = 0; _i < 2; ++_i) \
        __builtin_amdgcn_global_load_lds((const unsigned*)((const char*)(gbase) + (voff)[_i]), (PG8_LAS unsigned*)(lds + (bufoff) + ldsw + _i * 8192), 16, 0, 0); } while (0)
#define PG8_LDA(dst, b, h) do { _Pragma("unroll") for (int m = 0; m < 4; ++m) _Pragma("unroll") for (int k = 0; k < 2; ++k) dst[m][k] = *(const PG8_LAS bf16x8*)(lds + PG8_SA(b, h) + aoff + m * 2048 + k * 1024); } while (0)
#define PG8_LDB(dst, b, h) do { _Pragma("unroll") for (int n = 0; n < 2; ++n) _Pragma("unroll") for (int k = 0; k < 2; ++k) dst[n][k] = *(const PG8_LAS bf16x8*)(lds + PG8_SB(b, h) + boff + n * 2048 + k * 1024); } while (0)
#define PG8_MMA(ai, bj, At, Bt) do { __builtin_amdgcn_s_setprio(1); _Pragma("unroll") for (int m = 0; m < 4; ++m) _Pragma("unroll") for (int n = 0; n < 2; ++n) _Pragma("unroll") for (int k = 0; k < 2; ++k) \
        acc[ai][bj][m][n] = SWAP ? __builtin_amdgcn_mfma_f32_16x16x32_bf16(At[m][k], Bt[n][k], acc[ai][bj][m][n], 0, 0, 0) : __builtin_amdgcn_mfma_f32_16x16x32_bf16(Bt[n][k], At[m][k], acc[ai][bj][m][n], 0, 0, 0); __builtin_amdgcn_s_setprio(0); } while (0)
#define PG8_WAIT_V(n) asm volatile("s_waitcnt vmcnt(" #n ")" ::: "memory")
#define PG8_WAIT_L(n) asm volatile("s_waitcnt lgkmcnt(" #n ")" ::: "memory")
#define PG8_BAR __builtin_amdgcn_s_barrier()
#define PG8_SCHED __builtin_amdgcn_sched_barrier(0)
    Unit cur, nxt; int ui = 0;
    if (!S.next(0, cur)) return;
    f32x4 acc[2][2][4][2];
#pragma unroll
    for (int a = 0; a < 2; ++a)
#pragma unroll
        for (int b = 0; b < 2; ++b)
#pragma unroll
            for (int m = 0; m < 4; ++m)
#pragma unroll
                for (int n = 0; n < 2; ++n) acc[a][b][m][n] = (f32x4){0.f, 0.f, 0.f, 0.f};
    bf16x8 At[4][2], B0[2][2], B1[2][2];
    const char* cA = (const char*)g.A + (size_t)cur.pm * tstep; const char* cB = (const char*)g.Bt + (size_t)cur.pn * tstep;
    S.a_ready(cur);
    PG8_STAGE(PG8_SB(0, 0), cB, voffB); PG8_STAGE(PG8_SA(0, 0), cA, voffA); PG8_STAGE(PG8_SB(0, 1), cB + hstep, voffB); PG8_STAGE(PG8_SA(0, 1), cA + hstep, voffA);
    if (wr == 1) PG8_BAR;
    PG8_WAIT_V(4); PG8_BAR;
    PG8_STAGE(PG8_SB(1, 0), cB + kstep, voffB); PG8_STAGE(PG8_SA(1, 0), cA + kstep, voffA); PG8_STAGE(PG8_SB(1, 1), cB + hstep + kstep, voffB);
    PG8_WAIT_V(6); PG8_BAR;
    PG8_STAMP();
    for (;;) {
        const bool has_next = S.next(ui + 1, nxt);
        const char* nA = has_next ? (const char*)g.A + (size_t)nxt.pm * tstep : cA; const char* nB = has_next ? (const char*)g.Bt + (size_t)nxt.pn * tstep : cB;
        for (int t = 0; t < nt; t += 2) {
            const bool last = (t == nt - 2);
            const char* a1 = cA + (size_t)(t + 1) * kstep;
            const char* a2 = last ? nA : cA + (size_t)(t + 2) * kstep; const char* b2 = last ? nB : cB + (size_t)(t + 2) * kstep;
            const char* a3 = a2 + kstep; const char* b3 = b2 + kstep;
            if (last && has_next) S.a_ready(nxt);
            PG8_LDB(B0, 0, 0); PG8_SCHED; PG8_LDA(At, 0, 0); PG8_STAGE(PG8_SA(1, 1), a1 + hstep, voffA);
            PG8_WAIT_L(8); PG8_BAR; PG8_WAIT_L(0); PG8_MMA(0, 0, At, B0); PG8_BAR; PG8_SCHED;
            PG8_LDB(B1, 0, 1); PG8_STAGE(PG8_SB(0, 0), b2, voffB);
            PG8_BAR; PG8_WAIT_L(0); PG8_MMA(0, 1, At, B1); PG8_BAR;
            PG8_LDA(At, 0, 1); PG8_STAGE(PG8_SA(0, 0), a2, voffA);
            PG8_BAR; PG8_WAIT_L(0); PG8_MMA(1, 0, At, B0); PG8_BAR; PG8_SCHED;
            PG8_STAGE(PG8_SB(0, 1), b2 + hstep, voffB);
            PG8_WAIT_V(6); PG8_BAR; PG8_MMA(1, 1, At, B1); PG8_BAR;
            PG8_LDB(B0, 1, 0); PG8_SCHED; PG8_LDA(At, 1, 0); PG8_STAGE(PG8_SA(0, 1), a2 + hstep, voffA);
            PG8_WAIT_L(8); PG8_BAR; PG8_WAIT_L(0); PG8_MMA(0, 0, At, B0); PG8_BAR; PG8_SCHED;
            PG8_LDB(B1, 1, 1); PG8_STAGE(PG8_SB(1, 0), b3, voffB);
            PG8_BAR; PG8_WAIT_L(0); PG8_MMA(0, 1, At, B1); PG8_BAR;
            PG8_LDA(At, 1, 1); PG8_STAGE(PG8_SA(1, 0), a3, voffA);
            PG8_BAR; PG8_WAIT_L(0); PG8_MMA(1, 0, At, B0); PG8_BAR; PG8_SCHED;
            PG8_STAGE(PG8_SB(1, 1), b3 + hstep, voffB);
            PG8_WAIT_V(6); PG8_BAR; PG8_MMA(1, 1, At, B1); PG8_BAR;
        }
        PG8_STAMP();
        if constexpr (!Epi::AFTER_DRAIN) { E(acc, cur, wr, wc, fr, fq); S.done(cur); }
        PG8_STAMP();
        if (!has_next) break;
#pragma unroll
        for (int a = 0; a < 2; ++a)
#pragma unroll
            for (int b = 0; b < 2; ++b)
#pragma unroll
                for (int m = 0; m < 4; ++m)
#pragma unroll
                    for (int n = 0; n < 2; ++n) acc[a][b][m][n] = (f32x4){0.f, 0.f, 0.f, 0.f};
        cur = nxt; cA = nA; cB = nB; ++ui;
    }
    PG8_WAIT_V(0);
    if (wr == 0) PG8_BAR;
    PG8_BAR;
    if constexpr (Epi::AFTER_DRAIN) { E.fused(acc, cur, wr, wc, fr, fq, lds, wid, lane); S.done(cur); }
    PG8_STAMP();
    if (STAMP && wid == 0) { stamps[lane] = lane < nts ? (((unsigned long long)(unsigned)ts_hi << 32) | (unsigned)ts_lo) : 0ull;
        if (lane == 62) stamps[62] = rt_entry; if (lane == 63) stamps[63] = (unsigned long long)wall_clock64(); }
#undef PG8_STAMP
#undef PG8_SA
#undef PG8_SB
#undef PG8_STAGE
#undef PG8_LDA
#undef PG8_LDB
#undef PG8_MMA
#undef PG8_WAIT_V
#undef PG8_WAIT_L
#undef PG8_BAR
#undef PG8_SCHED
}
}

struct Epi1 {
  static constexpr bool PERM = true, AFTER_DRAIN = false;
  unsigned char* ws; u16* mg; const float* b_gate; bool dup;
  DI void operator()(const pg8::f32x4 (&acc)[2][2][4][2], const pg8::Unit& u, int wr, int wc, int fr, int fq) const {
    const int pn = u.pn;
    const int rowb = u.pm * 256 + wr * 64 + fr;
    const int colu = wc * 32 + 8 * fq;
    if (pn < 4) {
      u16* dst = (pn < 3) ? (u16*)(ws + OFF_CQ) + pn * 256 : (u16*)(ws + OFF_CKV);
      const int ld = (pn < 3) ? 768 : 256;
      float* ssq = (float*)(ws + OFF_SSQ) + ((pn < 3) ? 0 : T);
#pragma unroll
      for (int ai = 0; ai < 2; ++ai)
#pragma unroll
        for (int m = 0; m < 4; ++m) {
          const int row = rowb + ai * 128 + m * 16;
          float ss = 0.f;
#pragma unroll
          for (int bj = 0; bj < 2; ++bj) {
            const pg8::f32x4 v0 = acc[ai][bj][m][0], v1 = acc[ai][bj][m][1];
            ss += v0[0] * v0[0] + v0[1] * v0[1] + v0[2] * v0[2] + v0[3] * v0[3] + v1[0] * v1[0] + v1[1] * v1[1] + v1[2] * v1[2] + v1[3] * v1[3];
            u4v o; o.x = pk2(v0[0], v0[1]); o.y = pk2(v0[2], v0[3]); o.z = pk2(v1[0], v1[1]); o.w = pk2(v1[2], v1[3]);
            *(u4v*)(dst + (size_t)row * ld + bj * 128 + colu) = o;
          }
          ss = xor16_add(ss); ss = xor32_add(ss);
          if (fq == 0 && !dup) atomicAdd(ssq + row, ss);
        }
    } else if (pn < 8) {
      u16* dst = (u16*)(ws + ((pn < 6) ? OFF_SGA : OFF_SGB)) + (pn & 1) * 256;
#pragma unroll
      for (int ai = 0; ai < 2; ++ai)
#pragma unroll
        for (int m = 0; m < 4; ++m) {
          const int row = rowb + ai * 128 + m * 16;
#pragma unroll
          for (int bj = 0; bj < 2; ++bj) {
            const pg8::f32x4 v0 = acc[ai][bj][m][0], v1 = acc[ai][bj][m][1];
            u4v o; o.x = pk2(siluf_(v0[0]), siluf_(v0[1])); o.y = pk2(siluf_(v0[2]), siluf_(v0[3]));
            o.z = pk2(siluf_(v1[0]), siluf_(v1[1])); o.w = pk2(siluf_(v1[2]), siluf_(v1[3]));
            *(u4v*)(dst + (size_t)row * 512 + bj * 128 + colu) = o;
          }
        }
    } else if (pn >= 16) {
      if (pn < 22) {
        u16* dst = (u16*)(ws + ((pn < 18) ? OFF_HQ : (pn < 20) ? OFF_HF : OFF_HI)) + (pn & 1) * 256;
#pragma unroll
        for (int ai = 0; ai < 2; ++ai)
#pragma unroll
          for (int m = 0; m < 4; ++m) {
            const int row = rowb + ai * 128 + m * 16;
#pragma unroll
            for (int bj = 0; bj < 2; ++bj) {
              const pg8::f32x4 v0 = acc[ai][bj][m][0], v1 = acc[ai][bj][m][1];
              u4v o; o.x = pk2(v0[0], v0[1]); o.y = pk2(v0[2], v0[3]); o.z = pk2(v1[0], v1[1]); o.w = pk2(v1[2], v1[3]);
              *(u4v*)(dst + (size_t)row * 512 + bj * 128 + colu) = o;
            }
          }
      } else if (colu < 32) {
        float* dst = (float*)(ws + OFF_KPE);
#pragma unroll
        for (int ai = 0; ai < 2; ++ai)
#pragma unroll
          for (int m = 0; m < 4; ++m) {
            const int row = rowb + ai * 128 + m * 16;
            *(pg8::f32x4*)(dst + (size_t)row * 32 + colu) = acc[ai][0][m][0];
            *(pg8::f32x4*)(dst + (size_t)row * 32 + colu + 4) = acc[ai][0][m][1];
          }
      }
    } else {
      const int cb = (pn - 8) * 256 + colu;
      f4v b0[2], b1[2];
#pragma unroll
      for (int bj = 0; bj < 2; ++bj) { b0[bj] = *(const f4v*)(b_gate + cb + bj * 128); b1[bj] = *(const f4v*)(b_gate + cb + bj * 128 + 4); }
#pragma unroll
      for (int ai = 0; ai < 2; ++ai)
#pragma unroll
        for (int m = 0; m < 4; ++m) {
          const int row = rowb + ai * 128 + m * 16;
#pragma unroll
          for (int bj = 0; bj < 2; ++bj) {
            const pg8::f32x4 v0 = acc[ai][bj][m][0], v1 = acc[ai][bj][m][1];
            u4v o; o.x = pk2(sigmoidf_(v0[0] + b0[bj].x), sigmoidf_(v0[1] + b0[bj].y)); o.y = pk2(sigmoidf_(v0[2] + b0[bj].z), sigmoidf_(v0[3] + b0[bj].w));
            o.z = pk2(sigmoidf_(v1[0] + b1[bj].x), sigmoidf_(v1[1] + b1[bj].y)); o.w = pk2(sigmoidf_(v1[2] + b1[bj].z), sigmoidf_(v1[3] + b1[bj].w));
            *(u4v*)(mg + ((((size_t)(u.pm * 8 + (pn - 8)) * 8 + (wr * 4 + wc)) * 16 + (ai * 8 + m * 2 + bj)) * 64 + (fq * 16 + fr)) * 8) = o;
          }
        }
    }
  }
};


struct Epi6 {
  static constexpr bool PERM = true, AFTER_DRAIN = false;
  u16* out; float* ssq; bool dup;
  DI void operator()(const pg8::f32x4 (&acc)[2][2][4][2], const pg8::Unit& u, int wr, int wc, int fr, int fq) const {
    const int rowb = u.pm * 256 + wr * 64 + fr;
    const int colb = u.pn * 256 + wc * 32 + 8 * fq;
#pragma unroll
    for (int ai = 0; ai < 2; ++ai)
#pragma unroll
      for (int m = 0; m < 4; ++m) {
        const int row = rowb + ai * 128 + m * 16;
        float ss = 0.f;
#pragma unroll
        for (int bj = 0; bj < 2; ++bj) {
          const pg8::f32x4 v0 = acc[ai][bj][m][0], v1 = acc[ai][bj][m][1];
          ss += v0[0] * v0[0] + v0[1] * v0[1] + v0[2] * v0[2] + v0[3] * v0[3] + v1[0] * v1[0] + v1[1] * v1[1] + v1[2] * v1[2] + v1[3] * v1[3];
          u4v o; o.x = pk2(v0[0], v0[1]); o.y = pk2(v0[2], v0[3]); o.z = pk2(v1[0], v1[1]); o.w = pk2(v1[2], v1[3]);
          *(u4v*)(out + (size_t)row * 1024 + colb + bj * 128) = o;
        }
        ss = xor16_add(ss); ss = xor32_add(ss);
        if (fq == 0 && !dup) atomicAdd(ssq + row, ss);
      }
  }
};
template <bool SECOND> struct Epi5 {
  static constexpr bool PERM = true, AFTER_DRAIN = false;
  const u16* mg; u16* mi; u16* mo;
  DI void operator()(const pg8::f32x4 (&acc)[2][2][4][2], const pg8::Unit& u, int wr, int wc, int fr, int fq) const {
    const int rowb = u.pm * 256 + wr * 64 + fr;
    const int colb = u.pn * 256 + wc * 32 + 8 * fq;
    const size_t gbase = (((size_t)(u.pm * 8 + u.pn + (SECOND ? 4 : 0)) * 8 + (wr * 4 + wc)) * 16) * 64 + (fq * 16 + fr);
    const size_t ibase = (((size_t)(u.pm * 4 + u.pn) * 8 + (wr * 4 + wc)) * 16) * 64 + (fq * 16 + fr);
#pragma unroll
    for (int hb = 0; hb < 4; ++hb) {
      const int ai = hb >> 1, m0 = (hb & 1) * 2;
      u4v g[4], pm[4];
#pragma unroll
      for (int f4 = 0; f4 < 4; ++f4) {
        const int f = ai * 8 + (m0 + (f4 >> 1)) * 2 + (f4 & 1);
        g[f4] = *(const u4v*)(mg + (gbase + (size_t)f * 64) * 8);
        if (SECOND) pm[f4] = *(const u4v*)(mi + (ibase + (size_t)f * 64) * 8);
      }
#pragma unroll
      for (int f4 = 0; f4 < 4; ++f4) {
        const int m = m0 + (f4 >> 1), bj = f4 & 1;
        const int row = rowb + ai * 128 + m * 16;
        const pg8::f32x4 v0 = acc[ai][bj][m][0], v1 = acc[ai][bj][m][1];
        float r0 = v0[0] * bflo(g[f4].x), r1 = v0[1] * bfhi(g[f4].x), r2 = v0[2] * bflo(g[f4].y), r3 = v0[3] * bfhi(g[f4].y);
        float r4 = v1[0] * bflo(g[f4].z), r5 = v1[1] * bfhi(g[f4].z), r6 = v1[2] * bflo(g[f4].w), r7 = v1[3] * bfhi(g[f4].w);
        if (SECOND) {
          r0 += bflo(pm[f4].x); r1 += bfhi(pm[f4].x); r2 += bflo(pm[f4].y); r3 += bfhi(pm[f4].y);
          r4 += bflo(pm[f4].z); r5 += bfhi(pm[f4].z); r6 += bflo(pm[f4].w); r7 += bfhi(pm[f4].w);
        }
        u4v o; o.x = pk2(r0, r1); o.y = pk2(r2, r3); o.z = pk2(r4, r5); o.w = pk2(r6, r7);
        if (SECOND) *(u4v*)(mo + (size_t)row * 1024 + colb + bj * 128) = o;
        else *(u4v*)(mi + (ibase + (size_t)(ai * 8 + m * 2 + bj) * 64) * 8) = o;
      }
      __builtin_amdgcn_sched_barrier(0);
    }
  }
};
struct EpiQ {
  static constexpr bool PERM = true, AFTER_DRAIN = false;
  const float* ssq_q; const float* rope; u16* Qo;
  DI void operator()(const pg8::f32x4 (&acc)[2][2][4][2], const pg8::Unit& u, int wr, int wc, int fr, int fq) const {
    const int rowb = u.pm * 256 + wr * 64 + fr;
    const int colu = wc * 32 + 8 * fq;
    float sq[8];
#pragma unroll
    for (int i = 0; i < 8; ++i) sq[i] = ssq_q[rowb + (i >> 2) * 128 + (i & 3) * 16];
    if (u.pn < 2) {
#pragma unroll
      for (int ai = 0; ai < 2; ++ai)
#pragma unroll
        for (int m = 0; m < 4; ++m) {
          const int row = rowb + ai * 128 + m * 16;
          const int b = row >> 12, spos = row & 4095;
          const float sc = rsqrtf(sq[ai * 4 + m] * (1.f / 768.f) + EPS) * QSCALE;
#pragma unroll
          for (int bj = 0; bj < 2; ++bj) {
            const pg8::f32x4 v0 = acc[ai][bj][m][0], v1 = acc[ai][bj][m][1];
            const int head = u.pn * 4 + bj * 2 + (colu >> 6), d = colu & 63;
            u4v o; o.x = pk2(v0[0] * sc, v0[1] * sc); o.y = pk2(v0[2] * sc, v0[3] * sc); o.z = pk2(v1[0] * sc, v1[1] * sc); o.w = pk2(v1[2] * sc, v1[3] * sc);
            *(u4v*)(Qo + ((size_t)(b * 8 + head) * 4096 + spos) * 96 + d) = o;
          }
        }
    } else {
#pragma unroll
      for (int ai = 0; ai < 2; ++ai) {
        f4v cs[4], sn[4];
#pragma unroll
        for (int i = 0; i < 4; ++i) {
          const int spos = (rowb + ai * 128 + i * 16) & 4095;
          cs[i] = *(const f4v*)(rope + spos * 16 + 4 * fq); sn[i] = *(const f4v*)(rope + 65536 + spos * 16 + 4 * fq);
        }
#pragma unroll
        for (int m = 0; m < 4; ++m) {
          const int row = rowb + ai * 128 + m * 16;
          const int b = row >> 12, spos = row & 4095;
          const float sc = rsqrtf(sq[ai * 4 + m] * (1.f / 768.f) + EPS) * QSCALE;
          const f4v c4 = cs[m], s4 = sn[m];
#pragma unroll
          for (int bj = 0; bj < 2; ++bj) {
            const pg8::f32x4 v0 = acc[ai][bj][m][0], v1 = acc[ai][bj][m][1];
            const int head = bj * 4 + wc;
            u2v o1, o2;
            o1.x = pk2((v0[0] * c4.x - v1[0] * s4.x) * sc, (v0[1] * c4.y - v1[1] * s4.y) * sc);
            o1.y = pk2((v0[2] * c4.z - v1[2] * s4.z) * sc, (v0[3] * c4.w - v1[3] * s4.w) * sc);
            o2.x = pk2((v0[0] * s4.x + v1[0] * c4.x) * sc, (v0[1] * s4.y + v1[1] * c4.y) * sc);
            o2.y = pk2((v0[2] * s4.z + v1[2] * c4.z) * sc, (v0[3] * s4.w + v1[3] * c4.w) * sc);
            u16* qp = Qo + ((size_t)(b * 8 + head) * 4096 + spos) * 96 + 64 + 4 * fq;
            *(u2v*)qp = o1; *(u2v*)(qp + 16) = o2;
          }
        }
        __builtin_amdgcn_sched_barrier(0);
      }
    }
  }
};

struct EpiK {
  static constexpr bool PERM = true, AFTER_DRAIN = false;
  const float* ssq_kv; u16* Ko;
  DI void operator()(const pg8::f32x4 (&acc)[2][2][4][2], const pg8::Unit& u, int wr, int wc, int fr, int fq) const {
    const int rowb = u.pm * 256 + wr * 64 + fr;
    float sq[8];
#pragma unroll
    for (int i = 0; i < 8; ++i) sq[i] = ssq_kv[rowb + (i >> 2) * 128 + (i & 3) * 16];
#pragma unroll
    for (int ai = 0; ai < 2; ++ai)
#pragma unroll
      for (int m = 0; m < 4; ++m) {
        const int row = rowb + ai * 128 + m * 16;
        const int b = row >> 12, spos = row & 4095;
        const float sc = rsqrtf(sq[ai * 4 + m] * (1.f / 256.f) + EPS);
#pragma unroll
        for (int bj = 0; bj < 2; ++bj) {
          const pg8::f32x4 v0 = acc[ai][bj][m][0], v1 = acc[ai][bj][m][1];
          const int col = u.pn * 256 + bj * 128 + wc * 32 + 8 * fq;
          const int head = col >> 6, d = col & 63;
          u4v o; o.x = pk2(v0[0] * sc, v0[1] * sc); o.y = pk2(v0[2] * sc, v0[3] * sc); o.z = pk2(v1[0] * sc, v1[1] * sc); o.w = pk2(v1[2] * sc, v1[3] * sc);
          *(u4v*)(Ko + ((size_t)(b * 8 + head) * 4096 + spos) * 96 + d) = o;
        }
      }
  }
};
struct EpiV {
  static constexpr bool PERM = false, AFTER_DRAIN = false;
  const float* ssq_kv; u16* Vo;
  DI void operator()(const pg8::f32x4 (&acc)[2][2][4][2], const pg8::Unit& u, int wr, int wc, int fr, int fq) const {
    f4v sq[8];
#pragma unroll
    for (int i = 0; i < 8; ++i) sq[i] = *(const f4v*)(ssq_kv + u.pm * 256 + (i >> 2) * 128 + wr * 64 + (i & 3) * 16 + 4 * fq);
#pragma unroll
    for (int ai = 0; ai < 2; ++ai)
#pragma unroll
      for (int m = 0; m < 4; ++m) {
        const int row4 = u.pm * 256 + ai * 128 + wr * 64 + m * 16 + 4 * fq;
        const int b = row4 >> 12, spos = row4 & 4095;
        const f4v q = sq[ai * 4 + m];
        const float s0 = rsqrtf(q.x * (1.f / 256.f) + EPS), s1 = rsqrtf(q.y * (1.f / 256.f) + EPS), s2 = rsqrtf(q.z * (1.f / 256.f) + EPS), s3 = rsqrtf(q.w * (1.f / 256.f) + EPS);
#pragma unroll
        for (int bj = 0; bj < 2; ++bj)
#pragma unroll
          for (int n = 0; n < 2; ++n) {
            const pg8::f32x4 v = acc[ai][bj][m][n];
            const int col = u.pn * 256 + bj * 128 + wc * 32 + n * 16 + fr;
            const int head = col >> 6, dv = col & 63;
            u2v o; o.x = pk2(v[0] * s0, v[1] * s1); o.y = pk2(v[2] * s2, v[3] * s3);
            *(u2v*)(Vo + ((size_t)(b * 8 + head) * 64 + dv) * 4096 + spos) = o;
          }
        __builtin_amdgcn_sched_barrier(0);
      }
  }
};
DI void phase1(const Params& p, unsigned char* smem, bool dup = false) {
  unsigned char* ws = p.ws;
  pg8::Gemm g{(const u16*)(ws + OFF_H), (const u16*)(ws + OFF_WIN), T, NP, 1024};
  pg8::StaticOrder S; S.init(T, NP, (int)gridDim.x, (int)blockIdx.x);
  Epi1 E{ws, (u16*)p.out, p.b_gate, dup};
  pg8::gemm_phase<Epi1, pg8::StaticOrder, false>((PG8_LAS unsigned char*)smem, g, S, E, nullptr);
}

DI void hgrn_prep_tile(const Params& p, float* stage, int tid, int b, int hh, int prow0, int nblk0) {
  unsigned char* ws = p.ws;
  const int bh = b * 8 + hh;
  if (tid < 128) {
    const int c = tid & 63, blk = tid >> 6;
    const float l0 = p.lb_logits[hh * 64 + c], l1 = p.lb_logits[512 + hh * 64 + c];
    const float lbv = 1.f / (1.f + expf(l1 - l0));
    float cum = 0.f;
    for (int rr = 0; rr < 32; ++rr) {
      float* sp = stage + (blk * 32 + rr) * SST + c;
      const float q = sp[0], hf = sp[64];
      const float sg = 1.f / (1.f + expf(-hf));
      const float f = lbv + (1.f - lbv) * sg;
      cum += logf(f);
      const float e = expf(cum);
      sp[0] = q * e;
      sp[64] = (1.f - f) / e;
    }
    ((float*)(ws + OFF_DECAY))[((size_t)bh * 128 + nblk0 + blk) * 64 + c] = expf(cum);
  }
  __syncthreads();
#pragma unroll
  for (int it = 0; it < 2; ++it) {
    const int item = tid + 256 * it, rr = item >> 3, cc = (item & 7) * 8;
    const f4v a = *(const f4v*)(stage + rr * SST + cc), c = *(const f4v*)(stage + rr * SST + cc + 4);
    const f4v d = *(const f4v*)(stage + rr * SST + 64 + cc), e = *(const f4v*)(stage + rr * SST + 64 + cc + 4);
    const size_t o = (size_t)(prow0 + rr) * 512 + hh * 64 + cc;
    *(u4v*)((u16*)(ws + OFF_QDEC) + o) = pk8(a, c);
    *(u4v*)((u16*)(ws + OFF_KINV) + o) = pk8(d, e);
  }
}
DI void hi_vt_tile(const Params& p, float* stage, int tid, int b, int q2, int nblk0) {
  unsigned char* ws = p.ws;
#pragma unroll
        for (int it = 0; it < 4; ++it) {
          const int item = tid + 256 * it, sc = item & 3, col = (item >> 2) & 127, blk = item >> 9;
          float v[8];
#pragma unroll
          for (int i = 0; i < 8; ++i) v[i] = stage[(blk * 32 + sc * 8 + i) * SST + col];
          u4v o; o.x = pk2(v[0], v[1]); o.y = pk2(v[2], v[3]); o.z = pk2(v[4], v[5]); o.w = pk2(v[6], v[7]);
          const int bh = b * 8 + q2 * 2 + (col >> 6);
          *(u4v*)((u16*)(ws + OFF_VT) + (((size_t)bh * 128 + nblk0 + blk) * 64 + (col & 63)) * 32 + sc * 8) = o;
        }
}
DI void stage_load64(float* stage, const u16* src, int coff, int tid) {
#pragma unroll
  for (int it = 0; it < 2; ++it) {
    const int item = tid + 256 * it, rr = item >> 3, ch = item & 7;
    const u4v v = *(const u4v*)(src + (size_t)rr * 512 + ch * 8);
    float* d = stage + rr * SST + coff + ch * 8;
    *(f4v*)d = f4v{bflo(v.x), bfhi(v.x), bflo(v.y), bfhi(v.y)};
    *(f4v*)(d + 4) = f4v{bflo(v.z), bfhi(v.z), bflo(v.w), bfhi(v.w)};
  }
}


constexpr int PST = 68;
DI void hgrn_prep_native(const Params& p, float* pl, int rb, int hh) {
  unsigned char* ws = p.ws;
  const int tid = threadIdx.x;
  float* Qp = pl; float* G = pl + 128 * PST; float* Kn = pl + 2 * 128 * PST;
  const int prow0 = rb * 128, b = prow0 >> 12, bh = b * 8 + hh, nblk0 = (prow0 & 4095) >> 5;
  const int ch = tid & 7;
  float lbv[8];
  {
    const f4v a0 = *(const f4v*)(p.lb_logits + hh * 64 + ch * 8), a1 = *(const f4v*)(p.lb_logits + hh * 64 + ch * 8 + 4);
    const f4v b0 = *(const f4v*)(p.lb_logits + 512 + hh * 64 + ch * 8), b1 = *(const f4v*)(p.lb_logits + 512 + hh * 64 + ch * 8 + 4);
    const float l0[8] = {a0.x, a0.y, a0.z, a0.w, a1.x, a1.y, a1.z, a1.w}, l1[8] = {b0.x, b0.y, b0.z, b0.w, b1.x, b1.y, b1.z, b1.w};
#pragma unroll
    for (int i = 0; i < 8; ++i) lbv[i] = 1.f / (1.f + expf(l1[i] - l0[i]));
  }
  __syncthreads();
#pragma unroll
  for (int it = 0; it < 2; ++it) {
    const int rr = (tid + 512 * it) >> 3;
    const size_t go = (size_t)(prow0 + rr) * 512 + hh * 64 + ch * 8;
    const u4v qv = *(const u4v*)((const u16*)(ws + OFF_HQ) + go), fv = *(const u4v*)((const u16*)(ws + OFF_HF) + go);
    const float q[8] = {bflo(qv.x), bfhi(qv.x), bflo(qv.y), bfhi(qv.y), bflo(qv.z), bfhi(qv.z), bflo(qv.w), bfhi(qv.w)};
    const float hf[8] = {bflo(fv.x), bfhi(fv.x), bflo(fv.y), bfhi(fv.y), bflo(fv.z), bfhi(fv.z), bflo(fv.w), bfhi(fv.w)};
    float g[8], kn[8];
#pragma unroll
    for (int i = 0; i < 8; ++i) {
      const float sg = rcpf(1.f + __builtin_amdgcn_exp2f(-1.4426950408889634f * hf[i]));
      const float f = lbv[i] + (1.f - lbv[i]) * sg;
      g[i] = __builtin_amdgcn_logf(f);
      kn[i] = 1.f - f;
    }
    float* d = Qp + rr * PST + ch * 8;
    *(f4v*)d = f4v{q[0], q[1], q[2], q[3]}; *(f4v*)(d + 4) = f4v{q[4], q[5], q[6], q[7]};
    d = G + rr * PST + ch * 8;
    *(f4v*)d = f4v{g[0], g[1], g[2], g[3]}; *(f4v*)(d + 4) = f4v{g[4], g[5], g[6], g[7]};
    d = Kn + rr * PST + ch * 8;
    *(f4v*)d = f4v{kn[0], kn[1], kn[2], kn[3]}; *(f4v*)(d + 4) = f4v{kn[4], kn[5], kn[6], kn[7]};
  }
  __syncthreads();
  if (tid < 256) {
    const int c = tid & 63, blk = tid >> 6;
    float* gp = G + (blk * 32) * PST + c;
    float v[32];
#pragma unroll
    for (int r2 = 0; r2 < 32; ++r2) v[r2] = gp[r2 * PST];
    float cum = 0.f;
#pragma unroll
    for (int r2 = 0; r2 < 32; ++r2) { cum += v[r2]; gp[r2 * PST] = cum; }
    ((float*)(ws + OFF_DECAY))[((size_t)bh * 128 + nblk0 + blk) * 64 + c] = __builtin_amdgcn_exp2f(cum);
  }
  __syncthreads();
#pragma unroll
  for (int it = 0; it < 2; ++it) {
    const int rr = (tid + 512 * it) >> 3;
    const float* s0 = Qp + rr * PST + ch * 8; const float* s1 = G + rr * PST + ch * 8; const float* s2 = Kn + rr * PST + ch * 8;
    const f4v q0 = *(const f4v*)s0, q1 = *(const f4v*)(s0 + 4), c0 = *(const f4v*)s1, c1 = *(const f4v*)(s1 + 4), k0 = *(const f4v*)s2, k1 = *(const f4v*)(s2 + 4);
    const float q[8] = {q0.x, q0.y, q0.z, q0.w, q1.x, q1.y, q1.z, q1.w}, cm[8] = {c0.x, c0.y, c0.z, c0.w, c1.x, c1.y, c1.z, c1.w}, kn[8] = {k0.x, k0.y, k0.z, k0.w, k1.x, k1.y, k1.z, k1.w};
    float qd[8], ki[8];
#pragma unroll
    for (int i = 0; i < 8; ++i) { qd[i] = q[i] * __builtin_amdgcn_exp2f(cm[i]); ki[i] = kn[i] * __builtin_amdgcn_exp2f(-cm[i]); }
    const size_t go = (size_t)(prow0 + rr) * 512 + hh * 64 + ch * 8;
    u4v o; o.x = pk2(qd[0], qd[1]); o.y = pk2(qd[2], qd[3]); o.z = pk2(qd[4], qd[5]); o.w = pk2(qd[6], qd[7]);
    *(u4v*)((u16*)(ws + OFF_QDEC) + go) = o;
    o.x = pk2(ki[0], ki[1]); o.y = pk2(ki[2], ki[3]); o.z = pk2(ki[4], ki[5]); o.w = pk2(ki[6], ki[7]);
    *(u4v*)((u16*)(ws + OFF_KINV) + go) = o;
  }
}
constexpr int VTS = 136;
DI void hi_vt_native(const Params& p, u16* img, int rb, int q2) {
  unsigned char* ws = p.ws;
  const int tid = threadIdx.x;
  const int prow0 = rb * 128, b = prow0 >> 12, nblk0 = (prow0 & 4095) >> 5;
  __syncthreads();
#pragma unroll
  for (int it = 0; it < 4; ++it) {
    const int item = tid + 512 * it, rr = item >> 4, c16 = item & 15;
    *(u4v*)(img + rr * VTS + c16 * 8) = *(const u4v*)((const u16*)(ws + OFF_HI) + (size_t)(prow0 + rr) * 512 + q2 * 128 + c16 * 8);
  }
  __syncthreads();
#pragma unroll
  for (int it = 0; it < 4; ++it) {
    const int item = tid + 512 * it, sc = item & 3, col = (item >> 2) & 127, blk = item >> 9;
    u32 w[4];
#pragma unroll
    for (int i = 0; i < 4; ++i) {
      const u32 lo = img[(blk * 32 + sc * 8 + 2 * i) * VTS + col], hi = img[(blk * 32 + sc * 8 + 2 * i + 1) * VTS + col];
      w[i] = lo | (hi << 16);
    }
    const int bh = b * 8 + q2 * 2 + (col >> 6);
    *(u4v*)((u16*)(ws + OFF_VT) + (((size_t)bh * 128 + nblk0 + blk) * 64 + (col & 63)) * 32 + sc * 8) = u4v{w[0], w[1], w[2], w[3]};
  }
}

DI void rope8(const float* x1, const float* x2, const float* rope, int spos, int j0, bool first, float scale, float (&o)[8]) {
  const f4v c0 = *(const f4v*)(rope + spos * 16 + j0), c1 = *(const f4v*)(rope + spos * 16 + j0 + 4);
  const f4v s0 = *(const f4v*)(rope + 65536 + spos * 16 + j0), s1 = *(const f4v*)(rope + 65536 + spos * 16 + j0 + 4);
  const float cs[8] = {c0.x, c0.y, c0.z, c0.w, c1.x, c1.y, c1.z, c1.w};
  const float sn[8] = {s0.x, s0.y, s0.z, s0.w, s1.x, s1.y, s1.z, s1.w};
#pragma unroll
  for (int i = 0; i < 8; ++i) o[i] = scale * (first ? (x1[i] * cs[i] - x2[i] * sn[i]) : (x1[i] * sn[i] + x2[i] * cs[i]));
}

DI void phase2(const Params& p, unsigned char* smem, u16* lds) {
  unsigned char* ws = p.ws;
  const int tid = VTID;
  float* stage = (float*)lds;
  const float* ssq_q = (const float*)(ws + OFF_SSQ);
  const float* ssq_kv = ssq_q + T;
  const float* rope = (const float*)(ws + OFF_ROPE);
  u16* Qo = (u16*)(ws + OFF_Q);
  u16* Ko = (u16*)(ws + OFF_K);
  u16* Vo = (u16*)(ws + OFF_VTT);
#pragma nounroll
  for (int rep = 0; rep < (DUP_PH == 21 ? p.ph_hi - 7 : 1); ++rep) {
    pg8::Gemm g{(const u16*)(ws + OFF_CQ), (const u16*)(ws + OFF_WUQ), T, 768, 768};
    pg8::StaticOrder S; S.init(T, 768, (int)gridDim.x, (int)blockIdx.x);
    EpiQ E{ssq_q, rope, Qo};
    pg8::gemm_phase<EpiQ, pg8::StaticOrder, false>((PG8_LAS unsigned char*)smem, g, S, E, nullptr);
  }
#pragma nounroll
  for (int rep = 0; rep < (DUP_PH == 23 ? p.ph_hi - 7 : 1); ++rep) {
    pg8::StaticOrder S; S.init(T, 512, (int)gridDim.x, (int)blockIdx.x);
    {
      int kk = 256; asm volatile("" : "+s"(kk));
      pg8::Gemm g{(const u16*)(ws + OFF_CKV), (const u16*)(ws + OFF_WUKV), T, 512, kk};
      EpiK E{ssq_kv, Ko};
      pg8::gemm_phase<EpiK, pg8::StaticOrder, false>((PG8_LAS unsigned char*)smem, g, S, E, nullptr);
    }
  }
#pragma nounroll
  for (int rep = 0; rep < (DUP_PH == 22 ? p.ph_hi - 7 : 1); ++rep) {
    const int gtid = blockIdx.x * blockDim.x + threadIdx.x, gthreads = gridDim.x * blockDim.x;
    for (int idx = gtid; idx < T * 4; idx += gthreads) {
      const int tok = idx >> 2, wv = (idx & 3) * 8, j0 = wv & 15;
      const int b = tok >> 12, spos = tok & 4095;
      const float* kp = (const float*)(ws + OFF_KPE) + (size_t)tok * 32;
      const f4v a0 = *(const f4v*)(kp + j0), a1 = *(const f4v*)(kp + j0 + 4);
      const f4v b0 = *(const f4v*)(kp + 16 + j0), b1 = *(const f4v*)(kp + 16 + j0 + 4);
      const float x1[8] = {a0.x, a0.y, a0.z, a0.w, a1.x, a1.y, a1.z, a1.w};
      const float x2[8] = {b0.x, b0.y, b0.z, b0.w, b1.x, b1.y, b1.z, b1.w};
      float o[8];
      rope8(x1, x2, rope, spos, j0, wv < 16, 1.f, o);
      u4v ov; ov.x = pk2(o[0], o[1]); ov.y = pk2(o[2], o[3]); ov.z = pk2(o[4], o[5]); ov.w = pk2(o[6], o[7]);
#pragma unroll
      for (int head = 0; head < 8; ++head) *(u4v*)(Ko + ((size_t)(b * 8 + head) * 4096 + spos) * 96 + 64 + wv) = ov;
    }
  }
  for (int rep = 0; rep < (DUP_PH == 20 ? 2 : 1); ++rep)
  for (int t = blockIdx.x; t < 2048 + 1024; t += gridDim.x) {
    if (t < 2048) hgrn_prep_native(p, (float*)smem, t >> 3, t & 7);
    else hi_vt_native(p, (u16*)smem, (t - 2048) >> 2, (t - 2048) & 3);
  }
}

DI void phase2b(const Params& p, unsigned char* smem) {
  unsigned char* ws = p.ws;
  const int tid = VTID;
  {
    pg8::StaticOrder S; S.init(T, 512, (int)gridDim.x, (int)blockIdx.x);
    int kk = 256; asm volatile("" : "+s"(kk));
    pg8::Gemm g{(const u16*)(ws + OFF_CKV), (const u16*)(ws + OFF_WUKV) + (size_t)512 * 256, T, 512, kk};
    EpiV E{(const float*)(ws + OFF_SSQ) + T, (u16*)(ws + OFF_VTT)};
    pg8::gemm_phase<EpiV, pg8::StaticOrder, false, true>((PG8_LAS unsigned char*)smem, g, S, E, nullptr);
  }
  for (int t = VBID; t < 2048; t += VBN) {
    {
      const int idx = t;
      const int bh = idx >> 5, n = (idx & 31) * 4 + (tid >> 6);
      const int lane = tid & 63, r = lane & 31, h = lane >> 5;
      const u16* kn = (const u16*)(ws + OFF_KINV) + ((size_t)(bh >> 3) * 4096 + n * 32) * 512 + (bh & 7) * 64;
      const u16* vt = (const u16*)(ws + OFF_VT) + ((size_t)bh * 128 + n) * 64 * 32;
      bf16x8 a[2][2], bb[2][2];
#pragma unroll
      for (int i = 0; i < 2; ++i)
#pragma unroll
        for (int ks = 0; ks < 2; ++ks) {
          {
            bf16x8 av;
#pragma unroll
            for (int j = 0; j < 8; ++j) av[j] = (short)kn[(size_t)(ks * 16 + h * 8 + j) * 512 + i * 32 + r];
            a[i][ks] = av;
          }
          bb[i][ks] = *(const bf16x8*)(vt + (i * 32 + r) * 32 + ks * 16 + h * 8);
        }
      u16* up = (u16*)(ws + OFF_UPD) + ((size_t)bh * 128 + n) * 4096;
#pragma unroll
      for (int kb = 0; kb < 2; ++kb)
#pragma unroll
        for (int vb = 0; vb < 2; ++vb) {
          f32x16 c = zero16();
          c = MFMA(a[kb][0], bb[vb][0], c);
          c = MFMA(a[kb][1], bb[vb][1], c);
#pragma unroll
          for (int g = 0; g < 4; ++g) {
            u2v o; o.x = pk2(c[4 * g], c[4 * g + 1]); o.y = pk2(c[4 * g + 2], c[4 * g + 3]);
            *(u2v*)(up + (vb * 32 + r) * 64 + kb * 32 + 8 * g + 4 * h) = o;
          }
        }
    }
  }
}

constexpr int KST = 104, VST = 72;
constexpr int ATT_BUF = 64 * KST + 64 * VST;

constexpr int KST2 = 104, VST2 = 132;
constexpr int ATT_BUF2 = 128 * KST2 + 64 * VST2;
DI void att_qk(const u16* sk, const bf16x8 (&qf)[6], float nm, f32x16 (&st)[2]) {
#pragma unroll
  for (int i = 0; i < 16; ++i) { st[0][i] = nm; st[1][i] = nm; }
#pragma unroll
  for (int kb = 0; kb < 2; ++kb)
#pragma unroll
    for (int ks = 0; ks < 6; ++ks) {
      const bf16x8 kf = *(const bf16x8*)(sk + kb * 32 * KST2 + ks * 16);
      st[kb] = MFMA(kf, qf[ks], st[kb]);
    }
}
DI float att_softmax(f32x16 (&st)[2], float adj, bool adjnz, bool first, float& mref, float& l, f32x16 (&o)[2]) {
  float mx = st[0][0];
#pragma unroll
  for (int i = 1; i < 16; ++i) mx = fmaxf(mx, st[0][i]);
#pragma unroll
  for (int i = 0; i < 16; ++i) mx = fmaxf(mx, st[1][i]);
  mx = xor32_max(mx) - adj;
  f2v ps = f2v{0.f, 0.f};
  float shift_out = 0.f;
  if (first || adjnz || __builtin_amdgcn_ballot_w64(mx > 8.f) != 0ull) {
    const float shift = first ? mx : fmaxf(mx, 0.f);
    const float tot = adj + shift;
    const float alpha = first ? 0.f : __builtin_amdgcn_exp2f(-shift);
    mref += shift;
#pragma unroll
    for (int kb = 0; kb < 2; ++kb)
#pragma unroll
      for (int i = 0; i < 16; i += 2) {
        const float p0 = __builtin_amdgcn_exp2f(st[kb][i] - tot), p1 = __builtin_amdgcn_exp2f(st[kb][i + 1] - tot);
        st[kb][i] = p0; st[kb][i + 1] = p1; ps += f2v{p0, p1};
      }
    l = l * alpha + (ps.x + ps.y);
#pragma unroll
    for (int i = 0; i < 16; ++i) { o[0][i] *= alpha; o[1][i] *= alpha; }
    shift_out = shift;
  } else {
#pragma unroll
    for (int kb = 0; kb < 2; ++kb)
#pragma unroll
      for (int i = 0; i < 16; i += 2) {
        const float p0 = __builtin_amdgcn_exp2f(st[kb][i]), p1 = __builtin_amdgcn_exp2f(st[kb][i + 1]);
        st[kb][i] = p0; st[kb][i + 1] = p1; ps += f2v{p0, p1};
      }
    l += ps.x + ps.y;
  }
  return shift_out;
}
DI void att_pv(const u16* sv, const f32x16 (&st)[2], f32x16 (&o)[2]) {
#pragma unroll
  for (int s4 = 0; s4 < 4; ++s4) {
    const int kb = s4 >> 1, rb = 8 * (s4 & 1);
    u4v pu; pu.x = pk2(st[kb][rb], st[kb][rb + 1]); pu.y = pk2(st[kb][rb + 2], st[kb][rb + 3]);
    pu.z = pk2(st[kb][rb + 4], st[kb][rb + 5]); pu.w = pk2(st[kb][rb + 6], st[kb][rb + 7]);
    const bf16x8 pb = __builtin_bit_cast(bf16x8, pu);
#pragma unroll
    for (int db = 0; db < 2; ++db) {
      const s16x4 lo = *(const s16x4*)(sv + db * 32 * VST2 + 16 * s4);
      const s16x4 hi = *(const s16x4*)(sv + db * 32 * VST2 + 16 * s4 + 8);
      const bf16x8 vf = __builtin_shufflevector(lo, hi, 0, 1, 2, 3, 4, 5, 6, 7);
      o[db] = MFMA(vf, pb, o[db]);
    }
  }
}
DI void attn8_item(const Params& p, u16* lds, int bh, int qt) {
  unsigned char* ws = p.ws;
  const int tid = threadIdx.x, lane = tid & 63, w = tid >> 6, r = lane & 31, h = lane >> 5;
  const u16* Qp = (const u16*)(ws + OFF_Q) + (size_t)bh * 4096 * 96;
  const u16* Kp = (const u16*)(ws + OFF_K) + (size_t)bh * 4096 * 96;
  const u16* Vp = (const u16*)(ws + OFF_VTT) + (size_t)bh * 64 * 4096;
  const int q0 = qt * 256 + w * 32;
  bf16x8 qf[6];
#pragma unroll
  for (int ks = 0; ks < 6; ++ks) qf[ks] = *(const bf16x8*)(Qp + (size_t)(q0 + r) * 96 + ks * 16 + h * 8);
  f32x16 o[2]; o[0] = zero16(); o[1] = zero16();
  float mref = 0.f, l = 0.f;
  const int Jmax = 2 * qt + 1, jw = 4 * qt + (w >> 1);
  int kr[3], kc[3];
#pragma unroll
  for (int i = 0; i < 3; ++i) { const int idx = tid + 512 * i; kr[i] = idx / 12; kc[i] = idx % 12; }
  const int vr = tid >> 4, vc = tid & 15;
  u4v rk[3], rv[2];
#pragma unroll
  for (int i = 0; i < 3; ++i) rk[i] = *(const u4v*)(Kp + (size_t)kr[i] * 96 + kc[i] * 8);
#pragma unroll
  for (int i = 0; i < 2; ++i) rv[i] = *(const u4v*)(Vp + (size_t)(vr + 32 * i) * 4096 + vc * 8);
  __syncthreads();
#pragma unroll
  for (int i = 0; i < 3; ++i) *(u4v*)(lds + kr[i] * KST2 + kc[i] * 8) = rk[i];
#pragma unroll
  for (int i = 0; i < 2; ++i) { u16* dv = lds + 128 * KST2 + (vr + 32 * i) * VST2 + vc * 8; *(u2v*)dv = u2v{rv[i].x, rv[i].y}; *(u2v*)(dv + 4) = u2v{rv[i].z, rv[i].w}; }
  __syncthreads();
  for (int J = 0; J <= Jmax; ++J) {
    const int cur = J & 1;
    if (J < Jmax) {
#pragma unroll
      for (int i = 0; i < 3; ++i) rk[i] = *(const u4v*)(Kp + (size_t)((J + 1) * 128 + kr[i]) * 96 + kc[i] * 8);
#pragma unroll
      for (int i = 0; i < 2; ++i) rv[i] = *(const u4v*)(Vp + (size_t)(vr + 32 * i) * 4096 + (J + 1) * 128 + vc * 8);
    }
    const u16* sk = lds + cur * ATT_BUF2 + r * KST2 + h * 8;
    const u16* sv = lds + cur * ATT_BUF2 + 128 * KST2 + r * VST2 + 4 * h;
    if (2 * J + 1 <= jw) {
      f32x16 s0[2], s1[2];
      const float nm = -mref;
      att_qk(sk, qf, nm, s0);
      att_qk(sk + 64 * KST2, qf, nm, s1);
      const float sh = att_softmax(s0, 0.f, false, J == 0, mref, l, o);
      const bool adjnz = __builtin_amdgcn_ballot_w64(sh != 0.f) != 0ull;
      att_pv(sv, s0, o);
      att_softmax(s1, sh, adjnz, false, mref, l, o);
      att_pv(sv + 64, s1, o);
    } else if (2 * J <= jw) {
      f32x16 s0[2];
      att_qk(sk, qf, -mref, s0);
      att_softmax(s0, 0.f, false, J == 0, mref, l, o);
      att_pv(sv, s0, o);
    }
    if (J < Jmax) {
      u16* d = lds + (cur ^ 1) * ATT_BUF2;
#pragma unroll
      for (int i = 0; i < 3; ++i) *(u4v*)(d + kr[i] * KST2 + kc[i] * 8) = rk[i];
#pragma unroll
      for (int i = 0; i < 2; ++i) { u16* dv = d + 128 * KST2 + (vr + 32 * i) * VST2 + vc * 8; *(u2v*)dv = u2v{rv[i].x, rv[i].y}; *(u2v*)(dv + 4) = u2v{rv[i].z, rv[i].w}; }
    }
    __syncthreads();
  }
  l = xor32_add(l);
  const float inv = 1.f / l;
  const int b = bh >> 3, head = bh & 7;
  const size_t tok = (size_t)b * 4096 + q0 + r;
  const u16* sga = (const u16*)(ws + OFF_SGA) + tok * 512 + head * 64;
  u16* ya = (u16*)(ws + OFF_YA) + tok * 512 + head * 64;
#pragma unroll
  for (int db = 0; db < 2; ++db)
#pragma unroll
    for (int g = 0; g < 4; ++g) {
      const int dv0 = db * 32 + 8 * g + 4 * h;
      const u2v gt = *(const u2v*)(sga + dv0);
      u2v ov;
      ov.x = pk2(o[db][4 * g] * inv * bflo(gt.x), o[db][4 * g + 1] * inv * bfhi(gt.x));
      ov.y = pk2(o[db][4 * g + 2] * inv * bflo(gt.y), o[db][4 * g + 3] * inv * bfhi(gt.y));
      *(u2v*)(ya + dv0) = ov;
    }
}

DI void scan_item(const Params& p, int i, size_t out_off = OFF_UPD) {
  unsigned char* ws = p.ws;
  const int tid = threadIdx.x;
  const int bh = i >> 2, part = i & 3;
  const int e = part * 1024 + tid * 2, k = e & 63;
  u32* U = (u32*)((u16*)(ws + OFF_UPD) + (size_t)bh * 128 * 4096 + e);
  u32* UO = (u32*)((u16*)(ws + out_off) + (size_t)bh * 128 * 4096 + e);
  const f2v* Dc = (const f2v*)((const float*)(ws + OFF_DECAY) + (size_t)bh * 128 * 64 + k);
  float s0 = 0.f, s1 = 0.f;
  for (int n0 = 0; n0 < 128; n0 += 32) {
    u32 u[32]; f2v d[32];
#pragma unroll
    for (int q = 0; q < 32; ++q) { u[q] = U[(size_t)(n0 + q) * 2048]; d[q] = Dc[(n0 + q) * 32]; }
#pragma unroll
    for (int q = 0; q < 32; ++q) {
      UO[(size_t)(n0 + q) * 2048] = pk2(s0, s1);
      s0 = d[q].x * (s0 + bflo(u[q]));
      s1 = d[q].y * (s1 + bfhi(u[q]));
    }
  }
}

DI void phase3(const Params& p, unsigned char* smem, bool dup = false) {
  int* s_item = (int*)(smem + LDS_BYTES - 64);
  int* ctr = (int*)(p.ws + OFF_SSQ + (size_t)3 * T * 4) + (dup ? 1 : 0);
  constexpr int NSCAN = 256, NATT = 1024;
  for (;;) {
    __syncthreads();
    if (threadIdx.x == 0) *s_item = atomicAdd(ctr, 1);
    __syncthreads();
    const int item = *s_item;
    if (item >= NSCAN + NATT) break;
    if (item < NSCAN) { if (!dup) scan_item(p, item); }
    else { const int idx = item - NSCAN; attn8_item(p, (u16*)smem, idx & 63, 15 - (idx >> 6)); }
  }
}

DI void phase4(const Params& p) {
  unsigned char* ws = p.ws;
  const int tid = VTID, lane = tid & 63, w = tid >> 6, r = lane & 31, h = lane >> 5;
  for (int t = VBID; t < 2048; t += VBN) {
    const int bh = t >> 5, n = (t & 31) * 4 + w;
    const int b = bh >> 3, head = bh & 7;
    const size_t tok0 = (size_t)b * 4096 + n * 32;
    const u16* qd = (const u16*)(ws + OFF_QDEC) + (tok0 + r) * 512 + head * 64 + h * 8;
    const u16* ki = (const u16*)(ws + OFF_KINV) + (tok0 + r) * 512 + head * 64 + h * 8;
    const u16* vt = (const u16*)(ws + OFF_VT) + ((size_t)bh * 128 + n) * 64 * 32;
    const u16* sp = (const u16*)(ws + OFF_UPD) + ((size_t)bh * 128 + n) * 4096;
    bf16x8 qf[4], kf[4];
#pragma unroll
    for (int ks = 0; ks < 4; ++ks) { qf[ks] = *(const bf16x8*)(qd + ks * 16); kf[ks] = *(const bf16x8*)(ki + ks * 16); }
    f32x16 at = zero16();
#pragma unroll
    for (int ks = 0; ks < 4; ++ks) at = MFMA(kf[ks], qf[ks], at);
#pragma unroll
    for (int i = 0; i < 16; ++i) if (crow(i, h) > r) at[i] = 0.f;
    f32x16 o[2]; o[0] = zero16(); o[1] = zero16();
#pragma unroll
    for (int s2 = 0; s2 < 2; ++s2) {
      u4v pu; pu.x = pk2(at[8 * s2], at[8 * s2 + 1]); pu.y = pk2(at[8 * s2 + 2], at[8 * s2 + 3]);
      pu.z = pk2(at[8 * s2 + 4], at[8 * s2 + 5]); pu.w = pk2(at[8 * s2 + 6], at[8 * s2 + 7]);
      const bf16x8 pb = __builtin_bit_cast(bf16x8, pu);
#pragma unroll
      for (int vb = 0; vb < 2; ++vb) {
        const s16x4 lo = *(const s16x4*)(vt + (vb * 32 + r) * 32 + 16 * s2 + 4 * h);
        const s16x4 hi = *(const s16x4*)(vt + (vb * 32 + r) * 32 + 16 * s2 + 8 + 4 * h);
        const bf16x8 vf = __builtin_shufflevector(lo, hi, 0, 1, 2, 3, 4, 5, 6, 7);
        o[vb] = MFMA(vf, pb, o[vb]);
      }
    }
#pragma unroll
    for (int vb = 0; vb < 2; ++vb)
#pragma unroll
      for (int ks = 0; ks < 4; ++ks) {
        const bf16x8 sf = *(const bf16x8*)(sp + (vb * 32 + r) * 64 + ks * 16 + h * 8);
        o[vb] = MFMA(sf, qf[ks], o[vb]);
      }
    float ss = 0.f;
#pragma unroll
    for (int i = 0; i < 16; ++i) ss += o[0][i] * o[0][i] + o[1][i] * o[1][i];
    ss = xor32_add(ss);
    const float rs = rsqrtf(ss * (1.f / 64.f) + EPS);
    const u16* sgb = (const u16*)(ws + OFF_SGB) + (tok0 + r) * 512 + head * 64;
    u16* yb = (u16*)(ws + OFF_YB) + (tok0 + r) * 512 + head * 64;
#pragma unroll
    for (int vb = 0; vb < 2; ++vb)
#pragma unroll
      for (int g = 0; g < 4; ++g) {
        const int v0 = vb * 32 + 8 * g + 4 * h;
        const u2v gt = *(const u2v*)(sgb + v0);
        u2v ov;
        ov.x = pk2(o[vb][4 * g] * rs * bflo(gt.x), o[vb][4 * g + 1] * rs * bfhi(gt.x));
        ov.y = pk2(o[vb][4 * g + 2] * rs * bflo(gt.y), o[vb][4 * g + 3] * rs * bfhi(gt.y));
        *(u2v*)(yb + v0) = ov;
      }
  }
}

DI void phase5(const Params& p, unsigned char* smem) {
  unsigned char* ws = p.ws;
  pg8::StaticOrder S; S.init(T, 1024, (int)gridDim.x, (int)blockIdx.x);
  {
    pg8::Gemm g{(const u16*)(ws + OFF_YA), (const u16*)(ws + OFF_WA), T, 1024, 512};
    Epi5<false> E{(const u16*)p.out, (u16*)(ws + OFF_H), (u16*)(ws + OFF_M)};
    pg8::gemm_phase<Epi5<false>, pg8::StaticOrder, false>((PG8_LAS unsigned char*)smem, g, S, E, nullptr);
  }
  {
    pg8::Gemm g{(const u16*)(ws + OFF_YB), (const u16*)(ws + OFF_WB), T, 1024, 512};
    Epi5<true> E{(const u16*)p.out, (u16*)(ws + OFF_H), (u16*)(ws + OFF_M)};
    pg8::gemm_phase<Epi5<true>, pg8::StaticOrder, false>((PG8_LAS unsigned char*)smem, g, S, E, nullptr);
  }
}

DI void phase6(const Params& p, unsigned char* smem, bool dup = false) {
  unsigned char* ws = p.ws;
  pg8::Gemm g{(const u16*)(ws + OFF_M), (const u16*)(ws + OFF_WO), T, 1024, 1024};
  pg8::StaticOrder S; S.init(T, 1024, (int)gridDim.x, (int)blockIdx.x);
  Epi6 E{(u16*)(ws + OFF_H), (float*)(ws + OFF_SSQ) + 2 * T, dup};
  pg8::gemm_phase<Epi6, pg8::StaticOrder, false>((PG8_LAS unsigned char*)smem, g, S, E, nullptr);
}

DI void phase7(const Params& p) {
  const float* ssq_y = (const float*)(p.ws + OFF_SSQ) + 2 * T;
  const u2v* Y = (const u2v*)(p.ws + OFF_H);
  const int gtid = blockIdx.x * blockDim.x + threadIdx.x, gthreads = gridDim.x * blockDim.x;
  for (int i = gtid; i < T * 256; i += gthreads) {
    const int row = i >> 8, c4 = i & 255;
    const float rs = rsqrtf(ssq_y[row] * (1.f / 1024.f) + EPS);
    const u2v y = Y[i];
    const f4v xv = ((const f4v*)p.x)[i];
    const f4v g = ((const f4v*)p.g_post)[c4];
    f4v o;
    o.x = xv.x + bflo(y.x) * rs * g.x; o.y = xv.y + bfhi(y.x) * rs * g.y; o.z = xv.z + bflo(y.y) * rs * g.z; o.w = xv.w + bfhi(y.y) * rs * g.w;
    ((f4v*)p.out)[i] = o;
  }
}

__global__ void __launch_bounds__(512, 2) fwd_megakernel(Params p) {
  extern __shared__ __attribute__((aligned(16))) unsigned char smem[];
  u16* lds = (u16*)(smem + (threadIdx.x >> 8) * VLDS);
  cg::grid_group grid = cg::this_grid();
  volatile LAS unsigned* xst = (volatile LAS unsigned*)(smem + LDS_BYTES - 48);
  if (threadIdx.x == 0) { xst[0] = 0u; xst[1] = 0u; }
  __syncthreads();
  XcdBarrier xb = xcd_barrier_post((unsigned*)(p.ws + OFF_BAR), xst);
  if (p.ph_hi > 1000) grid.sync();
#define RUN_PHASE(N, CALL) if (p.ph_lo <= N && N < p.ph_hi) { if (N > p.ph_lo) xcd_barrier(xb); CALL; }
#define DUP_PHASE(N, CALL) if (DUP_PH == N) { xcd_barrier(xb); CALL; }
  RUN_PHASE(0, phase0(p))
  DUP_PHASE(0, phase0(p))
  if (p.ph_lo <= 1 && 1 < p.ph_hi) for (int rep = 0; rep < (DUP_PH == 1 ? 2 : 1); ++rep) { if (rep > 0 || 1 > p.ph_lo) xcd_barrier(xb); phase1(p, smem, rep > 0); }
  if (p.ph_lo <= 2 && 2 < p.ph_hi) for (int rep = 0; rep < (DUP_PH == 2 ? 2 : 1); ++rep) { if (rep > 0 || 2 > p.ph_lo) xcd_barrier(xb); phase2(p, smem, lds); }
  RUN_PHASE(3, phase2b(p, smem))
  DUP_PHASE(3, phase2b(p, smem))
  RUN_PHASE(4, phase3(p, smem))
  DUP_PHASE(4, phase3(p, smem, true))
  if (DUP_PH == 9) { xcd_barrier(xb); for (int i = blockIdx.x; i < 256; i += gridDim.x) scan_item(p, i, OFF_K); }
  RUN_PHASE(5, phase4(p))
  DUP_PHASE(5, phase4(p))
  RUN_PHASE(6, phase5(p, smem))
  DUP_PHASE(6, phase5(p, smem))
  RUN_PHASE(7, phase6(p, smem))
  DUP_PHASE(7, phase6(p, smem, true))
  RUN_PHASE(8, phase7(p))
  if (DUP_PH == 8) { xcd_barrier(xb); phase6(p, smem, true); xcd_barrier(xb); phase7(p); }
}

extern "C" void kernel_launch(void* const* d_in, const int* in_sizes, int n_in, void* d_out, int out_size, void* d_ws, size_t ws_size,
                              hipStream_t stream) {
  static int grid_blocks = 0;
  if (!grid_blocks) {
    int dev = 0, cus = 0, per_cu = 0;
    hipGetDevice(&dev);
    hipDeviceGetAttribute(&cus, hipDeviceAttributeMultiprocessorCount, dev);
    hipFuncSetAttribute((const void*)fwd_megakernel, hipFuncAttributeMaxDynamicSharedMemorySize, LDS_BYTES);
    hipOccupancyMaxActiveBlocksPerMultiprocessor(&per_cu, (const void*)fwd_megakernel, 512, LDS_BYTES);
    if (per_cu < 1) per_cu = 1;
    if (per_cu > 1) per_cu = 1;
    grid_blocks = cus * per_cu;
    if (ws_size < WS_NEED) fprintf(stderr, "kernel_launch: workspace too small: %zu < %zu\n", ws_size, (size_t)WS_NEED);
  }
  if (ws_size < WS_NEED) return;
  Params p{};
  p.x = (const float*)d_in[0]; p.g_pre = (const float*)d_in[1]; p.w_in = (const float*)d_in[2]; p.b_gate = (const float*)d_in[3];
  p.g_q = (const float*)d_in[4]; p.w_uq = (const float*)d_in[5]; p.g_kv = (const float*)d_in[6]; p.w_ukv = (const float*)d_in[7];
  p.lb_logits = (const float*)d_in[8]; p.g_hgrn = (const float*)d_in[9]; p.w_a = (const float*)d_in[10]; p.w_b = (const float*)d_in[11];
  p.w_out = (const float*)d_in[12]; p.g_post = (const float*)d_in[13];
  p.out = (float*)d_out; p.ws = (unsigned char*)d_ws;
#if ONE_LAUNCH
  p.ph_lo = 0; p.ph_hi = 9;
  (void)hipMemsetAsync((unsigned char*)d_ws + OFF_BAR, 0, 16384, stream);
  void* args[] = {&p};
  hipError_t e = hipLaunchCooperativeKernel((const void*)fwd_megakernel, dim3(grid_blocks), dim3(512), args, LDS_BYTES, stream);
  if (e != hipSuccess) fprintf(stderr, "cooperative launch failed: %s (grid %d)\n", hipGetErrorString(e), grid_blocks);
#else
  for (int ph = 0; ph < 9; ++ph) {
    p.ph_lo = ph; p.ph_hi = ph + 1;
    (void)hipMemsetAsync((unsigned char*)d_ws + OFF_BAR, 0, 16384, stream);
    void* args[] = {&p};
    hipError_t e = hipLaunchCooperativeKernel((const void*)fwd_megakernel, dim3(grid_blocks), dim3(512), args, LDS_BYTES, stream);
    if (e != hipSuccess) fprintf(stderr, "cooperative launch failed: %s (grid %d)\n", hipGetErrorString(e), grid_blocks);
  }
#endif
}
```

```cpp
#include <hip/hip_runtime.h>
#include <hip/hip_cooperative_groups.h>
#include <cstdio>
namespace cg = cooperative_groups;

#define DI __device__ __forceinline__
#define VTID ((int)(threadIdx.x & 255))
#define VBID ((int)(blockIdx.x * 2 + (threadIdx.x >> 8)))
#define VBN ((int)(gridDim.x * 2))
typedef unsigned short u16;
typedef unsigned int u32;
typedef __attribute__((ext_vector_type(8))) short bf16x8;
typedef __attribute__((ext_vector_type(4))) short s16x4;
typedef __attribute__((ext_vector_type(16))) float f32x16;
typedef __attribute__((ext_vector_type(2))) __bf16 bf2_t;
typedef __attribute__((ext_vector_type(2))) float f2_t;
typedef __attribute__((ext_vector_type(4))) unsigned int u4v;
typedef __attribute__((ext_vector_type(2))) unsigned int u2v;
typedef __attribute__((ext_vector_type(4))) float f4v;
typedef __attribute__((ext_vector_type(2))) float f2v;
#define MFMA(a, b, c) __builtin_amdgcn_mfma_f32_32x32x16_bf16((a), (b), (c), 0, 0, 0)

#ifndef DUP_PH
#define DUP_PH -1
#endif
#ifndef ONE_LAUNCH
#define ONE_LAUNCH 1
#endif

constexpr int T = 32768;
constexpr int SEQ = 4096;
constexpr int DIN = 5664;
constexpr int NP = 5888;
constexpr float EPS = 1e-6f;
constexpr float QSCALE = 1.4426950408889634f * 0.10206207261596575f;

constexpr size_t SZ_WIN = (size_t)NP * 1024 * 2;
constexpr size_t OFF_WIN = 0;
constexpr size_t OFF_WUQ = OFF_WIN + SZ_WIN;
constexpr size_t OFF_WUKV = OFF_WUQ + (size_t)768 * 768 * 2;
constexpr size_t OFF_WA = OFF_WUKV + (size_t)1024 * 256 * 2;
constexpr size_t OFF_WB = OFF_WA + (size_t)1024 * 512 * 2;
constexpr size_t OFF_WO = OFF_WB + (size_t)1024 * 512 * 2;
constexpr size_t OFF_ROPE = OFF_WO + (size_t)1024 * 1024 * 2;
constexpr size_t OFF_SSQ = OFF_ROPE + (size_t)4096 * 16 * 2 * 4;
constexpr size_t OFF_DECAY = OFF_SSQ + (size_t)(3 * T + 64) * 4;
constexpr size_t OFF_H = OFF_DECAY + (size_t)64 * 128 * 64 * 4;
constexpr size_t OFF_Q = OFF_H;
constexpr size_t OFF_CQ = OFF_H + (size_t)T * 1024 * 2;
constexpr size_t OFF_YA = OFF_CQ;
constexpr size_t OFF_CKV = OFF_CQ + (size_t)T * 768 * 2;
constexpr size_t OFF_KPE = OFF_CKV + (size_t)T * 256 * 2;
constexpr size_t OFF_SGA = OFF_KPE + (size_t)T * 32 * 4;
constexpr size_t OFF_SGB = OFF_SGA + (size_t)T * 512 * 2;
constexpr size_t OFF_HQ = OFF_SGB + (size_t)T * 512 * 2;
constexpr size_t OFF_UPD = OFF_HQ;
constexpr size_t OFF_HF = OFF_HQ + (size_t)T * 512 * 2;
constexpr size_t OFF_HI = OFF_HF + (size_t)T * 512 * 2;
constexpr size_t OFF_YB = OFF_HI;
constexpr size_t OFF_QDEC = OFF_HI + (size_t)T * 512 * 2;
constexpr size_t OFF_KINV = OFF_QDEC + (size_t)T * 512 * 2;
constexpr size_t OFF_VT = OFF_KINV + (size_t)T * 512 * 2;
constexpr size_t OFF_K = OFF_VT + (size_t)T * 512 * 2;
constexpr size_t OFF_M = OFF_K;
constexpr size_t OFF_VTT = OFF_K + (size_t)T * 768 * 2;
constexpr size_t OFF_BAR = OFF_VTT + (size_t)T * 512 * 2;
constexpr size_t WS_NEED = OFF_BAR + 16384;

constexpr int VLDS = 2 * 2 * 128 * 72 * 2;
constexpr int LDS_BYTES = 2 * VLDS + 64;
constexpr int SST = 132;

struct Params {
  const float *x, *g_pre, *w_in, *b_gate, *g_q, *w_uq, *g_kv, *w_ukv, *lb_logits, *g_hgrn, *w_a, *w_b, *w_out, *g_post;
  float* out;
  unsigned char* ws;
  int ph_lo, ph_hi;
};

DI u32 pk2(float a, float b) { f2_t v = {a, b}; bf2_t r = __builtin_convertvector(v, bf2_t); return __builtin_bit_cast(u32, r); }
DI float bflo(u32 u) { return __uint_as_float(u << 16); }
DI float bfhi(u32 u) { return __uint_as_float(u & 0xffff0000u); }
DI u4v pk8(f4v a, f4v b) { u4v r; r.x = pk2(a.x, a.y); r.y = pk2(a.z, a.w); r.z = pk2(b.x, b.y); r.w = pk2(b.z, b.w); return r; }
DI float rcpf(float x) { return __builtin_amdgcn_rcpf(x); }
DI float sigmoidf_(float x) { return rcpf(1.f + __expf(-x)); }
DI float siluf_(float x) { return x * sigmoidf_(x); }
DI float xor32_max(float x) { const unsigned u = __float_as_uint(x); auto r = __builtin_amdgcn_permlane32_swap(u, u, false, false); return fmaxf(__uint_as_float(r[0]), __uint_as_float(r[1])); }
DI float xor32_add(float x) { const unsigned u = __float_as_uint(x); auto r = __builtin_amdgcn_permlane32_swap(u, u, false, false); return __uint_as_float(r[0]) + __uint_as_float(r[1]); }
DI float xor16_add(float x) { const unsigned u = __float_as_uint(x); auto r = __builtin_amdgcn_permlane16_swap(u, u, false, false); return __uint_as_float(r[0]) + __uint_as_float(r[1]); }
DI int crow(int reg, int h) { return (reg & 3) + 8 * (reg >> 2) + 4 * h; }
DI f32x16 zero16() { f32x16 z;
#pragma unroll
  for (int i = 0; i < 16; ++i) z[i] = 0.f; return z; }

__constant__ float c_invfreq[16] = {1.0f, 0.5623413324356079f, 0.3162277638912201f, 0.17782793939113617f, 0.10000000149011612f,
  0.05623413249850273f, 0.03162277489900589f, 0.017782794311642647f, 0.009999999776482582f, 0.005623413249850273f,
  0.003162277629598975f, 0.0017782794311642647f, 0.0010000000474974513f, 0.000562341301701963f, 0.0003162277571391314f,
  0.00017782794020604342f};

DI void sincos_d(double a, float& sn, float& cs) {
  const double k = rint(a * 0.63661977236758134308);
  const double y = a - k * 1.57079632679489661923;
  const double y2 = y * y;
  const double s = y * (1.0 + y2 * (-1.0 / 6 + y2 * (1.0 / 120 + y2 * (-1.0 / 5040 + y2 * (1.0 / 362880 + y2 * (-1.0 / 39916800 + y2 * (1.0 / 6227020800.0)))))));
  const double c = 1.0 + y2 * (-0.5 + y2 * (1.0 / 24 + y2 * (-1.0 / 720 + y2 * (1.0 / 40320 + y2 * (-1.0 / 3628800 + y2 * (1.0 / 479001600.0 + y2 * (-1.0 / 87178291200.0)))))));
  const int q = ((int)k) & 3;
  const double ss = (q == 0) ? s : (q == 1) ? c : (q == 2) ? -s : -c;
  const double cc = (q == 0) ? c : (q == 1) ? -s : (q == 2) ? -c : s;
  sn = (float)ss; cs = (float)cc;
}

#define XB_TMO      128
#define XB_XCNT(j)  (256  + 64 * (j))
#define XB_XSUB(j)  (1280 + 64 * (j))
#define XB_XGEN(j)  (2304 + 64 * (j))
#define XB_TOP      3328
#define XB_TOPGEN   3392
#define XCD_BAR_WORDS 3456
#define XB_SPIN_CAP (1u << 22)
#define LAS __attribute__((address_space(3)))
DI unsigned xb_ld(unsigned* p)              { return __hip_atomic_load(p, __ATOMIC_RELAXED, __HIP_MEMORY_SCOPE_AGENT); }
DI unsigned xb_add(unsigned* p, unsigned v) { return __hip_atomic_fetch_add(p, v, __ATOMIC_RELAXED, __HIP_MEMORY_SCOPE_AGENT); }
DI unsigned xb_xcc_id() { return (unsigned)__builtin_amdgcn_s_getreg((3 << 11) | 20) & 0xFu; }
#define XB_SPIN(cond, bar) do { unsigned _sp = 0; while (cond) { __builtin_amdgcn_s_sleep(1); \
    if ((++_sp & 255u) == 0u) { if (xb_ld(&(bar)[XB_TMO])) break; if (_sp > XB_SPIN_CAP) { atomicAdd(&(bar)[XB_TMO], 1u); break; } } } } while (0)
struct XcdBarrier { unsigned* bar; unsigned x; volatile LAS unsigned* st; };
DI XcdBarrier xcd_barrier_post(unsigned* bar, volatile LAS unsigned* st) {
  XcdBarrier b; b.bar = bar; b.x = xb_xcc_id(); b.st = st;
  if (threadIdx.x == 0) (void)xb_add(&bar[XB_XCNT(b.x)], 1u);
  return b;
}
DI void xcd_barrier_complete(unsigned* bar, unsigned x, unsigned& nloc, unsigned& nx) {
  const unsigned G = gridDim.x * gridDim.y * gridDim.z;
  unsigned sum, cnt, mine, sp = 0u;
  for (;;) {
    sum = 0u; cnt = 0u; mine = 0u;
#pragma unroll
    for (unsigned j = 0; j < 16; ++j) { const unsigned c = xb_ld(&bar[XB_XCNT(j)]); sum += c; cnt += (c > 0u) ? 1u : 0u; mine = (j == x) ? c : mine; }
    if (sum == G) break;
    __builtin_amdgcn_s_sleep(1);
    if ((++sp & 255u) == 0u) { if (xb_ld(&bar[XB_TMO])) break; if (sp > XB_SPIN_CAP) { atomicAdd(&bar[XB_TMO], 1u); break; } }
  }
  nloc = mine > 0u ? mine : 1u; nx = cnt > 0u ? cnt : 1u;
}
DI void xcd_barrier(const XcdBarrier& b) {
  asm volatile("s_waitcnt vmcnt(0)" ::: "memory");
  __syncthreads();
  if (threadIdx.x == 0) {
    unsigned* bar = b.bar;
    __builtin_amdgcn_s_waitcnt(0);
    unsigned nloc = b.st[0], nx = b.st[1];
    if (nloc == 0u) { xcd_barrier_complete(bar, b.x, nloc, nx); b.st[0] = nloc; b.st[1] = nx; }
    const unsigned old = xb_add(&bar[XB_XSUB(b.x)], 1u);
    const unsigned gen = old / nloc;
    if (old + 1u == (gen + 1u) * nloc) {
      __builtin_amdgcn_fence(__ATOMIC_RELEASE, "agent");
      asm volatile("s_waitcnt vmcnt(0)" ::: "memory");
      const unsigned og = xb_add(&bar[XB_TOP], 1u);
      const unsigned tg = og / nx;
      if (og + 1u == (tg + 1u) * nx) xb_add(&bar[XB_TOPGEN], 1u);
      else XB_SPIN(xb_ld(&bar[XB_TOPGEN]) == tg, bar);
      __builtin_amdgcn_fence(__ATOMIC_ACQUIRE, "agent");
      xb_add(&bar[XB_XGEN(b.x)], 1u);
      asm volatile("s_waitcnt vmcnt(0)" ::: "memory");
    } else {
      XB_SPIN(xb_ld(&bar[XB_XGEN(b.x)]) == gen, bar);
      __builtin_amdgcn_fence(__ATOMIC_ACQUIRE, "agent");
      asm volatile("s_waitcnt vmcnt(0)" ::: "memory");
    }
  }
  __syncthreads();
}

template <int KIND>
DI int colmap(int n) {
  if (KIND == 0) {
    if (n < 1024) return n;
    if (n < 1536) return 1056 + (n - 1024);
    if (n < 2048) return 3104 + (n - 1536);
    if (n < 4096) return 3616 + (n - 2048);
    if (n < 4608) return 1568 + (n - 4096);
    if (n < 5120) return 2080 + (n - 4608);
    if (n < 5632) return 2592 + (n - 5120);
    if (n < 5664) return 1024 + (n - 5632);
    return -1;
  } else if (KIND == 1) {
    if (n < 512) return (n >> 6) * 96 + (n & 63);
    int i = n - 512; int w = i & 31, g = w >> 3, e = w & 7; return (i >> 5) * 96 + 64 + ((e < 4) ? (4 * g + e) : (16 + 4 * g + (e - 4)));
  } else if (KIND == 3) {
    if (n < 512) return (n >> 6) * 128 + (n & 63);
    int i = n - 512; return (i >> 6) * 128 + 64 + (i & 63);
  } else return n;
}
template <int KIND>
DI void conv_weight(u16* dst, const float* src, int ldw, int ncount, int K, const float* gain, int gmask, int gtid, int gthreads) {
  const int total = ncount * (K >> 3);
  for (int it = gtid; it < total; it += gthreads) {
    const int n = it % ncount, kc = it / ncount;
    const int sc = colmap<KIND>(n);
    float v[8];
#pragma unroll
    for (int i = 0; i < 8; ++i) {
      const int k = kc * 8 + i;
      float x = (sc >= 0) ? src[(size_t)k * ldw + sc] : 0.f;
      if (gain) x *= gain[k & gmask];
      v[i] = x;
    }
    u4v o; o.x = pk2(v[0], v[1]); o.y = pk2(v[2], v[3]); o.z = pk2(v[4], v[5]); o.w = pk2(v[6], v[7]);
    *(u4v*)(dst + (size_t)n * K + kc * 8) = o;
  }
}

DI void phase0(const Params& p) {
  unsigned char* ws = p.ws;
  const int gtid = blockIdx.x * blockDim.x + threadIdx.x, gthreads = gridDim.x * blockDim.x;
  float* ssq = (float*)(ws + OFF_SSQ);
  for (int i = gtid; i < 3 * T + 64; i += gthreads) ssq[i] = 0.f;
  float* rope = (float*)(ws + OFF_ROPE);
  for (int i = gtid; i < 4096 * 16; i += gthreads) {
    const int pos = i >> 4, j = i & 15;
    const float ang = (float)pos * c_invfreq[j];
    float sn, cs; sincos_d((double)ang, sn, cs);
    rope[i] = cs; rope[65536 + i] = sn;
  }
  conv_weight<0>((u16*)(ws + OFF_WIN), p.w_in, DIN, NP, 1024, nullptr, 0, gtid, gthreads);
  u16* H = (u16*)(ws + OFF_H);
  const int lane = threadIdx.x & 63;
  const int gw = gtid >> 6, nw = gthreads >> 6;
  for (int row = gw; row < T; row += nw) {
    const f4v* xr = (const f4v*)(p.x + (size_t)row * 1024);
    f4v v[4];
    float ss = 0.f;
#pragma unroll
    for (int i = 0; i < 4; ++i) { v[i] = xr[lane * 4 + i]; ss += v[i].x * v[i].x + v[i].y * v[i].y + v[i].z * v[i].z + v[i].w * v[i].w; }
#pragma unroll
    for (int o = 32; o >= 1; o >>= 1) ss += __shfl_xor(ss, o);
    const float rs = rsqrtf(ss * (1.f / 1024.f) + EPS);
    const f4v* gp = (const f4v*)(p.g_pre);
    f4v g[4];
#pragma unroll
    for (int i = 0; i < 4; ++i) { g[i] = gp[lane * 4 + i]; v[i].x *= rs * g[i].x; v[i].y *= rs * g[i].y; v[i].z *= rs * g[i].z; v[i].w *= rs * g[i].w; }
    u4v* hr = (u4v*)(H + (size_t)row * 1024 + lane * 16);
    hr[0] = pk8(v[0], v[1]); hr[1] = pk8(v[2], v[3]);
  }
}

constexpr int TS = 128 * 72;
DI void gemm_ld(u4v (&ra)[4], u4v (&rb)[4], const u16* ga, const u16* gb, int lda, int ldb, int ko) {
#pragma unroll
  for (int i = 0; i < 4; ++i) { ra[i] = *(const u4v*)(ga + (size_t)(32 * i) * lda + ko); rb[i] = *(const u4v*)(gb + (size_t)(32 * i) * ldb + ko); }
}
DI void gemm_st(const u4v (&ra)[4], const u4v (&rb)[4], u16* buf, int lr, int lc) {
  u16* sa = buf; u16* sb = buf + TS;
#pragma unroll
  for (int i = 0; i < 4; ++i) { *(u4v*)(sa + (lr + 32 * i) * 72 + lc * 8) = ra[i]; *(u4v*)(sb + (lr + 32 * i) * 72 + lc * 8) = rb[i]; }
}
DI void gemm_mma(const u16* buf, f32x16 (&acc)[2][2], int wm, int wn, int r, int h) {
  const u16* sa = buf + (wm * 64 + r) * 72 + h * 8;
  const u16* sb = buf + TS + (wn * 64 + r) * 72 + h * 8;
#pragma unroll
  for (int ks = 0; ks < 4; ++ks) {
    const bf16x8 a0 = *(const bf16x8*)(sa + ks * 16);
    const bf16x8 a1 = *(const bf16x8*)(sa + 32 * 72 + ks * 16);
    const bf16x8 b0 = *(const bf16x8*)(sb + ks * 16);
    const bf16x8 b1 = *(const bf16x8*)(sb + 32 * 72 + ks * 16);
    acc[0][0] = MFMA(a0, b0, acc[0][0]);
    acc[0][1] = MFMA(a0, b1, acc[0][1]);
    acc[1][0] = MFMA(a1, b0, acc[1][0]);
    acc[1][1] = MFMA(a1, b1, acc[1][1]);
  }
}
DI void gemm_core(const u16* __restrict__ A, int lda, const u16* __restrict__ B, int ldb, int K, u16* lds, f32x16 (&acc)[2][2], int tid) {
  const int lane = tid & 63, w = tid >> 6, wm = w >> 1, wn = w & 1, r = lane & 31, h = lane >> 5;
  const int lc = tid & 7, lr = tid >> 3;
  const u16* ga = A + (size_t)lr * lda + lc * 8;
  const u16* gb = B + (size_t)lr * ldb + lc * 8;
  u4v ra0[4], rb0[4], ra1[4], rb1[4];
  gemm_ld(ra0, rb0, ga, gb, lda, ldb, 0);
  gemm_ld(ra1, rb1, ga, gb, lda, ldb, 64);
#pragma unroll
  for (int i = 0; i < 2; ++i)
#pragma unroll
    for (int j = 0; j < 2; ++j) acc[i][j] = zero16();
  u16* L0 = lds; u16* L1 = lds + 2 * TS;
  __syncthreads();
  gemm_st(ra0, rb0, L0, lr, lc);
  __syncthreads();
  const int nk = K >> 6;
  int kt = 0;
  for (; kt + 2 < nk; kt += 2) {
    gemm_ld(ra0, rb0, ga, gb, lda, ldb, (kt + 2) * 64);
    __builtin_amdgcn_sched_barrier(0);
    gemm_mma(L0, acc, wm, wn, r, h);
    gemm_st(ra1, rb1, L1, lr, lc);
    __syncthreads();
    gemm_ld(ra1, rb1, ga, gb, lda, ldb, (kt + 3) * 64);
    __builtin_amdgcn_sched_barrier(0);
    gemm_mma(L1, acc, wm, wn, r, h);
    gemm_st(ra0, rb0, L0, lr, lc);
    __syncthreads();
  }
  gemm_mma(L0, acc, wm, wn, r, h);
  gemm_st(ra1, rb1, L1, lr, lc);
  __syncthreads();
  gemm_mma(L1, acc, wm, wn, r, h);
  __syncthreads();
}

DI void stage_pass(const f32x16 (&acc)[2][2], float* stage, int p, int tid) {
  const int lane = tid & 63, w = tid >> 6, wm = w >> 1, wn = w & 1, r = lane & 31, h = lane >> 5;
  __syncthreads();
  if (wm == p) {
#pragma unroll
    for (int i = 0; i < 2; ++i)
#pragma unroll
      for (int j = 0; j < 2; ++j)
#pragma unroll
        for (int reg = 0; reg < 16; ++reg) stage[(i * 32 + crow(reg, h)) * SST + wn * 64 + j * 32 + r] = acc[i][j][reg];
  }
  __syncthreads();
}

namespace pg8 {
#define PG8_LAS __attribute__((address_space(3)))
typedef unsigned short bf16_t;
typedef short bf16x8 __attribute__((ext_vector_type(8)));
typedef float f32x4 __attribute__((ext_vector_type(4)));
typedef unsigned u32x4 __attribute__((ext_vector_type(4)));
constexpr int BM = 256, BK = 64, HALF = 128, HTB = HALF * BK * 2  , STAGE_BYTES = 8 * HTB, NXCD = 8, WGM = 8;

__host__ __device__ __forceinline__ int lds_byte(int r, int c) { const int st = (r >> 4) * 2 + (c >> 5), rr = r & 15, cc = c & 31, ob = rr * 64 + cc * 2; return st * 1024 + (ob ^ (((ob >> 9) & 1) << 5)); }
__host__ __device__ __forceinline__ void stage_rc(int b, int& R, int& C) { const int st = b / 1024, sb = b % 1024, swz = sb ^ (((sb >> 9) & 1) << 5); R = (st >> 1) * 16 + swz / 64; C = (st & 1) * 32 + (swz % 64) / 2; }
__host__ __device__ __forceinline__ int perm32(int rho) { const int n = rho >> 4, i = rho & 15; return 8 * (i >> 2) + 4 * n + (i & 3); }

struct Unit { int pm, pn; };
struct Gemm { const bf16_t* A; const bf16_t* Bt; int M, N, K; };

struct StaticOrder {
    int nM, nN, nwg, G, c;
    __host__ __device__ void init(int M, int N, int G_, int c_) { nM = M / BM; nN = N / BM; nwg = nM * nN; G = G_; c = c_; }
    __host__ __device__ bool next(int i, Unit& u) const {
        const long L = (long)i * G + c; if (L >= nwg) return false;
        int wgid = (int)L; { const int q = nwg / NXCD, r = nwg % NXCD, xcd = wgid % NXCD, off = wgid / NXCD; wgid = (xcd < r ? xcd * (q + 1) : r * (q + 1) + (xcd - r) * q) + off; }
        const int nig = WGM * nN, gid = wgid / nig, fm = gid * WGM, gsz = (nM - fm) < WGM ? (nM - fm) : WGM;
        u.pm = fm + ((wgid % nig) % gsz); u.pn = (wgid % nig) / gsz; return true;
    }
    __device__ __forceinline__ void a_ready(const Unit&) const {}
    __device__ __forceinline__ void done(const Unit&) const {}
};
template <class Epi, class Sched, bool STAMP = false, bool SWAP = false>
__device__ __forceinline__ void gemm_phase(PG8_LAS unsigned char* lds, const Gemm g, const Sched& S, const Epi& E, unsigned long long* stamps) {
    const int tid = threadIdx.x, wid = __builtin_amdgcn_readfirstlane(tid >> 6), lane = tid & 63, wr = wid >> 2, wc = wid & 3, fr = lane & 15, fq = lane >> 4;
    const int K = g.K, nt = K / BK;
    int ts_lo = 0, ts_hi = 0, nts = 0; const unsigned long long rt_entry = STAMP ? (unsigned long long)wall_clock64() : 0ull;
#define PG8_STAMP() do { if (STAMP && wid == 0 && nts < 64) { const unsigned long long _c = (unsigned long long)clock64(); \
        ts_lo = (lane == nts) ? (int)(unsigned)_c : ts_lo; ts_hi = (lane == nts) ? (int)(unsigned)(_c >> 32) : ts_hi; ++nts; } } while (0)
    PG8_STAMP();
    unsigned voffA[2], voffB[2];
#pragma unroll
    for (int i = 0; i < 2; ++i) { int R, C; stage_rc(tid * 16 + i * 8192, R, C); const int Rb = Epi::PERM ? ((R & ~31) + perm32(R & 31)) : R;
        voffA[i] = (unsigned)(R * K + C) * 2u; voffB[i] = (unsigned)(Rb * K + C) * 2u; }
    const size_t kstep = (size_t)(BK * 2);
    const size_t hstep = (size_t)HALF * K * 2;
    const size_t tstep = 2 * hstep;
    const unsigned ldsw = (unsigned)wid * 1024u;
    const int aoff = lds_byte(wr * 64 + fr, fq * 8), boff = lds_byte(wc * 32 + fr, fq * 8);
#define PG8_SA(b, h) (((b) * 2 + (h)) * HTB)
#define PG8_SB(b, h) ((4 + (b) * 2 + (h)) * HTB)
#define PG8_STAGE(bufoff, gbase, voff) do { _Pragma("unroll") for (int _i = 0; _i < 2; ++_i) \
        __builtin_amdgcn_global_load_lds((const unsigned*)((const char*)(gbase) + (voff)[_i]), (PG8_LAS unsigned*)(lds + (bufoff) + ldsw + _i * 8192), 16, 0, 0); } while (0)
#define PG8_LDA(dst, b, h) do { _Pragma("unroll") for (int m = 0; m < 4; ++m) _Pragma("unroll") for (int k = 0; k < 2; ++k) dst[m][k] = *(const PG8_LAS bf16x8*)(lds + PG8_SA(b, h) + aoff + m * 2048 + k * 1024); } while (0)
#define PG8_LDB(dst, b, h) do { _Pragma("unroll") for (int n = 0; n < 2; ++n) _Pragma("unroll") for (int k = 0; k < 2; ++k) dst[n][k] = *(const PG8_LAS bf16x8*)(lds + PG8_SB(b, h) + boff + n * 2048 + k * 1024); } while (0)
#define PG8_MMA(ai, bj, At, Bt) do { __builtin_amdgcn_s_setprio(1); _Pragma("unroll") for (int m = 0; m < 4; ++m) _Pragma("unroll") for (int n = 0; n < 2; ++n) _Pragma("unroll") for (int k = 0; k < 2; ++k) \
        acc[ai][bj][m][n] = SWAP ? __builtin_amdgcn_mfma_f32_16x16x32_bf16(At[m][k], Bt[n][k], acc[ai][bj][m][n], 0, 0, 0) : __builtin_amdgcn_mfma_f32_16x16x32_bf16(Bt[n][k], At[m][k], acc[ai][bj][m][n], 0, 0, 0); __builtin_amdgcn_s_setprio(0); } while (0)
#define PG8_WAIT_V(n) asm volatile("s_waitcnt vmcnt(" #n ")" ::: "memory")
#define PG8_WAIT_L(n) asm volatile("s_waitcnt lgkmcnt(" #n ")" ::: "memory")
#define PG8_BAR __builtin_amdgcn_s_barrier()
#define PG8_SCHED __builtin_amdgcn_sched_barrier(0)
    Unit cur, nxt; int ui = 0;
    if (!S.next(0, cur)) return;
    f32x4 acc[2][2][4][2];
#pragma unroll
    for (int a = 0; a < 2; ++a)
#pragma unroll
        for (int b = 0; b < 2; ++b)
#pragma unroll
            for (int m = 0; m < 4; ++m)
#pragma unroll
                for (int n = 0; n < 2; ++n) acc[a][b][m][n] = (f32x4){0.f, 0.f, 0.f, 0.f};
    bf16x8 At[4][2], B0[2][2], B1[2][2];
    const char* cA = (const char*)g.A + (size_t)cur.pm * tstep; const char* cB = (const char*)g.Bt + (size_t)cur.pn * tstep;
    S.a_ready(cur);
    PG8_STAGE(PG8_SB(0, 0), cB, voffB); PG8_STAGE(PG8_SA(0, 0), cA, voffA); PG8_STAGE(PG8_SB(0, 1), cB + hstep, voffB); PG8_STAGE(PG8_SA(0, 1), cA + hstep, voffA);
    if (wr == 1) PG8_BAR;
    PG8_WAIT_V(4); PG8_BAR;
    PG8_STAGE(PG8_SB(1, 0), cB + kstep, voffB); PG8_STAGE(PG8_SA(1, 0), cA + kstep, voffA); PG8_STAGE(PG8_SB(1, 1), cB + hstep + kstep, voffB);
    PG8_WAIT_V(6); PG8_BAR;
    PG8_STAMP();
    for (;;) {
        const bool has_next = S.next(ui + 1, nxt);
        const char* nA = has_next ? (const char*)g.A + (size_t)nxt.pm * tstep : cA; const char* nB = has_next ? (const char*)g.Bt + (size_t)nxt.pn * tstep : cB;
        for (int t = 0; t < nt; t += 2) {
            const bool last = (t == nt - 2);
            const char* a1 = cA + (size_t)(t + 1) * kstep;
            const char* a2 = last ? nA : cA + (size_t)(t + 2) * kstep; const char* b2 = last ? nB : cB + (size_t)(t + 2) * kstep;
            const char* a3 = a2 + kstep; const char* b3 = b2 + kstep;
            if (last && has_next) S.a_ready(nxt);
            PG8_LDB(B0, 0, 0); PG8_SCHED; PG8_LDA(At, 0, 0); PG8_STAGE(PG8_SA(1, 1), a1 + hstep, voffA);
            PG8_WAIT_L(8); PG8_BAR; PG8_WAIT_L(0); PG8_MMA(0, 0, At, B0); PG8_BAR; PG8_SCHED;
            PG8_LDB(B1, 0, 1); PG8_STAGE(PG8_SB(0, 0), b2, voffB);
            PG8_BAR; PG8_WAIT_L(0); PG8_MMA(0, 1, At, B1); PG8_BAR;
            PG8_LDA(At, 0, 1); PG8_STAGE(PG8_SA(0, 0), a2, voffA);
            PG8_BAR; PG8_WAIT_L(0); PG8_MMA(1, 0, At, B0); PG8_BAR; PG8_SCHED;
            PG8_STAGE(PG8_SB(0, 1), b2 + hstep, voffB);
            PG8_WAIT_V(6); PG8_BAR; PG8_MMA(1, 1, At, B1); PG8_BAR;
            PG8_LDB(B0, 1, 0); PG8_SCHED; PG8_LDA(At, 1, 0); PG8_STAGE(PG8_SA(0, 1), a2 + hstep, voffA);
            PG8_WAIT_L(8); PG8_BAR; PG8_WAIT_L(0); PG8_MMA(0, 0, At, B0); PG8_BAR; PG8_SCHED;
            PG8_LDB(B1, 1, 1); PG8_STAGE(PG8_SB(1, 0), b3, voffB);
            PG8_BAR; PG8_WAIT_L(0); PG8_MMA(0, 1, At, B1); PG8_BAR;
            PG8_LDA(At, 1, 1); PG8_STAGE(PG8_SA(1, 0), a3, voffA);
            PG8_BAR; PG8_WAIT_L(0); PG8_MMA(1, 0, At, B0); PG8_BAR; PG8_SCHED;
            PG8_STAGE(PG8_SB(1, 1), b3 + hstep, voffB);
            PG8_WAIT_V(6); PG8_BAR; PG8_MMA(1, 1, At, B1); PG8_BAR;
        }
        PG8_STAMP();
        if constexpr (!Epi::AFTER_DRAIN) { E(acc, cur, wr, wc, fr, fq); S.done(cur); }
        PG8_STAMP();
        if (!has_next) break;
#pragma unroll
        for (int a = 0; a < 2; ++a)
#pragma unroll
            for (int b = 0; b < 2; ++b)
#pragma unroll
                for (int m = 0; m < 4; ++m)
#pragma unroll
                    for (int n = 0; n < 2; ++n) acc[a][b][m][n] = (f32x4){0.f, 0.f, 0.f, 0.f};
        cur = nxt; cA = nA; cB = nB; ++ui;
    }
    PG8_WAIT_V(0);
    if (wr == 0) PG8_BAR;
    PG8_BAR;
    if constexpr (Epi::AFTER_DRAIN) { E.fused(acc, cur, wr, wc, fr, fq, lds, wid, lane); S.done(cur); }
    PG8_STAMP();
    if (STAMP && wid == 0) { stamps[lane] = lane < nts ? (((unsigned long long)(unsigned)ts_hi << 32) | (unsigned)ts_lo) : 0ull;
        if (lane == 62) stamps[62] = rt_entry; if (lane == 63) stamps[63] = (unsigned long long)wall_clock64(); }
#undef PG8_STAMP
#undef PG8_SA
#undef PG8_SB
#undef PG8_STAGE
#undef PG8_LDA
#undef PG8_LDB
#undef PG8_MMA
#undef PG8_WAIT_V
#undef PG8_WAIT_L
#undef PG8_BAR
#undef PG8_SCHED
}
}

struct Epi1 {
  static constexpr bool PERM = true, AFTER_DRAIN = false;
  unsigned char* ws; u16* mg; const float* b_gate; bool dup;
  DI void operator()(const pg8::f32x4 (&acc)[2][2][4][2], const pg8::Unit& u, int wr, int wc, int fr, int fq) const {
    const int pn = u.pn;
    const int rowb = u.pm * 256 + wr * 64 + fr;
    const int colu = wc * 32 + 8 * fq;
    if (pn < 4) {
      u16* dst = (pn < 3) ? (u16*)(ws + OFF_CQ) + pn * 256 : (u16*)(ws + OFF_CKV);
      const int ld = (pn < 3) ? 768 : 256;
      float* ssq = (float*)(ws + OFF_SSQ) + ((pn < 3) ? 0 : T);
#pragma unroll
      for (int ai = 0; ai < 2; ++ai)
#pragma unroll
        for (int m = 0; m < 4; ++m) {
          const int row = rowb + ai * 128 + m * 16;
          float ss = 0.f;
#pragma unroll
          for (int bj = 0; bj < 2; ++bj) {
            const pg8::f32x4 v0 = acc[ai][bj][m][0], v1 = acc[ai][bj][m][1];
            ss += v0[0] * v0[0] + v0[1] * v0[1] + v0[2] * v0[2] + v0[3] * v0[3] + v1[0] * v1[0] + v1[1] * v1[1] + v1[2] * v1[2] + v1[3] * v1[3];
            u4v o; o.x = pk2(v0[0], v0[1]); o.y = pk2(v0[2], v0[3]); o.z = pk2(v1[0], v1[1]); o.w = pk2(v1[2], v1[3]);
            *(u4v*)(dst + (size_t)row * ld + bj * 128 + colu) = o;
          }
          ss = xor16_add(ss); ss = xor32_add(ss);
          if (fq == 0 && !dup) atomicAdd(ssq + row, ss);
        }
    } else if (pn < 8) {
      u16* dst = (u16*)(ws + ((pn < 6) ? OFF_SGA : OFF_SGB)) + (pn & 1) * 256;
#pragma unroll
      for (int ai = 0; ai < 2; ++ai)
#pragma unroll
        for (int m = 0; m < 4; ++m) {
          const int row = rowb + ai * 128 + m * 16;
#pragma unroll
          for (int bj = 0; bj < 2; ++bj) {
            const pg8::f32x4 v0 = acc[ai][bj][m][0], v1 = acc[ai][bj][m][1];
            u4v o; o.x = pk2(siluf_(v0[0]), siluf_(v0[1])); o.y = pk2(siluf_(v0[2]), siluf_(v0[3]));
            o.z = pk2(siluf_(v1[0]), siluf_(v1[1])); o.w = pk2(siluf_(v1[2]), siluf_(v1[3]));
            *(u4v*)(dst + (size_t)row * 512 + bj * 128 + colu) = o;
          }
        }
    } else if (pn >= 16) {
      if (pn < 22) {
        u16* dst = (u16*)(ws + ((pn < 18) ? OFF_HQ : (pn < 20) ? OFF_HF : OFF_HI)) + (pn & 1) * 256;
#pragma unroll
        for (int ai = 0; ai < 2; ++ai)
#pragma unroll
          for (int m = 0; m < 4; ++m) {
            const int row = rowb + ai * 128 + m * 16;
#pragma unroll
            for (int bj = 0; bj < 2; ++bj) {
              const pg8::f32x4 v0 = acc[ai][bj][m][0], v1 = acc[ai][bj][m][1];
              u4v o; o.x = pk2(v0[0], v0[1]); o.y = pk2(v0[2], v0[3]); o.z = pk2(v1[0], v1[1]); o.w = pk2(v1[2], v1[3]);
              *(u4v*)(dst + (size_t)row * 512 + bj * 128 + colu) = o;
            }
          }
      } else if (colu < 32) {
        float* dst = (float*)(ws + OFF_KPE);
#pragma unroll
        for (int ai = 0; ai < 2; ++ai)
#pragma unroll
          for (int m = 0; m < 4; ++m) {
            const int row = rowb + ai * 128 + m * 16;
            *(pg8::f32x4*)(dst + (size_t)row * 32 + colu) = acc[ai][0][m][0];
            *(pg8::f32x4*)(dst + (size_t)row * 32 + colu + 4) = acc[ai][0][m][1];
          }
      }
    } else {
      const int cb = (pn - 8) * 256 + colu;
      f4v b0[2], b1[2];
#pragma unroll
      for (int bj = 0; bj < 2; ++bj) { b0[bj] = *(const f4v*)(b_gate + cb + bj * 128); b1[bj] = *(const f4v*)(b_gate + cb + bj * 128 + 4); }
#pragma unroll
      for (int ai = 0; ai < 2; ++ai)
#pragma unroll
        for (int m = 0; m < 4; ++m) {
          const int row = rowb + ai * 128 + m * 16;
#pragma unroll
          for (int bj = 0; bj < 2; ++bj) {
            const pg8::f32x4 v0 = acc[ai][bj][m][0], v1 = acc[ai][bj][m][1];
            u4v o; o.x = pk2(sigmoidf_(v0[0] + b0[bj].x), sigmoidf_(v0[1] + b0[bj].y)); o.y = pk2(sigmoidf_(v0[2] + b0[bj].z), sigmoidf_(v0[3] + b0[bj].w));
            o.z = pk2(sigmoidf_(v1[0] + b1[bj].x), sigmoidf_(v1[1] + b1[bj].y)); o.w = pk2(sigmoidf_(v1[2] + b1[bj].z), sigmoidf_(v1[3] + b1[bj].w));
            *(u4v*)(mg + ((((size_t)(u.pm * 8 + (pn - 8)) * 8 + (wr * 4 + wc)) * 16 + (ai * 8 + m * 2 + bj)) * 64 + (fq * 16 + fr)) * 8) = o;
          }
        }
    }
  }
};


struct Epi6 {
  static constexpr bool PERM = true, AFTER_DRAIN = false;
  u16* out; float* ssq; bool dup;
  DI void operator()(const pg8::f32x4 (&acc)[2][2][4][2], const pg8::Unit& u, int wr, int wc, int fr, int fq) const {
    const int rowb = u.pm * 256 + wr * 64 + fr;
    const int colb = u.pn * 256 + wc * 32 + 8 * fq;
#pragma unroll
    for (int ai = 0; ai < 2; ++ai)
#pragma unroll
      for (int m = 0; m < 4; ++m) {
        const int row = rowb + ai * 128 + m * 16;
        float ss = 0.f;
#pragma unroll
        for (int bj = 0; bj < 2; ++bj) {
          const pg8::f32x4 v0 = acc[ai][bj][m][0], v1 = acc[ai][bj][m][1];
          ss += v0[0] * v0[0] + v0[1] * v0[1] + v0[2] * v0[2] + v0[3] * v0[3] + v1[0] * v1[0] + v1[1] * v1[1] + v1[2] * v1[2] + v1[3] * v1[3];
          u4v o; o.x = pk2(v0[0], v0[1]); o.y = pk2(v0[2], v0[3]); o.z = pk2(v1[0], v1[1]); o.w = pk2(v1[2], v1[3]);
          *(u4v*)(out + (size_t)row * 1024 + colb + bj * 128) = o;
        }
        ss = xor16_add(ss); ss = xor32_add(ss);
        if (fq == 0 && !dup) atomicAdd(ssq + row, ss);
      }
  }
};
template <bool SECOND> struct Epi5 {
  static constexpr bool PERM = true, AFTER_DRAIN = false;
  const u16* mg; u16* mi; u16* mo;
  DI void operator()(const pg8::f32x4 (&acc)[2][2][4][2], const pg8::Unit& u, int wr, int wc, int fr, int fq) const {
    const int rowb = u.pm * 256 + wr * 64 + fr;
    const int colb = u.pn * 256 + wc * 32 + 8 * fq;
    const size_t gbase = (((size_t)(u.pm * 8 + u.pn + (SECOND ? 4 : 0)) * 8 + (wr * 4 + wc)) * 16) * 64 + (fq * 16 + fr);
    const size_t ibase = (((size_t)(u.pm * 4 + u.pn) * 8 + (wr * 4 + wc)) * 16) * 64 + (fq * 16 + fr);
#pragma unroll
    for (int hb = 0; hb < 4; ++hb) {
      const int ai = hb >> 1, m0 = (hb & 1) * 2;
      u4v g[4], pm[4];
#pragma unroll
      for (int f4 = 0; f4 < 4; ++f4) {
        const int f = ai * 8 + (m0 + (f4 >> 1)) * 2 + (f4 & 1);
        g[f4] = *(const u4v*)(mg + (gbase + (size_t)f * 64) * 8);
        if (SECOND) pm[f4] = *(const u4v*)(mi + (ibase + (size_t)f * 64) * 8);
      }
#pragma unroll
      for (int f4 = 0; f4 < 4; ++f4) {
        const int m = m0 + (f4 >> 1), bj = f4 & 1;
        const int row = rowb + ai * 128 + m * 16;
        const pg8::f32x4 v0 = acc[ai][bj][m][0], v1 = acc[ai][bj][m][1];
        float r0 = v0[0] * bflo(g[f4].x), r1 = v0[1] * bfhi(g[f4].x), r2 = v0[2] * bflo(g[f4].y), r3 = v0[3] * bfhi(g[f4].y);
        float r4 = v1[0] * bflo(g[f4].z), r5 = v1[1] * bfhi(g[f4].z), r6 = v1[2] * bflo(g[f4].w), r7 = v1[3] * bfhi(g[f4].w);
        if (SECOND) {
          r0 += bflo(pm[f4].x); r1 += bfhi(pm[f4].x); r2 += bflo(pm[f4].y); r3 += bfhi(pm[f4].y);
          r4 += bflo(pm[f4].z); r5 += bfhi(pm[f4].z); r6 += bflo(pm[f4].w); r7 += bfhi(pm[f4].w);
        }
        u4v o; o.x = pk2(r0, r1); o.y = pk2(r2, r3); o.z = pk2(r4, r5); o.w = pk2(r6, r7);
        if (SECOND) *(u4v*)(mo + (size_t)row * 1024 + colb + bj * 128) = o;
        else *(u4v*)(mi + (ibase + (size_t)(ai * 8 + m * 2 + bj) * 64) * 8) = o;
      }
      __builtin_amdgcn_sched_barrier(0);
    }
  }
};
struct EpiQ {
  static constexpr bool PERM = true, AFTER_DRAIN = false;
  const float* ssq_q; const float* rope; u16* Qo;
  DI void operator()(const pg8::f32x4 (&acc)[2][2][4][2], const pg8::Unit& u, int wr, int wc, int fr, int fq) const {
    const int rowb = u.pm * 256 + wr * 64 + fr;
    const int colu = wc * 32 + 8 * fq;
    float sq[8];
#pragma unroll
    for (int i = 0; i < 8; ++i) sq[i] = ssq_q[rowb + (i >> 2) * 128 + (i & 3) * 16];
    if (u.pn < 2) {
#pragma unroll
      for (int ai = 0; ai < 2; ++ai)
#pragma unroll
        for (int m = 0; m < 4; ++m) {
          const int row = rowb + ai * 128 + m * 16;
          const int b = row >> 12, spos = row & 4095;
          const float sc = rsqrtf(sq[ai * 4 + m] * (1.f / 768.f) + EPS) * QSCALE;
#pragma unroll
          for (int bj = 0; bj < 2; ++bj) {
            const pg8::f32x4 v0 = acc[ai][bj][m][0], v1 = acc[ai][bj][m][1];
            const int head = u.pn * 4 + bj * 2 + (colu >> 6), d = colu & 63;
            u4v o; o.x = pk2(v0[0] * sc, v0[1] * sc); o.y = pk2(v0[2] * sc, v0[3] * sc); o.z = pk2(v1[0] * sc, v1[1] * sc); o.w = pk2(v1[2] * sc, v1[3] * sc);
            *(u4v*)(Qo + ((size_t)(b * 8 + head) * 4096 + spos) * 96 + d) = o;
          }
        }
    } else {
#pragma unroll
      for (int ai = 0; ai < 2; ++ai) {
        f4v cs[4], sn[4];
#pragma unroll
        for (int i = 0; i < 4; ++i) {
          const int spos = (rowb + ai * 128 + i * 16) & 4095;
          cs[i] = *(const f4v*)(rope + spos * 16 + 4 * fq); sn[i] = *(const f4v*)(rope + 65536 + spos * 16 + 4 * fq);
        }
#pragma unroll
        for (int m = 0; m < 4; ++m) {
          const int row = rowb + ai * 128 + m * 16;
          const int b = row >> 12, spos = row & 4095;
          const float sc = rsqrtf(sq[ai * 4 + m] * (1.f / 768.f) + EPS) * QSCALE;
          const f4v c4 = cs[m], s4 = sn[m];
#pragma unroll
          for (int bj = 0; bj < 2; ++bj) {
            const pg8::f32x4 v0 = acc[ai][bj][m][0], v1 = acc[ai][bj][m][1];
            const int head = bj * 4 + wc;
            u2v o1, o2;
            o1.x = pk2((v0[0] * c4.x - v1[0] * s4.x) * sc, (v0[1] * c4.y - v1[1] * s4.y) * sc);
            o1.y = pk2((v0[2] * c4.z - v1[2] * s4.z) * sc, (v0[3] * c4.w - v1[3] * s4.w) * sc);
            o2.x = pk2((v0[0] * s4.x + v1[0] * c4.x) * sc, (v0[1] * s4.y + v1[1] * c4.y) * sc);
            o2.y = pk2((v0[2] * s4.z + v1[2] * c4.z) * sc, (v0[3] * s4.w + v1[3] * c4.w) * sc);
            u16* qp = Qo + ((size_t)(b * 8 + head) * 4096 + spos) * 96 + 64 + 4 * fq;
            *(u2v*)qp = o1; *(u2v*)(qp + 16) = o2;
          }
        }
        __builtin_amdgcn_sched_barrier(0);
      }
    }
  }
};

struct EpiK {
  static constexpr bool PERM = true, AFTER_DRAIN = false;
  const float* ssq_kv; u16* Ko;
  DI void operator()(const pg8::f32x4 (&acc)[2][2][4][2], const pg8::Unit& u, int wr, int wc, int fr, int fq) const {
    const int rowb = u.pm * 256 + wr * 64 + fr;
    float sq[8];
#pragma unroll
    for (int i = 0; i < 8; ++i) sq[i] = ssq_kv[rowb + (i >> 2) * 128 + (i & 3) * 16];
#pragma unroll
    for (int ai = 0; ai < 2; ++ai)
#pragma unroll
      for (int m = 0; m < 4; ++m) {
        const int row = rowb + ai * 128 + m * 16;
        const int b = row >> 12, spos = row & 4095;
        const float sc = rsqrtf(sq[ai * 4 + m] * (1.f / 256.f) + EPS);
#pragma unroll
        for (int bj = 0; bj < 2; ++bj) {
          const pg8::f32x4 v0 = acc[ai][bj][m][0], v1 = acc[ai][bj][m][1];
          const int col = u.pn * 256 + bj * 128 + wc * 32 + 8 * fq;
          const int head = col >> 6, d = col & 63;
          u4v o; o.x = pk2(v0[0] * sc, v0[1] * sc); o.y = pk2(v0[2] * sc, v0[3] * sc); o.z = pk2(v1[0] * sc, v1[1] * sc); o.w = pk2(v1[2] * sc, v1[3] * sc);
          *(u4v*)(Ko + ((size_t)(b * 8 + head) * 4096 + spos) * 96 + d) = o;
        }
      }
  }
};
struct EpiV {
  static constexpr bool PERM = false, AFTER_DRAIN = false;
  const float* ssq_kv; u16* Vo;
  DI void operator()(const pg8::f32x4 (&acc)[2][2][4][2], const pg8::Unit& u, int wr, int wc, int fr, int fq) const {
    f4v sq[8];
#pragma unroll
    for (int i = 0; i < 8; ++i) sq[i] = *(const f4v*)(ssq_kv + u.pm * 256 + (i >> 2) * 128 + wr * 64 + (i & 3) * 16 + 4 * fq);
#pragma unroll
    for (int ai = 0; ai < 2; ++ai)
#pragma unroll
      for (int m = 0; m < 4; ++m) {
        const int row4 = u.pm * 256 + ai * 128 + wr * 64 + m * 16 + 4 * fq;
        const int b = row4 >> 12, spos = row4 & 4095;
        const f4v q = sq[ai * 4 + m];
        const float s0 = rsqrtf(q.x * (1.f / 256.f) + EPS), s1 = rsqrtf(q.y * (1.f / 256.f) + EPS), s2 = rsqrtf(q.z * (1.f / 256.f) + EPS), s3 = rsqrtf(q.w * (1.f / 256.f) + EPS);
#pragma unroll
        for (int bj = 0; bj < 2; ++bj)
#pragma unroll
          for (int n = 0; n < 2; ++n) {
            const pg8::f32x4 v = acc[ai][bj][m][n];
            const int col = u.pn * 256 + bj * 128 + wc * 32 + n * 16 + fr;
            const int head = col >> 6, dv = col & 63;
            u2v o; o.x = pk2(v[0] * s0, v[1] * s1); o.y = pk2(v[2] * s2, v[3] * s3);
            *(u2v*)(Vo + ((size_t)(b * 8 + head) * 64 + dv) * 4096 + spos) = o;
          }
        __builtin_amdgcn_sched_barrier(0);
      }
  }
};
DI void phase1(const Params& p, unsigned char* smem, bool dup = false) {
  unsigned char* ws = p.ws;
  pg8::Gemm g{(const u16*)(ws + OFF_H), (const u16*)(ws + OFF_WIN), T, NP, 1024};
  pg8::StaticOrder S; S.init(T, NP, (int)gridDim.x, (int)blockIdx.x);
  Epi1 E{ws, (u16*)p.out, p.b_gate, dup};
  pg8::gemm_phase<Epi1, pg8::StaticOrder, false>((PG8_LAS unsigned char*)smem, g, S, E, nullptr);
  const int nlight = (int)gridDim.x / 2;
  if (!dup && (int)blockIdx.x >= (int)gridDim.x - nlight) {
    const int gtid = ((int)blockIdx.x - ((int)gridDim.x - nlight)) * (int)blockDim.x + (int)threadIdx.x, gthreads = nlight * (int)blockDim.x;
    conv_weight<1>((u16*)(ws + OFF_WUQ), p.w_uq, 768, 768, 768, p.g_q, 1023, gtid, gthreads);
    conv_weight<3>((u16*)(ws + OFF_WUKV), p.w_ukv, 1024, 1024, 256, p.g_kv, 255, gtid, gthreads);
    conv_weight<2>((u16*)(ws + OFF_WA), p.w_a, 1024, 1024, 512, nullptr, 0, gtid, gthreads);
    conv_weight<2>((u16*)(ws + OFF_WB), p.w_b, 1024, 1024, 512, p.g_hgrn, 63, gtid, gthreads);
    conv_weight<2>((u16*)(ws + OFF_WO), p.w_out, 1024, 1024, 1024, nullptr, 0, gtid, gthreads);
  }
}

DI void hgrn_prep_tile(const Params& p, float* stage, int tid, int b, int hh, int prow0, int nblk0) {
  unsigned char* ws = p.ws;
  const int bh = b * 8 + hh;
  if (tid < 128) {
    const int c = tid & 63, blk = tid >> 6;
    const float l0 = p.lb_logits[hh * 64 + c], l1 = p.lb_logits[512 + hh * 64 + c];
    const float lbv = 1.f / (1.f + expf(l1 - l0));
    float cum = 0.f;
    for (int rr = 0; rr < 32; ++rr) {
      float* sp = stage + (blk * 32 + rr) * SST + c;
      const float q = sp[0], hf = sp[64];
      const float sg = 1.f / (1.f + expf(-hf));
      const float f = lbv + (1.f - lbv) * sg;
      cum += logf(f);
      const float e = expf(cum);
      sp[0] = q * e;
      sp[64] = (1.f - f) / e;
    }
    ((float*)(ws + OFF_DECAY))[((size_t)bh * 128 + nblk0 + blk) * 64 + c] = expf(cum);
  }
  __syncthreads();
#pragma unroll
  for (int it = 0; it < 2; ++it) {
    const int item = tid + 256 * it, rr = item >> 3, cc = (item & 7) * 8;
    const f4v a = *(const f4v*)(stage + rr * SST + cc), c = *(const f4v*)(stage + rr * SST + cc + 4);
    const f4v d = *(const f4v*)(stage + rr * SST + 64 + cc), e = *(const f4v*)(stage + rr * SST + 64 + cc + 4);
    const size_t o = (size_t)(prow0 + rr) * 512 + hh * 64 + cc;
    *(u4v*)((u16*)(ws + OFF_QDEC) + o) = pk8(a, c);
    *(u4v*)((u16*)(ws + OFF_KINV) + o) = pk8(d, e);
  }
}
DI void hi_vt_tile(const Params& p, float* stage, int tid, int b, int q2, int nblk0) {
  unsigned char* ws = p.ws;
#pragma unroll
        for (int it = 0; it < 4; ++it) {
          const int item = tid + 256 * it, sc = item & 3, col = (item >> 2) & 127, blk = item >> 9;
          float v[8];
#pragma unroll
          for (int i = 0; i < 8; ++i) v[i] = stage[(blk * 32 + sc * 8 + i) * SST + col];
          u4v o; o.x = pk2(v[0], v[1]); o.y = pk2(v[2], v[3]); o.z = pk2(v[4], v[5]); o.w = pk2(v[6], v[7]);
          const int bh = b * 8 + q2 * 2 + (col >> 6);
          *(u4v*)((u16*)(ws + OFF_VT) + (((size_t)bh * 128 + nblk0 + blk) * 64 + (col & 63)) * 32 + sc * 8) = o;
        }
}
DI void stage_load64(float* stage, const u16* src, int coff, int tid) {
#pragma unroll
  for (int it = 0; it < 2; ++it) {
    const int item = tid + 256 * it, rr = item >> 3, ch = item & 7;
    const u4v v = *(const u4v*)(src + (size_t)rr * 512 + ch * 8);
    float* d = stage + rr * SST + coff + ch * 8;
    *(f4v*)d = f4v{bflo(v.x), bfhi(v.x), bflo(v.y), bfhi(v.y)};
    *(f4v*)(d + 4) = f4v{bflo(v.z), bfhi(v.z), bflo(v.w), bfhi(v.w)};
  }
}


constexpr int PST = 68;
DI void hgrn_prep_native(const Params& p, float* pl, int rb, int hh) {
  unsigned char* ws = p.ws;
  const int tid = threadIdx.x;
  float* Qp = pl; float* G = pl + 128 * PST; float* Kn = pl + 2 * 128 * PST;
  const int prow0 = rb * 128, b = prow0 >> 12, bh = b * 8 + hh, nblk0 = (prow0 & 4095) >> 5;
  const int ch = tid & 7;
  float lbv[8];
  {
    const f4v a0 = *(const f4v*)(p.lb_logits + hh * 64 + ch * 8), a1 = *(const f4v*)(p.lb_logits + hh * 64 + ch * 8 + 4);
    const f4v b0 = *(const f4v*)(p.lb_logits + 512 + hh * 64 + ch * 8), b1 = *(const f4v*)(p.lb_logits + 512 + hh * 64 + ch * 8 + 4);
    const float l0[8] = {a0.x, a0.y, a0.z, a0.w, a1.x, a1.y, a1.z, a1.w}, l1[8] = {b0.x, b0.y, b0.z, b0.w, b1.x, b1.y, b1.z, b1.w};
#pragma unroll
    for (int i = 0; i < 8; ++i) lbv[i] = 1.f / (1.f + expf(l1[i] - l0[i]));
  }
  __syncthreads();
#pragma unroll
  for (int it = 0; it < 2; ++it) {
    const int rr = (tid + 512 * it) >> 3;
    const size_t go = (size_t)(prow0 + rr) * 512 + hh * 64 + ch * 8;
    const u4v qv = *(const u4v*)((const u16*)(ws + OFF_HQ) + go), fv = *(const u4v*)((const u16*)(ws + OFF_HF) + go);
    const float q[8] = {bflo(qv.x), bfhi(qv.x), bflo(qv.y), bfhi(qv.y), bflo(qv.z), bfhi(qv.z), bflo(qv.w), bfhi(qv.w)};
    const float hf[8] = {bflo(fv.x), bfhi(fv.x), bflo(fv.y), bfhi(fv.y), bflo(fv.z), bfhi(fv.z), bflo(fv.w), bfhi(fv.w)};
    float g[8], kn[8];
#pragma unroll
    for (int i = 0; i < 8; ++i) {
      const float sg = rcpf(1.f + __builtin_amdgcn_exp2f(-1.4426950408889634f * hf[i]));
      const float f = lbv[i] + (1.f - lbv[i]) * sg;
      g[i] = __builtin_amdgcn_logf(f);
      kn[i] = 1.f - f;
    }
    float* d = Qp + rr * PST + ch * 8;
    *(f4v*)d = f4v{q[0], q[1], q[2], q[3]}; *(f4v*)(d + 4) = f4v{q[4], q[5], q[6], q[7]};
    d = G + rr * PST + ch * 8;
    *(f4v*)d = f4v{g[0], g[1], g[2], g[3]}; *(f4v*)(d + 4) = f4v{g[4], g[5], g[6], g[7]};
    d = Kn + rr * PST + ch * 8;
    *(f4v*)d = f4v{kn[0], kn[1], kn[2], kn[3]}; *(f4v*)(d + 4) = f4v{kn[4], kn[5], kn[6], kn[7]};
  }
  __syncthreads();
  if (tid < 256) {
    const int c = tid & 63, blk = tid >> 6;
    float* gp = G + (blk * 32) * PST + c;
    float v[32];
#pragma unroll
    for (int r2 = 0; r2 < 32; ++r2) v[r2] = gp[r2 * PST];
    float cum = 0.f;
#pragma unroll
    for (int r2 = 0; r2 < 32; ++r2) { cum += v[r2]; gp[r2 * PST] = cum; }
    ((float*)(ws + OFF_DECAY))[((size_t)bh * 128 + nblk0 + blk) * 64 + c] = __builtin_amdgcn_exp2f(cum);
  }
  __syncthreads();
#pragma unroll
  for (int it = 0; it < 2; ++it) {
    const int rr = (tid + 512 * it) >> 3;
    const float* s0 = Qp + rr * PST + ch * 8; const float* s1 = G + rr * PST + ch * 8; const float* s2 = Kn + rr * PST + ch * 8;
    const f4v q0 = *(const f4v*)s0, q1 = *(const f4v*)(s0 + 4), c0 = *(const f4v*)s1, c1 = *(const f4v*)(s1 + 4), k0 = *(const f4v*)s2, k1 = *(const f4v*)(s2 + 4);
    const float q[8] = {q0.x, q0.y, q0.z, q0.w, q1.x, q1.y, q1.z, q1.w}, cm[8] = {c0.x, c0.y, c0.z, c0.w, c1.x, c1.y, c1.z, c1.w}, kn[8] = {k0.x, k0.y, k0.z, k0.w, k1.x, k1.y, k1.z, k1.w};
    float qd[8], ki[8];
#pragma unroll
    for (int i = 0; i < 8; ++i) { qd[i] = q[i] * __builtin_amdgcn_exp2f(cm[i]); ki[i] = kn[i] * __builtin_amdgcn_exp2f(-cm[i]); }
    const size_t go = (size_t)(prow0 + rr) * 512 + hh * 64 + ch * 8;
    u4v o; o.x = pk2(qd[0], qd[1]); o.y = pk2(qd[2], qd[3]); o.z = pk2(qd[4], qd[5]); o.w = pk2(qd[6], qd[7]);
    *(u4v*)((u16*)(ws + OFF_QDEC) + go) = o;
    o.x = pk2(ki[0], ki[1]); o.y = pk2(ki[2], ki[3]); o.z = pk2(ki[4], ki[5]); o.w = pk2(ki[6], ki[7]);
    *(u4v*)((u16*)(ws + OFF_KINV) + go) = o;
  }
}
constexpr int VTS = 136;
DI void hi_vt_native(const Params& p, u16* img, int rb, int q2) {
  unsigned char* ws = p.ws;
  const int tid = threadIdx.x;
  const int prow0 = rb * 128, b = prow0 >> 12, nblk0 = (prow0 & 4095) >> 5;
  __syncthreads();
#pragma unroll
  for (int it = 0; it < 4; ++it) {
    const int item = tid + 512 * it, rr = item >> 4, c16 = item & 15;
    *(u4v*)(img + rr * VTS + c16 * 8) = *(const u4v*)((const u16*)(ws + OFF_HI) + (size_t)(prow0 + rr) * 512 + q2 * 128 + c16 * 8);
  }
  __syncthreads();
#pragma unroll
  for (int it = 0; it < 4; ++it) {
    const int item = tid + 512 * it, sc = item & 3, col = (item >> 2) & 127, blk = item >> 9;
    u32 w[4];
#pragma unroll
    for (int i = 0; i < 4; ++i) {
      const u32 lo = img[(blk * 32 + sc * 8 + 2 * i) * VTS + col], hi = img[(blk * 32 + sc * 8 + 2 * i + 1) * VTS + col];
      w[i] = lo | (hi << 16);
    }
    const int bh = b * 8 + q2 * 2 + (col >> 6);
    *(u4v*)((u16*)(ws + OFF_VT) + (((size_t)bh * 128 + nblk0 + blk) * 64 + (col & 63)) * 32 + sc * 8) = u4v{w[0], w[1], w[2], w[3]};
  }
}

DI void rope8(const float* x1, const float* x2, const float* rope, int spos, int j0, bool first, float scale, float (&o)[8]) {
  const f4v c0 = *(const f4v*)(rope + spos * 16 + j0), c1 = *(const f4v*)(rope + spos * 16 + j0 + 4);
  const f4v s0 = *(const f4v*)(rope + 65536 + spos * 16 + j0), s1 = *(const f4v*)(rope + 65536 + spos * 16 + j0 + 4);
  const float cs[8] = {c0.x, c0.y, c0.z, c0.w, c1.x, c1.y, c1.z, c1.w};
  const float sn[8] = {s0.x, s0.y, s0.z, s0.w, s1.x, s1.y, s1.z, s1.w};
#pragma unroll
  for (int i = 0; i < 8; ++i) o[i] = scale * (first ? (x1[i] * cs[i] - x2[i] * sn[i]) : (x1[i] * sn[i] + x2[i] * cs[i]));
}

DI void phase2(const Params& p, unsigned char* smem, u16* lds) {
  unsigned char* ws = p.ws;
  const int tid = VTID;
  float* stage = (float*)lds;
  const float* ssq_q = (const float*)(ws + OFF_SSQ);
  const float* ssq_kv = ssq_q + T;
  const float* rope = (const float*)(ws + OFF_ROPE);
  u16* Qo = (u16*)(ws + OFF_Q);
  u16* Ko = (u16*)(ws + OFF_K);
  u16* Vo = (u16*)(ws + OFF_VTT);
#pragma nounroll
  for (int rep = 0; rep < (DUP_PH == 21 ? p.ph_hi - 7 : 1); ++rep) {
    pg8::Gemm g{(const u16*)(ws + OFF_CQ), (const u16*)(ws + OFF_WUQ), T, 768, 768};
    pg8::StaticOrder S; S.init(T, 768, (int)gridDim.x, (int)blockIdx.x);
    EpiQ E{ssq_q, rope, Qo};
    pg8::gemm_phase<EpiQ, pg8::StaticOrder, false>((PG8_LAS unsigned char*)smem, g, S, E, nullptr);
  }
#pragma nounroll
  for (int rep = 0; rep < (DUP_PH == 23 ? p.ph_hi - 7 : 1); ++rep) {
    pg8::StaticOrder S; S.init(T, 512, (int)gridDim.x, (int)blockIdx.x);
    {
      int kk = 256; asm volatile("" : "+s"(kk));
      pg8::Gemm g{(const u16*)(ws + OFF_CKV), (const u16*)(ws + OFF_WUKV), T, 512, kk};
      EpiK E{ssq_kv, Ko};
      pg8::gemm_phase<EpiK, pg8::StaticOrder, false>((PG8_LAS unsigned char*)smem, g, S, E, nullptr);
    }
  }
#pragma nounroll
  for (int rep = 0; rep < (DUP_PH == 22 ? p.ph_hi - 7 : 1); ++rep) {
    const int gtid = blockIdx.x * blockDim.x + threadIdx.x, gthreads = gridDim.x * blockDim.x;
    for (int idx = gtid; idx < T * 4; idx += gthreads) {
      const int tok = idx >> 2, wv = (idx & 3) * 8, j0 = wv & 15;
      const int b = tok >> 12, spos = tok & 4095;
      const float* kp = (const float*)(ws + OFF_KPE) + (size_t)tok * 32;
      const f4v a0 = *(const f4v*)(kp + j0), a1 = *(const f4v*)(kp + j0 + 4);
      const f4v b0 = *(const f4v*)(kp + 16 + j0), b1 = *(const f4v*)(kp + 16 + j0 + 4);
      const float x1[8] = {a0.x, a0.y, a0.z, a0.w, a1.x, a1.y, a1.z, a1.w};
      const float x2[8] = {b0.x, b0.y, b0.z, b0.w, b1.x, b1.y, b1.z, b1.w};
      float o[8];
      rope8(x1, x2, rope, spos, j0, wv < 16, 1.f, o);
      u4v ov; ov.x = pk2(o[0], o[1]); ov.y = pk2(o[2], o[3]); ov.z = pk2(o[4], o[5]); ov.w = pk2(o[6], o[7]);
#pragma unroll
      for (int head = 0; head < 8; ++head) *(u4v*)(Ko + ((size_t)(b * 8 + head) * 4096 + spos) * 96 + 64 + wv) = ov;
    }
  }
  for (int rep = 0; rep < (DUP_PH == 20 ? 2 : 1); ++rep)
  for (int t = blockIdx.x; t < 2048 + 1024; t += gridDim.x) {
    if (t < 2048) hgrn_prep_native(p, (float*)smem, t >> 3, t & 7);
    else hi_vt_native(p, (u16*)smem, (t - 2048) >> 2, (t - 2048) & 3);
  }
}

DI void phase2b(const Params& p, unsigned char* smem) {
  unsigned char* ws = p.ws;
  const int tid = VTID;
  {
    pg8::StaticOrder S; S.init(T, 512, (int)gridDim.x, (int)blockIdx.x);
    int kk = 256; asm volatile("" : "+s"(kk));
    pg8::Gemm g{(const u16*)(ws + OFF_CKV), (const u16*)(ws + OFF_WUKV) + (size_t)512 * 256, T, 512, kk};
    EpiV E{(const float*)(ws + OFF_SSQ) + T, (u16*)(ws + OFF_VTT)};
    pg8::gemm_phase<EpiV, pg8::StaticOrder, false, true>((PG8_LAS unsigned char*)smem, g, S, E, nullptr);
  }
  for (int t = VBID; t < 2048; t += VBN) {
    {
      const int idx = t;
      const int bh = idx >> 5, n = (idx & 31) * 4 + (tid >> 6);
      const int lane = tid & 63, r = lane & 31, h = lane >> 5;
      const u16* kn = (const u16*)(ws + OFF_KINV) + ((size_t)(bh >> 3) * 4096 + n * 32) * 512 + (bh & 7) * 64;
      const u16* vt = (const u16*)(ws + OFF_VT) + ((size_t)bh * 128 + n) * 64 * 32;
      bf16x8 a[2][2], bb[2][2];
#pragma unroll
      for (int i = 0; i < 2; ++i)
#pragma unroll
        for (int ks = 0; ks < 2; ++ks) {
          {
            bf16x8 av;
#pragma unroll
            for (int j = 0; j < 8; ++j) av[j] = (short)kn[(size_t)(ks * 16 + h * 8 + j) * 512 + i * 32 + r];
            a[i][ks] = av;
          }
          bb[i][ks] = *(const bf16x8*)(vt + (i * 32 + r) * 32 + ks * 16 + h * 8);
        }
      u16* up = (u16*)(ws + OFF_UPD) + ((size_t)bh * 128 + n) * 4096;
#pragma unroll
      for (int kb = 0; kb < 2; ++kb)
#pragma unroll
        for (int vb = 0; vb < 2; ++vb) {
          f32x16 c = zero16();
          c = MFMA(a[kb][0], bb[vb][0], c);
          c = MFMA(a[kb][1], bb[vb][1], c);
#pragma unroll
          for (int g = 0; g < 4; ++g) {
            u2v o; o.x = pk2(c[4 * g], c[4 * g + 1]); o.y = pk2(c[4 * g + 2], c[4 * g + 3]);
            *(u2v*)(up + (vb * 32 + r) * 64 + kb * 32 + 8 * g + 4 * h) = o;
          }
        }
    }
  }
}

constexpr int KST = 104, VST = 72;
constexpr int ATT_BUF = 64 * KST + 64 * VST;

constexpr int KST2 = 104, VST2 = 132;
constexpr int ATT_BUF2 = 128 * KST2 + 64 * VST2;
DI void att_qk(const u16* sk, const bf16x8 (&qf)[6], float nm, f32x16 (&st)[2]) {
#pragma unroll
  for (int i = 0; i < 16; ++i) { st[0][i] = nm; st[1][i] = nm; }
#pragma unroll
  for (int kb = 0; kb < 2; ++kb)
#pragma unroll
    for (int ks = 0; ks < 6; ++ks) {
      const bf16x8 kf = *(const bf16x8*)(sk + kb * 32 * KST2 + ks * 16);
      st[kb] = MFMA(kf, qf[ks], st[kb]);
    }
}
DI float att_softmax(f32x16 (&st)[2], float adj, bool adjnz, bool first, float& mref, float& l, f32x16 (&o)[2]) {
  float mx = st[0][0];
#pragma unroll
  for (int i = 1; i < 16; ++i) mx = fmaxf(mx, st[0][i]);
#pragma unroll
  for (int i = 0; i < 16; ++i) mx = fmaxf(mx, st[1][i]);
  mx = xor32_max(mx) - adj;
  f2v ps = f2v{0.f, 0.f};
  float shift_out = 0.f;
  if (first || adjnz || __builtin_amdgcn_ballot_w64(mx > 8.f) != 0ull) {
    const float shift = first ? mx : fmaxf(mx, 0.f);
    const float tot = adj + shift;
    const float alpha = first ? 0.f : __builtin_amdgcn_exp2f(-shift);
    mref += shift;
#pragma unroll
    for (int kb = 0; kb < 2; ++kb)
#pragma unroll
      for (int i = 0; i < 16; i += 2) {
        const float p0 = __builtin_amdgcn_exp2f(st[kb][i] - tot), p1 = __builtin_amdgcn_exp2f(st[kb][i + 1] - tot);
        st[kb][i] = p0; st[kb][i + 1] = p1; ps += f2v{p0, p1};
      }
    l = l * alpha + (ps.x + ps.y);
#pragma unroll
    for (int i = 0; i < 16; ++i) { o[0][i] *= alpha; o[1][i] *= alpha; }
    shift_out = shift;
  } else {
#pragma unroll
    for (int kb = 0; kb < 2; ++kb)
#pragma unroll
      for (int i = 0; i < 16; i += 2) {
        const float p0 = __builtin_amdgcn_exp2f(st[kb][i]), p1 = __builtin_amdgcn_exp2f(st[kb][i + 1]);
        st[kb][i] = p0; st[kb][i + 1] = p1; ps += f2v{p0, p1};
      }
    l += ps.x + ps.y;
  }
  return shift_out;
}
DI void att_pv(const u16* sv, const f32x16 (&st)[2], f32x16 (&o)[2]) {
#pragma unroll
  for (int s4 = 0; s4 < 4; ++s4) {
    const int kb = s4 >> 1, rb = 8 * (s4 & 1);
    u4v pu; pu.x = pk2(st[kb][rb], st[kb][rb + 1]); pu.y = pk2(st[kb][rb + 2], st[kb][rb + 3]);
    pu.z = pk2(st[kb][rb + 4], st[kb][rb + 5]); pu.w = pk2(st[kb][rb + 6], st[kb][rb + 7]);
    const bf16x8 pb = __builtin_bit_cast(bf16x8, pu);
#pragma unroll
    for (int db = 0; db < 2; ++db) {
      const s16x4 lo = *(const s16x4*)(sv + db * 32 * VST2 + 16 * s4);
      const s16x4 hi = *(const s16x4*)(sv + db * 32 * VST2 + 16 * s4 + 8);
      const bf16x8 vf = __builtin_shufflevector(lo, hi, 0, 1, 2, 3, 4, 5, 6, 7);
      o[db] = MFMA(vf, pb, o[db]);
    }
  }
}
DI void attn8_item(const Params& p, u16* lds, int bh, int qt) {
  unsigned char* ws = p.ws;
  const int tid = threadIdx.x, lane = tid & 63, w = tid >> 6, r = lane & 31, h = lane >> 5;
  const u16* Qp = (const u16*)(ws + OFF_Q) + (size_t)bh * 4096 * 96;
  const u16* Kp = (const u16*)(ws + OFF_K) + (size_t)bh * 4096 * 96;
  const u16* Vp = (const u16*)(ws + OFF_VTT) + (size_t)bh * 64 * 4096;
  const int q0 = qt * 256 + w * 32;
  bf16x8 qf[6];
#pragma unroll
  for (int ks = 0; ks < 6; ++ks) qf[ks] = *(const bf16x8*)(Qp + (size_t)(q0 + r) * 96 + ks * 16 + h * 8);
  f32x16 o[2]; o[0] = zero16(); o[1] = zero16();
  float mref = 0.f, l = 0.f;
  const int Jmax = 2 * qt + 1, jw = 4 * qt + (w >> 1);
  int kr[3], kc[3];
#pragma unroll
  for (int i = 0; i < 3; ++i) { const int idx = tid + 512 * i; kr[i] = idx / 12; kc[i] = idx % 12; }
  const int vr = tid >> 4, vc = tid & 15;
  u4v rk[3], rv[2];
#pragma unroll
  for (int i = 0; i < 3; ++i) rk[i] = *(const u4v*)(Kp + (size_t)kr[i] * 96 + kc[i] * 8);
#pragma unroll
  for (int i = 0; i < 2; ++i) rv[i] = *(const u4v*)(Vp + (size_t)(vr + 32 * i) * 4096 + vc * 8);
  __syncthreads();
#pragma unroll
  for (int i = 0; i < 3; ++i) *(u4v*)(lds + kr[i] * KST2 + kc[i] * 8) = rk[i];
#pragma unroll
  for (int i = 0; i < 2; ++i) { u16* dv = lds + 128 * KST2 + (vr + 32 * i) * VST2 + vc * 8; *(u2v*)dv = u2v{rv[i].x, rv[i].y}; *(u2v*)(dv + 4) = u2v{rv[i].z, rv[i].w}; }
  __syncthreads();
  for (int J = 0; J <= Jmax; ++J) {
    const int cur = J & 1;
    if (J < Jmax) {
#pragma unroll
      for (int i = 0; i < 3; ++i) rk[i] = *(const u4v*)(Kp + (size_t)((J + 1) * 128 + kr[i]) * 96 + kc[i] * 8);
#pragma unroll
      for (int i = 0; i < 2; ++i) rv[i] = *(const u4v*)(Vp + (size_t)(vr + 32 * i) * 4096 + (J + 1) * 128 + vc * 8);
    }
    const u16* sk = lds + cur * ATT_BUF2 + r * KST2 + h * 8;
    const u16* sv = lds + cur * ATT_BUF2 + 128 * KST2 + r * VST2 + 4 * h;
    if (2 * J + 1 <= jw) {
      f32x16 s0[2], s1[2];
      const float nm = -mref;
      att_qk(sk, qf, nm, s0);
      att_qk(sk + 64 * KST2, qf, nm, s1);
      const float sh = att_softmax(s0, 0.f, false, J == 0, mref, l, o);
      const bool adjnz = __builtin_amdgcn_ballot_w64(sh != 0.f) != 0ull;
      att_pv(sv, s0, o);
      att_softmax(s1, sh, adjnz, false, mref, l, o);
      att_pv(sv + 64, s1, o);
    } else if (2 * J <= jw) {
      f32x16 s0[2];
      att_qk(sk, qf, -mref, s0);
      att_softmax(s0, 0.f, false, J == 0, mref, l, o);
      att_pv(sv, s0, o);
    }
    if (J < Jmax) {
      u16* d = lds + (cur ^ 1) * ATT_BUF2;
#pragma unroll
      for (int i = 0; i < 3; ++i) *(u4v*)(d + kr[i] * KST2 + kc[i] * 8) = rk[i];
#pragma unroll
      for (int i = 0; i < 2; ++i) { u16* dv = d + 128 * KST2 + (vr + 32 * i) * VST2 + vc * 8; *(u2v*)dv = u2v{rv[i].x, rv[i].y}; *(u2v*)(dv + 4) = u2v{rv[i].z, rv[i].w}; }
    }
    __syncthreads();
  }
  l = xor32_add(l);
  const float inv = 1.f / l;
  const int b = bh >> 3, head = bh & 7;
  const size_t tok = (size_t)b * 4096 + q0 + r;
  const u16* sga = (const u16*)(ws + OFF_SGA) + tok * 512 + head * 64;
  u16* ya = (u16*)(ws + OFF_YA) + tok * 512 + head * 64;
#pragma unroll
  for (int db = 0; db < 2; ++db)
#pragma unroll
    for (int g = 0; g < 4; ++g) {
      const int dv0 = db * 32 + 8 * g + 4 * h;
      const u2v gt = *(const u2v*)(sga + dv0);
      u2v ov;
      ov.x = pk2(o[db][4 * g] * inv * bflo(gt.x), o[db][4 * g + 1] * inv * bfhi(gt.x));
      ov.y = pk2(o[db][4 * g + 2] * inv * bflo(gt.y), o[db][4 * g + 3] * inv * bfhi(gt.y));
      *(u2v*)(ya + dv0) = ov;
    }
}

DI void scan_item(const Params& p, int i, size_t out_off = OFF_UPD) {
  unsigned char* ws = p.ws;
  const int tid = threadIdx.x;
  const int bh = i >> 2, part = i & 3;
  const int e = part * 1024 + tid * 2, k = e & 63;
  u32* U = (u32*)((u16*)(ws + OFF_UPD) + (size_t)bh * 128 * 4096 + e);
  u32* UO = (u32*)((u16*)(ws + out_off) + (size_t)bh * 128 * 4096 + e);
  const f2v* Dc = (const f2v*)((const float*)(ws + OFF_DECAY) + (size_t)bh * 128 * 64 + k);
  float s0 = 0.f, s1 = 0.f;
  for (int n0 = 0; n0 < 128; n0 += 32) {
    u32 u[32]; f2v d[32];
#pragma unroll
    for (int q = 0; q < 32; ++q) { u[q] = U[(size_t)(n0 + q) * 2048]; d[q] = Dc[(n0 + q) * 32]; }
#pragma unroll
    for (int q = 0; q < 32; ++q) {
      UO[(size_t)(n0 + q) * 2048] = pk2(s0, s1);
      s0 = d[q].x * (s0 + bflo(u[q]));
      s1 = d[q].y * (s1 + bfhi(u[q]));
    }
  }
}

DI void phase3(const Params& p, unsigned char* smem, bool dup = false) {
  int* s_item = (int*)(smem + LDS_BYTES - 64);
  int* ctr = (int*)(p.ws + OFF_SSQ + (size_t)3 * T * 4) + (dup ? 1 : 0);
  constexpr int NSCAN = 256, NATT = 1024;
  for (;;) {
    __syncthreads();
    if (threadIdx.x == 0) *s_item = atomicAdd(ctr, 1);
    __syncthreads();
    const int item = *s_item;
    if (item >= NSCAN + NATT) break;
    if (item < NSCAN) { if (!dup) scan_item(p, item); }
    else { const int idx = item - NSCAN; attn8_item(p, (u16*)smem, idx & 63, 15 - (idx >> 6)); }
  }
}

DI void phase4(const Params& p) {
  unsigned char* ws = p.ws;
  const int tid = VTID, lane = tid & 63, w = tid >> 6, r = lane & 31, h = lane >> 5;
  for (int t = VBID; t < 2048; t += VBN) {
    const int bh = t >> 5, n = (t & 31) * 4 + w;
    const int b = bh >> 3, head = bh & 7;
    const size_t tok0 = (size_t)b * 4096 + n * 32;
    const u16* qd = (const u16*)(ws + OFF_QDEC) + (tok0 + r) * 512 + head * 64 + h * 8;
    const u16* ki = (const u16*)(ws + OFF_KINV) + (tok0 + r) * 512 + head * 64 + h * 8;
    const u16* vt = (const u16*)(ws + OFF_VT) + ((size_t)bh * 128 + n) * 64 * 32;
    const u16* sp = (const u16*)(ws + OFF_UPD) + ((size_t)bh * 128 + n) * 4096;
    bf16x8 qf[4], kf[4];
#pragma unroll
    for (int ks = 0; ks < 4; ++ks) { qf[ks] = *(const bf16x8*)(qd + ks * 16); kf[ks] = *(const bf16x8*)(ki + ks * 16); }
    f32x16 at = zero16();
#pragma unroll
    for (int ks = 0; ks < 4; ++ks) at = MFMA(kf[ks], qf[ks], at);
#pragma unroll
    for (int i = 0; i < 16; ++i) if (crow(i, h) > r) at[i] = 0.f;
    f32x16 o[2]; o[0] = zero16(); o[1] = zero16();
#pragma unroll
    for (int s2 = 0; s2 < 2; ++s2) {
      u4v pu; pu.x = pk2(at[8 * s2], at[8 * s2 + 1]); pu.y = pk2(at[8 * s2 + 2], at[8 * s2 + 3]);
      pu.z = pk2(at[8 * s2 + 4], at[8 * s2 + 5]); pu.w = pk2(at[8 * s2 + 6], at[8 * s2 + 7]);
      const bf16x8 pb = __builtin_bit_cast(bf16x8, pu);
#pragma unroll
      for (int vb = 0; vb < 2; ++vb) {
        const s16x4 lo = *(const s16x4*)(vt + (vb * 32 + r) * 32 + 16 * s2 + 4 * h);
        const s16x4 hi = *(const s16x4*)(vt + (vb * 32 + r) * 32 + 16 * s2 + 8 + 4 * h);
        const bf16x8 vf = __builtin_shufflevector(lo, hi, 0, 1, 2, 3, 4, 5, 6, 7);
        o[vb] = MFMA(vf, pb, o[vb]);
      }
    }
#pragma unroll
    for (int vb = 0; vb < 2; ++vb)
#pragma unroll
      for (int ks = 0; ks < 4; ++ks) {
        const bf16x8 sf = *(const bf16x8*)(sp + (vb * 32 + r) * 64 + ks * 16 + h * 8);
        o[vb] = MFMA(sf, qf[ks], o[vb]);
      }
    float ss = 0.f;
#pragma unroll
    for (int i = 0; i < 16; ++i) ss += o[0][i] * o[0][i] + o[1][i] * o[1][i];
    ss = xor32_add(ss);
    const float rs = rsqrtf(ss * (1.f / 64.f) + EPS);
    const u16* sgb = (const u16*)(ws + OFF_SGB) + (tok0 + r) * 512 + head * 64;
    u16* yb = (u16*)(ws + OFF_YB) + (tok0 + r) * 512 + head * 64;
#pragma unroll
    for (int vb = 0; vb < 2; ++vb)
#pragma unroll
      for (int g = 0; g < 4; ++g) {
        const int v0 = vb * 32 + 8 * g + 4 * h;
        const u2v gt = *(const u2v*)(sgb + v0);
        u2v ov;
        ov.x = pk2(o[vb][4 * g] * rs * bflo(gt.x), o[vb][4 * g + 1] * rs * bfhi(gt.x));
        ov.y = pk2(o[vb][4 * g + 2] * rs * bflo(gt.y), o[vb][4 * g + 3] * rs * bfhi(gt.y));
        *(u2v*)(yb + v0) = ov;
      }
  }
}

DI void phase5(const Params& p, unsigned char* smem) {
  unsigned char* ws = p.ws;
  pg8::StaticOrder S; S.init(T, 1024, (int)gridDim.x, (int)blockIdx.x);
  {
    pg8::Gemm g{(const u16*)(ws + OFF_YA), (const u16*)(ws + OFF_WA), T, 1024, 512};
    Epi5<false> E{(const u16*)p.out, (u16*)(ws + OFF_H), (u16*)(ws + OFF_M)};
    pg8::gemm_phase<Epi5<false>, pg8::StaticOrder, false>((PG8_LAS unsigned char*)smem, g, S, E, nullptr);
  }
  {
    pg8::Gemm g{(const u16*)(ws + OFF_YB), (const u16*)(ws + OFF_WB), T, 1024, 512};
    Epi5<true> E{(const u16*)p.out, (u16*)(ws + OFF_H), (u16*)(ws + OFF_M)};
    pg8::gemm_phase<Epi5<true>, pg8::StaticOrder, false>((PG8_LAS unsigned char*)smem, g, S, E, nullptr);
  }
}

DI void phase6(const Params& p, unsigned char* smem, bool dup = false) {
  unsigned char* ws = p.ws;
  pg8::Gemm g{(const u16*)(ws + OFF_M), (const u16*)(ws + OFF_WO), T, 1024, 1024};
  pg8::StaticOrder S; S.init(T, 1024, (int)gridDim.x, (int)blockIdx.x);
  Epi6 E{(u16*)(ws + OFF_H), (float*)(ws + OFF_SSQ) + 2 * T, dup};
  pg8::gemm_phase<Epi6, pg8::StaticOrder, false>((PG8_LAS unsigned char*)smem, g, S, E, nullptr);
}

DI void phase7(const Params& p) {
  const float* ssq_y = (const float*)(p.ws + OFF_SSQ) + 2 * T;
  const u2v* Y = (const u2v*)(p.ws + OFF_H);
  const int gtid = blockIdx.x * blockDim.x + threadIdx.x, gthreads = gridDim.x * blockDim.x;
  for (int i = gtid; i < T * 256; i += gthreads) {
    const int row = i >> 8, c4 = i & 255;
    const float rs = rsqrtf(ssq_y[row] * (1.f / 1024.f) + EPS);
    const u2v y = Y[i];
    const f4v xv = ((const f4v*)p.x)[i];
    const f4v g = ((const f4v*)p.g_post)[c4];
    f4v o;
    o.x = xv.x + bflo(y.x) * rs * g.x; o.y = xv.y + bfhi(y.x) * rs * g.y; o.z = xv.z + bflo(y.y) * rs * g.z; o.w = xv.w + bfhi(y.y) * rs * g.w;
    ((f4v*)p.out)[i] = o;
  }
}

__global__ void __launch_bounds__(512, 2) fwd_megakernel(Params p) {
  extern __shared__ __attribute__((aligned(16))) unsigned char smem[];
  u16* lds = (u16*)(smem + (threadIdx.x >> 8) * VLDS);
  cg::grid_group grid = cg::this_grid();
  volatile LAS unsigned* xst = (volatile LAS unsigned*)(smem + LDS_BYTES - 48);
  if (threadIdx.x == 0) { xst[0] = 0u; xst[1] = 0u; }
  __syncthreads();
  XcdBarrier xb = xcd_barrier_post((unsigned*)(p.ws + OFF_BAR), xst);
  if (p.ph_hi > 1000) grid.sync();
#define RUN_PHASE(N, CALL) if (p.ph_lo <= N && N < p.ph_hi) { if (N > p.ph_lo) xcd_barrier(xb); CALL; }
#define DUP_PHASE(N, CALL) if (DUP_PH == N) { xcd_barrier(xb); CALL; }
  RUN_PHASE(0, phase0(p))
  DUP_PHASE(0, phase0(p))
  if (p.ph_lo <= 1 && 1 < p.ph_hi) for (int rep = 0; rep < (DUP_PH == 1 ? 2 : 1); ++rep) { if (rep > 0 || 1 > p.ph_lo) xcd_barrier(xb); phase1(p, smem, rep > 0); }
  if (p.ph_lo <= 2 && 2 < p.ph_hi) for (int rep = 0; rep < (DUP_PH == 2 ? 2 : 1); ++rep) { if (rep > 0 || 2 > p.ph_lo) xcd_barrier(xb); phase2(p, smem, lds); }
  RUN_PHASE(3, phase2b(p, smem))
  DUP_PHASE(3, phase2b(p, smem))
  RUN_PHASE(4, phase3(p, smem))
  DUP_PHASE(4, phase3(p, smem, true))
  if (DUP_PH == 9) { xcd_barrier(xb); for (int i = blockIdx.x; i < 256; i += gridDim.x) scan_item(p, i, OFF_K); }
  RUN_PHASE(5, phase4(p))
  DUP_PHASE(5, phase4(p))
  RUN_PHASE(6, phase5(p, smem))
  DUP_PHASE(6, phase5(p, smem))
  RUN_PHASE(7, phase6(p, smem))
  DUP_PHASE(7, phase6(p, smem, true))
  RUN_PHASE(8, phase7(p))
  if (DUP_PH == 8) { xcd_barrier(xb); phase6(p, smem, true); xcd_barrier(xb); phase7(p); }
}

extern "C" void kernel_launch(void* const* d_in, const int* in_sizes, int n_in, void* d_out, int out_size, void* d_ws, size_t ws_size,
                              hipStream_t stream) {
  static int grid_blocks = 0;
  if (!grid_blocks) {
    int dev = 0, cus = 0, per_cu = 0;
    hipGetDevice(&dev);
    hipDeviceGetAttribute(&cus, hipDeviceAttributeMultiprocessorCount, dev);
    hipFuncSetAttribute((const void*)fwd_megakernel, hipFuncAttributeMaxDynamicSharedMemorySize, LDS_BYTES);
    hipOccupancyMaxActiveBlocksPerMultiprocessor(&per_cu, (const void*)fwd_megakernel, 512, LDS_BYTES);
    if (per_cu < 1) per_cu = 1;
    if (per_cu > 1) per_cu = 1;
    grid_blocks = cus * per_cu;
    if (ws_size < WS_NEED) fprintf(stderr, "kernel_launch: workspace too small: %zu < %zu\n", ws_size, (size_t)WS_NEED);
  }
  if (ws_size < WS_NEED) return;
  Params p{};
  p.x = (const float*)d_in[0]; p.g_pre = (const float*)d_in[1]; p.w_in = (const float*)d_in[2]; p.b_gate = (const float*)d_in[3];
  p.g_q = (const float*)d_in[4]; p.w_uq = (const float*)d_in[5]; p.g_kv = (const float*)d_in[6]; p.w_ukv = (const float*)d_in[7];
  p.lb_logits = (const float*)d_in[8]; p.g_hgrn = (const float*)d_in[9]; p.w_a = (const float*)d_in[10]; p.w_b = (const float*)d_in[11];
  p.w_out = (const float*)d_in[12]; p.g_post = (const float*)d_in[13];
  p.out = (float*)d_out; p.ws = (unsigned char*)d_ws;
#if ONE_LAUNCH
  p.ph_lo = 0; p.ph_hi = 9;
  (void)hipMemsetAsync((unsigned char*)d_ws + OFF_BAR, 0, 16384, stream);
  void* args[] = {&p};
  hipError_t e = hipLaunchCooperativeKernel((const void*)fwd_megakernel, dim3(grid_blocks), dim3(512), args, LDS_BYTES, stream);
  if (e != hipSuccess) fprintf(stderr, "cooperative launch failed: %s (grid %d)\n", hipGetErrorString(e), grid_blocks);
#else
  for (int ph = 0; ph < 9; ++ph) {
    p.ph_lo = ph; p.ph_hi = ph + 1;
    (void)hipMemsetAsync((unsigned char*)d_ws + OFF_BAR, 0, 16384, stream);
    void* args[] = {&p};
    hipError_t e = hipLaunchCooperativeKernel((const void*)fwd_megakernel, dim3(grid_blocks), dim3(512), args, LDS_BYTES, stream);
    if (e != hipSuccess) fprintf(stderr, "cooperative launch failed: %s (grid %d)\n", hipGetErrorString(e), grid_blocks);
  }
#endif
}
```

```cpp
#include <hip/hip_runtime.h>
#include <hip/hip_cooperative_groups.h>
#include <cstdio>
namespace cg = cooperative_groups;

#define DI __device__ __forceinline__
#define VTID ((int)(threadIdx.x & 255))
#define VBID ((int)(blockIdx.x * 2 + (threadIdx.x >> 8)))
#define VBN ((int)(gridDim.x * 2))
typedef unsigned short u16;
typedef unsigned int u32;
typedef __attribute__((ext_vector_type(8))) short bf16x8;
typedef __attribute__((ext_vector_type(4))) short s16x4;
typedef __attribute__((ext_vector_type(16))) float f32x16;
typedef __attribute__((ext_vector_type(2))) __bf16 bf2_t;
typedef __attribute__((ext_vector_type(2))) float f2_t;
typedef __attribute__((ext_vector_type(4))) unsigned int u4v;
typedef __attribute__((ext_vector_type(2))) unsigned int u2v;
typedef __attribute__((ext_vector_type(4))) float f4v;
typedef __attribute__((ext_vector_type(2))) float f2v;
#define MFMA(a, b, c) __builtin_amdgcn_mfma_f32_32x32x16_bf16((a), (b), (c), 0, 0, 0)

#ifndef DUP_PH
#define DUP_PH -1
#endif
#ifndef ONE_LAUNCH
#define ONE_LAUNCH 1
#endif

constexpr int T = 32768;
constexpr int SEQ = 4096;
constexpr int DIN = 5664;
constexpr int NP = 5888;
constexpr float EPS = 1e-6f;
constexpr float QSCALE = 1.4426950408889634f * 0.10206207261596575f;

constexpr size_t SZ_WIN = (size_t)NP * 1024 * 2;
constexpr size_t OFF_WIN = 0;
constexpr size_t OFF_WUQ = OFF_WIN + SZ_WIN;
constexpr size_t OFF_WUKV = OFF_WUQ + (size_t)768 * 768 * 2;
constexpr size_t OFF_WA = OFF_WUKV + (size_t)1024 * 256 * 2;
constexpr size_t OFF_WB = OFF_WA + (size_t)1024 * 512 * 2;
constexpr size_t OFF_WO = OFF_WB + (size_t)1024 * 512 * 2;
constexpr size_t OFF_ROPE = OFF_WO + (size_t)1024 * 1024 * 2;
constexpr size_t OFF_SSQ = OFF_ROPE + (size_t)4096 * 16 * 2 * 4;
constexpr size_t OFF_DECAY = OFF_SSQ + (size_t)(3 * T + 64) * 4;
constexpr size_t OFF_H = OFF_DECAY + (size_t)64 * 128 * 64 * 4;
constexpr size_t OFF_Q = OFF_H;
constexpr size_t OFF_CQ = OFF_H + (size_t)T * 1024 * 2;
constexpr size_t OFF_YA = OFF_CQ;
constexpr size_t OFF_CKV = OFF_CQ + (size_t)T * 768 * 2;
constexpr size_t OFF_KPE = OFF_CKV + (size_t)T * 256 * 2;
constexpr size_t OFF_SGA = OFF_KPE + (size_t)T * 32 * 4;
constexpr size_t OFF_SGB = OFF_SGA + (size_t)T * 512 * 2;
constexpr size_t OFF_HQ = OFF_SGB + (size_t)T * 512 * 2;
constexpr size_t OFF_UPD = OFF_HQ;
constexpr size_t OFF_HF = OFF_HQ + (size_t)T * 512 * 2;
constexpr size_t OFF_HI = OFF_HF + (size_t)T * 512 * 2;
constexpr size_t OFF_YB = OFF_HI;
constexpr size_t OFF_QDEC = OFF_HI + (size_t)T * 512 * 2;
constexpr size_t OFF_KINV = OFF_QDEC + (size_t)T * 512 * 2;
constexpr size_t OFF_VT = OFF_KINV + (size_t)T * 512 * 2;
constexpr size_t OFF_K = OFF_VT + (size_t)T * 512 * 2;
constexpr size_t OFF_M = OFF_K;
constexpr size_t OFF_VTT = OFF_K + (size_t)T * 768 * 2;
constexpr size_t OFF_BAR = OFF_VTT + (size_t)T * 512 * 2;
constexpr size_t WS_NEED = OFF_BAR + 16384;

constexpr int VLDS = 2 * 2 * 128 * 72 * 2;
constexpr int LDS_BYTES = 2 * VLDS + 64;
constexpr int SST = 132;

struct Params {
  const float *x, *g_pre, *w_in, *b_gate, *g_q, *w_uq, *g_kv, *w_ukv, *lb_logits, *g_hgrn, *w_a, *w_b, *w_out, *g_post;
  float* out;
  unsigned char* ws;
  int ph_lo, ph_hi;
};

DI u32 pk2(float a, float b) { f2_t v = {a, b}; bf2_t r = __builtin_convertvector(v, bf2_t); return __builtin_bit_cast(u32, r); }
DI float bflo(u32 u) { return __uint_as_float(u << 16); }
DI float bfhi(u32 u) { return __uint_as_float(u & 0xffff0000u); }
DI u4v pk8(f4v a, f4v b) { u4v r; r.x = pk2(a.x, a.y); r.y = pk2(a.z, a.w); r.z = pk2(b.x, b.y); r.w = pk2(b.z, b.w); return r; }
DI float rcpf(float x) { return __builtin_amdgcn_rcpf(x); }
DI float sigmoidf_(float x) { return rcpf(1.f + __expf(-x)); }
DI float siluf_(float x) { return x * sigmoidf_(x); }
DI float xor32_max(float x) { const unsigned u = __float_as_uint(x); auto r = __builtin_amdgcn_permlane32_swap(u, u, false, false); return fmaxf(__uint_as_float(r[0]), __uint_as_float(r[1])); }
DI float xor32_add(float x) { const unsigned u = __float_as_uint(x); auto r = __builtin_amdgcn_permlane32_swap(u, u, false, false); return __uint_as_float(r[0]) + __uint_as_float(r[1]); }
DI float xor16_add(float x) { const unsigned u = __float_as_uint(x); auto r = __builtin_amdgcn_permlane16_swap(u, u, false, false); return __uint_as_float(r[0]) + __uint_as_float(r[1]); }
DI int crow(int reg, int h) { return (reg & 3) + 8 * (reg >> 2) + 4 * h; }
DI f32x16 zero16() { f32x16 z;
#pragma unroll
  for (int i = 0; i < 16; ++i) z[i] = 0.f; return z; }

__constant__ float c_invfreq[16] = {1.0f, 0.5623413324356079f, 0.3162277638912201f, 0.17782793939113617f, 0.10000000149011612f,
  0.05623413249850273f, 0.03162277489900589f, 0.017782794311642647f, 0.009999999776482582f, 0.005623413249850273f,
  0.003162277629598975f, 0.0017782794311642647f, 0.0010000000474974513f, 0.000562341301701963f, 0.0003162277571391314f,
  0.00017782794020604342f};

DI void sincos_d(double a, float& sn, float& cs) {
  const double k = rint(a * 0.63661977236758134308);
  const double y = a - k * 1.57079632679489661923;
  const double y2 = y * y;
  const double s = y * (1.0 + y2 * (-1.0 / 6 + y2 * (1.0 / 120 + y2 * (-1.0 / 5040 + y2 * (1.0 / 362880 + y2 * (-1.0 / 39916800 + y2 * (1.0 / 6227020800.0)))))));
  const double c = 1.0 + y2 * (-0.5 + y2 * (1.0 / 24 + y2 * (-1.0 / 720 + y2 * (1.0 / 40320 + y2 * (-1.0 / 3628800 + y2 * (1.0 / 479001600.0 + y2 * (-1.0 / 87178291200.0)))))));
  const int q = ((int)k) & 3;
  const double ss = (q == 0) ? s : (q == 1) ? c : (q == 2) ? -s : -c;
  const double cc = (q == 0) ? c : (q == 1) ? -s : (q == 2) ? -c : s;
  sn = (float)ss; cs = (float)cc;
}

#define XB_TMO      128
#define XB_XCNT(j)  (256  + 64 * (j))
#define XB_XSUB(j)  (1280 + 64 * (j))
#define XB_XGEN(j)  (2304 + 64 * (j))
#define XB_TOP      3328
#define XB_TOPGEN   3392
#define XCD_BAR_WORDS 3456
#define XB_SPIN_CAP (1u << 22)
#define LAS __attribute__((address_space(3)))
DI unsigned xb_ld(unsigned* p)              { return __hip_atomic_load(p, __ATOMIC_RELAXED, __HIP_MEMORY_SCOPE_AGENT); }
DI unsigned xb_add(unsigned* p, unsigned v) { return __hip_atomic_fetch_add(p, v, __ATOMIC_RELAXED, __HIP_MEMORY_SCOPE_AGENT); }
DI unsigned xb_xcc_id() { return (unsigned)__builtin_amdgcn_s_getreg((3 << 11) | 20) & 0xFu; }
#define XB_SPIN(cond, bar) do { unsigned _sp = 0; while (cond) { __builtin_amdgcn_s_sleep(1); \
    if ((++_sp & 255u) == 0u) { if (xb_ld(&(bar)[XB_TMO])) break; if (_sp > XB_SPIN_CAP) { atomicAdd(&(bar)[XB_TMO], 1u); break; } } } } while (0)
struct XcdBarrier { unsigned* bar; unsigned x; volatile LAS unsigned* st; };
DI XcdBarrier xcd_barrier_post(unsigned* bar, volatile LAS unsigned* st) {
  XcdBarrier b; b.bar = bar; b.x = xb_xcc_id(); b.st = st;
  if (threadIdx.x == 0) (void)xb_add(&bar[XB_XCNT(b.x)], 1u);
  return b;
}
DI void xcd_barrier_complete(unsigned* bar, unsigned x, unsigned& nloc, unsigned& nx) {
  const unsigned G = gridDim.x * gridDim.y * gridDim.z;
  unsigned sum, cnt, mine, sp = 0u;
  for (;;) {
    sum = 0u; cnt = 0u; mine = 0u;
#pragma unroll
    for (unsigned j = 0; j < 16; ++j) { const unsigned c = xb_ld(&bar[XB_XCNT(j)]); sum += c; cnt += (c > 0u) ? 1u : 0u; mine = (j == x) ? c : mine; }
    if (sum == G) break;
    __builtin_amdgcn_s_sleep(1);
    if ((++sp & 255u) == 0u) { if (xb_ld(&bar[XB_TMO])) break; if (sp > XB_SPIN_CAP) { atomicAdd(&bar[XB_TMO], 1u); break; } }
  }
  nloc = mine > 0u ? mine : 1u; nx = cnt > 0u ? cnt : 1u;
}
DI void xcd_barrier(const XcdBarrier& b) {
  asm volatile("s_waitcnt vmcnt(0)" ::: "memory");
  __syncthreads();
  if (threadIdx.x == 0) {
    unsigned* bar = b.bar;
    __builtin_amdgcn_s_waitcnt(0);
    unsigned nloc = b.st[0], nx = b.st[1];
    if (nloc == 0u) { xcd_barrier_complete(bar, b.x, nloc, nx); b.st[0] = nloc; b.st[1] = nx; }
    const unsigned old = xb_add(&bar[XB_XSUB(b.x)], 1u);
    const unsigned gen = old / nloc;
    if (old + 1u == (gen + 1u) * nloc) {
      __builtin_amdgcn_fence(__ATOMIC_RELEASE, "agent");
      asm volatile("s_waitcnt vmcnt(0)" ::: "memory");
      const unsigned og = xb_add(&bar[XB_TOP], 1u);
      const unsigned tg = og / nx;
      if (og + 1u == (tg + 1u) * nx) xb_add(&bar[XB_TOPGEN], 1u);
      else XB_SPIN(xb_ld(&bar[XB_TOPGEN]) == tg, bar);
      __builtin_amdgcn_fence(__ATOMIC_ACQUIRE, "agent");
      xb_add(&bar[XB_XGEN(b.x)], 1u);
      asm volatile("s_waitcnt vmcnt(0)" ::: "memory");
    } else {
      XB_SPIN(xb_ld(&bar[XB_XGEN(b.x)]) == gen, bar);
      __builtin_amdgcn_fence(__ATOMIC_ACQUIRE, "agent");
      asm volatile("s_waitcnt vmcnt(0)" ::: "memory");
    }
  }
  __syncthreads();
}

template <int KIND>
DI int colmap(int n) {
  if (KIND == 0) {
    if (n < 1024) return n;
    if (n < 1536) return 1056 + (n - 1024);
    if (n < 2048) return 3104 + (n - 1536);
    if (n < 4096) return 3616 + (n - 2048);
    if (n < 4608) return 1568 + (n - 4096);
    if (n < 5120) return 2080 + (n - 4608);
    if (n < 5632) return 2592 + (n - 5120);
    if (n < 5664) return 1024 + (n - 5632);
    return -1;
  } else if (KIND == 1) {
    if (n < 512) return (n >> 6) * 96 + (n & 63);
    int i = n - 512; int w = i & 31, g = w >> 3, e = w & 7; return (i >> 5) * 96 + 64 + ((e < 4) ? (4 * g + e) : (16 + 4 * g + (e - 4)));
  } else if (KIND == 3) {
    if (n < 512) return (n >> 6) * 128 + (n & 63);
    int i = n - 512; return (i >> 6) * 128 + 64 + (i & 63);
  } else return n;
}
template <int KIND>
DI void conv_weight(u16* dst, const float* src, int ldw, int ncount, int K, const float* gain, int gmask, int gtid, int gthreads) {
  const int total = ncount * (K >> 3);
  for (int it = gtid; it < total; it += gthreads) {
    const int n = it % ncount, kc = it / ncount;
    const int sc = colmap<KIND>(n);
    float v[8];
#pragma unroll
    for (int i = 0; i < 8; ++i) {
      const int k = kc * 8 + i;
      float x = (sc >= 0) ? src[(size_t)k * ldw + sc] : 0.f;
      if (gain) x *= gain[k & gmask];
      v[i] = x;
    }
    u4v o; o.x = pk2(v[0], v[1]); o.y = pk2(v[2], v[3]); o.z = pk2(v[4], v[5]); o.w = pk2(v[6], v[7]);
    *(u4v*)(dst + (size_t)n * K + kc * 8) = o;
  }
}

DI void phase0(const Params& p) {
  unsigned char* ws = p.ws;
  const int gtid = blockIdx.x * blockDim.x + threadIdx.x, gthreads = gridDim.x * blockDim.x;
  float* ssq = (float*)(ws + OFF_SSQ);
  for (int i = gtid; i < 3 * T + 64; i += gthreads) ssq[i] = 0.f;
  float* rope = (float*)(ws + OFF_ROPE);
  for (int i = gtid; i < 4096 * 16; i += gthreads) {
    const int pos = i >> 4, j = i & 15;
    const float ang = (float)pos * c_invfreq[j];
    float sn, cs; sincos_d((double)ang, sn, cs);
    rope[i] = cs; rope[65536 + i] = sn;
  }
  conv_weight<0>((u16*)(ws + OFF_WIN), p.w_in, DIN, NP, 1024, nullptr, 0, gtid, gthreads);
  u16* H = (u16*)(ws + OFF_H);
  const int lane = threadIdx.x & 63;
  const int gw = gtid >> 6, nw = gthreads >> 6;
  for (int row = gw; row < T; row += nw) {
    const f4v* xr = (const f4v*)(p.x + (size_t)row * 1024);
    f4v v[4];
    float ss = 0.f;
#pragma unroll
    for (int i = 0; i < 4; ++i) { v[i] = xr[lane * 4 + i]; ss += v[i].x * v[i].x + v[i].y * v[i].y + v[i].z * v[i].z + v[i].w * v[i].w; }
#pragma unroll
    for (int o = 32; o >= 1; o >>= 1) ss += __shfl_xor(ss, o);
    const float rs = rsqrtf(ss * (1.f / 1024.f) + EPS);
    const f4v* gp = (const f4v*)(p.g_pre);
    f4v g[4];
#pragma unroll
    for (int i = 0; i < 4; ++i) { g[i] = gp[lane * 4 + i]; v[i].x *= rs * g[i].x; v[i].y *= rs * g[i].y; v[i].z *= rs * g[i].z; v[i].w *= rs * g[i].w; }
    u4v* hr = (u4v*)(H + (size_t)row * 1024 + lane * 16);
    hr[0] = pk8(v[0], v[1]); hr[1] = pk8(v[2], v[3]);
  }
}

constexpr int TS = 128 * 72;
DI void gemm_ld(u4v (&ra)[4], u4v (&rb)[4], const u16* ga, const u16* gb, int lda, int ldb, int ko) {
#pragma unroll
  for (int i = 0; i < 4; ++i) { ra[i] = *(const u4v*)(ga + (size_t)(32 * i) * lda + ko); rb[i] = *(const u4v*)(gb + (size_t)(32 * i) * ldb + ko); }
}
DI void gemm_st(const u4v (&ra)[4], const u4v (&rb)[4], u16* buf, int lr, int lc) {
  u16* sa = buf; u16* sb = buf + TS;
#pragma unroll
  for (int i = 0; i < 4; ++i) { *(u4v*)(sa + (lr + 32 * i) * 72 + lc * 8) = ra[i]; *(u4v*)(sb + (lr + 32 * i) * 72 + lc * 8) = rb[i]; }
}
DI void gemm_mma(const u16* buf, f32x16 (&acc)[2][2], int wm, int wn, int r, int h) {
  const u16* sa = buf + (wm * 64 + r) * 72 + h * 8;
  const u16* sb = buf + TS + (wn * 64 + r) * 72 + h * 8;
#pragma unroll
  for (int ks = 0; ks < 4; ++ks) {
    const bf16x8 a0 = *(const bf16x8*)(sa + ks * 16);
    const bf16x8 a1 = *(const bf16x8*)(sa + 32 * 72 + ks * 16);
    const bf16x8 b0 = *(const bf16x8*)(sb + ks * 16);
    const bf16x8 b1 = *(const bf16x8*)(sb + 32 * 72 + ks * 16);
    acc[0][0] = MFMA(a0, b0, acc[0][0]);
    acc[0][1] = MFMA(a0, b1, acc[0][1]);
    acc[1][0] = MFMA(a1, b0, acc[1][0]);
    acc[1][1] = MFMA(a1, b1, acc[1][1]);
  }
}
DI void gemm_core(const u16* __restrict__ A, int lda, const u16* __restrict__ B, int ldb, int K, u16* lds, f32x16 (&acc)[2][2], int tid) {
  const int lane = tid & 63, w = tid >> 6, wm = w >> 1, wn = w & 1, r = lane & 31, h = lane >> 5;
  const int lc = tid & 7, lr = tid >> 3;
  const u16* ga = A + (size_t)lr * lda + lc * 8;
  const u16* gb = B + (size_t)lr * ldb + lc * 8;
  u4v ra0[4], rb0[4], ra1[4], rb1[4];
  gemm_ld(ra0, rb0, ga, gb, lda, ldb, 0);
  gemm_ld(ra1, rb1, ga, gb, lda, ldb, 64);
#pragma unroll
  for (int i = 0; i < 2; ++i)
#pragma unroll
    for (int j = 0; j < 2; ++j) acc[i][j] = zero16();
  u16* L0 = lds; u16* L1 = lds + 2 * TS;
  __syncthreads();
  gemm_st(ra0, rb0, L0, lr, lc);
  __syncthreads();
  const int nk = K >> 6;
  int kt = 0;
  for (; kt + 2 < nk; kt += 2) {
    gemm_ld(ra0, rb0, ga, gb, lda, ldb, (kt + 2) * 64);
    __builtin_amdgcn_sched_barrier(0);
    gemm_mma(L0, acc, wm, wn, r, h);
    gemm_st(ra1, rb1, L1, lr, lc);
    __syncthreads();
    gemm_ld(ra1, rb1, ga, gb, lda, ldb, (kt + 3) * 64);
    __builtin_amdgcn_sched_barrier(0);
    gemm_mma(L1, acc, wm, wn, r, h);
    gemm_st(ra0, rb0, L0, lr, lc);
    __syncthreads();
  }
  gemm_mma(L0, acc, wm, wn, r, h);
  gemm_st(ra1, rb1, L1, lr, lc);
  __syncthreads();
  gemm_mma(L1, acc, wm, wn, r, h);
  __syncthreads();
}

DI void stage_pass(const f32x16 (&acc)[2][2], float* stage, int p, int tid) {
  const int lane = tid & 63, w = tid >> 6, wm = w >> 1, wn = w & 1, r = lane & 31, h = lane >> 5;
  __syncthreads();
  if (wm == p) {
#pragma unroll
    for (int i = 0; i < 2; ++i)
#pragma unroll
      for (int j = 0; j < 2; ++j)
#pragma unroll
        for (int reg = 0; reg < 16; ++reg) stage[(i * 32 + crow(reg, h)) * SST + wn * 64 + j * 32 + r] = acc[i][j][reg];
  }
  __syncthreads();
}

namespace pg8 {
#define PG8_LAS __attribute__((address_space(3)))
typedef unsigned short bf16_t;
typedef short bf16x8 __attribute__((ext_vector_type(8)));
typedef float f32x4 __attribute__((ext_vector_type(4)));
typedef unsigned u32x4 __attribute__((ext_vector_type(4)));
constexpr int BM = 256, BK = 64, HALF = 128, HTB = HALF * BK * 2  , STAGE_BYTES = 8 * HTB, NXCD = 8, WGM = 8;

__host__ __device__ __forceinline__ int lds_byte(int r, int c) { const int st = (r >> 4) * 2 + (c >> 5), rr = r & 15, cc = c & 31, ob = rr * 64 + cc * 2; return st * 1024 + (ob ^ (((ob >> 9) & 1) << 5)); }
__host__ __device__ __forceinline__ void stage_rc(int b, int& R, int& C) { const int st = b / 1024, sb = b % 1024, swz = sb ^ (((sb >> 9) & 1) << 5); R = (st >> 1) * 16 + swz / 64; C = (st & 1) * 32 + (swz % 64) / 2; }
__host__ __device__ __forceinline__ int perm32(int rho) { const int n = rho >> 4, i = rho & 15; return 8 * (i >> 2) + 4 * n + (i & 3); }

struct Unit { int pm, pn; };
struct Gemm { const bf16_t* A; const bf16_t* Bt; int M, N, K; };

struct StaticOrder {
    int nM, nN, nwg, G, c;
    __host__ __device__ void init(int M, int N, int G_, int c_) { nM = M / BM; nN = N / BM; nwg = nM * nN; G = G_; c = c_; }
    __host__ __device__ bool next(int i, Unit& u) const {
        const long L = (long)i * G + c; if (L >= nwg) return false;
        int wgid = (int)L; { const int q = nwg / NXCD, r = nwg % NXCD, xcd = wgid % NXCD, off = wgid / NXCD; wgid = (xcd < r ? xcd * (q + 1) : r * (q + 1) + (xcd - r) * q) + off; }
        const int nig = WGM * nN, gid = wgid / nig, fm = gid * WGM, gsz = (nM - fm) < WGM ? (nM - fm) : WGM;
        u.pm = fm + ((wgid % nig) % gsz); u.pn = (wgid % nig) / gsz; return true;
    }
    __device__ __forceinline__ void a_ready(const Unit&) const {}
    __device__ __forceinline__ void done(const Unit&) const {}
};
template <class Epi, class Sched, bool STAMP = false, bool SWAP = false>
__device__ __forceinline__ void gemm_phase(PG8_LAS unsigned char* lds, const Gemm g, const Sched& S, const Epi& E, unsigned long long* stamps) {
    const int tid = threadIdx.x, wid = __builtin_amdgcn_readfirstlane(tid >> 6), lane = tid & 63, wr = wid >> 2, wc = wid & 3, fr = lane & 15, fq = lane >> 4;
    const int K = g.K, nt = K / BK;
    int ts_lo = 0, ts_hi = 0, nts = 0; const unsigned long long rt_entry = STAMP ? (unsigned long long)wall_clock64() : 0ull;
#define PG8_STAMP() do { if (STAMP && wid == 0 && nts < 64) { const unsigned long long _c = (unsigned long long)clock64(); \
        ts_lo = (lane == nts) ? (int)(unsigned)_c : ts_lo; ts_hi = (lane == nts) ? (int)(unsigned)(_c >> 32) : ts_hi; ++nts; } } while (0)
    PG8_STAMP();
    unsigned voffA[2], voffB[2];
#pragma unroll
    for (int i = 0; i < 2; ++i) { int R, C; stage_rc(tid * 16 + i * 8192, R, C); const int Rb = Epi::PERM ? ((R & ~31) + perm32(R & 31)) : R;
        voffA[i] = (unsigned)(R * K + C) * 2u; voffB[i] = (unsigned)(Rb * K + C) * 2u; }
    const size_t kstep = (size_t)(BK * 2);
    const size_t hstep = (size_t)HALF * K * 2;
    const size_t tstep = 2 * hstep;
    const unsigned ldsw = (unsigned)wid * 1024u;
    const int aoff = lds_byte(wr * 64 + fr, fq * 8), boff = lds_byte(wc * 32 + fr, fq * 8);
#define PG8_SA(b, h) (((b) * 2 + (h)) * HTB)
#define PG8_SB(b, h) ((4 + (b) * 2 + (h)) * HTB)
#define PG8_STAGE(bufoff, gbase, voff) do { _Pragma("unroll") for (int _i = 0; _i < 2; ++_i) \
        __builtin_amdgcn_global_load_lds((const unsigned*)((const char*)(gbase) + (voff)[_i]), (PG8_LAS unsigned*)(lds + (bufoff) + ldsw + _i * 8192), 16, 0, 0); } while (0)
#define PG8_LDA(dst, b, h) do { _Pragma("unroll") for (int m = 0; m < 4; ++m) _Pragma("unroll") for (int k = 0; k < 2; ++k) dst[m][k] = *(const PG8_LAS bf16x8*)(lds + PG8_SA(b, h) + aoff + m * 2048 + k * 1024); } while (0)
#define PG8_LDB(dst, b, h) do { _Pragma("unroll") for (int n = 0; n < 2; ++n) _Pragma("unroll") for (int k = 0; k < 2; ++k) dst[n][k] = *(const PG8_LAS bf16x8*)(lds + PG8_SB(b, h) + boff + n * 2048 + k * 1024); } while (0)
#define PG8_MMA(ai, bj, At, Bt) do { __builtin_amdgcn_s_setprio(1); _Pragma("unroll") for (int m = 0; m < 4; ++m) _Pragma("unroll") for (int n = 0; n < 2; ++n) _Pragma("unroll") for (int k = 0; k < 2; ++k) \
        acc[ai][bj][m][n] = SWAP ? __builtin_amdgcn_mfma_f32_16x16x32_bf16(At[m][k], Bt[n][k], acc[ai][bj][m][n], 0, 0, 0) : __builtin_amdgcn_mfma_f32_16x16x32_bf16(Bt[n][k], At[m][k], acc[ai][bj][m][n], 0, 0, 0); __builtin_amdgcn_s_setprio(0); } while (0)
#define PG8_WAIT_V(n) asm volatile("s_waitcnt vmcnt(" #n ")" ::: "memory")
#define PG8_WAIT_L(n) asm volatile("s_waitcnt lgkmcnt(" #n ")" ::: "memory")
#define PG8_BAR __builtin_amdgcn_s_barrier()
#define PG8_SCHED __builtin_amdgcn_sched_barrier(0)
    Unit cur, nxt; int ui = 0;
    if (!S.next(0, cur)) return;
    f32x4 acc[2][2][4][2];
#pragma unroll
    for (int a = 0; a < 2; ++a)
#pragma unroll
        for (int b = 0; b < 2; ++b)
#pragma unroll
            for (int m = 0; m < 4; ++m)
#pragma unroll
                for (int n = 0; n < 2; ++n) acc[a][b][m][n] = (f32x4){0.f, 0.f, 0.f, 0.f};
    bf16x8 At[4][2], B0[2][2], B1[2][2];
    const char* cA = (const char*)g.A + (size_t)cur.pm * tstep; const char* cB = (const char*)g.Bt + (size_t)cur.pn * tstep;
    S.a_ready(cur);
    PG8_STAGE(PG8_SB(0, 0), cB, voffB); PG8_STAGE(PG8_SA(0, 0), cA, voffA); PG8_STAGE(PG8_SB(0, 1), cB + hstep, voffB); PG8_STAGE(PG8_SA(0, 1), cA + hstep, voffA);
    if (wr == 1) PG8_BAR;
    PG8_WAIT_V(4); PG8_BAR;
    PG8_STAGE(PG8_SB(1, 0), cB + kstep, voffB); PG8_STAGE(PG8_SA(1, 0), cA + kstep, voffA); PG8_STAGE(PG8_SB(1, 1), cB + hstep + kstep, voffB);
    PG8_WAIT_V(6); PG8_BAR;
    PG8_STAMP();
    for (;;) {
        const bool has_next = S.next(ui + 1, nxt);
        const char* nA = has_next ? (const char*)g.A + (size_t)nxt.pm * tstep : cA; const char* nB = has_next ? (const char*)g.Bt + (size_t)nxt.pn * tstep : cB;
        for (int t = 0; t < nt; t += 2) {
            const bool last = (t == nt - 2);
            const char* a1 = cA + (size_t)(t + 1) * kstep;
            const char* a2 = last ? nA : cA + (size_t)(t + 2) * kstep; const char* b2 = last ? nB : cB + (size_t)(t + 2) * kstep;
            const char* a3 = a2 + kstep; const char* b3 = b2 + kstep;
            if (last && has_next) S.a_ready(nxt);
            PG8_LDB(B0, 0, 0); PG8_SCHED; PG8_LDA(At, 0, 0); PG8_STAGE(PG8_SA(1, 1), a1 + hstep, voffA);
            PG8_WAIT_L(8); PG8_BAR; PG8_WAIT_L(0); PG8_MMA(0, 0, At, B0); PG8_BAR; PG8_SCHED;
            PG8_LDB(B1, 0, 1); PG8_STAGE(PG8_SB(0, 0), b2, voffB);
            PG8_BAR; PG8_WAIT_L(0); PG8_MMA(0, 1, At, B1); PG8_BAR;
            PG8_LDA(At, 0, 1); PG8_STAGE(PG8_SA(0, 0), a2, voffA);
            PG8_BAR; PG8_WAIT_L(0); PG8_MMA(1, 0, At, B0); PG8_BAR; PG8_SCHED;
            PG8_STAGE(PG8_SB(0, 1), b2 + hstep, voffB);
            PG8_WAIT_V(6); PG8_BAR; PG8_MMA(1, 1, At, B1); PG8_BAR;
            PG8_LDB(B0, 1, 0); PG8_SCHED; PG8_LDA(At, 1, 0); PG8_STAGE(PG8_SA(0, 1), a2 + hstep, voffA);
            PG8_WAIT_L(8); PG8_BAR; PG8_WAIT_L(0); PG8_MMA(0, 0, At, B0); PG8_BAR; PG8_SCHED;
            PG8_LDB(B1, 1, 1); PG8_STAGE(PG8_SB(1, 0), b3, voffB);
            PG8_BAR; PG8_WAIT_L(0); PG8_MMA(0, 1, At, B1); PG8_BAR;
            PG8_LDA(At, 1, 1); PG8_STAGE(PG8_SA(1, 0), a3, voffA);
            PG8_BAR; PG8_WAIT_L(0); PG8_MMA(1, 0, At, B0); PG8_BAR; PG8_SCHED;
            PG8_STAGE(PG8_SB(1, 1), b3 + hstep, voffB);
            PG8_WAIT_V(6); PG8_BAR; PG8_MMA(1, 1, At, B1); PG8_BAR;
        }
        PG8_STAMP();
        if constexpr (!Epi::AFTER_DRAIN) { E(acc, cur, wr, wc, fr, fq); S.done(cur); }
        PG8_STAMP();
        if (!has_next) break;
#pragma unroll
        for (int a = 0; a < 2; ++a)
#pragma unroll
            for (int b = 0; b < 2; ++b)
#pragma unroll
                for (int m = 0; m < 4; ++m)
#pragma unroll
                    for (int n = 0; n < 2; ++n) acc[a][b][m][n] = (f32x4){0.f, 0.f, 0.f, 0.f};
        cur = nxt; cA = nA; cB = nB; ++ui;
    }
    PG8_WAIT_V(0);
    if (wr == 0) PG8_BAR;
    PG8_BAR;
    if constexpr (Epi::AFTER_DRAIN) { E.fused(acc, cur, wr, wc, fr, fq, lds, wid, lane); S.done(cur); }
    PG8_STAMP();
    if (STAMP && wid == 0) { stamps[lane] = lane < nts ? (((unsigned long long)(unsigned)ts_hi << 32) | (unsigned)ts_lo) : 0ull;
        if (lane == 62) stamps[62] = rt_entry; if (lane == 63) stamps[63] = (unsigned long long)wall_clock64(); }
#undef PG8_STAMP
#undef PG8_SA
#undef PG8_SB
#undef PG8_STAGE
#undef PG8_LDA
#undef PG8_LDB
#undef PG8_MMA
#undef PG8_WAIT_V
#undef PG8_WAIT_L
#undef PG8_BAR
#undef PG8_SCHED
}
}

struct Epi1 {
  static constexpr bool PERM = true, AFTER_DRAIN = false;
  unsigned char* ws; u16* mg; const float* b_gate; bool dup;
  DI void operator()(const pg8::f32x4 (&acc)[2][2][4][2], const pg8::Unit& u, int wr, int wc, int fr, int fq) const {
    const int pn = u.pn;
    const int rowb = u.pm * 256 + wr * 64 + fr;
    const int colu = wc * 32 + 8 * fq;
    if (pn < 4) {
      u16* dst = (pn < 3) ? (u16*)(ws + OFF_CQ) + pn * 256 : (u16*)(ws + OFF_CKV);
      const int ld = (pn < 3) ? 768 : 256;
      float* ssq = (float*)(ws + OFF_SSQ) + ((pn < 3) ? 0 : T);
#pragma unroll
      for (int ai = 0; ai < 2; ++ai)
#pragma unroll
        for (int m = 0; m < 4; ++m) {
          const int row = rowb + ai * 128 + m * 16;
          float ss = 0.f;
#pragma unroll
          for (int bj = 0; bj < 2; ++bj) {
            const pg8::f32x4 v0 = acc[ai][bj][m][0], v1 = acc[ai][bj][m][1];
            ss += v0[0] * v0[0] + v0[1] * v0[1] + v0[2] * v0[2] + v0[3] * v0[3] + v1[0] * v1[0] + v1[1] * v1[1] + v1[2] * v1[2] + v1[3] * v1[3];
            u4v o; o.x = pk2(v0[0], v0[1]); o.y = pk2(v0[2], v0[3]); o.z = pk2(v1[0], v1[1]); o.w = pk2(v1[2], v1[3]);
            *(u4v*)(dst + (size_t)row * ld + bj * 128 + colu) = o;
          }
          ss = xor16_add(ss); ss = xor32_add(ss);
          if (fq == 0 && !dup) atomicAdd(ssq + row, ss);
        }
    } else if (pn < 8) {
      u16* dst = (u16*)(ws + ((pn < 6) ? OFF_SGA : OFF_SGB)) + (pn & 1) * 256;
#pragma unroll
      for (int ai = 0; ai < 2; ++ai)
#pragma unroll
        for (int m = 0; m < 4; ++m) {
          const int row = rowb + ai * 128 + m * 16;
#pragma unroll
          for (int bj = 0; bj < 2; ++bj) {
            const pg8::f32x4 v0 = acc[ai][bj][m][0], v1 = acc[ai][bj][m][1];
            u4v o; o.x = pk2(siluf_(v0[0]), siluf_(v0[1])); o.y = pk2(siluf_(v0[2]), siluf_(v0[3]));
            o.z = pk2(siluf_(v1[0]), siluf_(v1[1])); o.w = pk2(siluf_(v1[2]), siluf_(v1[3]));
            *(u4v*)(dst + (size_t)row * 512 + bj * 128 + colu) = o;
          }
        }
    } else if (pn >= 16) {
      if (pn < 22) {
        u16* dst = (u16*)(ws + ((pn < 18) ? OFF_HQ : (pn < 20) ? OFF_HF : OFF_HI)) + (pn & 1) * 256;
#pragma unroll
        for (int ai = 0; ai < 2; ++ai)
#pragma unroll
          for (int m = 0; m < 4; ++m) {
            const int row = rowb + ai * 128 + m * 16;
#pragma unroll
            for (int bj = 0; bj < 2; ++bj) {
              const pg8::f32x4 v0 = acc[ai][bj][m][0], v1 = acc[ai][bj][m][1];
              u4v o; o.x = pk2(v0[0], v0[1]); o.y = pk2(v0[2], v0[3]); o.z = pk2(v1[0], v1[1]); o.w = pk2(v1[2], v1[3]);
              *(u4v*)(dst + (size_t)row * 512 + bj * 128 + colu) = o;
            }
          }
      } else if (colu < 32) {
        float* dst = (float*)(ws + OFF_KPE);
#pragma unroll
        for (int ai = 0; ai < 2; ++ai)
#pragma unroll
          for (int m = 0; m < 4; ++m) {
            const int row = rowb + ai * 128 + m * 16;
            *(pg8::f32x4*)(dst + (size_t)row * 32 + colu) = acc[ai][0][m][0];
            *(pg8::f32x4*)(dst + (size_t)row * 32 + colu + 4) = acc[ai][0][m][1];
          }
      }
    } else {
      const int cb = (pn - 8) * 256 + colu;
      f4v b0[2], b1[2];
#pragma unroll
      for (int bj = 0; bj < 2; ++bj) { b0[bj] = *(const f4v*)(b_gate + cb + bj * 128); b1[bj] = *(const f4v*)(b_gate + cb + bj * 128 + 4); }
#pragma unroll
      for (int ai = 0; ai < 2; ++ai)
#pragma unroll
        for (int m = 0; m < 4; ++m) {
          const int row = rowb + ai * 128 + m * 16;
#pragma unroll
          for (int bj = 0; bj < 2; ++bj) {
            const pg8::f32x4 v0 = acc[ai][bj][m][0], v1 = acc[ai][bj][m][1];
            u4v o; o.x = pk2(sigmoidf_(v0[0] + b0[bj].x), sigmoidf_(v0[1] + b0[bj].y)); o.y = pk2(sigmoidf_(v0[2] + b0[bj].z), sigmoidf_(v0[3] + b0[bj].w));
            o.z = pk2(sigmoidf_(v1[0] + b1[bj].x), sigmoidf_(v1[1] + b1[bj].y)); o.w = pk2(sigmoidf_(v1[2] + b1[bj].z), sigmoidf_(v1[3] + b1[bj].w));
            *(u4v*)(mg + ((((size_t)(u.pm * 8 + (pn - 8)) * 8 + (wr * 4 + wc)) * 16 + (ai * 8 + m * 2 + bj)) * 64 + (fq * 16 + fr)) * 8) = o;
          }
        }
    }
  }
};


struct Epi6 {
  static constexpr bool PERM = true, AFTER_DRAIN = false;
  u16* out; float* ssq; bool dup;
  DI void operator()(const pg8::f32x4 (&acc)[2][2][4][2], const pg8::Unit& u, int wr, int wc, int fr, int fq) const {
    const int rowb = u.pm * 256 + wr * 64 + fr;
    const int colb = u.pn * 256 + wc * 32 + 8 * fq;
#pragma unroll
    for (int ai = 0; ai < 2; ++ai)
#pragma unroll
      for (int m = 0; m < 4; ++m) {
        const int row = rowb + ai * 128 + m * 16;
        float ss = 0.f;
#pragma unroll
        for (int bj = 0; bj < 2; ++bj) {
          const pg8::f32x4 v0 = acc[ai][bj][m][0], v1 = acc[ai][bj][m][1];
          ss += v0[0] * v0[0] + v0[1] * v0[1] + v0[2] * v0[2] + v0[3] * v0[3] + v1[0] * v1[0] + v1[1] * v1[1] + v1[2] * v1[2] + v1[3] * v1[3];
          u4v o; o.x = pk2(v0[0], v0[1]); o.y = pk2(v0[2], v0[3]); o.z = pk2(v1[0], v1[1]); o.w = pk2(v1[2], v1[3]);
          *(u4v*)(out + (size_t)row * 1024 + colb + bj * 128) = o;
        }
        ss = xor16_add(ss); ss = xor32_add(ss);
        if (fq == 0 && !dup) atomicAdd(ssq + row, ss);
      }
  }
};
template <bool SECOND> struct Epi5 {
  static constexpr bool PERM = true, AFTER_DRAIN = false;
  const u16* mg; u16* mi; u16* mo;
  DI void operator()(const pg8::f32x4 (&acc)[2][2][4][2], const pg8::Unit& u, int wr, int wc, int fr, int fq) const {
    const int rowb = u.pm * 256 + wr * 64 + fr;
    const int colb = u.pn * 256 + wc * 32 + 8 * fq;
    const size_t gbase = (((size_t)(u.pm * 8 + u.pn + (SECOND ? 4 : 0)) * 8 + (wr * 4 + wc)) * 16) * 64 + (fq * 16 + fr);
    const size_t ibase = (((size_t)(u.pm * 4 + u.pn) * 8 + (wr * 4 + wc)) * 16) * 64 + (fq * 16 + fr);
#pragma unroll
    for (int hb = 0; hb < 4; ++hb) {
      const int ai = hb >> 1, m0 = (hb & 1) * 2;
      u4v g[4], pm[4];
#pragma unroll
      for (int f4 = 0; f4 < 4; ++f4) {
        const int f = ai * 8 + (m0 + (f4 >> 1)) * 2 + (f4 & 1);
        g[f4] = *(const u4v*)(mg + (gbase + (size_t)f * 64) * 8);
        if (SECOND) pm[f4] = *(const u4v*)(mi + (ibase + (size_t)f * 64) * 8);
      }
#pragma unroll
      for (int f4 = 0; f4 < 4; ++f4) {
        const int m = m0 + (f4 >> 1), bj = f4 & 1;
        const int row = rowb + ai * 128 + m * 16;
        const pg8::f32x4 v0 = acc[ai][bj][m][0], v1 = acc[ai][bj][m][1];
        float r0 = v0[0] * bflo(g[f4].x), r1 = v0[1] * bfhi(g[f4].x), r2 = v0[2] * bflo(g[f4].y), r3 = v0[3] * bfhi(g[f4].y);
        float r4 = v1[0] * bflo(g[f4].z), r5 = v1[1] * bfhi(g[f4].z), r6 = v1[2] * bflo(g[f4].w), r7 = v1[3] * bfhi(g[f4].w);
        if (SECOND) {
          r0 += bflo(pm[f4].x); r1 += bfhi(pm[f4].x); r2 += bflo(pm[f4].y); r3 += bfhi(pm[f4].y);
          r4 += bflo(pm[f4].z); r5 += bfhi(pm[f4].z); r6 += bflo(pm[f4].w); r7 += bfhi(pm[f4].w);
        }
        u4v o; o.x = pk2(r0, r1); o.y = pk2(r2, r3); o.z = pk2(r4, r5); o.w = pk2(r6, r7);
        if (SECOND) *(u4v*)(mo + (size_t)row * 1024 + colb + bj * 128) = o;
        else *(u4v*)(mi + (ibase + (size_t)(ai * 8 + m * 2 + bj) * 64) * 8) = o;
      }
      __builtin_amdgcn_sched_barrier(0);
    }
  }
};
struct EpiQ {
  static constexpr bool PERM = true, AFTER_DRAIN = false;
  const float* ssq_q; const float* rope; u16* Qo;
  DI void operator()(const pg8::f32x4 (&acc)[2][2][4][2], const pg8::Unit& u, int wr, int wc, int fr, int fq) const {
    const int rowb = u.pm * 256 + wr * 64 + fr;
    const int colu = wc * 32 + 8 * fq;
    float sq[8];
#pragma unroll
    for (int i = 0; i < 8; ++i) sq[i] = ssq_q[rowb + (i >> 2) * 128 + (i & 3) * 16];
    if (u.pn < 2) {
#pragma unroll
      for (int ai = 0; ai < 2; ++ai)
#pragma unroll
        for (int m = 0; m < 4; ++m) {
          const int row = rowb + ai * 128 + m * 16;
          const int b = row >> 12, spos = row & 4095;
          const float sc = rsqrtf(sq[ai * 4 + m] * (1.f / 768.f) + EPS) * QSCALE;
#pragma unroll
          for (int bj = 0; bj < 2; ++bj) {
            const pg8::f32x4 v0 = acc[ai][bj][m][0], v1 = acc[ai][bj][m][1];
            const int head = u.pn * 4 + bj * 2 + (colu >> 6), d = colu & 63;
            u4v o; o.x = pk2(v0[0] * sc, v0[1] * sc); o.y = pk2(v0[2] * sc, v0[3] * sc); o.z = pk2(v1[0] * sc, v1[1] * sc); o.w = pk2(v1[2] * sc, v1[3] * sc);
            *(u4v*)(Qo + ((size_t)(b * 8 + head) * 4096 + spos) * 96 + d) = o;
          }
        }
    } else {
#pragma unroll
      for (int ai = 0; ai < 2; ++ai) {
        f4v cs[4], sn[4];
#pragma unroll
        for (int i = 0; i < 4; ++i) {
          const int spos = (rowb + ai * 128 + i * 16) & 4095;
          cs[i] = *(const f4v*)(rope + spos * 16 + 4 * fq); sn[i] = *(const f4v*)(rope + 65536 + spos * 16 + 4 * fq);
        }
#pragma unroll
        for (int m = 0; m < 4; ++m) {
          const int row = rowb + ai * 128 + m * 16;
          const int b = row >> 12, spos = row & 4095;
          const float sc = rsqrtf(sq[ai * 4 + m] * (1.f / 768.f) + EPS) * QSCALE;
          const f4v c4 = cs[m], s4 = sn[m];
#pragma unroll
          for (int bj = 0; bj < 2; ++bj) {
            const pg8::f32x4 v0 = acc[ai][bj][m][0], v1 = acc[ai][bj][m][1];
            const int head = bj * 4 + wc;
            u2v o1, o2;
            o1.x = pk2((v0[0] * c4.x - v1[0] * s4.x) * sc, (v0[1] * c4.y - v1[1] * s4.y) * sc);
            o1.y = pk2((v0[2] * c4.z - v1[2] * s4.z) * sc, (v0[3] * c4.w - v1[3] * s4.w) * sc);
            o2.x = pk2((v0[0] * s4.x + v1[0] * c4.x) * sc, (v0[1] * s4.y + v1[1] * c4.y) * sc);
            o2.y = pk2((v0[2] * s4.z + v1[2] * c4.z) * sc, (v0[3] * s4.w + v1[3] * c4.w) * sc);
            u16* qp = Qo + ((size_t)(b * 8 + head) * 4096 + spos) * 96 + 64 + 4 * fq;
            *(u2v*)qp = o1; *(u2v*)(qp + 16) = o2;
          }
        }
        __builtin_amdgcn_sched_barrier(0);
      }
    }
  }
};

struct EpiK {
  static constexpr bool PERM = true, AFTER_DRAIN = false;
  const float* ssq_kv; u16* Ko;
  DI void operator()(const pg8::f32x4 (&acc)[2][2][4][2], const pg8::Unit& u, int wr, int wc, int fr, int fq) const {
    const int rowb = u.pm * 256 + wr * 64 + fr;
    float sq[8];
#pragma unroll
    for (int i = 0; i < 8; ++i) sq[i] = ssq_kv[rowb + (i >> 2) * 128 + (i & 3) * 16];
#pragma unroll
    for (int ai = 0; ai < 2; ++ai)
#pragma unroll
      for (int m = 0; m < 4; ++m) {
        const int row = rowb + ai * 128 + m * 16;
        const int b = row >> 12, spos = row & 4095;
        const float sc = rsqrtf(sq[ai * 4 + m] * (1.f / 256.f) + EPS);
#pragma unroll
        for (int bj = 0; bj < 2; ++bj) {
          const pg8::f32x4 v0 = acc[ai][bj][m][0], v1 = acc[ai][bj][m][1];
          const int col = u.pn * 256 + bj * 128 + wc * 32 + 8 * fq;
          const int head = col >> 6, d = col & 63;
          u4v o; o.x = pk2(v0[0] * sc, v0[1] * sc); o.y = pk2(v0[2] * sc, v0[3] * sc); o.z = pk2(v1[0] * sc, v1[1] * sc); o.w = pk2(v1[2] * sc, v1[3] * sc);
          *(u4v*)(Ko + ((size_t)(b * 8 + head) * 4096 + spos) * 96 + d) = o;
        }
      }
  }
};
struct EpiV {
  static constexpr bool PERM = false, AFTER_DRAIN = false;
  const float* ssq_kv; u16* Vo;
  DI void operator()(const pg8::f32x4 (&acc)[2][2][4][2], const pg8::Unit& u, int wr, int wc, int fr, int fq) const {
    f4v sq[8];
#pragma unroll
    for (int i = 0; i < 8; ++i) sq[i] = *(const f4v*)(ssq_kv + u.pm * 256 + (i >> 2) * 128 + wr * 64 + (i & 3) * 16 + 4 * fq);
#pragma unroll
    for (int ai = 0; ai < 2; ++ai)
#pragma unroll
      for (int m = 0; m < 4; ++m) {
        const int row4 = u.pm * 256 + ai * 128 + wr * 64 + m * 16 + 4 * fq;
        const int b = row4 >> 12, spos = row4 & 4095;
        const f4v q = sq[ai * 4 + m];
        const float s0 = rsqrtf(q.x * (1.f / 256.f) + EPS), s1 = rsqrtf(q.y * (1.f / 256.f) + EPS), s2 = rsqrtf(q.z * (1.f / 256.f) + EPS), s3 = rsqrtf(q.w * (1.f / 256.f) + EPS);
#pragma unroll
        for (int bj = 0; bj < 2; ++bj)
#pragma unroll
          for (int n = 0; n < 2; ++n) {
            const pg8::f32x4 v = acc[ai][bj][m][n];
            const int col = u.pn * 256 + bj * 128 + wc * 32 + n * 16 + fr;
            const int head = col >> 6, dv = col & 63;
            u2v o; o.x = pk2(v[0] * s0, v[1] * s1); o.y = pk2(v[2] * s2, v[3] * s3);
            *(u2v*)(Vo + ((size_t)(b * 8 + head) * 64 + dv) * 4096 + spos) = o;
          }
        __builtin_amdgcn_sched_barrier(0);
      }
  }
};
DI void phase1(const Params& p, unsigned char* smem, bool dup = false) {
  unsigned char* ws = p.ws;
  pg8::Gemm g{(const u16*)(ws + OFF_H), (const u16*)(ws + OFF_WIN), T, NP, 1024};
  pg8::StaticOrder S; S.init(T, NP, (int)gridDim.x, (int)blockIdx.x);
  Epi1 E{ws, (u16*)p.out, p.b_gate, dup};
  pg8::gemm_phase<Epi1, pg8::StaticOrder, false>((PG8_LAS unsigned char*)smem, g, S, E, nullptr);
  const int nlight = (int)gridDim.x / 2;
  if (!dup && (int)blockIdx.x >= (int)gridDim.x - nlight) {
    const int gtid = ((int)blockIdx.x - ((int)gridDim.x - nlight)) * (int)blockDim.x + (int)threadIdx.x, gthreads = nlight * (int)blockDim.x;
    conv_weight<1>((u16*)(ws + OFF_WUQ), p.w_uq, 768, 768, 768, p.g_q, 1023, gtid, gthreads);
    conv_weight<3>((u16*)(ws + OFF_WUKV), p.w_ukv, 1024, 1024, 256, p.g_kv, 255, gtid, gthreads);
    conv_weight<2>((u16*)(ws + OFF_WA), p.w_a, 1024, 1024, 512, nullptr, 0, gtid, gthreads);
    conv_weight<2>((u16*)(ws + OFF_WB), p.w_b, 1024, 1024, 512, p.g_hgrn, 63, gtid, gthreads);
    conv_weight<2>((u16*)(ws + OFF_WO), p.w_out, 1024, 1024, 1024, nullptr, 0, gtid, gthreads);
  }
}

DI void hgrn_prep_tile(const Params& p, float* stage, int tid, int b, int hh, int prow0, int nblk0) {
  unsigned char* ws = p.ws;
  const int bh = b * 8 + hh;
  if (tid < 128) {
    const int c = tid & 63, blk = tid >> 6;
    const float l0 = p.lb_logits[hh * 64 + c], l1 = p.lb_logits[512 + hh * 64 + c];
    const float lbv = 1.f / (1.f + expf(l1 - l0));
    float cum = 0.f;
    for (int rr = 0; rr < 32; ++rr) {
      float* sp = stage + (blk * 32 + rr) * SST + c;
      const float q = sp[0], hf = sp[64];
      const float sg = 1.f / (1.f + expf(-hf));
      const float f = lbv + (1.f - lbv) * sg;
      cum += logf(f);
      const float e = expf(cum);
      sp[0] = q * e;
      sp[64] = (1.f - f) / e;
    }
    ((float*)(ws + OFF_DECAY))[((size_t)bh * 128 + nblk0 + blk) * 64 + c] = expf(cum);
  }
  __syncthreads();
#pragma unroll
  for (int it = 0; it < 2; ++it) {
    const int item = tid + 256 * it, rr = item >> 3, cc = (item & 7) * 8;
    const f4v a = *(const f4v*)(stage + rr * SST + cc), c = *(const f4v*)(stage + rr * SST + cc + 4);
    const f4v d = *(const f4v*)(stage + rr * SST + 64 + cc), e = *(const f4v*)(stage + rr * SST + 64 + cc + 4);
    const size_t o = (size_t)(prow0 + rr) * 512 + hh * 64 + cc;
    *(u4v*)((u16*)(ws + OFF_QDEC) + o) = pk8(a, c);
    *(u4v*)((u16*)(ws + OFF_KINV) + o) = pk8(d, e);
  }
}
DI void hi_vt_tile(const Params& p, float* stage, int tid, int b, int q2, int nblk0) {
  unsigned char* ws = p.ws;
#pragma unroll
        for (int it = 0; it < 4; ++it) {
          const int item = tid + 256 * it, sc = item & 3, col = (item >> 2) & 127, blk = item >> 9;
          float v[8];
#pragma unroll
          for (int i = 0; i < 8; ++i) v[i] = stage[(blk * 32 + sc * 8 + i) * SST + col];
          u4v o; o.x = pk2(v[0], v[1]); o.y = pk2(v[2], v[3]); o.z = pk2(v[4], v[5]); o.w = pk2(v[6], v[7]);
          const int bh = b * 8 + q2 * 2 + (col >> 6);
          *(u4v*)((u16*)(ws + OFF_VT) + (((size_t)bh * 128 + nblk0 + blk) * 64 + (col & 63)) * 32 + sc * 8) = o;
        }
}
DI void stage_load64(float* stage, const u16* src, int coff, int tid) {
#pragma unroll
  for (int it = 0; it < 2; ++it) {
    const int item = tid + 256 * it, rr = item >> 3, ch = item & 7;
    const u4v v = *(const u4v*)(src + (size_t)rr * 512 + ch * 8);
    float* d = stage + rr * SST + coff + ch * 8;
    *(f4v*)d = f4v{bflo(v.x), bfhi(v.x), bflo(v.y), bfhi(v.y)};
    *(f4v*)(d + 4) = f4v{bflo(v.z), bfhi(v.z), bflo(v.w), bfhi(v.w)};
  }
}


constexpr int PST = 68;
DI void hgrn_prep_native(const Params& p, float* pl, int rb, int hh) {
  unsigned char* ws = p.ws;
  const int tid = threadIdx.x;
  float* Qp = pl; float* G = pl + 128 * PST; float* Kn = pl + 2 * 128 * PST;
  const int prow0 = rb * 128, b = prow0 >> 12, bh = b * 8 + hh, nblk0 = (prow0 & 4095) >> 5;
  const int ch = tid & 7;
  float lbv[8];
  {
    const f4v a0 = *(const f4v*)(p.lb_logits + hh * 64 + ch * 8), a1 = *(const f4v*)(p.lb_logits + hh * 64 + ch * 8 + 4);
    const f4v b0 = *(const f4v*)(p.lb_logits + 512 + hh * 64 + ch * 8), b1 = *(const f4v*)(p.lb_logits + 512 + hh * 64 + ch * 8 + 4);
    const float l0[8] = {a0.x, a0.y, a0.z, a0.w, a1.x, a1.y, a1.z, a1.w}, l1[8] = {b0.x, b0.y, b0.z, b0.w, b1.x, b1.y, b1.z, b1.w};
#pragma unroll
    for (int i = 0; i < 8; ++i) lbv[i] = 1.f / (1.f + expf(l1[i] - l0[i]));
  }
  __syncthreads();
#pragma unroll
  for (int it = 0; it < 2; ++it) {
    const int rr = (tid + 512 * it) >> 3;
    const size_t go = (size_t)(prow0 + rr) * 512 + hh * 64 + ch * 8;
    const u4v qv = *(const u4v*)((const u16*)(ws + OFF_HQ) + go), fv = *(const u4v*)((const u16*)(ws + OFF_HF) + go);
    const float q[8] = {bflo(qv.x), bfhi(qv.x), bflo(qv.y), bfhi(qv.y), bflo(qv.z), bfhi(qv.z), bflo(qv.w), bfhi(qv.w)};
    const float hf[8] = {bflo(fv.x), bfhi(fv.x), bflo(fv.y), bfhi(fv.y), bflo(fv.z), bfhi(fv.z), bflo(fv.w), bfhi(fv.w)};
    float g[8], kn[8];
#pragma unroll
    for (int i = 0; i < 8; ++i) {
      const float sg = rcpf(1.f + __builtin_amdgcn_exp2f(-1.4426950408889634f * hf[i]));
      const float f = lbv[i] + (1.f - lbv[i]) * sg;
      g[i] = __builtin_amdgcn_logf(f);
      kn[i] = 1.f - f;
    }
    float* d = Qp + rr * PST + ch * 8;
    *(f4v*)d = f4v{q[0], q[1], q[2], q[3]}; *(f4v*)(d + 4) = f4v{q[4], q[5], q[6], q[7]};
    d = G + rr * PST + ch * 8;
    *(f4v*)d = f4v{g[0], g[1], g[2], g[3]}; *(f4v*)(d + 4) = f4v{g[4], g[5], g[6], g[7]};
    d = Kn + rr * PST + ch * 8;
    *(f4v*)d = f4v{kn[0], kn[1], kn[2], kn[3]}; *(f4v*)(d + 4) = f4v{kn[4], kn[5], kn[6], kn[7]};
  }
  __syncthreads();
  if (tid < 256) {
    const int c = tid & 63, blk = tid >> 6;
    float* gp = G + (blk * 32) * PST + c;
    float v[32];
#pragma unroll
    for (int r2 = 0; r2 < 32; ++r2) v[r2] = gp[r2 * PST];
    float cum = 0.f;
#pragma unroll
    for (int r2 = 0; r2 < 32; ++r2) { cum += v[r2]; gp[r2 * PST] = cum; }
    ((float*)(ws + OFF_DECAY))[((size_t)bh * 128 + nblk0 + blk) * 64 + c] = __builtin_amdgcn_exp2f(cum);
  }
  __syncthreads();
#pragma unroll
  for (int it = 0; it < 2; ++it) {
    const int rr = (tid + 512 * it) >> 3;
    const float* s0 = Qp + rr * PST + ch * 8; const float* s1 = G + rr * PST + ch * 8; const float* s2 = Kn + rr * PST + ch * 8;
    const f4v q0 = *(const f4v*)s0, q1 = *(const f4v*)(s0 + 4), c0 = *(const f4v*)s1, c1 = *(const f4v*)(s1 + 4), k0 = *(const f4v*)s2, k1 = *(const f4v*)(s2 + 4);
    const float q[8] = {q0.x, q0.y, q0.z, q0.w, q1.x, q1.y, q1.z, q1.w}, cm[8] = {c0.x, c0.y, c0.z, c0.w, c1.x, c1.y, c1.z, c1.w}, kn[8] = {k0.x, k0.y, k0.z, k0.w, k1.x, k1.y, k1.z, k1.w};
    float qd[8], ki[8];
#pragma unroll
    for (int i = 0; i < 8; ++i) { qd[i] = q[i] * __builtin_amdgcn_exp2f(cm[i]); ki[i] = kn[i] * __builtin_amdgcn_exp2f(-cm[i]); }
    const size_t go = (size_t)(prow0 + rr) * 512 + hh * 64 + ch * 8;
    u4v o; o.x = pk2(qd[0], qd[1]); o.y = pk2(qd[2], qd[3]); o.z = pk2(qd[4], qd[5]); o.w = pk2(qd[6], qd[7]);
    *(u4v*)((u16*)(ws + OFF_QDEC) + go) = o;
    o.x = pk2(ki[0], ki[1]); o.y = pk2(ki[2], ki[3]); o.z = pk2(ki[4], ki[5]); o.w = pk2(ki[6], ki[7]);
    *(u4v*)((u16*)(ws + OFF_KINV) + go) = o;
  }
}
constexpr int VTS = 136;
DI void hi_vt_native(const Params& p, u16* img, int rb, int q2) {
  unsigned char* ws = p.ws;
  const int tid = threadIdx.x;
  const int prow0 = rb * 128, b = prow0 >> 12, nblk0 = (prow0 & 4095) >> 5;
  __syncthreads();
#pragma unroll
  for (int it = 0; it < 4; ++it) {
    const int item = tid + 512 * it, rr = item >> 4, c16 = item & 15;
    *(u4v*)(img + rr * VTS + c16 * 8) = *(const u4v*)((const u16*)(ws + OFF_HI) + (size_t)(prow0 + rr) * 512 + q2 * 128 + c16 * 8);
  }
  __syncthreads();
#pragma unroll
  for (int it = 0; it < 4; ++it) {
    const int item = tid + 512 * it, sc = item & 3, col = (item >> 2) & 127, blk = item >> 9;
    u32 w[4];
#pragma unroll
    for (int i = 0; i < 4; ++i) {
      const u32 lo = img[(blk * 32 + sc * 8 + 2 * i) * VTS + col], hi = img[(blk * 32 + sc * 8 + 2 * i + 1) * VTS + col];
      w[i] = lo | (hi << 16);
    }
    const int bh = b * 8 + q2 * 2 + (col >> 6);
    *(u4v*)((u16*)(ws + OFF_VT) + (((size_t)bh * 128 + nblk0 + blk) * 64 + (col & 63)) * 32 + sc * 8) = u4v{w[0], w[1], w[2], w[3]};
  }
}

DI void rope8(const float* x1, const float* x2, const float* rope, int spos, int j0, bool first, float scale, float (&o)[8]) {
  const f4v c0 = *(const f4v*)(rope + spos * 16 + j0), c1 = *(const f4v*)(rope + spos * 16 + j0 + 4);
  const f4v s0 = *(const f4v*)(rope + 65536 + spos * 16 + j0), s1 = *(const f4v*)(rope + 65536 + spos * 16 + j0 + 4);
  const float cs[8] = {c0.x, c0.y, c0.z, c0.w, c1.x, c1.y, c1.z, c1.w};
  const float sn[8] = {s0.x, s0.y, s0.z, s0.w, s1.x, s1.y, s1.z, s1.w};
#pragma unroll
  for (int i = 0; i < 8; ++i) o[i] = scale * (first ? (x1[i] * cs[i] - x2[i] * sn[i]) : (x1[i] * sn[i] + x2[i] * cs[i]));
}

DI void phase2(const Params& p, unsigned char* smem, u16* lds) {
  unsigned char* ws = p.ws;
  const int tid = VTID;
  float* stage = (float*)lds;
  const float* ssq_q = (const float*)(ws + OFF_SSQ);
  const float* ssq_kv = ssq_q + T;
  const float* rope = (const float*)(ws + OFF_ROPE);
  u16* Qo = (u16*)(ws + OFF_Q);
  u16* Ko = (u16*)(ws + OFF_K);
  u16* Vo = (u16*)(ws + OFF_VTT);
#pragma nounroll
  for (int rep = 0; rep < (DUP_PH == 21 ? p.ph_hi - 7 : 1); ++rep) {
    pg8::Gemm g{(const u16*)(ws + OFF_CQ), (const u16*)(ws + OFF_WUQ), T, 768, 768};
    pg8::StaticOrder S; S.init(T, 768, (int)gridDim.x, (int)blockIdx.x);
    EpiQ E{ssq_q, rope, Qo};
    pg8::gemm_phase<EpiQ, pg8::StaticOrder, false>((PG8_LAS unsigned char*)smem, g, S, E, nullptr);
  }
#pragma nounroll
  for (int rep = 0; rep < (DUP_PH == 23 ? p.ph_hi - 7 : 1); ++rep) {
    pg8::StaticOrder S; S.init(T, 512, (int)gridDim.x, (int)blockIdx.x);
    {
      int kk = 256; asm volatile("" : "+s"(kk));
      pg8::Gemm g{(const u16*)(ws + OFF_CKV), (const u16*)(ws + OFF_WUKV), T, 512, kk};
      EpiK E{ssq_kv, Ko};
      pg8::gemm_phase<EpiK, pg8::StaticOrder, false>((PG8_LAS unsigned char*)smem, g, S, E, nullptr);
    }
  }
#pragma nounroll
  for (int rep = 0; rep < (DUP_PH == 22 ? p.ph_hi - 7 : 1); ++rep) {
    const int gtid = blockIdx.x * blockDim.x + threadIdx.x, gthreads = gridDim.x * blockDim.x;
    for (int idx = gtid; idx < T * 4; idx += gthreads) {
      const int tok = idx >> 2, wv = (idx & 3) * 8, j0 = wv & 15;
      const int b = tok >> 12, spos = tok & 4095;
      const float* kp = (const float*)(ws + OFF_KPE) + (size_t)tok * 32;
      const f4v a0 = *(const f4v*)(kp + j0), a1 = *(const f4v*)(kp + j0 + 4);
      const f4v b0 = *(const f4v*)(kp + 16 + j0), b1 = *(const f4v*)(kp + 16 + j0 + 4);
      const float x1[8] = {a0.x, a0.y, a0.z, a0.w, a1.x, a1.y, a1.z, a1.w};
      const float x2[8] = {b0.x, b0.y, b0.z, b0.w, b1.x, b1.y, b1.z, b1.w};
      float o[8];
      rope8(x1, x2, rope, spos, j0, wv < 16, 1.f, o);
      u4v ov; ov.x = pk2(o[0], o[1]); ov.y = pk2(o[2], o[3]); ov.z = pk2(o[4], o[5]); ov.w = pk2(o[6], o[7]);
#pragma unroll
      for (int head = 0; head < 8; ++head) *(u4v*)(Ko + ((size_t)(b * 8 + head) * 4096 + spos) * 96 + 64 + wv) = ov;
    }
  }
  for (int rep = 0; rep < (DUP_PH == 20 ? 2 : 1); ++rep)
  {
    const int G = (int)gridDim.x, c = (int)blockIdx.x, hG = G / 2, round = 2 * G + hG;
    for (int base = 0; base < 2048 + 1024; base += round) {
#pragma unroll 1
      for (int k = 0; k < 3; ++k) {
        if (k == 2 && c < G - hG) break;
        const int t = base + (k == 0 ? c : k == 1 ? G + c : 2 * G + (c - (G - hG)));
        if (t >= 2048 + 1024) break;
        if (t < 2048) hgrn_prep_native(p, (float*)smem, t >> 3, t & 7);
        else hi_vt_native(p, (u16*)smem, (t - 2048) >> 2, (t - 2048) & 3);
      }
    }
  }
}

DI void phase2b(const Params& p, unsigned char* smem) {
  unsigned char* ws = p.ws;
  const int tid = VTID;
  {
    pg8::StaticOrder S; S.init(T, 512, (int)gridDim.x, (int)blockIdx.x);
    int kk = 256; asm volatile("" : "+s"(kk));
    pg8::Gemm g{(const u16*)(ws + OFF_CKV), (const u16*)(ws + OFF_WUKV) + (size_t)512 * 256, T, 512, kk};
    EpiV E{(const float*)(ws + OFF_SSQ) + T, (u16*)(ws + OFF_VTT)};
    pg8::gemm_phase<EpiV, pg8::StaticOrder, false, true>((PG8_LAS unsigned char*)smem, g, S, E, nullptr);
  }
  for (int t = VBID; t < 2048; t += VBN) {
    {
      const int idx = t;
      const int bh = idx >> 5, n = (idx & 31) * 4 + (tid >> 6);
      const int lane = tid & 63, r = lane & 31, h = lane >> 5;
      const u16* kn = (const u16*)(ws + OFF_KINV) + ((size_t)(bh >> 3) * 4096 + n * 32) * 512 + (bh & 7) * 64;
      const u16* vt = (const u16*)(ws + OFF_VT) + ((size_t)bh * 128 + n) * 64 * 32;
      bf16x8 a[2][2], bb[2][2];
#pragma unroll
      for (int i = 0; i < 2; ++i)
#pragma unroll
        for (int ks = 0; ks < 2; ++ks) {
          {
            bf16x8 av;
#pragma unroll
            for (int j = 0; j < 8; ++j) av[j] = (short)kn[(size_t)(ks * 16 + h * 8 + j) * 512 + i * 32 + r];
            a[i][ks] = av;
          }
          bb[i][ks] = *(const bf16x8*)(vt + (i * 32 + r) * 32 + ks * 16 + h * 8);
        }
      u16* up = (u16*)(ws + OFF_UPD) + ((size_t)bh * 128 + n) * 4096;
#pragma unroll
      for (int kb = 0; kb < 2; ++kb)
#pragma unroll
        for (int vb = 0; vb < 2; ++vb) {
          f32x16 c = zero16();
          c = MFMA(a[kb][0], bb[vb][0], c);
          c = MFMA(a[kb][1], bb[vb][1], c);
#pragma unroll
          for (int g = 0; g < 4; ++g) {
            u2v o; o.x = pk2(c[4 * g], c[4 * g + 1]); o.y = pk2(c[4 * g + 2], c[4 * g + 3]);
            *(u2v*)(up + (vb * 32 + r) * 64 + kb * 32 + 8 * g + 4 * h) = o;
          }
        }
    }
  }
}

constexpr int KST = 104, VST = 72;
constexpr int ATT_BUF = 64 * KST + 64 * VST;

constexpr int KST2 = 104, VST2 = 132;
constexpr int ATT_BUF2 = 128 * KST2 + 64 * VST2;
DI void att_qk(const u16* sk, const bf16x8 (&qf)[6], float nm, f32x16 (&st)[2]) {
#pragma unroll
  for (int i = 0; i < 16; ++i) { st[0][i] = nm; st[1][i] = nm; }
#pragma unroll
  for (int kb = 0; kb < 2; ++kb)
#pragma unroll
    for (int ks = 0; ks < 6; ++ks) {
      const bf16x8 kf = *(const bf16x8*)(sk + kb * 32 * KST2 + ks * 16);
      st[kb] = MFMA(kf, qf[ks], st[kb]);
    }
}
DI float att_softmax(f32x16 (&st)[2], float adj, bool adjnz, bool first, float& mref, float& l, f32x16 (&o)[2]) {
  float mx = st[0][0];
#pragma unroll
  for (int i = 1; i < 16; ++i) mx = fmaxf(mx, st[0][i]);
#pragma unroll
  for (int i = 0; i < 16; ++i) mx = fmaxf(mx, st[1][i]);
  mx = xor32_max(mx) - adj;
  f2v ps = f2v{0.f, 0.f};
  float shift_out = 0.f;
  if (first || adjnz || __builtin_amdgcn_ballot_w64(mx > 8.f) != 0ull) {
    const float shift = first ? mx : fmaxf(mx, 0.f);
    const float tot = adj + shift;
    const float alpha = first ? 0.f : __builtin_amdgcn_exp2f(-shift);
    mref += shift;
#pragma unroll
    for (int kb = 0; kb < 2; ++kb)
#pragma unroll
      for (int i = 0; i < 16; i += 2) {
        const float p0 = __builtin_amdgcn_exp2f(st[kb][i] - tot), p1 = __builtin_amdgcn_exp2f(st[kb][i + 1] - tot);
        st[kb][i] = p0; st[kb][i + 1] = p1; ps += f2v{p0, p1};
      }
    l = l * alpha + (ps.x + ps.y);
#pragma unroll
    for (int i = 0; i < 16; ++i) { o[0][i] *= alpha; o[1][i] *= alpha; }
    shift_out = shift;
  } else {
#pragma unroll
    for (int kb = 0; kb < 2; ++kb)
#pragma unroll
      for (int i = 0; i < 16; i += 2) {
        const float p0 = __builtin_amdgcn_exp2f(st[kb][i]), p1 = __builtin_amdgcn_exp2f(st[kb][i + 1]);
        st[kb][i] = p0; st[kb][i + 1] = p1; ps += f2v{p0, p1};
      }
    l += ps.x + ps.y;
  }
  return shift_out;
}
DI void att_pv(const u16* sv, const f32x16 (&st)[2], f32x16 (&o)[2]) {
#pragma unroll
  for (int s4 = 0; s4 < 4; ++s4) {
    const int kb = s4 >> 1, rb = 8 * (s4 & 1);
    u4v pu; pu.x = pk2(st[kb][rb], st[kb][rb + 1]); pu.y = pk2(st[kb][rb + 2], st[kb][rb + 3]);
    pu.z = pk2(st[kb][rb + 4], st[kb][rb + 5]); pu.w = pk2(st[kb][rb + 6], st[kb][rb + 7]);
    const bf16x8 pb = __builtin_bit_cast(bf16x8, pu);
#pragma unroll
    for (int db = 0; db < 2; ++db) {
      const s16x4 lo = *(const s16x4*)(sv + db * 32 * VST2 + 16 * s4);
      const s16x4 hi = *(const s16x4*)(sv + db * 32 * VST2 + 16 * s4 + 8);
      const bf16x8 vf = __builtin_shufflevector(lo, hi, 0, 1, 2, 3, 4, 5, 6, 7);
      o[db] = MFMA(vf, pb, o[db]);
    }
  }
}
DI void attn8_item(const Params& p, u16* lds, int bh, int qt) {
  unsigned char* ws = p.ws;
  const int tid = threadIdx.x, lane = tid & 63, w = tid >> 6, r = lane & 31, h = lane >> 5;
  const u16* Qp = (const u16*)(ws + OFF_Q) + (size_t)bh * 4096 * 96;
  const u16* Kp = (const u16*)(ws + OFF_K) + (size_t)bh * 4096 * 96;
  const u16* Vp = (const u16*)(ws + OFF_VTT) + (size_t)bh * 64 * 4096;
  const int q0 = qt * 256 + w * 32;
  bf16x8 qf[6];
#pragma unroll
  for (int ks = 0; ks < 6; ++ks) qf[ks] = *(const bf16x8*)(Qp + (size_t)(q0 + r) * 96 + ks * 16 + h * 8);
  f32x16 o[2]; o[0] = zero16(); o[1] = zero16();
  float mref = 0.f, l = 0.f;
  const int Jmax = 2 * qt + 1, jw = 4 * qt + (w >> 1);
  int kr[3], kc[3];
#pragma unroll
  for (int i = 0; i < 3; ++i) { const int idx = tid + 512 * i; kr[i] = idx / 12; kc[i] = idx % 12; }
  const int vr = tid >> 4, vc = tid & 15;
  u4v rk[3], rv[2];
#pragma unroll
  for (int i = 0; i < 3; ++i) rk[i] = *(const u4v*)(Kp + (size_t)kr[i] * 96 + kc[i] * 8);
#pragma unroll
  for (int i = 0; i < 2; ++i) rv[i] = *(const u4v*)(Vp + (size_t)(vr + 32 * i) * 4096 + vc * 8);
  __syncthreads();
#pragma unroll
  for (int i = 0; i < 3; ++i) *(u4v*)(lds + kr[i] * KST2 + kc[i] * 8) = rk[i];
#pragma unroll
  for (int i = 0; i < 2; ++i) { u16* dv = lds + 128 * KST2 + (vr + 32 * i) * VST2 + vc * 8; *(u2v*)dv = u2v{rv[i].x, rv[i].y}; *(u2v*)(dv + 4) = u2v{rv[i].z, rv[i].w}; }
  __syncthreads();
  for (int J = 0; J <= Jmax; ++J) {
    const int cur = J & 1;
    if (J < Jmax) {
#pragma unroll
      for (int i = 0; i < 3; ++i) rk[i] = *(const u4v*)(Kp + (size_t)((J + 1) * 128 + kr[i]) * 96 + kc[i] * 8);
#pragma unroll
      for (int i = 0; i < 2; ++i) rv[i] = *(const u4v*)(Vp + (size_t)(vr + 32 * i) * 4096 + (J + 1) * 128 + vc * 8);
    }
    const u16* sk = lds + cur * ATT_BUF2 + r * KST2 + h * 8;
    const u16* sv = lds + cur * ATT_BUF2 + 128 * KST2 + r * VST2 + 4 * h;
    if (2 * J + 1 <= jw) {
      f32x16 s0[2], s1[2];
      const float nm = -mref;
      att_qk(sk, qf, nm, s0);
      att_qk(sk + 64 * KST2, qf, nm, s1);
      const float sh = att_softmax(s0, 0.f, false, J == 0, mref, l, o);
      const bool adjnz = __builtin_amdgcn_ballot_w64(sh != 0.f) != 0ull;
      att_pv(sv, s0, o);
      att_softmax(s1, sh, adjnz, false, mref, l, o);
      att_pv(sv + 64, s1, o);
    } else if (2 * J <= jw) {
      f32x16 s0[2];
      att_qk(sk, qf, -mref, s0);
      att_softmax(s0, 0.f, false, J == 0, mref, l, o);
      att_pv(sv, s0, o);
    }
    if (J < Jmax) {
      u16* d = lds + (cur ^ 1) * ATT_BUF2;
#pragma unroll
      for (int i = 0; i < 3; ++i) *(u4v*)(d + kr[i] * KST2 + kc[i] * 8) = rk[i];
#pragma unroll
      for (int i = 0; i < 2; ++i) { u16* dv = d + 128 * KST2 + (vr + 32 * i) * VST2 + vc * 8; *(u2v*)dv = u2v{rv[i].x, rv[i].y}; *(u2v*)(dv + 4) = u2v{rv[i].z, rv[i].w}; }
    }
    __syncthreads();
  }
  l = xor32_add(l);
  const float inv = 1.f / l;
  const int b = bh >> 3, head = bh & 7;
  const size_t tok = (size_t)b * 4096 + q0 + r;
  const u16* sga = (const u16*)(ws + OFF_SGA) + tok * 512 + head * 64;
  u16* ya = (u16*)(ws + OFF_YA) + tok * 512 + head * 64;
#pragma unroll
  for (int db = 0; db < 2; ++db)
#pragma unroll
    for (int g = 0; g < 4; ++g) {
      const int dv0 = db * 32 + 8 * g + 4 * h;
      const u2v gt = *(const u2v*)(sga + dv0);
      u2v ov;
      ov.x = pk2(o[db][4 * g] * inv * bflo(gt.x), o[db][4 * g + 1] * inv * bfhi(gt.x));
      ov.y = pk2(o[db][4 * g + 2] * inv * bflo(gt.y), o[db][4 * g + 3] * inv * bfhi(gt.y));
      *(u2v*)(ya + dv0) = ov;
    }
}

DI void scan_item(const Params& p, int i, size_t out_off = OFF_UPD) {
  unsigned char* ws = p.ws;
  const int tid = threadIdx.x;
  const int bh = i >> 2, part = i & 3;
  const int e = part * 1024 + tid * 2, k = e & 63;
  u32* U = (u32*)((u16*)(ws + OFF_UPD) + (size_t)bh * 128 * 4096 + e);
  u32* UO = (u32*)((u16*)(ws + out_off) + (size_t)bh * 128 * 4096 + e);
  const f2v* Dc = (const f2v*)((const float*)(ws + OFF_DECAY) + (size_t)bh * 128 * 64 + k);
  float s0 = 0.f, s1 = 0.f;
  for (int n0 = 0; n0 < 128; n0 += 32) {
    u32 u[32]; f2v d[32];
#pragma unroll
    for (int q = 0; q < 32; ++q) { u[q] = U[(size_t)(n0 + q) * 2048]; d[q] = Dc[(n0 + q) * 32]; }
#pragma unroll
    for (int q = 0; q < 32; ++q) {
      UO[(size_t)(n0 + q) * 2048] = pk2(s0, s1);
      s0 = d[q].x * (s0 + bflo(u[q]));
      s1 = d[q].y * (s1 + bfhi(u[q]));
    }
  }
}

DI void phase3(const Params& p, unsigned char* smem, bool dup = false) {
  int* s_item = (int*)(smem + LDS_BYTES - 64);
  int* ctr = (int*)(p.ws + OFF_SSQ + (size_t)3 * T * 4) + (dup ? 1 : 0);
  constexpr int NSCAN = 256, NATT = 1024;
  for (;;) {
    __syncthreads();
    if (threadIdx.x == 0) *s_item = atomicAdd(ctr, 1);
    __syncthreads();
    const int item = *s_item;
    if (item >= NSCAN + NATT) break;
    if (item < NSCAN) { if (!dup) scan_item(p, item); }
    else { const int idx = item - NSCAN; attn8_item(p, (u16*)smem, idx & 63, 15 - (idx >> 6)); }
  }
}

DI void phase4(const Params& p) {
  unsigned char* ws = p.ws;
  const int tid = VTID, lane = tid & 63, w = tid >> 6, r = lane & 31, h = lane >> 5;
  for (int t = VBID; t < 2048; t += VBN) {
    const int bh = t >> 5, n = (t & 31) * 4 + w;
    const int b = bh >> 3, head = bh & 7;
    const size_t tok0 = (size_t)b * 4096 + n * 32;
    const u16* qd = (const u16*)(ws + OFF_QDEC) + (tok0 + r) * 512 + head * 64 + h * 8;
    const u16* ki = (const u16*)(ws + OFF_KINV) + (tok0 + r) * 512 + head * 64 + h * 8;
    const u16* vt = (const u16*)(ws + OFF_VT) + ((size_t)bh * 128 + n) * 64 * 32;
    const u16* sp = (const u16*)(ws + OFF_UPD) + ((size_t)bh * 128 + n) * 4096;
    bf16x8 qf[4], kf[4];
#pragma unroll
    for (int ks = 0; ks < 4; ++ks) { qf[ks] = *(const bf16x8*)(qd + ks * 16); kf[ks] = *(const bf16x8*)(ki + ks * 16); }
    f32x16 at = zero16();
#pragma unroll
    for (int ks = 0; ks < 4; ++ks) at = MFMA(kf[ks], qf[ks], at);
#pragma unroll
    for (int i = 0; i < 16; ++i) if (crow(i, h) > r) at[i] = 0.f;
    f32x16 o[2]; o[0] = zero16(); o[1] = zero16();
#pragma unroll
    for (int s2 = 0; s2 < 2; ++s2) {
      u4v pu; pu.x = pk2(at[8 * s2], at[8 * s2 + 1]); pu.y = pk2(at[8 * s2 + 2], at[8 * s2 + 3]);
      pu.z = pk2(at[8 * s2 + 4], at[8 * s2 + 5]); pu.w = pk2(at[8 * s2 + 6], at[8 * s2 + 7]);
      const bf16x8 pb = __builtin_bit_cast(bf16x8, pu);
#pragma unroll
      for (int vb = 0; vb < 2; ++vb) {
        const s16x4 lo = *(const s16x4*)(vt + (vb * 32 + r) * 32 + 16 * s2 + 4 * h);
        const s16x4 hi = *(const s16x4*)(vt + (vb * 32 + r) * 32 + 16 * s2 + 8 + 4 * h);
        const bf16x8 vf = __builtin_shufflevector(lo, hi, 0, 1, 2, 3, 4, 5, 6, 7);
        o[vb] = MFMA(vf, pb, o[vb]);
      }
    }
#pragma unroll
    for (int vb = 0; vb < 2; ++vb)
#pragma unroll
      for (int ks = 0; ks < 4; ++ks) {
        const bf16x8 sf = *(const bf16x8*)(sp + (vb * 32 + r) * 64 + ks * 16 + h * 8);
        o[vb] = MFMA(sf, qf[ks], o[vb]);
      }
    float ss = 0.f;
#pragma unroll
    for (int i = 0; i < 16; ++i) ss += o[0][i] * o[0][i] + o[1][i] * o[1][i];
    ss = xor32_add(ss);
    const float rs = rsqrtf(ss * (1.f / 64.f) + EPS);
    const u16* sgb = (const u16*)(ws + OFF_SGB) + (tok0 + r) * 512 + head * 64;
    u16* yb = (u16*)(ws + OFF_YB) + (tok0 + r) * 512 + head * 64;
#pragma unroll
    for (int vb = 0; vb < 2; ++vb)
#pragma unroll
      for (int g = 0; g < 4; ++g) {
        const int v0 = vb * 32 + 8 * g + 4 * h;
        const u2v gt = *(const u2v*)(sgb + v0);
        u2v ov;
        ov.x = pk2(o[vb][4 * g] * rs * bflo(gt.x), o[vb][4 * g + 1] * rs * bfhi(gt.x));
        ov.y = pk2(o[vb][4 * g + 2] * rs * bflo(gt.y), o[vb][4 * g + 3] * rs * bfhi(gt.y));
        *(u2v*)(yb + v0) = ov;
      }
  }
}

DI void phase5(const Params& p, unsigned char* smem) {
  unsigned char* ws = p.ws;
  pg8::StaticOrder S; S.init(T, 1024, (int)gridDim.x, (int)blockIdx.x);
  {
    pg8::Gemm g{(const u16*)(ws + OFF_YA), (const u16*)(ws + OFF_WA), T, 1024, 512};
    Epi5<false> E{(const u16*)p.out, (u16*)(ws + OFF_H), (u16*)(ws + OFF_M)};
    pg8::gemm_phase<Epi5<false>, pg8::StaticOrder, false>((PG8_LAS unsigned char*)smem, g, S, E, nullptr);
  }
  {
    pg8::Gemm g{(const u16*)(ws + OFF_YB), (const u16*)(ws + OFF_WB), T, 1024, 512};
    Epi5<true> E{(const u16*)p.out, (u16*)(ws + OFF_H), (u16*)(ws + OFF_M)};
    pg8::gemm_phase<Epi5<true>, pg8::StaticOrder, false>((PG8_LAS unsigned char*)smem, g, S, E, nullptr);
  }
}

DI void phase6(const Params& p, unsigned char* smem, bool dup = false) {
  unsigned char* ws = p.ws;
  pg8::Gemm g{(const u16*)(ws + OFF_M), (const u16*)(ws + OFF_WO), T, 1024, 1024};
  pg8::StaticOrder S; S.init(T, 1024, (int)gridDim.x, (int)blockIdx.x);
  Epi6 E{(u16*)(ws + OFF_H), (float*)(ws + OFF_SSQ) + 2 * T, dup};
  pg8::gemm_phase<Epi6, pg8::StaticOrder, false>((PG8_LAS unsigned char*)smem, g, S, E, nullptr);
}

DI void phase7(const Params& p) {
  const float* ssq_y = (const float*)(p.ws + OFF_SSQ) + 2 * T;
  const u2v* Y = (const u2v*)(p.ws + OFF_H);
  const int gtid = blockIdx.x * blockDim.x + threadIdx.x, gthreads = gridDim.x * blockDim.x;
  for (int i = gtid; i < T * 256; i += gthreads) {
    const int row = i >> 8, c4 = i & 255;
    const float rs = rsqrtf(ssq_y[row] * (1.f / 1024.f) + EPS);
    const u2v y = Y[i];
    const f4v xv = ((const f4v*)p.x)[i];
    const f4v g = ((const f4v*)p.g_post)[c4];
    f4v o;
    o.x = xv.x + bflo(y.x) * rs * g.x; o.y = xv.y + bfhi(y.x) * rs * g.y; o.z = xv.z + bflo(y.y) * rs * g.z; o.w = xv.w + bfhi(y.y) * rs * g.w;
    ((f4v*)p.out)[i] = o;
  }
}

__global__ void __launch_bounds__(512, 2) fwd_megakernel(Params p) {
  extern __shared__ __attribute__((aligned(16))) unsigned char smem[];
  u16* lds = (u16*)(smem + (threadIdx.x >> 8) * VLDS);
  cg::grid_group grid = cg::this_grid();
  volatile LAS unsigned* xst = (volatile LAS unsigned*)(smem + LDS_BYTES - 48);
  if (threadIdx.x == 0) { xst[0] = 0u; xst[1] = 0u; }
  __syncthreads();
  XcdBarrier xb = xcd_barrier_post((unsigned*)(p.ws + OFF_BAR), xst);
  if (p.ph_hi > 1000) grid.sync();
#define RUN_PHASE(N, CALL) if (p.ph_lo <= N && N < p.ph_hi) { if (N > p.ph_lo) xcd_barrier(xb); CALL; }
#define DUP_PHASE(N, CALL) if (DUP_PH == N) { xcd_barrier(xb); CALL; }
  RUN_PHASE(0, phase0(p))
  DUP_PHASE(0, phase0(p))
  if (p.ph_lo <= 1 && 1 < p.ph_hi) for (int rep = 0; rep < (DUP_PH == 1 ? 2 : 1); ++rep) { if (rep > 0 || 1 > p.ph_lo) xcd_barrier(xb); phase1(p, smem, rep > 0); }
  if (p.ph_lo <= 2 && 2 < p.ph_hi) for (int rep = 0; rep < (DUP_PH == 2 ? 2 : 1); ++rep) { if (rep > 0 || 2 > p.ph_lo) xcd_barrier(xb); phase2(p, smem, lds); }
  RUN_PHASE(3, phase2b(p, smem))
  DUP_PHASE(3, phase2b(p, smem))
  RUN_PHASE(4, phase3(p, smem))
  DUP_PHASE(4, phase3(p, smem, true))
  if (DUP_PH == 9) { xcd_barrier(xb); for (int i = blockIdx.x; i < 256; i += gridDim.x) scan_item(p, i, OFF_K); }
  RUN_PHASE(5, phase4(p))
  DUP_PHASE(5, phase4(p))
  RUN_PHASE(6, phase5(p, smem))
  DUP_PHASE(6, phase5(p, smem))
  RUN_PHASE(7, phase6(p, smem))
  DUP_PHASE(7, phase6(p, smem, true))
  RUN_PHASE(8, phase7(p))
  if (DUP_PH == 8) { xcd_barrier(xb); phase6(p, smem, true); xcd_barrier(xb); phase7(p); }
}

extern "C" void kernel_launch(void* const* d_in, const int* in_sizes, int n_in, void* d_out, int out_size, void* d_ws, size_t ws_size,
                              hipStream_t stream) {
  static int grid_blocks = 0;
  if (!grid_blocks) {
    int dev = 0, cus = 0, per_cu = 0;
    hipGetDevice(&dev);
    hipDeviceGetAttribute(&cus, hipDeviceAttributeMultiprocessorCount, dev);
    hipFuncSetAttribute((const void*)fwd_megakernel, hipFuncAttributeMaxDynamicSharedMemorySize, LDS_BYTES);
    hipOccupancyMaxActiveBlocksPerMultiprocessor(&per_cu, (const void*)fwd_megakernel, 512, LDS_BYTES);
    if (per_cu < 1) per_cu = 1;
    if (per_cu > 1) per_cu = 1;
    grid_blocks = cus * per_cu;
    if (ws_size < WS_NEED) fprintf(stderr, "kernel_launch: workspace too small: %zu < %zu\n", ws_size, (size_t)WS_NEED);
  }
  if (ws_size < WS_NEED) return;
  Params p{};
  p.x = (const float*)d_in[0]; p.g_pre = (const float*)d_in[1]; p.w_in = (const float*)d_in[2]; p.b_gate = (const float*)d_in[3];
  p.g_q = (const float*)d_in[4]; p.w_uq = (const float*)d_in[5]; p.g_kv = (const float*)d_in[6]; p.w_ukv = (const float*)d_in[7];
  p.lb_logits = (const float*)d_in[8]; p.g_hgrn = (const float*)d_in[9]; p.w_a = (const float*)d_in[10]; p.w_b = (const float*)d_in[11];
  p.w_out = (const float*)d_in[12]; p.g_post = (const float*)d_in[13];
  p.out = (float*)d_out; p.ws = (unsigned char*)d_ws;
#if ONE_LAUNCH
  p.ph_lo = 0; p.ph_hi = 9;
  (void)hipMemsetAsync((unsigned char*)d_ws + OFF_BAR, 0, 16384, stream);
  void* args[] = {&p};
  hipError_t e = hipLaunchCooperativeKernel((const void*)fwd_megakernel, dim3(grid_blocks), dim3(512), args, LDS_BYTES, stream);
  if (e != hipSuccess) fprintf(stderr, "cooperative launch failed: %s (grid %d)\n", hipGetErrorString(e), grid_blocks);
#else
  for (int ph = 0; ph < 9; ++ph) {
    p.ph_lo = ph; p.ph_hi = ph + 1;
    (void)hipMemsetAsync((unsigned char*)d_ws + OFF_BAR, 0, 16384, stream);
    void* args[] = {&p};
    hipError_t e = hipLaunchCooperativeKernel((const void*)fwd_megakernel, dim3(grid_blocks), dim3(512), args, LDS_BYTES, stream);
    if (e != hipSuccess) fprintf(stderr, "cooperative launch failed: %s (grid %d)\n", hipGetErrorString(e), grid_blocks);
  }
#endif
}
```

```cpp
#include <hip/hip_runtime.h>
#include <hip/hip_cooperative_groups.h>
#include <cstdio>
namespace cg = cooperative_groups;

#define DI __device__ __forceinline__
#define VTID ((int)(threadIdx.x & 255))
#define VBID ((int)(blockIdx.x * 2 + (threadIdx.x >> 8)))
#define VBN ((int)(gridDim.x * 2))
typedef unsigned short u16;
typedef unsigned int u32;
typedef __attribute__((ext_vector_type(8))) short bf16x8;
typedef __attribute__((ext_vector_type(4))) short s16x4;
typedef __attribute__((ext_vector_type(16))) float f32x16;
typedef __attribute__((ext_vector_type(2))) __bf16 bf2_t;
typedef __attribute__((ext_vector_type(2))) float f2_t;
typedef __attribute__((ext_vector_type(4))) unsigned int u4v;
typedef __attribute__((ext_vector_type(2))) unsigned int u2v;
typedef __attribute__((ext_vector_type(4))) float f4v;
typedef __attribute__((ext_vector_type(2))) float f2v;
#define MFMA(a, b, c) __builtin_amdgcn_mfma_f32_32x32x16_bf16((a), (b), (c), 0, 0, 0)

#ifndef DUP_PH
#define DUP_PH -1
#endif
#ifndef ONE_LAUNCH
#define ONE_LAUNCH 1
#endif

constexpr int T = 32768;
constexpr int SEQ = 4096;
constexpr int DIN = 5664;
constexpr int NP = 5888;
constexpr float EPS = 1e-6f;
constexpr float QSCALE = 1.4426950408889634f * 0.10206207261596575f;

constexpr size_t SZ_WIN = (size_t)NP * 1024 * 2;
constexpr size_t OFF_WIN = 0;
constexpr size_t OFF_WUQ = OFF_WIN + SZ_WIN;
constexpr size_t OFF_WUKV = OFF_WUQ + (size_t)768 * 768 * 2;
constexpr size_t OFF_WA = OFF_WUKV + (size_t)1024 * 256 * 2;
constexpr size_t OFF_WB = OFF_WA + (size_t)1024 * 512 * 2;
constexpr size_t OFF_WO = OFF_WB + (size_t)1024 * 512 * 2;
constexpr size_t OFF_ROPE = OFF_WO + (size_t)1024 * 1024 * 2;
constexpr size_t OFF_SSQ = OFF_ROPE + (size_t)4096 * 16 * 2 * 4;
constexpr size_t OFF_DECAY = OFF_SSQ + (size_t)(3 * T + 64) * 4;
constexpr size_t OFF_H = OFF_DECAY + (size_t)64 * 128 * 64 * 4;
constexpr size_t OFF_Q = OFF_H;
constexpr size_t OFF_CQ = OFF_H + (size_t)T * 1024 * 2;
constexpr size_t OFF_YA = OFF_CQ;
constexpr size_t OFF_CKV = OFF_CQ + (size_t)T * 768 * 2;
constexpr size_t OFF_KPE = OFF_CKV + (size_t)T * 256 * 2;
constexpr size_t OFF_SGA = OFF_KPE + (size_t)T * 32 * 4;
constexpr size_t OFF_SGB = OFF_SGA + (size_t)T * 512 * 2;
constexpr size_t OFF_HQ = OFF_SGB + (size_t)T * 512 * 2;
constexpr size_t OFF_UPD = OFF_HQ;
constexpr size_t OFF_HF = OFF_HQ + (size_t)T * 512 * 2;
constexpr size_t OFF_HI = OFF_HF + (size_t)T * 512 * 2;
constexpr size_t OFF_YB = OFF_HI;
constexpr size_t OFF_QDEC = OFF_HI + (size_t)T * 512 * 2;
constexpr size_t OFF_KINV = OFF_QDEC + (size_t)T * 512 * 2;
constexpr size_t OFF_VT = OFF_KINV + (size_t)T * 512 * 2;
constexpr size_t OFF_K = OFF_VT + (size_t)T * 512 * 2;
constexpr size_t OFF_M = OFF_K;
constexpr size_t OFF_VTT = OFF_K + (size_t)T * 768 * 2;
constexpr size_t OFF_BAR = OFF_VTT + (size_t)T * 512 * 2;
constexpr size_t WS_NEED = OFF_BAR + 16384;

constexpr int VLDS = 2 * 2 * 128 * 72 * 2;
constexpr int LDS_BYTES = 2 * VLDS + 64;
constexpr int SST = 132;

struct Params {
  const float *x, *g_pre, *w_in, *b_gate, *g_q, *w_uq, *g_kv, *w_ukv, *lb_logits, *g_hgrn, *w_a, *w_b, *w_out, *g_post;
  float* out;
  unsigned char* ws;
  int ph_lo, ph_hi;
};

DI u32 pk2(float a, float b) { f2_t v = {a, b}; bf2_t r = __builtin_convertvector(v, bf2_t); return __builtin_bit_cast(u32, r); }
DI float bflo(u32 u) { return __uint_as_float(u << 16); }
DI float bfhi(u32 u) { return __uint_as_float(u & 0xffff0000u); }
DI u4v pk8(f4v a, f4v b) { u4v r; r.x = pk2(a.x, a.y); r.y = pk2(a.z, a.w); r.z = pk2(b.x, b.y); r.w = pk2(b.z, b.w); return r; }
DI float rcpf(float x) { return __builtin_amdgcn_rcpf(x); }
DI float sigmoidf_(float x) { return rcpf(1.f + __expf(-x)); }
DI float siluf_(float x) { return x * sigmoidf_(x); }
DI float xor32_max(float x) { const unsigned u = __float_as_uint(x); auto r = __builtin_amdgcn_permlane32_swap(u, u, false, false); return fmaxf(__uint_as_float(r[0]), __uint_as_float(r[1])); }
DI float xor32_add(float x) { const unsigned u = __float_as_uint(x); auto r = __builtin_amdgcn_permlane32_swap(u, u, false, false); return __uint_as_float(r[0]) + __uint_as_float(r[1]); }
DI float xor16_add(float x) { const unsigned u = __float_as_uint(x); auto r = __builtin_amdgcn_permlane16_swap(u, u, false, false); return __uint_as_float(r[0]) + __uint_as_float(r[1]); }
DI int crow(int reg, int h) { return (reg & 3) + 8 * (reg >> 2) + 4 * h; }
DI f32x16 zero16() { f32x16 z;
#pragma unroll
  for (int i = 0; i < 16; ++i) z[i] = 0.f; return z; }

__constant__ float c_invfreq[16] = {1.0f, 0.5623413324356079f, 0.3162277638912201f, 0.17782793939113617f, 0.10000000149011612f,
  0.05623413249850273f, 0.03162277489900589f, 0.017782794311642647f, 0.009999999776482582f, 0.005623413249850273f,
  0.003162277629598975f, 0.0017782794311642647f, 0.0010000000474974513f, 0.000562341301701963f, 0.0003162277571391314f,
  0.00017782794020604342f};

DI void sincos_d(double a, float& sn, float& cs) {
  const double k = rint(a * 0.63661977236758134308);
  const double y = a - k * 1.57079632679489661923;
  const double y2 = y * y;
  const double s = y * (1.0 + y2 * (-1.0 / 6 + y2 * (1.0 / 120 + y2 * (-1.0 / 5040 + y2 * (1.0 / 362880 + y2 * (-1.0 / 39916800 + y2 * (1.0 / 6227020800.0)))))));
  const double c = 1.0 + y2 * (-0.5 + y2 * (1.0 / 24 + y2 * (-1.0 / 720 + y2 * (1.0 / 40320 + y2 * (-1.0 / 3628800 + y2 * (1.0 / 479001600.0 + y2 * (-1.0 / 87178291200.0)))))));
  const int q = ((int)k) & 3;
  const double ss = (q == 0) ? s : (q == 1) ? c : (q == 2) ? -s : -c;
  const double cc = (q == 0) ? c : (q == 1) ? -s : (q == 2) ? -c : s;
  sn = (float)ss; cs = (float)cc;
}

#define XB_TMO      128
#define XB_XCNT(j)  (256  + 64 * (j))
#define XB_XSUB(j)  (1280 + 64 * (j))
#define XB_XGEN(j)  (2304 + 64 * (j))
#define XB_TOP      3328
#define XB_TOPGEN   3392
#define XCD_BAR_WORDS 3456
#define XB_SPIN_CAP (1u << 22)
#define LAS __attribute__((address_space(3)))
DI unsigned xb_ld(unsigned* p)              { return __hip_atomic_load(p, __ATOMIC_RELAXED, __HIP_MEMORY_SCOPE_AGENT); }
DI unsigned xb_add(unsigned* p, unsigned v) { return __hip_atomic_fetch_add(p, v, __ATOMIC_RELAXED, __HIP_MEMORY_SCOPE_AGENT); }
DI unsigned xb_xcc_id() { return (unsigned)__builtin_amdgcn_s_getreg((3 << 11) | 20) & 0xFu; }
#define XB_SPIN(cond, bar) do { unsigned _sp = 0; while (cond) { __builtin_amdgcn_s_sleep(1); \
    if ((++_sp & 255u) == 0u) { if (xb_ld(&(bar)[XB_TMO])) break; if (_sp > XB_SPIN_CAP) { atomicAdd(&(bar)[XB_TMO], 1u); break; } } } } while (0)
struct XcdBarrier { unsigned* bar; unsigned x; volatile LAS unsigned* st; };
DI XcdBarrier xcd_barrier_post(unsigned* bar, volatile LAS unsigned* st) {
  XcdBarrier b; b.bar = bar; b.x = xb_xcc_id(); b.st = st;
  if (threadIdx.x == 0) (void)xb_add(&bar[XB_XCNT(b.x)], 1u);
  return b;
}
DI void xcd_barrier_complete(unsigned* bar, unsigned x, unsigned& nloc, unsigned& nx) {
  const unsigned G = gridDim.x * gridDim.y * gridDim.z;
  unsigned sum, cnt, mine, sp = 0u;
  for (;;) {
    sum = 0u; cnt = 0u; mine = 0u;
#pragma unroll
    for (unsigned j = 0; j < 16; ++j) { const unsigned c = xb_ld(&bar[XB_XCNT(j)]); sum += c; cnt += (c > 0u) ? 1u : 0u; mine = (j == x) ? c : mine; }
    if (sum == G) break;
    __builtin_amdgcn_s_sleep(1);
    if ((++sp & 255u) == 0u) { if (xb_ld(&bar[XB_TMO])) break; if (sp > XB_SPIN_CAP) { atomicAdd(&bar[XB_TMO], 1u); break; } }
  }
  nloc = mine > 0u ? mine : 1u; nx = cnt > 0u ? cnt : 1u;
}
DI void xcd_barrier(const XcdBarrier& b) {
  asm volatile("s_waitcnt vmcnt(0)" ::: "memory");
  __syncthreads();
  if (threadIdx.x == 0) {
    unsigned* bar = b.bar;
    __builtin_amdgcn_s_waitcnt(0);
    unsigned nloc = b.st[0], nx = b.st[1];
    if (nloc == 0u) { xcd_barrier_complete(bar, b.x, nloc, nx); b.st[0] = nloc; b.st[1] = nx; }
    const unsigned old = xb_add(&bar[XB_XSUB(b.x)], 1u);
    const unsigned gen = old / nloc;
    if (old + 1u == (gen + 1u) * nloc) {
      __builtin_amdgcn_fence(__ATOMIC_RELEASE, "agent");
      asm volatile("s_waitcnt vmcnt(0)" ::: "memory");
      const unsigned og = xb_add(&bar[XB_TOP], 1u);
      const unsigned tg = og / nx;
      if (og + 1u == (tg + 1u) * nx) xb_add(&bar[XB_TOPGEN], 1u);
      else XB_SPIN(xb_ld(&bar[XB_TOPGEN]) == tg, bar);
      __builtin_amdgcn_fence(__ATOMIC_ACQUIRE, "agent");
      xb_add(&bar[XB_XGEN(b.x)], 1u);
      asm volatile("s_waitcnt vmcnt(0)" ::: "memory");
    } else {
      XB_SPIN(xb_ld(&bar[XB_XGEN(b.x)]) == gen, bar);
      __builtin_amdgcn_fence(__ATOMIC_ACQUIRE, "agent");
      asm volatile("s_waitcnt vmcnt(0)" ::: "memory");
    }
  }
  __syncthreads();
}

template <int KIND>
DI int colmap(int n) {
  if (KIND == 0) {
    if (n < 1024) return n;
    if (n < 1536) return 1056 + (n - 1024);
    if (n < 2048) return 3104 + (n - 1536);
    if (n < 4096) return 3616 + (n - 2048);
    if (n < 4608) return 1568 + (n - 4096);
    if (n < 5120) return 2080 + (n - 4608);
    if (n < 5632) return 2592 + (n - 5120);
    if (n < 5664) return 1024 + (n - 5632);
    return -1;
  } else if (KIND == 1) {
    if (n < 512) return (n >> 6) * 96 + (n & 63);
    int i = n - 512; int w = i & 31, g = w >> 3, e = w & 7; return (i >> 5) * 96 + 64 + ((e < 4) ? (4 * g + e) : (16 + 4 * g + (e - 4)));
  } else if (KIND == 3) {
    if (n < 512) return (n >> 6) * 128 + (n & 63);
    int i = n - 512; return (i >> 6) * 128 + 64 + (i & 63);
  } else return n;
}
template <int KIND>
DI void conv_weight(u16* dst, const float* src, int ldw, int ncount, int K, const float* gain, int gmask, int gtid, int gthreads) {
  const int total = ncount * (K >> 3);
  for (int it = gtid; it < total; it += gthreads) {
    const int n = it % ncount, kc = it / ncount;
    const int sc = colmap<KIND>(n);
    float v[8];
#pragma unroll
    for (int i = 0; i < 8; ++i) {
      const int k = kc * 8 + i;
      float x = (sc >= 0) ? src[(size_t)k * ldw + sc] : 0.f;
      if (gain) x *= gain[k & gmask];
      v[i] = x;
    }
    u4v o; o.x = pk2(v[0], v[1]); o.y = pk2(v[2], v[3]); o.z = pk2(v[4], v[5]); o.w = pk2(v[6], v[7]);
    *(u4v*)(dst + (size_t)n * K + kc * 8) = o;
  }
}

DI void phase0(const Params& p) {
  unsigned char* ws = p.ws;
  const int gtid = blockIdx.x * blockDim.x + threadIdx.x, gthreads = gridDim.x * blockDim.x;
  float* ssq = (float*)(ws + OFF_SSQ);
  for (int i = gtid; i < 3 * T + 64; i += gthreads) ssq[i] = 0.f;
  float* rope = (float*)(ws + OFF_ROPE);
  for (int i = gtid; i < 4096 * 16; i += gthreads) {
    const int pos = i >> 4, j = i & 15;
    const float ang = (float)pos * c_invfreq[j];
    float sn, cs; sincos_d((double)ang, sn, cs);
    rope[i] = cs; rope[65536 + i] = sn;
  }
  conv_weight<0>((u16*)(ws + OFF_WIN), p.w_in, DIN, NP, 1024, nullptr, 0, gtid, gthreads);
  u16* H = (u16*)(ws + OFF_H);
  const int lane = threadIdx.x & 63;
  const int gw = gtid >> 6, nw = gthreads >> 6;
  for (int row = gw; row < T; row += nw) {
    const f4v* xr = (const f4v*)(p.x + (size_t)row * 1024);
    f4v v[4];
    float ss = 0.f;
#pragma unroll
    for (int i = 0; i < 4; ++i) { v[i] = xr[lane * 4 + i]; ss += v[i].x * v[i].x + v[i].y * v[i].y + v[i].z * v[i].z + v[i].w * v[i].w; }
#pragma unroll
    for (int o = 32; o >= 1; o >>= 1) ss += __shfl_xor(ss, o);
    const float rs = rsqrtf(ss * (1.f / 1024.f) + EPS);
    const f4v* gp = (const f4v*)(p.g_pre);
    f4v g[4];
#pragma unroll
    for (int i = 0; i < 4; ++i) { g[i] = gp[lane * 4 + i]; v[i].x *= rs * g[i].x; v[i].y *= rs * g[i].y; v[i].z *= rs * g[i].z; v[i].w *= rs * g[i].w; }
    u4v* hr = (u4v*)(H + (size_t)row * 1024 + lane * 16);
    hr[0] = pk8(v[0], v[1]); hr[1] = pk8(v[2], v[3]);
  }
}

constexpr int TS = 128 * 72;
DI void gemm_ld(u4v (&ra)[4], u4v (&rb)[4], const u16* ga, const u16* gb, int lda, int ldb, int ko) {
#pragma unroll
  for (int i = 0; i < 4; ++i) { ra[i] = *(const u4v*)(ga + (size_t)(32 * i) * lda + ko); rb[i] = *(const u4v*)(gb + (size_t)(32 * i) * ldb + ko); }
}
DI void gemm_st(const u4v (&ra)[4], const u4v (&rb)[4], u16* buf, int lr, int lc) {
  u16* sa = buf; u16* sb = buf + TS;
#pragma unroll
  for (int i = 0; i < 4; ++i) { *(u4v*)(sa + (lr + 32 * i) * 72 + lc * 8) = ra[i]; *(u4v*)(sb + (lr + 32 * i) * 72 + lc * 8) = rb[i]; }
}
DI void gemm_mma(const u16* buf, f32x16 (&acc)[2][2], int wm, int wn, int r, int h) {
  const u16* sa = buf + (wm * 64 + r) * 72 + h * 8;
  const u16* sb = buf + TS + (wn * 64 + r) * 72 + h * 8;
#pragma unroll
  for (int ks = 0; ks < 4; ++ks) {
    const bf16x8 a0 = *(const bf16x8*)(sa + ks * 16);
    const bf16x8 a1 = *(const bf16x8*)(sa + 32 * 72 + ks * 16);
    const bf16x8 b0 = *(const bf16x8*)(sb + ks * 16);
    const bf16x8 b1 = *(const bf16x8*)(sb + 32 * 72 + ks * 16);
    acc[0][0] = MFMA(a0, b0, acc[0][0]);
    acc[0][1] = MFMA(a0, b1, acc[0][1]);
    acc[1][0] = MFMA(a1, b0, acc[1][0]);
    acc[1][1] = MFMA(a1, b1, acc[1][1]);
  }
}
DI void gemm_core(const u16* __restrict__ A, int lda, const u16* __restrict__ B, int ldb, int K, u16* lds, f32x16 (&acc)[2][2], int tid) {
  const int lane = tid & 63, w = tid >> 6, wm = w >> 1, wn = w & 1, r = lane & 31, h = lane >> 5;
  const int lc = tid & 7, lr = tid >> 3;
  const u16* ga = A + (size_t)lr * lda + lc * 8;
  const u16* gb = B + (size_t)lr * ldb + lc * 8;
  u4v ra0[4], rb0[4], ra1[4], rb1[4];
  gemm_ld(ra0, rb0, ga, gb, lda, ldb, 0);
  gemm_ld(ra1, rb1, ga, gb, lda, ldb, 64);
#pragma unroll
  for (int i = 0; i < 2; ++i)
#pragma unroll
    for (int j = 0; j < 2; ++j) acc[i][j] = zero16();
  u16* L0 = lds; u16* L1 = lds + 2 * TS;
  __syncthreads();
  gemm_st(ra0, rb0, L0, lr, lc);
  __syncthreads();
  const int nk = K >> 6;
  int kt = 0;
  for (; kt + 2 < nk; kt += 2) {
    gemm_ld(ra0, rb0, ga, gb, lda, ldb, (kt + 2) * 64);
    __builtin_amdgcn_sched_barrier(0);
    gemm_mma(L0, acc, wm, wn, r, h);
    gemm_st(ra1, rb1, L1, lr, lc);
    __syncthreads();
    gemm_ld(ra1, rb1, ga, gb, lda, ldb, (kt + 3) * 64);
    __builtin_amdgcn_sched_barrier(0);
    gemm_mma(L1, acc, wm, wn, r, h);
    gemm_st(ra0, rb0, L0, lr, lc);
    __syncthreads();
  }
  gemm_mma(L0, acc, wm, wn, r, h);
  gemm_st(ra1, rb1, L1, lr, lc);
  __syncthreads();
  gemm_mma(L1, acc, wm, wn, r, h);
  __syncthreads();
}

DI void stage_pass(const f32x16 (&acc)[2][2], float* stage, int p, int tid) {
  const int lane = tid & 63, w = tid >> 6, wm = w >> 1, wn = w & 1, r = lane & 31, h = lane >> 5;
  __syncthreads();
  if (wm == p) {
#pragma unroll
    for (int i = 0; i < 2; ++i)
#pragma unroll
      for (int j = 0; j < 2; ++j)
#pragma unroll
        for (int reg = 0; reg < 16; ++reg) stage[(i * 32 + crow(reg, h)) * SST + wn * 64 + j * 32 + r] = acc[i][j][reg];
  }
  __syncthreads();
}

namespace pg8 {
#define PG8_LAS __attribute__((address_space(3)))
typedef unsigned short bf16_t;
typedef short bf16x8 __attribute__((ext_vector_type(8)));
typedef float f32x4 __attribute__((ext_vector_type(4)));
typedef unsigned u32x4 __attribute__((ext_vector_type(4)));
constexpr int BM = 256, BK = 64, HALF = 128, HTB = HALF * BK * 2  , STAGE_BYTES = 8 * HTB, NXCD = 8, WGM = 8;

__host__ __device__ __forceinline__ int lds_byte(int r, int c) { const int st = (r >> 4) * 2 + (c >> 5), rr = r & 15, cc = c & 31, ob = rr * 64 + cc * 2; return st * 1024 + (ob ^ (((ob >> 9) & 1) << 5)); }
__host__ __device__ __forceinline__ void stage_rc(int b, int& R, int& C) { const int st = b / 1024, sb = b % 1024, swz = sb ^ (((sb >> 9) & 1) << 5); R = (st >> 1) * 16 + swz / 64; C = (st & 1) * 32 + (swz % 64) / 2; }
__host__ __device__ __forceinline__ int perm32(int rho) { const int n = rho >> 4, i = rho & 15; return 8 * (i >> 2) + 4 * n + (i & 3); }

struct Unit { int pm, pn; };
struct Gemm { const bf16_t* A; const bf16_t* Bt; int M, N, K; };

struct StaticOrder {
    int nM, nN, nwg, G, c;
    __host__ __device__ void init(int M, int N, int G_, int c_) { nM = M / BM; nN = N / BM; nwg = nM * nN; G = G_; c = c_; }
    __host__ __device__ bool next(int i, Unit& u) const {
        const long L = (long)i * G + c; if (L >= nwg) return false;
        int wgid = (int)L; { const int q = nwg / NXCD, r = nwg % NXCD, xcd = wgid % NXCD, off = wgid / NXCD; wgid = (xcd < r ? xcd * (q + 1) : r * (q + 1) + (xcd - r) * q) + off; }
        const int nig = WGM * nN, gid = wgid / nig, fm = gid * WGM, gsz = (nM - fm) < WGM ? (nM - fm) : WGM;
        u.pm = fm + ((wgid % nig) % gsz); u.pn = (wgid % nig) / gsz; return true;
    }
    __device__ __forceinline__ void a_ready(const Unit&) const {}
    __device__ __forceinline__ void done(const Unit&) const {}
};
template <class Epi, class Sched, bool STAMP = false, bool SWAP = false>
__device__ __forceinline__ void gemm_phase(PG8_LAS unsigned char* lds, const Gemm g, const Sched& S, const Epi& E, unsigned long long* stamps) {
    const int tid = threadIdx.x, wid = __builtin_amdgcn_readfirstlane(tid >> 6), lane = tid & 63, wr = wid >> 2, wc = wid & 3, fr = lane & 15, fq = lane >> 4;
    const int K = g.K, nt = K / BK;
    int ts_lo = 0, ts_hi = 0, nts = 0; const unsigned long long rt_entry = STAMP ? (unsigned long long)wall_clock64() : 0ull;
#define PG8_STAMP() do { if (STAMP && wid == 0 && nts < 64) { const unsigned long long _c = (unsigned long long)clock64(); \
        ts_lo = (lane == nts) ? (int)(unsigned)_c : ts_lo; ts_hi = (lane == nts) ? (int)(unsigned)(_c >> 32) : ts_hi; ++nts; } } while (0)
    PG8_STAMP();
    unsigned voffA[2], voffB[2];
#pragma unroll
    for (int i = 0; i < 2; ++i) { int R, C; stage_rc(tid * 16 + i * 8192, R, C); const int Rb = Epi::PERM ? ((R & ~31) + perm32(R & 31)) : R;
        voffA[i] = (unsigned)(R * K + C) * 2u; voffB[i] = (unsigned)(Rb * K + C) * 2u; }
    const size_t kstep = (size_t)(BK * 2);
    const size_t hstep = (size_t)HALF * K * 2;
    const size_t tstep = 2 * hstep;
    const unsigned ldsw = (unsigned)wid * 1024u;
    const int aoff = lds_byte(wr * 64 + fr, fq * 8), boff = lds_byte(wc * 32 + fr, fq * 8);
#define PG8_SA(b, h) (((b) * 2 + (h)) * HTB)
#define PG8_SB(b, h) ((4 + (b) * 2 + (h)) * HTB)
#define PG8_STAGE(bufoff, gbase, voff) do { _Pragma("unroll") for (int _i = 0; _i < 2; ++_i) \
        __builtin_amdgcn_global_load_lds((const unsigned*)((const char*)(gbase) + (voff)[_i]), (PG8_LAS unsigned*)(lds + (bufoff) + ldsw + _i * 8192), 16, 0, 0); } while (0)
#define PG8_LDA(dst, b, h) do { _Pragma("unroll") for (int m = 0; m < 4; ++m) _Pragma("unroll") for (int k = 0; k < 2; ++k) dst[m][k] = *(const PG8_LAS bf16x8*)(lds + PG8_SA(b, h) + aoff + m * 2048 + k * 1024); } while (0)
#define PG8_LDB(dst, b, h) do { _Pragma("unroll") for (int n = 0; n < 2; ++n) _Pragma("unroll") for (int k = 0; k < 2; ++k) dst[n][k] = *(const PG8_LAS bf16x8*)(lds + PG8_SB(b, h) + boff + n * 2048 + k * 1024); } while (0)
#define PG8_MMA(ai, bj, At, Bt) do { __builtin_amdgcn_s_setprio(1); _Pragma("unroll") for (int m = 0; m < 4; ++m) _Pragma("unroll") for (int n = 0; n < 2; ++n) _Pragma("unroll") for (int k = 0; k < 2; ++k) \
        acc[ai][bj][m][n] = SWAP ? __builtin_amdgcn_mfma_f32_16x16x32_bf16(At[m][k], Bt[n][k], acc[ai][bj][m][n], 0, 0, 0) : __builtin_amdgcn_mfma_f32_16x16x32_bf16(Bt[n][k], At[m][k], acc[ai][bj][m][n], 0, 0, 0); __builtin_amdgcn_s_setprio(0); } while (0)
#define PG8_WAIT_V(n) asm volatile("s_waitcnt vmcnt(" #n ")" ::: "memory")
#define PG8_WAIT_L(n) asm volatile("s_waitcnt lgkmcnt(" #n ")" ::: "memory")
#define PG8_BAR __builtin_amdgcn_s_barrier()
#define PG8_SCHED __builtin_amdgcn_sched_barrier(0)
    Unit cur, nxt; int ui = 0;
    if (!S.next(0, cur)) return;
    f32x4 acc[2][2][4][2];
#pragma unroll
    for (int a = 0; a < 2; ++a)
#pragma unroll
        for (int b = 0; b < 2; ++b)
#pragma unroll
            for (int m = 0; m < 4; ++m)
#pragma unroll
                for (int n = 0; n < 2; ++n) acc[a][b][m][n] = (f32x4){0.f, 0.f, 0.f, 0.f};
    bf16x8 At[4][2], B0[2][2], B1[2][2];
    const char* cA = (const char*)g.A + (size_t)cur.pm * tstep; const char* cB = (const char*)g.Bt + (size_t)cur.pn * tstep;
    S.a_ready(cur);
    PG8_STAGE(PG8_SB(0, 0), cB, voffB); PG8_STAGE(PG8_SA(0, 0), cA, voffA); PG8_STAGE(PG8_SB(0, 1), cB + hstep, voffB); PG8_STAGE(PG8_SA(0, 1), cA + hstep, voffA);
    if (wr == 1) PG8_BAR;
    PG8_WAIT_V(4); PG8_BAR;
    PG8_STAGE(PG8_SB(1, 0), cB + kstep, voffB); PG8_STAGE(PG8_SA(1, 0), cA + kstep, voffA); PG8_STAGE(PG8_SB(1, 1), cB + hstep + kstep, voffB);
    PG8_WAIT_V(6); PG8_BAR;
    PG8_STAMP();
    for (;;) {
        const bool has_next = S.next(ui + 1, nxt);
        const char* nA = has_next ? (const char*)g.A + (size_t)nxt.pm * tstep : cA; const char* nB = has_next ? (const char*)g.Bt + (size_t)nxt.pn * tstep : cB;
        for (int t = 0; t < nt; t += 2) {
            const bool last = (t == nt - 2);
            const char* a1 = cA + (size_t)(t + 1) * kstep;
            const char* a2 = last ? nA : cA + (size_t)(t + 2) * kstep; const char* b2 = last ? nB : cB + (size_t)(t + 2) * kstep;
            const char* a3 = a2 + kstep; const char* b3 = b2 + kstep;
            if (last && has_next) S.a_ready(nxt);
            PG8_LDB(B0, 0, 0); PG8_SCHED; PG8_LDA(At, 0, 0); PG8_STAGE(PG8_SA(1, 1), a1 + hstep, voffA);
            PG8_WAIT_L(8); PG8_BAR; PG8_WAIT_L(0); PG8_MMA(0, 0, At, B0); PG8_BAR; PG8_SCHED;
            PG8_LDB(B1, 0, 1); PG8_STAGE(PG8_SB(0, 0), b2, voffB);
            PG8_BAR; PG8_WAIT_L(0); PG8_MMA(0, 1, At, B1); PG8_BAR;
            PG8_LDA(At, 0, 1); PG8_STAGE(PG8_SA(0, 0), a2, voffA);
            PG8_BAR; PG8_WAIT_L(0); PG8_MMA(1, 0, At, B0); PG8_BAR; PG8_SCHED;
            PG8_STAGE(PG8_SB(0, 1), b2 + hstep, voffB);
            PG8_WAIT_V(6); PG8_BAR; PG8_MMA(1, 1, At, B1); PG8_BAR;
            PG8_LDB(B0, 1, 0); PG8_SCHED; PG8_LDA(At, 1, 0); PG8_STAGE(PG8_SA(0, 1), a2 + hstep, voffA);
            PG8_WAIT_L(8); PG8_BAR; PG8_WAIT_L(0); PG8_MMA(0, 0, At, B0); PG8_BAR; PG8_SCHED;
            PG8_LDB(B1, 1, 1); PG8_STAGE(PG8_SB(1, 0), b3, voffB);
            PG8_BAR; PG8_WAIT_L(0); PG8_MMA(0, 1, At, B1); PG8_BAR;
            PG8_LDA(At, 1, 1); PG8_STAGE(PG8_SA(1, 0), a3, voffA);
            PG8_BAR; PG8_WAIT_L(0); PG8_MMA(1, 0, At, B0); PG8_BAR; PG8_SCHED;
            PG8_STAGE(PG8_SB(1, 1), b3 + hstep, voffB);
            PG8_WAIT_V(6); PG8_BAR; PG8_MMA(1, 1, At, B1); PG8_BAR;
        }
        PG8_STAMP();
        if constexpr (!Epi::AFTER_DRAIN) { E(acc, cur, wr, wc, fr, fq); S.done(cur); }
        PG8_STAMP();
        if (!has_next) break;
#pragma unroll
        for (int a = 0; a < 2; ++a)
#pragma unroll
            for (int b = 0; b < 2; ++b)
#pragma unroll
                for (int m = 0; m < 4; ++m)
#pragma unroll
                    for (int n = 0; n < 2; ++n) acc[a][b][m][n] = (f32x4){0.f, 0.f, 0.f, 0.f};
        cur = nxt; cA = nA; cB = nB; ++ui;
    }
    PG8_WAIT_V(0);
    if (wr == 0) PG8_BAR;
    PG8_BAR;
    if constexpr (Epi::AFTER_DRAIN) { E.fused(acc, cur, wr, wc, fr, fq, lds, wid, lane); S.done(cur); }
    PG8_STAMP();
    if (STAMP && wid == 0) { stamps[lane] = lane < nts ? (((unsigned long long)(unsigned)ts_hi << 32) | (unsigned)ts_lo) : 0ull;
        if (lane == 62) stamps[62] = rt_entry; if (lane == 63) stamps[63] = (unsigned long long)wall_clock64(); }
#undef PG8_STAMP
#undef PG8_SA
#undef PG8_SB
#undef PG8_STAGE
#undef PG8_LDA
#undef PG8_LDB
#undef PG8_MMA
#undef PG8_WAIT_V
#undef PG8_WAIT_L
#undef PG8_BAR
#undef PG8_SCHED
}
}

struct Epi1 {
  static constexpr bool PERM = true, AFTER_DRAIN = false;
  unsigned char* ws; u16* mg; const float* b_gate; bool dup;
  DI void operator()(const pg8::f32x4 (&acc)[2][2][4][2], const pg8::Unit& u, int wr, int wc, int fr, int fq) const {
    const int pn = u.pn;
    const int rowb = u.pm * 256 + wr * 64 + fr;
    const int colu = wc * 32 + 8 * fq;
    if (pn < 4) {
      u16* dst = (pn < 3) ? (u16*)(ws + OFF_CQ) + pn * 256 : (u16*)(ws + OFF_CKV);
      const int ld = (pn < 3) ? 768 : 256;
      float* ssq = (float*)(ws + OFF_SSQ) + ((pn < 3) ? 0 : T);
#pragma unroll
      for (int ai = 0; ai < 2; ++ai)
#pragma unroll
        for (int m = 0; m < 4; ++m) {
          const int row = rowb + ai * 128 + m * 16;
          float ss = 0.f;
#pragma unroll
          for (int bj = 0; bj < 2; ++bj) {
            const pg8::f32x4 v0 = acc[ai][bj][m][0], v1 = acc[ai][bj][m][1];
            ss += v0[0] * v0[0] + v0[1] * v0[1] + v0[2] * v0[2] + v0[3] * v0[3] + v1[0] * v1[0] + v1[1] * v1[1] + v1[2] * v1[2] + v1[3] * v1[3];
            u4v o; o.x = pk2(v0[0], v0[1]); o.y = pk2(v0[2], v0[3]); o.z = pk2(v1[0], v1[1]); o.w = pk2(v1[2], v1[3]);
            *(u4v*)(dst + (size_t)row * ld + bj * 128 + colu) = o;
          }
          ss = xor16_add(ss); ss = xor32_add(ss);
          if (fq == 0 && !dup) atomicAdd(ssq + row, ss);
        }
    } else if (pn < 8) {
      u16* dst = (u16*)(ws + ((pn < 6) ? OFF_SGA : OFF_SGB)) + (pn & 1) * 256;
#pragma unroll
      for (int ai = 0; ai < 2; ++ai)
#pragma unroll
        for (int m = 0; m < 4; ++m) {
          const int row = rowb + ai * 128 + m * 16;
#pragma unroll
          for (int bj = 0; bj < 2; ++bj) {
            const pg8::f32x4 v0 = acc[ai][bj][m][0], v1 = acc[ai][bj][m][1];
            u4v o; o.x = pk2(siluf_(v0[0]), siluf_(v0[1])); o.y = pk2(siluf_(v0[2]), siluf_(v0[3]));
            o.z = pk2(siluf_(v1[0]), siluf_(v1[1])); o.w = pk2(siluf_(v1[2]), siluf_(v1[3]));
            *(u4v*)(dst + (size_t)row * 512 + bj * 128 + colu) = o;
          }
        }
    } else if (pn >= 16) {
      if (pn < 22) {
        u16* dst = (u16*)(ws + ((pn < 18) ? OFF_HQ : (pn < 20) ? OFF_HF : OFF_HI)) + (pn & 1) * 256;
#pragma unroll
        for (int ai = 0; ai < 2; ++ai)
#pragma unroll
          for (int m = 0; m < 4; ++m) {
            const int row = rowb + ai * 128 + m * 16;
#pragma unroll
            for (int bj = 0; bj < 2; ++bj) {
              const pg8::f32x4 v0 = acc[ai][bj][m][0], v1 = acc[ai][bj][m][1];
              u4v o; o.x = pk2(v0[0], v0[1]); o.y = pk2(v0[2], v0[3]); o.z = pk2(v1[0], v1[1]); o.w = pk2(v1[2], v1[3]);
              *(u4v*)(dst + (size_t)row * 512 + bj * 128 + colu) = o;
            }
          }
      } else if (colu < 32) {
        float* dst = (float*)(ws + OFF_KPE);
#pragma unroll
        for (int ai = 0; ai < 2; ++ai)
#pragma unroll
          for (int m = 0; m < 4; ++m) {
            const int row = rowb + ai * 128 + m * 16;
            *(pg8::f32x4*)(dst + (size_t)row * 32 + colu) = acc[ai][0][m][0];
            *(pg8::f32x4*)(dst + (size_t)row * 32 + colu + 4) = acc[ai][0][m][1];
          }
      }
    } else {
      const int cb = (pn - 8) * 256 + colu;
      f4v b0[2], b1[2];
#pragma unroll
      for (int bj = 0; bj < 2; ++bj) { b0[bj] = *(const f4v*)(b_gate + cb + bj * 128); b1[bj] = *(const f4v*)(b_gate + cb + bj * 128 + 4); }
#pragma unroll
      for (int ai = 0; ai < 2; ++ai)
#pragma unroll
        for (int m = 0; m < 4; ++m) {
          const int row = rowb + ai * 128 + m * 16;
#pragma unroll
          for (int bj = 0; bj < 2; ++bj) {
            const pg8::f32x4 v0 = acc[ai][bj][m][0], v1 = acc[ai][bj][m][1];
            u4v o; o.x = pk2(sigmoidf_(v0[0] + b0[bj].x), sigmoidf_(v0[1] + b0[bj].y)); o.y = pk2(sigmoidf_(v0[2] + b0[bj].z), sigmoidf_(v0[3] + b0[bj].w));
            o.z = pk2(sigmoidf_(v1[0] + b1[bj].x), sigmoidf_(v1[1] + b1[bj].y)); o.w = pk2(sigmoidf_(v1[2] + b1[bj].z), sigmoidf_(v1[3] + b1[bj].w));
            *(u4v*)(mg + ((((size_t)(u.pm * 8 + (pn - 8)) * 8 + (wr * 4 + wc)) * 16 + (ai * 8 + m * 2 + bj)) * 64 + (fq * 16 + fr)) * 8) = o;
          }
        }
    }
  }
};


struct Epi6 {
  static constexpr bool PERM = true, AFTER_DRAIN = false;
  u16* out; float* ssq; bool dup;
  DI void operator()(const pg8::f32x4 (&acc)[2][2][4][2], const pg8::Unit& u, int wr, int wc, int fr, int fq) const {
    const int rowb = u.pm * 256 + wr * 64 + fr;
    const int colb = u.pn * 256 + wc * 32 + 8 * fq;
#pragma unroll
    for (int ai = 0; ai < 2; ++ai)
#pragma unroll
      for (int m = 0; m < 4; ++m) {
        const int row = rowb + ai * 128 + m * 16;
        float ss = 0.f;
#pragma unroll
        for (int bj = 0; bj < 2; ++bj) {
          const pg8::f32x4 v0 = acc[ai][bj][m][0], v1 = acc[ai][bj][m][1];
          ss += v0[0] * v0[0] + v0[1] * v0[1] + v0[2] * v0[2] + v0[3] * v0[3] + v1[0] * v1[0] + v1[1] * v1[1] + v1[2] * v1[2] + v1[3] * v1[3];
          u4v o; o.x = pk2(v0[0], v0[1]); o.y = pk2(v0[2], v0[3]); o.z = pk2(v1[0], v1[1]); o.w = pk2(v1[2], v1[3]);
          *(u4v*)(out + (size_t)row * 1024 + colb + bj * 128) = o;
        }
        ss = xor16_add(ss); ss = xor32_add(ss);
        if (fq == 0 && !dup) atomicAdd(ssq + row, ss);
      }
  }
};
template <bool SECOND> struct Epi5 {
  static constexpr bool PERM = true, AFTER_DRAIN = false;
  const u16* mg; u16* mi; u16* mo;
  DI void operator()(const pg8::f32x4 (&acc)[2][2][4][2], const pg8::Unit& u, int wr, int wc, int fr, int fq) const {
    const int rowb = u.pm * 256 + wr * 64 + fr;
    const int colb = u.pn * 256 + wc * 32 + 8 * fq;
    const size_t gbase = (((size_t)(u.pm * 8 + u.pn + (SECOND ? 4 : 0)) * 8 + (wr * 4 + wc)) * 16) * 64 + (fq * 16 + fr);
    const size_t ibase = (((size_t)(u.pm * 4 + u.pn) * 8 + (wr * 4 + wc)) * 16) * 64 + (fq * 16 + fr);
#pragma unroll
    for (int hb = 0; hb < 4; ++hb) {
      const int ai = hb >> 1, m0 = (hb & 1) * 2;
      u4v g[4], pm[4];
#pragma unroll
      for (int f4 = 0; f4 < 4; ++f4) {
        const int f = ai * 8 + (m0 + (f4 >> 1)) * 2 + (f4 & 1);
        g[f4] = *(const u4v*)(mg + (gbase + (size_t)f * 64) * 8);
        if (SECOND) pm[f4] = *(const u4v*)(mi + (ibase + (size_t)f * 64) * 8);
      }
#pragma unroll
      for (int f4 = 0; f4 < 4; ++f4) {
        const int m = m0 + (f4 >> 1), bj = f4 & 1;
        const int row = rowb + ai * 128 + m * 16;
        const pg8::f32x4 v0 = acc[ai][bj][m][0], v1 = acc[ai][bj][m][1];
        float r0 = v0[0] * bflo(g[f4].x), r1 = v0[1] * bfhi(g[f4].x), r2 = v0[2] * bflo(g[f4].y), r3 = v0[3] * bfhi(g[f4].y);
        float r4 = v1[0] * bflo(g[f4].z), r5 = v1[1] * bfhi(g[f4].z), r6 = v1[2] * bflo(g[f4].w), r7 = v1[3] * bfhi(g[f4].w);
        if (SECOND) {
          r0 += bflo(pm[f4].x); r1 += bfhi(pm[f4].x); r2 += bflo(pm[f4].y); r3 += bfhi(pm[f4].y);
          r4 += bflo(pm[f4].z); r5 += bfhi(pm[f4].z); r6 += bflo(pm[f4].w); r7 += bfhi(pm[f4].w);
        }
        u4v o; o.x = pk2(r0, r1); o.y = pk2(r2, r3); o.z = pk2(r4, r5); o.w = pk2(r6, r7);
        if (SECOND) *(u4v*)(mo + (size_t)row * 1024 + colb + bj * 128) = o;
        else *(u4v*)(mi + (ibase + (size_t)(ai * 8 + m * 2 + bj) * 64) * 8) = o;
      }
      __builtin_amdgcn_sched_barrier(0);
    }
  }
};
struct EpiQ {
  static constexpr bool PERM = true, AFTER_DRAIN = false;
  const float* ssq_q; const float* rope; u16* Qo;
  DI void operator()(const pg8::f32x4 (&acc)[2][2][4][2], const pg8::Unit& u, int wr, int wc, int fr, int fq) const {
    const int rowb = u.pm * 256 + wr * 64 + fr;
    const int colu = wc * 32 + 8 * fq;
    float sq[8];
#pragma unroll
    for (int i = 0; i < 8; ++i) sq[i] = ssq_q[rowb + (i >> 2) * 128 + (i & 3) * 16];
    if (u.pn < 2) {
#pragma unroll
      for (int ai = 0; ai < 2; ++ai)
#pragma unroll
        for (int m = 0; m < 4; ++m) {
          const int row = rowb + ai * 128 + m * 16;
          const int b = row >> 12, spos = row & 4095;
          const float sc = rsqrtf(sq[ai * 4 + m] * (1.f / 768.f) + EPS) * QSCALE;
#pragma unroll
          for (int bj = 0; bj < 2; ++bj) {
            const pg8::f32x4 v0 = acc[ai][bj][m][0], v1 = acc[ai][bj][m][1];
            const int head = u.pn * 4 + bj * 2 + (colu >> 6), d = colu & 63;
            u4v o; o.x = pk2(v0[0] * sc, v0[1] * sc); o.y = pk2(v0[2] * sc, v0[3] * sc); o.z = pk2(v1[0] * sc, v1[1] * sc); o.w = pk2(v1[2] * sc, v1[3] * sc);
            *(u4v*)(Qo + ((size_t)(b * 8 + head) * 4096 + spos) * 96 + d) = o;
          }
        }
    } else {
#pragma unroll
      for (int ai = 0; ai < 2; ++ai) {
        f4v cs[4], sn[4];
#pragma unroll
        for (int i = 0; i < 4; ++i) {
          const int spos = (rowb + ai * 128 + i * 16) & 4095;
          cs[i] = *(const f4v*)(rope + spos * 16 + 4 * fq); sn[i] = *(const f4v*)(rope + 65536 + spos * 16 + 4 * fq);
        }
#pragma unroll
        for (int m = 0; m < 4; ++m) {
          const int row = rowb + ai * 128 + m * 16;
          const int b = row >> 12, spos = row & 4095;
          const float sc = rsqrtf(sq[ai * 4 + m] * (1.f / 768.f) + EPS) * QSCALE;
          const f4v c4 = cs[m], s4 = sn[m];
#pragma unroll
          for (int bj = 0; bj < 2; ++bj) {
            const pg8::f32x4 v0 = acc[ai][bj][m][0], v1 = acc[ai][bj][m][1];
            const int head = bj * 4 + wc;
            u2v o1, o2;
            o1.x = pk2((v0[0] * c4.x - v1[0] * s4.x) * sc, (v0[1] * c4.y - v1[1] * s4.y) * sc);
            o1.y = pk2((v0[2] * c4.z - v1[2] * s4.z) * sc, (v0[3] * c4.w - v1[3] * s4.w) * sc);
            o2.x = pk2((v0[0] * s4.x + v1[0] * c4.x) * sc, (v0[1] * s4.y + v1[1] * c4.y) * sc);
            o2.y = pk2((v0[2] * s4.z + v1[2] * c4.z) * sc, (v0[3] * s4.w + v1[3] * c4.w) * sc);
            u16* qp = Qo + ((size_t)(b * 8 + head) * 4096 + spos) * 96 + 64 + 4 * fq;
            *(u2v*)qp = o1; *(u2v*)(qp + 16) = o2;
          }
        }
        __builtin_amdgcn_sched_barrier(0);
      }
    }
  }
};

struct EpiK {
  static constexpr bool PERM = true, AFTER_DRAIN = false;
  const float* ssq_kv; u16* Ko;
  DI void operator()(const pg8::f32x4 (&acc)[2][2][4][2], const pg8::Unit& u, int wr, int wc, int fr, int fq) const {
    const int rowb = u.pm * 256 + wr * 64 + fr;
    float sq[8];
#pragma unroll
    for (int i = 0; i < 8; ++i) sq[i] = ssq_kv[rowb + (i >> 2) * 128 + (i & 3) * 16];
#pragma unroll
    for (int ai = 0; ai < 2; ++ai)
#pragma unroll
      for (int m = 0; m < 4; ++m) {
        const int row = rowb + ai * 128 + m * 16;
        const int b = row >> 12, spos = row & 4095;
        const float sc = rsqrtf(sq[ai * 4 + m] * (1.f / 256.f) + EPS);
#pragma unroll
        for (int bj = 0; bj < 2; ++bj) {
          const pg8::f32x4 v0 = acc[ai][bj][m][0], v1 = acc[ai][bj][m][1];
          const int col = u.pn * 256 + bj * 128 + wc * 32 + 8 * fq;
          const int head = col >> 6, d = col & 63;
          u4v o; o.x = pk2(v0[0] * sc, v0[1] * sc); o.y = pk2(v0[2] * sc, v0[3] * sc); o.z = pk2(v1[0] * sc, v1[1] * sc); o.w = pk2(v1[2] * sc, v1[3] * sc);
          *(u4v*)(Ko + ((size_t)(b * 8 + head) * 4096 + spos) * 96 + d) = o;
        }
      }
  }
};
struct EpiV {
  static constexpr bool PERM = false, AFTER_DRAIN = false;
  const float* ssq_kv; u16* Vo;
  DI void operator()(const pg8::f32x4 (&acc)[2][2][4][2], const pg8::Unit& u, int wr, int wc, int fr, int fq) const {
    f4v sq[8];
#pragma unroll
    for (int i = 0; i < 8; ++i) sq[i] = *(const f4v*)(ssq_kv + u.pm * 256 + (i >> 2) * 128 + wr * 64 + (i & 3) * 16 + 4 * fq);
#pragma unroll
    for (int ai = 0; ai < 2; ++ai)
#pragma unroll
      for (int m = 0; m < 4; ++m) {
        const int row4 = u.pm * 256 + ai * 128 + wr * 64 + m * 16 + 4 * fq;
        const int b = row4 >> 12, spos = row4 & 4095;
        const f4v q = sq[ai * 4 + m];
        const float s0 = rsqrtf(q.x * (1.f / 256.f) + EPS), s1 = rsqrtf(q.y * (1.f / 256.f) + EPS), s2 = rsqrtf(q.z * (1.f / 256.f) + EPS), s3 = rsqrtf(q.w * (1.f / 256.f) + EPS);
#pragma unroll
        for (int bj = 0; bj < 2; ++bj)
#pragma unroll
          for (int n = 0; n < 2; ++n) {
            const pg8::f32x4 v = acc[ai][bj][m][n];
            const int col = u.pn * 256 + bj * 128 + wc * 32 + n * 16 + fr;
            const int head = col >> 6, dv = col & 63;
            u2v o; o.x = pk2(v[0] * s0, v[1] * s1); o.y = pk2(v[2] * s2, v[3] * s3);
            *(u2v*)(Vo + ((size_t)(b * 8 + head) * 64 + dv) * 4096 + spos) = o;
          }
        __builtin_amdgcn_sched_barrier(0);
      }
  }
};
DI void phase1(const Params& p, unsigned char* smem, bool dup = false) {
  unsigned char* ws = p.ws;
  pg8::Gemm g{(const u16*)(ws + OFF_H), (const u16*)(ws + OFF_WIN), T, NP, 1024};
  pg8::StaticOrder S; S.init(T, NP, (int)gridDim.x, (int)blockIdx.x);
  Epi1 E{ws, (u16*)p.out, p.b_gate, dup};
  pg8::gemm_phase<Epi1, pg8::StaticOrder, false>((PG8_LAS unsigned char*)smem, g, S, E, nullptr);
  const int nlight = (int)gridDim.x / 2;
  if (!dup && (int)blockIdx.x >= (int)gridDim.x - nlight) {
    const int gtid = ((int)blockIdx.x - ((int)gridDim.x - nlight)) * (int)blockDim.x + (int)threadIdx.x, gthreads = nlight * (int)blockDim.x;
    conv_weight<1>((u16*)(ws + OFF_WUQ), p.w_uq, 768, 768, 768, p.g_q, 1023, gtid, gthreads);
    conv_weight<3>((u16*)(ws + OFF_WUKV), p.w_ukv, 1024, 1024, 256, p.g_kv, 255, gtid, gthreads);
    conv_weight<2>((u16*)(ws + OFF_WA), p.w_a, 1024, 1024, 512, nullptr, 0, gtid, gthreads);
    conv_weight<2>((u16*)(ws + OFF_WB), p.w_b, 1024, 1024, 512, p.g_hgrn, 63, gtid, gthreads);
    conv_weight<2>((u16*)(ws + OFF_WO), p.w_out, 1024, 1024, 1024, nullptr, 0, gtid, gthreads);
  }
}

DI void hgrn_prep_tile(const Params& p, float* stage, int tid, int b, int hh, int prow0, int nblk0) {
  unsigned char* ws = p.ws;
  const int bh = b * 8 + hh;
  if (tid < 128) {
    const int c = tid & 63, blk = tid >> 6;
    const float l0 = p.lb_logits[hh * 64 + c], l1 = p.lb_logits[512 + hh * 64 + c];
    const float lbv = 1.f / (1.f + expf(l1 - l0));
    float cum = 0.f;
    for (int rr = 0; rr < 32; ++rr) {
      float* sp = stage + (blk * 32 + rr) * SST + c;
      const float q = sp[0], hf = sp[64];
      const float sg = 1.f / (1.f + expf(-hf));
      const float f = lbv + (1.f - lbv) * sg;
      cum += logf(f);
      const float e = expf(cum);
      sp[0] = q * e;
      sp[64] = (1.f - f) / e;
    }
    ((float*)(ws + OFF_DECAY))[((size_t)bh * 128 + nblk0 + blk) * 64 + c] = expf(cum);
  }
  __syncthreads();
#pragma unroll
  for (int it = 0; it < 2; ++it) {
    const int item = tid + 256 * it, rr = item >> 3, cc = (item & 7) * 8;
    const f4v a = *(const f4v*)(stage + rr * SST + cc), c = *(const f4v*)(stage + rr * SST + cc + 4);
    const f4v d = *(const f4v*)(stage + rr * SST + 64 + cc), e = *(const f4v*)(stage + rr * SST + 64 + cc + 4);
    const size_t o = (size_t)(prow0 + rr) * 512 + hh * 64 + cc;
    *(u4v*)((u16*)(ws + OFF_QDEC) + o) = pk8(a, c);
    *(u4v*)((u16*)(ws + OFF_KINV) + o) = pk8(d, e);
  }
}
DI void hi_vt_tile(const Params& p, float* stage, int tid, int b, int q2, int nblk0) {
  unsigned char* ws = p.ws;
#pragma unroll
        for (int it = 0; it < 4; ++it) {
          const int item = tid + 256 * it, sc = item & 3, col = (item >> 2) & 127, blk = item >> 9;
          float v[8];
#pragma unroll
          for (int i = 0; i < 8; ++i) v[i] = stage[(blk * 32 + sc * 8 + i) * SST + col];
          u4v o; o.x = pk2(v[0], v[1]); o.y = pk2(v[2], v[3]); o.z = pk2(v[4], v[5]); o.w = pk2(v[6], v[7]);
          const int bh = b * 8 + q2 * 2 + (col >> 6);
          *(u4v*)((u16*)(ws + OFF_VT) + (((size_t)bh * 128 + nblk0 + blk) * 64 + (col & 63)) * 32 + sc * 8) = o;
        }
}
DI void stage_load64(float* stage, const u16* src, int coff, int tid) {
#pragma unroll
  for (int it = 0; it < 2; ++it) {
    const int item = tid + 256 * it, rr = item >> 3, ch = item & 7;
    const u4v v = *(const u4v*)(src + (size_t)rr * 512 + ch * 8);
    float* d = stage + rr * SST + coff + ch * 8;
    *(f4v*)d = f4v{bflo(v.x), bfhi(v.x), bflo(v.y), bfhi(v.y)};
    *(f4v*)(d + 4) = f4v{bflo(v.z), bfhi(v.z), bflo(v.w), bfhi(v.w)};
  }
}


constexpr int PST = 68;
DI void hgrn_prep_native(const Params& p, float* pl, int rb, int hh) {
  unsigned char* ws = p.ws;
  const int tid = threadIdx.x;
  float* Qp = pl; float* G = pl + 128 * PST; float* Kn = pl + 2 * 128 * PST;
  const int prow0 = rb * 128, b = prow0 >> 12, bh = b * 8 + hh, nblk0 = (prow0 & 4095) >> 5;
  const int ch = tid & 7;
  float lbv[8];
  {
    const f4v a0 = *(const f4v*)(p.lb_logits + hh * 64 + ch * 8), a1 = *(const f4v*)(p.lb_logits + hh * 64 + ch * 8 + 4);
    const f4v b0 = *(const f4v*)(p.lb_logits + 512 + hh * 64 + ch * 8), b1 = *(const f4v*)(p.lb_logits + 512 + hh * 64 + ch * 8 + 4);
    const float l0[8] = {a0.x, a0.y, a0.z, a0.w, a1.x, a1.y, a1.z, a1.w}, l1[8] = {b0.x, b0.y, b0.z, b0.w, b1.x, b1.y, b1.z, b1.w};
#pragma unroll
    for (int i = 0; i < 8; ++i) lbv[i] = 1.f / (1.f + expf(l1[i] - l0[i]));
  }
  __syncthreads();
#pragma unroll
  for (int it = 0; it < 2; ++it) {
    const int rr = (tid + 512 * it) >> 3;
    const size_t go = (size_t)(prow0 + rr) * 512 + hh * 64 + ch * 8;
    const u4v qv = *(const u4v*)((const u16*)(ws + OFF_HQ) + go), fv = *(const u4v*)((const u16*)(ws + OFF_HF) + go);
    const float q[8] = {bflo(qv.x), bfhi(qv.x), bflo(qv.y), bfhi(qv.y), bflo(qv.z), bfhi(qv.z), bflo(qv.w), bfhi(qv.w)};
    const float hf[8] = {bflo(fv.x), bfhi(fv.x), bflo(fv.y), bfhi(fv.y), bflo(fv.z), bfhi(fv.z), bflo(fv.w), bfhi(fv.w)};
    float g[8], kn[8];
#pragma unroll
    for (int i = 0; i < 8; ++i) {
      const float sg = rcpf(1.f + __builtin_amdgcn_exp2f(-1.4426950408889634f * hf[i]));
      const float f = lbv[i] + (1.f - lbv[i]) * sg;
      g[i] = __builtin_amdgcn_logf(f);
      kn[i] = 1.f - f;
    }
    float* d = Qp + rr * PST + ch * 8;
    *(f4v*)d = f4v{q[0], q[1], q[2], q[3]}; *(f4v*)(d + 4) = f4v{q[4], q[5], q[6], q[7]};
    d = G + rr * PST + ch * 8;
    *(f4v*)d = f4v{g[0], g[1], g[2], g[3]}; *(f4v*)(d + 4) = f4v{g[4], g[5], g[6], g[7]};
    d = Kn + rr * PST + ch * 8;
    *(f4v*)d = f4v{kn[0], kn[1], kn[2], kn[3]}; *(f4v*)(d + 4) = f4v{kn[4], kn[5], kn[6], kn[7]};
  }
  __syncthreads();
  if (tid < 256) {
    const int c = tid & 63, blk = tid >> 6;
    float* gp = G + (blk * 32) * PST + c;
    float v[32];
#pragma unroll
    for (int r2 = 0; r2 < 32; ++r2) v[r2] = gp[r2 * PST];
    float cum = 0.f;
#pragma unroll
    for (int r2 = 0; r2 < 32; ++r2) { cum += v[r2]; gp[r2 * PST] = cum; }
    ((float*)(ws + OFF_DECAY))[((size_t)bh * 128 + nblk0 + blk) * 64 + c] = __builtin_amdgcn_exp2f(cum);
  }
  __syncthreads();
#pragma unroll
  for (int it = 0; it < 2; ++it) {
    const int rr = (tid + 512 * it) >> 3;
    const float* s0 = Qp + rr * PST + ch * 8; const float* s1 = G + rr * PST + ch * 8; const float* s2 = Kn + rr * PST + ch * 8;
    const f4v q0 = *(const f4v*)s0, q1 = *(const f4v*)(s0 + 4), c0 = *(const f4v*)s1, c1 = *(const f4v*)(s1 + 4), k0 = *(const f4v*)s2, k1 = *(const f4v*)(s2 + 4);
    const float q[8] = {q0.x, q0.y, q0.z, q0.w, q1.x, q1.y, q1.z, q1.w}, cm[8] = {c0.x, c0.y, c0.z, c0.w, c1.x, c1.y, c1.z, c1.w}, kn[8] = {k0.x, k0.y, k0.z, k0.w, k1.x, k1.y, k1.z, k1.w};
    float qd[8], ki[8];
#pragma unroll
    for (int i = 0; i < 8; ++i) { qd[i] = q[i] * __builtin_amdgcn_exp2f(cm[i]); ki[i] = kn[i] * __builtin_amdgcn_exp2f(-cm[i]); }
    const size_t go = (size_t)(prow0 + rr) * 512 + hh * 64 + ch * 8;
    u4v o; o.x = pk2(qd[0], qd[1]); o.y = pk2(qd[2], qd[3]); o.z = pk2(qd[4], qd[5]); o.w = pk2(qd[6], qd[7]);
    *(u4v*)((u16*)(ws + OFF_QDEC) + go) = o;
    o.x = pk2(ki[0], ki[1]); o.y = pk2(ki[2], ki[3]); o.z = pk2(ki[4], ki[5]); o.w = pk2(ki[6], ki[7]);
    *(u4v*)((u16*)(ws + OFF_KINV) + go) = o;
  }
}
constexpr int VTS = 136;
DI void hi_vt_native(const Params& p, u16* img, int rb, int q2) {
  unsigned char* ws = p.ws;
  const int tid = threadIdx.x;
  const int prow0 = rb * 128, b = prow0 >> 12, nblk0 = (prow0 & 4095) >> 5;
  __syncthreads();
#pragma unroll
  for (int it = 0; it < 4; ++it) {
    const int item = tid + 512 * it, rr = item >> 4, c16 = item & 15;
    *(u4v*)(img + rr * VTS + c16 * 8) = *(const u4v*)((const u16*)(ws + OFF_HI) + (size_t)(prow0 + rr) * 512 + q2 * 128 + c16 * 8);
  }
  __syncthreads();
#pragma unroll
  for (int it = 0; it < 4; ++it) {
    const int item = tid + 512 * it, sc = item & 3, col = (item >> 2) & 127, blk = item >> 9;
    u32 w[4];
#pragma unroll
    for (int i = 0; i < 4; ++i) {
      const u32 lo = img[(blk * 32 + sc * 8 + 2 * i) * VTS + col], hi = img[(blk * 32 + sc * 8 + 2 * i + 1) * VTS + col];
      w[i] = lo | (hi << 16);
    }
    const int bh = b * 8 + q2 * 2 + (col >> 6);
    *(u4v*)((u16*)(ws + OFF_VT) + (((size_t)bh * 128 + nblk0 + blk) * 64 + (col & 63)) * 32 + sc * 8) = u4v{w[0], w[1], w[2], w[3]};
  }
}

DI void rope8(const float* x1, const float* x2, const float* rope, int spos, int j0, bool first, float scale, float (&o)[8]) {
  const f4v c0 = *(const f4v*)(rope + spos * 16 + j0), c1 = *(const f4v*)(rope + spos * 16 + j0 + 4);
  const f4v s0 = *(const f4v*)(rope + 65536 + spos * 16 + j0), s1 = *(const f4v*)(rope + 65536 + spos * 16 + j0 + 4);
  const float cs[8] = {c0.x, c0.y, c0.z, c0.w, c1.x, c1.y, c1.z, c1.w};
  const float sn[8] = {s0.x, s0.y, s0.z, s0.w, s1.x, s1.y, s1.z, s1.w};
#pragma unroll
  for (int i = 0; i < 8; ++i) o[i] = scale * (first ? (x1[i] * cs[i] - x2[i] * sn[i]) : (x1[i] * sn[i] + x2[i] * cs[i]));
}

DI void phase2(const Params& p, unsigned char* smem, u16* lds) {
  unsigned char* ws = p.ws;
  const int tid = VTID;
  float* stage = (float*)lds;
  const float* ssq_q = (const float*)(ws + OFF_SSQ);
  const float* ssq_kv = ssq_q + T;
  const float* rope = (const float*)(ws + OFF_ROPE);
  u16* Qo = (u16*)(ws + OFF_Q);
  u16* Ko = (u16*)(ws + OFF_K);
  u16* Vo = (u16*)(ws + OFF_VTT);
#pragma nounroll
  for (int rep = 0; rep < (DUP_PH == 21 ? p.ph_hi - 7 : 1); ++rep) {
    pg8::Gemm g{(const u16*)(ws + OFF_CQ), (const u16*)(ws + OFF_WUQ), T, 768, 768};
    pg8::StaticOrder S; S.init(T, 768, (int)gridDim.x, (int)blockIdx.x);
    EpiQ E{ssq_q, rope, Qo};
    pg8::gemm_phase<EpiQ, pg8::StaticOrder, false>((PG8_LAS unsigned char*)smem, g, S, E, nullptr);
  }
#pragma nounroll
  for (int rep = 0; rep < (DUP_PH == 23 ? p.ph_hi - 7 : 1); ++rep) {
    pg8::StaticOrder S; S.init(T, 512, (int)gridDim.x, (int)blockIdx.x);
    {
      int kk = 256; asm volatile("" : "+s"(kk));
      pg8::Gemm g{(const u16*)(ws + OFF_CKV), (const u16*)(ws + OFF_WUKV), T, 512, kk};
      EpiK E{ssq_kv, Ko};
      pg8::gemm_phase<EpiK, pg8::StaticOrder, false>((PG8_LAS unsigned char*)smem, g, S, E, nullptr);
    }
  }
#pragma nounroll
  for (int rep = 0; rep < (DUP_PH == 22 ? p.ph_hi - 7 : 1); ++rep) {
    const int gtid = blockIdx.x * blockDim.x + threadIdx.x, gthreads = gridDim.x * blockDim.x;
    for (int idx = gtid; idx < T * 4; idx += gthreads) {
      const int tok = idx >> 2, wv = (idx & 3) * 8, j0 = wv & 15;
      const int b = tok >> 12, spos = tok & 4095;
      const float* kp = (const float*)(ws + OFF_KPE) + (size_t)tok * 32;
      const f4v a0 = *(const f4v*)(kp + j0), a1 = *(const f4v*)(kp + j0 + 4);
      const f4v b0 = *(const f4v*)(kp + 16 + j0), b1 = *(const f4v*)(kp + 16 + j0 + 4);
      const float x1[8] = {a0.x, a0.y, a0.z, a0.w, a1.x, a1.y, a1.z, a1.w};
      const float x2[8] = {b0.x, b0.y, b0.z, b0.w, b1.x, b1.y, b1.z, b1.w};
      float o[8];
      rope8(x1, x2, rope, spos, j0, wv < 16, 1.f, o);
      u4v ov; ov.x = pk2(o[0], o[1]); ov.y = pk2(o[2], o[3]); ov.z = pk2(o[4], o[5]); ov.w = pk2(o[6], o[7]);
#pragma unroll
      for (int head = 0; head < 8; ++head) *(u4v*)(Ko + ((size_t)(b * 8 + head) * 4096 + spos) * 96 + 64 + wv) = ov;
    }
  }
  for (int rep = 0; rep < (DUP_PH == 20 ? 2 : 1); ++rep)
  {
    const int G = (int)gridDim.x, c = (int)blockIdx.x, hG = G / 2, round = 2 * G + hG;
    for (int base = 0; base < 2048 + 1024; base += round) {
#pragma unroll 1
      for (int k = 0; k < 3; ++k) {
        if (k == 2 && c < G - hG) break;
        const int t = base + (k == 0 ? c : k == 1 ? G + c : 2 * G + (c - (G - hG)));
        if (t >= 2048 + 1024) break;
        if (t < 2048) hgrn_prep_native(p, (float*)smem, t >> 3, t & 7);
        else hi_vt_native(p, (u16*)smem, (t - 2048) >> 2, (t - 2048) & 3);
      }
    }
  }
}

DI void phase2b(const Params& p, unsigned char* smem) {
  unsigned char* ws = p.ws;
  const int tid = VTID;
  {
    pg8::StaticOrder S; S.init(T, 512, (int)gridDim.x, (int)blockIdx.x);
    int kk = 256; asm volatile("" : "+s"(kk));
    pg8::Gemm g{(const u16*)(ws + OFF_CKV), (const u16*)(ws + OFF_WUKV) + (size_t)512 * 256, T, 512, kk};
    EpiV E{(const float*)(ws + OFF_SSQ) + T, (u16*)(ws + OFF_VTT)};
    pg8::gemm_phase<EpiV, pg8::StaticOrder, false, true>((PG8_LAS unsigned char*)smem, g, S, E, nullptr);
  }
}

constexpr int KST2 = 104, VST2 = 132;
constexpr int ATT_BUF2 = 128 * KST2 + 64 * VST2;
DI void att_qk(const u16* sk, const bf16x8 (&qf)[6], float nm, f32x16 (&st)[2]) {
#pragma unroll
  for (int i = 0; i < 16; ++i) { st[0][i] = nm; st[1][i] = nm; }
#pragma unroll
  for (int kb = 0; kb < 2; ++kb)
#pragma unroll
    for (int ks = 0; ks < 6; ++ks) {
      const bf16x8 kf = *(const bf16x8*)(sk + kb * 32 * KST2 + ks * 16);
      st[kb] = MFMA(kf, qf[ks], st[kb]);
    }
}
DI float att_softmax(f32x16 (&st)[2], float adj, bool adjnz, bool first, float& mref, float& l, f32x16 (&o)[2]) {
  float mx = st[0][0];
#pragma unroll
  for (int i = 1; i < 16; ++i) mx = fmaxf(mx, st[0][i]);
#pragma unroll
  for (int i = 0; i < 16; ++i) mx = fmaxf(mx, st[1][i]);
  mx = xor32_max(mx) - adj;
  f2v ps = f2v{0.f, 0.f};
  float shift_out = 0.f;
  if (first || adjnz || __builtin_amdgcn_ballot_w64(mx > 8.f) != 0ull) {
    const float shift = first ? mx : fmaxf(mx, 0.f);
    const float tot = adj + shift;
    const float alpha = first ? 0.f : __builtin_amdgcn_exp2f(-shift);
    mref += shift;
#pragma unroll
    for (int kb = 0; kb < 2; ++kb)
#pragma unroll
      for (int i = 0; i < 16; i += 2) {
        const float p0 = __builtin_amdgcn_exp2f(st[kb][i] - tot), p1 = __builtin_amdgcn_exp2f(st[kb][i + 1] - tot);
        st[kb][i] = p0; st[kb][i + 1] = p1; ps += f2v{p0, p1};
      }
    l = l * alpha + (ps.x + ps.y);
#pragma unroll
    for (int i = 0; i < 16; ++i) { o[0][i] *= alpha; o[1][i] *= alpha; }
    shift_out = shift;
  } else {
#pragma unroll
    for (int kb = 0; kb < 2; ++kb)
#pragma unroll
      for (int i = 0; i < 16; i += 2) {
        const float p0 = __builtin_amdgcn_exp2f(st[kb][i]), p1 = __builtin_amdgcn_exp2f(st[kb][i + 1]);
        st[kb][i] = p0; st[kb][i + 1] = p1; ps += f2v{p0, p1};
      }
    l += ps.x + ps.y;
  }
  return shift_out;
}
DI void att_pv(const u16* sv, const f32x16 (&st)[2], f32x16 (&o)[2]) {
#pragma unroll
  for (int s4 = 0; s4 < 4; ++s4) {
    const int kb = s4 >> 1, rb = 8 * (s4 & 1);
    u4v pu; pu.x = pk2(st[kb][rb], st[kb][rb + 1]); pu.y = pk2(st[kb][rb + 2], st[kb][rb + 3]);
    pu.z = pk2(st[kb][rb + 4], st[kb][rb + 5]); pu.w = pk2(st[kb][rb + 6], st[kb][rb + 7]);
    const bf16x8 pb = __builtin_bit_cast(bf16x8, pu);
#pragma unroll
    for (int db = 0; db < 2; ++db) {
      const s16x4 lo = *(const s16x4*)(sv + db * 32 * VST2 + 16 * s4);
      const s16x4 hi = *(const s16x4*)(sv + db * 32 * VST2 + 16 * s4 + 8);
      const bf16x8 vf = __builtin_shufflevector(lo, hi, 0, 1, 2, 3, 4, 5, 6, 7);
      o[db] = MFMA(vf, pb, o[db]);
    }
  }
}
DI void attn8_item(const Params& p, u16* lds, int bh, int qt) {
  unsigned char* ws = p.ws;
  const int tid = threadIdx.x, lane = tid & 63, w = tid >> 6, r = lane & 31, h = lane >> 5;
  const u16* Qp = (const u16*)(ws + OFF_Q) + (size_t)bh * 4096 * 96;
  const u16* Kp = (const u16*)(ws + OFF_K) + (size_t)bh * 4096 * 96;
  const u16* Vp = (const u16*)(ws + OFF_VTT) + (size_t)bh * 64 * 4096;
  const int q0 = qt * 256 + w * 32;
  bf16x8 qf[6];
#pragma unroll
  for (int ks = 0; ks < 6; ++ks) qf[ks] = *(const bf16x8*)(Qp + (size_t)(q0 + r) * 96 + ks * 16 + h * 8);
  f32x16 o[2]; o[0] = zero16(); o[1] = zero16();
  float mref = 0.f, l = 0.f;
  const int Jmax = 2 * qt + 1, jw = 4 * qt + (w >> 1);
  int kr[3], kc[3];
#pragma unroll
  for (int i = 0; i < 3; ++i) { const int idx = tid + 512 * i; kr[i] = idx / 12; kc[i] = idx % 12; }
  const int vr = tid >> 4, vc = tid & 15;
  u4v rk[3], rv[2];
#pragma unroll
  for (int i = 0; i < 3; ++i) rk[i] = *(const u4v*)(Kp + (size_t)kr[i] * 96 + kc[i] * 8);
#pragma unroll
  for (int i = 0; i < 2; ++i) rv[i] = *(const u4v*)(Vp + (size_t)(vr + 32 * i) * 4096 + vc * 8);
  __syncthreads();
#pragma unroll
  for (int i = 0; i < 3; ++i) *(u4v*)(lds + kr[i] * KST2 + kc[i] * 8) = rk[i];
#pragma unroll
  for (int i = 0; i < 2; ++i) { u16* dv = lds + 128 * KST2 + (vr + 32 * i) * VST2 + vc * 8; *(u2v*)dv = u2v{rv[i].x, rv[i].y}; *(u2v*)(dv + 4) = u2v{rv[i].z, rv[i].w}; }
  __syncthreads();
  for (int J = 0; J <= Jmax; ++J) {
    const int cur = J & 1;
    if (J < Jmax) {
#pragma unroll
      for (int i = 0; i < 3; ++i) rk[i] = *(const u4v*)(Kp + (size_t)((J + 1) * 128 + kr[i]) * 96 + kc[i] * 8);
#pragma unroll
      for (int i = 0; i < 2; ++i) rv[i] = *(const u4v*)(Vp + (size_t)(vr + 32 * i) * 4096 + (J + 1) * 128 + vc * 8);
    }
    const u16* sk = lds + cur * ATT_BUF2 + r * KST2 + h * 8;
    const u16* sv = lds + cur * ATT_BUF2 + 128 * KST2 + r * VST2 + 4 * h;
    if (2 * J + 1 <= jw) {
      f32x16 s0[2], s1[2];
      const float nm = -mref;
      att_qk(sk, qf, nm, s0);
      att_qk(sk + 64 * KST2, qf, nm, s1);
      const float sh = att_softmax(s0, 0.f, false, J == 0, mref, l, o);
      const bool adjnz = __builtin_amdgcn_ballot_w64(sh != 0.f) != 0ull;
      att_pv(sv, s0, o);
      att_softmax(s1, sh, adjnz, false, mref, l, o);
      att_pv(sv + 64, s1, o);
    } else if (2 * J <= jw) {
      f32x16 s0[2];
      att_qk(sk, qf, -mref, s0);
      att_softmax(s0, 0.f, false, J == 0, mref, l, o);
      att_pv(sv, s0, o);
    }
    if (J < Jmax) {
      u16* d = lds + (cur ^ 1) * ATT_BUF2;
#pragma unroll
      for (int i = 0; i < 3; ++i) *(u4v*)(d + kr[i] * KST2 + kc[i] * 8) = rk[i];
#pragma unroll
      for (int i = 0; i < 2; ++i) { u16* dv = d + 128 * KST2 + (vr + 32 * i) * VST2 + vc * 8; *(u2v*)dv = u2v{rv[i].x, rv[i].y}; *(u2v*)(dv + 4) = u2v{rv[i].z, rv[i].w}; }
    }
    __syncthreads();
  }
  l = xor32_add(l);
  const float inv = 1.f / l;
  const int b = bh >> 3, head = bh & 7;
  const size_t tok = (size_t)b * 4096 + q0 + r;
  const u16* sga = (const u16*)(ws + OFF_SGA) + tok * 512 + head * 64;
  u16* ya = (u16*)(ws + OFF_YA) + tok * 512 + head * 64;
#pragma unroll
  for (int db = 0; db < 2; ++db)
#pragma unroll
    for (int g = 0; g < 4; ++g) {
      const int dv0 = db * 32 + 8 * g + 4 * h;
      const u2v gt = *(const u2v*)(sga + dv0);
      u2v ov;
      ov.x = pk2(o[db][4 * g] * inv * bflo(gt.x), o[db][4 * g + 1] * inv * bfhi(gt.x));
      ov.y = pk2(o[db][4 * g + 2] * inv * bflo(gt.y), o[db][4 * g + 3] * inv * bfhi(gt.y));
      *(u2v*)(ya + dv0) = ov;
    }
}

DI void scan_item(const Params& p, int i, size_t out_off = OFF_UPD) {
  unsigned char* ws = p.ws;
  const int tid = threadIdx.x;
  const int bh = i >> 2, part = i & 3;
  const int e = part * 1024 + tid * 2, k = e & 63;
  u32* U = (u32*)((u16*)(ws + OFF_UPD) + (size_t)bh * 128 * 4096 + e);
  u32* UO = (u32*)((u16*)(ws + out_off) + (size_t)bh * 128 * 4096 + e);
  const f2v* Dc = (const f2v*)((const float*)(ws + OFF_DECAY) + (size_t)bh * 128 * 64 + k);
  float s0 = 0.f, s1 = 0.f;
  for (int n0 = 0; n0 < 128; n0 += 32) {
    u32 u[32]; f2v d[32];
#pragma unroll
    for (int q = 0; q < 32; ++q) { u[q] = U[(size_t)(n0 + q) * 2048]; d[q] = Dc[(n0 + q) * 32]; }
#pragma unroll
    for (int q = 0; q < 32; ++q) {
      UO[(size_t)(n0 + q) * 2048] = pk2(s0, s1);
      s0 = d[q].x * (s0 + bflo(u[q]));
      s1 = d[q].y * (s1 + bfhi(u[q]));
    }
  }
}

DI void hgrn_state_item(const Params& p, float* ub, int bh, int vb) {
  unsigned char* ws = p.ws;
  const int tid = threadIdx.x, lane = tid & 63, w = tid >> 6, r = lane & 31, h = lane >> 5;
  const int b = bh >> 3, head = bh & 7;
  const u16* kn_base = (const u16*)(ws + OFF_KINV) + ((size_t)b * 4096) * 512 + head * 64;
  const u16* vt_base = (const u16*)(ws + OFF_VT) + ((size_t)bh * 128) * 64 * 32;
  const float* dec = (const float*)(ws + OFF_DECAY) + (size_t)bh * 128 * 64;
  u16* up = (u16*)(ws + OFF_UPD) + (size_t)bh * 128 * 4096;
  const int vl = tid >> 4, k0 = (tid & 15) * 4;
  constexpr int KS = 68;
  f4v st = f4v{0.f, 0.f, 0.f, 0.f};
#pragma unroll 1
  for (int i = 0; i < 16; ++i) {
    const int n = i * 8 + w;
    bf16x8 a[2][2], bb[2];
    const u16* kn = kn_base + (size_t)(n * 32) * 512;
#pragma unroll
    for (int kb = 0; kb < 2; ++kb)
#pragma unroll
      for (int ks = 0; ks < 2; ++ks) {
        bf16x8 av;
#pragma unroll
        for (int j = 0; j < 8; ++j) av[j] = (short)kn[(size_t)(ks * 16 + h * 8 + j) * 512 + kb * 32 + r];
        a[kb][ks] = av;
      }
#pragma unroll
    for (int ks = 0; ks < 2; ++ks) bb[ks] = *(const bf16x8*)(vt_base + ((size_t)n * 64 + vb * 32 + r) * 32 + ks * 16 + h * 8);
    f4v d[8];
#pragma unroll
    for (int j = 0; j < 8; ++j) d[j] = *(const f4v*)(dec + (size_t)(i * 8 + j) * 64 + k0);
    __syncthreads();
#pragma unroll
    for (int kb = 0; kb < 2; ++kb) {
      f32x16 c = zero16();
      c = MFMA(a[kb][0], bb[0], c);
      c = MFMA(a[kb][1], bb[1], c);
#pragma unroll
      for (int g = 0; g < 4; ++g) *(f4v*)(ub + (w * 32 + r) * KS + kb * 32 + 8 * g + 4 * h) = f4v{c[4 * g], c[4 * g + 1], c[4 * g + 2], c[4 * g + 3]};
    }
    __syncthreads();
#pragma unroll
    for (int j = 0; j < 8; ++j) {
      const f4v u = *(const f4v*)(ub + (j * 32 + vl) * KS + k0);
      u2v o; o.x = pk2(st.x, st.y); o.y = pk2(st.z, st.w);
      *(u2v*)(up + (size_t)(i * 8 + j) * 4096 + (vb * 32 + vl) * 64 + k0) = o;
      st.x = d[j].x * (st.x + u.x); st.y = d[j].y * (st.y + u.y); st.z = d[j].z * (st.z + u.z); st.w = d[j].w * (st.w + u.w);
    }
  }
}

DI void phase3(const Params& p, unsigned char* smem, bool dup = false) {
  int* s_item = (int*)(smem + LDS_BYTES - 64);
  int* ctr = (int*)(p.ws + OFF_SSQ + (size_t)3 * T * 4) + (dup ? 1 : 0);
  constexpr int NSCAN = 0, NATT = 1024;
  if (!dup) for (int it = (int)blockIdx.x - ((int)gridDim.x - 128); it >= 0 && it < 128; it += 128 * 1024) hgrn_state_item(p, (float*)smem, it >> 1, it & 1);
  if (!dup && (int)gridDim.x < 128) for (int it = (int)blockIdx.x; it < 128; it += (int)gridDim.x) hgrn_state_item(p, (float*)smem, it >> 1, it & 1);
  for (;;) {
    __syncthreads();
    if (threadIdx.x == 0) *s_item = atomicAdd(ctr, 1);
    __syncthreads();
    const int item = *s_item;
    if (item >= NSCAN + NATT) break;
    if (item < NSCAN) { }
    else { const int idx = item - NSCAN; attn8_item(p, (u16*)smem, idx & 63, 15 - (idx >> 6)); }
  }
}

DI void phase4(const Params& p) {
  unsigned char* ws = p.ws;
  const int tid = VTID, lane = tid & 63, w = tid >> 6, r = lane & 31, h = lane >> 5;
  for (int t = VBID; t < 2048; t += VBN) {
    const int bh = t >> 5, n = (t & 31) * 4 + w;
    const int b = bh >> 3, head = bh & 7;
    const size_t tok0 = (size_t)b * 4096 + n * 32;
    const u16* qd = (const u16*)(ws + OFF_QDEC) + (tok0 + r) * 512 + head * 64 + h * 8;
    const u16* ki = (const u16*)(ws + OFF_KINV) + (tok0 + r) * 512 + head * 64 + h * 8;
    const u16* vt = (const u16*)(ws + OFF_VT) + ((size_t)bh * 128 + n) * 64 * 32;
    const u16* sp = (const u16*)(ws + OFF_UPD) + ((size_t)bh * 128 + n) * 4096;
    bf16x8 qf[4], kf[4];
#pragma unroll
    for (int ks = 0; ks < 4; ++ks) { qf[ks] = *(const bf16x8*)(qd + ks * 16); kf[ks] = *(const bf16x8*)(ki + ks * 16); }
    f32x16 at = zero16();
#pragma unroll
    for (int ks = 0; ks < 4; ++ks) at = MFMA(kf[ks], qf[ks], at);
#pragma unroll
    for (int i = 0; i < 16; ++i) if (crow(i, h) > r) at[i] = 0.f;
    f32x16 o[2]; o[0] = zero16(); o[1] = zero16();
#pragma unroll
    for (int s2 = 0; s2 < 2; ++s2) {
      u4v pu; pu.x = pk2(at[8 * s2], at[8 * s2 + 1]); pu.y = pk2(at[8 * s2 + 2], at[8 * s2 + 3]);
      pu.z = pk2(at[8 * s2 + 4], at[8 * s2 + 5]); pu.w = pk2(at[8 * s2 + 6], at[8 * s2 + 7]);
      const bf16x8 pb = __builtin_bit_cast(bf16x8, pu);
#pragma unroll
      for (int vb = 0; vb < 2; ++vb) {
        const s16x4 lo = *(const s16x4*)(vt + (vb * 32 + r) * 32 + 16 * s2 + 4 * h);
        const s16x4 hi = *(const s16x4*)(vt + (vb * 32 + r) * 32 + 16 * s2 + 8 + 4 * h);
        const bf16x8 vf = __builtin_shufflevector(lo, hi, 0, 1, 2, 3, 4, 5, 6, 7);
        o[vb] = MFMA(vf, pb, o[vb]);
      }
    }
#pragma unroll
    for (int vb = 0; vb < 2; ++vb)
#pragma unroll
      for (int ks = 0; ks < 4; ++ks) {
        const bf16x8 sf = *(const bf16x8*)(sp + (vb * 32 + r) * 64 + ks * 16 + h * 8);
        o[vb] = MFMA(sf, qf[ks], o[vb]);
      }
    float ss = 0.f;
#pragma unroll
    for (int i = 0; i < 16; ++i) ss += o[0][i] * o[0][i] + o[1][i] * o[1][i];
    ss = xor32_add(ss);
    const float rs = rsqrtf(ss * (1.f / 64.f) + EPS);
    const u16* sgb = (const u16*)(ws + OFF_SGB) + (tok0 + r) * 512 + head * 64;
    u16* yb = (u16*)(ws + OFF_YB) + (tok0 + r) * 512 + head * 64;
#pragma unroll
    for (int vb = 0; vb < 2; ++vb)
#pragma unroll
      for (int g = 0; g < 4; ++g) {
        const int v0 = vb * 32 + 8 * g + 4 * h;
        const u2v gt = *(const u2v*)(sgb + v0);
        u2v ov;
        ov.x = pk2(o[vb][4 * g] * rs * bflo(gt.x), o[vb][4 * g + 1] * rs * bfhi(gt.x));
        ov.y = pk2(o[vb][4 * g + 2] * rs * bflo(gt.y), o[vb][4 * g + 3] * rs * bfhi(gt.y));
        *(u2v*)(yb + v0) = ov;
      }
  }
}

DI void phase5(const Params& p, unsigned char* smem) {
  unsigned char* ws = p.ws;
  pg8::StaticOrder S; S.init(T, 1024, (int)gridDim.x, (int)blockIdx.x);
  {
    pg8::Gemm g{(const u16*)(ws + OFF_YA), (const u16*)(ws + OFF_WA), T, 1024, 512};
    Epi5<false> E{(const u16*)p.out, (u16*)(ws + OFF_H), (u16*)(ws + OFF_M)};
    pg8::gemm_phase<Epi5<false>, pg8::StaticOrder, false>((PG8_LAS unsigned char*)smem, g, S, E, nullptr);
  }
  {
    pg8::Gemm g{(const u16*)(ws + OFF_YB), (const u16*)(ws + OFF_WB), T, 1024, 512};
    Epi5<true> E{(const u16*)p.out, (u16*)(ws + OFF_H), (u16*)(ws + OFF_M)};
    pg8::gemm_phase<Epi5<true>, pg8::StaticOrder, false>((PG8_LAS unsigned char*)smem, g, S, E, nullptr);
  }
}

DI void phase6(const Params& p, unsigned char* smem, bool dup = false) {
  unsigned char* ws = p.ws;
  pg8::Gemm g{(const u16*)(ws + OFF_M), (const u16*)(ws + OFF_WO), T, 1024, 1024};
  pg8::StaticOrder S; S.init(T, 1024, (int)gridDim.x, (int)blockIdx.x);
  Epi6 E{(u16*)(ws + OFF_H), (float*)(ws + OFF_SSQ) + 2 * T, dup};
  pg8::gemm_phase<Epi6, pg8::StaticOrder, false>((PG8_LAS unsigned char*)smem, g, S, E, nullptr);
}

DI void phase7(const Params& p) {
  const float* ssq_y = (const float*)(p.ws + OFF_SSQ) + 2 * T;
  const u2v* Y = (const u2v*)(p.ws + OFF_H);
  const int gtid = blockIdx.x * blockDim.x + threadIdx.x, gthreads = gridDim.x * blockDim.x;
  for (int i = gtid; i < T * 256; i += gthreads) {
    const int row = i >> 8, c4 = i & 255;
    const float rs = rsqrtf(ssq_y[row] * (1.f / 1024.f) + EPS);
    const u2v y = Y[i];
    const f4v xv = ((const f4v*)p.x)[i];
    const f4v g = ((const f4v*)p.g_post)[c4];
    f4v o;
    o.x = xv.x + bflo(y.x) * rs * g.x; o.y = xv.y + bfhi(y.x) * rs * g.y; o.z = xv.z + bflo(y.y) * rs * g.z; o.w = xv.w + bfhi(y.y) * rs * g.w;
    ((f4v*)p.out)[i] = o;
  }
}

__global__ void __launch_bounds__(512, 2) fwd_megakernel(Params p) {
  extern __shared__ __attribute__((aligned(16))) unsigned char smem[];
  u16* lds = (u16*)(smem + (threadIdx.x >> 8) * VLDS);
  cg::grid_group grid = cg::this_grid();
  volatile LAS unsigned* xst = (volatile LAS unsigned*)(smem + LDS_BYTES - 48);
  if (threadIdx.x == 0) { xst[0] = 0u; xst[1] = 0u; }
  __syncthreads();
  XcdBarrier xb = xcd_barrier_post((unsigned*)(p.ws + OFF_BAR), xst);
  if (p.ph_hi > 1000) grid.sync();
#define RUN_PHASE(N, CALL) if (p.ph_lo <= N && N < p.ph_hi) { if (N > p.ph_lo) xcd_barrier(xb); CALL; }
#define DUP_PHASE(N, CALL) if (DUP_PH == N) { xcd_barrier(xb); CALL; }
  RUN_PHASE(0, phase0(p))
  DUP_PHASE(0, phase0(p))
  if (p.ph_lo <= 1 && 1 < p.ph_hi) for (int rep = 0; rep < (DUP_PH == 1 ? 2 : 1); ++rep) { if (rep > 0 || 1 > p.ph_lo) xcd_barrier(xb); phase1(p, smem, rep > 0); }
  if (p.ph_lo <= 2 && 2 < p.ph_hi) for (int rep = 0; rep < (DUP_PH == 2 ? 2 : 1); ++rep) { if (rep > 0 || 2 > p.ph_lo) xcd_barrier(xb); phase2(p, smem, lds); }
  RUN_PHASE(3, phase2b(p, smem))
  DUP_PHASE(3, phase2b(p, smem))
  RUN_PHASE(4, phase3(p, smem))
  DUP_PHASE(4, phase3(p, smem, true))
  if (DUP_PH == 9) { xcd_barrier(xb); for (int i = blockIdx.x; i < 256; i += gridDim.x) scan_item(p, i, OFF_K); }
  RUN_PHASE(5, phase4(p))
  DUP_PHASE(5, phase4(p))
  RUN_PHASE(6, phase5(p, smem))
  DUP_PHASE(6, phase5(p, smem))
  RUN_PHASE(7, phase6(p, smem))
  DUP_PHASE(7, phase6(p, smem, true))
  RUN_PHASE(8, phase7(p))
  if (DUP_PH == 8) { xcd_barrier(xb); phase6(p, smem, true); xcd_barrier(xb); phase7(p); }
}

extern "C" void kernel_launch(void* const* d_in, const int* in_sizes, int n_in, void* d_out, int out_size, void* d_ws, size_t ws_size,
                              hipStream_t stream) {
  static int grid_blocks = 0;
  if (!grid_blocks) {
    int dev = 0, cus = 0, per_cu = 0;
    hipGetDevice(&dev);
    hipDeviceGetAttribute(&cus, hipDeviceAttributeMultiprocessorCount, dev);
    hipFuncSetAttribute((const void*)fwd_megakernel, hipFuncAttributeMaxDynamicSharedMemorySize, LDS_BYTES);
    hipOccupancyMaxActiveBlocksPerMultiprocessor(&per_cu, (const void*)fwd_megakernel, 512, LDS_BYTES);
    if (per_cu < 1) per_cu = 1;
    if (per_cu > 1) per_cu = 1;
    grid_blocks = cus * per_cu;
    if (ws_size < WS_NEED) fprintf(stderr, "kernel_launch: workspace too small: %zu < %zu\n", ws_size, (size_t)WS_NEED);
  }
  if (ws_size < WS_NEED) return;
  Params p{};
  p.x = (const float*)d_in[0]; p.g_pre = (const float*)d_in[1]; p.w_in = (const float*)d_in[2]; p.b_gate = (const float*)d_in[3];
  p.g_q = (const float*)d_in[4]; p.w_uq = (const float*)d_in[5]; p.g_kv = (const float*)d_in[6]; p.w_ukv = (const float*)d_in[7];
  p.lb_logits = (const float*)d_in[8]; p.g_hgrn = (const float*)d_in[9]; p.w_a = (const float*)d_in[10]; p.w_b = (const float*)d_in[11];
  p.w_out = (const float*)d_in[12]; p.g_post = (const float*)d_in[13];
  p.out = (float*)d_out; p.ws = (unsigned char*)d_ws;
#if ONE_LAUNCH
  p.ph_lo = 0; p.ph_hi = 9;
  (void)hipMemsetAsync((unsigned char*)d_ws + OFF_BAR, 0, 16384, stream);
  void* args[] = {&p};
  hipError_t e = hipLaunchCooperativeKernel((const void*)fwd_megakernel, dim3(grid_blocks), dim3(512), args, LDS_BYTES, stream);
  if (e != hipSuccess) fprintf(stderr, "cooperative launch failed: %s (grid %d)\n", hipGetErrorString(e), grid_blocks);
#else
  for (int ph = 0; ph < 9; ++ph) {
    p.ph_lo = ph; p.ph_hi = ph + 1;
    (void)hipMemsetAsync((unsigned char*)d_ws + OFF_BAR, 0, 16384, stream);
    void* args[] = {&p};
    hipError_t e = hipLaunchCooperativeKernel((const void*)fwd_megakernel, dim3(grid_blocks), dim3(512), args, LDS_BYTES, stream);
    if (e != hipSuccess) fprintf(stderr, "cooperative launch failed: %s (grid %d)\n", hipGetErrorString(e), grid_blocks);
  }
#endif
}
```

```cpp
#include <hip/hip_runtime.h>
#include <hip/hip_cooperative_groups.h>
#include <cstdio>
namespace cg = cooperative_groups;

#define DI __device__ __forceinline__
#define VTID ((int)(threadIdx.x & 255))
#define VBID ((int)(blockIdx.x * 2 + (threadIdx.x >> 8)))
#define VBN ((int)(gridDim.x * 2))
typedef unsigned short u16;
typedef unsigned int u32;
typedef __attribute__((ext_vector_type(8))) short bf16x8;
typedef __attribute__((ext_vector_type(4))) short s16x4;
typedef __attribute__((ext_vector_type(16))) float f32x16;
typedef __attribute__((ext_vector_type(2))) __bf16 bf2_t;
typedef __attribute__((ext_vector_type(2))) float f2_t;
typedef __attribute__((ext_vector_type(4))) unsigned int u4v;
typedef __attribute__((ext_vector_type(2))) unsigned int u2v;
typedef __attribute__((ext_vector_type(4))) float f4v;
typedef __attribute__((ext_vector_type(2))) float f2v;
#define MFMA(a, b, c) __builtin_amdgcn_mfma_f32_32x32x16_bf16((a), (b), (c), 0, 0, 0)

#ifndef DUP_PH
#define DUP_PH -1
#endif
#ifndef ONE_LAUNCH
#define ONE_LAUNCH 1
#endif

constexpr int T = 32768;
constexpr int SEQ = 4096;
constexpr int DIN = 5664;
constexpr int NP = 5888;
constexpr float EPS = 1e-6f;
constexpr float QSCALE = 1.4426950408889634f * 0.10206207261596575f;

constexpr size_t SZ_WIN = (size_t)NP * 1024 * 2;
constexpr size_t OFF_WIN = 0;
constexpr size_t OFF_WUQ = OFF_WIN + SZ_WIN;
constexpr size_t OFF_WUKV = OFF_WUQ + (size_t)768 * 768 * 2;
constexpr size_t OFF_WA = OFF_WUKV + (size_t)1024 * 256 * 2;
constexpr size_t OFF_WB = OFF_WA + (size_t)1024 * 512 * 2;
constexpr size_t OFF_WO = OFF_WB + (size_t)1024 * 512 * 2;
constexpr size_t OFF_ROPE = OFF_WO + (size_t)1024 * 1024 * 2;
constexpr size_t OFF_SSQ = OFF_ROPE + (size_t)4096 * 16 * 2 * 4;
constexpr size_t OFF_DECAY = OFF_SSQ + (size_t)(3 * T + 64) * 4;
constexpr size_t OFF_H = OFF_DECAY + (size_t)64 * 128 * 64 * 4;
constexpr size_t OFF_Q = OFF_H;
constexpr size_t OFF_CQ = OFF_H + (size_t)T * 1024 * 2;
constexpr size_t OFF_YA = OFF_CQ;
constexpr size_t OFF_CKV = OFF_CQ + (size_t)T * 768 * 2;
constexpr size_t OFF_KPE = OFF_CKV + (size_t)T * 256 * 2;
constexpr size_t OFF_SGA = OFF_KPE + (size_t)T * 32 * 4;
constexpr size_t OFF_SGB = OFF_SGA + (size_t)T * 512 * 2;
constexpr size_t OFF_HQ = OFF_SGB + (size_t)T * 512 * 2;
constexpr size_t OFF_UPD = OFF_HQ;
constexpr size_t OFF_HF = OFF_HQ + (size_t)T * 512 * 2;
constexpr size_t OFF_HI = OFF_HF + (size_t)T * 512 * 2;
constexpr size_t OFF_YB = OFF_HI;
constexpr size_t OFF_QDEC = OFF_HI + (size_t)T * 512 * 2;
constexpr size_t OFF_KINV = OFF_QDEC + (size_t)T * 512 * 2;
constexpr size_t OFF_VT = OFF_KINV + (size_t)T * 512 * 2;
constexpr size_t OFF_K = OFF_VT + (size_t)T * 512 * 2;
constexpr size_t OFF_M = OFF_K;
constexpr size_t OFF_VTT = OFF_K + (size_t)T * 768 * 2;
constexpr size_t OFF_BAR = OFF_VTT + (size_t)T * 512 * 2;
constexpr size_t WS_NEED = OFF_BAR + 16384;

constexpr int VLDS = 2 * 2 * 128 * 72 * 2;
constexpr int LDS_BYTES = 2 * VLDS + 64;
constexpr int SST = 132;

struct Params {
  const float *x, *g_pre, *w_in, *b_gate, *g_q, *w_uq, *g_kv, *w_ukv, *lb_logits, *g_hgrn, *w_a, *w_b, *w_out, *g_post;
  float* out;
  unsigned char* ws;
  int ph_lo, ph_hi;
};

DI u32 pk2(float a, float b) { f2_t v = {a, b}; bf2_t r = __builtin_convertvector(v, bf2_t); return __builtin_bit_cast(u32, r); }
DI float bflo(u32 u) { return __uint_as_float(u << 16); }
DI float bfhi(u32 u) { return __uint_as_float(u & 0xffff0000u); }
DI u4v pk8(f4v a, f4v b) { u4v r; r.x = pk2(a.x, a.y); r.y = pk2(a.z, a.w); r.z = pk2(b.x, b.y); r.w = pk2(b.z, b.w); return r; }
DI float rcpf(float x) { return __builtin_amdgcn_rcpf(x); }
DI float sigmoidf_(float x) { return rcpf(1.f + __expf(-x)); }
DI float siluf_(float x) { return x * sigmoidf_(x); }
DI float xor32_max(float x) { const unsigned u = __float_as_uint(x); auto r = __builtin_amdgcn_permlane32_swap(u, u, false, false); return fmaxf(__uint_as_float(r[0]), __uint_as_float(r[1])); }
DI float xor32_add(float x) { const unsigned u = __float_as_uint(x); auto r = __builtin_amdgcn_permlane32_swap(u, u, false, false); return __uint_as_float(r[0]) + __uint_as_float(r[1]); }
DI float xor16_add(float x) { const unsigned u = __float_as_uint(x); auto r = __builtin_amdgcn_permlane16_swap(u, u, false, false); return __uint_as_float(r[0]) + __uint_as_float(r[1]); }
DI int crow(int reg, int h) { return (reg & 3) + 8 * (reg >> 2) + 4 * h; }
DI f32x16 zero16() { f32x16 z;
#pragma unroll
  for (int i = 0; i < 16; ++i) z[i] = 0.f; return z; }

__constant__ float c_invfreq[16] = {1.0f, 0.5623413324356079f, 0.3162277638912201f, 0.17782793939113617f, 0.10000000149011612f,
  0.05623413249850273f, 0.03162277489900589f, 0.017782794311642647f, 0.009999999776482582f, 0.005623413249850273f,
  0.003162277629598975f, 0.0017782794311642647f, 0.0010000000474974513f, 0.000562341301701963f, 0.0003162277571391314f,
  0.00017782794020604342f};

DI void sincos_d(double a, float& sn, float& cs) {
  const double k = rint(a * 0.63661977236758134308);
  const double y = a - k * 1.57079632679489661923;
  const double y2 = y * y;
  const double s = y * (1.0 + y2 * (-1.0 / 6 + y2 * (1.0 / 120 + y2 * (-1.0 / 5040 + y2 * (1.0 / 362880 + y2 * (-1.0 / 39916800 + y2 * (1.0 / 6227020800.0)))))));
  const double c = 1.0 + y2 * (-0.5 + y2 * (1.0 / 24 + y2 * (-1.0 / 720 + y2 * (1.0 / 40320 + y2 * (-1.0 / 3628800 + y2 * (1.0 / 479001600.0 + y2 * (-1.0 / 87178291200.0)))))));
  const int q = ((int)k) & 3;
  const double ss = (q == 0) ? s : (q == 1) ? c : (q == 2) ? -s : -c;
  const double cc = (q == 0) ? c : (q == 1) ? -s : (q == 2) ? -c : s;
  sn = (float)ss; cs = (float)cc;
}

#define XB_TMO      128
#define XB_XCNT(j)  (256  + 64 * (j))
#define XB_XSUB(j)  (1280 + 64 * (j))
#define XB_XGEN(j)  (2304 + 64 * (j))
#define XB_TOP      3328
#define XB_TOPGEN   3392
#define XCD_BAR_WORDS 3456
#define XB_SPIN_CAP (1u << 22)
#define LAS __attribute__((address_space(3)))
DI unsigned xb_ld(unsigned* p)              { return __hip_atomic_load(p, __ATOMIC_RELAXED, __HIP_MEMORY_SCOPE_AGENT); }
DI unsigned xb_add(unsigned* p, unsigned v) { return __hip_atomic_fetch_add(p, v, __ATOMIC_RELAXED, __HIP_MEMORY_SCOPE_AGENT); }
DI unsigned xb_xcc_id() { return (unsigned)__builtin_amdgcn_s_getreg((3 << 11) | 20) & 0xFu; }
#define XB_SPIN(cond, bar) do { unsigned _sp = 0; while (cond) { __builtin_amdgcn_s_sleep(1); \
    if ((++_sp & 255u) == 0u) { if (xb_ld(&(bar)[XB_TMO])) break; if (_sp > XB_SPIN_CAP) { atomicAdd(&(bar)[XB_TMO], 1u); break; } } } } while (0)
struct XcdBarrier { unsigned* bar; unsigned x; volatile LAS unsigned* st; };
DI XcdBarrier xcd_barrier_post(unsigned* bar, volatile LAS unsigned* st) {
  XcdBarrier b; b.bar = bar; b.x = xb_xcc_id(); b.st = st;
  if (threadIdx.x == 0) (void)xb_add(&bar[XB_XCNT(b.x)], 1u);
  return b;
}
DI void xcd_barrier_complete(unsigned* bar, unsigned x, unsigned& nloc, unsigned& nx) {
  const unsigned G = gridDim.x * gridDim.y * gridDim.z;
  unsigned sum, cnt, mine, sp = 0u;
  for (;;) {
    sum = 0u; cnt = 0u; mine = 0u;
#pragma unroll
    for (unsigned j = 0; j < 16; ++j) { const unsigned c = xb_ld(&bar[XB_XCNT(j)]); sum += c; cnt += (c > 0u) ? 1u : 0u; mine = (j == x) ? c : mine; }
    if (sum == G) break;
    __builtin_amdgcn_s_sleep(1);
    if ((++sp & 255u) == 0u) { if (xb_ld(&bar[XB_TMO])) break; if (sp > XB_SPIN_CAP) { atomicAdd(&bar[XB_TMO], 1u); break; } }
  }
  nloc = mine > 0u ? mine : 1u; nx = cnt > 0u ? cnt : 1u;
}
DI void xcd_barrier(const XcdBarrier& b) {
  asm volatile("s_waitcnt vmcnt(0)" ::: "memory");
  __syncthreads();
  if (threadIdx.x == 0) {
    unsigned* bar = b.bar;
    __builtin_amdgcn_s_waitcnt(0);
    unsigned nloc = b.st[0], nx = b.st[1];
    if (nloc == 0u) { xcd_barrier_complete(bar, b.x, nloc, nx); b.st[0] = nloc; b.st[1] = nx; }
    const unsigned old = xb_add(&bar[XB_XSUB(b.x)], 1u);
    const unsigned gen = old / nloc;
    if (old + 1u == (gen + 1u) * nloc) {
      __builtin_amdgcn_fence(__ATOMIC_RELEASE, "agent");
      asm volatile("s_waitcnt vmcnt(0)" ::: "memory");
      const unsigned og = xb_add(&bar[XB_TOP], 1u);
      const unsigned tg = og / nx;
      if (og + 1u == (tg + 1u) * nx) xb_add(&bar[XB_TOPGEN], 1u);
      else XB_SPIN(xb_ld(&bar[XB_TOPGEN]) == tg, bar);
      __builtin_amdgcn_fence(__ATOMIC_ACQUIRE, "agent");
      xb_add(&bar[XB_XGEN(b.x)], 1u);
      asm volatile("s_waitcnt vmcnt(0)" ::: "memory");
    } else {
      XB_SPIN(xb_ld(&bar[XB_XGEN(b.x)]) == gen, bar);
      __builtin_amdgcn_fence(__ATOMIC_ACQUIRE, "agent");
      asm volatile("s_waitcnt vmcnt(0)" ::: "memory");
    }
  }
  __syncthreads();
}

template <int KIND>
DI int colmap(int n) {
  if (KIND == 0) {
    if (n < 1024) return n;
    if (n < 1536) return 1056 + (n - 1024);
    if (n < 2048) return 3104 + (n - 1536);
    if (n < 4096) return 3616 + (n - 2048);
    if (n < 4608) return 1568 + (n - 4096);
    if (n < 5120) return 2080 + (n - 4608);
    if (n < 5632) return 2592 + (n - 5120);
    if (n < 5664) return 1024 + (n - 5632);
    return -1;
  } else if (KIND == 1) {
    if (n < 512) return (n >> 6) * 96 + (n & 63);
    int i = n - 512; int w = i & 31, g = w >> 3, e = w & 7; return (i >> 5) * 96 + 64 + ((e < 4) ? (4 * g + e) : (16 + 4 * g + (e - 4)));
  } else if (KIND == 3) {
    if (n < 512) return (n >> 6) * 128 + (n & 63);
    int i = n - 512; return (i >> 6) * 128 + 64 + (i & 63);
  } else return n;
}
template <int KIND>
DI void conv_weight(u16* dst, const float* src, int ldw, int ncount, int K, const float* gain, int gmask, int gtid, int gthreads) {
  const int total = ncount * (K >> 3);
  for (int it = gtid; it < total; it += gthreads) {
    const int n = it % ncount, kc = it / ncount;
    const int sc = colmap<KIND>(n);
    float v[8];
#pragma unroll
    for (int i = 0; i < 8; ++i) {
      const int k = kc * 8 + i;
      float x = (sc >= 0) ? src[(size_t)k * ldw + sc] : 0.f;
      if (gain) x *= gain[k & gmask];
      v[i] = x;
    }
    u4v o; o.x = pk2(v[0], v[1]); o.y = pk2(v[2], v[3]); o.z = pk2(v[4], v[5]); o.w = pk2(v[6], v[7]);
    *(u4v*)(dst + (size_t)n * K + kc * 8) = o;
  }
}

DI void phase0(const Params& p) {
  unsigned char* ws = p.ws;
  const int gtid = blockIdx.x * blockDim.x + threadIdx.x, gthreads = gridDim.x * blockDim.x;
  float* ssq = (float*)(ws + OFF_SSQ);
  for (int i = gtid; i < 3 * T + 64; i += gthreads) ssq[i] = 0.f;
  float* rope = (float*)(ws + OFF_ROPE);
  for (int i = gtid; i < 4096 * 16; i += gthreads) {
    const int pos = i >> 4, j = i & 15;
    const float ang = (float)pos * c_invfreq[j];
    float sn, cs; sincos_d((double)ang, sn, cs);
    rope[i] = cs; rope[65536 + i] = sn;
  }
  conv_weight<0>((u16*)(ws + OFF_WIN), p.w_in, DIN, NP, 1024, nullptr, 0, gtid, gthreads);
  u16* H = (u16*)(ws + OFF_H);
  const int lane = threadIdx.x & 63;
  const int gw = gtid >> 6, nw = gthreads >> 6;
  for (int row = gw; row < T; row += nw) {
    const f4v* xr = (const f4v*)(p.x + (size_t)row * 1024);
    f4v v[4];
    float ss = 0.f;
#pragma unroll
    for (int i = 0; i < 4; ++i) { v[i] = xr[lane * 4 + i]; ss += v[i].x * v[i].x + v[i].y * v[i].y + v[i].z * v[i].z + v[i].w * v[i].w; }
#pragma unroll
    for (int o = 32; o >= 1; o >>= 1) ss += __shfl_xor(ss, o);
    const float rs = rsqrtf(ss * (1.f / 1024.f) + EPS);
    const f4v* gp = (const f4v*)(p.g_pre);
    f4v g[4];
#pragma unroll
    for (int i = 0; i < 4; ++i) { g[i] = gp[lane * 4 + i]; v[i].x *= rs * g[i].x; v[i].y *= rs * g[i].y; v[i].z *= rs * g[i].z; v[i].w *= rs * g[i].w; }
    u4v* hr = (u4v*)(H + (size_t)row * 1024 + lane * 16);
    hr[0] = pk8(v[0], v[1]); hr[1] = pk8(v[2], v[3]);
  }
}

constexpr int TS = 128 * 72;
DI void gemm_ld(u4v (&ra)[4], u4v (&rb)[4], const u16* ga, const u16* gb, int lda, int ldb, int ko) {
#pragma unroll
  for (int i = 0; i < 4; ++i) { ra[i] = *(const u4v*)(ga + (size_t)(32 * i) * lda + ko); rb[i] = *(const u4v*)(gb + (size_t)(32 * i) * ldb + ko); }
}
DI void gemm_st(const u4v (&ra)[4], const u4v (&rb)[4], u16* buf, int lr, int lc) {
  u16* sa = buf; u16* sb = buf + TS;
#pragma unroll
  for (int i = 0; i < 4; ++i) { *(u4v*)(sa + (lr + 32 * i) * 72 + lc * 8) = ra[i]; *(u4v*)(sb + (lr + 32 * i) * 72 + lc * 8) = rb[i]; }
}
DI void gemm_mma(const u16* buf, f32x16 (&acc)[2][2], int wm, int wn, int r, int h) {
  const u16* sa = buf + (wm * 64 + r) * 72 + h * 8;
  const u16* sb = buf + TS + (wn * 64 + r) * 72 + h * 8;
#pragma unroll
  for (int ks = 0; ks < 4; ++ks) {
    const bf16x8 a0 = *(const bf16x8*)(sa + ks * 16);
    const bf16x8 a1 = *(const bf16x8*)(sa + 32 * 72 + ks * 16);
    const bf16x8 b0 = *(const bf16x8*)(sb + ks * 16);
    const bf16x8 b1 = *(const bf16x8*)(sb + 32 * 72 + ks * 16);
    acc[0][0] = MFMA(a0, b0, acc[0][0]);
    acc[0][1] = MFMA(a0, b1, acc[0][1]);
    acc[1][0] = MFMA(a1, b0, acc[1][0]);
    acc[1][1] = MFMA(a1, b1, acc[1][1]);
  }
}
DI void gemm_core(const u16* __restrict__ A, int lda, const u16* __restrict__ B, int ldb, int K, u16* lds, f32x16 (&acc)[2][2], int tid) {
  const int lane = tid & 63, w = tid >> 6, wm = w >> 1, wn = w & 1, r = lane & 31, h = lane >> 5;
  const int lc = tid & 7, lr = tid >> 3;
  const u16* ga = A + (size_t)lr * lda + lc * 8;
  const u16* gb = B + (size_t)lr * ldb + lc * 8;
  u4v ra0[4], rb0[4], ra1[4], rb1[4];
  gemm_ld(ra0, rb0, ga, gb, lda, ldb, 0);
  gemm_ld(ra1, rb1, ga, gb, lda, ldb, 64);
#pragma unroll
  for (int i = 0; i < 2; ++i)
#pragma unroll
    for (int j = 0; j < 2; ++j) acc[i][j] = zero16();
  u16* L0 = lds; u16* L1 = lds + 2 * TS;
  __syncthreads();
  gemm_st(ra0, rb0, L0, lr, lc);
  __syncthreads();
  const int nk = K >> 6;
  int kt = 0;
  for (; kt + 2 < nk; kt += 2) {
    gemm_ld(ra0, rb0, ga, gb, lda, ldb, (kt + 2) * 64);
    __builtin_amdgcn_sched_barrier(0);
    gemm_mma(L0, acc, wm, wn, r, h);
    gemm_st(ra1, rb1, L1, lr, lc);
    __syncthreads();
    gemm_ld(ra1, rb1, ga, gb, lda, ldb, (kt + 3) * 64);
    __builtin_amdgcn_sched_barrier(0);
    gemm_mma(L1, acc, wm, wn, r, h);
    gemm_st(ra0, rb0, L0, lr, lc);
    __syncthreads();
  }
  gemm_mma(L0, acc, wm, wn, r, h);
  gemm_st(ra1, rb1, L1, lr, lc);
  __syncthreads();
  gemm_mma(L1, acc, wm, wn, r, h);
  __syncthreads();
}

DI void stage_pass(const f32x16 (&acc)[2][2], float* stage, int p, int tid) {
  const int lane = tid & 63, w = tid >> 6, wm = w >> 1, wn = w & 1, r = lane & 31, h = lane >> 5;
  __syncthreads();
  if (wm == p) {
#pragma unroll
    for (int i = 0; i < 2; ++i)
#pragma unroll
      for (int j = 0; j < 2; ++j)
#pragma unroll
        for (int reg = 0; reg < 16; ++reg) stage[(i * 32 + crow(reg, h)) * SST + wn * 64 + j * 32 + r] = acc[i][j][reg];
  }
  __syncthreads();
}

namespace pg8 {
#define PG8_LAS __attribute__((address_space(3)))
typedef unsigned short bf16_t;
typedef short bf16x8 __attribute__((ext_vector_type(8)));
typedef float f32x4 __attribute__((ext_vector_type(4)));
typedef unsigned u32x4 __attribute__((ext_vector_type(4)));
constexpr int BM = 256, BK = 64, HALF = 128, HTB = HALF * BK * 2  , STAGE_BYTES = 8 * HTB, NXCD = 8, WGM = 8;

__host__ __device__ __forceinline__ int lds_byte(int r, int c) { const int st = (r >> 4) * 2 + (c >> 5), rr = r & 15, cc = c & 31, ob = rr * 64 + cc * 2; return st * 1024 + (ob ^ (((ob >> 9) & 1) << 5)); }
__host__ __device__ __forceinline__ void stage_rc(int b, int& R, int& C) { const int st = b / 1024, sb = b % 1024, swz = sb ^ (((sb >> 9) & 1) << 5); R = (st >> 1) * 16 + swz / 64; C = (st & 1) * 32 + (swz % 64) / 2; }
__host__ __device__ __forceinline__ int perm32(int rho) { const int n = rho >> 4, i = rho & 15; return 8 * (i >> 2) + 4 * n + (i & 3); }

struct Unit { int pm, pn; };
struct Gemm { const bf16_t* A; const bf16_t* Bt; int M, N, K; };

struct StaticOrder {
    int nM, nN, nwg, G, c;
    __host__ __device__ void init(int M, int N, int G_, int c_) { nM = M / BM; nN = N / BM; nwg = nM * nN; G = G_; c = c_; }
    __host__ __device__ bool next(int i, Unit& u) const {
        const long L = (long)i * G + c; if (L >= nwg) return false;
        int wgid = (int)L; { const int q = nwg / NXCD, r = nwg % NXCD, xcd = wgid % NXCD, off = wgid / NXCD; wgid = (xcd < r ? xcd * (q + 1) : r * (q + 1) + (xcd - r) * q) + off; }
        const int nig = WGM * nN, gid = wgid / nig, fm = gid * WGM, gsz = (nM - fm) < WGM ? (nM - fm) : WGM;
        u.pm = fm + ((wgid % nig) % gsz); u.pn = (wgid % nig) / gsz; return true;
    }
    __device__ __forceinline__ void a_ready(const Unit&) const {}
    __device__ __forceinline__ void done(const Unit&) const {}
};
template <class Epi, class Sched, bool STAMP = false, bool SWAP = false>
__device__ __forceinline__ void gemm_phase(PG8_LAS unsigned char* lds, const Gemm g, const Sched& S, const Epi& E, unsigned long long* stamps) {
    const int tid = threadIdx.x, wid = __builtin_amdgcn_readfirstlane(tid >> 6), lane = tid & 63, wr = wid >> 2, wc = wid & 3, fr = lane & 15, fq = lane >> 4;
    const int K = g.K, nt = K / BK;
    int ts_lo = 0, ts_hi = 0, nts = 0; const unsigned long long rt_entry = STAMP ? (unsigned long long)wall_clock64() : 0ull;
#define PG8_STAMP() do { if (STAMP && wid == 0 && nts < 64) { const unsigned long long _c = (unsigned long long)clock64(); \
        ts_lo = (lane == nts) ? (int)(unsigned)_c : ts_lo; ts_hi = (lane == nts) ? (int)(unsigned)(_c >> 32) : ts_hi; ++nts; } } while (0)
    PG8_STAMP();
    unsigned voffA[2], voffB[2];
#pragma unroll
    for (int i = 0; i < 2; ++i) { int R, C; stage_rc(tid * 16 + i * 8192, R, C); const int Rb = Epi::PERM ? ((R & ~31) + perm32(R & 31)) : R;
        voffA[i] = (unsigned)(R * K + C) * 2u; voffB[i] = (unsigned)(Rb * K + C) * 2u; }
    const size_t kstep = (size_t)(BK * 2);
    const size_t hstep = (size_t)HALF * K * 2;
    const size_t tstep = 2 * hstep;
    const unsigned ldsw = (unsigned)wid * 1024u;
    const int aoff = lds_byte(wr * 64 + fr, fq * 8), boff = lds_byte(wc * 32 + fr, fq * 8);
#define PG8_SA(b, h) (((b) * 2 + (h)) * HTB)
#define PG8_SB(b, h) ((4 + (b) * 2 + (h)) * HTB)
#define PG8_STAGE(bufoff, gbase, voff) do { _Pragma("unroll") for (int _i = 0; _i < 2; ++_i) \
        __builtin_amdgcn_global_load_lds((const unsigned*)((const char*)(gbase) + (voff)[_i]), (PG8_LAS unsigned*)(lds + (bufoff) + ldsw + _i * 8192), 16, 0, 0); } while (0)
#define PG8_LDA(dst, b, h) do { _Pragma("unroll") for (int m = 0; m < 4; ++m) _Pragma("unroll") for (int k = 0; k < 2; ++k) dst[m][k] = *(const PG8_LAS bf16x8*)(lds + PG8_SA(b, h) + aoff + m * 2048 + k * 1024); } while (0)
#define PG8_LDB(dst, b, h) do { _Pragma("unroll") for (int n = 0; n < 2; ++n) _Pragma("unroll") for (int k = 0; k < 2; ++k) dst[n][k] = *(const PG8_LAS bf16x8*)(lds + PG8_SB(b, h) + boff + n * 2048 + k * 1024); } while (0)
#define PG8_MMA(ai, bj, At, Bt) do { __builtin_amdgcn_s_setprio(1); _Pragma("unroll") for (int m = 0; m < 4; ++m) _Pragma("unroll") for (int n = 0; n < 2; ++n) _Pragma("unroll") for (int k = 0; k < 2; ++k) \
        acc[ai][bj][m][n] = SWAP ? __builtin_amdgcn_mfma_f32_16x16x32_bf16(At[m][k], Bt[n][k], acc[ai][bj][m][n], 0, 0, 0) : __builtin_amdgcn_mfma_f32_16x16x32_bf16(Bt[n][k], At[m][k], acc[ai][bj][m][n], 0, 0, 0); __builtin_amdgcn_s_setprio(0); } while (0)
#define PG8_WAIT_V(n) asm volatile("s_waitcnt vmcnt(" #n ")" ::: "memory")
#define PG8_WAIT_L(n) asm volatile("s_waitcnt lgkmcnt(" #n ")" ::: "memory")
#define PG8_BAR __builtin_amdgcn_s_barrier()
#define PG8_SCHED __builtin_amdgcn_sched_barrier(0)
    Unit cur, nxt; int ui = 0;
    if (!S.next(0, cur)) return;
    f32x4 acc[2][2][4][2];
#pragma unroll
    for (int a = 0; a < 2; ++a)
#pragma unroll
        for (int b = 0; b < 2; ++b)
#pragma unroll
            for (int m = 0; m < 4; ++m)
#pragma unroll
                for (int n = 0; n < 2; ++n) acc[a][b][m][n] = (f32x4){0.f, 0.f, 0.f, 0.f};
    bf16x8 At[4][2], B0[2][2], B1[2][2];
    const char* cA = (const char*)g.A + (size_t)cur.pm * tstep; const char* cB = (const char*)g.Bt + (size_t)cur.pn * tstep;
    S.a_ready(cur);
    PG8_STAGE(PG8_SB(0, 0), cB, voffB); PG8_STAGE(PG8_SA(0, 0), cA, voffA); PG8_STAGE(PG8_SB(0, 1), cB + hstep, voffB); PG8_STAGE(PG8_SA(0, 1), cA + hstep, voffA);
    if (wr == 1) PG8_BAR;
    PG8_WAIT_V(4); PG8_BAR;
    PG8_STAGE(PG8_SB(1, 0), cB + kstep, voffB); PG8_STAGE(PG8_SA(1, 0), cA + kstep, voffA); PG8_STAGE(PG8_SB(1, 1), cB + hstep + kstep, voffB);
    PG8_WAIT_V(6); PG8_BAR;
    PG8_STAMP();
    for (;;) {
        const bool has_next = S.next(ui + 1, nxt);
        const char* nA = has_next ? (const char*)g.A + (size_t)nxt.pm * tstep : cA; const char* nB = has_next ? (const char*)g.Bt + (size_t)nxt.pn * tstep : cB;
        for (int t = 0; t < nt; t += 2) {
            const bool last = (t == nt - 2);
            const char* a1 = cA + (size_t)(t + 1) * kstep;
            const char* a2 = last ? nA : cA + (size_t)(t + 2) * kstep; const char* b2 = last ? nB : cB + (size_t)(t + 2) * kstep;
            const char* a3 = a2 + kstep; const char* b3 = b2 + kstep;
            if (last && has_next) S.a_ready(nxt);
            PG8_LDB(B0, 0, 0); PG8_SCHED; PG8_LDA(At, 0, 0); PG8_STAGE(PG8_SA(1, 1), a1 + hstep, voffA);
            PG8_WAIT_L(8); PG8_BAR; PG8_WAIT_L(0); PG8_MMA(0, 0, At, B0); PG8_BAR; PG8_SCHED;
            PG8_LDB(B1, 0, 1); PG8_STAGE(PG8_SB(0, 0), b2, voffB);
            PG8_BAR; PG8_WAIT_L(0); PG8_MMA(0, 1, At, B1); PG8_BAR;
            PG8_LDA(At, 0, 1); PG8_STAGE(PG8_SA(0, 0), a2, voffA);
            PG8_BAR; PG8_WAIT_L(0); PG8_MMA(1, 0, At, B0); PG8_BAR; PG8_SCHED;
            PG8_STAGE(PG8_SB(0, 1), b2 + hstep, voffB);
            PG8_WAIT_V(6); PG8_BAR; PG8_MMA(1, 1, At, B1); PG8_BAR;
            PG8_LDB(B0, 1, 0); PG8_SCHED; PG8_LDA(At, 1, 0); PG8_STAGE(PG8_SA(0, 1), a2 + hstep, voffA);
            PG8_WAIT_L(8); PG8_BAR; PG8_WAIT_L(0); PG8_MMA(0, 0, At, B0); PG8_BAR; PG8_SCHED;
            PG8_LDB(B1, 1, 1); PG8_STAGE(PG8_SB(1, 0), b3, voffB);
            PG8_BAR; PG8_WAIT_L(0); PG8_MMA(0, 1, At, B1); PG8_BAR;
            PG8_LDA(At, 1, 1); PG8_STAGE(PG8_SA(1, 0), a3, voffA);
            PG8_BAR; PG8_WAIT_L(0); PG8_MMA(1, 0, At, B0); PG8_BAR; PG8_SCHED;
            PG8_STAGE(PG8_SB(1, 1), b3 + hstep, voffB);
            PG8_WAIT_V(6); PG8_BAR; PG8_MMA(1, 1, At, B1); PG8_BAR;
        }
        PG8_STAMP();
        if constexpr (!Epi::AFTER_DRAIN) { E(acc, cur, wr, wc, fr, fq); S.done(cur); }
        PG8_STAMP();
        if (!has_next) break;
#pragma unroll
        for (int a = 0; a < 2; ++a)
#pragma unroll
            for (int b = 0; b < 2; ++b)
#pragma unroll
                for (int m = 0; m < 4; ++m)
#pragma unroll
                    for (int n = 0; n < 2; ++n) acc[a][b][m][n] = (f32x4){0.f, 0.f, 0.f, 0.f};
        cur = nxt; cA = nA; cB = nB; ++ui;
    }
    PG8_WAIT_V(0);
    if (wr == 0) PG8_BAR;
    PG8_BAR;
    if constexpr (Epi::AFTER_DRAIN) { E.fused(acc, cur, wr, wc, fr, fq, lds, wid, lane); S.done(cur); }
    PG8_STAMP();
    if (STAMP && wid == 0) { stamps[lane] = lane < nts ? (((unsigned long long)(unsigned)ts_hi << 32) | (unsigned)ts_lo) : 0ull;
        if (lane == 62) stamps[62] = rt_entry; if (lane == 63) stamps[63] = (unsigned long long)wall_clock64(); }
#undef PG8_STAMP
#undef PG8_SA
#undef PG8_SB
#undef PG8_STAGE
#undef PG8_LDA
#undef PG8_LDB
#undef PG8_MMA
#undef PG8_WAIT_V
#undef PG8_WAIT_L
#undef PG8_BAR
#undef PG8_SCHED
}
}

struct Epi1 {
  static constexpr bool PERM = true, AFTER_DRAIN = false;
  unsigned char* ws; u16* mg; const float* b_gate; bool dup;
  DI void operator()(const pg8::f32x4 (&acc)[2][2][4][2], const pg8::Unit& u, int wr, int wc, int fr, int fq) const {
    const int pn = u.pn;
    const int rowb = u.pm * 256 + wr * 64 + fr;
    const int colu = wc * 32 + 8 * fq;
    if (pn < 4) {
      u16* dst = (pn < 3) ? (u16*)(ws + OFF_CQ) + pn * 256 : (u16*)(ws + OFF_CKV);
      const int ld = (pn < 3) ? 768 : 256;
      float* ssq = (float*)(ws + OFF_SSQ) + ((pn < 3) ? 0 : T);
#pragma unroll
      for (int ai = 0; ai < 2; ++ai)
#pragma unroll
        for (int m = 0; m < 4; ++m) {
          const int row = rowb + ai * 128 + m * 16;
          float ss = 0.f;
#pragma unroll
          for (int bj = 0; bj < 2; ++bj) {
            const pg8::f32x4 v0 = acc[ai][bj][m][0], v1 = acc[ai][bj][m][1];
            ss += v0[0] * v0[0] + v0[1] * v0[1] + v0[2] * v0[2] + v0[3] * v0[3] + v1[0] * v1[0] + v1[1] * v1[1] + v1[2] * v1[2] + v1[3] * v1[3];
            u4v o; o.x = pk2(v0[0], v0[1]); o.y = pk2(v0[2], v0[3]); o.z = pk2(v1[0], v1[1]); o.w = pk2(v1[2], v1[3]);
            *(u4v*)(dst + (size_t)row * ld + bj * 128 + colu) = o;
          }
          ss = xor16_add(ss); ss = xor32_add(ss);
          if (fq == 0 && !dup) atomicAdd(ssq + row, ss);
        }
    } else if (pn < 8) {
      u16* dst = (u16*)(ws + ((pn < 6) ? OFF_SGA : OFF_SGB)) + (pn & 1) * 256;
#pragma unroll
      for (int ai = 0; ai < 2; ++ai)
#pragma unroll
        for (int m = 0; m < 4; ++m) {
          const int row = rowb + ai * 128 + m * 16;
#pragma unroll
          for (int bj = 0; bj < 2; ++bj) {
            const pg8::f32x4 v0 = acc[ai][bj][m][0], v1 = acc[ai][bj][m][1];
            u4v o; o.x = pk2(siluf_(v0[0]), siluf_(v0[1])); o.y = pk2(siluf_(v0[2]), siluf_(v0[3]));
            o.z = pk2(siluf_(v1[0]), siluf_(v1[1])); o.w = pk2(siluf_(v1[2]), siluf_(v1[3]));
            *(u4v*)(dst + (size_t)row * 512 + bj * 128 + colu) = o;
          }
        }
    } else if (pn >= 16) {
      if (pn < 22) {
        u16* dst = (u16*)(ws + ((pn < 18) ? OFF_HQ : (pn < 20) ? OFF_HF : OFF_HI)) + (pn & 1) * 256;
#pragma unroll
        for (int ai = 0; ai < 2; ++ai)
#pragma unroll
          for (int m = 0; m < 4; ++m) {
            const int row = rowb + ai * 128 + m * 16;
#pragma unroll
            for (int bj = 0; bj < 2; ++bj) {
              const pg8::f32x4 v0 = acc[ai][bj][m][0], v1 = acc[ai][bj][m][1];
              u4v o; o.x = pk2(v0[0], v0[1]); o.y = pk2(v0[2], v0[3]); o.z = pk2(v1[0], v1[1]); o.w = pk2(v1[2], v1[3]);
              *(u4v*)(dst + (size_t)row * 512 + bj * 128 + colu) = o;
            }
          }
      } else if (colu < 32) {
        float* dst = (float*)(ws + OFF_KPE);
#pragma unroll
        for (int ai = 0; ai < 2; ++ai)
#pragma unroll
          for (int m = 0; m < 4; ++m) {
            const int row = rowb + ai * 128 + m * 16;
            *(pg8::f32x4*)(dst + (size_t)row * 32 + colu) = acc[ai][0][m][0];
            *(pg8::f32x4*)(dst + (size_t)row * 32 + colu + 4) = acc[ai][0][m][1];
          }
      }
    } else {
      const int cb = (pn - 8) * 256 + colu;
      f4v b0[2], b1[2];
#pragma unroll
      for (int bj = 0; bj < 2; ++bj) { b0[bj] = *(const f4v*)(b_gate + cb + bj * 128); b1[bj] = *(const f4v*)(b_gate + cb + bj * 128 + 4); }
#pragma unroll
      for (int ai = 0; ai < 2; ++ai)
#pragma unroll
        for (int m = 0; m < 4; ++m) {
          const int row = rowb + ai * 128 + m * 16;
#pragma unroll
          for (int bj = 0; bj < 2; ++bj) {
            const pg8::f32x4 v0 = acc[ai][bj][m][0], v1 = acc[ai][bj][m][1];
            u4v o; o.x = pk2(sigmoidf_(v0[0] + b0[bj].x), sigmoidf_(v0[1] + b0[bj].y)); o.y = pk2(sigmoidf_(v0[2] + b0[bj].z), sigmoidf_(v0[3] + b0[bj].w));
            o.z = pk2(sigmoidf_(v1[0] + b1[bj].x), sigmoidf_(v1[1] + b1[bj].y)); o.w = pk2(sigmoidf_(v1[2] + b1[bj].z), sigmoidf_(v1[3] + b1[bj].w));
            *(u4v*)(mg + ((((size_t)(u.pm * 8 + (pn - 8)) * 8 + (wr * 4 + wc)) * 16 + (ai * 8 + m * 2 + bj)) * 64 + (fq * 16 + fr)) * 8) = o;
          }
        }
    }
  }
};


struct Epi6 {
  static constexpr bool PERM = true, AFTER_DRAIN = false;
  u16* out; float* ssq; bool dup;
  DI void operator()(const pg8::f32x4 (&acc)[2][2][4][2], const pg8::Unit& u, int wr, int wc, int fr, int fq) const {
    const int rowb = u.pm * 256 + wr * 64 + fr;
    const int colb = u.pn * 256 + wc * 32 + 8 * fq;
#pragma unroll
    for (int ai = 0; ai < 2; ++ai)
#pragma unroll
      for (int m = 0; m < 4; ++m) {
        const int row = rowb + ai * 128 + m * 16;
        float ss = 0.f;
#pragma unroll
        for (int bj = 0; bj < 2; ++bj) {
          const pg8::f32x4 v0 = acc[ai][bj][m][0], v1 = acc[ai][bj][m][1];
          ss += v0[0] * v0[0] + v0[1] * v0[1] + v0[2] * v0[2] + v0[3] * v0[3] + v1[0] * v1[0] + v1[1] * v1[1] + v1[2] * v1[2] + v1[3] * v1[3];
          u4v o; o.x = pk2(v0[0], v0[1]); o.y = pk2(v0[2], v0[3]); o.z = pk2(v1[0], v1[1]); o.w = pk2(v1[2], v1[3]);
          *(u4v*)(out + (size_t)row * 1024 + colb + bj * 128) = o;
        }
        ss = xor16_add(ss); ss = xor32_add(ss);
        if (fq == 0 && !dup) atomicAdd(ssq + row, ss);
      }
  }
};
template <bool SECOND> struct Epi5 {
  static constexpr bool PERM = true, AFTER_DRAIN = false;
  const u16* mg; u16* mi; u16* mo;
  DI void operator()(const pg8::f32x4 (&acc)[2][2][4][2], const pg8::Unit& u, int wr, int wc, int fr, int fq) const {
    const int rowb = u.pm * 256 + wr * 64 + fr;
    const int colb = u.pn * 256 + wc * 32 + 8 * fq;
    const size_t gbase = (((size_t)(u.pm * 8 + u.pn + (SECOND ? 4 : 0)) * 8 + (wr * 4 + wc)) * 16) * 64 + (fq * 16 + fr);
    const size_t ibase = (((size_t)(u.pm * 4 + u.pn) * 8 + (wr * 4 + wc)) * 16) * 64 + (fq * 16 + fr);
#pragma unroll
    for (int hb = 0; hb < 4; ++hb) {
      const int ai = hb >> 1, m0 = (hb & 1) * 2;
      u4v g[4], pm[4];
#pragma unroll
      for (int f4 = 0; f4 < 4; ++f4) {
        const int f = ai * 8 + (m0 + (f4 >> 1)) * 2 + (f4 & 1);
        g[f4] = *(const u4v*)(mg + (gbase + (size_t)f * 64) * 8);
        if (SECOND) pm[f4] = *(const u4v*)(mi + (ibase + (size_t)f * 64) * 8);
      }
#pragma unroll
      for (int f4 = 0; f4 < 4; ++f4) {
        const int m = m0 + (f4 >> 1), bj = f4 & 1;
        const int row = rowb + ai * 128 + m * 16;
        const pg8::f32x4 v0 = acc[ai][bj][m][0], v1 = acc[ai][bj][m][1];
        float r0 = v0[0] * bflo(g[f4].x), r1 = v0[1] * bfhi(g[f4].x), r2 = v0[2] * bflo(g[f4].y), r3 = v0[3] * bfhi(g[f4].y);
        float r4 = v1[0] * bflo(g[f4].z), r5 = v1[1] * bfhi(g[f4].z), r6 = v1[2] * bflo(g[f4].w), r7 = v1[3] * bfhi(g[f4].w);
        if (SECOND) {
          r0 += bflo(pm[f4].x); r1 += bfhi(pm[f4].x); r2 += bflo(pm[f4].y); r3 += bfhi(pm[f4].y);
          r4 += bflo(pm[f4].z); r5 += bfhi(pm[f4].z); r6 += bflo(pm[f4].w); r7 += bfhi(pm[f4].w);
        }
        u4v o; o.x = pk2(r0, r1); o.y = pk2(r2, r3); o.z = pk2(r4, r5); o.w = pk2(r6, r7);
        if (SECOND) *(u4v*)(mo + (size_t)row * 1024 + colb + bj * 128) = o;
        else *(u4v*)(mi + (ibase + (size_t)(ai * 8 + m * 2 + bj) * 64) * 8) = o;
      }
      __builtin_amdgcn_sched_barrier(0);
    }
  }
};
struct EpiQ {
  static constexpr bool PERM = true, AFTER_DRAIN = false;
  const float* ssq_q; const float* rope; u16* Qo;
  DI void operator()(const pg8::f32x4 (&acc)[2][2][4][2], const pg8::Unit& u, int wr, int wc, int fr, int fq) const {
    const int rowb = u.pm * 256 + wr * 64 + fr;
    const int colu = wc * 32 + 8 * fq;
    float sq[8];
#pragma unroll
    for (int i = 0; i < 8; ++i) sq[i] = ssq_q[rowb + (i >> 2) * 128 + (i & 3) * 16];
    if (u.pn < 2) {
#pragma unroll
      for (int ai = 0; ai < 2; ++ai)
#pragma unroll
        for (int m = 0; m < 4; ++m) {
          const int row = rowb + ai * 128 + m * 16;
          const int b = row >> 12, spos = row & 4095;
          const float sc = rsqrtf(sq[ai * 4 + m] * (1.f / 768.f) + EPS) * QSCALE;
#pragma unroll
          for (int bj = 0; bj < 2; ++bj) {
            const pg8::f32x4 v0 = acc[ai][bj][m][0], v1 = acc[ai][bj][m][1];
            const int head = u.pn * 4 + bj * 2 + (colu >> 6), d = colu & 63;
            u4v o; o.x = pk2(v0[0] * sc, v0[1] * sc); o.y = pk2(v0[2] * sc, v0[3] * sc); o.z = pk2(v1[0] * sc, v1[1] * sc); o.w = pk2(v1[2] * sc, v1[3] * sc);
            *(u4v*)(Qo + ((size_t)(b * 8 + head) * 4096 + spos) * 96 + d) = o;
          }
        }
    } else {
#pragma unroll
      for (int ai = 0; ai < 2; ++ai) {
        f4v cs[4], sn[4];
#pragma unroll
        for (int i = 0; i < 4; ++i) {
          const int spos = (rowb + ai * 128 + i * 16) & 4095;
          cs[i] = *(const f4v*)(rope + spos * 16 + 4 * fq); sn[i] = *(const f4v*)(rope + 65536 + spos * 16 + 4 * fq);
        }
#pragma unroll
        for (int m = 0; m < 4; ++m) {
          const int row = rowb + ai * 128 + m * 16;
          const int b = row >> 12, spos = row & 4095;
          const float sc = rsqrtf(sq[ai * 4 + m] * (1.f / 768.f) + EPS) * QSCALE;
          const f4v c4 = cs[m], s4 = sn[m];
#pragma unroll
          for (int bj = 0; bj < 2; ++bj) {
            const pg8::f32x4 v0 = acc[ai][bj][m][0], v1 = acc[ai][bj][m][1];
            const int head = bj * 4 + wc;
            u2v o1, o2;
            o1.x = pk2((v0[0] * c4.x - v1[0] * s4.x) * sc, (v0[1] * c4.y - v1[1] * s4.y) * sc);
            o1.y = pk2((v0[2] * c4.z - v1[2] * s4.z) * sc, (v0[3] * c4.w - v1[3] * s4.w) * sc);
            o2.x = pk2((v0[0] * s4.x + v1[0] * c4.x) * sc, (v0[1] * s4.y + v1[1] * c4.y) * sc);
            o2.y = pk2((v0[2] * s4.z + v1[2] * c4.z) * sc, (v0[3] * s4.w + v1[3] * c4.w) * sc);
            u16* qp = Qo + ((size_t)(b * 8 + head) * 4096 + spos) * 96 + 64 + 4 * fq;
            *(u2v*)qp = o1; *(u2v*)(qp + 16) = o2;
          }
        }
        __builtin_amdgcn_sched_barrier(0);
      }
    }
  }
};

struct EpiK {
  static constexpr bool PERM = true, AFTER_DRAIN = false;
  const float* ssq_kv; u16* Ko;
  DI void operator()(const pg8::f32x4 (&acc)[2][2][4][2], const pg8::Unit& u, int wr, int wc, int fr, int fq) const {
    const int rowb = u.pm * 256 + wr * 64 + fr;
    float sq[8];
#pragma unroll
    for (int i = 0; i < 8; ++i) sq[i] = ssq_kv[rowb + (i >> 2) * 128 + (i & 3) * 16];
#pragma unroll
    for (int ai = 0; ai < 2; ++ai)
#pragma unroll
      for (int m = 0; m < 4; ++m) {
        const int row = rowb + ai * 128 + m * 16;
        const int b = row >> 12, spos = row & 4095;
        const float sc = rsqrtf(sq[ai * 4 + m] * (1.f / 256.f) + EPS);
#pragma unroll
        for (int bj = 0; bj < 2; ++bj) {
          const pg8::f32x4 v0 = acc[ai][bj][m][0], v1 = acc[ai][bj][m][1];
          const int col = u.pn * 256 + bj * 128 + wc * 32 + 8 * fq;
          const int head = col >> 6, d = col & 63;
          u4v o; o.x = pk2(v0[0] * sc, v0[1] * sc); o.y = pk2(v0[2] * sc, v0[3] * sc); o.z = pk2(v1[0] * sc, v1[1] * sc); o.w = pk2(v1[2] * sc, v1[3] * sc);
          *(u4v*)(Ko + ((size_t)(b * 8 + head) * 4096 + spos) * 96 + d) = o;
        }
      }
  }
};
struct EpiV {
  static constexpr bool PERM = false, AFTER_DRAIN = false;
  const float* ssq_kv; u16* Vo;
  DI void operator()(const pg8::f32x4 (&acc)[2][2][4][2], const pg8::Unit& u, int wr, int wc, int fr, int fq) const {
    f4v sq[8];
#pragma unroll
    for (int i = 0; i < 8; ++i) sq[i] = *(const f4v*)(ssq_kv + u.pm * 256 + (i >> 2) * 128 + wr * 64 + (i & 3) * 16 + 4 * fq);
#pragma unroll
    for (int ai = 0; ai < 2; ++ai)
#pragma unroll
      for (int m = 0; m < 4; ++m) {
        const int row4 = u.pm * 256 + ai * 128 + wr * 64 + m * 16 + 4 * fq;
        const int b = row4 >> 12, spos = row4 & 4095;
        const f4v q = sq[ai * 4 + m];
        const float s0 = rsqrtf(q.x * (1.f / 256.f) + EPS), s1 = rsqrtf(q.y * (1.f / 256.f) + EPS), s2 = rsqrtf(q.z * (1.f / 256.f) + EPS), s3 = rsqrtf(q.w * (1.f / 256.f) + EPS);
#pragma unroll
        for (int bj = 0; bj < 2; ++bj)
#pragma unroll
          for (int n = 0; n < 2; ++n) {
            const pg8::f32x4 v = acc[ai][bj][m][n];
            const int col = u.pn * 256 + bj * 128 + wc * 32 + n * 16 + fr;
            const int head = col >> 6, dv = col & 63;
            u2v o; o.x = pk2(v[0] * s0, v[1] * s1); o.y = pk2(v[2] * s2, v[3] * s3);
            *(u2v*)(Vo + ((size_t)(b * 8 + head) * 64 + dv) * 4096 + spos) = o;
          }
        __builtin_amdgcn_sched_barrier(0);
      }
  }
};
DI void phase1(const Params& p, unsigned char* smem, bool dup = false) {
  unsigned char* ws = p.ws;
  pg8::Gemm g{(const u16*)(ws + OFF_H), (const u16*)(ws + OFF_WIN), T, NP, 1024};
  pg8::StaticOrder S; S.init(T, NP, (int)gridDim.x, (int)blockIdx.x);
  Epi1 E{ws, (u16*)p.out, p.b_gate, dup};
  pg8::gemm_phase<Epi1, pg8::StaticOrder, false>((PG8_LAS unsigned char*)smem, g, S, E, nullptr);
  const int nlight = (int)gridDim.x / 2;
  if (!dup && (int)blockIdx.x >= (int)gridDim.x - nlight) {
    const int gtid = ((int)blockIdx.x - ((int)gridDim.x - nlight)) * (int)blockDim.x + (int)threadIdx.x, gthreads = nlight * (int)blockDim.x;
    conv_weight<1>((u16*)(ws + OFF_WUQ), p.w_uq, 768, 768, 768, p.g_q, 1023, gtid, gthreads);
    conv_weight<3>((u16*)(ws + OFF_WUKV), p.w_ukv, 1024, 1024, 256, p.g_kv, 255, gtid, gthreads);
    conv_weight<2>((u16*)(ws + OFF_WA), p.w_a, 1024, 1024, 512, nullptr, 0, gtid, gthreads);
    conv_weight<2>((u16*)(ws + OFF_WB), p.w_b, 1024, 1024, 512, p.g_hgrn, 63, gtid, gthreads);
    conv_weight<2>((u16*)(ws + OFF_WO), p.w_out, 1024, 1024, 1024, nullptr, 0, gtid, gthreads);
  }
}

DI void hgrn_prep_tile(const Params& p, float* stage, int tid, int b, int hh, int prow0, int nblk0) {
  unsigned char* ws = p.ws;
  const int bh = b * 8 + hh;
  if (tid < 128) {
    const int c = tid & 63, blk = tid >> 6;
    const float l0 = p.lb_logits[hh * 64 + c], l1 = p.lb_logits[512 + hh * 64 + c];
    const float lbv = 1.f / (1.f + expf(l1 - l0));
    float cum = 0.f;
    for (int rr = 0; rr < 32; ++rr) {
      float* sp = stage + (blk * 32 + rr) * SST + c;
      const float q = sp[0], hf = sp[64];
      const float sg = 1.f / (1.f + expf(-hf));
      const float f = lbv + (1.f - lbv) * sg;
      cum += logf(f);
      const float e = expf(cum);
      sp[0] = q * e;
      sp[64] = (1.f - f) / e;
    }
    ((float*)(ws + OFF_DECAY))[((size_t)bh * 128 + nblk0 + blk) * 64 + c] = expf(cum);
  }
  __syncthreads();
#pragma unroll
  for (int it = 0; it < 2; ++it) {
    const int item = tid + 256 * it, rr = item >> 3, cc = (item & 7) * 8;
    const f4v a = *(const f4v*)(stage + rr * SST + cc), c = *(const f4v*)(stage + rr * SST + cc + 4);
    const f4v d = *(const f4v*)(stage + rr * SST + 64 + cc), e = *(const f4v*)(stage + rr * SST + 64 + cc + 4);
    const size_t o = (size_t)(prow0 + rr) * 512 + hh * 64 + cc;
    *(u4v*)((u16*)(ws + OFF_QDEC) + o) = pk8(a, c);
    *(u4v*)((u16*)(ws + OFF_KINV) + o) = pk8(d, e);
  }
}
DI void hi_vt_tile(const Params& p, float* stage, int tid, int b, int q2, int nblk0) {
  unsigned char* ws = p.ws;
#pragma unroll
        for (int it = 0; it < 4; ++it) {
          const int item = tid + 256 * it, sc = item & 3, col = (item >> 2) & 127, blk = item >> 9;
          float v[8];
#pragma unroll
          for (int i = 0; i < 8; ++i) v[i] = stage[(blk * 32 + sc * 8 + i) * SST + col];
          u4v o; o.x = pk2(v[0], v[1]); o.y = pk2(v[2], v[3]); o.z = pk2(v[4], v[5]); o.w = pk2(v[6], v[7]);
          const int bh = b * 8 + q2 * 2 + (col >> 6);
          *(u4v*)((u16*)(ws + OFF_VT) + (((size_t)bh * 128 + nblk0 + blk) * 64 + (col & 63)) * 32 + sc * 8) = o;
        }
}
DI void stage_load64(float* stage, const u16* src, int coff, int tid) {
#pragma unroll
  for (int it = 0; it < 2; ++it) {
    const int item = tid + 256 * it, rr = item >> 3, ch = item & 7;
    const u4v v = *(const u4v*)(src + (size_t)rr * 512 + ch * 8);
    float* d = stage + rr * SST + coff + ch * 8;
    *(f4v*)d = f4v{bflo(v.x), bfhi(v.x), bflo(v.y), bfhi(v.y)};
    *(f4v*)(d + 4) = f4v{bflo(v.z), bfhi(v.z), bflo(v.w), bfhi(v.w)};
  }
}


constexpr int PST = 68;
DI void hgrn_prep_native(const Params& p, float* pl, int rb, int hh) {
  unsigned char* ws = p.ws;
  const int tid = threadIdx.x;
  float* Qp = pl; float* G = pl + 128 * PST; float* Kn = pl + 2 * 128 * PST;
  const int prow0 = rb * 128, b = prow0 >> 12, bh = b * 8 + hh, nblk0 = (prow0 & 4095) >> 5;
  const int ch = tid & 7;
  float lbv[8];
  {
    const f4v a0 = *(const f4v*)(p.lb_logits + hh * 64 + ch * 8), a1 = *(const f4v*)(p.lb_logits + hh * 64 + ch * 8 + 4);
    const f4v b0 = *(const f4v*)(p.lb_logits + 512 + hh * 64 + ch * 8), b1 = *(const f4v*)(p.lb_logits + 512 + hh * 64 + ch * 8 + 4);
    const float l0[8] = {a0.x, a0.y, a0.z, a0.w, a1.x, a1.y, a1.z, a1.w}, l1[8] = {b0.x, b0.y, b0.z, b0.w, b1.x, b1.y, b1.z, b1.w};
#pragma unroll
    for (int i = 0; i < 8; ++i) lbv[i] = 1.f / (1.f + expf(l1[i] - l0[i]));
  }
  __syncthreads();
#pragma unroll
  for (int it = 0; it < 2; ++it) {
    const int rr = (tid + 512 * it) >> 3;
    const size_t go = (size_t)(prow0 + rr) * 512 + hh * 64 + ch * 8;
    const u4v qv = *(const u4v*)((const u16*)(ws + OFF_HQ) + go), fv = *(const u4v*)((const u16*)(ws + OFF_HF) + go);
    const float q[8] = {bflo(qv.x), bfhi(qv.x), bflo(qv.y), bfhi(qv.y), bflo(qv.z), bfhi(qv.z), bflo(qv.w), bfhi(qv.w)};
    const float hf[8] = {bflo(fv.x), bfhi(fv.x), bflo(fv.y), bfhi(fv.y), bflo(fv.z), bfhi(fv.z), bflo(fv.w), bfhi(fv.w)};
    float g[8], kn[8];
#pragma unroll
    for (int i = 0; i < 8; ++i) {
      const float sg = rcpf(1.f + __builtin_amdgcn_exp2f(-1.4426950408889634f * hf[i]));
      const float f = lbv[i] + (1.f - lbv[i]) * sg;
      g[i] = __builtin_amdgcn_logf(f);
      kn[i] = 1.f - f;
    }
    float* d = Qp + rr * PST + ch * 8;
    *(f4v*)d = f4v{q[0], q[1], q[2], q[3]}; *(f4v*)(d + 4) = f4v{q[4], q[5], q[6], q[7]};
    d = G + rr * PST + ch * 8;
    *(f4v*)d = f4v{g[0], g[1], g[2], g[3]}; *(f4v*)(d + 4) = f4v{g[4], g[5], g[6], g[7]};
    d = Kn + rr * PST + ch * 8;
    *(f4v*)d = f4v{kn[0], kn[1], kn[2], kn[3]}; *(f4v*)(d + 4) = f4v{kn[4], kn[5], kn[6], kn[7]};
  }
  __syncthreads();
  if (tid < 256) {
    const int c = tid & 63, blk = tid >> 6;
    float* gp = G + (blk * 32) * PST + c;
    float v[32];
#pragma unroll
    for (int r2 = 0; r2 < 32; ++r2) v[r2] = gp[r2 * PST];
    float cum = 0.f;
#pragma unroll
    for (int r2 = 0; r2 < 32; ++r2) { cum += v[r2]; gp[r2 * PST] = cum; }
    ((float*)(ws + OFF_DECAY))[((size_t)bh * 128 + nblk0 + blk) * 64 + c] = __builtin_amdgcn_exp2f(cum);
  }
  __syncthreads();
#pragma unroll
  for (int it = 0; it < 2; ++it) {
    const int rr = (tid + 512 * it) >> 3;
    const float* s0 = Qp + rr * PST + ch * 8; const float* s1 = G + rr * PST + ch * 8; const float* s2 = Kn + rr * PST + ch * 8;
    const f4v q0 = *(const f4v*)s0, q1 = *(const f4v*)(s0 + 4), c0 = *(const f4v*)s1, c1 = *(const f4v*)(s1 + 4), k0 = *(const f4v*)s2, k1 = *(const f4v*)(s2 + 4);
    const float q[8] = {q0.x, q0.y, q0.z, q0.w, q1.x, q1.y, q1.z, q1.w}, cm[8] = {c0.x, c0.y, c0.z, c0.w, c1.x, c1.y, c1.z, c1.w}, kn[8] = {k0.x, k0.y, k0.z, k0.w, k1.x, k1.y, k1.z, k1.w};
    float qd[8], ki[8];
#pragma unroll
    for (int i = 0; i < 8; ++i) { qd[i] = q[i] * __builtin_amdgcn_exp2f(cm[i]); ki[i] = kn[i] * __builtin_amdgcn_exp2f(-cm[i]); }
    const size_t go = (size_t)(prow0 + rr) * 512 + hh * 64 + ch * 8;
    u4v o; o.x = pk2(qd[0], qd[1]); o.y = pk2(qd[2], qd[3]); o.z = pk2(qd[4], qd[5]); o.w = pk2(qd[6], qd[7]);
    *(u4v*)((u16*)(ws + OFF_QDEC) + go) = o;
    o.x = pk2(ki[0], ki[1]); o.y = pk2(ki[2], ki[3]); o.z = pk2(ki[4], ki[5]); o.w = pk2(ki[6], ki[7]);
    *(u4v*)((u16*)(ws + OFF_KINV) + go) = o;
  }
}
constexpr int VTS = 136;
DI void hi_vt_native(const Params& p, u16* img, int rb, int q2) {
  unsigned char* ws = p.ws;
  const int tid = threadIdx.x;
  const int prow0 = rb * 128, b = prow0 >> 12, nblk0 = (prow0 & 4095) >> 5;
  __syncthreads();
#pragma unroll
  for (int it = 0; it < 4; ++it) {
    const int item = tid + 512 * it, rr = item >> 4, c16 = item & 15;
    *(u4v*)(img + rr * VTS + c16 * 8) = *(const u4v*)((const u16*)(ws + OFF_HI) + (size_t)(prow0 + rr) * 512 + q2 * 128 + c16 * 8);
  }
  __syncthreads();
#pragma unroll
  for (int it = 0; it < 4; ++it) {
    const int item = tid + 512 * it, sc = item & 3, col = (item >> 2) & 127, blk = item >> 9;
    u32 w[4];
#pragma unroll
    for (int i = 0; i < 4; ++i) {
      const u32 lo = img[(blk * 32 + sc * 8 + 2 * i) * VTS + col], hi = img[(blk * 32 + sc * 8 + 2 * i + 1) * VTS + col];
      w[i] = lo | (hi << 16);
    }
    const int bh = b * 8 + q2 * 2 + (col >> 6);
    *(u4v*)((u16*)(ws + OFF_VT) + (((size_t)bh * 128 + nblk0 + blk) * 64 + (col & 63)) * 32 + sc * 8) = u4v{w[0], w[1], w[2], w[3]};
  }
}

DI void rope8(const float* x1, const float* x2, const float* rope, int spos, int j0, bool first, float scale, float (&o)[8]) {
  const f4v c0 = *(const f4v*)(rope + spos * 16 + j0), c1 = *(const f4v*)(rope + spos * 16 + j0 + 4);
  const f4v s0 = *(const f4v*)(rope + 65536 + spos * 16 + j0), s1 = *(const f4v*)(rope + 65536 + spos * 16 + j0 + 4);
  const float cs[8] = {c0.x, c0.y, c0.z, c0.w, c1.x, c1.y, c1.z, c1.w};
  const float sn[8] = {s0.x, s0.y, s0.z, s0.w, s1.x, s1.y, s1.z, s1.w};
#pragma unroll
  for (int i = 0; i < 8; ++i) o[i] = scale * (first ? (x1[i] * cs[i] - x2[i] * sn[i]) : (x1[i] * sn[i] + x2[i] * cs[i]));
}

DI void phase2(const Params& p, unsigned char* smem, u16* lds) {
  unsigned char* ws = p.ws;
  const int tid = VTID;
  float* stage = (float*)lds;
  const float* ssq_q = (const float*)(ws + OFF_SSQ);
  const float* ssq_kv = ssq_q + T;
  const float* rope = (const float*)(ws + OFF_ROPE);
  u16* Qo = (u16*)(ws + OFF_Q);
  u16* Ko = (u16*)(ws + OFF_K);
  u16* Vo = (u16*)(ws + OFF_VTT);
#pragma nounroll
  for (int rep = 0; rep < (DUP_PH == 21 ? p.ph_hi - 7 : 1); ++rep) {
    pg8::Gemm g{(const u16*)(ws + OFF_CQ), (const u16*)(ws + OFF_WUQ), T, 768, 768};
    pg8::StaticOrder S; S.init(T, 768, (int)gridDim.x, (int)blockIdx.x);
    EpiQ E{ssq_q, rope, Qo};
    pg8::gemm_phase<EpiQ, pg8::StaticOrder, false>((PG8_LAS unsigned char*)smem, g, S, E, nullptr);
  }
#pragma nounroll
  for (int rep = 0; rep < (DUP_PH == 23 ? p.ph_hi - 7 : 1); ++rep) {
    pg8::StaticOrder S; S.init(T, 512, (int)gridDim.x, (int)blockIdx.x);
    {
      int kk = 256; asm volatile("" : "+s"(kk));
      pg8::Gemm g{(const u16*)(ws + OFF_CKV), (const u16*)(ws + OFF_WUKV), T, 512, kk};
      EpiK E{ssq_kv, Ko};
      pg8::gemm_phase<EpiK, pg8::StaticOrder, false>((PG8_LAS unsigned char*)smem, g, S, E, nullptr);
    }
  }
  {
    pg8::StaticOrder S; S.init(T, 512, (int)gridDim.x, (int)blockIdx.x);
    int kk = 256; asm volatile("" : "+s"(kk));
    pg8::Gemm g{(const u16*)(ws + OFF_CKV), (const u16*)(ws + OFF_WUKV) + (size_t)512 * 256, T, 512, kk};
    EpiV E{(const float*)(ws + OFF_SSQ) + T, (u16*)(ws + OFF_VTT)};
    pg8::gemm_phase<EpiV, pg8::StaticOrder, false, true>((PG8_LAS unsigned char*)smem, g, S, E, nullptr);
  }
#pragma nounroll
  for (int rep = 0; rep < (DUP_PH == 22 ? p.ph_hi - 7 : 1); ++rep) {
    const int gtid = blockIdx.x * blockDim.x + threadIdx.x, gthreads = gridDim.x * blockDim.x;
    for (int idx = gtid; idx < T * 4; idx += gthreads) {
      const int tok = idx >> 2, wv = (idx & 3) * 8, j0 = wv & 15;
      const int b = tok >> 12, spos = tok & 4095;
      const float* kp = (const float*)(ws + OFF_KPE) + (size_t)tok * 32;
      const f4v a0 = *(const f4v*)(kp + j0), a1 = *(const f4v*)(kp + j0 + 4);
      const f4v b0 = *(const f4v*)(kp + 16 + j0), b1 = *(const f4v*)(kp + 16 + j0 + 4);
      const float x1[8] = {a0.x, a0.y, a0.z, a0.w, a1.x, a1.y, a1.z, a1.w};
      const float x2[8] = {b0.x, b0.y, b0.z, b0.w, b1.x, b1.y, b1.z, b1.w};
      float o[8];
      rope8(x1, x2, rope, spos, j0, wv < 16, 1.f, o);
      u4v ov; ov.x = pk2(o[0], o[1]); ov.y = pk2(o[2], o[3]); ov.z = pk2(o[4], o[5]); ov.w = pk2(o[6], o[7]);
#pragma unroll
      for (int head = 0; head < 8; ++head) *(u4v*)(Ko + ((size_t)(b * 8 + head) * 4096 + spos) * 96 + 64 + wv) = ov;
    }
  }
  for (int rep = 0; rep < (DUP_PH == 20 ? 2 : 1); ++rep)
  {
    const int G = (int)gridDim.x, c = (int)blockIdx.x, hG = G / 2, round = 2 * G + hG;
    for (int base = 0; base < 2048 + 1024; base += round) {
#pragma unroll 1
      for (int k = 0; k < 3; ++k) {
        if (k == 2 && c < G - hG) break;
        const int t = base + (k == 0 ? c : k == 1 ? G + c : 2 * G + (c - (G - hG)));
        if (t >= 2048 + 1024) break;
        if (t < 2048) hgrn_prep_native(p, (float*)smem, t >> 3, t & 7);
        else hi_vt_native(p, (u16*)smem, (t - 2048) >> 2, (t - 2048) & 3);
      }
    }
  }
}

DI void phase2b(const Params& p, unsigned char* smem) {
  unsigned char* ws = p.ws;
  const int tid = VTID;
}

constexpr int KST2 = 104, VST2 = 132;
constexpr int ATT_BUF2 = 128 * KST2 + 64 * VST2;
DI void att_qk(const u16* sk, const bf16x8 (&qf)[6], float nm, f32x16 (&st)[2]) {
#pragma unroll
  for (int i = 0; i < 16; ++i) { st[0][i] = nm; st[1][i] = nm; }
#pragma unroll
  for (int kb = 0; kb < 2; ++kb)
#pragma unroll
    for (int ks = 0; ks < 6; ++ks) {
      const bf16x8 kf = *(const bf16x8*)(sk + kb * 32 * KST2 + ks * 16);
      st[kb] = MFMA(kf, qf[ks], st[kb]);
    }
}
DI float att_softmax(f32x16 (&st)[2], float adj, bool adjnz, bool first, float& mref, float& l, f32x16 (&o)[2]) {
  float mx = st[0][0];
#pragma unroll
  for (int i = 1; i < 16; ++i) mx = fmaxf(mx, st[0][i]);
#pragma unroll
  for (int i = 0; i < 16; ++i) mx = fmaxf(mx, st[1][i]);
  mx = xor32_max(mx) - adj;
  f2v ps = f2v{0.f, 0.f};
  float shift_out = 0.f;
  if (first || adjnz || __builtin_amdgcn_ballot_w64(mx > 8.f) != 0ull) {
    const float shift = first ? mx : fmaxf(mx, 0.f);
    const float tot = adj + shift;
    const float alpha = first ? 0.f : __builtin_amdgcn_exp2f(-shift);
    mref += shift;
#pragma unroll
    for (int kb = 0; kb < 2; ++kb)
#pragma unroll
      for (int i = 0; i < 16; i += 2) {
        const float p0 = __builtin_amdgcn_exp2f(st[kb][i] - tot), p1 = __builtin_amdgcn_exp2f(st[kb][i + 1] - tot);
        st[kb][i] = p0; st[kb][i + 1] = p1; ps += f2v{p0, p1};
      }
    l = l * alpha + (ps.x + ps.y);
#pragma unroll
    for (int i = 0; i < 16; ++i) { o[0][i] *= alpha; o[1][i] *= alpha; }
    shift_out = shift;
  } else {
#pragma unroll
    for (int kb = 0; kb < 2; ++kb)
#pragma unroll
      for (int i = 0; i < 16; i += 2) {
        const float p0 = __builtin_amdgcn_exp2f(st[kb][i]), p1 = __builtin_amdgcn_exp2f(st[kb][i + 1]);
        st[kb][i] = p0; st[kb][i + 1] = p1; ps += f2v{p0, p1};
      }
    l += ps.x + ps.y;
  }
  return shift_out;
}
DI void att_pv(const u16* sv, const f32x16 (&st)[2], f32x16 (&o)[2]) {
#pragma unroll
  for (int s4 = 0; s4 < 4; ++s4) {
    const int kb = s4 >> 1, rb = 8 * (s4 & 1);
    u4v pu; pu.x = pk2(st[kb][rb], st[kb][rb + 1]); pu.y = pk2(st[kb][rb + 2], st[kb][rb + 3]);
    pu.z = pk2(st[kb][rb + 4], st[kb][rb + 5]); pu.w = pk2(st[kb][rb + 6], st[kb][rb + 7]);
    const bf16x8 pb = __builtin_bit_cast(bf16x8, pu);
#pragma unroll
    for (int db = 0; db < 2; ++db) {
      const s16x4 lo = *(const s16x4*)(sv + db * 32 * VST2 + 16 * s4);
      const s16x4 hi = *(const s16x4*)(sv + db * 32 * VST2 + 16 * s4 + 8);
      const bf16x8 vf = __builtin_shufflevector(lo, hi, 0, 1, 2, 3, 4, 5, 6, 7);
      o[db] = MFMA(vf, pb, o[db]);
    }
  }
}
DI void attn8_item(const Params& p, u16* lds, int bh, int qt) {
  unsigned char* ws = p.ws;
  const int tid = threadIdx.x, lane = tid & 63, w = tid >> 6, r = lane & 31, h = lane >> 5;
  const u16* Qp = (const u16*)(ws + OFF_Q) + (size_t)bh * 4096 * 96;
  const u16* Kp = (const u16*)(ws + OFF_K) + (size_t)bh * 4096 * 96;
  const u16* Vp = (const u16*)(ws + OFF_VTT) + (size_t)bh * 64 * 4096;
  const int q0 = qt * 256 + w * 32;
  bf16x8 qf[6];
#pragma unroll
  for (int ks = 0; ks < 6; ++ks) qf[ks] = *(const bf16x8*)(Qp + (size_t)(q0 + r) * 96 + ks * 16 + h * 8);
  f32x16 o[2]; o[0] = zero16(); o[1] = zero16();
  float mref = 0.f, l = 0.f;
  const int Jmax = 2 * qt + 1, jw = 4 * qt + (w >> 1);
  int kr[3], kc[3];
#pragma unroll
  for (int i = 0; i < 3; ++i) { const int idx = tid + 512 * i; kr[i] = idx / 12; kc[i] = idx % 12; }
  const int vr = tid >> 4, vc = tid & 15;
  u4v rk[3], rv[2];
#pragma unroll
  for (int i = 0; i < 3; ++i) rk[i] = *(const u4v*)(Kp + (size_t)kr[i] * 96 + kc[i] * 8);
#pragma unroll
  for (int i = 0; i < 2; ++i) rv[i] = *(const u4v*)(Vp + (size_t)(vr + 32 * i) * 4096 + vc * 8);
  __syncthreads();
#pragma unroll
  for (int i = 0; i < 3; ++i) *(u4v*)(lds + kr[i] * KST2 + kc[i] * 8) = rk[i];
#pragma unroll
  for (int i = 0; i < 2; ++i) { u16* dv = lds + 128 * KST2 + (vr + 32 * i) * VST2 + vc * 8; *(u2v*)dv = u2v{rv[i].x, rv[i].y}; *(u2v*)(dv + 4) = u2v{rv[i].z, rv[i].w}; }
  __syncthreads();
  for (int J = 0; J <= Jmax; ++J) {
    const int cur = J & 1;
    if (J < Jmax) {
#pragma unroll
      for (int i = 0; i < 3; ++i) rk[i] = *(const u4v*)(Kp + (size_t)((J + 1) * 128 + kr[i]) * 96 + kc[i] * 8);
#pragma unroll
      for (int i = 0; i < 2; ++i) rv[i] = *(const u4v*)(Vp + (size_t)(vr + 32 * i) * 4096 + (J + 1) * 128 + vc * 8);
    }
    const u16* sk = lds + cur * ATT_BUF2 + r * KST2 + h * 8;
    const u16* sv = lds + cur * ATT_BUF2 + 128 * KST2 + r * VST2 + 4 * h;
    if (2 * J + 1 <= jw) {
      f32x16 s0[2], s1[2];
      const float nm = -mref;
      att_qk(sk, qf, nm, s0);
      att_qk(sk + 64 * KST2, qf, nm, s1);
      const float sh = att_softmax(s0, 0.f, false, J == 0, mref, l, o);
      const bool adjnz = __builtin_amdgcn_ballot_w64(sh != 0.f) != 0ull;
      att_pv(sv, s0, o);
      att_softmax(s1, sh, adjnz, false, mref, l, o);
      att_pv(sv + 64, s1, o);
    } else if (2 * J <= jw) {
      f32x16 s0[2];
      att_qk(sk, qf, -mref, s0);
      att_softmax(s0, 0.f, false, J == 0, mref, l, o);
      att_pv(sv, s0, o);
    }
    if (J < Jmax) {
      u16* d = lds + (cur ^ 1) * ATT_BUF2;
#pragma unroll
      for (int i = 0; i < 3; ++i) *(u4v*)(d + kr[i] * KST2 + kc[i] * 8) = rk[i];
#pragma unroll
      for (int i = 0; i < 2; ++i) { u16* dv = d + 128 * KST2 + (vr + 32 * i) * VST2 + vc * 8; *(u2v*)dv = u2v{rv[i].x, rv[i].y}; *(u2v*)(dv + 4) = u2v{rv[i].z, rv[i].w}; }
    }
    __syncthreads();
  }
  l = xor32_add(l);
  const float inv = 1.f / l;
  const int b = bh >> 3, head = bh & 7;
  const size_t tok = (size_t)b * 4096 + q0 + r;
  const u16* sga = (const u16*)(ws + OFF_SGA) + tok * 512 + head * 64;
  u16* ya = (u16*)(ws + OFF_YA) + tok * 512 + head * 64;
#pragma unroll
  for (int db = 0; db < 2; ++db)
#pragma unroll
    for (int g = 0; g < 4; ++g) {
      const int dv0 = db * 32 + 8 * g + 4 * h;
      const u2v gt = *(const u2v*)(sga + dv0);
      u2v ov;
      ov.x = pk2(o[db][4 * g] * inv * bflo(gt.x), o[db][4 * g + 1] * inv * bfhi(gt.x));
      ov.y = pk2(o[db][4 * g + 2] * inv * bflo(gt.y), o[db][4 * g + 3] * inv * bfhi(gt.y));
      *(u2v*)(ya + dv0) = ov;
    }
}

DI void scan_item(const Params& p, int i, size_t out_off = OFF_UPD) {
  unsigned char* ws = p.ws;
  const int tid = threadIdx.x;
  const int bh = i >> 2, part = i & 3;
  const int e = part * 1024 + tid * 2, k = e & 63;
  u32* U = (u32*)((u16*)(ws + OFF_UPD) + (size_t)bh * 128 * 4096 + e);
  u32* UO = (u32*)((u16*)(ws + out_off) + (size_t)bh * 128 * 4096 + e);
  const f2v* Dc = (const f2v*)((const float*)(ws + OFF_DECAY) + (size_t)bh * 128 * 64 + k);
  float s0 = 0.f, s1 = 0.f;
  for (int n0 = 0; n0 < 128; n0 += 32) {
    u32 u[32]; f2v d[32];
#pragma unroll
    for (int q = 0; q < 32; ++q) { u[q] = U[(size_t)(n0 + q) * 2048]; d[q] = Dc[(n0 + q) * 32]; }
#pragma unroll
    for (int q = 0; q < 32; ++q) {
      UO[(size_t)(n0 + q) * 2048] = pk2(s0, s1);
      s0 = d[q].x * (s0 + bflo(u[q]));
      s1 = d[q].y * (s1 + bfhi(u[q]));
    }
  }
}

DI void hgrn_state_item(const Params& p, float* ub, int bh, int vb) {
  unsigned char* ws = p.ws;
  const int tid = threadIdx.x, lane = tid & 63, w = tid >> 6, r = lane & 31, h = lane >> 5;
  const int b = bh >> 3, head = bh & 7;
  const u16* kn_base = (const u16*)(ws + OFF_KINV) + ((size_t)b * 4096) * 512 + head * 64;
  const u16* vt_base = (const u16*)(ws + OFF_VT) + ((size_t)bh * 128) * 64 * 32;
  const float* dec = (const float*)(ws + OFF_DECAY) + (size_t)bh * 128 * 64;
  u16* up = (u16*)(ws + OFF_UPD) + (size_t)bh * 128 * 4096;
  const int vl = tid >> 4, k0 = (tid & 15) * 4;
  constexpr int KS = 68;
  f4v st = f4v{0.f, 0.f, 0.f, 0.f};
#pragma unroll 1
  for (int i = 0; i < 16; ++i) {
    const int n = i * 8 + w;
    bf16x8 a[2][2], bb[2];
    const u16* kn = kn_base + (size_t)(n * 32) * 512;
#pragma unroll
    for (int kb = 0; kb < 2; ++kb)
#pragma unroll
      for (int ks = 0; ks < 2; ++ks) {
        bf16x8 av;
#pragma unroll
        for (int j = 0; j < 8; ++j) av[j] = (short)kn[(size_t)(ks * 16 + h * 8 + j) * 512 + kb * 32 + r];
        a[kb][ks] = av;
      }
#pragma unroll
    for (int ks = 0; ks < 2; ++ks) bb[ks] = *(const bf16x8*)(vt_base + ((size_t)n * 64 + vb * 32 + r) * 32 + ks * 16 + h * 8);
    f4v d[8];
#pragma unroll
    for (int j = 0; j < 8; ++j) d[j] = *(const f4v*)(dec + (size_t)(i * 8 + j) * 64 + k0);
    __syncthreads();
#pragma unroll
    for (int kb = 0; kb < 2; ++kb) {
      f32x16 c = zero16();
      c = MFMA(a[kb][0], bb[0], c);
      c = MFMA(a[kb][1], bb[1], c);
#pragma unroll
      for (int g = 0; g < 4; ++g) *(f4v*)(ub + (w * 32 + r) * KS + kb * 32 + 8 * g + 4 * h) = f4v{c[4 * g], c[4 * g + 1], c[4 * g + 2], c[4 * g + 3]};
    }
    __syncthreads();
#pragma unroll
    for (int j = 0; j < 8; ++j) {
      const f4v u = *(const f4v*)(ub + (j * 32 + vl) * KS + k0);
      u2v o; o.x = pk2(st.x, st.y); o.y = pk2(st.z, st.w);
      *(u2v*)(up + (size_t)(i * 8 + j) * 4096 + (vb * 32 + vl) * 64 + k0) = o;
      st.x = d[j].x * (st.x + u.x); st.y = d[j].y * (st.y + u.y); st.z = d[j].z * (st.z + u.z); st.w = d[j].w * (st.w + u.w);
    }
  }
}

DI void phase3(const Params& p, unsigned char* smem, bool dup = false) {
  int* s_item = (int*)(smem + LDS_BYTES - 64);
  int* ctr = (int*)(p.ws + OFF_SSQ + (size_t)3 * T * 4) + (dup ? 1 : 0);
  constexpr int NSCAN = 0, NATT = 1024;
  if (!dup) for (int it = (int)blockIdx.x - ((int)gridDim.x - 128); it >= 0 && it < 128; it += 128 * 1024) hgrn_state_item(p, (float*)smem, it >> 1, it & 1);
  if (!dup && (int)gridDim.x < 128) for (int it = (int)blockIdx.x; it < 128; it += (int)gridDim.x) hgrn_state_item(p, (float*)smem, it >> 1, it & 1);
  for (;;) {
    __syncthreads();
    if (threadIdx.x == 0) *s_item = atomicAdd(ctr, 1);
    __syncthreads();
    const int item = *s_item;
    if (item >= NSCAN + NATT) break;
    if (item < NSCAN) { }
    else { const int idx = item - NSCAN; attn8_item(p, (u16*)smem, idx & 63, 15 - (idx >> 6)); }
  }
}

DI void phase4(const Params& p) {
  unsigned char* ws = p.ws;
  const int tid = VTID, lane = tid & 63, w = tid >> 6, r = lane & 31, h = lane >> 5;
  for (int t = VBID; t < 2048; t += VBN) {
    const int bh = t >> 5, n = (t & 31) * 4 + w;
    const int b = bh >> 3, head = bh & 7;
    const size_t tok0 = (size_t)b * 4096 + n * 32;
    const u16* qd = (const u16*)(ws + OFF_QDEC) + (tok0 + r) * 512 + head * 64 + h * 8;
    const u16* ki = (const u16*)(ws + OFF_KINV) + (tok0 + r) * 512 + head * 64 + h * 8;
    const u16* vt = (const u16*)(ws + OFF_VT) + ((size_t)bh * 128 + n) * 64 * 32;
    const u16* sp = (const u16*)(ws + OFF_UPD) + ((size_t)bh * 128 + n) * 4096;
    bf16x8 qf[4], kf[4];
#pragma unroll
    for (int ks = 0; ks < 4; ++ks) { qf[ks] = *(const bf16x8*)(qd + ks * 16); kf[ks] = *(const bf16x8*)(ki + ks * 16); }
    f32x16 at = zero16();
#pragma unroll
    for (int ks = 0; ks < 4; ++ks) at = MFMA(kf[ks], qf[ks], at);
#pragma unroll
    for (int i = 0; i < 16; ++i) if (crow(i, h) > r) at[i] = 0.f;
    f32x16 o[2]; o[0] = zero16(); o[1] = zero16();
#pragma unroll
    for (int s2 = 0; s2 < 2; ++s2) {
      u4v pu; pu.x = pk2(at[8 * s2], at[8 * s2 + 1]); pu.y = pk2(at[8 * s2 + 2], at[8 * s2 + 3]);
      pu.z = pk2(at[8 * s2 + 4], at[8 * s2 + 5]); pu.w = pk2(at[8 * s2 + 6], at[8 * s2 + 7]);
      const bf16x8 pb = __builtin_bit_cast(bf16x8, pu);
#pragma unroll
      for (int vb = 0; vb < 2; ++vb) {
        const s16x4 lo = *(const s16x4*)(vt + (vb * 32 + r) * 32 + 16 * s2 + 4 * h);
        const s16x4 hi = *(const s16x4*)(vt + (vb * 32 + r) * 32 + 16 * s2 + 8 + 4 * h);
        const bf16x8 vf = __builtin_shufflevector(lo, hi, 0, 1, 2, 3, 4, 5, 6, 7);
        o[vb] = MFMA(vf, pb, o[vb]);
      }
    }
#pragma unroll
    for (int vb = 0; vb < 2; ++vb)
#pragma unroll
      for (int ks = 0; ks < 4; ++ks) {
        const bf16x8 sf = *(const bf16x8*)(sp + (vb * 32 + r) * 64 + ks * 16 + h * 8);
        o[vb] = MFMA(sf, qf[ks], o[vb]);
      }
    float ss = 0.f;
#pragma unroll
    for (int i = 0; i < 16; ++i) ss += o[0][i] * o[0][i] + o[1][i] * o[1][i];
    ss = xor32_add(ss);
    const float rs = rsqrtf(ss * (1.f / 64.f) + EPS);
    const u16* sgb = (const u16*)(ws + OFF_SGB) + (tok0 + r) * 512 + head * 64;
    u16* yb = (u16*)(ws + OFF_YB) + (tok0 + r) * 512 + head * 64;
#pragma unroll
    for (int vb = 0; vb < 2; ++vb)
#pragma unroll
      for (int g = 0; g < 4; ++g) {
        const int v0 = vb * 32 + 8 * g + 4 * h;
        const u2v gt = *(const u2v*)(sgb + v0);
        u2v ov;
        ov.x = pk2(o[vb][4 * g] * rs * bflo(gt.x), o[vb][4 * g + 1] * rs * bfhi(gt.x));
        ov.y = pk2(o[vb][4 * g + 2] * rs * bflo(gt.y), o[vb][4 * g + 3] * rs * bfhi(gt.y));
        *(u2v*)(yb + v0) = ov;
      }
  }
}

DI void phase5(const Params& p, unsigned char* smem) {
  unsigned char* ws = p.ws;
  pg8::StaticOrder S; S.init(T, 1024, (int)gridDim.x, (int)blockIdx.x);
  {
    pg8::Gemm g{(const u16*)(ws + OFF_YA), (const u16*)(ws + OFF_WA), T, 1024, 512};
    Epi5<false> E{(const u16*)p.out, (u16*)(ws + OFF_H), (u16*)(ws + OFF_M)};
    pg8::gemm_phase<Epi5<false>, pg8::StaticOrder, false>((PG8_LAS unsigned char*)smem, g, S, E, nullptr);
  }
  {
    pg8::Gemm g{(const u16*)(ws + OFF_YB), (const u16*)(ws + OFF_WB), T, 1024, 512};
    Epi5<true> E{(const u16*)p.out, (u16*)(ws + OFF_H), (u16*)(ws + OFF_M)};
    pg8::gemm_phase<Epi5<true>, pg8::StaticOrder, false>((PG8_LAS unsigned char*)smem, g, S, E, nullptr);
  }
}

DI void phase6(const Params& p, unsigned char* smem, bool dup = false) {
  unsigned char* ws = p.ws;
  pg8::Gemm g{(const u16*)(ws + OFF_M), (const u16*)(ws + OFF_WO), T, 1024, 1024};
  pg8::StaticOrder S; S.init(T, 1024, (int)gridDim.x, (int)blockIdx.x);
  Epi6 E{(u16*)(ws + OFF_H), (float*)(ws + OFF_SSQ) + 2 * T, dup};
  pg8::gemm_phase<Epi6, pg8::StaticOrder, false>((PG8_LAS unsigned char*)smem, g, S, E, nullptr);
}

DI void phase7(const Params& p) {
  const float* ssq_y = (const float*)(p.ws + OFF_SSQ) + 2 * T;
  const u2v* Y = (const u2v*)(p.ws + OFF_H);
  const int gtid = blockIdx.x * blockDim.x + threadIdx.x, gthreads = gridDim.x * blockDim.x;
  for (int i = gtid; i < T * 256; i += gthreads) {
    const int row = i >> 8, c4 = i & 255;
    const float rs = rsqrtf(ssq_y[row] * (1.f / 1024.f) + EPS);
    const u2v y = Y[i];
    const f4v xv = ((const f4v*)p.x)[i];
    const f4v g = ((const f4v*)p.g_post)[c4];
    f4v o;
    o.x = xv.x + bflo(y.x) * rs * g.x; o.y = xv.y + bfhi(y.x) * rs * g.y; o.z = xv.z + bflo(y.y) * rs * g.z; o.w = xv.w + bfhi(y.y) * rs * g.w;
    ((f4v*)p.out)[i] = o;
  }
}

__global__ void __launch_bounds__(512, 2) fwd_megakernel(Params p) {
  extern __shared__ __attribute__((aligned(16))) unsigned char smem[];
  u16* lds = (u16*)(smem + (threadIdx.x >> 8) * VLDS);
  cg::grid_group grid = cg::this_grid();
  volatile LAS unsigned* xst = (volatile LAS unsigned*)(smem + LDS_BYTES - 48);
  if (threadIdx.x == 0) { xst[0] = 0u; xst[1] = 0u; }
  __syncthreads();
  XcdBarrier xb = xcd_barrier_post((unsigned*)(p.ws + OFF_BAR), xst);
  if (p.ph_hi > 1000) grid.sync();
#define RUN_PHASE(N, CALL) if (p.ph_lo <= N && N < p.ph_hi) { if (N > p.ph_lo) xcd_barrier(xb); CALL; }
#define DUP_PHASE(N, CALL) if (DUP_PH == N) { xcd_barrier(xb); CALL; }
  RUN_PHASE(0, phase0(p))
  DUP_PHASE(0, phase0(p))
  if (p.ph_lo <= 1 && 1 < p.ph_hi) for (int rep = 0; rep < (DUP_PH == 1 ? 2 : 1); ++rep) { if (rep > 0 || 1 > p.ph_lo) xcd_barrier(xb); phase1(p, smem, rep > 0); }
  if (p.ph_lo <= 2 && 2 < p.ph_hi) for (int rep = 0; rep < (DUP_PH == 2 ? 2 : 1); ++rep) { if (rep > 0 || 2 > p.ph_lo) xcd_barrier(xb); phase2(p, smem, lds); }
  RUN_PHASE(4, phase3(p, smem))
  DUP_PHASE(4, phase3(p, smem, true))
  if (DUP_PH == 9) { xcd_barrier(xb); for (int i = blockIdx.x; i < 256; i += gridDim.x) scan_item(p, i, OFF_K); }
  RUN_PHASE(5, phase4(p))
  DUP_PHASE(5, phase4(p))
  RUN_PHASE(6, phase5(p, smem))
  DUP_PHASE(6, phase5(p, smem))
  RUN_PHASE(7, phase6(p, smem))
  DUP_PHASE(7, phase6(p, smem, true))
  RUN_PHASE(8, phase7(p))
  if (DUP_PH == 8) { xcd_barrier(xb); phase6(p, smem, true); xcd_barrier(xb); phase7(p); }
}

extern "C" void kernel_launch(void* const* d_in, const int* in_sizes, int n_in, void* d_out, int out_size, void* d_ws, size_t ws_size,
                              hipStream_t stream) {
  static int grid_blocks = 0;
  if (!grid_blocks) {
    int dev = 0, cus = 0, per_cu = 0;
    hipGetDevice(&dev);
    hipDeviceGetAttribute(&cus, hipDeviceAttributeMultiprocessorCount, dev);
    hipFuncSetAttribute((const void*)fwd_megakernel, hipFuncAttributeMaxDynamicSharedMemorySize, LDS_BYTES);
    hipOccupancyMaxActiveBlocksPerMultiprocessor(&per_cu, (const void*)fwd_megakernel, 512, LDS_BYTES);
    if (per_cu < 1) per_cu = 1;
    if (per_cu > 1) per_cu = 1;
    grid_blocks = cus * per_cu;
    if (ws_size < WS_NEED) fprintf(stderr, "kernel_launch: workspace too small: %zu < %zu\n", ws_size, (size_t)WS_NEED);
  }
  if (ws_size < WS_NEED) return;
  Params p{};
  p.x = (const float*)d_in[0]; p.g_pre = (const float*)d_in[1]; p.w_in = (const float*)d_in[2]; p.b_gate = (const float*)d_in[3];
  p.g_q = (const float*)d_in[4]; p.w_uq = (const float*)d_in[5]; p.g_kv = (const float*)d_in[6]; p.w_ukv = (const float*)d_in[7];
  p.lb_logits = (const float*)d_in[8]; p.g_hgrn = (const float*)d_in[9]; p.w_a = (const float*)d_in[10]; p.w_b = (const float*)d_in[11];
  p.w_out = (const float*)d_in[12]; p.g_post = (const float*)d_in[13];
  p.out = (float*)d_out; p.ws = (unsigned char*)d_ws;
#if ONE_LAUNCH
  p.ph_lo = 0; p.ph_hi = 9;
  (void)hipMemsetAsync((unsigned char*)d_ws + OFF_BAR, 0, 16384, stream);
  void* args[] = {&p};
  hipError_t e = hipLaunchCooperativeKernel((const void*)fwd_megakernel, dim3(grid_blocks), dim3(512), args, LDS_BYTES, stream);
  if (e != hipSuccess) fprintf(stderr, "cooperative launch failed: %s (grid %d)\n", hipGetErrorString(e), grid_blocks);
#else
  for (int ph = 0; ph < 9; ++ph) {
    p.ph_lo = ph; p.ph_hi = ph + 1;
    (void)hipMemsetAsync((unsigned char*)d_ws + OFF_BAR, 0, 16384, stream);
    void* args[] = {&p};
    hipError_t e = hipLaunchCooperativeKernel((const void*)fwd_megakernel, dim3(grid_blocks), dim3(512), args, LDS_BYTES, stream);
    if (e != hipSuccess) fprintf(stderr, "cooperative launch failed: %s (grid %d)\n", hipGetErrorString(e), grid_blocks);
  }
#endif
}
```

```cpp
#include <hip/hip_runtime.h>
#include <hip/hip_cooperative_groups.h>
#include <cstdio>
namespace cg = cooperative_groups;

#define DI __device__ __forceinline__
#define VTID ((int)(threadIdx.x & 255))
#define VBID ((int)(blockIdx.x * 2 + (threadIdx.x >> 8)))
#define VBN ((int)(gridDim.x * 2))
typedef unsigned short u16;
typedef unsigned int u32;
typedef __attribute__((ext_vector_type(8))) short bf16x8;
typedef __attribute__((ext_vector_type(4))) short s16x4;
typedef __attribute__((ext_vector_type(16))) float f32x16;
typedef __attribute__((ext_vector_type(2))) __bf16 bf2_t;
typedef __attribute__((ext_vector_type(2))) float f2_t;
typedef __attribute__((ext_vector_type(4))) unsigned int u4v;
typedef __attribute__((ext_vector_type(2))) unsigned int u2v;
typedef __attribute__((ext_vector_type(4))) float f4v;
typedef __attribute__((ext_vector_type(2))) float f2v;
#define MFMA(a, b, c) __builtin_amdgcn_mfma_f32_32x32x16_bf16((a), (b), (c), 0, 0, 0)

#ifndef DUP_PH
#define DUP_PH -1
#endif
#ifndef ONE_LAUNCH
#define ONE_LAUNCH 1
#endif

constexpr int T = 32768;
constexpr int SEQ = 4096;
constexpr int DIN = 5664;
constexpr int NP = 5888;
constexpr float EPS = 1e-6f;
constexpr float QSCALE = 1.4426950408889634f * 0.10206207261596575f;

constexpr size_t SZ_WIN = (size_t)NP * 1024 * 2;
constexpr size_t OFF_WIN = 0;
constexpr size_t OFF_WUQ = OFF_WIN + SZ_WIN;
constexpr size_t OFF_WUKV = OFF_WUQ + (size_t)768 * 768 * 2;
constexpr size_t OFF_WA = OFF_WUKV + (size_t)1024 * 256 * 2;
constexpr size_t OFF_WB = OFF_WA + (size_t)1024 * 512 * 2;
constexpr size_t OFF_WO = OFF_WB + (size_t)1024 * 512 * 2;
constexpr size_t OFF_ROPE = OFF_WO + (size_t)1024 * 1024 * 2;
constexpr size_t OFF_SSQ = OFF_ROPE + (size_t)4096 * 16 * 2 * 4;
constexpr size_t OFF_DECAY = OFF_SSQ + (size_t)(3 * T + 256) * 4;
constexpr size_t OFF_H = OFF_DECAY + (size_t)64 * 128 * 64 * 4;
constexpr size_t OFF_Q = OFF_H;
constexpr size_t OFF_CQ = OFF_H + (size_t)T * 1024 * 2;
constexpr size_t OFF_YA = OFF_CQ;
constexpr size_t OFF_CKV = OFF_CQ + (size_t)T * 768 * 2;
constexpr size_t OFF_KPE = OFF_CKV + (size_t)T * 256 * 2;
constexpr size_t OFF_SGA = OFF_KPE + (size_t)T * 32 * 4;
constexpr size_t OFF_SGB = OFF_SGA + (size_t)T * 512 * 2;
constexpr size_t OFF_HQ = OFF_SGB + (size_t)T * 512 * 2;
constexpr size_t OFF_UPD = OFF_HQ;
constexpr size_t OFF_HF = OFF_HQ + (size_t)T * 512 * 2;
constexpr size_t OFF_HI = OFF_HF + (size_t)T * 512 * 2;
constexpr size_t OFF_YB = OFF_HI;
constexpr size_t OFF_QDEC = OFF_HI + (size_t)T * 512 * 2;
constexpr size_t OFF_KINV = OFF_QDEC + (size_t)T * 512 * 2;
constexpr size_t OFF_VT = OFF_KINV + (size_t)T * 512 * 2;
constexpr size_t OFF_K = OFF_VT + (size_t)T * 512 * 2;
constexpr size_t OFF_M = OFF_K;
constexpr size_t OFF_VTT = OFF_K + (size_t)T * 768 * 2;
constexpr size_t OFF_BAR = OFF_VTT + (size_t)T * 512 * 2;
constexpr size_t WS_NEED = OFF_BAR + 16384;

constexpr int VLDS = 2 * 2 * 128 * 72 * 2;
constexpr int LDS_BYTES = 2 * VLDS + 64;
constexpr int SST = 132;

struct Params {
  const float *x, *g_pre, *w_in, *b_gate, *g_q, *w_uq, *g_kv, *w_ukv, *lb_logits, *g_hgrn, *w_a, *w_b, *w_out, *g_post;
  float* out;
  unsigned char* ws;
  int ph_lo, ph_hi;
};

DI u32 pk2(float a, float b) { f2_t v = {a, b}; bf2_t r = __builtin_convertvector(v, bf2_t); return __builtin_bit_cast(u32, r); }
DI float bflo(u32 u) { return __uint_as_float(u << 16); }
DI float bfhi(u32 u) { return __uint_as_float(u & 0xffff0000u); }
DI u4v pk8(f4v a, f4v b) { u4v r; r.x = pk2(a.x, a.y); r.y = pk2(a.z, a.w); r.z = pk2(b.x, b.y); r.w = pk2(b.z, b.w); return r; }
DI float rcpf(float x) { return __builtin_amdgcn_rcpf(x); }
DI float sigmoidf_(float x) { return rcpf(1.f + __expf(-x)); }
DI float siluf_(float x) { return x * sigmoidf_(x); }
DI float xor32_max(float x) { const unsigned u = __float_as_uint(x); auto r = __builtin_amdgcn_permlane32_swap(u, u, false, false); return fmaxf(__uint_as_float(r[0]), __uint_as_float(r[1])); }
DI float xor32_add(float x) { const unsigned u = __float_as_uint(x); auto r = __builtin_amdgcn_permlane32_swap(u, u, false, false); return __uint_as_float(r[0]) + __uint_as_float(r[1]); }
DI float xor16_add(float x) { const unsigned u = __float_as_uint(x); auto r = __builtin_amdgcn_permlane16_swap(u, u, false, false); return __uint_as_float(r[0]) + __uint_as_float(r[1]); }
DI int crow(int reg, int h) { return (reg & 3) + 8 * (reg >> 2) + 4 * h; }
DI f32x16 zero16() { f32x16 z;
#pragma unroll
  for (int i = 0; i < 16; ++i) z[i] = 0.f; return z; }

__constant__ float c_invfreq[16] = {1.0f, 0.5623413324356079f, 0.3162277638912201f, 0.17782793939113617f, 0.10000000149011612f,
  0.05623413249850273f, 0.03162277489900589f, 0.017782794311642647f, 0.009999999776482582f, 0.005623413249850273f,
  0.003162277629598975f, 0.0017782794311642647f, 0.0010000000474974513f, 0.000562341301701963f, 0.0003162277571391314f,
  0.00017782794020604342f};

DI void sincos_d(double a, float& sn, float& cs) {
  const double k = rint(a * 0.63661977236758134308);
  const double y = a - k * 1.57079632679489661923;
  const double y2 = y * y;
  const double s = y * (1.0 + y2 * (-1.0 / 6 + y2 * (1.0 / 120 + y2 * (-1.0 / 5040 + y2 * (1.0 / 362880 + y2 * (-1.0 / 39916800 + y2 * (1.0 / 6227020800.0)))))));
  const double c = 1.0 + y2 * (-0.5 + y2 * (1.0 / 24 + y2 * (-1.0 / 720 + y2 * (1.0 / 40320 + y2 * (-1.0 / 3628800 + y2 * (1.0 / 479001600.0 + y2 * (-1.0 / 87178291200.0)))))));
  const int q = ((int)k) & 3;
  const double ss = (q == 0) ? s : (q == 1) ? c : (q == 2) ? -s : -c;
  const double cc = (q == 0) ? c : (q == 1) ? -s : (q == 2) ? -c : s;
  sn = (float)ss; cs = (float)cc;
}

#define XB_TMO      128
#define XB_XCNT(j)  (256  + 64 * (j))
#define XB_XSUB(j)  (1280 + 64 * (j))
#define XB_XGEN(j)  (2304 + 64 * (j))
#define XB_TOP      3328
#define XB_TOPGEN   3392
#define XCD_BAR_WORDS 3456
#define XB_SPIN_CAP (1u << 22)
#define LAS __attribute__((address_space(3)))
DI unsigned xb_ld(unsigned* p)              { return __hip_atomic_load(p, __ATOMIC_RELAXED, __HIP_MEMORY_SCOPE_AGENT); }
DI unsigned xb_add(unsigned* p, unsigned v) { return __hip_atomic_fetch_add(p, v, __ATOMIC_RELAXED, __HIP_MEMORY_SCOPE_AGENT); }
DI unsigned xb_xcc_id() { return (unsigned)__builtin_amdgcn_s_getreg((3 << 11) | 20) & 0xFu; }
#define XB_SPIN(cond, bar) do { unsigned _sp = 0; while (cond) { __builtin_amdgcn_s_sleep(1); \
    if ((++_sp & 255u) == 0u) { if (xb_ld(&(bar)[XB_TMO])) break; if (_sp > XB_SPIN_CAP) { atomicAdd(&(bar)[XB_TMO], 1u); break; } } } } while (0)
struct XcdBarrier { unsigned* bar; unsigned x; volatile LAS unsigned* st; };
DI XcdBarrier xcd_barrier_post(unsigned* bar, volatile LAS unsigned* st) {
  XcdBarrier b; b.bar = bar; b.x = xb_xcc_id(); b.st = st;
  if (threadIdx.x == 0) (void)xb_add(&bar[XB_XCNT(b.x)], 1u);
  return b;
}
DI void xcd_barrier_complete(unsigned* bar, unsigned x, unsigned& nloc, unsigned& nx) {
  const unsigned G = gridDim.x * gridDim.y * gridDim.z;
  unsigned sum, cnt, mine, sp = 0u;
  for (;;) {
    sum = 0u; cnt = 0u; mine = 0u;
#pragma unroll
    for (unsigned j = 0; j < 16; ++j) { const unsigned c = xb_ld(&bar[XB_XCNT(j)]); sum += c; cnt += (c > 0u) ? 1u : 0u; mine = (j == x) ? c : mine; }
    if (sum == G) break;
    __builtin_amdgcn_s_sleep(1);
    if ((++sp & 255u) == 0u) { if (xb_ld(&bar[XB_TMO])) break; if (sp > XB_SPIN_CAP) { atomicAdd(&bar[XB_TMO], 1u); break; } }
  }
  nloc = mine > 0u ? mine : 1u; nx = cnt > 0u ? cnt : 1u;
}
DI void xcd_barrier(const XcdBarrier& b) {
  asm volatile("s_waitcnt vmcnt(0)" ::: "memory");
  __syncthreads();
  if (threadIdx.x == 0) {
    unsigned* bar = b.bar;
    __builtin_amdgcn_s_waitcnt(0);
    unsigned nloc = b.st[0], nx = b.st[1];
    if (nloc == 0u) { xcd_barrier_complete(bar, b.x, nloc, nx); b.st[0] = nloc; b.st[1] = nx; }
    const unsigned old = xb_add(&bar[XB_XSUB(b.x)], 1u);
    const unsigned gen = old / nloc;
    if (old + 1u == (gen + 1u) * nloc) {
      __builtin_amdgcn_fence(__ATOMIC_RELEASE, "agent");
      asm volatile("s_waitcnt vmcnt(0)" ::: "memory");
      const unsigned og = xb_add(&bar[XB_TOP], 1u);
      const unsigned tg = og / nx;
      if (og + 1u == (tg + 1u) * nx) xb_add(&bar[XB_TOPGEN], 1u);
      else XB_SPIN(xb_ld(&bar[XB_TOPGEN]) == tg, bar);
      __builtin_amdgcn_fence(__ATOMIC_ACQUIRE, "agent");
      xb_add(&bar[XB_XGEN(b.x)], 1u);
      asm volatile("s_waitcnt vmcnt(0)" ::: "memory");
    } else {
      XB_SPIN(xb_ld(&bar[XB_XGEN(b.x)]) == gen, bar);
      __builtin_amdgcn_fence(__ATOMIC_ACQUIRE, "agent");
      asm volatile("s_waitcnt vmcnt(0)" ::: "memory");
    }
  }
  __syncthreads();
}

template <int KIND>
DI int colmap(int n) {
  if (KIND == 0) {
    if (n < 1024) return n;
    if (n < 1536) return 1056 + (n - 1024);
    if (n < 2048) return 3104 + (n - 1536);
    if (n < 4096) return 3616 + (n - 2048);
    if (n < 4608) return 1568 + (n - 4096);
    if (n < 5120) return 2080 + (n - 4608);
    if (n < 5632) return 2592 + (n - 5120);
    if (n < 5664) return 1024 + (n - 5632);
    return -1;
  } else if (KIND == 1) {
    if (n < 512) return (n >> 6) * 96 + (n & 63);
    int i = n - 512; int w = i & 31, g = w >> 3, e = w & 7; return (i >> 5) * 96 + 64 + ((e < 4) ? (4 * g + e) : (16 + 4 * g + (e - 4)));
  } else if (KIND == 3) {
    if (n < 512) return (n >> 6) * 128 + (n & 63);
    int i = n - 512; return (i >> 6) * 128 + 64 + (i & 63);
  } else return n;
}
template <int KIND>
DI void conv_weight(u16* dst, const float* src, int ldw, int ncount, int K, const float* gain, int gmask, int gtid, int gthreads) {
  const int total = ncount * (K >> 3);
  for (int it = gtid; it < total; it += gthreads) {
    const int n = it % ncount, kc = it / ncount;
    const int sc = colmap<KIND>(n);
    float v[8];
#pragma unroll
    for (int i = 0; i < 8; ++i) {
      const int k = kc * 8 + i;
      float x = (sc >= 0) ? src[(size_t)k * ldw + sc] : 0.f;
      if (gain) x *= gain[k & gmask];
      v[i] = x;
    }
    u4v o; o.x = pk2(v[0], v[1]); o.y = pk2(v[2], v[3]); o.z = pk2(v[4], v[5]); o.w = pk2(v[6], v[7]);
    *(u4v*)(dst + (size_t)n * K + kc * 8) = o;
  }
}

DI void phase0(const Params& p) {
  unsigned char* ws = p.ws;
  const int gtid = blockIdx.x * blockDim.x + threadIdx.x, gthreads = gridDim.x * blockDim.x;
  float* ssq = (float*)(ws + OFF_SSQ);
  for (int i = gtid; i < 3 * T + 256; i += gthreads) ssq[i] = 0.f;
  float* rope = (float*)(ws + OFF_ROPE);
  for (int i = gtid; i < 4096 * 16; i += gthreads) {
    const int pos = i >> 4, j = i & 15;
    const float ang = (float)pos * c_invfreq[j];
    float sn, cs; sincos_d((double)ang, sn, cs);
    rope[i] = cs; rope[65536 + i] = sn;
  }
  conv_weight<0>((u16*)(ws + OFF_WIN), p.w_in, DIN, NP, 1024, nullptr, 0, gtid, gthreads);
  u16* H = (u16*)(ws + OFF_H);
  const int lane = threadIdx.x & 63;
  const int gw = gtid >> 6, nw = gthreads >> 6;
  for (int row = gw; row < T; row += nw) {
    const f4v* xr = (const f4v*)(p.x + (size_t)row * 1024);
    f4v v[4];
    float ss = 0.f;
#pragma unroll
    for (int i = 0; i < 4; ++i) { v[i] = xr[lane * 4 + i]; ss += v[i].x * v[i].x + v[i].y * v[i].y + v[i].z * v[i].z + v[i].w * v[i].w; }
#pragma unroll
    for (int o = 32; o >= 1; o >>= 1) ss += __shfl_xor(ss, o);
    const float rs = rsqrtf(ss * (1.f / 1024.f) + EPS);
    const f4v* gp = (const f4v*)(p.g_pre);
    f4v g[4];
#pragma unroll
    for (int i = 0; i < 4; ++i) { g[i] = gp[lane * 4 + i]; v[i].x *= rs * g[i].x; v[i].y *= rs * g[i].y; v[i].z *= rs * g[i].z; v[i].w *= rs * g[i].w; }
    u4v* hr = (u4v*)(H + (size_t)row * 1024 + lane * 16);
    hr[0] = pk8(v[0], v[1]); hr[1] = pk8(v[2], v[3]);
  }
}

constexpr int TS = 128 * 72;
DI void gemm_ld(u4v (&ra)[4], u4v (&rb)[4], const u16* ga, const u16* gb, int lda, int ldb, int ko) {
#pragma unroll
  for (int i = 0; i < 4; ++i) { ra[i] = *(const u4v*)(ga + (size_t)(32 * i) * lda + ko); rb[i] = *(const u4v*)(gb + (size_t)(32 * i) * ldb + ko); }
}
DI void gemm_st(const u4v (&ra)[4], const u4v (&rb)[4], u16* buf, int lr, int lc) {
  u16* sa = buf; u16* sb = buf + TS;
#pragma unroll
  for (int i = 0; i < 4; ++i) { *(u4v*)(sa + (lr + 32 * i) * 72 + lc * 8) = ra[i]; *(u4v*)(sb + (lr + 32 * i) * 72 + lc * 8) = rb[i]; }
}
DI void gemm_mma(const u16* buf, f32x16 (&acc)[2][2], int wm, int wn, int r, int h) {
  const u16* sa = buf + (wm * 64 + r) * 72 + h * 8;
  const u16* sb = buf + TS + (wn * 64 + r) * 72 + h * 8;
#pragma unroll
  for (int ks = 0; ks < 4; ++ks) {
    const bf16x8 a0 = *(const bf16x8*)(sa + ks * 16);
    const bf16x8 a1 = *(const bf16x8*)(sa + 32 * 72 + ks * 16);
    const bf16x8 b0 = *(const bf16x8*)(sb + ks * 16);
    const bf16x8 b1 = *(const bf16x8*)(sb + 32 * 72 + ks * 16);
    acc[0][0] = MFMA(a0, b0, acc[0][0]);
    acc[0][1] = MFMA(a0, b1, acc[0][1]);
    acc[1][0] = MFMA(a1, b0, acc[1][0]);
    acc[1][1] = MFMA(a1, b1, acc[1][1]);
  }
}
DI void gemm_core(const u16* __restrict__ A, int lda, const u16* __restrict__ B, int ldb, int K, u16* lds, f32x16 (&acc)[2][2], int tid) {
  const int lane = tid & 63, w = tid >> 6, wm = w >> 1, wn = w & 1, r = lane & 31, h = lane >> 5;
  const int lc = tid & 7, lr = tid >> 3;
  const u16* ga = A + (size_t)lr * lda + lc * 8;
  const u16* gb = B + (size_t)lr * ldb + lc * 8;
  u4v ra0[4], rb0[4], ra1[4], rb1[4];
  gemm_ld(ra0, rb0, ga, gb, lda, ldb, 0);
  gemm_ld(ra1, rb1, ga, gb, lda, ldb, 64);
#pragma unroll
  for (int i = 0; i < 2; ++i)
#pragma unroll
    for (int j = 0; j < 2; ++j) acc[i][j] = zero16();
  u16* L0 = lds; u16* L1 = lds + 2 * TS;
  __syncthreads();
  gemm_st(ra0, rb0, L0, lr, lc);
  __syncthreads();
  const int nk = K >> 6;
  int kt = 0;
  for (; kt + 2 < nk; kt += 2) {
    gemm_ld(ra0, rb0, ga, gb, lda, ldb, (kt + 2) * 64);
    __builtin_amdgcn_sched_barrier(0);
    gemm_mma(L0, acc, wm, wn, r, h);
    gemm_st(ra1, rb1, L1, lr, lc);
    __syncthreads();
    gemm_ld(ra1, rb1, ga, gb, lda, ldb, (kt + 3) * 64);
    __builtin_amdgcn_sched_barrier(0);
    gemm_mma(L1, acc, wm, wn, r, h);
    gemm_st(ra0, rb0, L0, lr, lc);
    __syncthreads();
  }
  gemm_mma(L0, acc, wm, wn, r, h);
  gemm_st(ra1, rb1, L1, lr, lc);
  __syncthreads();
  gemm_mma(L1, acc, wm, wn, r, h);
  __syncthreads();
}

DI void stage_pass(const f32x16 (&acc)[2][2], float* stage, int p, int tid) {
  const int lane = tid & 63, w = tid >> 6, wm = w >> 1, wn = w & 1, r = lane & 31, h = lane >> 5;
  __syncthreads();
  if (wm == p) {
#pragma unroll
    for (int i = 0; i < 2; ++i)
#pragma unroll
      for (int j = 0; j < 2; ++j)
#pragma unroll
        for (int reg = 0; reg < 16; ++reg) stage[(i * 32 + crow(reg, h)) * SST + wn * 64 + j * 32 + r] = acc[i][j][reg];
  }
  __syncthreads();
}

namespace pg8 {
#define PG8_LAS __attribute__((address_space(3)))
typedef unsigned short bf16_t;
typedef short bf16x8 __attribute__((ext_vector_type(8)));
typedef float f32x4 __attribute__((ext_vector_type(4)));
typedef unsigned u32x4 __attribute__((ext_vector_type(4)));
constexpr int BM = 256, BK = 64, HALF = 128, HTB = HALF * BK * 2  , STAGE_BYTES = 8 * HTB, NXCD = 8, WGM = 8;

__host__ __device__ __forceinline__ int lds_byte(int r, int c) { const int st = (r >> 4) * 2 + (c >> 5), rr = r & 15, cc = c & 31, ob = rr * 64 + cc * 2; return st * 1024 + (ob ^ (((ob >> 9) & 1) << 5)); }
__host__ __device__ __forceinline__ void stage_rc(int b, int& R, int& C) { const int st = b / 1024, sb = b % 1024, swz = sb ^ (((sb >> 9) & 1) << 5); R = (st >> 1) * 16 + swz / 64; C = (st & 1) * 32 + (swz % 64) / 2; }
__host__ __device__ __forceinline__ int perm32(int rho) { const int n = rho >> 4, i = rho & 15; return 8 * (i >> 2) + 4 * n + (i & 3); }

struct Unit { int pm, pn; };
struct Gemm { const bf16_t* A; const bf16_t* Bt; int M, N, K; };

struct StaticOrder {
    int nM, nN, nwg, G, c;
    __host__ __device__ void init(int M, int N, int G_, int c_) { nM = M / BM; nN = N / BM; nwg = nM * nN; G = G_; c = c_; }
    __host__ __device__ bool next(int i, Unit& u) const {
        const long L = (long)i * G + c; if (L >= nwg) return false;
        int wgid = (int)L; { const int q = nwg / NXCD, r = nwg % NXCD, xcd = wgid % NXCD, off = wgid / NXCD; wgid = (xcd < r ? xcd * (q + 1) : r * (q + 1) + (xcd - r) * q) + off; }
        const int nig = WGM * nN, gid = wgid / nig, fm = gid * WGM, gsz = (nM - fm) < WGM ? (nM - fm) : WGM;
        u.pm = fm + ((wgid % nig) % gsz); u.pn = (wgid % nig) / gsz; return true;
    }
    __device__ __forceinline__ void a_ready(const Unit&) const {}
    __device__ __forceinline__ void done(const Unit&) const {}
};
template <class Epi, class Sched, bool STAMP = false, bool SWAP = false>
__device__ __forceinline__ void gemm_phase(PG8_LAS unsigned char* lds, const Gemm g, const Sched& S, const Epi& E, unsigned long long* stamps) {
    const int tid = threadIdx.x, wid = __builtin_amdgcn_readfirstlane(tid >> 6), lane = tid & 63, wr = wid >> 2, wc = wid & 3, fr = lane & 15, fq = lane >> 4;
    const int K = g.K, nt = K / BK;
    int ts_lo = 0, ts_hi = 0, nts = 0; const unsigned long long rt_entry = STAMP ? (unsigned long long)wall_clock64() : 0ull;
#define PG8_STAMP() do { if (STAMP && wid == 0 && nts < 64) { const unsigned long long _c = (unsigned long long)clock64(); \
        ts_lo = (lane == nts) ? (int)(unsigned)_c : ts_lo; ts_hi = (lane == nts) ? (int)(unsigned)(_c >> 32) : ts_hi; ++nts; } } while (0)
    PG8_STAMP();
    unsigned voffA[2], voffB[2];
#pragma unroll
    for (int i = 0; i < 2; ++i) { int R, C; stage_rc(tid * 16 + i * 8192, R, C); const int Rb = Epi::PERM ? ((R & ~31) + perm32(R & 31)) : R;
        voffA[i] = (unsigned)(R * K + C) * 2u; voffB[i] = (unsigned)(Rb * K + C) * 2u; }
    const size_t kstep = (size_t)(BK * 2);
    const size_t hstep = (size_t)HALF * K * 2;
    const size_t tstep = 2 * hstep;
    const unsigned ldsw = (unsigned)wid * 1024u;
    const int aoff = lds_byte(wr * 64 + fr, fq * 8), boff = lds_byte(wc * 32 + fr, fq * 8);
#define PG8_SA(b, h) (((b) * 2 + (h)) * HTB)
#define PG8_SB(b, h) ((4 + (b) * 2 + (h)) * HTB)
#define PG8_STAGE(bufoff, gbase, voff) do { _Pragma("unroll") for (int _i = 0; _i < 2; ++_i) \
        __builtin_amdgcn_global_load_lds((const unsigned*)((const char*)(gbase) + (voff)[_i]), (PG8_LAS unsigned*)(lds + (bufoff) + ldsw + _i * 8192), 16, 0, 0); } while (0)
#define PG8_LDA(dst, b, h) do { _Pragma("unroll") for (int m = 0; m < 4; ++m) _Pragma("unroll") for (int k = 0; k < 2; ++k) dst[m][k] = *(const PG8_LAS bf16x8*)(lds + PG8_SA(b, h) + aoff + m * 2048 + k * 1024); } while (0)
#define PG8_LDB(dst, b, h) do { _Pragma("unroll") for (int n = 0; n < 2; ++n) _Pragma("unroll") for (int k = 0; k < 2; ++k) dst[n][k] = *(const PG8_LAS bf16x8*)(lds + PG8_SB(b, h) + boff + n * 2048 + k * 1024); } while (0)
#define PG8_MMA(ai, bj, At, Bt) do { __builtin_amdgcn_s_setprio(1); _Pragma("unroll") for (int m = 0; m < 4; ++m) _Pragma("unroll") for (int n = 0; n < 2; ++n) _Pragma("unroll") for (int k = 0; k < 2; ++k) \
        acc[ai][bj][m][n] = SWAP ? __builtin_amdgcn_mfma_f32_16x16x32_bf16(At[m][k], Bt[n][k], acc[ai][bj][m][n], 0, 0, 0) : __builtin_amdgcn_mfma_f32_16x16x32_bf16(Bt[n][k], At[m][k], acc[ai][bj][m][n], 0, 0, 0); __builtin_amdgcn_s_setprio(0); } while (0)
#define PG8_WAIT_V(n) asm volatile("s_waitcnt vmcnt(" #n ")" ::: "memory")
#define PG8_WAIT_L(n) asm volatile("s_waitcnt lgkmcnt(" #n ")" ::: "memory")
#define PG8_BAR __builtin_amdgcn_s_barrier()
#define PG8_SCHED __builtin_amdgcn_sched_barrier(0)
    Unit cur, nxt; int ui = 0;
    if (!S.next(0, cur)) return;
    f32x4 acc[2][2][4][2];
#pragma unroll
    for (int a = 0; a < 2; ++a)
#pragma unroll
        for (int b = 0; b < 2; ++b)
#pragma unroll
            for (int m = 0; m < 4; ++m)
#pragma unroll
                for (int n = 0; n < 2; ++n) acc[a][b][m][n] = (f32x4){0.f, 0.f, 0.f, 0.f};
    bf16x8 At[4][2], B0[2][2], B1[2][2];
    const char* cA = (const char*)g.A + (size_t)cur.pm * tstep; const char* cB = (const char*)g.Bt + (size_t)cur.pn * tstep;
    S.a_ready(cur);
    PG8_STAGE(PG8_SB(0, 0), cB, voffB); PG8_STAGE(PG8_SA(0, 0), cA, voffA); PG8_STAGE(PG8_SB(0, 1), cB + hstep, voffB); PG8_STAGE(PG8_SA(0, 1), cA + hstep, voffA);
    if (wr == 1) PG8_BAR;
    PG8_WAIT_V(4); PG8_BAR;
    PG8_STAGE(PG8_SB(1, 0), cB + kstep, voffB); PG8_STAGE(PG8_SA(1, 0), cA + kstep, voffA); PG8_STAGE(PG8_SB(1, 1), cB + hstep + kstep, voffB);
    PG8_WAIT_V(6); PG8_BAR;
    PG8_STAMP();
    for (;;) {
        const bool has_next = S.next(ui + 1, nxt);
        const char* nA = has_next ? (const char*)g.A + (size_t)nxt.pm * tstep : cA; const char* nB = has_next ? (const char*)g.Bt + (size_t)nxt.pn * tstep : cB;
        for (int t = 0; t < nt; t += 2) {
            const bool last = (t == nt - 2);
            const char* a1 = cA + (size_t)(t + 1) * kstep;
            const char* a2 = last ? nA : cA + (size_t)(t + 2) * kstep; const char* b2 = last ? nB : cB + (size_t)(t + 2) * kstep;
            const char* a3 = a2 + kstep; const char* b3 = b2 + kstep;
            if (last && has_next) S.a_ready(nxt);
            PG8_LDB(B0, 0, 0); PG8_SCHED; PG8_LDA(At, 0, 0); PG8_STAGE(PG8_SA(1, 1), a1 + hstep, voffA);
            PG8_WAIT_L(8); PG8_BAR; PG8_WAIT_L(0); PG8_MMA(0, 0, At, B0); PG8_BAR; PG8_SCHED;
            PG8_LDB(B1, 0, 1); PG8_STAGE(PG8_SB(0, 0), b2, voffB);
            PG8_BAR; PG8_WAIT_L(0); PG8_MMA(0, 1, At, B1); PG8_BAR;
            PG8_LDA(At, 0, 1); PG8_STAGE(PG8_SA(0, 0), a2, voffA);
            PG8_BAR; PG8_WAIT_L(0); PG8_MMA(1, 0, At, B0); PG8_BAR; PG8_SCHED;
            PG8_STAGE(PG8_SB(0, 1), b2 + hstep, voffB);
            PG8_WAIT_V(6); PG8_BAR; PG8_MMA(1, 1, At, B1); PG8_BAR;
            PG8_LDB(B0, 1, 0); PG8_SCHED; PG8_LDA(At, 1, 0); PG8_STAGE(PG8_SA(0, 1), a2 + hstep, voffA);
            PG8_WAIT_L(8); PG8_BAR; PG8_WAIT_L(0); PG8_MMA(0, 0, At, B0); PG8_BAR; PG8_SCHED;
            PG8_LDB(B1, 1, 1); PG8_STAGE(PG8_SB(1, 0), b3, voffB);
            PG8_BAR; PG8_WAIT_L(0); PG8_MMA(0, 1, At, B1); PG8_BAR;
            PG8_LDA(At, 1, 1); PG8_STAGE(PG8_SA(1, 0), a3, voffA);
            PG8_BAR; PG8_WAIT_L(0); PG8_MMA(1, 0, At, B0); PG8_BAR; PG8_SCHED;
            PG8_STAGE(PG8_SB(1, 1), b3 + hstep, voffB);
            PG8_WAIT_V(6); PG8_BAR; PG8_MMA(1, 1, At, B1); PG8_BAR;
        }
        PG8_STAMP();
        if constexpr (!Epi::AFTER_DRAIN) { E(acc, cur, wr, wc, fr, fq); S.done(cur); }
        PG8_STAMP();
        if (!has_next) break;
#pragma unroll
        for (int a = 0; a < 2; ++a)
#pragma unroll
            for (int b = 0; b < 2; ++b)
#pragma unroll
                for (int m = 0; m < 4; ++m)
#pragma unroll
                    for (int n = 0; n < 2; ++n) acc[a][b][m][n] = (f32x4){0.f, 0.f, 0.f, 0.f};
        cur = nxt; cA = nA; cB = nB; ++ui;
    }
    PG8_WAIT_V(0);
    if (wr == 0) PG8_BAR;
    PG8_BAR;
    if constexpr (Epi::AFTER_DRAIN) { E.fused(acc, cur, wr, wc, fr, fq, lds, wid, lane); S.done(cur); }
    PG8_STAMP();
    if (STAMP && wid == 0) { stamps[lane] = lane < nts ? (((unsigned long long)(unsigned)ts_hi << 32) | (unsigned)ts_lo) : 0ull;
        if (lane == 62) stamps[62] = rt_entry; if (lane == 63) stamps[63] = (unsigned long long)wall_clock64(); }
#undef PG8_STAMP
#undef PG8_SA
#undef PG8_SB
#undef PG8_STAGE
#undef PG8_LDA
#undef PG8_LDB
#undef PG8_MMA
#undef PG8_WAIT_V
#undef PG8_WAIT_L
#undef PG8_BAR
#undef PG8_SCHED
}
}

struct Epi1 {
  static constexpr bool PERM = true, AFTER_DRAIN = false;
  unsigned char* ws; u16* mg; const float* b_gate; bool dup;
  DI void operator()(const pg8::f32x4 (&acc)[2][2][4][2], const pg8::Unit& u, int wr, int wc, int fr, int fq) const {
    const int pn = u.pn;
    const int rowb = u.pm * 256 + wr * 64 + fr;
    const int colu = wc * 32 + 8 * fq;
    if (pn < 4) {
      u16* dst = (pn < 3) ? (u16*)(ws + OFF_CQ) + pn * 256 : (u16*)(ws + OFF_CKV);
      const int ld = (pn < 3) ? 768 : 256;
      float* ssq = (float*)(ws + OFF_SSQ) + ((pn < 3) ? 0 : T);
#pragma unroll
      for (int ai = 0; ai < 2; ++ai)
#pragma unroll
        for (int m = 0; m < 4; ++m) {
          const int row = rowb + ai * 128 + m * 16;
          float ss = 0.f;
#pragma unroll
          for (int bj = 0; bj < 2; ++bj) {
            const pg8::f32x4 v0 = acc[ai][bj][m][0], v1 = acc[ai][bj][m][1];
            ss += v0[0] * v0[0] + v0[1] * v0[1] + v0[2] * v0[2] + v0[3] * v0[3] + v1[0] * v1[0] + v1[1] * v1[1] + v1[2] * v1[2] + v1[3] * v1[3];
            u4v o; o.x = pk2(v0[0], v0[1]); o.y = pk2(v0[2], v0[3]); o.z = pk2(v1[0], v1[1]); o.w = pk2(v1[2], v1[3]);
            *(u4v*)(dst + (size_t)row * ld + bj * 128 + colu) = o;
          }
          ss = xor16_add(ss); ss = xor32_add(ss);
          if (fq == 0 && !dup) atomicAdd(ssq + row, ss);
        }
    } else if (pn < 8) {
      u16* dst = (u16*)(ws + ((pn < 6) ? OFF_SGA : OFF_SGB)) + (pn & 1) * 256;
#pragma unroll
      for (int ai = 0; ai < 2; ++ai)
#pragma unroll
        for (int m = 0; m < 4; ++m) {
          const int row = rowb + ai * 128 + m * 16;
#pragma unroll
          for (int bj = 0; bj < 2; ++bj) {
            const pg8::f32x4 v0 = acc[ai][bj][m][0], v1 = acc[ai][bj][m][1];
            u4v o; o.x = pk2(siluf_(v0[0]), siluf_(v0[1])); o.y = pk2(siluf_(v0[2]), siluf_(v0[3]));
            o.z = pk2(siluf_(v1[0]), siluf_(v1[1])); o.w = pk2(siluf_(v1[2]), siluf_(v1[3]));
            *(u4v*)(dst + (size_t)row * 512 + bj * 128 + colu) = o;
          }
        }
    } else if (pn >= 16) {
      if (pn < 22) {
        u16* dst = (u16*)(ws + ((pn < 18) ? OFF_HQ : (pn < 20) ? OFF_HF : OFF_HI)) + (pn & 1) * 256;
#pragma unroll
        for (int ai = 0; ai < 2; ++ai)
#pragma unroll
          for (int m = 0; m < 4; ++m) {
            const int row = rowb + ai * 128 + m * 16;
#pragma unroll
            for (int bj = 0; bj < 2; ++bj) {
              const pg8::f32x4 v0 = acc[ai][bj][m][0], v1 = acc[ai][bj][m][1];
              u4v o; o.x = pk2(v0[0], v0[1]); o.y = pk2(v0[2], v0[3]); o.z = pk2(v1[0], v1[1]); o.w = pk2(v1[2], v1[3]);
              *(u4v*)(dst + (size_t)row * 512 + bj * 128 + colu) = o;
            }
          }
      } else if (colu < 32) {
        float* dst = (float*)(ws + OFF_KPE);
#pragma unroll
        for (int ai = 0; ai < 2; ++ai)
#pragma unroll
          for (int m = 0; m < 4; ++m) {
            const int row = rowb + ai * 128 + m * 16;
            *(pg8::f32x4*)(dst + (size_t)row * 32 + colu) = acc[ai][0][m][0];
            *(pg8::f32x4*)(dst + (size_t)row * 32 + colu + 4) = acc[ai][0][m][1];
          }
      }
    } else {
      const int cb = (pn - 8) * 256 + colu;
      f4v b0[2], b1[2];
#pragma unroll
      for (int bj = 0; bj < 2; ++bj) { b0[bj] = *(const f4v*)(b_gate + cb + bj * 128); b1[bj] = *(const f4v*)(b_gate + cb + bj * 128 + 4); }
#pragma unroll
      for (int ai = 0; ai < 2; ++ai)
#pragma unroll
        for (int m = 0; m < 4; ++m) {
          const int row = rowb + ai * 128 + m * 16;
#pragma unroll
          for (int bj = 0; bj < 2; ++bj) {
            const pg8::f32x4 v0 = acc[ai][bj][m][0], v1 = acc[ai][bj][m][1];
            u4v o; o.x = pk2(sigmoidf_(v0[0] + b0[bj].x), sigmoidf_(v0[1] + b0[bj].y)); o.y = pk2(sigmoidf_(v0[2] + b0[bj].z), sigmoidf_(v0[3] + b0[bj].w));
            o.z = pk2(sigmoidf_(v1[0] + b1[bj].x), sigmoidf_(v1[1] + b1[bj].y)); o.w = pk2(sigmoidf_(v1[2] + b1[bj].z), sigmoidf_(v1[3] + b1[bj].w));
            *(u4v*)(mg + ((((size_t)(u.pm * 8 + (pn - 8)) * 8 + (wr * 4 + wc)) * 16 + (ai * 8 + m * 2 + bj)) * 64 + (fq * 16 + fr)) * 8) = o;
          }
        }
    }
  }
};


struct Epi6 {
  static constexpr bool PERM = true, AFTER_DRAIN = false;
  u16* out; float* ssq; bool dup;
  DI void operator()(const pg8::f32x4 (&acc)[2][2][4][2], const pg8::Unit& u, int wr, int wc, int fr, int fq) const {
    const int rowb = u.pm * 256 + wr * 64 + fr;
    const int colb = u.pn * 256 + wc * 32 + 8 * fq;
#pragma unroll
    for (int ai = 0; ai < 2; ++ai)
#pragma unroll
      for (int m = 0; m < 4; ++m) {
        const int row = rowb + ai * 128 + m * 16;
        float ss = 0.f;
#pragma unroll
        for (int bj = 0; bj < 2; ++bj) {
          const pg8::f32x4 v0 = acc[ai][bj][m][0], v1 = acc[ai][bj][m][1];
          ss += v0[0] * v0[0] + v0[1] * v0[1] + v0[2] * v0[2] + v0[3] * v0[3] + v1[0] * v1[0] + v1[1] * v1[1] + v1[2] * v1[2] + v1[3] * v1[3];
          u4v o; o.x = pk2(v0[0], v0[1]); o.y = pk2(v0[2], v0[3]); o.z = pk2(v1[0], v1[1]); o.w = pk2(v1[2], v1[3]);
          *(u4v*)(out + (size_t)row * 1024 + colb + bj * 128) = o;
        }
        ss = xor16_add(ss); ss = xor32_add(ss);
        if (fq == 0 && !dup) atomicAdd(ssq + row, ss);
      }
  }
};
template <bool SECOND> struct Epi5 {
  static constexpr bool PERM = true, AFTER_DRAIN = false;
  const u16* mg; u16* mi; u16* mo;
  DI void operator()(const pg8::f32x4 (&acc)[2][2][4][2], const pg8::Unit& u, int wr, int wc, int fr, int fq) const {
    const int rowb = u.pm * 256 + wr * 64 + fr;
    const int colb = u.pn * 256 + wc * 32 + 8 * fq;
    const size_t gbase = (((size_t)(u.pm * 8 + u.pn + (SECOND ? 4 : 0)) * 8 + (wr * 4 + wc)) * 16) * 64 + (fq * 16 + fr);
    const size_t ibase = (((size_t)(u.pm * 4 + u.pn) * 8 + (wr * 4 + wc)) * 16) * 64 + (fq * 16 + fr);
#pragma unroll
    for (int hb = 0; hb < 4; ++hb) {
      const int ai = hb >> 1, m0 = (hb & 1) * 2;
      u4v g[4], pm[4];
#pragma unroll
      for (int f4 = 0; f4 < 4; ++f4) {
        const int f = ai * 8 + (m0 + (f4 >> 1)) * 2 + (f4 & 1);
        g[f4] = *(const u4v*)(mg + (gbase + (size_t)f * 64) * 8);
        if (SECOND) pm[f4] = *(const u4v*)(mi + (ibase + (size_t)f * 64) * 8);
      }
#pragma unroll
      for (int f4 = 0; f4 < 4; ++f4) {
        const int m = m0 + (f4 >> 1), bj = f4 & 1;
        const int row = rowb + ai * 128 + m * 16;
        const pg8::f32x4 v0 = acc[ai][bj][m][0], v1 = acc[ai][bj][m][1];
        float r0 = v0[0] * bflo(g[f4].x), r1 = v0[1] * bfhi(g[f4].x), r2 = v0[2] * bflo(g[f4].y), r3 = v0[3] * bfhi(g[f4].y);
        float r4 = v1[0] * bflo(g[f4].z), r5 = v1[1] * bfhi(g[f4].z), r6 = v1[2] * bflo(g[f4].w), r7 = v1[3] * bfhi(g[f4].w);
        if (SECOND) {
          r0 += bflo(pm[f4].x); r1 += bfhi(pm[f4].x); r2 += bflo(pm[f4].y); r3 += bfhi(pm[f4].y);
          r4 += bflo(pm[f4].z); r5 += bfhi(pm[f4].z); r6 += bflo(pm[f4].w); r7 += bfhi(pm[f4].w);
        }
        u4v o; o.x = pk2(r0, r1); o.y = pk2(r2, r3); o.z = pk2(r4, r5); o.w = pk2(r6, r7);
        if (SECOND) *(u4v*)(mo + (size_t)row * 1024 + colb + bj * 128) = o;
        else *(u4v*)(mi + (ibase + (size_t)(ai * 8 + m * 2 + bj) * 64) * 8) = o;
      }
      __builtin_amdgcn_sched_barrier(0);
    }
  }
};
struct EpiQ {
  static constexpr bool PERM = true, AFTER_DRAIN = false;
  const float* ssq_q; const float* rope; u16* Qo;
  DI void operator()(const pg8::f32x4 (&acc)[2][2][4][2], const pg8::Unit& u, int wr, int wc, int fr, int fq) const {
    const int rowb = u.pm * 256 + wr * 64 + fr;
    const int colu = wc * 32 + 8 * fq;
    float sq[8];
#pragma unroll
    for (int i = 0; i < 8; ++i) sq[i] = ssq_q[rowb + (i >> 2) * 128 + (i & 3) * 16];
    if (u.pn < 2) {
#pragma unroll
      for (int ai = 0; ai < 2; ++ai)
#pragma unroll
        for (int m = 0; m < 4; ++m) {
          const int row = rowb + ai * 128 + m * 16;
          const int b = row >> 12, spos = row & 4095;
          const float sc = rsqrtf(sq[ai * 4 + m] * (1.f / 768.f) + EPS) * QSCALE;
#pragma unroll
          for (int bj = 0; bj < 2; ++bj) {
            const pg8::f32x4 v0 = acc[ai][bj][m][0], v1 = acc[ai][bj][m][1];
            const int head = u.pn * 4 + bj * 2 + (colu >> 6), d = colu & 63;
            u4v o; o.x = pk2(v0[0] * sc, v0[1] * sc); o.y = pk2(v0[2] * sc, v0[3] * sc); o.z = pk2(v1[0] * sc, v1[1] * sc); o.w = pk2(v1[2] * sc, v1[3] * sc);
            *(u4v*)(Qo + ((size_t)(b * 8 + head) * 4096 + spos) * 96 + d) = o;
          }
        }
    } else {
#pragma unroll
      for (int ai = 0; ai < 2; ++ai) {
        f4v cs[4], sn[4];
#pragma unroll
        for (int i = 0; i < 4; ++i) {
          const int spos = (rowb + ai * 128 + i * 16) & 4095;
          cs[i] = *(const f4v*)(rope + spos * 16 + 4 * fq); sn[i] = *(const f4v*)(rope + 65536 + spos * 16 + 4 * fq);
        }
#pragma unroll
        for (int m = 0; m < 4; ++m) {
          const int row = rowb + ai * 128 + m * 16;
          const int b = row >> 12, spos = row & 4095;
          const float sc = rsqrtf(sq[ai * 4 + m] * (1.f / 768.f) + EPS) * QSCALE;
          const f4v c4 = cs[m], s4 = sn[m];
#pragma unroll
          for (int bj = 0; bj < 2; ++bj) {
            const pg8::f32x4 v0 = acc[ai][bj][m][0], v1 = acc[ai][bj][m][1];
            const int head = bj * 4 + wc;
            u2v o1, o2;
            o1.x = pk2((v0[0] * c4.x - v1[0] * s4.x) * sc, (v0[1] * c4.y - v1[1] * s4.y) * sc);
            o1.y = pk2((v0[2] * c4.z - v1[2] * s4.z) * sc, (v0[3] * c4.w - v1[3] * s4.w) * sc);
            o2.x = pk2((v0[0] * s4.x + v1[0] * c4.x) * sc, (v0[1] * s4.y + v1[1] * c4.y) * sc);
            o2.y = pk2((v0[2] * s4.z + v1[2] * c4.z) * sc, (v0[3] * s4.w + v1[3] * c4.w) * sc);
            u16* qp = Qo + ((size_t)(b * 8 + head) * 4096 + spos) * 96 + 64 + 4 * fq;
            *(u2v*)qp = o1; *(u2v*)(qp + 16) = o2;
          }
        }
        __builtin_amdgcn_sched_barrier(0);
      }
    }
  }
};

struct EpiK {
  static constexpr bool PERM = true, AFTER_DRAIN = false;
  const float* ssq_kv; u16* Ko;
  DI void operator()(const pg8::f32x4 (&acc)[2][2][4][2], const pg8::Unit& u, int wr, int wc, int fr, int fq) const {
    const int rowb = u.pm * 256 + wr * 64 + fr;
    float sq[8];
#pragma unroll
    for (int i = 0; i < 8; ++i) sq[i] = ssq_kv[rowb + (i >> 2) * 128 + (i & 3) * 16];
#pragma unroll
    for (int ai = 0; ai < 2; ++ai)
#pragma unroll
      for (int m = 0; m < 4; ++m) {
        const int row = rowb + ai * 128 + m * 16;
        const int b = row >> 12, spos = row & 4095;
        const float sc = rsqrtf(sq[ai * 4 + m] * (1.f / 256.f) + EPS);
#pragma unroll
        for (int bj = 0; bj < 2; ++bj) {
          const pg8::f32x4 v0 = acc[ai][bj][m][0], v1 = acc[ai][bj][m][1];
          const int col = u.pn * 256 + bj * 128 + wc * 32 + 8 * fq;
          const int head = col >> 6, d = col & 63;
          u4v o; o.x = pk2(v0[0] * sc, v0[1] * sc); o.y = pk2(v0[2] * sc, v0[3] * sc); o.z = pk2(v1[0] * sc, v1[1] * sc); o.w = pk2(v1[2] * sc, v1[3] * sc);
          *(u4v*)(Ko + ((size_t)(b * 8 + head) * 4096 + spos) * 96 + d) = o;
        }
      }
  }
};
struct EpiV {
  static constexpr bool PERM = false, AFTER_DRAIN = false;
  const float* ssq_kv; u16* Vo;
  DI void operator()(const pg8::f32x4 (&acc)[2][2][4][2], const pg8::Unit& u, int wr, int wc, int fr, int fq) const {
    f4v sq[8];
#pragma unroll
    for (int i = 0; i < 8; ++i) sq[i] = *(const f4v*)(ssq_kv + u.pm * 256 + (i >> 2) * 128 + wr * 64 + (i & 3) * 16 + 4 * fq);
#pragma unroll
    for (int ai = 0; ai < 2; ++ai)
#pragma unroll
      for (int m = 0; m < 4; ++m) {
        const int row4 = u.pm * 256 + ai * 128 + wr * 64 + m * 16 + 4 * fq;
        const int b = row4 >> 12, spos = row4 & 4095;
        const f4v q = sq[ai * 4 + m];
        const float s0 = rsqrtf(q.x * (1.f / 256.f) + EPS), s1 = rsqrtf(q.y * (1.f / 256.f) + EPS), s2 = rsqrtf(q.z * (1.f / 256.f) + EPS), s3 = rsqrtf(q.w * (1.f / 256.f) + EPS);
#pragma unroll
        for (int bj = 0; bj < 2; ++bj)
#pragma unroll
          for (int n = 0; n < 2; ++n) {
            const pg8::f32x4 v = acc[ai][bj][m][n];
            const int col = u.pn * 256 + bj * 128 + wc * 32 + n * 16 + fr;
            const int head = col >> 6, dv = col & 63;
            u2v o; o.x = pk2(v[0] * s0, v[1] * s1); o.y = pk2(v[2] * s2, v[3] * s3);
            *(u2v*)(Vo + ((size_t)(b * 8 + head) * 64 + dv) * 4096 + spos) = o;
          }
        __builtin_amdgcn_sched_barrier(0);
      }
  }
};
DI void phase1(const Params& p, unsigned char* smem, bool dup = false) {
  unsigned char* ws = p.ws;
  pg8::Gemm g{(const u16*)(ws + OFF_H), (const u16*)(ws + OFF_WIN), T, NP, 1024};
  pg8::StaticOrder S; S.init(T, NP, (int)gridDim.x, (int)blockIdx.x);
  Epi1 E{ws, (u16*)p.out, p.b_gate, dup};
  pg8::gemm_phase<Epi1, pg8::StaticOrder, false>((PG8_LAS unsigned char*)smem, g, S, E, nullptr);
  const int nlight = (int)gridDim.x / 2;
  if (!dup && (int)blockIdx.x >= (int)gridDim.x - nlight) {
    const int gtid = ((int)blockIdx.x - ((int)gridDim.x - nlight)) * (int)blockDim.x + (int)threadIdx.x, gthreads = nlight * (int)blockDim.x;
    conv_weight<1>((u16*)(ws + OFF_WUQ), p.w_uq, 768, 768, 768, p.g_q, 1023, gtid, gthreads);
    conv_weight<3>((u16*)(ws + OFF_WUKV), p.w_ukv, 1024, 1024, 256, p.g_kv, 255, gtid, gthreads);
    conv_weight<2>((u16*)(ws + OFF_WA), p.w_a, 1024, 1024, 512, nullptr, 0, gtid, gthreads);
    conv_weight<2>((u16*)(ws + OFF_WB), p.w_b, 1024, 1024, 512, p.g_hgrn, 63, gtid, gthreads);
    conv_weight<2>((u16*)(ws + OFF_WO), p.w_out, 1024, 1024, 1024, nullptr, 0, gtid, gthreads);
  }
}

DI void hgrn_prep_tile(const Params& p, float* stage, int tid, int b, int hh, int prow0, int nblk0) {
  unsigned char* ws = p.ws;
  const int bh = b * 8 + hh;
  if (tid < 128) {
    const int c = tid & 63, blk = tid >> 6;
    const float l0 = p.lb_logits[hh * 64 + c], l1 = p.lb_logits[512 + hh * 64 + c];
    const float lbv = 1.f / (1.f + expf(l1 - l0));
    float cum = 0.f;
    for (int rr = 0; rr < 32; ++rr) {
      float* sp = stage + (blk * 32 + rr) * SST + c;
      const float q = sp[0], hf = sp[64];
      const float sg = 1.f / (1.f + expf(-hf));
      const float f = lbv + (1.f - lbv) * sg;
      cum += logf(f);
      const float e = expf(cum);
      sp[0] = q * e;
      sp[64] = (1.f - f) / e;
    }
    ((float*)(ws + OFF_DECAY))[((size_t)bh * 128 + nblk0 + blk) * 64 + c] = expf(cum);
  }
  __syncthreads();
#pragma unroll
  for (int it = 0; it < 2; ++it) {
    const int item = tid + 256 * it, rr = item >> 3, cc = (item & 7) * 8;
    const f4v a = *(const f4v*)(stage + rr * SST + cc), c = *(const f4v*)(stage + rr * SST + cc + 4);
    const f4v d = *(const f4v*)(stage + rr * SST + 64 + cc), e = *(const f4v*)(stage + rr * SST + 64 + cc + 4);
    const size_t o = (size_t)(prow0 + rr) * 512 + hh * 64 + cc;
    *(u4v*)((u16*)(ws + OFF_QDEC) + o) = pk8(a, c);
    *(u4v*)((u16*)(ws + OFF_KINV) + o) = pk8(d, e);
  }
}
DI void hi_vt_tile(const Params& p, float* stage, int tid, int b, int q2, int nblk0) {
  unsigned char* ws = p.ws;
#pragma unroll
        for (int it = 0; it < 4; ++it) {
          const int item = tid + 256 * it, sc = item & 3, col = (item >> 2) & 127, blk = item >> 9;
          float v[8];
#pragma unroll
          for (int i = 0; i < 8; ++i) v[i] = stage[(blk * 32 + sc * 8 + i) * SST + col];
          u4v o; o.x = pk2(v[0], v[1]); o.y = pk2(v[2], v[3]); o.z = pk2(v[4], v[5]); o.w = pk2(v[6], v[7]);
          const int bh = b * 8 + q2 * 2 + (col >> 6);
          *(u4v*)((u16*)(ws + OFF_VT) + (((size_t)bh * 128 + nblk0 + blk) * 64 + (col & 63)) * 32 + sc * 8) = o;
        }
}
DI void stage_load64(float* stage, const u16* src, int coff, int tid) {
#pragma unroll
  for (int it = 0; it < 2; ++it) {
    const int item = tid + 256 * it, rr = item >> 3, ch = item & 7;
    const u4v v = *(const u4v*)(src + (size_t)rr * 512 + ch * 8);
    float* d = stage + rr * SST + coff + ch * 8;
    *(f4v*)d = f4v{bflo(v.x), bfhi(v.x), bflo(v.y), bfhi(v.y)};
    *(f4v*)(d + 4) = f4v{bflo(v.z), bfhi(v.z), bflo(v.w), bfhi(v.w)};
  }
}


constexpr int PST = 68;
DI void hgrn_prep_native(const Params& p, float* pl, int rb, int hh) {
  unsigned char* ws = p.ws;
  const int tid = threadIdx.x;
  float* Qp = pl; float* G = pl + 128 * PST; float* Kn = pl + 2 * 128 * PST;
  const int prow0 = rb * 128, b = prow0 >> 12, bh = b * 8 + hh, nblk0 = (prow0 & 4095) >> 5;
  const int ch = tid & 7;
  float lbv[8];
  {
    const f4v a0 = *(const f4v*)(p.lb_logits + hh * 64 + ch * 8), a1 = *(const f4v*)(p.lb_logits + hh * 64 + ch * 8 + 4);
    const f4v b0 = *(const f4v*)(p.lb_logits + 512 + hh * 64 + ch * 8), b1 = *(const f4v*)(p.lb_logits + 512 + hh * 64 + ch * 8 + 4);
    const float l0[8] = {a0.x, a0.y, a0.z, a0.w, a1.x, a1.y, a1.z, a1.w}, l1[8] = {b0.x, b0.y, b0.z, b0.w, b1.x, b1.y, b1.z, b1.w};
#pragma unroll
    for (int i = 0; i < 8; ++i) lbv[i] = 1.f / (1.f + expf(l1[i] - l0[i]));
  }
  __syncthreads();
#pragma unroll
  for (int it = 0; it < 2; ++it) {
    const int rr = (tid + 512 * it) >> 3;
    const size_t go = (size_t)(prow0 + rr) * 512 + hh * 64 + ch * 8;
    const u4v qv = *(const u4v*)((const u16*)(ws + OFF_HQ) + go), fv = *(const u4v*)((const u16*)(ws + OFF_HF) + go);
    const float q[8] = {bflo(qv.x), bfhi(qv.x), bflo(qv.y), bfhi(qv.y), bflo(qv.z), bfhi(qv.z), bflo(qv.w), bfhi(qv.w)};
    const float hf[8] = {bflo(fv.x), bfhi(fv.x), bflo(fv.y), bfhi(fv.y), bflo(fv.z), bfhi(fv.z), bflo(fv.w), bfhi(fv.w)};
    float g[8], kn[8];
#pragma unroll
    for (int i = 0; i < 8; ++i) {
      const float sg = rcpf(1.f + __builtin_amdgcn_exp2f(-1.4426950408889634f * hf[i]));
      const float f = lbv[i] + (1.f - lbv[i]) * sg;
      g[i] = __builtin_amdgcn_logf(f);
      kn[i] = 1.f - f;
    }
    float* d = Qp + rr * PST + ch * 8;
    *(f4v*)d = f4v{q[0], q[1], q[2], q[3]}; *(f4v*)(d + 4) = f4v{q[4], q[5], q[6], q[7]};
    d = G + rr * PST + ch * 8;
    *(f4v*)d = f4v{g[0], g[1], g[2], g[3]}; *(f4v*)(d + 4) = f4v{g[4], g[5], g[6], g[7]};
    d = Kn + rr * PST + ch * 8;
    *(f4v*)d = f4v{kn[0], kn[1], kn[2], kn[3]}; *(f4v*)(d + 4) = f4v{kn[4], kn[5], kn[6], kn[7]};
  }
  __syncthreads();
  if (tid < 256) {
    const int c = tid & 63, blk = tid >> 6;
    float* gp = G + (blk * 32) * PST + c;
    float v[32];
#pragma unroll
    for (int r2 = 0; r2 < 32; ++r2) v[r2] = gp[r2 * PST];
    float cum = 0.f;
#pragma unroll
    for (int r2 = 0; r2 < 32; ++r2) { cum += v[r2]; gp[r2 * PST] = cum; }
    ((float*)(ws + OFF_DECAY))[((size_t)bh * 128 + nblk0 + blk) * 64 + c] = __builtin_amdgcn_exp2f(cum);
  }
  __syncthreads();
#pragma unroll
  for (int it = 0; it < 2; ++it) {
    const int rr = (tid + 512 * it) >> 3;
    const float* s0 = Qp + rr * PST + ch * 8; const float* s1 = G + rr * PST + ch * 8; const float* s2 = Kn + rr * PST + ch * 8;
    const f4v q0 = *(const f4v*)s0, q1 = *(const f4v*)(s0 + 4), c0 = *(const f4v*)s1, c1 = *(const f4v*)(s1 + 4), k0 = *(const f4v*)s2, k1 = *(const f4v*)(s2 + 4);
    const float q[8] = {q0.x, q0.y, q0.z, q0.w, q1.x, q1.y, q1.z, q1.w}, cm[8] = {c0.x, c0.y, c0.z, c0.w, c1.x, c1.y, c1.z, c1.w}, kn[8] = {k0.x, k0.y, k0.z, k0.w, k1.x, k1.y, k1.z, k1.w};
    float qd[8], ki[8];
#pragma unroll
    for (int i = 0; i < 8; ++i) { qd[i] = q[i] * __builtin_amdgcn_exp2f(cm[i]); ki[i] = kn[i] * __builtin_amdgcn_exp2f(-cm[i]); }
    const size_t go = (size_t)(prow0 + rr) * 512 + hh * 64 + ch * 8;
    u4v o; o.x = pk2(qd[0], qd[1]); o.y = pk2(qd[2], qd[3]); o.z = pk2(qd[4], qd[5]); o.w = pk2(qd[6], qd[7]);
    *(u4v*)((u16*)(ws + OFF_QDEC) + go) = o;
    o.x = pk2(ki[0], ki[1]); o.y = pk2(ki[2], ki[3]); o.z = pk2(ki[4], ki[5]); o.w = pk2(ki[6], ki[7]);
    *(u4v*)((u16*)(ws + OFF_KINV) + go) = o;
  }
}
constexpr int VTS = 136;
DI void hi_vt_native(const Params& p, u16* img, int rb, int q2) {
  unsigned char* ws = p.ws;
  const int tid = threadIdx.x;
  const int prow0 = rb * 128, b = prow0 >> 12, nblk0 = (prow0 & 4095) >> 5;
  __syncthreads();
#pragma unroll
  for (int it = 0; it < 4; ++it) {
    const int item = tid + 512 * it, rr = item >> 4, c16 = item & 15;
    *(u4v*)(img + rr * VTS + c16 * 8) = *(const u4v*)((const u16*)(ws + OFF_HI) + (size_t)(prow0 + rr) * 512 + q2 * 128 + c16 * 8);
  }
  __syncthreads();
#pragma unroll
  for (int it = 0; it < 4; ++it) {
    const int item = tid + 512 * it, sc = item & 3, col = (item >> 2) & 127, blk = item >> 9;
    u32 w[4];
#pragma unroll
    for (int i = 0; i < 4; ++i) {
      const u32 lo = img[(blk * 32 + sc * 8 + 2 * i) * VTS + col], hi = img[(blk * 32 + sc * 8 + 2 * i + 1) * VTS + col];
      w[i] = lo | (hi << 16);
    }
    const int bh = b * 8 + q2 * 2 + (col >> 6);
    *(u4v*)((u16*)(ws + OFF_VT) + (((size_t)bh * 128 + nblk0 + blk) * 64 + (col & 63)) * 32 + sc * 8) = u4v{w[0], w[1], w[2], w[3]};
  }
}

DI void rope8(const float* x1, const float* x2, const float* rope, int spos, int j0, bool first, float scale, float (&o)[8]) {
  const f4v c0 = *(const f4v*)(rope + spos * 16 + j0), c1 = *(const f4v*)(rope + spos * 16 + j0 + 4);
  const f4v s0 = *(const f4v*)(rope + 65536 + spos * 16 + j0), s1 = *(const f4v*)(rope + 65536 + spos * 16 + j0 + 4);
  const float cs[8] = {c0.x, c0.y, c0.z, c0.w, c1.x, c1.y, c1.z, c1.w};
  const float sn[8] = {s0.x, s0.y, s0.z, s0.w, s1.x, s1.y, s1.z, s1.w};
#pragma unroll
  for (int i = 0; i < 8; ++i) o[i] = scale * (first ? (x1[i] * cs[i] - x2[i] * sn[i]) : (x1[i] * sn[i] + x2[i] * cs[i]));
}

DI void phase2(const Params& p, unsigned char* smem, u16* lds) {
  unsigned char* ws = p.ws;
  const int tid = VTID;
  float* stage = (float*)lds;
  const float* ssq_q = (const float*)(ws + OFF_SSQ);
  const float* ssq_kv = ssq_q + T;
  const float* rope = (const float*)(ws + OFF_ROPE);
  u16* Qo = (u16*)(ws + OFF_Q);
  u16* Ko = (u16*)(ws + OFF_K);
  u16* Vo = (u16*)(ws + OFF_VTT);
#pragma nounroll
  for (int rep = 0; rep < (DUP_PH == 21 ? p.ph_hi - 7 : 1); ++rep) {
    pg8::Gemm g{(const u16*)(ws + OFF_CQ), (const u16*)(ws + OFF_WUQ), T, 768, 768};
    pg8::StaticOrder S; S.init(T, 768, (int)gridDim.x, (int)blockIdx.x);
    EpiQ E{ssq_q, rope, Qo};
    pg8::gemm_phase<EpiQ, pg8::StaticOrder, false>((PG8_LAS unsigned char*)smem, g, S, E, nullptr);
  }
#pragma nounroll
  for (int rep = 0; rep < (DUP_PH == 23 ? p.ph_hi - 7 : 1); ++rep) {
    pg8::StaticOrder S; S.init(T, 512, (int)gridDim.x, (int)blockIdx.x);
    {
      int kk = 256; asm volatile("" : "+s"(kk));
      pg8::Gemm g{(const u16*)(ws + OFF_CKV), (const u16*)(ws + OFF_WUKV), T, 512, kk};
      EpiK E{ssq_kv, Ko};
      pg8::gemm_phase<EpiK, pg8::StaticOrder, false>((PG8_LAS unsigned char*)smem, g, S, E, nullptr);
    }
  }
  {
    pg8::StaticOrder S; S.init(T, 512, (int)gridDim.x, (int)blockIdx.x);
    int kk = 256; asm volatile("" : "+s"(kk));
    pg8::Gemm g{(const u16*)(ws + OFF_CKV), (const u16*)(ws + OFF_WUKV) + (size_t)512 * 256, T, 512, kk};
    EpiV E{(const float*)(ws + OFF_SSQ) + T, (u16*)(ws + OFF_VTT)};
    pg8::gemm_phase<EpiV, pg8::StaticOrder, false, true>((PG8_LAS unsigned char*)smem, g, S, E, nullptr);
  }
#pragma nounroll
  for (int rep = 0; rep < (DUP_PH == 22 ? p.ph_hi - 7 : 1); ++rep) {
    const int gtid = blockIdx.x * blockDim.x + threadIdx.x, gthreads = gridDim.x * blockDim.x;
    for (int idx = gtid; idx < T * 4; idx += gthreads) {
      const int tok = idx >> 2, wv = (idx & 3) * 8, j0 = wv & 15;
      const int b = tok >> 12, spos = tok & 4095;
      const float* kp = (const float*)(ws + OFF_KPE) + (size_t)tok * 32;
      const f4v a0 = *(const f4v*)(kp + j0), a1 = *(const f4v*)(kp + j0 + 4);
      const f4v b0 = *(const f4v*)(kp + 16 + j0), b1 = *(const f4v*)(kp + 16 + j0 + 4);
      const float x1[8] = {a0.x, a0.y, a0.z, a0.w, a1.x, a1.y, a1.z, a1.w};
      const float x2[8] = {b0.x, b0.y, b0.z, b0.w, b1.x, b1.y, b1.z, b1.w};
      float o[8];
      rope8(x1, x2, rope, spos, j0, wv < 16, 1.f, o);
      u4v ov; ov.x = pk2(o[0], o[1]); ov.y = pk2(o[2], o[3]); ov.z = pk2(o[4], o[5]); ov.w = pk2(o[6], o[7]);
#pragma unroll
      for (int head = 0; head < 8; ++head) *(u4v*)(Ko + ((size_t)(b * 8 + head) * 4096 + spos) * 96 + 64 + wv) = ov;
    }
  }
  for (int rep = 0; rep < (DUP_PH == 20 ? 2 : 1); ++rep)
  {
    const int G = (int)gridDim.x, c = (int)blockIdx.x, hG = G / 2, round = 2 * G + hG;
    for (int base = 0; base < 2048 + 1024; base += round) {
#pragma unroll 1
      for (int k = 0; k < 3; ++k) {
        if (k == 2 && c < G - hG) break;
        const int t = base + (k == 0 ? c : k == 1 ? G + c : 2 * G + (c - (G - hG)));
        if (t >= 2048 + 1024) break;
        if (t < 2048) hgrn_prep_native(p, (float*)smem, t >> 3, t & 7);
        else hi_vt_native(p, (u16*)smem, (t - 2048) >> 2, (t - 2048) & 3);
      }
    }
  }
}

DI void phase2b(const Params& p, unsigned char* smem) {
  unsigned char* ws = p.ws;
  const int tid = VTID;
}

constexpr int KST2 = 104, VST2 = 132;
constexpr int ATT_BUF2 = 128 * KST2 + 64 * VST2;
DI void att_qk(const u16* sk, const bf16x8 (&qf)[6], float nm, f32x16 (&st)[2]) {
#pragma unroll
  for (int i = 0; i < 16; ++i) { st[0][i] = nm; st[1][i] = nm; }
#pragma unroll
  for (int kb = 0; kb < 2; ++kb)
#pragma unroll
    for (int ks = 0; ks < 6; ++ks) {
      const bf16x8 kf = *(const bf16x8*)(sk + kb * 32 * KST2 + ks * 16);
      st[kb] = MFMA(kf, qf[ks], st[kb]);
    }
}
DI float att_softmax(f32x16 (&st)[2], float adj, bool adjnz, bool first, float& mref, float& l, f32x16 (&o)[2]) {
  float mx = st[0][0];
#pragma unroll
  for (int i = 1; i < 16; ++i) mx = fmaxf(mx, st[0][i]);
#pragma unroll
  for (int i = 0; i < 16; ++i) mx = fmaxf(mx, st[1][i]);
  mx = xor32_max(mx) - adj;
  f2v ps = f2v{0.f, 0.f};
  float shift_out = 0.f;
  if (first || adjnz || __builtin_amdgcn_ballot_w64(mx > 8.f) != 0ull) {
    const float shift = first ? mx : fmaxf(mx, 0.f);
    const float tot = adj + shift;
    const float alpha = first ? 0.f : __builtin_amdgcn_exp2f(-shift);
    mref += shift;
#pragma unroll
    for (int kb = 0; kb < 2; ++kb)
#pragma unroll
      for (int i = 0; i < 16; i += 2) {
        const float p0 = __builtin_amdgcn_exp2f(st[kb][i] - tot), p1 = __builtin_amdgcn_exp2f(st[kb][i + 1] - tot);
        st[kb][i] = p0; st[kb][i + 1] = p1; ps += f2v{p0, p1};
      }
    l = l * alpha + (ps.x + ps.y);
#pragma unroll
    for (int i = 0; i < 16; ++i) { o[0][i] *= alpha; o[1][i] *= alpha; }
    shift_out = shift;
  } else {
#pragma unroll
    for (int kb = 0; kb < 2; ++kb)
#pragma unroll
      for (int i = 0; i < 16; i += 2) {
        const float p0 = __builtin_amdgcn_exp2f(st[kb][i]), p1 = __builtin_amdgcn_exp2f(st[kb][i + 1]);
        st[kb][i] = p0; st[kb][i + 1] = p1; ps += f2v{p0, p1};
      }
    l += ps.x + ps.y;
  }
  return shift_out;
}
DI void att_pv(const u16* sv, const f32x16 (&st)[2], f32x16 (&o)[2]) {
#pragma unroll
  for (int s4 = 0; s4 < 4; ++s4) {
    const int kb = s4 >> 1, rb = 8 * (s4 & 1);
    u4v pu; pu.x = pk2(st[kb][rb], st[kb][rb + 1]); pu.y = pk2(st[kb][rb + 2], st[kb][rb + 3]);
    pu.z = pk2(st[kb][rb + 4], st[kb][rb + 5]); pu.w = pk2(st[kb][rb + 6], st[kb][rb + 7]);
    const bf16x8 pb = __builtin_bit_cast(bf16x8, pu);
#pragma unroll
    for (int db = 0; db < 2; ++db) {
      const s16x4 lo = *(const s16x4*)(sv + db * 32 * VST2 + 16 * s4);
      const s16x4 hi = *(const s16x4*)(sv + db * 32 * VST2 + 16 * s4 + 8);
      const bf16x8 vf = __builtin_shufflevector(lo, hi, 0, 1, 2, 3, 4, 5, 6, 7);
      o[db] = MFMA(vf, pb, o[db]);
    }
  }
}
DI void attn8_item(const Params& p, u16* lds, int bh, int qt) {
  unsigned char* ws = p.ws;
  const int tid = threadIdx.x, lane = tid & 63, w = tid >> 6, r = lane & 31, h = lane >> 5;
  const u16* Qp = (const u16*)(ws + OFF_Q) + (size_t)bh * 4096 * 96;
  const u16* Kp = (const u16*)(ws + OFF_K) + (size_t)bh * 4096 * 96;
  const u16* Vp = (const u16*)(ws + OFF_VTT) + (size_t)bh * 64 * 4096;
  const int q0 = qt * 256 + w * 32;
  bf16x8 qf[6];
#pragma unroll
  for (int ks = 0; ks < 6; ++ks) qf[ks] = *(const bf16x8*)(Qp + (size_t)(q0 + r) * 96 + ks * 16 + h * 8);
  f32x16 o[2]; o[0] = zero16(); o[1] = zero16();
  float mref = 0.f, l = 0.f;
  const int Jmax = 2 * qt + 1, jw = 4 * qt + (w >> 1);
  int kr[3], kc[3];
#pragma unroll
  for (int i = 0; i < 3; ++i) { const int idx = tid + 512 * i; kr[i] = idx / 12; kc[i] = idx % 12; }
  const int vr = tid >> 4, vc = tid & 15;
  u4v rk[3], rv[2];
#pragma unroll
  for (int i = 0; i < 3; ++i) rk[i] = *(const u4v*)(Kp + (size_t)kr[i] * 96 + kc[i] * 8);
#pragma unroll
  for (int i = 0; i < 2; ++i) rv[i] = *(const u4v*)(Vp + (size_t)(vr + 32 * i) * 4096 + vc * 8);
  __syncthreads();
#pragma unroll
  for (int i = 0; i < 3; ++i) *(u4v*)(lds + kr[i] * KST2 + kc[i] * 8) = rk[i];
#pragma unroll
  for (int i = 0; i < 2; ++i) { u16* dv = lds + 128 * KST2 + (vr + 32 * i) * VST2 + vc * 8; *(u2v*)dv = u2v{rv[i].x, rv[i].y}; *(u2v*)(dv + 4) = u2v{rv[i].z, rv[i].w}; }
  __syncthreads();
  for (int J = 0; J <= Jmax; ++J) {
    const int cur = J & 1;
    if (J < Jmax) {
#pragma unroll
      for (int i = 0; i < 3; ++i) rk[i] = *(const u4v*)(Kp + (size_t)((J + 1) * 128 + kr[i]) * 96 + kc[i] * 8);
#pragma unroll
      for (int i = 0; i < 2; ++i) rv[i] = *(const u4v*)(Vp + (size_t)(vr + 32 * i) * 4096 + (J + 1) * 128 + vc * 8);
    }
    const u16* sk = lds + cur * ATT_BUF2 + r * KST2 + h * 8;
    const u16* sv = lds + cur * ATT_BUF2 + 128 * KST2 + r * VST2 + 4 * h;
    if (2 * J + 1 <= jw) {
      f32x16 s0[2], s1[2];
      const float nm = -mref;
      att_qk(sk, qf, nm, s0);
      att_qk(sk + 64 * KST2, qf, nm, s1);
      const float sh = att_softmax(s0, 0.f, false, J == 0, mref, l, o);
      const bool adjnz = __builtin_amdgcn_ballot_w64(sh != 0.f) != 0ull;
      att_pv(sv, s0, o);
      att_softmax(s1, sh, adjnz, false, mref, l, o);
      att_pv(sv + 64, s1, o);
    } else if (2 * J <= jw) {
      f32x16 s0[2];
      att_qk(sk, qf, -mref, s0);
      att_softmax(s0, 0.f, false, J == 0, mref, l, o);
      att_pv(sv, s0, o);
    }
    if (J < Jmax) {
      u16* d = lds + (cur ^ 1) * ATT_BUF2;
#pragma unroll
      for (int i = 0; i < 3; ++i) *(u4v*)(d + kr[i] * KST2 + kc[i] * 8) = rk[i];
#pragma unroll
      for (int i = 0; i < 2; ++i) { u16* dv = d + 128 * KST2 + (vr + 32 * i) * VST2 + vc * 8; *(u2v*)dv = u2v{rv[i].x, rv[i].y}; *(u2v*)(dv + 4) = u2v{rv[i].z, rv[i].w}; }
    }
    __syncthreads();
  }
  l = xor32_add(l);
  const float inv = 1.f / l;
  const int b = bh >> 3, head = bh & 7;
  const size_t tok = (size_t)b * 4096 + q0 + r;
  const u16* sga = (const u16*)(ws + OFF_SGA) + tok * 512 + head * 64;
  u16* ya = (u16*)(ws + OFF_YA) + tok * 512 + head * 64;
#pragma unroll
  for (int db = 0; db < 2; ++db)
#pragma unroll
    for (int g = 0; g < 4; ++g) {
      const int dv0 = db * 32 + 8 * g + 4 * h;
      const u2v gt = *(const u2v*)(sga + dv0);
      u2v ov;
      ov.x = pk2(o[db][4 * g] * inv * bflo(gt.x), o[db][4 * g + 1] * inv * bfhi(gt.x));
      ov.y = pk2(o[db][4 * g + 2] * inv * bflo(gt.y), o[db][4 * g + 3] * inv * bfhi(gt.y));
      *(u2v*)(ya + dv0) = ov;
    }
}

DI void scan_item(const Params& p, int i, size_t out_off = OFF_UPD) {
  unsigned char* ws = p.ws;
  const int tid = threadIdx.x;
  const int bh = i >> 2, part = i & 3;
  const int e = part * 1024 + tid * 2, k = e & 63;
  u32* U = (u32*)((u16*)(ws + OFF_UPD) + (size_t)bh * 128 * 4096 + e);
  u32* UO = (u32*)((u16*)(ws + out_off) + (size_t)bh * 128 * 4096 + e);
  const f2v* Dc = (const f2v*)((const float*)(ws + OFF_DECAY) + (size_t)bh * 128 * 64 + k);
  float s0 = 0.f, s1 = 0.f;
  for (int n0 = 0; n0 < 128; n0 += 32) {
    u32 u[32]; f2v d[32];
#pragma unroll
    for (int q = 0; q < 32; ++q) { u[q] = U[(size_t)(n0 + q) * 2048]; d[q] = Dc[(n0 + q) * 32]; }
#pragma unroll
    for (int q = 0; q < 32; ++q) {
      UO[(size_t)(n0 + q) * 2048] = pk2(s0, s1);
      s0 = d[q].x * (s0 + bflo(u[q]));
      s1 = d[q].y * (s1 + bfhi(u[q]));
    }
  }
}

DI void hgrn_state_item(const Params& p, float* ub, int bh, int vb) {
  unsigned char* ws = p.ws;
  const int tid = threadIdx.x, lane = tid & 63, w = tid >> 6, r = lane & 31, h = lane >> 5;
  const int b = bh >> 3, head = bh & 7;
  const u16* kn_base = (const u16*)(ws + OFF_KINV) + ((size_t)b * 4096) * 512 + head * 64;
  const u16* vt_base = (const u16*)(ws + OFF_VT) + ((size_t)bh * 128) * 64 * 32;
  const float* dec = (const float*)(ws + OFF_DECAY) + (size_t)bh * 128 * 64;
  u16* up = (u16*)(ws + OFF_UPD) + (size_t)bh * 128 * 4096;
  const int vl = tid >> 4, k0 = (tid & 15) * 4;
  constexpr int KS = 68;
  f4v st = f4v{0.f, 0.f, 0.f, 0.f};
#pragma unroll 1
  for (int i = 0; i < 16; ++i) {
    const int n = i * 8 + w;
    bf16x8 a[2][2], bb[2];
    const u16* kn = kn_base + (size_t)(n * 32) * 512;
#pragma unroll
    for (int kb = 0; kb < 2; ++kb)
#pragma unroll
      for (int ks = 0; ks < 2; ++ks) {
        bf16x8 av;
#pragma unroll
        for (int j = 0; j < 8; ++j) av[j] = (short)kn[(size_t)(ks * 16 + h * 8 + j) * 512 + kb * 32 + r];
        a[kb][ks] = av;
      }
#pragma unroll
    for (int ks = 0; ks < 2; ++ks) bb[ks] = *(const bf16x8*)(vt_base + ((size_t)n * 64 + vb * 32 + r) * 32 + ks * 16 + h * 8);
    f4v d[8];
#pragma unroll
    for (int j = 0; j < 8; ++j) d[j] = *(const f4v*)(dec + (size_t)(i * 8 + j) * 64 + k0);
    __syncthreads();
#pragma unroll
    for (int kb = 0; kb < 2; ++kb) {
      f32x16 c = zero16();
      c = MFMA(a[kb][0], bb[0], c);
      c = MFMA(a[kb][1], bb[1], c);
#pragma unroll
      for (int g = 0; g < 4; ++g) *(f4v*)(ub + (w * 32 + r) * KS + kb * 32 + 8 * g + 4 * h) = f4v{c[4 * g], c[4 * g + 1], c[4 * g + 2], c[4 * g + 3]};
    }
    __syncthreads();
#pragma unroll
    for (int j = 0; j < 8; ++j) {
      const f4v u = *(const f4v*)(ub + (j * 32 + vl) * KS + k0);
      u2v o; o.x = pk2(st.x, st.y); o.y = pk2(st.z, st.w);
      *(u2v*)(up + (size_t)(i * 8 + j) * 4096 + (vb * 32 + vl) * 64 + k0) = o;
      st.x = d[j].x * (st.x + u.x); st.y = d[j].y * (st.y + u.y); st.z = d[j].z * (st.z + u.z); st.w = d[j].w * (st.w + u.w);
    }
  }
  asm volatile("s_waitcnt vmcnt(0)" ::: "memory");
  __syncthreads();
  if (threadIdx.x == 0) {
    __builtin_amdgcn_fence(__ATOMIC_RELEASE, "agent");
    asm volatile("s_waitcnt vmcnt(0)" ::: "memory");
    __hip_atomic_fetch_add((unsigned*)(ws + OFF_SSQ + (size_t)3 * T * 4) + 64 + bh, 1u, __ATOMIC_RELAXED, __HIP_MEMORY_SCOPE_AGENT);
  }
}

DI void h3_item(const Params& p, int t);
DI void phase3(const Params& p, unsigned char* smem, bool dup = false) {
  int* s_item = (int*)(smem + LDS_BYTES - 64);
  int* ctr = (int*)(p.ws + OFF_SSQ + (size_t)3 * T * 4) + (dup ? 1 : 0);
  unsigned* done = (unsigned*)(p.ws + OFF_SSQ + (size_t)3 * T * 4) + 64;
  if (!dup) for (int it = (int)blockIdx.x - ((int)gridDim.x - 128); it >= 0 && it < 128; it += 128 * 1024) hgrn_state_item(p, (float*)smem, it >> 1, it & 1);
  if (!dup && (int)gridDim.x < 128) for (int it = (int)blockIdx.x; it < 128; it += (int)gridDim.x) hgrn_state_item(p, (float*)smem, it >> 1, it & 1);
  for (;;) {
    __syncthreads();
    if (threadIdx.x == 0) *s_item = atomicAdd(ctr, 1);
    __syncthreads();
    const int item = *s_item;
    if (item >= 2048) break;
    int att = -1, h3 = -1;
    if (item < 256) att = item;
    else { const int j = item - 256, g = j / 7, pos = j % 7; if (pos == 0 || pos == 2 || pos == 4) att = 256 + 3 * g + (pos >> 1); else h3 = 4 * g + (pos == 1 ? 0 : pos == 3 ? 1 : pos == 5 ? 2 : 3); }
    if (att >= 0) attn8_item(p, (u16*)smem, att & 63, 15 - (att >> 6));
    else if (!dup) {
      const int bh = h3 >> 4;
      if (threadIdx.x == 0) {
        unsigned sp = 0;
        while (__hip_atomic_load(done + bh, __ATOMIC_RELAXED, __HIP_MEMORY_SCOPE_AGENT) < 2u) { __builtin_amdgcn_s_sleep(2); if (++sp > (1u << 22)) break; }
        __builtin_amdgcn_fence(__ATOMIC_ACQUIRE, "agent");
        asm volatile("s_waitcnt vmcnt(0)" ::: "memory");
      }
      __syncthreads();
      h3_item(p, 2 * h3 + (int)(threadIdx.x >> 8));
    }
  }
}

DI void h3_item(const Params& p, int t) {
  unsigned char* ws = p.ws;
  const int tid = VTID, lane = tid & 63, w = tid >> 6, r = lane & 31, h = lane >> 5;
  {
    const int bh = t >> 5, n = (t & 31) * 4 + w;
    const int b = bh >> 3, head = bh & 7;
    const size_t tok0 = (size_t)b * 4096 + n * 32;
    const u16* qd = (const u16*)(ws + OFF_QDEC) + (tok0 + r) * 512 + head * 64 + h * 8;
    const u16* ki = (const u16*)(ws + OFF_KINV) + (tok0 + r) * 512 + head * 64 + h * 8;
    const u16* vt = (const u16*)(ws + OFF_VT) + ((size_t)bh * 128 + n) * 64 * 32;
    const u16* sp = (const u16*)(ws + OFF_UPD) + ((size_t)bh * 128 + n) * 4096;
    bf16x8 qf[4], kf[4];
#pragma unroll
    for (int ks = 0; ks < 4; ++ks) { qf[ks] = *(const bf16x8*)(qd + ks * 16); kf[ks] = *(const bf16x8*)(ki + ks * 16); }
    f32x16 at = zero16();
#pragma unroll
    for (int ks = 0; ks < 4; ++ks) at = MFMA(kf[ks], qf[ks], at);
#pragma unroll
    for (int i = 0; i < 16; ++i) if (crow(i, h) > r) at[i] = 0.f;
    f32x16 o[2]; o[0] = zero16(); o[1] = zero16();
#pragma unroll
    for (int s2 = 0; s2 < 2; ++s2) {
      u4v pu; pu.x = pk2(at[8 * s2], at[8 * s2 + 1]); pu.y = pk2(at[8 * s2 + 2], at[8 * s2 + 3]);
      pu.z = pk2(at[8 * s2 + 4], at[8 * s2 + 5]); pu.w = pk2(at[8 * s2 + 6], at[8 * s2 + 7]);
      const bf16x8 pb = __builtin_bit_cast(bf16x8, pu);
#pragma unroll
      for (int vb = 0; vb < 2; ++vb) {
        const s16x4 lo = *(const s16x4*)(vt + (vb * 32 + r) * 32 + 16 * s2 + 4 * h);
        const s16x4 hi = *(const s16x4*)(vt + (vb * 32 + r) * 32 + 16 * s2 + 8 + 4 * h);
        const bf16x8 vf = __builtin_shufflevector(lo, hi, 0, 1, 2, 3, 4, 5, 6, 7);
        o[vb] = MFMA(vf, pb, o[vb]);
      }
    }
#pragma unroll
    for (int vb = 0; vb < 2; ++vb)
#pragma unroll
      for (int ks = 0; ks < 4; ++ks) {
        const bf16x8 sf = *(const bf16x8*)(sp + (vb * 32 + r) * 64 + ks * 16 + h * 8);
        o[vb] = MFMA(sf, qf[ks], o[vb]);
      }
    float ss = 0.f;
#pragma unroll
    for (int i = 0; i < 16; ++i) ss += o[0][i] * o[0][i] + o[1][i] * o[1][i];
    ss = xor32_add(ss);
    const float rs = rsqrtf(ss * (1.f / 64.f) + EPS);
    const u16* sgb = (const u16*)(ws + OFF_SGB) + (tok0 + r) * 512 + head * 64;
    u16* yb = (u16*)(ws + OFF_YB) + (tok0 + r) * 512 + head * 64;
#pragma unroll
    for (int vb = 0; vb < 2; ++vb)
#pragma unroll
      for (int g = 0; g < 4; ++g) {
        const int v0 = vb * 32 + 8 * g + 4 * h;
        const u2v gt = *(const u2v*)(sgb + v0);
        u2v ov;
        ov.x = pk2(o[vb][4 * g] * rs * bflo(gt.x), o[vb][4 * g + 1] * rs * bfhi(gt.x));
        ov.y = pk2(o[vb][4 * g + 2] * rs * bflo(gt.y), o[vb][4 * g + 3] * rs * bfhi(gt.y));
        *(u2v*)(yb + v0) = ov;
      }
  }
}

DI void phase5(const Params& p, unsigned char* smem) {
  unsigned char* ws = p.ws;
  pg8::StaticOrder S; S.init(T, 1024, (int)gridDim.x, (int)blockIdx.x);
  {
    pg8::Gemm g{(const u16*)(ws + OFF_YA), (const u16*)(ws + OFF_WA), T, 1024, 512};
    Epi5<false> E{(const u16*)p.out, (u16*)(ws + OFF_H), (u16*)(ws + OFF_M)};
    pg8::gemm_phase<Epi5<false>, pg8::StaticOrder, false>((PG8_LAS unsigned char*)smem, g, S, E, nullptr);
  }
  {
    pg8::Gemm g{(const u16*)(ws + OFF_YB), (const u16*)(ws + OFF_WB), T, 1024, 512};
    Epi5<true> E{(const u16*)p.out, (u16*)(ws + OFF_H), (u16*)(ws + OFF_M)};
    pg8::gemm_phase<Epi5<true>, pg8::StaticOrder, false>((PG8_LAS unsigned char*)smem, g, S, E, nullptr);
  }
}

DI void phase6(const Params& p, unsigned char* smem, bool dup = false) {
  unsigned char* ws = p.ws;
  pg8::Gemm g{(const u16*)(ws + OFF_M), (const u16*)(ws + OFF_WO), T, 1024, 1024};
  pg8::StaticOrder S; S.init(T, 1024, (int)gridDim.x, (int)blockIdx.x);
  Epi6 E{(u16*)(ws + OFF_H), (float*)(ws + OFF_SSQ) + 2 * T, dup};
  pg8::gemm_phase<Epi6, pg8::StaticOrder, false>((PG8_LAS unsigned char*)smem, g, S, E, nullptr);
}

DI void phase7(const Params& p) {
  const float* ssq_y = (const float*)(p.ws + OFF_SSQ) + 2 * T;
  const u2v* Y = (const u2v*)(p.ws + OFF_H);
  const int gtid = blockIdx.x * blockDim.x + threadIdx.x, gthreads = gridDim.x * blockDim.x;
  for (int i = gtid; i < T * 256; i += gthreads) {
    const int row = i >> 8, c4 = i & 255;
    const float rs = rsqrtf(ssq_y[row] * (1.f / 1024.f) + EPS);
    const u2v y = Y[i];
    const f4v xv = ((const f4v*)p.x)[i];
    const f4v g = ((const f4v*)p.g_post)[c4];
    f4v o;
    o.x = xv.x + bflo(y.x) * rs * g.x; o.y = xv.y + bfhi(y.x) * rs * g.y; o.z = xv.z + bflo(y.y) * rs * g.z; o.w = xv.w + bfhi(y.y) * rs * g.w;
    ((f4v*)p.out)[i] = o;
  }
}

__global__ void __launch_bounds__(512, 2) fwd_megakernel(Params p) {
  extern __shared__ __attribute__((aligned(16))) unsigned char smem[];
  u16* lds = (u16*)(smem + (threadIdx.x >> 8) * VLDS);
  cg::grid_group grid = cg::this_grid();
  volatile LAS unsigned* xst = (volatile LAS unsigned*)(smem + LDS_BYTES - 48);
  if (threadIdx.x == 0) { xst[0] = 0u; xst[1] = 0u; }
  __syncthreads();
  XcdBarrier xb = xcd_barrier_post((unsigned*)(p.ws + OFF_BAR), xst);
  if (p.ph_hi > 1000) grid.sync();
#define RUN_PHASE(N, CALL) if (p.ph_lo <= N && N < p.ph_hi) { if (N > p.ph_lo) xcd_barrier(xb); CALL; }
#define DUP_PHASE(N, CALL) if (DUP_PH == N) { xcd_barrier(xb); CALL; }
  RUN_PHASE(0, phase0(p))
  DUP_PHASE(0, phase0(p))
  if (p.ph_lo <= 1 && 1 < p.ph_hi) for (int rep = 0; rep < (DUP_PH == 1 ? 2 : 1); ++rep) { if (rep > 0 || 1 > p.ph_lo) xcd_barrier(xb); phase1(p, smem, rep > 0); }
  if (p.ph_lo <= 2 && 2 < p.ph_hi) for (int rep = 0; rep < (DUP_PH == 2 ? 2 : 1); ++rep) { if (rep > 0 || 2 > p.ph_lo) xcd_barrier(xb); phase2(p, smem, lds); }
  RUN_PHASE(4, phase3(p, smem))
  DUP_PHASE(4, phase3(p, smem, true))
  if (DUP_PH == 9) { xcd_barrier(xb); for (int i = blockIdx.x; i < 256; i += gridDim.x) scan_item(p, i, OFF_K); }
  RUN_PHASE(6, phase5(p, smem))
  DUP_PHASE(6, phase5(p, smem))
  RUN_PHASE(7, phase6(p, smem))
  DUP_PHASE(7, phase6(p, smem, true))
  RUN_PHASE(8, phase7(p))
  if (DUP_PH == 8) { xcd_barrier(xb); phase6(p, smem, true); xcd_barrier(xb); phase7(p); }
}

extern "C" void kernel_launch(void* const* d_in, const int* in_sizes, int n_in, void* d_out, int out_size, void* d_ws, size_t ws_size,
                              hipStream_t stream) {
  static int grid_blocks = 0;
  if (!grid_blocks) {
    int dev = 0, cus = 0, per_cu = 0;
    hipGetDevice(&dev);
    hipDeviceGetAttribute(&cus, hipDeviceAttributeMultiprocessorCount, dev);
    hipFuncSetAttribute((const void*)fwd_megakernel, hipFuncAttributeMaxDynamicSharedMemorySize, LDS_BYTES);
    hipOccupancyMaxActiveBlocksPerMultiprocessor(&per_cu, (const void*)fwd_megakernel, 512, LDS_BYTES);
    if (per_cu < 1) per_cu = 1;
    if (per_cu > 1) per_cu = 1;
    grid_blocks = cus * per_cu;
    if (ws_size < WS_NEED) fprintf(stderr, "kernel_launch: workspace too small: %zu < %zu\n", ws_size, (size_t)WS_NEED);
  }
  if (ws_size < WS_NEED) return;
  Params p{};
  p.x = (const float*)d_in[0]; p.g_pre = (const float*)d_in[1]; p.w_in = (const float*)d_in[2]; p.b_gate = (const float*)d_in[3];
  p.g_q = (const float*)d_in[4]; p.w_uq = (const float*)d_in[5]; p.g_kv = (const float*)d_in[6]; p.w_ukv = (const float*)d_in[7];
  p.lb_logits = (const float*)d_in[8]; p.g_hgrn = (const float*)d_in[9]; p.w_a = (const float*)d_in[10]; p.w_b = (const float*)d_in[11];
  p.w_out = (const float*)d_in[12]; p.g_post = (const float*)d_in[13];
  p.out = (float*)d_out; p.ws = (unsigned char*)d_ws;
#if ONE_LAUNCH
  p.ph_lo = 0; p.ph_hi = 9;
  (void)hipMemsetAsync((unsigned char*)d_ws + OFF_BAR, 0, 16384, stream);
  void* args[] = {&p};
  hipError_t e = hipLaunchCooperativeKernel((const void*)fwd_megakernel, dim3(grid_blocks), dim3(512), args, LDS_BYTES, stream);
  if (e != hipSuccess) fprintf(stderr, "cooperative launch failed: %s (grid %d)\n", hipGetErrorString(e), grid_blocks);
#else
  for (int ph = 0; ph < 9; ++ph) {
    p.ph_lo = ph; p.ph_hi = ph + 1;
    (void)hipMemsetAsync((unsigned char*)d_ws + OFF_BAR, 0, 16384, stream);
    void* args[] = {&p};
    hipError_t e = hipLaunchCooperativeKernel((const void*)fwd_megakernel, dim3(grid_blocks), dim3(512), args, LDS_BYTES, stream);
    if (e != hipSuccess) fprintf(stderr, "cooperative launch failed: %s (grid %d)\n", hipGetErrorString(e), grid_blocks);
  }
#endif
}
```

```cpp
#include <hip/hip_runtime.h>
#include <hip/hip_cooperative_groups.h>
#include <cstdio>
namespace cg = cooperative_groups;

#define DI __device__ __forceinline__
#define VTID ((int)(threadIdx.x & 255))
#define VBID ((int)(blockIdx.x * 2 + (threadIdx.x >> 8)))
#define VBN ((int)(gridDim.x * 2))
typedef unsigned short u16;
typedef unsigned int u32;
typedef __attribute__((ext_vector_type(8))) short bf16x8;
typedef __attribute__((ext_vector_type(4))) short s16x4;
typedef __attribute__((ext_vector_type(16))) float f32x16;
typedef __attribute__((ext_vector_type(2))) __bf16 bf2_t;
typedef __attribute__((ext_vector_type(2))) float f2_t;
typedef __attribute__((ext_vector_type(4))) unsigned int u4v;
typedef __attribute__((ext_vector_type(2))) unsigned int u2v;
typedef __attribute__((ext_vector_type(4))) float f4v;
typedef __attribute__((ext_vector_type(2))) float f2v;
#define MFMA(a, b, c) __builtin_amdgcn_mfma_f32_32x32x16_bf16((a), (b), (c), 0, 0, 0)

#ifndef DUP_PH
#define DUP_PH -1
#endif
#ifndef ONE_LAUNCH
#define ONE_LAUNCH 1
#endif

constexpr int T = 32768;
constexpr int SEQ = 4096;
constexpr int DIN = 5664;
constexpr int NP = 5888;
constexpr float EPS = 1e-6f;
constexpr float QSCALE = 1.4426950408889634f * 0.10206207261596575f;

constexpr size_t SZ_WIN = (size_t)NP * 1024 * 2;
constexpr size_t OFF_WIN = 0;
constexpr size_t OFF_WUQ = OFF_WIN + SZ_WIN;
constexpr size_t OFF_WUKV = OFF_WUQ + (size_t)768 * 768 * 2;
constexpr size_t OFF_WA = OFF_WUKV + (size_t)1024 * 256 * 2;
constexpr size_t OFF_WB = OFF_WA + (size_t)1024 * 512 * 2;
constexpr size_t OFF_WO = OFF_WB + (size_t)1024 * 512 * 2;
constexpr size_t OFF_ROPE = OFF_WO + (size_t)1024 * 1024 * 2;
constexpr size_t OFF_SSQ = OFF_ROPE + (size_t)4096 * 16 * 2 * 4;
constexpr size_t OFF_DECAY = OFF_SSQ + (size_t)(3 * T + 256) * 4;
constexpr size_t OFF_H = OFF_DECAY + (size_t)64 * 128 * 64 * 4;
constexpr size_t OFF_Q = OFF_H;
constexpr size_t OFF_CQ = OFF_H + (size_t)T * 1024 * 2;
constexpr size_t OFF_YA = OFF_CQ;
constexpr size_t OFF_CKV = OFF_CQ + (size_t)T * 768 * 2;
constexpr size_t OFF_KPE = OFF_CKV + (size_t)T * 256 * 2;
constexpr size_t OFF_SGA = OFF_KPE + (size_t)T * 32 * 4;
constexpr size_t OFF_SGB = OFF_SGA + (size_t)T * 512 * 2;
constexpr size_t OFF_HQ = OFF_SGB + (size_t)T * 512 * 2;
constexpr size_t OFF_UPD = OFF_HQ;
constexpr size_t OFF_HF = OFF_HQ + (size_t)T * 512 * 2;
constexpr size_t OFF_HI = OFF_HF + (size_t)T * 512 * 2;
constexpr size_t OFF_YB = OFF_HI;
constexpr size_t OFF_QDEC = OFF_HI + (size_t)T * 512 * 2;
constexpr size_t OFF_KINV = OFF_QDEC + (size_t)T * 512 * 2;
constexpr size_t OFF_VT = OFF_KINV + (size_t)T * 512 * 2;
constexpr size_t OFF_K = OFF_VT + (size_t)T * 512 * 2;
constexpr size_t OFF_M = OFF_K;
constexpr size_t OFF_VTT = OFF_K + (size_t)T * 768 * 2;
constexpr size_t OFF_BAR = OFF_VTT + (size_t)T * 512 * 2;
constexpr size_t WS_NEED = OFF_BAR + 16384;

constexpr int VLDS = 2 * 2 * 128 * 72 * 2;
constexpr int LDS_BYTES = 2 * VLDS + 64;
constexpr int SST = 132;

struct Params {
  const float *x, *g_pre, *w_in, *b_gate, *g_q, *w_uq, *g_kv, *w_ukv, *lb_logits, *g_hgrn, *w_a, *w_b, *w_out, *g_post;
  float* out;
  unsigned char* ws;
  int ph_lo, ph_hi;
};

DI u32 pk2(float a, float b) { f2_t v = {a, b}; bf2_t r = __builtin_convertvector(v, bf2_t); return __builtin_bit_cast(u32, r); }
DI float bflo(u32 u) { return __uint_as_float(u << 16); }
DI float bfhi(u32 u) { return __uint_as_float(u & 0xffff0000u); }
DI u4v pk8(f4v a, f4v b) { u4v r; r.x = pk2(a.x, a.y); r.y = pk2(a.z, a.w); r.z = pk2(b.x, b.y); r.w = pk2(b.z, b.w); return r; }
DI float rcpf(float x) { return __builtin_amdgcn_rcpf(x); }
DI float sigmoidf_(float x) { return rcpf(1.f + __expf(-x)); }
DI float siluf_(float x) { return x * sigmoidf_(x); }
DI float xor32_max(float x) { const unsigned u = __float_as_uint(x); auto r = __builtin_amdgcn_permlane32_swap(u, u, false, false); return fmaxf(__uint_as_float(r[0]), __uint_as_float(r[1])); }
DI float xor32_add(float x) { const unsigned u = __float_as_uint(x); auto r = __builtin_amdgcn_permlane32_swap(u, u, false, false); return __uint_as_float(r[0]) + __uint_as_float(r[1]); }
DI float xor16_add(float x) { const unsigned u = __float_as_uint(x); auto r = __builtin_amdgcn_permlane16_swap(u, u, false, false); return __uint_as_float(r[0]) + __uint_as_float(r[1]); }
DI int crow(int reg, int h) { return (reg & 3) + 8 * (reg >> 2) + 4 * h; }
DI f32x16 zero16() { f32x16 z;
#pragma unroll
  for (int i = 0; i < 16; ++i) z[i] = 0.f; return z; }

__constant__ float c_invfreq[16] = {1.0f, 0.5623413324356079f, 0.3162277638912201f, 0.17782793939113617f, 0.10000000149011612f,
  0.05623413249850273f, 0.03162277489900589f, 0.017782794311642647f, 0.009999999776482582f, 0.005623413249850273f,
  0.003162277629598975f, 0.0017782794311642647f, 0.0010000000474974513f, 0.000562341301701963f, 0.0003162277571391314f,
  0.00017782794020604342f};

DI void sincos_d(double a, float& sn, float& cs) {
  const double k = rint(a * 0.63661977236758134308);
  const double y = a - k * 1.57079632679489661923;
  const double y2 = y * y;
  const double s = y * (1.0 + y2 * (-1.0 / 6 + y2 * (1.0 / 120 + y2 * (-1.0 / 5040 + y2 * (1.0 / 362880 + y2 * (-1.0 / 39916800 + y2 * (1.0 / 6227020800.0)))))));
  const double c = 1.0 + y2 * (-0.5 + y2 * (1.0 / 24 + y2 * (-1.0 / 720 + y2 * (1.0 / 40320 + y2 * (-1.0 / 3628800 + y2 * (1.0 / 479001600.0 + y2 * (-1.0 / 87178291200.0)))))));
  const int q = ((int)k) & 3;
  const double ss = (q == 0) ? s : (q == 1) ? c : (q == 2) ? -s : -c;
  const double cc = (q == 0) ? c : (q == 1) ? -s : (q == 2) ? -c : s;
  sn = (float)ss; cs = (float)cc;
}

#define XB_TMO      128
#define XB_XCNT(j)  (256  + 64 * (j))
#define XB_XSUB(j)  (1280 + 64 * (j))
#define XB_XGEN(j)  (2304 + 64 * (j))
#define XB_TOP      3328
#define XB_TOPGEN   3392
#define XCD_BAR_WORDS 3456
#define XB_SPIN_CAP (1u << 22)
#define LAS __attribute__((address_space(3)))
DI unsigned xb_ld(unsigned* p)              { return __hip_atomic_load(p, __ATOMIC_RELAXED, __HIP_MEMORY_SCOPE_AGENT); }
DI unsigned xb_add(unsigned* p, unsigned v) { return __hip_atomic_fetch_add(p, v, __ATOMIC_RELAXED, __HIP_MEMORY_SCOPE_AGENT); }
DI unsigned xb_xcc_id() { return (unsigned)__builtin_amdgcn_s_getreg((3 << 11) | 20) & 0xFu; }
#define XB_SPIN(cond, bar) do { unsigned _sp = 0; while (cond) { __builtin_amdgcn_s_sleep(1); \
    if ((++_sp & 255u) == 0u) { if (xb_ld(&(bar)[XB_TMO])) break; if (_sp > XB_SPIN_CAP) { atomicAdd(&(bar)[XB_TMO], 1u); break; } } } } while (0)
struct XcdBarrier { unsigned* bar; unsigned x; volatile LAS unsigned* st; };
DI XcdBarrier xcd_barrier_post(unsigned* bar, volatile LAS unsigned* st) {
  XcdBarrier b; b.bar = bar; b.x = xb_xcc_id(); b.st = st;
  if (threadIdx.x == 0) (void)xb_add(&bar[XB_XCNT(b.x)], 1u);
  return b;
}
DI void xcd_barrier_complete(unsigned* bar, unsigned x, unsigned& nloc, unsigned& nx) {
  const unsigned G = gridDim.x * gridDim.y * gridDim.z;
  unsigned sum, cnt, mine, sp = 0u;
  for (;;) {
    sum = 0u; cnt = 0u; mine = 0u;
#pragma unroll
    for (unsigned j = 0; j < 16; ++j) { const unsigned c = xb_ld(&bar[XB_XCNT(j)]); sum += c; cnt += (c > 0u) ? 1u : 0u; mine = (j == x) ? c : mine; }
    if (sum == G) break;
    __builtin_amdgcn_s_sleep(1);
    if ((++sp & 255u) == 0u) { if (xb_ld(&bar[XB_TMO])) break; if (sp > XB_SPIN_CAP) { atomicAdd(&bar[XB_TMO], 1u); break; } }
  }
  nloc = mine > 0u ? mine : 1u; nx = cnt > 0u ? cnt : 1u;
}
DI void xcd_barrier(const XcdBarrier& b) {
  asm volatile("s_waitcnt vmcnt(0)" ::: "memory");
  __syncthreads();
  if (threadIdx.x == 0) {
    unsigned* bar = b.bar;
    __builtin_amdgcn_s_waitcnt(0);
    unsigned nloc = b.st[0], nx = b.st[1];
    if (nloc == 0u) { xcd_barrier_complete(bar, b.x, nloc, nx); b.st[0] = nloc; b.st[1] = nx; }
    const unsigned old = xb_add(&bar[XB_XSUB(b.x)], 1u);
    const unsigned gen = old / nloc;
    if (old + 1u == (gen + 1u) * nloc) {
      __builtin_amdgcn_fence(__ATOMIC_RELEASE, "agent");
      asm volatile("s_waitcnt vmcnt(0)" ::: "memory");
      const unsigned og = xb_add(&bar[XB_TOP], 1u);
      const unsigned tg = og / nx;
      if (og + 1u == (tg + 1u) * nx) xb_add(&bar[XB_TOPGEN], 1u);
      else XB_SPIN(xb_ld(&bar[XB_TOPGEN]) == tg, bar);
      __builtin_amdgcn_fence(__ATOMIC_ACQUIRE, "agent");
      xb_add(&bar[XB_XGEN(b.x)], 1u);
      asm volatile("s_waitcnt vmcnt(0)" ::: "memory");
    } else {
      XB_SPIN(xb_ld(&bar[XB_XGEN(b.x)]) == gen, bar);
      __builtin_amdgcn_fence(__ATOMIC_ACQUIRE, "agent");
      asm volatile("s_waitcnt vmcnt(0)" ::: "memory");
    }
  }
  __syncthreads();
}

template <int KIND>
DI int colmap(int n) {
  if (KIND == 0) {
    if (n < 1024) return n;
    if (n < 1536) return 1056 + (n - 1024);
    if (n < 2048) return 3104 + (n - 1536);
    if (n < 4096) return 3616 + (n - 2048);
    if (n < 4608) return 1568 + (n - 4096);
    if (n < 5120) return 2080 + (n - 4608);
    if (n < 5632) return 2592 + (n - 5120);
    if (n < 5664) return 1024 + (n - 5632);
    return -1;
  } else if (KIND == 1) {
    if (n < 512) return (n >> 6) * 96 + (n & 63);
    int i = n - 512; int w = i & 31, g = w >> 3, e = w & 7; return (i >> 5) * 96 + 64 + ((e < 4) ? (4 * g + e) : (16 + 4 * g + (e - 4)));
  } else if (KIND == 3) {
    if (n < 512) return (n >> 6) * 128 + (n & 63);
    int i = n - 512; return (i >> 6) * 128 + 64 + (i & 63);
  } else return n;
}
template <int KIND>
DI void conv_weight(u16* dst, const float* src, int ldw, int ncount, int K, const float* gain, int gmask, int gtid, int gthreads) {
  const int total = ncount * (K >> 3);
  for (int it = gtid; it < total; it += gthreads) {
    const int n = it % ncount, kc = it / ncount;
    const int sc = colmap<KIND>(n);
    float v[8];
#pragma unroll
    for (int i = 0; i < 8; ++i) {
      const int k = kc * 8 + i;
      float x = (sc >= 0) ? src[(size_t)k * ldw + sc] : 0.f;
      if (gain) x *= gain[k & gmask];
      v[i] = x;
    }
    u4v o; o.x = pk2(v[0], v[1]); o.y = pk2(v[2], v[3]); o.z = pk2(v[4], v[5]); o.w = pk2(v[6], v[7]);
    *(u4v*)(dst + (size_t)n * K + kc * 8) = o;
  }
}

DI void phase0(const Params& p) {
  unsigned char* ws = p.ws;
  const int gtid = blockIdx.x * blockDim.x + threadIdx.x, gthreads = gridDim.x * blockDim.x;
  float* ssq = (float*)(ws + OFF_SSQ);
  for (int i = gtid; i < 3 * T + 256; i += gthreads) ssq[i] = 0.f;
  float* rope = (float*)(ws + OFF_ROPE);
  for (int i = gtid; i < 4096 * 16; i += gthreads) {
    const int pos = i >> 4, j = i & 15;
    const float ang = (float)pos * c_invfreq[j];
    float sn, cs; sincos_d((double)ang, sn, cs);
    rope[i] = cs; rope[65536 + i] = sn;
  }
  conv_weight<0>((u16*)(ws + OFF_WIN), p.w_in, DIN, NP, 1024, nullptr, 0, gtid, gthreads);
  u16* H = (u16*)(ws + OFF_H);
  const int lane = threadIdx.x & 63;
  const int gw = gtid >> 6, nw = gthreads >> 6;
  for (int row = gw; row < T; row += nw) {
    const f4v* xr = (const f4v*)(p.x + (size_t)row * 1024);
    f4v v[4];
    float ss = 0.f;
#pragma unroll
    for (int i = 0; i < 4; ++i) { v[i] = xr[lane * 4 + i]; ss += v[i].x * v[i].x + v[i].y * v[i].y + v[i].z * v[i].z + v[i].w * v[i].w; }
#pragma unroll
    for (int o = 32; o >= 1; o >>= 1) ss += __shfl_xor(ss, o);
    const float rs = rsqrtf(ss * (1.f / 1024.f) + EPS);
    const f4v* gp = (const f4v*)(p.g_pre);
    f4v g[4];
#pragma unroll
    for (int i = 0; i < 4; ++i) { g[i] = gp[lane * 4 + i]; v[i].x *= rs * g[i].x; v[i].y *= rs * g[i].y; v[i].z *= rs * g[i].z; v[i].w *= rs * g[i].w; }
    u4v* hr = (u4v*)(H + (size_t)row * 1024 + lane * 16);
    hr[0] = pk8(v[0], v[1]); hr[1] = pk8(v[2], v[3]);
  }
}

constexpr int TS = 128 * 72;
DI void gemm_ld(u4v (&ra)[4], u4v (&rb)[4], const u16* ga, const u16* gb, int lda, int ldb, int ko) {
#pragma unroll
  for (int i = 0; i < 4; ++i) { ra[i] = *(const u4v*)(ga + (size_t)(32 * i) * lda + ko); rb[i] = *(const u4v*)(gb + (size_t)(32 * i) * ldb + ko); }
}
DI void gemm_st(const u4v (&ra)[4], const u4v (&rb)[4], u16* buf, int lr, int lc) {
  u16* sa = buf; u16* sb = buf + TS;
#pragma unroll
  for (int i = 0; i < 4; ++i) { *(u4v*)(sa + (lr + 32 * i) * 72 + lc * 8) = ra[i]; *(u4v*)(sb + (lr + 32 * i) * 72 + lc * 8) = rb[i]; }
}
DI void gemm_mma(const u16* buf, f32x16 (&acc)[2][2], int wm, int wn, int r, int h) {
  const u16* sa = buf + (wm * 64 + r) * 72 + h * 8;
  const u16* sb = buf + TS + (wn * 64 + r) * 72 + h * 8;
#pragma unroll
  for (int ks = 0; ks < 4; ++ks) {
    const bf16x8 a0 = *(const bf16x8*)(sa + ks * 16);
    const bf16x8 a1 = *(const bf16x8*)(sa + 32 * 72 + ks * 16);
    const bf16x8 b0 = *(const bf16x8*)(sb + ks * 16);
    const bf16x8 b1 = *(const bf16x8*)(sb + 32 * 72 + ks * 16);
    acc[0][0] = MFMA(a0, b0, acc[0][0]);
    acc[0][1] = MFMA(a0, b1, acc[0][1]);
    acc[1][0] = MFMA(a1, b0, acc[1][0]);
    acc[1][1] = MFMA(a1, b1, acc[1][1]);
  }
}
DI void gemm_core(const u16* __restrict__ A, int lda, const u16* __restrict__ B, int ldb, int K, u16* lds, f32x16 (&acc)[2][2], int tid) {
  const int lane = tid & 63, w = tid >> 6, wm = w >> 1, wn = w & 1, r = lane & 31, h = lane >> 5;
  const int lc = tid & 7, lr = tid >> 3;
  const u16* ga = A + (size_t)lr * lda + lc * 8;
  const u16* gb = B + (size_t)lr * ldb + lc * 8;
  u4v ra0[4], rb0[4], ra1[4], rb1[4];
  gemm_ld(ra0, rb0, ga, gb, lda, ldb, 0);
  gemm_ld(ra1, rb1, ga, gb, lda, ldb, 64);
#pragma unroll
  for (int i = 0; i < 2; ++i)
#pragma unroll
    for (int j = 0; j < 2; ++j) acc[i][j] = zero16();
  u16* L0 = lds; u16* L1 = lds + 2 * TS;
  __syncthreads();
  gemm_st(ra0, rb0, L0, lr, lc);
  __syncthreads();
  const int nk = K >> 6;
  int kt = 0;
  for (; kt + 2 < nk; kt += 2) {
    gemm_ld(ra0, rb0, ga, gb, lda, ldb, (kt + 2) * 64);
    __builtin_amdgcn_sched_barrier(0);
    gemm_mma(L0, acc, wm, wn, r, h);
    gemm_st(ra1, rb1, L1, lr, lc);
    __syncthreads();
    gemm_ld(ra1, rb1, ga, gb, lda, ldb, (kt + 3) * 64);
    __builtin_amdgcn_sched_barrier(0);
    gemm_mma(L1, acc, wm, wn, r, h);
    gemm_st(ra0, rb0, L0, lr, lc);
    __syncthreads();
  }
  gemm_mma(L0, acc, wm, wn, r, h);
  gemm_st(ra1, rb1, L1, lr, lc);
  __syncthreads();
  gemm_mma(L1, acc, wm, wn, r, h);
  __syncthreads();
}

DI void stage_pass(const f32x16 (&acc)[2][2], float* stage, int p, int tid) {
  const int lane = tid & 63, w = tid >> 6, wm = w >> 1, wn = w & 1, r = lane & 31, h = lane >> 5;
  __syncthreads();
  if (wm == p) {
#pragma unroll
    for (int i = 0; i < 2; ++i)
#pragma unroll
      for (int j = 0; j < 2; ++j)
#pragma unroll
        for (int reg = 0; reg < 16; ++reg) stage[(i * 32 + crow(reg, h)) * SST + wn * 64 + j * 32 + r] = acc[i][j][reg];
  }
  __syncthreads();
}

namespace pg8 {
#define PG8_LAS __attribute__((address_space(3)))
typedef unsigned short bf16_t;
typedef short bf16x8 __attribute__((ext_vector_type(8)));
typedef float f32x4 __attribute__((ext_vector_type(4)));
typedef unsigned u32x4 __attribute__((ext_vector_type(4)));
constexpr int BM = 256, BK = 64, HALF = 128, HTB = HALF * BK * 2  , STAGE_BYTES = 8 * HTB, NXCD = 8, WGM = 8;

__host__ __device__ __forceinline__ int lds_byte(int r, int c) { const int st = (r >> 4) * 2 + (c >> 5), rr = r & 15, cc = c & 31, ob = rr * 64 + cc * 2; return st * 1024 + (ob ^ (((ob >> 9) & 1) << 5)); }
__host__ __device__ __forceinline__ void stage_rc(int b, int& R, int& C) { const int st = b / 1024, sb = b % 1024, swz = sb ^ (((sb >> 9) & 1) << 5); R = (st >> 1) * 16 + swz / 64; C = (st & 1) * 32 + (swz % 64) / 2; }
__host__ __device__ __forceinline__ int perm32(int rho) { const int n = rho >> 4, i = rho & 15; return 8 * (i >> 2) + 4 * n + (i & 3); }

struct Unit { int pm, pn; };
struct Gemm { const bf16_t* A; const bf16_t* Bt; int M, N, K; };

struct StaticOrder {
    int nM, nN, nwg, G, c;
    __host__ __device__ void init(int M, int N, int G_, int c_) { nM = M / BM; nN = N / BM; nwg = nM * nN; G = G_; c = c_; }
    __host__ __device__ bool next(int i, Unit& u) const {
        const long L = (long)i * G + c; if (L >= nwg) return false;
        int wgid = (int)L; { const int q = nwg / NXCD, r = nwg % NXCD, xcd = wgid % NXCD, off = wgid / NXCD; wgid = (xcd < r ? xcd * (q + 1) : r * (q + 1) + (xcd - r) * q) + off; }
        const int nig = WGM * nN, gid = wgid / nig, fm = gid * WGM, gsz = (nM - fm) < WGM ? (nM - fm) : WGM;
        u.pm = fm + ((wgid % nig) % gsz); u.pn = (wgid % nig) / gsz; return true;
    }
    __device__ __forceinline__ void a_ready(const Unit&) const {}
    __device__ __forceinline__ void done(const Unit&) const {}
};
template <class Epi, class Sched, bool STAMP = false, bool SWAP = false>
__device__ __forceinline__ void gemm_phase(PG8_LAS unsigned char* lds, const Gemm g, const Sched& S, const Epi& E, unsigned long long* stamps) {
    const int tid = threadIdx.x, wid = __builtin_amdgcn_readfirstlane(tid >> 6), lane = tid & 63, wr = wid >> 2, wc = wid & 3, fr = lane & 15, fq = lane >> 4;
    const int K = g.K, nt = K / BK;
    int ts_lo = 0, ts_hi = 0, nts = 0; const unsigned long long rt_entry = STAMP ? (unsigned long long)wall_clock64() : 0ull;
#define PG8_STAMP() do { if (STAMP && wid == 0 && nts < 64) { const unsigned long long _c = (unsigned long long)clock64(); \
        ts_lo = (lane == nts) ? (int)(unsigned)_c : ts_lo; ts_hi = (lane == nts) ? (int)(unsigned)(_c >> 32) : ts_hi; ++nts; } } while (0)
    PG8_STAMP();
    unsigned voffA[2], voffB[2];
#pragma unroll
    for (int i = 0; i < 2; ++i) { int R, C; stage_rc(tid * 16 + i * 8192, R, C); const int Rb = Epi::PERM ? ((R & ~31) + perm32(R & 31)) : R;
        voffA[i] = (unsigned)(R * K + C) * 2u; voffB[i] = (unsigned)(Rb * K + C) * 2u; }
    const size_t kstep = (size_t)(BK * 2);
    const size_t hstep = (size_t)HALF * K * 2;
    const size_t tstep = 2 * hstep;
    const unsigned ldsw = (unsigned)wid * 1024u;
    const int aoff = lds_byte(wr * 64 + fr, fq * 8), boff = lds_byte(wc * 32 + fr, fq * 8);
#define PG8_SA(b, h) (((b) * 2 + (h)) * HTB)
#define PG8_SB(b, h) ((4 + (b) * 2 + (h)) * HTB)
#define PG8_STAGE(bufoff, gbase, voff) do { _Pragma("unroll") for (int _i = 0; _i < 2; ++_i) \
        __builtin_amdgcn_global_load_lds((const unsigned*)((const char*)(gbase) + (voff)[_i]), (PG8_LAS unsigned*)(lds + (bufoff) + ldsw + _i * 8192), 16, 0, 0); } while (0)
#define PG8_LDA(dst, b, h) do { _Pragma("unroll") for (int m = 0; m < 4; ++m) _Pragma("unroll") for (int k = 0; k < 2; ++k) dst[m][k] = *(const PG8_LAS bf16x8*)(lds + PG8_SA(b, h) + aoff + m * 2048 + k * 1024); } while (0)
#define PG8_LDB(dst, b, h) do { _Pragma("unroll") for (int n = 0; n < 2; ++n) _Pragma("unroll") for (int k = 0; k < 2; ++k) dst[n][k] = *(const PG8_LAS bf16x8*)(lds + PG8_SB(b, h) + boff + n * 2048 + k * 1024); } while (0)
#define PG8_MMA(ai, bj, At, Bt) do { __builtin_amdgcn_s_setprio(1); _Pragma("unroll") for (int m = 0; m < 4; ++m) _Pragma("unroll") for (int n = 0; n < 2; ++n) _Pragma("unroll") for (int k = 0; k < 2; ++k) \
        acc[ai][bj][m][n] = SWAP ? __builtin_amdgcn_mfma_f32_16x16x32_bf16(At[m][k], Bt[n][k], acc[ai][bj][m][n], 0, 0, 0) : __builtin_amdgcn_mfma_f32_16x16x32_bf16(Bt[n][k], At[m][k], acc[ai][bj][m][n], 0, 0, 0); __builtin_amdgcn_s_setprio(0); } while (0)
#define PG8_WAIT_V(n) asm volatile("s_waitcnt vmcnt(" #n ")" ::: "memory")
#define PG8_WAIT_L(n) asm volatile("s_waitcnt lgkmcnt(" #n ")" ::: "memory")
#define PG8_BAR __builtin_amdgcn_s_barrier()
#define PG8_SCHED __builtin_amdgcn_sched_barrier(0)
    Unit cur, nxt; int ui = 0;
    if (!S.next(0, cur)) return;
    f32x4 acc[2][2][4][2];
#pragma unroll
    for (int a = 0; a < 2; ++a)
#pragma unroll
        for (int b = 0; b < 2; ++b)
#pragma unroll
            for (int m = 0; m < 4; ++m)
#pragma unroll
                for (int n = 0; n < 2; ++n) acc[a][b][m][n] = (f32x4){0.f, 0.f, 0.f, 0.f};
    bf16x8 At[4][2], B0[2][2], B1[2][2];
    const char* cA = (const char*)g.A + (size_t)cur.pm * tstep; const char* cB = (const char*)g.Bt + (size_t)cur.pn * tstep;
    S.a_ready(cur);
    PG8_STAGE(PG8_SB(0, 0), cB, voffB); PG8_STAGE(PG8_SA(0, 0), cA, voffA); PG8_STAGE(PG8_SB(0, 1), cB + hstep, voffB); PG8_STAGE(PG8_SA(0, 1), cA + hstep, voffA);
    if (wr == 1) PG8_BAR;
    PG8_WAIT_V(4); PG8_BAR;
    PG8_STAGE(PG8_SB(1, 0), cB + kstep, voffB); PG8_STAGE(PG8_SA(1, 0), cA + kstep, voffA); PG8_STAGE(PG8_SB(1, 1), cB + hstep + kstep, voffB);
    PG8_WAIT_V(6); PG8_BAR;
    PG8_STAMP();
    for (;;) {
        const bool has_next = S.next(ui + 1, nxt);
        const char* nA = has_next ? (const char*)g.A + (size_t)nxt.pm * tstep : cA; const char* nB = has_next ? (const char*)g.Bt + (size_t)nxt.pn * tstep : cB;
        for (int t = 0; t < nt; t += 2) {
            const bool last = (t == nt - 2);
            const char* a1 = cA + (size_t)(t + 1) * kstep;
            const char* a2 = last ? nA : cA + (size_t)(t + 2) * kstep; const char* b2 = last ? nB : cB + (size_t)(t + 2) * kstep;
            const char* a3 = a2 + kstep; const char* b3 = b2 + kstep;
            if (last && has_next) S.a_ready(nxt);
            PG8_LDB(B0, 0, 0); PG8_SCHED; PG8_LDA(At, 0, 0); PG8_STAGE(PG8_SA(1, 1), a1 + hstep, voffA);
            PG8_WAIT_L(8); PG8_BAR; PG8_WAIT_L(0); PG8_MMA(0, 0, At, B0); PG8_BAR; PG8_SCHED;
            PG8_LDB(B1, 0, 1); PG8_STAGE(PG8_SB(0, 0), b2, voffB);
            PG8_BAR; PG8_WAIT_L(0); PG8_MMA(0, 1, At, B1); PG8_BAR;
            PG8_LDA(At, 0, 1); PG8_STAGE(PG8_SA(0, 0), a2, voffA);
            PG8_BAR; PG8_WAIT_L(0); PG8_MMA(1, 0, At, B0); PG8_BAR; PG8_SCHED;
            PG8_STAGE(PG8_SB(0, 1), b2 + hstep, voffB);
            PG8_WAIT_V(6); PG8_BAR; PG8_MMA(1, 1, At, B1); PG8_BAR;
            PG8_LDB(B0, 1, 0); PG8_SCHED; PG8_LDA(At, 1, 0); PG8_STAGE(PG8_SA(0, 1), a2 + hstep, voffA);
            PG8_WAIT_L(8); PG8_BAR; PG8_WAIT_L(0); PG8_MMA(0, 0, At, B0); PG8_BAR; PG8_SCHED;
            PG8_LDB(B1, 1, 1); PG8_STAGE(PG8_SB(1, 0), b3, voffB);
            PG8_BAR; PG8_WAIT_L(0); PG8_MMA(0, 1, At, B1); PG8_BAR;
            PG8_LDA(At, 1, 1); PG8_STAGE(PG8_SA(1, 0), a3, voffA);
            PG8_BAR; PG8_WAIT_L(0); PG8_MMA(1, 0, At, B0); PG8_BAR; PG8_SCHED;
            PG8_STAGE(PG8_SB(1, 1), b3 + hstep, voffB);
            PG8_WAIT_V(6); PG8_BAR; PG8_MMA(1, 1, At, B1); PG8_BAR;
        }
        PG8_STAMP();
        if constexpr (!Epi::AFTER_DRAIN) { E(acc, cur, wr, wc, fr, fq); S.done(cur); }
        PG8_STAMP();
        if (!has_next) break;
#pragma unroll
        for (int a = 0; a < 2; ++a)
#pragma unroll
            for (int b = 0; b < 2; ++b)
#pragma unroll
                for (int m = 0; m < 4; ++m)
#pragma unroll
                    for (int n = 0; n < 2; ++n) acc[a][b][m][n] = (f32x4){0.f, 0.f, 0.f, 0.f};
        cur = nxt; cA = nA; cB = nB; ++ui;
    }
    PG8_WAIT_V(0);
    if (wr == 0) PG8_BAR;
    PG8_BAR;
    if constexpr (Epi::AFTER_DRAIN) { E.fused(acc, cur, wr, wc, fr, fq, lds, wid, lane); S.done(cur); }
    PG8_STAMP();
    if (STAMP && wid == 0) { stamps[lane] = lane < nts ? (((unsigned long long)(unsigned)ts_hi << 32) | (unsigned)ts_lo) : 0ull;
        if (lane == 62) stamps[62] = rt_entry; if (lane == 63) stamps[63] = (unsigned long long)wall_clock64(); }
#undef PG8_STAMP
#undef PG8_SA
#undef PG8_SB
#undef PG8_STAGE
#undef PG8_LDA
#undef PG8_LDB
#undef PG8_MMA
#undef PG8_WAIT_V
#undef PG8_WAIT_L
#undef PG8_BAR
#undef PG8_SCHED
}
}

struct Epi1 {
  static constexpr bool PERM = true, AFTER_DRAIN = false;
  unsigned char* ws; u16* mg; const float* b_gate; bool dup;
  DI void operator()(const pg8::f32x4 (&acc)[2][2][4][2], const pg8::Unit& u, int wr, int wc, int fr, int fq) const {
    const int pn = u.pn;
    const int rowb = u.pm * 256 + wr * 64 + fr;
    const int colu = wc * 32 + 8 * fq;
    if (pn < 4) {
      u16* dst = (pn < 3) ? (u16*)(ws + OFF_CQ) + pn * 256 : (u16*)(ws + OFF_CKV);
      const int ld = (pn < 3) ? 768 : 256;
      float* ssq = (float*)(ws + OFF_SSQ) + ((pn < 3) ? 0 : T);
#pragma unroll
      for (int ai = 0; ai < 2; ++ai)
#pragma unroll
        for (int m = 0; m < 4; ++m) {
          const int row = rowb + ai * 128 + m * 16;
          float ss = 0.f;
#pragma unroll
          for (int bj = 0; bj < 2; ++bj) {
            const pg8::f32x4 v0 = acc[ai][bj][m][0], v1 = acc[ai][bj][m][1];
            ss += v0[0] * v0[0] + v0[1] * v0[1] + v0[2] * v0[2] + v0[3] * v0[3] + v1[0] * v1[0] + v1[1] * v1[1] + v1[2] * v1[2] + v1[3] * v1[3];
            u4v o; o.x = pk2(v0[0], v0[1]); o.y = pk2(v0[2], v0[3]); o.z = pk2(v1[0], v1[1]); o.w = pk2(v1[2], v1[3]);
            *(u4v*)(dst + (size_t)row * ld + bj * 128 + colu) = o;
          }
          ss = xor16_add(ss); ss = xor32_add(ss);
          if (fq == 0 && !dup) atomicAdd(ssq + row, ss);
        }
    } else if (pn < 8) {
      u16* dst = (u16*)(ws + ((pn < 6) ? OFF_SGA : OFF_SGB)) + (pn & 1) * 256;
#pragma unroll
      for (int ai = 0; ai < 2; ++ai)
#pragma unroll
        for (int m = 0; m < 4; ++m) {
          const int row = rowb + ai * 128 + m * 16;
#pragma unroll
          for (int bj = 0; bj < 2; ++bj) {
            const pg8::f32x4 v0 = acc[ai][bj][m][0], v1 = acc[ai][bj][m][1];
            u4v o; o.x = pk2(siluf_(v0[0]), siluf_(v0[1])); o.y = pk2(siluf_(v0[2]), siluf_(v0[3]));
            o.z = pk2(siluf_(v1[0]), siluf_(v1[1])); o.w = pk2(siluf_(v1[2]), siluf_(v1[3]));
            *(u4v*)(dst + (size_t)row * 512 + bj * 128 + colu) = o;
          }
        }
    } else if (pn >= 16) {
      if (pn < 22) {
        u16* dst = (u16*)(ws + ((pn < 18) ? OFF_HQ : (pn < 20) ? OFF_HF : OFF_HI)) + (pn & 1) * 256;
#pragma unroll
        for (int ai = 0; ai < 2; ++ai)
#pragma unroll
          for (int m = 0; m < 4; ++m) {
            const int row = rowb + ai * 128 + m * 16;
#pragma unroll
            for (int bj = 0; bj < 2; ++bj) {
              const pg8::f32x4 v0 = acc[ai][bj][m][0], v1 = acc[ai][bj][m][1];
              u4v o; o.x = pk2(v0[0], v0[1]); o.y = pk2(v0[2], v0[3]); o.z = pk2(v1[0], v1[1]); o.w = pk2(v1[2], v1[3]);
              *(u4v*)(dst + (size_t)row * 512 + bj * 128 + colu) = o;
            }
          }
      } else if (colu < 32) {
        float* dst = (float*)(ws + OFF_KPE);
#pragma unroll
        for (int ai = 0; ai < 2; ++ai)
#pragma unroll
          for (int m = 0; m < 4; ++m) {
            const int row = rowb + ai * 128 + m * 16;
            *(pg8::f32x4*)(dst + (size_t)row * 32 + colu) = acc[ai][0][m][0];
            *(pg8::f32x4*)(dst + (size_t)row * 32 + colu + 4) = acc[ai][0][m][1];
          }
      }
    } else {
      const int cb = (pn - 8) * 256 + colu;
      f4v b0[2], b1[2];
#pragma unroll
      for (int bj = 0; bj < 2; ++bj) { b0[bj] = *(const f4v*)(b_gate + cb + bj * 128); b1[bj] = *(const f4v*)(b_gate + cb + bj * 128 + 4); }
#pragma unroll
      for (int ai = 0; ai < 2; ++ai)
#pragma unroll
        for (int m = 0; m < 4; ++m) {
          const int row = rowb + ai * 128 + m * 16;
#pragma unroll
          for (int bj = 0; bj < 2; ++bj) {
            const pg8::f32x4 v0 = acc[ai][bj][m][0], v1 = acc[ai][bj][m][1];
            u4v o; o.x = pk2(sigmoidf_(v0[0] + b0[bj].x), sigmoidf_(v0[1] + b0[bj].y)); o.y = pk2(sigmoidf_(v0[2] + b0[bj].z), sigmoidf_(v0[3] + b0[bj].w));
            o.z = pk2(sigmoidf_(v1[0] + b1[bj].x), sigmoidf_(v1[1] + b1[bj].y)); o.w = pk2(sigmoidf_(v1[2] + b1[bj].z), sigmoidf_(v1[3] + b1[bj].w));
            *(u4v*)(mg + ((((size_t)(u.pm * 8 + (pn - 8)) * 8 + (wr * 4 + wc)) * 16 + (ai * 8 + m * 2 + bj)) * 64 + (fq * 16 + fr)) * 8) = o;
          }
        }
    }
  }
};


struct Epi6 {
  static constexpr bool PERM = true, AFTER_DRAIN = false;
  u16* out; float* ssq; bool dup;
  DI void operator()(const pg8::f32x4 (&acc)[2][2][4][2], const pg8::Unit& u, int wr, int wc, int fr, int fq) const {
    const int rowb = u.pm * 256 + wr * 64 + fr;
    const int colb = u.pn * 256 + wc * 32 + 8 * fq;
#pragma unroll
    for (int ai = 0; ai < 2; ++ai)
#pragma unroll
      for (int m = 0; m < 4; ++m) {
        const int row = rowb + ai * 128 + m * 16;
        float ss = 0.f;
#pragma unroll
        for (int bj = 0; bj < 2; ++bj) {
          const pg8::f32x4 v0 = acc[ai][bj][m][0], v1 = acc[ai][bj][m][1];
          ss += v0[0] * v0[0] + v0[1] * v0[1] + v0[2] * v0[2] + v0[3] * v0[3] + v1[0] * v1[0] + v1[1] * v1[1] + v1[2] * v1[2] + v1[3] * v1[3];
          u4v o; o.x = pk2(v0[0], v0[1]); o.y = pk2(v0[2], v0[3]); o.z = pk2(v1[0], v1[1]); o.w = pk2(v1[2], v1[3]);
          *(u4v*)(out + (size_t)row * 1024 + colb + bj * 128) = o;
        }
        ss = xor16_add(ss); ss = xor32_add(ss);
        if (fq == 0 && !dup) atomicAdd(ssq + row, ss);
      }
  }
};
template <bool SECOND> struct Epi5 {
  static constexpr bool PERM = true, AFTER_DRAIN = false;
  const u16* mg; u16* mi; u16* mo;
  DI void operator()(const pg8::f32x4 (&acc)[2][2][4][2], const pg8::Unit& u, int wr, int wc, int fr, int fq) const {
    const int rowb = u.pm * 256 + wr * 64 + fr;
    const int colb = u.pn * 256 + wc * 32 + 8 * fq;
    const size_t gbase = (((size_t)(u.pm * 8 + u.pn + (SECOND ? 4 : 0)) * 8 + (wr * 4 + wc)) * 16) * 64 + (fq * 16 + fr);
    const size_t ibase = (((size_t)(u.pm * 4 + u.pn) * 8 + (wr * 4 + wc)) * 16) * 64 + (fq * 16 + fr);
#pragma unroll
    for (int hb = 0; hb < 4; ++hb) {
      const int ai = hb >> 1, m0 = (hb & 1) * 2;
      u4v g[4], pm[4];
#pragma unroll
      for (int f4 = 0; f4 < 4; ++f4) {
        const int f = ai * 8 + (m0 + (f4 >> 1)) * 2 + (f4 & 1);
        g[f4] = *(const u4v*)(mg + (gbase + (size_t)f * 64) * 8);
        if (SECOND) pm[f4] = *(const u4v*)(mi + (ibase + (size_t)f * 64) * 8);
      }
#pragma unroll
      for (int f4 = 0; f4 < 4; ++f4) {
        const int m = m0 + (f4 >> 1), bj = f4 & 1;
        const int row = rowb + ai * 128 + m * 16;
        const pg8::f32x4 v0 = acc[ai][bj][m][0], v1 = acc[ai][bj][m][1];
        float r0 = v0[0] * bflo(g[f4].x), r1 = v0[1] * bfhi(g[f4].x), r2 = v0[2] * bflo(g[f4].y), r3 = v0[3] * bfhi(g[f4].y);
        float r4 = v1[0] * bflo(g[f4].z), r5 = v1[1] * bfhi(g[f4].z), r6 = v1[2] * bflo(g[f4].w), r7 = v1[3] * bfhi(g[f4].w);
        if (SECOND) {
          r0 += bflo(pm[f4].x); r1 += bfhi(pm[f4].x); r2 += bflo(pm[f4].y); r3 += bfhi(pm[f4].y);
          r4 += bflo(pm[f4].z); r5 += bfhi(pm[f4].z); r6 += bflo(pm[f4].w); r7 += bfhi(pm[f4].w);
        }
        u4v o; o.x = pk2(r0, r1); o.y = pk2(r2, r3); o.z = pk2(r4, r5); o.w = pk2(r6, r7);
        if (SECOND) *(u4v*)(mo + (size_t)row * 1024 + colb + bj * 128) = o;
        else *(u4v*)(mi + (ibase + (size_t)(ai * 8 + m * 2 + bj) * 64) * 8) = o;
      }
      __builtin_amdgcn_sched_barrier(0);
    }
  }
};
struct EpiQ {
  static constexpr bool PERM = true, AFTER_DRAIN = false;
  const float* ssq_q; const float* rope; u16* Qo;
  DI void operator()(const pg8::f32x4 (&acc)[2][2][4][2], const pg8::Unit& u, int wr, int wc, int fr, int fq) const {
    const int rowb = u.pm * 256 + wr * 64 + fr;
    const int colu = wc * 32 + 8 * fq;
    float sq[8];
#pragma unroll
    for (int i = 0; i < 8; ++i) sq[i] = ssq_q[rowb + (i >> 2) * 128 + (i & 3) * 16];
    if (u.pn < 2) {
#pragma unroll
      for (int ai = 0; ai < 2; ++ai)
#pragma unroll
        for (int m = 0; m < 4; ++m) {
          const int row = rowb + ai * 128 + m * 16;
          const int b = row >> 12, spos = row & 4095;
          const float sc = rsqrtf(sq[ai * 4 + m] * (1.f / 768.f) + EPS) * QSCALE;
#pragma unroll
          for (int bj = 0; bj < 2; ++bj) {
            const pg8::f32x4 v0 = acc[ai][bj][m][0], v1 = acc[ai][bj][m][1];
            const int head = u.pn * 4 + bj * 2 + (colu >> 6), d = colu & 63;
            u4v o; o.x = pk2(v0[0] * sc, v0[1] * sc); o.y = pk2(v0[2] * sc, v0[3] * sc); o.z = pk2(v1[0] * sc, v1[1] * sc); o.w = pk2(v1[2] * sc, v1[3] * sc);
            *(u4v*)(Qo + ((size_t)(b * 8 + head) * 4096 + spos) * 96 + d) = o;
          }
        }
    } else {
#pragma unroll
      for (int ai = 0; ai < 2; ++ai) {
        f4v cs[4], sn[4];
#pragma unroll
        for (int i = 0; i < 4; ++i) {
          const int spos = (rowb + ai * 128 + i * 16) & 4095;
          cs[i] = *(const f4v*)(rope + spos * 16 + 4 * fq); sn[i] = *(const f4v*)(rope + 65536 + spos * 16 + 4 * fq);
        }
#pragma unroll
        for (int m = 0; m < 4; ++m) {
          const int row = rowb + ai * 128 + m * 16;
          const int b = row >> 12, spos = row & 4095;
          const float sc = rsqrtf(sq[ai * 4 + m] * (1.f / 768.f) + EPS) * QSCALE;
          const f4v c4 = cs[m], s4 = sn[m];
#pragma unroll
          for (int bj = 0; bj < 2; ++bj) {
            const pg8::f32x4 v0 = acc[ai][bj][m][0], v1 = acc[ai][bj][m][1];
            const int head = bj * 4 + wc;
            u2v o1, o2;
            o1.x = pk2((v0[0] * c4.x - v1[0] * s4.x) * sc, (v0[1] * c4.y - v1[1] * s4.y) * sc);
            o1.y = pk2((v0[2] * c4.z - v1[2] * s4.z) * sc, (v0[3] * c4.w - v1[3] * s4.w) * sc);
            o2.x = pk2((v0[0] * s4.x + v1[0] * c4.x) * sc, (v0[1] * s4.y + v1[1] * c4.y) * sc);
            o2.y = pk2((v0[2] * s4.z + v1[2] * c4.z) * sc, (v0[3] * s4.w + v1[3] * c4.w) * sc);
            u16* qp = Qo + ((size_t)(b * 8 + head) * 4096 + spos) * 96 + 64 + 4 * fq;
            *(u2v*)qp = o1; *(u2v*)(qp + 16) = o2;
          }
        }
        __builtin_amdgcn_sched_barrier(0);
      }
    }
  }
};

struct EpiK {
  static constexpr bool PERM = true, AFTER_DRAIN = false;
  const float* ssq_kv; u16* Ko;
  DI void operator()(const pg8::f32x4 (&acc)[2][2][4][2], const pg8::Unit& u, int wr, int wc, int fr, int fq) const {
    const int rowb = u.pm * 256 + wr * 64 + fr;
    float sq[8];
#pragma unroll
    for (int i = 0; i < 8; ++i) sq[i] = ssq_kv[rowb + (i >> 2) * 128 + (i & 3) * 16];
#pragma unroll
    for (int ai = 0; ai < 2; ++ai)
#pragma unroll
      for (int m = 0; m < 4; ++m) {
        const int row = rowb + ai * 128 + m * 16;
        const int b = row >> 12, spos = row & 4095;
        const float sc = rsqrtf(sq[ai * 4 + m] * (1.f / 256.f) + EPS);
#pragma unroll
        for (int bj = 0; bj < 2; ++bj) {
          const pg8::f32x4 v0 = acc[ai][bj][m][0], v1 = acc[ai][bj][m][1];
          const int col = u.pn * 256 + bj * 128 + wc * 32 + 8 * fq;
          const int head = col >> 6, d = col & 63;
          u4v o; o.x = pk2(v0[0] * sc, v0[1] * sc); o.y = pk2(v0[2] * sc, v0[3] * sc); o.z = pk2(v1[0] * sc, v1[1] * sc); o.w = pk2(v1[2] * sc, v1[3] * sc);
          *(u4v*)(Ko + ((size_t)(b * 8 + head) * 4096 + spos) * 96 + d) = o;
        }
      }
  }
};
struct EpiV {
  static constexpr bool PERM = false, AFTER_DRAIN = false;
  const float* ssq_kv; u16* Vo;
  DI void operator()(const pg8::f32x4 (&acc)[2][2][4][2], const pg8::Unit& u, int wr, int wc, int fr, int fq) const {
    f4v sq[8];
#pragma unroll
    for (int i = 0; i < 8; ++i) sq[i] = *(const f4v*)(ssq_kv + u.pm * 256 + (i >> 2) * 128 + wr * 64 + (i & 3) * 16 + 4 * fq);
#pragma unroll
    for (int ai = 0; ai < 2; ++ai)
#pragma unroll
      for (int m = 0; m < 4; ++m) {
        const int row4 = u.pm * 256 + ai * 128 + wr * 64 + m * 16 + 4 * fq;
        const int b = row4 >> 12, spos = row4 & 4095;
        const f4v q = sq[ai * 4 + m];
        const float s0 = rsqrtf(q.x * (1.f / 256.f) + EPS), s1 = rsqrtf(q.y * (1.f / 256.f) + EPS), s2 = rsqrtf(q.z * (1.f / 256.f) + EPS), s3 = rsqrtf(q.w * (1.f / 256.f) + EPS);
#pragma unroll
        for (int bj = 0; bj < 2; ++bj)
#pragma unroll
          for (int n = 0; n < 2; ++n) {
            const pg8::f32x4 v = acc[ai][bj][m][n];
            const int col = u.pn * 256 + bj * 128 + wc * 32 + n * 16 + fr;
            const int head = col >> 6, dv = col & 63;
            u2v o; o.x = pk2(v[0] * s0, v[1] * s1); o.y = pk2(v[2] * s2, v[3] * s3);
            *(u2v*)(Vo + ((size_t)(b * 8 + head) * 64 + dv) * 4096 + spos) = o;
          }
        __builtin_amdgcn_sched_barrier(0);
      }
  }
};
DI void phase1(const Params& p, unsigned char* smem, bool dup = false) {
  unsigned char* ws = p.ws;
  pg8::Gemm g{(const u16*)(ws + OFF_H), (const u16*)(ws + OFF_WIN), T, NP, 1024};
  pg8::StaticOrder S; S.init(T, NP, (int)gridDim.x, (int)blockIdx.x);
  Epi1 E{ws, (u16*)p.out, p.b_gate, dup};
  pg8::gemm_phase<Epi1, pg8::StaticOrder, false>((PG8_LAS unsigned char*)smem, g, S, E, nullptr);
  const int nlight = (int)gridDim.x / 2;
  if (!dup && (int)blockIdx.x >= (int)gridDim.x - nlight) {
    const int gtid = ((int)blockIdx.x - ((int)gridDim.x - nlight)) * (int)blockDim.x + (int)threadIdx.x, gthreads = nlight * (int)blockDim.x;
    conv_weight<1>((u16*)(ws + OFF_WUQ), p.w_uq, 768, 768, 768, p.g_q, 1023, gtid, gthreads);
    conv_weight<3>((u16*)(ws + OFF_WUKV), p.w_ukv, 1024, 1024, 256, p.g_kv, 255, gtid, gthreads);
    conv_weight<2>((u16*)(ws + OFF_WA), p.w_a, 1024, 1024, 512, nullptr, 0, gtid, gthreads);
    conv_weight<2>((u16*)(ws + OFF_WB), p.w_b, 1024, 1024, 512, p.g_hgrn, 63, gtid, gthreads);
    conv_weight<2>((u16*)(ws + OFF_WO), p.w_out, 1024, 1024, 1024, nullptr, 0, gtid, gthreads);
  }
}

DI void hgrn_prep_tile(const Params& p, float* stage, int tid, int b, int hh, int prow0, int nblk0) {
  unsigned char* ws = p.ws;
  const int bh = b * 8 + hh;
  if (tid < 128) {
    const int c = tid & 63, blk = tid >> 6;
    const float l0 = p.lb_logits[hh * 64 + c], l1 = p.lb_logits[512 + hh * 64 + c];
    const float lbv = 1.f / (1.f + expf(l1 - l0));
    float cum = 0.f;
    for (int rr = 0; rr < 32; ++rr) {
      float* sp = stage + (blk * 32 + rr) * SST + c;
      const float q = sp[0], hf = sp[64];
      const float sg = 1.f / (1.f + expf(-hf));
      const float f = lbv + (1.f - lbv) * sg;
      cum += logf(f);
      const float e = expf(cum);
      sp[0] = q * e;
      sp[64] = (1.f - f) / e;
    }
    ((float*)(ws + OFF_DECAY))[((size_t)bh * 128 + nblk0 + blk) * 64 + c] = expf(cum);
  }
  __syncthreads();
#pragma unroll
  for (int it = 0; it < 2; ++it) {
    const int item = tid + 256 * it, rr = item >> 3, cc = (item & 7) * 8;
    const f4v a = *(const f4v*)(stage + rr * SST + cc), c = *(const f4v*)(stage + rr * SST + cc + 4);
    const f4v d = *(const f4v*)(stage + rr * SST + 64 + cc), e = *(const f4v*)(stage + rr * SST + 64 + cc + 4);
    const size_t o = (size_t)(prow0 + rr) * 512 + hh * 64 + cc;
    *(u4v*)((u16*)(ws + OFF_QDEC) + o) = pk8(a, c);
    *(u4v*)((u16*)(ws + OFF_KINV) + o) = pk8(d, e);
  }
}
DI void hi_vt_tile(const Params& p, float* stage, int tid, int b, int q2, int nblk0) {
  unsigned char* ws = p.ws;
#pragma unroll
        for (int it = 0; it < 4; ++it) {
          const int item = tid + 256 * it, sc = item & 3, col = (item >> 2) & 127, blk = item >> 9;
          float v[8];
#pragma unroll
          for (int i = 0; i < 8; ++i) v[i] = stage[(blk * 32 + sc * 8 + i) * SST + col];
          u4v o; o.x = pk2(v[0], v[1]); o.y = pk2(v[2], v[3]); o.z = pk2(v[4], v[5]); o.w = pk2(v[6], v[7]);
          const int bh = b * 8 + q2 * 2 + (col >> 6);
          *(u4v*)((u16*)(ws + OFF_VT) + (((size_t)bh * 128 + nblk0 + blk) * 64 + (col & 63)) * 32 + sc * 8) = o;
        }
}
DI void stage_load64(float* stage, const u16* src, int coff, int tid) {
#pragma unroll
  for (int it = 0; it < 2; ++it) {
    const int item = tid + 256 * it, rr = item >> 3, ch = item & 7;
    const u4v v = *(const u4v*)(src + (size_t)rr * 512 + ch * 8);
    float* d = stage + rr * SST + coff + ch * 8;
    *(f4v*)d = f4v{bflo(v.x), bfhi(v.x), bflo(v.y), bfhi(v.y)};
    *(f4v*)(d + 4) = f4v{bflo(v.z), bfhi(v.z), bflo(v.w), bfhi(v.w)};
  }
}


constexpr int PST = 68;
DI void hgrn_prep_native(const Params& p, float* pl, int rb, int hh) {
  unsigned char* ws = p.ws;
  const int tid = threadIdx.x;
  float* Qp = pl; float* G = pl + 128 * PST; float* Kn = pl + 2 * 128 * PST;
  const int prow0 = rb * 128, b = prow0 >> 12, bh = b * 8 + hh, nblk0 = (prow0 & 4095) >> 5;
  const int ch = tid & 7;
  float lbv[8];
  {
    const f4v a0 = *(const f4v*)(p.lb_logits + hh * 64 + ch * 8), a1 = *(const f4v*)(p.lb_logits + hh * 64 + ch * 8 + 4);
    const f4v b0 = *(const f4v*)(p.lb_logits + 512 + hh * 64 + ch * 8), b1 = *(const f4v*)(p.lb_logits + 512 + hh * 64 + ch * 8 + 4);
    const float l0[8] = {a0.x, a0.y, a0.z, a0.w, a1.x, a1.y, a1.z, a1.w}, l1[8] = {b0.x, b0.y, b0.z, b0.w, b1.x, b1.y, b1.z, b1.w};
#pragma unroll
    for (int i = 0; i < 8; ++i) lbv[i] = 1.f / (1.f + expf(l1[i] - l0[i]));
  }
  __syncthreads();
#pragma unroll
  for (int it = 0; it < 2; ++it) {
    const int rr = (tid + 512 * it) >> 3;
    const size_t go = (size_t)(prow0 + rr) * 512 + hh * 64 + ch * 8;
    const u4v qv = *(const u4v*)((const u16*)(ws + OFF_HQ) + go), fv = *(const u4v*)((const u16*)(ws + OFF_HF) + go);
    const float q[8] = {bflo(qv.x), bfhi(qv.x), bflo(qv.y), bfhi(qv.y), bflo(qv.z), bfhi(qv.z), bflo(qv.w), bfhi(qv.w)};
    const float hf[8] = {bflo(fv.x), bfhi(fv.x), bflo(fv.y), bfhi(fv.y), bflo(fv.z), bfhi(fv.z), bflo(fv.w), bfhi(fv.w)};
    float g[8], kn[8];
#pragma unroll
    for (int i = 0; i < 8; ++i) {
      const float sg = rcpf(1.f + __builtin_amdgcn_exp2f(-1.4426950408889634f * hf[i]));
      const float f = lbv[i] + (1.f - lbv[i]) * sg;
      g[i] = __builtin_amdgcn_logf(f);
      kn[i] = 1.f - f;
    }
    float* d = Qp + rr * PST + ch * 8;
    *(f4v*)d = f4v{q[0], q[1], q[2], q[3]}; *(f4v*)(d + 4) = f4v{q[4], q[5], q[6], q[7]};
    d = G + rr * PST + ch * 8;
    *(f4v*)d = f4v{g[0], g[1], g[2], g[3]}; *(f4v*)(d + 4) = f4v{g[4], g[5], g[6], g[7]};
    d = Kn + rr * PST + ch * 8;
    *(f4v*)d = f4v{kn[0], kn[1], kn[2], kn[3]}; *(f4v*)(d + 4) = f4v{kn[4], kn[5], kn[6], kn[7]};
  }
  __syncthreads();
  if (tid < 256) {
    const int c = tid & 63, blk = tid >> 6;
    float* gp = G + (blk * 32) * PST + c;
    float v[32];
#pragma unroll
    for (int r2 = 0; r2 < 32; ++r2) v[r2] = gp[r2 * PST];
    float cum = 0.f;
#pragma unroll
    for (int r2 = 0; r2 < 32; ++r2) { cum += v[r2]; gp[r2 * PST] = cum; }
    ((float*)(ws + OFF_DECAY))[((size_t)bh * 128 + nblk0 + blk) * 64 + c] = __builtin_amdgcn_exp2f(cum);
  }
  __syncthreads();
#pragma unroll
  for (int it = 0; it < 2; ++it) {
    const int rr = (tid + 512 * it) >> 3;
    const float* s0 = Qp + rr * PST + ch * 8; const float* s1 = G + rr * PST + ch * 8; const float* s2 = Kn + rr * PST + ch * 8;
    const f4v q0 = *(const f4v*)s0, q1 = *(const f4v*)(s0 + 4), c0 = *(const f4v*)s1, c1 = *(const f4v*)(s1 + 4), k0 = *(const f4v*)s2, k1 = *(const f4v*)(s2 + 4);
    const float q[8] = {q0.x, q0.y, q0.z, q0.w, q1.x, q1.y, q1.z, q1.w}, cm[8] = {c0.x, c0.y, c0.z, c0.w, c1.x, c1.y, c1.z, c1.w}, kn[8] = {k0.x, k0.y, k0.z, k0.w, k1.x, k1.y, k1.z, k1.w};
    float qd[8], ki[8];
#pragma unroll
    for (int i = 0; i < 8; ++i) { qd[i] = q[i] * __builtin_amdgcn_exp2f(cm[i]); ki[i] = kn[i] * __builtin_amdgcn_exp2f(-cm[i]); }
    const size_t go = (size_t)(prow0 + rr) * 512 + hh * 64 + ch * 8;
    u4v o; o.x = pk2(qd[0], qd[1]); o.y = pk2(qd[2], qd[3]); o.z = pk2(qd[4], qd[5]); o.w = pk2(qd[6], qd[7]);
    *(u4v*)((u16*)(ws + OFF_QDEC) + go) = o;
    o.x = pk2(ki[0], ki[1]); o.y = pk2(ki[2], ki[3]); o.z = pk2(ki[4], ki[5]); o.w = pk2(ki[6], ki[7]);
    *(u4v*)((u16*)(ws + OFF_KINV) + go) = o;
  }
}
constexpr int VTS = 136;
DI void hi_vt_native(const Params& p, u16* img, int rb, int q2) {
  unsigned char* ws = p.ws;
  const int tid = threadIdx.x;
  const int prow0 = rb * 128, b = prow0 >> 12, nblk0 = (prow0 & 4095) >> 5;
  __syncthreads();
#pragma unroll
  for (int it = 0; it < 4; ++it) {
    const int item = tid + 512 * it, rr = item >> 4, c16 = item & 15;
    *(u4v*)(img + rr * VTS + c16 * 8) = *(const u4v*)((const u16*)(ws + OFF_HI) + (size_t)(prow0 + rr) * 512 + q2 * 128 + c16 * 8);
  }
  __syncthreads();
#pragma unroll
  for (int it = 0; it < 4; ++it) {
    const int item = tid + 512 * it, sc = item & 3, col = (item >> 2) & 127, blk = item >> 9;
    u32 w[4];
#pragma unroll
    for (int i = 0; i < 4; ++i) {
      const u32 lo = img[(blk * 32 + sc * 8 + 2 * i) * VTS + col], hi = img[(blk * 32 + sc * 8 + 2 * i + 1) * VTS + col];
      w[i] = lo | (hi << 16);
    }
    const int bh = b * 8 + q2 * 2 + (col >> 6);
    *(u4v*)((u16*)(ws + OFF_VT) + (((size_t)bh * 128 + nblk0 + blk) * 64 + (col & 63)) * 32 + sc * 8) = u4v{w[0], w[1], w[2], w[3]};
  }
}

DI void rope8(const float* x1, const float* x2, const float* rope, int spos, int j0, bool first, float scale, float (&o)[8]) {
  const f4v c0 = *(const f4v*)(rope + spos * 16 + j0), c1 = *(const f4v*)(rope + spos * 16 + j0 + 4);
  const f4v s0 = *(const f4v*)(rope + 65536 + spos * 16 + j0), s1 = *(const f4v*)(rope + 65536 + spos * 16 + j0 + 4);
  const float cs[8] = {c0.x, c0.y, c0.z, c0.w, c1.x, c1.y, c1.z, c1.w};
  const float sn[8] = {s0.x, s0.y, s0.z, s0.w, s1.x, s1.y, s1.z, s1.w};
#pragma unroll
  for (int i = 0; i < 8; ++i) o[i] = scale * (first ? (x1[i] * cs[i] - x2[i] * sn[i]) : (x1[i] * sn[i] + x2[i] * cs[i]));
}

DI void phase2(const Params& p, unsigned char* smem, u16* lds) {
  unsigned char* ws = p.ws;
  const int tid = VTID;
  float* stage = (float*)lds;
  const float* ssq_q = (const float*)(ws + OFF_SSQ);
  const float* ssq_kv = ssq_q + T;
  const float* rope = (const float*)(ws + OFF_ROPE);
  u16* Qo = (u16*)(ws + OFF_Q);
  u16* Ko = (u16*)(ws + OFF_K);
  u16* Vo = (u16*)(ws + OFF_VTT);
#pragma nounroll
  for (int rep = 0; rep < (DUP_PH == 21 ? p.ph_hi - 7 : 1); ++rep) {
    pg8::Gemm g{(const u16*)(ws + OFF_CQ), (const u16*)(ws + OFF_WUQ), T, 768, 768};
    pg8::StaticOrder S; S.init(T, 768, (int)gridDim.x, (int)blockIdx.x);
    EpiQ E{ssq_q, rope, Qo};
    pg8::gemm_phase<EpiQ, pg8::StaticOrder, false>((PG8_LAS unsigned char*)smem, g, S, E, nullptr);
  }
#pragma nounroll
  for (int rep = 0; rep < (DUP_PH == 23 ? p.ph_hi - 7 : 1); ++rep) {
    pg8::StaticOrder S; S.init(T, 512, (int)gridDim.x, (int)blockIdx.x);
    {
      int kk = 256; asm volatile("" : "+s"(kk));
      pg8::Gemm g{(const u16*)(ws + OFF_CKV), (const u16*)(ws + OFF_WUKV), T, 512, kk};
      EpiK E{ssq_kv, Ko};
      pg8::gemm_phase<EpiK, pg8::StaticOrder, false>((PG8_LAS unsigned char*)smem, g, S, E, nullptr);
    }
  }
  {
    pg8::StaticOrder S; S.init(T, 512, (int)gridDim.x, (int)blockIdx.x);
    int kk = 256; asm volatile("" : "+s"(kk));
    pg8::Gemm g{(const u16*)(ws + OFF_CKV), (const u16*)(ws + OFF_WUKV) + (size_t)512 * 256, T, 512, kk};
    EpiV E{(const float*)(ws + OFF_SSQ) + T, (u16*)(ws + OFF_VTT)};
    pg8::gemm_phase<EpiV, pg8::StaticOrder, false, true>((PG8_LAS unsigned char*)smem, g, S, E, nullptr);
  }
#pragma nounroll
  for (int rep = 0; rep < (DUP_PH == 22 ? p.ph_hi - 7 : 1); ++rep) {
    const int gtid = blockIdx.x * blockDim.x + threadIdx.x, gthreads = gridDim.x * blockDim.x;
    for (int idx = gtid; idx < T * 4; idx += gthreads) {
      const int tok = idx >> 2, wv = (idx & 3) * 8, j0 = wv & 15;
      const int b = tok >> 12, spos = tok & 4095;
      const float* kp = (const float*)(ws + OFF_KPE) + (size_t)tok * 32;
      const f4v a0 = *(const f4v*)(kp + j0), a1 = *(const f4v*)(kp + j0 + 4);
      const f4v b0 = *(const f4v*)(kp + 16 + j0), b1 = *(const f4v*)(kp + 16 + j0 + 4);
      const float x1[8] = {a0.x, a0.y, a0.z, a0.w, a1.x, a1.y, a1.z, a1.w};
      const float x2[8] = {b0.x, b0.y, b0.z, b0.w, b1.x, b1.y, b1.z, b1.w};
      float o[8];
      rope8(x1, x2, rope, spos, j0, wv < 16, 1.f, o);
      u4v ov; ov.x = pk2(o[0], o[1]); ov.y = pk2(o[2], o[3]); ov.z = pk2(o[4], o[5]); ov.w = pk2(o[6], o[7]);
#pragma unroll
      for (int head = 0; head < 8; ++head) *(u4v*)(Ko + ((size_t)(b * 8 + head) * 4096 + spos) * 96 + 64 + wv) = ov;
    }
  }
  for (int rep = 0; rep < (DUP_PH == 20 ? 2 : 1); ++rep)
  {
    const int G = (int)gridDim.x, c = (int)blockIdx.x, hG = G / 2, round = 2 * G + hG;
    for (int base = 0; base < 2048 + 1024; base += round) {
#pragma unroll 1
      for (int k = 0; k < 3; ++k) {
        if (k == 2 && c < G - hG) break;
        const int t = base + (k == 0 ? c : k == 1 ? G + c : 2 * G + (c - (G - hG)));
        if (t >= 2048 + 1024) break;
        if (t < 2048) hgrn_prep_native(p, (float*)smem, t >> 3, t & 7);
        else hi_vt_native(p, (u16*)smem, (t - 2048) >> 2, (t - 2048) & 3);
      }
    }
  }
}

DI void phase2b(const Params& p, unsigned char* smem) {
  unsigned char* ws = p.ws;
  const int tid = VTID;
}

constexpr int KST2 = 104, VST2 = 132;
constexpr int ATT_BUF2 = 128 * KST2 + 64 * VST2;
DI void att_qk(const u16* sk, const bf16x8 (&qf)[6], float nm, f32x16 (&st)[2]) {
#pragma unroll
  for (int i = 0; i < 16; ++i) { st[0][i] = nm; st[1][i] = nm; }
#pragma unroll
  for (int kb = 0; kb < 2; ++kb)
#pragma unroll
    for (int ks = 0; ks < 6; ++ks) {
      const bf16x8 kf = *(const bf16x8*)(sk + kb * 32 * KST2 + ks * 16);
      st[kb] = MFMA(kf, qf[ks], st[kb]);
    }
}
DI float att_softmax(f32x16 (&st)[2], float adj, bool adjnz, bool first, float& mref, float& l, f32x16 (&o)[2]) {
  float mx = st[0][0];
#pragma unroll
  for (int i = 1; i < 16; ++i) mx = fmaxf(mx, st[0][i]);
#pragma unroll
  for (int i = 0; i < 16; ++i) mx = fmaxf(mx, st[1][i]);
  mx = xor32_max(mx) - adj;
  f2v ps = f2v{0.f, 0.f};
  float shift_out = 0.f;
  if (first || adjnz || __builtin_amdgcn_ballot_w64(mx > 8.f) != 0ull) {
    const float shift = first ? mx : fmaxf(mx, 0.f);
    const float tot = adj + shift;
    const float alpha = first ? 0.f : __builtin_amdgcn_exp2f(-shift);
    mref += shift;
#pragma unroll
    for (int kb = 0; kb < 2; ++kb)
#pragma unroll
      for (int i = 0; i < 16; i += 2) {
        const float p0 = __builtin_amdgcn_exp2f(st[kb][i] - tot), p1 = __builtin_amdgcn_exp2f(st[kb][i + 1] - tot);
        st[kb][i] = p0; st[kb][i + 1] = p1; ps += f2v{p0, p1};
      }
    l = l * alpha + (ps.x + ps.y);
#pragma unroll
    for (int i = 0; i < 16; ++i) { o[0][i] *= alpha; o[1][i] *= alpha; }
    shift_out = shift;
  } else {
#pragma unroll
    for (int kb = 0; kb < 2; ++kb)
#pragma unroll
      for (int i = 0; i < 16; i += 2) {
        const float p0 = __builtin_amdgcn_exp2f(st[kb][i]), p1 = __builtin_amdgcn_exp2f(st[kb][i + 1]);
        st[kb][i] = p0; st[kb][i + 1] = p1; ps += f2v{p0, p1};
      }
    l += ps.x + ps.y;
  }
  return shift_out;
}
DI void att_pv(const u16* sv, const f32x16 (&st)[2], f32x16 (&o)[2]) {
#pragma unroll
  for (int s4 = 0; s4 < 4; ++s4) {
    const int kb = s4 >> 1, rb = 8 * (s4 & 1);
    u4v pu; pu.x = pk2(st[kb][rb], st[kb][rb + 1]); pu.y = pk2(st[kb][rb + 2], st[kb][rb + 3]);
    pu.z = pk2(st[kb][rb + 4], st[kb][rb + 5]); pu.w = pk2(st[kb][rb + 6], st[kb][rb + 7]);
    const bf16x8 pb = __builtin_bit_cast(bf16x8, pu);
#pragma unroll
    for (int db = 0; db < 2; ++db) {
      const s16x4 lo = *(const s16x4*)(sv + db * 32 * VST2 + 16 * s4);
      const s16x4 hi = *(const s16x4*)(sv + db * 32 * VST2 + 16 * s4 + 8);
      const bf16x8 vf = __builtin_shufflevector(lo, hi, 0, 1, 2, 3, 4, 5, 6, 7);
      o[db] = MFMA(vf, pb, o[db]);
    }
  }
}
DI void attn8_item(const Params& p, u16* lds, int bh, int qt) {
  unsigned char* ws = p.ws;
  const int tid = threadIdx.x, lane = tid & 63, w = tid >> 6, r = lane & 31, h = lane >> 5;
  const u16* Qp = (const u16*)(ws + OFF_Q) + (size_t)bh * 4096 * 96;
  const u16* Kp = (const u16*)(ws + OFF_K) + (size_t)bh * 4096 * 96;
  const u16* Vp = (const u16*)(ws + OFF_VTT) + (size_t)bh * 64 * 4096;
  const int q0 = qt * 256 + w * 32;
  bf16x8 qf[6];
#pragma unroll
  for (int ks = 0; ks < 6; ++ks) qf[ks] = *(const bf16x8*)(Qp + (size_t)(q0 + r) * 96 + ks * 16 + h * 8);
  f32x16 o[2]; o[0] = zero16(); o[1] = zero16();
  float mref = 0.f, l = 0.f;
  const int Jmax = 2 * qt + 1, jw = 4 * qt + (w >> 1);
  int kr[3], kc[3];
#pragma unroll
  for (int i = 0; i < 3; ++i) { const int idx = tid + 512 * i; kr[i] = idx / 12; kc[i] = idx % 12; }
  const int vr = tid >> 4, vc = tid & 15;
  u4v rk[3], rv[2];
#pragma unroll
  for (int i = 0; i < 3; ++i) rk[i] = *(const u4v*)(Kp + (size_t)kr[i] * 96 + kc[i] * 8);
#pragma unroll
  for (int i = 0; i < 2; ++i) rv[i] = *(const u4v*)(Vp + (size_t)(vr + 32 * i) * 4096 + vc * 8);
  __syncthreads();
#pragma unroll
  for (int i = 0; i < 3; ++i) *(u4v*)(lds + kr[i] * KST2 + kc[i] * 8) = rk[i];
#pragma unroll
  for (int i = 0; i < 2; ++i) { u16* dv = lds + 128 * KST2 + (vr + 32 * i) * VST2 + vc * 8; *(u2v*)dv = u2v{rv[i].x, rv[i].y}; *(u2v*)(dv + 4) = u2v{rv[i].z, rv[i].w}; }
  __syncthreads();
  for (int J = 0; J <= Jmax; ++J) {
    const int cur = J & 1;
    if (J < Jmax) {
#pragma unroll
      for (int i = 0; i < 3; ++i) rk[i] = *(const u4v*)(Kp + (size_t)((J + 1) * 128 + kr[i]) * 96 + kc[i] * 8);
#pragma unroll
      for (int i = 0; i < 2; ++i) rv[i] = *(const u4v*)(Vp + (size_t)(vr + 32 * i) * 4096 + (J + 1) * 128 + vc * 8);
    }
    const u16* sk = lds + cur * ATT_BUF2 + r * KST2 + h * 8;
    const u16* sv = lds + cur * ATT_BUF2 + 128 * KST2 + r * VST2 + 4 * h;
    if (2 * J + 1 <= jw) {
      f32x16 s0[2], s1[2];
      const float nm = -mref;
      att_qk(sk, qf, nm, s0);
      att_qk(sk + 64 * KST2, qf, nm, s1);
      const float sh = att_softmax(s0, 0.f, false, J == 0, mref, l, o);
      const bool adjnz = __builtin_amdgcn_ballot_w64(sh != 0.f) != 0ull;
      att_pv(sv, s0, o);
      att_softmax(s1, sh, adjnz, false, mref, l, o);
      att_pv(sv + 64, s1, o);
    } else if (2 * J <= jw) {
      f32x16 s0[2];
      att_qk(sk, qf, -mref, s0);
      att_softmax(s0, 0.f, false, J == 0, mref, l, o);
      att_pv(sv, s0, o);
    }
    if (J < Jmax) {
      u16* d = lds + (cur ^ 1) * ATT_BUF2;
#pragma unroll
      for (int i = 0; i < 3; ++i) *(u4v*)(d + kr[i] * KST2 + kc[i] * 8) = rk[i];
#pragma unroll
      for (int i = 0; i < 2; ++i) { u16* dv = d + 128 * KST2 + (vr + 32 * i) * VST2 + vc * 8; *(u2v*)dv = u2v{rv[i].x, rv[i].y}; *(u2v*)(dv + 4) = u2v{rv[i].z, rv[i].w}; }
    }
    __syncthreads();
  }
  l = xor32_add(l);
  const float inv = 1.f / l;
  const int b = bh >> 3, head = bh & 7;
  const size_t tok = (size_t)b * 4096 + q0 + r;
  const u16* sga = (const u16*)(ws + OFF_SGA) + tok * 512 + head * 64;
  u16* ya = (u16*)(ws + OFF_YA) + tok * 512 + head * 64;
#pragma unroll
  for (int db = 0; db < 2; ++db)
#pragma unroll
    for (int g = 0; g < 4; ++g) {
      const int dv0 = db * 32 + 8 * g + 4 * h;
      const u2v gt = *(const u2v*)(sga + dv0);
      u2v ov;
      ov.x = pk2(o[db][4 * g] * inv * bflo(gt.x), o[db][4 * g + 1] * inv * bfhi(gt.x));
      ov.y = pk2(o[db][4 * g + 2] * inv * bflo(gt.y), o[db][4 * g + 3] * inv * bfhi(gt.y));
      *(u2v*)(ya + dv0) = ov;
    }
}

DI void scan_item(const Params& p, int i, size_t out_off = OFF_UPD) {
  unsigned char* ws = p.ws;
  const int tid = threadIdx.x;
  const int bh = i >> 2, part = i & 3;
  const int e = part * 1024 + tid * 2, k = e & 63;
  u32* U = (u32*)((u16*)(ws + OFF_UPD) + (size_t)bh * 128 * 4096 + e);
  u32* UO = (u32*)((u16*)(ws + out_off) + (size_t)bh * 128 * 4096 + e);
  const f2v* Dc = (const f2v*)((const float*)(ws + OFF_DECAY) + (size_t)bh * 128 * 64 + k);
  float s0 = 0.f, s1 = 0.f;
  for (int n0 = 0; n0 < 128; n0 += 32) {
    u32 u[32]; f2v d[32];
#pragma unroll
    for (int q = 0; q < 32; ++q) { u[q] = U[(size_t)(n0 + q) * 2048]; d[q] = Dc[(n0 + q) * 32]; }
#pragma unroll
    for (int q = 0; q < 32; ++q) {
      UO[(size_t)(n0 + q) * 2048] = pk2(s0, s1);
      s0 = d[q].x * (s0 + bflo(u[q]));
      s1 = d[q].y * (s1 + bfhi(u[q]));
    }
  }
}

DI void hgrn_state_item(const Params& p, float* ub, int bh, int vb) {
  unsigned char* ws = p.ws;
  const int tid = threadIdx.x, lane = tid & 63, w = tid >> 6, r = lane & 31, h = lane >> 5;
  const int b = bh >> 3, head = bh & 7;
  const u16* kn_base = (const u16*)(ws + OFF_KINV) + ((size_t)b * 4096) * 512 + head * 64;
  const u16* vt_base = (const u16*)(ws + OFF_VT) + ((size_t)bh * 128) * 64 * 32;
  const float* dec = (const float*)(ws + OFF_DECAY) + (size_t)bh * 128 * 64;
  u16* up = (u16*)(ws + OFF_UPD) + (size_t)bh * 128 * 4096;
  const int vl = tid >> 4, k0 = (tid & 15) * 4;
  constexpr int KS = 68;
  f4v st = f4v{0.f, 0.f, 0.f, 0.f};
#pragma unroll 1
  for (int i = 0; i < 16; ++i) {
    const int n = i * 8 + w;
    bf16x8 a[2][2], bb[2];
    const u16* kn = kn_base + (size_t)(n * 32) * 512;
#pragma unroll
    for (int kb = 0; kb < 2; ++kb)
#pragma unroll
      for (int ks = 0; ks < 2; ++ks) {
        bf16x8 av;
#pragma unroll
        for (int j = 0; j < 8; ++j) av[j] = (short)kn[(size_t)(ks * 16 + h * 8 + j) * 512 + kb * 32 + r];
        a[kb][ks] = av;
      }
#pragma unroll
    for (int ks = 0; ks < 2; ++ks) bb[ks] = *(const bf16x8*)(vt_base + ((size_t)n * 64 + vb * 32 + r) * 32 + ks * 16 + h * 8);
    f4v d[8];
#pragma unroll
    for (int j = 0; j < 8; ++j) d[j] = *(const f4v*)(dec + (size_t)(i * 8 + j) * 64 + k0);
    __syncthreads();
#pragma unroll
    for (int kb = 0; kb < 2; ++kb) {
      f32x16 c = zero16();
      c = MFMA(a[kb][0], bb[0], c);
      c = MFMA(a[kb][1], bb[1], c);
#pragma unroll
      for (int g = 0; g < 4; ++g) *(f4v*)(ub + (w * 32 + r) * KS + kb * 32 + 8 * g + 4 * h) = f4v{c[4 * g], c[4 * g + 1], c[4 * g + 2], c[4 * g + 3]};
    }
    __syncthreads();
#pragma unroll
    for (int j = 0; j < 8; ++j) {
      const f4v u = *(const f4v*)(ub + (j * 32 + vl) * KS + k0);
      u2v o; o.x = pk2(st.x, st.y); o.y = pk2(st.z, st.w);
      *(u2v*)(up + (size_t)(i * 8 + j) * 4096 + (vb * 32 + vl) * 64 + k0) = o;
      st.x = d[j].x * (st.x + u.x); st.y = d[j].y * (st.y + u.y); st.z = d[j].z * (st.z + u.z); st.w = d[j].w * (st.w + u.w);
    }
  }
  asm volatile("s_waitcnt vmcnt(0)" ::: "memory");
  __syncthreads();
  if (threadIdx.x == 0) {
    __builtin_amdgcn_fence(__ATOMIC_RELEASE, "agent");
    asm volatile("s_waitcnt vmcnt(0)" ::: "memory");
    __hip_atomic_fetch_add((unsigned*)(ws + OFF_SSQ + (size_t)3 * T * 4) + 64 + bh, 1u, __ATOMIC_RELAXED, __HIP_MEMORY_SCOPE_AGENT);
  }
}

DI void h3_item(const Params& p, int t);
DI void phase3(const Params& p, unsigned char* smem, bool dup = false) {
  int* s_item = (int*)(smem + LDS_BYTES - 64);
  int* ctr = (int*)(p.ws + OFF_SSQ + (size_t)3 * T * 4) + (dup ? 1 : 0);
  unsigned* done = (unsigned*)(p.ws + OFF_SSQ + (size_t)3 * T * 4) + 64;
  if (!dup) for (int it = (int)blockIdx.x - ((int)gridDim.x - 128); it >= 0 && it < 128; it += 128 * 1024) hgrn_state_item(p, (float*)smem, it >> 1, it & 1);
  if (!dup && (int)gridDim.x < 128) for (int it = (int)blockIdx.x; it < 128; it += (int)gridDim.x) hgrn_state_item(p, (float*)smem, it >> 1, it & 1);
  for (;;) {
    __syncthreads();
    if (threadIdx.x == 0) *s_item = atomicAdd(ctr, 1);
    __syncthreads();
    const int item = *s_item;
    if (item >= 2048) break;
    int att = -1, h3 = -1;
    if (item < 256) att = item;
    else { const int j = item - 256, g = j / 7, pos = j % 7; if (pos == 0 || pos == 2 || pos == 4) att = 256 + 3 * g + (pos >> 1); else h3 = 4 * g + (pos == 1 ? 0 : pos == 3 ? 1 : pos == 5 ? 2 : 3); }
    if (att >= 0) attn8_item(p, (u16*)smem, att & 63, 15 - (att >> 6));
    else if (!dup) {
      const int bh = h3 >> 4;
      if (threadIdx.x == 0) {
        unsigned sp = 0;
        while (__hip_atomic_load(done + bh, __ATOMIC_RELAXED, __HIP_MEMORY_SCOPE_AGENT) < 2u) { __builtin_amdgcn_s_sleep(2); if (++sp > (1u << 22)) break; }
        __builtin_amdgcn_fence(__ATOMIC_ACQUIRE, "agent");
        asm volatile("s_waitcnt vmcnt(0)" ::: "memory");
      }
      __syncthreads();
      h3_item(p, 2 * h3 + (int)(threadIdx.x >> 8));
    }
  }
}

DI void h3_item(const Params& p, int t) {
  unsigned char* ws = p.ws;
  const int tid = VTID, lane = tid & 63, w = tid >> 6, r = lane & 31, h = lane >> 5;
  {
    const int bh = t >> 5, n = (t & 31) * 4 + w;
    const int b = bh >> 3, head = bh & 7;
    const size_t tok0 = (size_t)b * 4096 + n * 32;
    const u16* qd = (const u16*)(ws + OFF_QDEC) + (tok0 + r) * 512 + head * 64 + h * 8;
    const u16* ki = (const u16*)(ws + OFF_KINV) + (tok0 + r) * 512 + head * 64 + h * 8;
    const u16* vt = (const u16*)(ws + OFF_VT) + ((size_t)bh * 128 + n) * 64 * 32;
    const u16* sp = (const u16*)(ws + OFF_UPD) + ((size_t)bh * 128 + n) * 4096;
    bf16x8 qf[4], kf[4];
#pragma unroll
    for (int ks = 0; ks < 4; ++ks) { qf[ks] = *(const bf16x8*)(qd + ks * 16); kf[ks] = *(const bf16x8*)(ki + ks * 16); }
    f32x16 at = zero16();
#pragma unroll
    for (int ks = 0; ks < 4; ++ks) at = MFMA(kf[ks], qf[ks], at);
#pragma unroll
    for (int i = 0; i < 16; ++i) if (crow(i, h) > r) at[i] = 0.f;
    f32x16 o[2]; o[0] = zero16(); o[1] = zero16();
#pragma unroll
    for (int s2 = 0; s2 < 2; ++s2) {
      u4v pu; pu.x = pk2(at[8 * s2], at[8 * s2 + 1]); pu.y = pk2(at[8 * s2 + 2], at[8 * s2 + 3]);
      pu.z = pk2(at[8 * s2 + 4], at[8 * s2 + 5]); pu.w = pk2(at[8 * s2 + 6], at[8 * s2 + 7]);
      const bf16x8 pb = __builtin_bit_cast(bf16x8, pu);
#pragma unroll
      for (int vb = 0; vb < 2; ++vb) {
        const s16x4 lo = *(const s16x4*)(vt + (vb * 32 + r) * 32 + 16 * s2 + 4 * h);
        const s16x4 hi = *(const s16x4*)(vt + (vb * 32 + r) * 32 + 16 * s2 + 8 + 4 * h);
        const bf16x8 vf = __builtin_shufflevector(lo, hi, 0, 1, 2, 3, 4, 5, 6, 7);
        o[vb] = MFMA(vf, pb, o[vb]);
      }
    }
#pragma unroll
    for (int vb = 0; vb < 2; ++vb)
#pragma unroll
      for (int ks = 0; ks < 4; ++ks) {
        const bf16x8 sf = *(const bf16x8*)(sp + (vb * 32 + r) * 64 + ks * 16 + h * 8);
        o[vb] = MFMA(sf, qf[ks], o[vb]);
      }
    float ss = 0.f;
#pragma unroll
    for (int i = 0; i < 16; ++i) ss += o[0][i] * o[0][i] + o[1][i] * o[1][i];
    ss = xor32_add(ss);
    const float rs = rsqrtf(ss * (1.f / 64.f) + EPS);
    const u16* sgb = (const u16*)(ws + OFF_SGB) + (tok0 + r) * 512 + head * 64;
    u16* yb = (u16*)(ws + OFF_YB) + (tok0 + r) * 512 + head * 64;
#pragma unroll
    for (int vb = 0; vb < 2; ++vb)
#pragma unroll
      for (int g = 0; g < 4; ++g) {
        const int v0 = vb * 32 + 8 * g + 4 * h;
        const u2v gt = *(const u2v*)(sgb + v0);
        u2v ov;
        ov.x = pk2(o[vb][4 * g] * rs * bflo(gt.x), o[vb][4 * g + 1] * rs * bfhi(gt.x));
        ov.y = pk2(o[vb][4 * g + 2] * rs * bflo(gt.y), o[vb][4 * g + 3] * rs * bfhi(gt.y));
        *(u2v*)(yb + v0) = ov;
      }
  }
}

DI void phase5(const Params& p, unsigned char* smem) {
  unsigned char* ws = p.ws;
  pg8::StaticOrder S; S.init(T, 1024, (int)gridDim.x, (int)blockIdx.x);
  {
    pg8::Gemm g{(const u16*)(ws + OFF_YA), (const u16*)(ws + OFF_WA), T, 1024, 512};
    Epi5<false> E{(const u16*)p.out, (u16*)(ws + OFF_H), (u16*)(ws + OFF_M)};
    pg8::gemm_phase<Epi5<false>, pg8::StaticOrder, false>((PG8_LAS unsigned char*)smem, g, S, E, nullptr);
  }
  {
    pg8::Gemm g{(const u16*)(ws + OFF_YB), (const u16*)(ws + OFF_WB), T, 1024, 512};
    Epi5<true> E{(const u16*)p.out, (u16*)(ws + OFF_H), (u16*)(ws + OFF_M)};
    pg8::gemm_phase<Epi5<true>, pg8::StaticOrder, false>((PG8_LAS unsigned char*)smem, g, S, E, nullptr);
  }
}

DI void phase6(const Params& p, unsigned char* smem, bool dup = false) {
  unsigned char* ws = p.ws;
  pg8::Gemm g{(const u16*)(ws + OFF_M), (const u16*)(ws + OFF_WO), T, 1024, 1024};
  pg8::StaticOrder S; S.init(T, 1024, (int)gridDim.x, (int)blockIdx.x);
  Epi6 E{(u16*)(ws + OFF_H), (float*)(ws + OFF_SSQ) + 2 * T, dup};
  pg8::gemm_phase<Epi6, pg8::StaticOrder, false>((PG8_LAS unsigned char*)smem, g, S, E, nullptr);
}

DI void phase7(const Params& p) {
  const float* ssq_y = (const float*)(p.ws + OFF_SSQ) + 2 * T;
  const u2v* Y = (const u2v*)(p.ws + OFF_H);
  const int gtid = blockIdx.x * blockDim.x + threadIdx.x, gthreads = gridDim.x * blockDim.x;
  for (int i = gtid; i < T * 256; i += gthreads) {
    const int row = i >> 8, c4 = i & 255;
    const float rs = rsqrtf(ssq_y[row] * (1.f / 1024.f) + EPS);
    const u2v y = Y[i];
    const f4v xv = ((const f4v*)p.x)[i];
    const f4v g = ((const f4v*)p.g_post)[c4];
    f4v o;
    o.x = xv.x + bflo(y.x) * rs * g.x; o.y = xv.y + bfhi(y.x) * rs * g.y; o.z = xv.z + bflo(y.y) * rs * g.z; o.w = xv.w + bfhi(y.y) * rs * g.w;
    ((f4v*)p.out)[i] = o;
  }
}

__global__ void __launch_bounds__(512, 2) fwd_megakernel(Params p) {
  extern __shared__ __attribute__((aligned(16))) unsigned char smem[];
  u16* lds = (u16*)(smem + (threadIdx.x >> 8) * VLDS);
  cg::grid_group grid = cg::this_grid();
  volatile LAS unsigned* xst = (volatile LAS unsigned*)(smem + LDS_BYTES - 48);
  if (threadIdx.x == 0) { xst[0] = 0u; xst[1] = 0u; }
  __syncthreads();
  XcdBarrier xb = xcd_barrier_post((unsigned*)(p.ws + OFF_BAR), xst);
#define RUN_PHASE(N, CALL) if (p.ph_lo <= N && N < p.ph_hi) { if (N > p.ph_lo) xcd_barrier(xb); CALL; }
#define DUP_PHASE(N, CALL) if (DUP_PH == N) { xcd_barrier(xb); CALL; }
  RUN_PHASE(0, phase0(p))
  DUP_PHASE(0, phase0(p))
  if (p.ph_lo <= 1 && 1 < p.ph_hi) for (int rep = 0; rep < (DUP_PH == 1 ? 2 : 1); ++rep) { if (rep > 0 || 1 > p.ph_lo) xcd_barrier(xb); phase1(p, smem, rep > 0); }
  if (p.ph_lo <= 2 && 2 < p.ph_hi) for (int rep = 0; rep < (DUP_PH == 2 ? 2 : 1); ++rep) { if (rep > 0 || 2 > p.ph_lo) xcd_barrier(xb); phase2(p, smem, lds); }
  RUN_PHASE(4, phase3(p, smem))
  DUP_PHASE(4, phase3(p, smem, true))
  if (DUP_PH == 9) { xcd_barrier(xb); for (int i = blockIdx.x; i < 256; i += gridDim.x) scan_item(p, i, OFF_K); }
  RUN_PHASE(6, phase5(p, smem))
  DUP_PHASE(6, phase5(p, smem))
  RUN_PHASE(7, phase6(p, smem))
  DUP_PHASE(7, phase6(p, smem, true))
  RUN_PHASE(8, phase7(p))
  if (DUP_PH == 8) { xcd_barrier(xb); phase6(p, smem, true); xcd_barrier(xb); phase7(p); }
}

extern "C" void kernel_launch(void* const* d_in, const int* in_sizes, int n_in, void* d_out, int out_size, void* d_ws, size_t ws_size,
                              hipStream_t stream) {
  static int grid_blocks = 0;
  if (!grid_blocks) {
    int dev = 0, cus = 0, per_cu = 0;
    hipGetDevice(&dev);
    hipDeviceGetAttribute(&cus, hipDeviceAttributeMultiprocessorCount, dev);
    hipFuncSetAttribute((const void*)fwd_megakernel, hipFuncAttributeMaxDynamicSharedMemorySize, LDS_BYTES);
    hipOccupancyMaxActiveBlocksPerMultiprocessor(&per_cu, (const void*)fwd_megakernel, 512, LDS_BYTES);
    if (per_cu < 1) per_cu = 1;
    if (per_cu > 1) per_cu = 1;
    grid_blocks = cus * per_cu;
    if (ws_size < WS_NEED) fprintf(stderr, "kernel_launch: workspace too small: %zu < %zu\n", ws_size, (size_t)WS_NEED);
  }
  if (ws_size < WS_NEED) return;
  Params p{};
  p.x = (const float*)d_in[0]; p.g_pre = (const float*)d_in[1]; p.w_in = (const float*)d_in[2]; p.b_gate = (const float*)d_in[3];
  p.g_q = (const float*)d_in[4]; p.w_uq = (const float*)d_in[5]; p.g_kv = (const float*)d_in[6]; p.w_ukv = (const float*)d_in[7];
  p.lb_logits = (const float*)d_in[8]; p.g_hgrn = (const float*)d_in[9]; p.w_a = (const float*)d_in[10]; p.w_b = (const float*)d_in[11];
  p.w_out = (const float*)d_in[12]; p.g_post = (const float*)d_in[13];
  p.out = (float*)d_out; p.ws = (unsigned char*)d_ws;
#if ONE_LAUNCH
  p.ph_lo = 0; p.ph_hi = 9;
  (void)hipMemsetAsync((unsigned char*)d_ws + OFF_BAR, 0, 16384, stream);
  void* args[] = {&p};
  hipError_t e = hipLaunchCooperativeKernel((const void*)fwd_megakernel, dim3(grid_blocks), dim3(512), args, LDS_BYTES, stream);
  if (e != hipSuccess) fprintf(stderr, "cooperative launch failed: %s (grid %d)\n", hipGetErrorString(e), grid_blocks);
#else
  for (int ph = 0; ph < 9; ++ph) {
    p.ph_lo = ph; p.ph_hi = ph + 1;
    (void)hipMemsetAsync((unsigned char*)d_ws + OFF_BAR, 0, 16384, stream);
    void* args[] = {&p};
    hipError_t e = hipLaunchCooperativeKernel((const void*)fwd_megakernel, dim3(grid_blocks), dim3(512), args, LDS_BYTES, stream);
    if (e != hipSuccess) fprintf(stderr, "cooperative launch failed: %s (grid %d)\n", hipGetErrorString(e), grid_blocks);
  }
#endif
}
```

```cpp
#include <hip/hip_runtime.h>
#include <hip/hip_cooperative_groups.h>
#include <cstdio>
namespace cg = cooperative_groups;

#define DI __device__ __forceinline__
#define VTID ((int)(threadIdx.x & 255))
#define VBID ((int)(blockIdx.x * 2 + (threadIdx.x >> 8)))
#define VBN ((int)(gridDim.x * 2))
typedef unsigned short u16;
typedef unsigned int u32;
typedef __attribute__((ext_vector_type(8))) short bf16x8;
typedef __attribute__((ext_vector_type(4))) short s16x4;
typedef __attribute__((ext_vector_type(16))) float f32x16;
typedef __attribute__((ext_vector_type(2))) __bf16 bf2_t;
typedef __attribute__((ext_vector_type(2))) float f2_t;
typedef __attribute__((ext_vector_type(4))) unsigned int u4v;
typedef __attribute__((ext_vector_type(2))) unsigned int u2v;
typedef __attribute__((ext_vector_type(4))) float f4v;
typedef __attribute__((ext_vector_type(2))) float f2v;
#define MFMA(a, b, c) __builtin_amdgcn_mfma_f32_32x32x16_bf16((a), (b), (c), 0, 0, 0)

#ifndef DUP_PH
#define DUP_PH -1
#endif
#ifndef ONE_LAUNCH
#define ONE_LAUNCH 1
#endif

constexpr int T = 32768;
constexpr int SEQ = 4096;
constexpr int DIN = 5664;
constexpr int NP = 5888;
constexpr float EPS = 1e-6f;
constexpr float QSCALE = 1.4426950408889634f * 0.10206207261596575f;

constexpr size_t SZ_WIN = (size_t)NP * 1024 * 2;
constexpr size_t OFF_WIN = 0;
constexpr size_t OFF_WUQ = OFF_WIN + SZ_WIN;
constexpr size_t OFF_WUKV = OFF_WUQ + (size_t)768 * 768 * 2;
constexpr size_t OFF_WA = OFF_WUKV + (size_t)1024 * 256 * 2;
constexpr size_t OFF_WB = OFF_WA + (size_t)1024 * 512 * 2;
constexpr size_t OFF_WO = OFF_WB + (size_t)1024 * 512 * 2;
constexpr size_t OFF_ROPE = OFF_WO + (size_t)1024 * 1024 * 2;
constexpr size_t OFF_SSQ = OFF_ROPE + (size_t)4096 * 16 * 2 * 4;
constexpr size_t OFF_DECAY = OFF_SSQ + (size_t)(3 * T + 256) * 4;
constexpr size_t OFF_H = OFF_DECAY + (size_t)64 * 128 * 64 * 4;
constexpr size_t OFF_Q = OFF_H;
constexpr size_t OFF_CQ = OFF_H + (size_t)T * 1024 * 2;
constexpr size_t OFF_YA = OFF_CQ;
constexpr size_t OFF_CKV = OFF_CQ + (size_t)T * 768 * 2;
constexpr size_t OFF_KPE = OFF_CKV + (size_t)T * 256 * 2;
constexpr size_t OFF_SGA = OFF_KPE + (size_t)T * 32 * 4;
constexpr size_t OFF_SGB = OFF_SGA + (size_t)T * 512 * 2;
constexpr size_t OFF_HQ = OFF_SGB + (size_t)T * 512 * 2;
constexpr size_t OFF_UPD = OFF_HQ;
constexpr size_t OFF_HF = OFF_HQ + (size_t)T * 512 * 2;
constexpr size_t OFF_HI = OFF_HF + (size_t)T * 512 * 2;
constexpr size_t OFF_YB = OFF_HI;
constexpr size_t OFF_QDEC = OFF_HI + (size_t)T * 512 * 2;
constexpr size_t OFF_KINV = OFF_QDEC + (size_t)T * 512 * 2;
constexpr size_t OFF_VT = OFF_KINV + (size_t)T * 512 * 2;
constexpr size_t OFF_K = OFF_VT + (size_t)T * 512 * 2;
constexpr size_t OFF_M = OFF_K;
constexpr size_t OFF_VTT = OFF_K + (size_t)T * 768 * 2;
constexpr size_t OFF_BAR = OFF_VTT + (size_t)T * 512 * 2;
constexpr size_t WS_NEED = OFF_BAR + 16384;

constexpr int VLDS = 2 * 2 * 128 * 72 * 2;
constexpr int LDS_BYTES = 2 * VLDS + 64;
constexpr int SST = 132;

struct Params {
  const float *x, *g_pre, *w_in, *b_gate, *g_q, *w_uq, *g_kv, *w_ukv, *lb_logits, *g_hgrn, *w_a, *w_b, *w_out, *g_post;
  float* out;
  unsigned char* ws;
  int ph_lo, ph_hi;
};

DI u32 pk2(float a, float b) { f2_t v = {a, b}; bf2_t r = __builtin_convertvector(v, bf2_t); return __builtin_bit_cast(u32, r); }
DI float bflo(u32 u) { return __uint_as_float(u << 16); }
DI float bfhi(u32 u) { return __uint_as_float(u & 0xffff0000u); }
DI u4v pk8(f4v a, f4v b) { u4v r; r.x = pk2(a.x, a.y); r.y = pk2(a.z, a.w); r.z = pk2(b.x, b.y); r.w = pk2(b.z, b.w); return r; }
DI float rcpf(float x) { return __builtin_amdgcn_rcpf(x); }
DI float sigmoidf_(float x) { return rcpf(1.f + __expf(-x)); }
DI float siluf_(float x) { return x * sigmoidf_(x); }
DI float xor32_max(float x) { const unsigned u = __float_as_uint(x); auto r = __builtin_amdgcn_permlane32_swap(u, u, false, false); return fmaxf(__uint_as_float(r[0]), __uint_as_float(r[1])); }
DI float xor32_add(float x) { const unsigned u = __float_as_uint(x); auto r = __builtin_amdgcn_permlane32_swap(u, u, false, false); return __uint_as_float(r[0]) + __uint_as_float(r[1]); }
DI float xor16_add(float x) { const unsigned u = __float_as_uint(x); auto r = __builtin_amdgcn_permlane16_swap(u, u, false, false); return __uint_as_float(r[0]) + __uint_as_float(r[1]); }
DI int crow(int reg, int h) { return (reg & 3) + 8 * (reg >> 2) + 4 * h; }
DI f32x16 zero16() { f32x16 z;
#pragma unroll
  for (int i = 0; i < 16; ++i) z[i] = 0.f; return z; }

__constant__ float c_invfreq[16] = {1.0f, 0.5623413324356079f, 0.3162277638912201f, 0.17782793939113617f, 0.10000000149011612f,
  0.05623413249850273f, 0.03162277489900589f, 0.017782794311642647f, 0.009999999776482582f, 0.005623413249850273f,
  0.003162277629598975f, 0.0017782794311642647f, 0.0010000000474974513f, 0.000562341301701963f, 0.0003162277571391314f,
  0.00017782794020604342f};

DI void sincos_d(double a, float& sn, float& cs) {
  const double k = rint(a * 0.63661977236758134308);
  const double y = a - k * 1.57079632679489661923;
  const double y2 = y * y;
  const double s = y * (1.0 + y2 * (-1.0 / 6 + y2 * (1.0 / 120 + y2 * (-1.0 / 5040 + y2 * (1.0 / 362880 + y2 * (-1.0 / 39916800 + y2 * (1.0 / 6227020800.0)))))));
  const double c = 1.0 + y2 * (-0.5 + y2 * (1.0 / 24 + y2 * (-1.0 / 720 + y2 * (1.0 / 40320 + y2 * (-1.0 / 3628800 + y2 * (1.0 / 479001600.0 + y2 * (-1.0 / 87178291200.0)))))));
  const int q = ((int)k) & 3;
  const double ss = (q == 0) ? s : (q == 1) ? c : (q == 2) ? -s : -c;
  const double cc = (q == 0) ? c : (q == 1) ? -s : (q == 2) ? -c : s;
  sn = (float)ss; cs = (float)cc;
}

#define XB_TMO      128
#define XB_XCNT(j)  (256  + 64 * (j))
#define XB_XSUB(j)  (1280 + 64 * (j))
#define XB_XGEN(j)  (2304 + 64 * (j))
#define XB_TOP      3328
#define XB_TOPGEN   3392
#define XCD_BAR_WORDS 3456
#define XB_SPIN_CAP (1u << 22)
#define LAS __attribute__((address_space(3)))
DI unsigned xb_ld(unsigned* p)              { return __hip_atomic_load(p, __ATOMIC_RELAXED, __HIP_MEMORY_SCOPE_AGENT); }
DI unsigned xb_add(unsigned* p, unsigned v) { return __hip_atomic_fetch_add(p, v, __ATOMIC_RELAXED, __HIP_MEMORY_SCOPE_AGENT); }
DI unsigned xb_xcc_id() { return (unsigned)__builtin_amdgcn_s_getreg((3 << 11) | 20) & 0xFu; }
#define XB_SPIN(cond, bar) do { unsigned _sp = 0; while (cond) { __builtin_amdgcn_s_sleep(1); \
    if ((++_sp & 255u) == 0u) { if (xb_ld(&(bar)[XB_TMO])) break; if (_sp > XB_SPIN_CAP) { atomicAdd(&(bar)[XB_TMO], 1u); break; } } } } while (0)
struct XcdBarrier { unsigned* bar; unsigned x; volatile LAS unsigned* st; };
DI XcdBarrier xcd_barrier_post(unsigned* bar, volatile LAS unsigned* st) {
  XcdBarrier b; b.bar = bar; b.x = xb_xcc_id(); b.st = st;
  if (threadIdx.x == 0) (void)xb_add(&bar[XB_XCNT(b.x)], 1u);
  return b;
}
DI void xcd_barrier_complete(unsigned* bar, unsigned x, unsigned& nloc, unsigned& nx) {
  const unsigned G = gridDim.x * gridDim.y * gridDim.z;
  unsigned sum, cnt, mine, sp = 0u;
  for (;;) {
    sum = 0u; cnt = 0u; mine = 0u;
#pragma unroll
    for (unsigned j = 0; j < 16; ++j) { const unsigned c = xb_ld(&bar[XB_XCNT(j)]); sum += c; cnt += (c > 0u) ? 1u : 0u; mine = (j == x) ? c : mine; }
    if (sum == G) break;
    __builtin_amdgcn_s_sleep(1);
    if ((++sp & 255u) == 0u) { if (xb_ld(&bar[XB_TMO])) break; if (sp > XB_SPIN_CAP) { atomicAdd(&bar[XB_TMO], 1u); break; } }
  }
  nloc = mine > 0u ? mine : 1u; nx = cnt > 0u ? cnt : 1u;
}
DI void xcd_barrier(const XcdBarrier& b) {
  asm volatile("s_waitcnt vmcnt(0)" ::: "memory");
  __syncthreads();
  if (threadIdx.x == 0) {
    unsigned* bar = b.bar;
    __builtin_amdgcn_s_waitcnt(0);
    unsigned nloc = b.st[0], nx = b.st[1];
    if (nloc == 0u) { xcd_barrier_complete(bar, b.x, nloc, nx); b.st[0] = nloc; b.st[1] = nx; }
    const unsigned old = xb_add(&bar[XB_XSUB(b.x)], 1u);
    const unsigned gen = old / nloc;
    if (old + 1u == (gen + 1u) * nloc) {
      __builtin_amdgcn_fence(__ATOMIC_RELEASE, "agent");
      asm volatile("s_waitcnt vmcnt(0)" ::: "memory");
      const unsigned og = xb_add(&bar[XB_TOP], 1u);
      const unsigned tg = og / nx;
      if (og + 1u == (tg + 1u) * nx) xb_add(&bar[XB_TOPGEN], 1u);
      else XB_SPIN(xb_ld(&bar[XB_TOPGEN]) == tg, bar);
      __builtin_amdgcn_fence(__ATOMIC_ACQUIRE, "agent");
      xb_add(&bar[XB_XGEN(b.x)], 1u);
      asm volatile("s_waitcnt vmcnt(0)" ::: "memory");
    } else {
      XB_SPIN(xb_ld(&bar[XB_XGEN(b.x)]) == gen, bar);
      __builtin_amdgcn_fence(__ATOMIC_ACQUIRE, "agent");
      asm volatile("s_waitcnt vmcnt(0)" ::: "memory");
    }
  }
  __syncthreads();
}

template <int KIND>
DI int colmap(int n) {
  if (KIND == 0) {
    if (n < 1024) return n;
    if (n < 1536) return 1056 + (n - 1024);
    if (n < 2048) return 3104 + (n - 1536);
    if (n < 4096) return 3616 + (n - 2048);
    if (n < 4608) return 1568 + (n - 4096);
    if (n < 5120) return 2080 + (n - 4608);
    if (n < 5632) return 2592 + (n - 5120);
    if (n < 5664) return 1024 + (n - 5632);
    return -1;
  } else if (KIND == 1) {
    if (n < 512) return (n >> 6) * 96 + (n & 63);
    int i = n - 512; int w = i & 31, g = w >> 3, e = w & 7; return (i >> 5) * 96 + 64 + ((e < 4) ? (4 * g + e) : (16 + 4 * g + (e - 4)));
  } else if (KIND == 3) {
    if (n < 512) return (n >> 6) * 128 + (n & 63);
    int i = n - 512; return (i >> 6) * 128 + 64 + (i & 63);
  } else return n;
}
template <int KIND>
DI void conv_weight(u16* dst, const float* src, int ldw, int ncount, int K, const float* gain, int gmask, int gtid, int gthreads) {
  const int total = ncount * (K >> 3);
  for (int it = gtid; it < total; it += gthreads) {
    const int n = it % ncount, kc = it / ncount;
    const int sc = colmap<KIND>(n);
    float v[8];
#pragma unroll
    for (int i = 0; i < 8; ++i) {
      const int k = kc * 8 + i;
      float x = (sc >= 0) ? src[(size_t)k * ldw + sc] : 0.f;
      if (gain) x *= gain[k & gmask];
      v[i] = x;
    }
    u4v o; o.x = pk2(v[0], v[1]); o.y = pk2(v[2], v[3]); o.z = pk2(v[4], v[5]); o.w = pk2(v[6], v[7]);
    *(u4v*)(dst + (size_t)n * K + kc * 8) = o;
  }
}

DI void phase0(const Params& p) {
  unsigned char* ws = p.ws;
  const int gtid = blockIdx.x * blockDim.x + threadIdx.x, gthreads = gridDim.x * blockDim.x;
  float* ssq = (float*)(ws + OFF_SSQ);
  for (int i = gtid; i < 3 * T + 256; i += gthreads) ssq[i] = 0.f;
  float* rope = (float*)(ws + OFF_ROPE);
  for (int i = gtid; i < 4096 * 16; i += gthreads) {
    const int pos = i >> 4, j = i & 15;
    const float ang = (float)pos * c_invfreq[j];
    float sn, cs; sincos_d((double)ang, sn, cs);
    rope[i] = cs; rope[65536 + i] = sn;
  }
  conv_weight<0>((u16*)(ws + OFF_WIN), p.w_in, DIN, NP, 1024, nullptr, 0, gtid, gthreads);
  u16* H = (u16*)(ws + OFF_H);
  const int lane = threadIdx.x & 63;
  const int gw = gtid >> 6, nw = gthreads >> 6;
  for (int row = gw; row < T; row += nw) {
    const f4v* xr = (const f4v*)(p.x + (size_t)row * 1024);
    f4v v[4];
    float ss = 0.f;
#pragma unroll
    for (int i = 0; i < 4; ++i) { v[i] = xr[lane * 4 + i]; ss += v[i].x * v[i].x + v[i].y * v[i].y + v[i].z * v[i].z + v[i].w * v[i].w; }
#pragma unroll
    for (int o = 32; o >= 1; o >>= 1) ss += __shfl_xor(ss, o);
    const float rs = rsqrtf(ss * (1.f / 1024.f) + EPS);
    const f4v* gp = (const f4v*)(p.g_pre);
    f4v g[4];
#pragma unroll
    for (int i = 0; i < 4; ++i) { g[i] = gp[lane * 4 + i]; v[i].x *= rs * g[i].x; v[i].y *= rs * g[i].y; v[i].z *= rs * g[i].z; v[i].w *= rs * g[i].w; }
    u4v* hr = (u4v*)(H + (size_t)row * 1024 + lane * 16);
    hr[0] = pk8(v[0], v[1]); hr[1] = pk8(v[2], v[3]);
  }
}

constexpr int TS = 128 * 72;
DI void gemm_ld(u4v (&ra)[4], u4v (&rb)[4], const u16* ga, const u16* gb, int lda, int ldb, int ko) {
#pragma unroll
  for (int i = 0; i < 4; ++i) { ra[i] = *(const u4v*)(ga + (size_t)(32 * i) * lda + ko); rb[i] = *(const u4v*)(gb + (size_t)(32 * i) * ldb + ko); }
}
DI void gemm_st(const u4v (&ra)[4], const u4v (&rb)[4], u16* buf, int lr, int lc) {
  u16* sa = buf; u16* sb = buf + TS;
#pragma unroll
  for (int i = 0; i < 4; ++i) { *(u4v*)(sa + (lr + 32 * i) * 72 + lc * 8) = ra[i]; *(u4v*)(sb + (lr + 32 * i) * 72 + lc * 8) = rb[i]; }
}
DI void gemm_mma(const u16* buf, f32x16 (&acc)[2][2], int wm, int wn, int r, int h) {
  const u16* sa = buf + (wm * 64 + r) * 72 + h * 8;
  const u16* sb = buf + TS + (wn * 64 + r) * 72 + h * 8;
#pragma unroll
  for (int ks = 0; ks < 4; ++ks) {
    const bf16x8 a0 = *(const bf16x8*)(sa + ks * 16);
    const bf16x8 a1 = *(const bf16x8*)(sa + 32 * 72 + ks * 16);
    const bf16x8 b0 = *(const bf16x8*)(sb + ks * 16);
    const bf16x8 b1 = *(const bf16x8*)(sb + 32 * 72 + ks * 16);
    acc[0][0] = MFMA(a0, b0, acc[0][0]);
    acc[0][1] = MFMA(a0, b1, acc[0][1]);
    acc[1][0] = MFMA(a1, b0, acc[1][0]);
    acc[1][1] = MFMA(a1, b1, acc[1][1]);
  }
}
DI void gemm_core(const u16* __restrict__ A, int lda, const u16* __restrict__ B, int ldb, int K, u16* lds, f32x16 (&acc)[2][2], int tid) {
  const int lane = tid & 63, w = tid >> 6, wm = w >> 1, wn = w & 1, r = lane & 31, h = lane >> 5;
  const int lc = tid & 7, lr = tid >> 3;
  const u16* ga = A + (size_t)lr * lda + lc * 8;
  const u16* gb = B + (size_t)lr * ldb + lc * 8;
  u4v ra0[4], rb0[4], ra1[4], rb1[4];
  gemm_ld(ra0, rb0, ga, gb, lda, ldb, 0);
  gemm_ld(ra1, rb1, ga, gb, lda, ldb, 64);
#pragma unroll
  for (int i = 0; i < 2; ++i)
#pragma unroll
    for (int j = 0; j < 2; ++j) acc[i][j] = zero16();
  u16* L0 = lds; u16* L1 = lds + 2 * TS;
  __syncthreads();
  gemm_st(ra0, rb0, L0, lr, lc);
  __syncthreads();
  const int nk = K >> 6;
  int kt = 0;
  for (; kt + 2 < nk; kt += 2) {
    gemm_ld(ra0, rb0, ga, gb, lda, ldb, (kt + 2) * 64);
    __builtin_amdgcn_sched_barrier(0);
    gemm_mma(L0, acc, wm, wn, r, h);
    gemm_st(ra1, rb1, L1, lr, lc);
    __syncthreads();
    gemm_ld(ra1, rb1, ga, gb, lda, ldb, (kt + 3) * 64);
    __builtin_amdgcn_sched_barrier(0);
    gemm_mma(L1, acc, wm, wn, r, h);
    gemm_st(ra0, rb0, L0, lr, lc);
    __syncthreads();
  }
  gemm_mma(L0, acc, wm, wn, r, h);
  gemm_st(ra1, rb1, L1, lr, lc);
  __syncthreads();
  gemm_mma(L1, acc, wm, wn, r, h);
  __syncthreads();
}

DI void stage_pass(const f32x16 (&acc)[2][2], float* stage, int p, int tid) {
  const int lane = tid & 63, w = tid >> 6, wm = w >> 1, wn = w & 1, r = lane & 31, h = lane >> 5;
  __syncthreads();
  if (wm == p) {
#pragma unroll
    for (int i = 0; i < 2; ++i)
#pragma unroll
      for (int j = 0; j < 2; ++j)
#pragma unroll
        for (int reg = 0; reg < 16; ++reg) stage[(i * 32 + crow(reg, h)) * SST + wn * 64 + j * 32 + r] = acc[i][j][reg];
  }
  __syncthreads();
}

namespace pg8 {
#define PG8_LAS __attribute__((address_space(3)))
typedef unsigned short bf16_t;
typedef short bf16x8 __attribute__((ext_vector_type(8)));
typedef float f32x4 __attribute__((ext_vector_type(4)));
typedef unsigned u32x4 __attribute__((ext_vector_type(4)));
constexpr int BM = 256, BK = 64, HALF = 128, HTB = HALF * BK * 2  , STAGE_BYTES = 8 * HTB, NXCD = 8, WGM = 8;

__host__ __device__ __forceinline__ int lds_byte(int r, int c) { const int st = (r >> 4) * 2 + (c >> 5), rr = r & 15, cc = c & 31, ob = rr * 64 + cc * 2; return st * 1024 + (ob ^ (((ob >> 9) & 1) << 5)); }
__host__ __device__ __forceinline__ void stage_rc(int b, int& R, int& C) { const int st = b / 1024, sb = b % 1024, swz = sb ^ (((sb >> 9) & 1) << 5); R = (st >> 1) * 16 + swz / 64; C = (st & 1) * 32 + (swz % 64) / 2; }
__host__ __device__ __forceinline__ int perm32(int rho) { const int n = rho >> 4, i = rho & 15; return 8 * (i >> 2) + 4 * n + (i & 3); }

struct Unit { int pm, pn; };
struct Gemm { const bf16_t* A; const bf16_t* Bt; int M, N, K; };

struct StaticOrder {
    int nM, nN, nwg, G, c;
    __host__ __device__ void init(int M, int N, int G_, int c_) { nM = M / BM; nN = N / BM; nwg = nM * nN; G = G_; c = c_; }
    __host__ __device__ bool next(int i, Unit& u) const {
        const long L = (long)i * G + c; if (L >= nwg) return false;
        int wgid = (int)L; { const int q = nwg / NXCD, r = nwg % NXCD, xcd = wgid % NXCD, off = wgid / NXCD; wgid = (xcd < r ? xcd * (q + 1) : r * (q + 1) + (xcd - r) * q) + off; }
        const int nig = WGM * nN, gid = wgid / nig, fm = gid * WGM, gsz = (nM - fm) < WGM ? (nM - fm) : WGM;
        u.pm = fm + ((wgid % nig) % gsz); u.pn = (wgid % nig) / gsz; return true;
    }
    __device__ __forceinline__ void a_ready(const Unit&) const {}
    __device__ __forceinline__ void done(const Unit&) const {}
};
template <class Epi, class Sched, bool STAMP = false, bool SWAP = false>
__device__ __forceinline__ void gemm_phase(PG8_LAS unsigned char* lds, const Gemm g, const Sched& S, const Epi& E, unsigned long long* stamps) {
    const int tid = threadIdx.x, wid = __builtin_amdgcn_readfirstlane(tid >> 6), lane = tid & 63, wr = wid >> 2, wc = wid & 3, fr = lane & 15, fq = lane >> 4;
    const int K = g.K, nt = K / BK;
    int ts_lo = 0, ts_hi = 0, nts = 0; const unsigned long long rt_entry = STAMP ? (unsigned long long)wall_clock64() : 0ull;
#define PG8_STAMP() do { if (STAMP && wid == 0 && nts < 64) { const unsigned long long _c = (unsigned long long)clock64(); \
        ts_lo = (lane == nts) ? (int)(unsigned)_c : ts_lo; ts_hi = (lane == nts) ? (int)(unsigned)(_c >> 32) : ts_hi; ++nts; } } while (0)
    PG8_STAMP();
    unsigned voffA[2], voffB[2];
#pragma unroll
    for (int i = 0; i < 2; ++i) { int R, C; stage_rc(tid * 16 + i * 8192, R, C); const int Rb = Epi::PERM ? ((R & ~31) + perm32(R & 31)) : R;
        voffA[i] = (unsigned)(R * K + C) * 2u; voffB[i] = (unsigned)(Rb * K + C) * 2u; }
    const size_t kstep = (size_t)(BK * 2);
    const size_t hstep = (size_t)HALF * K * 2;
    const size_t tstep = 2 * hstep;
    const unsigned ldsw = (unsigned)wid * 1024u;
    const int aoff = lds_byte(wr * 64 + fr, fq * 8), boff = lds_byte(wc * 32 + fr, fq * 8);
#define PG8_SA(b, h) (((b) * 2 + (h)) * HTB)
#define PG8_SB(b, h) ((4 + (b) * 2 + (h)) * HTB)
#define PG8_STAGE(bufoff, gbase, voff) do { _Pragma("unroll") for (int _i = 0; _i < 2; ++_i) \
        __builtin_amdgcn_global_load_lds((const unsigned*)((const char*)(gbase) + (voff)[_i]), (PG8_LAS unsigned*)(lds + (bufoff) + ldsw + _i * 8192), 16, 0, 0); } while (0)
#define PG8_LDA(dst, b, h) do { _Pragma("unroll") for (int m = 0; m < 4; ++m) _Pragma("unroll") for (int k = 0; k < 2; ++k) dst[m][k] = *(const PG8_LAS bf16x8*)(lds + PG8_SA(b, h) + aoff + m * 2048 + k * 1024); } while (0)
#define PG8_LDB(dst, b, h) do { _Pragma("unroll") for (int n = 0; n < 2; ++n) _Pragma("unroll") for (int k = 0; k < 2; ++k) dst[n][k] = *(const PG8_LAS bf16x8*)(lds + PG8_SB(b, h) + boff + n * 2048 + k * 1024); } while (0)
#define PG8_MMA(ai, bj, At, Bt) do { __builtin_amdgcn_s_setprio(1); _Pragma("unroll") for (int m = 0; m < 4; ++m) _Pragma("unroll") for (int n = 0; n < 2; ++n) _Pragma("unroll") for (int k = 0; k < 2; ++k) \
        acc[ai][bj][m][n] = SWAP ? __builtin_amdgcn_mfma_f32_16x16x32_bf16(At[m][k], Bt[n][k], acc[ai][bj][m][n], 0, 0, 0) : __builtin_amdgcn_mfma_f32_16x16x32_bf16(Bt[n][k], At[m][k], acc[ai][bj][m][n], 0, 0, 0); __builtin_amdgcn_s_setprio(0); } while (0)
#define PG8_WAIT_V(n) asm volatile("s_waitcnt vmcnt(" #n ")" ::: "memory")
#define PG8_WAIT_L(n) asm volatile("s_waitcnt lgkmcnt(" #n ")" ::: "memory")
#define PG8_BAR __builtin_amdgcn_s_barrier()
#define PG8_SCHED __builtin_amdgcn_sched_barrier(0)
    Unit cur, nxt; int ui = 0;
    if (!S.next(0, cur)) return;
    f32x4 acc[2][2][4][2];
#pragma unroll
    for (int a = 0; a < 2; ++a)
#pragma unroll
        for (int b = 0; b < 2; ++b)
#pragma unroll
            for (int m = 0; m < 4; ++m)
#pragma unroll
                for (int n = 0; n < 2; ++n) acc[a][b][m][n] = (f32x4){0.f, 0.f, 0.f, 0.f};
    bf16x8 At[4][2], B0[2][2], B1[2][2];
    const char* cA = (const char*)g.A + (size_t)cur.pm * tstep; const char* cB = (const char*)g.Bt + (size_t)cur.pn * tstep;
    S.a_ready(cur);
    PG8_STAGE(PG8_SB(0, 0), cB, voffB); PG8_STAGE(PG8_SA(0, 0), cA, voffA); PG8_STAGE(PG8_SB(0, 1), cB + hstep, voffB); PG8_STAGE(PG8_SA(0, 1), cA + hstep, voffA);
    if (wr == 1) PG8_BAR;
    PG8_WAIT_V(4); PG8_BAR;
    PG8_STAGE(PG8_SB(1, 0), cB + kstep, voffB); PG8_STAGE(PG8_SA(1, 0), cA + kstep, voffA); PG8_STAGE(PG8_SB(1, 1), cB + hstep + kstep, voffB);
    PG8_WAIT_V(6); PG8_BAR;
    PG8_STAMP();
    for (;;) {
        const bool has_next = S.next(ui + 1, nxt);
        const char* nA = has_next ? (const char*)g.A + (size_t)nxt.pm * tstep : cA; const char* nB = has_next ? (const char*)g.Bt + (size_t)nxt.pn * tstep : cB;
        for (int t = 0; t < nt; t += 2) {
            const bool last = (t == nt - 2);
            const char* a1 = cA + (size_t)(t + 1) * kstep;
            const char* a2 = last ? nA : cA + (size_t)(t + 2) * kstep; const char* b2 = last ? nB : cB + (size_t)(t + 2) * kstep;
            const char* a3 = a2 + kstep; const char* b3 = b2 + kstep;
            if (last && has_next) S.a_ready(nxt);
            PG8_LDB(B0, 0, 0); PG8_SCHED; PG8_LDA(At, 0, 0); PG8_STAGE(PG8_SA(1, 1), a1 + hstep, voffA);
            PG8_WAIT_L(8); PG8_BAR; PG8_WAIT_L(0); PG8_MMA(0, 0, At, B0); PG8_BAR; PG8_SCHED;
            PG8_LDB(B1, 0, 1); PG8_STAGE(PG8_SB(0, 0), b2, voffB);
            PG8_BAR; PG8_WAIT_L(0); PG8_MMA(0, 1, At, B1); PG8_BAR;
            PG8_LDA(At, 0, 1); PG8_STAGE(PG8_SA(0, 0), a2, voffA);
            PG8_BAR; PG8_WAIT_L(0); PG8_MMA(1, 0, At, B0); PG8_BAR; PG8_SCHED;
            PG8_STAGE(PG8_SB(0, 1), b2 + hstep, voffB);
            PG8_WAIT_V(6); PG8_BAR; PG8_MMA(1, 1, At, B1); PG8_BAR;
            PG8_LDB(B0, 1, 0); PG8_SCHED; PG8_LDA(At, 1, 0); PG8_STAGE(PG8_SA(0, 1), a2 + hstep, voffA);
            PG8_WAIT_L(8); PG8_BAR; PG8_WAIT_L(0); PG8_MMA(0, 0, At, B0); PG8_BAR; PG8_SCHED;
            PG8_LDB(B1, 1, 1); PG8_STAGE(PG8_SB(1, 0), b3, voffB);
            PG8_BAR; PG8_WAIT_L(0); PG8_MMA(0, 1, At, B1); PG8_BAR;
            PG8_LDA(At, 1, 1); PG8_STAGE(PG8_SA(1, 0), a3, voffA);
            PG8_BAR; PG8_WAIT_L(0); PG8_MMA(1, 0, At, B0); PG8_BAR; PG8_SCHED;
            PG8_STAGE(PG8_SB(1, 1), b3 + hstep, voffB);
            PG8_WAIT_V(6); PG8_BAR; PG8_MMA(1, 1, At, B1); PG8_BAR;
        }
        PG8_STAMP();
        if constexpr (!Epi::AFTER_DRAIN) { E(acc, cur, wr, wc, fr, fq); S.done(cur); }
        PG8_STAMP();
        if (!has_next) break;
#pragma unroll
        for (int a = 0; a < 2; ++a)
#pragma unroll
            for (int b = 0; b < 2; ++b)
#pragma unroll
                for (int m = 0; m < 4; ++m)
#pragma unroll
                    for (int n = 0; n < 2; ++n) acc[a][b][m][n] = (f32x4){0.f, 0.f, 0.f, 0.f};
        cur = nxt; cA = nA; cB = nB; ++ui;
    }
    PG8_WAIT_V(0);
    if (wr == 0) PG8_BAR;
    PG8_BAR;
    if constexpr (Epi::AFTER_DRAIN) { E.fused(acc, cur, wr, wc, fr, fq, lds, wid, lane); S.done(cur); }
    PG8_STAMP();
    if (STAMP && wid == 0) { stamps[lane] = lane < nts ? (((unsigned long long)(unsigned)ts_hi << 32) | (unsigned)ts_lo) : 0ull;
        if (lane == 62) stamps[62] = rt_entry; if (lane == 63) stamps[63] = (unsigned long long)wall_clock64(); }
#undef PG8_STAMP
#undef PG8_SA
#undef PG8_SB
#undef PG8_STAGE
#undef PG8_LDA
#undef PG8_LDB
#undef PG8_MMA
#undef PG8_WAIT_V
#undef PG8_WAIT_L
#undef PG8_BAR
#undef PG8_SCHED
}
}

struct Epi1 {
  static constexpr bool PERM = true, AFTER_DRAIN = false;
  unsigned char* ws; u16* mg; const float* b_gate; bool dup;
  DI void operator()(const pg8::f32x4 (&acc)[2][2][4][2], const pg8::Unit& u, int wr, int wc, int fr, int fq) const {
    const int pn = u.pn;
    const int rowb = u.pm * 256 + wr * 64 + fr;
    const int colu = wc * 32 + 8 * fq;
    if (pn < 4) {
      u16* dst = (pn < 3) ? (u16*)(ws + OFF_CQ) + pn * 256 : (u16*)(ws + OFF_CKV);
      const int ld = (pn < 3) ? 768 : 256;
      float* ssq = (float*)(ws + OFF_SSQ) + ((pn < 3) ? 0 : T);
#pragma unroll
      for (int ai = 0; ai < 2; ++ai)
#pragma unroll
        for (int m = 0; m < 4; ++m) {
          const int row = rowb + ai * 128 + m * 16;
          float ss = 0.f;
#pragma unroll
          for (int bj = 0; bj < 2; ++bj) {
            const pg8::f32x4 v0 = acc[ai][bj][m][0], v1 = acc[ai][bj][m][1];
            ss += v0[0] * v0[0] + v0[1] * v0[1] + v0[2] * v0[2] + v0[3] * v0[3] + v1[0] * v1[0] + v1[1] * v1[1] + v1[2] * v1[2] + v1[3] * v1[3];
            u4v o; o.x = pk2(v0[0], v0[1]); o.y = pk2(v0[2], v0[3]); o.z = pk2(v1[0], v1[1]); o.w = pk2(v1[2], v1[3]);
            *(u4v*)(dst + (size_t)row * ld + bj * 128 + colu) = o;
          }
          ss = xor16_add(ss); ss = xor32_add(ss);
          if (fq == 0 && !dup) atomicAdd(ssq + row, ss);
        }
    } else if (pn < 8) {
      u16* dst = (u16*)(ws + ((pn < 6) ? OFF_SGA : OFF_SGB)) + (pn & 1) * 256;
#pragma unroll
      for (int ai = 0; ai < 2; ++ai)
#pragma unroll
        for (int m = 0; m < 4; ++m) {
          const int row = rowb + ai * 128 + m * 16;
#pragma unroll
          for (int bj = 0; bj < 2; ++bj) {
            const pg8::f32x4 v0 = acc[ai][bj][m][0], v1 = acc[ai][bj][m][1];
            u4v o; o.x = pk2(siluf_(v0[0]), siluf_(v0[1])); o.y = pk2(siluf_(v0[2]), siluf_(v0[3]));
            o.z = pk2(siluf_(v1[0]), siluf_(v1[1])); o.w = pk2(siluf_(v1[2]), siluf_(v1[3]));
            *(u4v*)(dst + (size_t)row * 512 + bj * 128 + colu) = o;
          }
        }
    } else if (pn >= 16) {
      if (pn < 22) {
        u16* dst = (u16*)(ws + ((pn < 18) ? OFF_HQ : (pn < 20) ? OFF_HF : OFF_HI)) + (pn & 1) * 256;
#pragma unroll
        for (int ai = 0; ai < 2; ++ai)
#pragma unroll
          for (int m = 0; m < 4; ++m) {
            const int row = rowb + ai * 128 + m * 16;
#pragma unroll
            for (int bj = 0; bj < 2; ++bj) {
              const pg8::f32x4 v0 = acc[ai][bj][m][0], v1 = acc[ai][bj][m][1];
              u4v o; o.x = pk2(v0[0], v0[1]); o.y = pk2(v0[2], v0[3]); o.z = pk2(v1[0], v1[1]); o.w = pk2(v1[2], v1[3]);
              *(u4v*)(dst + (size_t)row * 512 + bj * 128 + colu) = o;
            }
          }
      } else if (colu < 32) {
        float* dst = (float*)(ws + OFF_KPE);
#pragma unroll
        for (int ai = 0; ai < 2; ++ai)
#pragma unroll
          for (int m = 0; m < 4; ++m) {
            const int row = rowb + ai * 128 + m * 16;
            *(pg8::f32x4*)(dst + (size_t)row * 32 + colu) = acc[ai][0][m][0];
            *(pg8::f32x4*)(dst + (size_t)row * 32 + colu + 4) = acc[ai][0][m][1];
          }
      }
    } else {
      const int cb = (pn - 8) * 256 + colu;
      f4v b0[2], b1[2];
#pragma unroll
      for (int bj = 0; bj < 2; ++bj) { b0[bj] = *(const f4v*)(b_gate + cb + bj * 128); b1[bj] = *(const f4v*)(b_gate + cb + bj * 128 + 4); }
#pragma unroll
      for (int ai = 0; ai < 2; ++ai)
#pragma unroll
        for (int m = 0; m < 4; ++m) {
          const int row = rowb + ai * 128 + m * 16;
#pragma unroll
          for (int bj = 0; bj < 2; ++bj) {
            const pg8::f32x4 v0 = acc[ai][bj][m][0], v1 = acc[ai][bj][m][1];
            u4v o; o.x = pk2(sigmoidf_(v0[0] + b0[bj].x), sigmoidf_(v0[1] + b0[bj].y)); o.y = pk2(sigmoidf_(v0[2] + b0[bj].z), sigmoidf_(v0[3] + b0[bj].w));
            o.z = pk2(sigmoidf_(v1[0] + b1[bj].x), sigmoidf_(v1[1] + b1[bj].y)); o.w = pk2(sigmoidf_(v1[2] + b1[bj].z), sigmoidf_(v1[3] + b1[bj].w));
            *(u4v*)(mg + ((((size_t)(u.pm * 8 + (pn - 8)) * 8 + (wr * 4 + wc)) * 16 + (ai * 8 + m * 2 + bj)) * 64 + (fq * 16 + fr)) * 8) = o;
          }
        }
    }
  }
};


struct Epi6 {
  static constexpr bool PERM = true, AFTER_DRAIN = false;
  u16* out; float* ssq; bool dup;
  DI void operator()(const pg8::f32x4 (&acc)[2][2][4][2], const pg8::Unit& u, int wr, int wc, int fr, int fq) const {
    const int rowb = u.pm * 256 + wr * 64 + fr;
    const int colb = u.pn * 256 + wc * 32 + 8 * fq;
#pragma unroll
    for (int ai = 0; ai < 2; ++ai)
#pragma unroll
      for (int m = 0; m < 4; ++m) {
        const int row = rowb + ai * 128 + m * 16;
        float ss = 0.f;
#pragma unroll
        for (int bj = 0; bj < 2; ++bj) {
          const pg8::f32x4 v0 = acc[ai][bj][m][0], v1 = acc[ai][bj][m][1];
          ss += v0[0] * v0[0] + v0[1] * v0[1] + v0[2] * v0[2] + v0[3] * v0[3] + v1[0] * v1[0] + v1[1] * v1[1] + v1[2] * v1[2] + v1[3] * v1[3];
          u4v o; o.x = pk2(v0[0], v0[1]); o.y = pk2(v0[2], v0[3]); o.z = pk2(v1[0], v1[1]); o.w = pk2(v1[2], v1[3]);
          *(u4v*)(out + (size_t)row * 1024 + colb + bj * 128) = o;
        }
        ss = xor16_add(ss); ss = xor32_add(ss);
        if (fq == 0 && !dup) atomicAdd(ssq + row, ss);
      }
  }
};
template <bool SECOND> struct Epi5 {
  static constexpr bool PERM = true, AFTER_DRAIN = false;
  const u16* mg; u16* mi; u16* mo;
  DI void operator()(const pg8::f32x4 (&acc)[2][2][4][2], const pg8::Unit& u, int wr, int wc, int fr, int fq) const {
    const int rowb = u.pm * 256 + wr * 64 + fr;
    const int colb = u.pn * 256 + wc * 32 + 8 * fq;
    const size_t gbase = (((size_t)(u.pm * 8 + u.pn + (SECOND ? 4 : 0)) * 8 + (wr * 4 + wc)) * 16) * 64 + (fq * 16 + fr);
    const size_t ibase = (((size_t)(u.pm * 4 + u.pn) * 8 + (wr * 4 + wc)) * 16) * 64 + (fq * 16 + fr);
#pragma unroll
    for (int hb = 0; hb < 4; ++hb) {
      const int ai = hb >> 1, m0 = (hb & 1) * 2;
      u4v g[4], pm[4];
#pragma unroll
      for (int f4 = 0; f4 < 4; ++f4) {
        const int f = ai * 8 + (m0 + (f4 >> 1)) * 2 + (f4 & 1);
        g[f4] = *(const u4v*)(mg + (gbase + (size_t)f * 64) * 8);
        if (SECOND) pm[f4] = *(const u4v*)(mi + (ibase + (size_t)f * 64) * 8);
      }
#pragma unroll
      for (int f4 = 0; f4 < 4; ++f4) {
        const int m = m0 + (f4 >> 1), bj = f4 & 1;
        const int row = rowb + ai * 128 + m * 16;
        const pg8::f32x4 v0 = acc[ai][bj][m][0], v1 = acc[ai][bj][m][1];
        float r0 = v0[0] * bflo(g[f4].x), r1 = v0[1] * bfhi(g[f4].x), r2 = v0[2] * bflo(g[f4].y), r3 = v0[3] * bfhi(g[f4].y);
        float r4 = v1[0] * bflo(g[f4].z), r5 = v1[1] * bfhi(g[f4].z), r6 = v1[2] * bflo(g[f4].w), r7 = v1[3] * bfhi(g[f4].w);
        if (SECOND) {
          r0 += bflo(pm[f4].x); r1 += bfhi(pm[f4].x); r2 += bflo(pm[f4].y); r3 += bfhi(pm[f4].y);
          r4 += bflo(pm[f4].z); r5 += bfhi(pm[f4].z); r6 += bflo(pm[f4].w); r7 += bfhi(pm[f4].w);
        }
        u4v o; o.x = pk2(r0, r1); o.y = pk2(r2, r3); o.z = pk2(r4, r5); o.w = pk2(r6, r7);
        if (SECOND) *(u4v*)(mo + (size_t)row * 1024 + colb + bj * 128) = o;
        else *(u4v*)(mi + (ibase + (size_t)(ai * 8 + m * 2 + bj) * 64) * 8) = o;
      }
      __builtin_amdgcn_sched_barrier(0);
    }
  }
};
struct EpiQ {
  static constexpr bool PERM = true, AFTER_DRAIN = false;
  const float* ssq_q; const float* rope; u16* Qo;
  DI void operator()(const pg8::f32x4 (&acc)[2][2][4][2], const pg8::Unit& u, int wr, int wc, int fr, int fq) const {
    const int rowb = u.pm * 256 + wr * 64 + fr;
    const int colu = wc * 32 + 8 * fq;
    float sq[8];
#pragma unroll
    for (int i = 0; i < 8; ++i) sq[i] = ssq_q[rowb + (i >> 2) * 128 + (i & 3) * 16];
    if (u.pn < 2) {
#pragma unroll
      for (int ai = 0; ai < 2; ++ai)
#pragma unroll
        for (int m = 0; m < 4; ++m) {
          const int row = rowb + ai * 128 + m * 16;
          const int b = row >> 12, spos = row & 4095;
          const float sc = rsqrtf(sq[ai * 4 + m] * (1.f / 768.f) + EPS) * QSCALE;
#pragma unroll
          for (int bj = 0; bj < 2; ++bj) {
            const pg8::f32x4 v0 = acc[ai][bj][m][0], v1 = acc[ai][bj][m][1];
            const int head = u.pn * 4 + bj * 2 + (colu >> 6), d = colu & 63;
            u4v o; o.x = pk2(v0[0] * sc, v0[1] * sc); o.y = pk2(v0[2] * sc, v0[3] * sc); o.z = pk2(v1[0] * sc, v1[1] * sc); o.w = pk2(v1[2] * sc, v1[3] * sc);
            *(u4v*)(Qo + ((size_t)(b * 8 + head) * 4096 + spos) * 96 + d) = o;
          }
        }
    } else {
#pragma unroll
      for (int ai = 0; ai < 2; ++ai) {
        f4v cs[4], sn[4];
#pragma unroll
        for (int i = 0; i < 4; ++i) {
          const int spos = (rowb + ai * 128 + i * 16) & 4095;
          cs[i] = *(const f4v*)(rope + spos * 16 + 4 * fq); sn[i] = *(const f4v*)(rope + 65536 + spos * 16 + 4 * fq);
        }
#pragma unroll
        for (int m = 0; m < 4; ++m) {
          const int row = rowb + ai * 128 + m * 16;
          const int b = row >> 12, spos = row & 4095;
          const float sc = rsqrtf(sq[ai * 4 + m] * (1.f / 768.f) + EPS) * QSCALE;
          const f4v c4 = cs[m], s4 = sn[m];
#pragma unroll
          for (int bj = 0; bj < 2; ++bj) {
            const pg8::f32x4 v0 = acc[ai][bj][m][0], v1 = acc[ai][bj][m][1];
            const int head = bj * 4 + wc;
            u2v o1, o2;
            o1.x = pk2((v0[0] * c4.x - v1[0] * s4.x) * sc, (v0[1] * c4.y - v1[1] * s4.y) * sc);
            o1.y = pk2((v0[2] * c4.z - v1[2] * s4.z) * sc, (v0[3] * c4.w - v1[3] * s4.w) * sc);
            o2.x = pk2((v0[0] * s4.x + v1[0] * c4.x) * sc, (v0[1] * s4.y + v1[1] * c4.y) * sc);
            o2.y = pk2((v0[2] * s4.z + v1[2] * c4.z) * sc, (v0[3] * s4.w + v1[3] * c4.w) * sc);
            u16* qp = Qo + ((size_t)(b * 8 + head) * 4096 + spos) * 96 + 64 + 4 * fq;
            *(u2v*)qp = o1; *(u2v*)(qp + 16) = o2;
          }
        }
        __builtin_amdgcn_sched_barrier(0);
      }
    }
  }
};

struct EpiK {
  static constexpr bool PERM = true, AFTER_DRAIN = false;
  const float* ssq_kv; u16* Ko;
  DI void operator()(const pg8::f32x4 (&acc)[2][2][4][2], const pg8::Unit& u, int wr, int wc, int fr, int fq) const {
    const int rowb = u.pm * 256 + wr * 64 + fr;
    float sq[8];
#pragma unroll
    for (int i = 0; i < 8; ++i) sq[i] = ssq_kv[rowb + (i >> 2) * 128 + (i & 3) * 16];
#pragma unroll
    for (int ai = 0; ai < 2; ++ai)
#pragma unroll
      for (int m = 0; m < 4; ++m) {
        const int row = rowb + ai * 128 + m * 16;
        const int b = row >> 12, spos = row & 4095;
        const float sc = rsqrtf(sq[ai * 4 + m] * (1.f / 256.f) + EPS);
#pragma unroll
        for (int bj = 0; bj < 2; ++bj) {
          const pg8::f32x4 v0 = acc[ai][bj][m][0], v1 = acc[ai][bj][m][1];
          const int col = u.pn * 256 + bj * 128 + wc * 32 + 8 * fq;
          const int head = col >> 6, d = col & 63;
          u4v o; o.x = pk2(v0[0] * sc, v0[1] * sc); o.y = pk2(v0[2] * sc, v0[3] * sc); o.z = pk2(v1[0] * sc, v1[1] * sc); o.w = pk2(v1[2] * sc, v1[3] * sc);
          *(u4v*)(Ko + ((size_t)(b * 8 + head) * 4096 + spos) * 96 + d) = o;
        }
      }
  }
};
struct EpiV {
  static constexpr bool PERM = false, AFTER_DRAIN = false;
  const float* ssq_kv; u16* Vo;
  DI void operator()(const pg8::f32x4 (&acc)[2][2][4][2], const pg8::Unit& u, int wr, int wc, int fr, int fq) const {
    f4v sq[8];
#pragma unroll
    for (int i = 0; i < 8; ++i) sq[i] = *(const f4v*)(ssq_kv + u.pm * 256 + (i >> 2) * 128 + wr * 64 + (i & 3) * 16 + 4 * fq);
#pragma unroll
    for (int ai = 0; ai < 2; ++ai)
#pragma unroll
      for (int m = 0; m < 4; ++m) {
        const int row4 = u.pm * 256 + ai * 128 + wr * 64 + m * 16 + 4 * fq;
        const int b = row4 >> 12, spos = row4 & 4095;
        const f4v q = sq[ai * 4 + m];
        const float s0 = rsqrtf(q.x * (1.f / 256.f) + EPS), s1 = rsqrtf(q.y * (1.f / 256.f) + EPS), s2 = rsqrtf(q.z * (1.f / 256.f) + EPS), s3 = rsqrtf(q.w * (1.f / 256.f) + EPS);
#pragma unroll
        for (int bj = 0; bj < 2; ++bj)
#pragma unroll
          for (int n = 0; n < 2; ++n) {
            const pg8::f32x4 v = acc[ai][bj][m][n];
            const int col = u.pn * 256 + bj * 128 + wc * 32 + n * 16 + fr;
            const int head = col >> 6, dv = col & 63;
            u2v o; o.x = pk2(v[0] * s0, v[1] * s1); o.y = pk2(v[2] * s2, v[3] * s3);
            *(u2v*)(Vo + ((size_t)(b * 8 + head) * 64 + dv) * 4096 + spos) = o;
          }
        __builtin_amdgcn_sched_barrier(0);
      }
  }
};
DI void phase1(const Params& p, unsigned char* smem, bool dup = false) {
  unsigned char* ws = p.ws;
  pg8::Gemm g{(const u16*)(ws + OFF_H), (const u16*)(ws + OFF_WIN), T, NP, 1024};
  pg8::StaticOrder S; S.init(T, NP, (int)gridDim.x, (int)blockIdx.x);
  Epi1 E{ws, (u16*)p.out, p.b_gate, dup};
  pg8::gemm_phase<Epi1, pg8::StaticOrder, false>((PG8_LAS unsigned char*)smem, g, S, E, nullptr);
  const int nlight = (int)gridDim.x / 2;
  if (!dup && (int)blockIdx.x >= (int)gridDim.x - nlight) {
    const int gtid = ((int)blockIdx.x - ((int)gridDim.x - nlight)) * (int)blockDim.x + (int)threadIdx.x, gthreads = nlight * (int)blockDim.x;
    conv_weight<1>((u16*)(ws + OFF_WUQ), p.w_uq, 768, 768, 768, p.g_q, 1023, gtid, gthreads);
    conv_weight<3>((u16*)(ws + OFF_WUKV), p.w_ukv, 1024, 1024, 256, p.g_kv, 255, gtid, gthreads);
    conv_weight<2>((u16*)(ws + OFF_WA), p.w_a, 1024, 1024, 512, nullptr, 0, gtid, gthreads);
    conv_weight<2>((u16*)(ws + OFF_WB), p.w_b, 1024, 1024, 512, p.g_hgrn, 63, gtid, gthreads);
    conv_weight<2>((u16*)(ws + OFF_WO), p.w_out, 1024, 1024, 1024, nullptr, 0, gtid, gthreads);
  }
}

DI void hgrn_prep_tile(const Params& p, float* stage, int tid, int b, int hh, int prow0, int nblk0) {
  unsigned char* ws = p.ws;
  const int bh = b * 8 + hh;
  if (tid < 128) {
    const int c = tid & 63, blk = tid >> 6;
    const float l0 = p.lb_logits[hh * 64 + c], l1 = p.lb_logits[512 + hh * 64 + c];
    const float lbv = 1.f / (1.f + expf(l1 - l0));
    float cum = 0.f;
    for (int rr = 0; rr < 32; ++rr) {
      float* sp = stage + (blk * 32 + rr) * SST + c;
      const float q = sp[0], hf = sp[64];
      const float sg = 1.f / (1.f + expf(-hf));
      const float f = lbv + (1.f - lbv) * sg;
      cum += logf(f);
      const float e = expf(cum);
      sp[0] = q * e;
      sp[64] = (1.f - f) / e;
    }
    ((float*)(ws + OFF_DECAY))[((size_t)bh * 128 + nblk0 + blk) * 64 + c] = expf(cum);
  }
  __syncthreads();
#pragma unroll
  for (int it = 0; it < 2; ++it) {
    const int item = tid + 256 * it, rr = item >> 3, cc = (item & 7) * 8;
    const f4v a = *(const f4v*)(stage + rr * SST + cc), c = *(const f4v*)(stage + rr * SST + cc + 4);
    const f4v d = *(const f4v*)(stage + rr * SST + 64 + cc), e = *(const f4v*)(stage + rr * SST + 64 + cc + 4);
    const size_t o = (size_t)(prow0 + rr) * 512 + hh * 64 + cc;
    *(u4v*)((u16*)(ws + OFF_QDEC) + o) = pk8(a, c);
    *(u4v*)((u16*)(ws + OFF_KINV) + o) = pk8(d, e);
  }
}
DI void hi_vt_tile(const Params& p, float* stage, int tid, int b, int q2, int nblk0) {
  unsigned char* ws = p.ws;
#pragma unroll
        for (int it = 0; it < 4; ++it) {
          const int item = tid + 256 * it, sc = item & 3, col = (item >> 2) & 127, blk = item >> 9;
          float v[8];
#pragma unroll
          for (int i = 0; i < 8; ++i) v[i] = stage[(blk * 32 + sc * 8 + i) * SST + col];
          u4v o; o.x = pk2(v[0], v[1]); o.y = pk2(v[2], v[3]); o.z = pk2(v[4], v[5]); o.w = pk2(v[6], v[7]);
          const int bh = b * 8 + q2 * 2 + (col >> 6);
          *(u4v*)((u16*)(ws + OFF_VT) + (((size_t)bh * 128 + nblk0 + blk) * 64 + (col & 63)) * 32 + sc * 8) = o;
        }
}
DI void stage_load64(float* stage, const u16* src, int coff, int tid) {
#pragma unroll
  for (int it = 0; it < 2; ++it) {
    const int item = tid + 256 * it, rr = item >> 3, ch = item & 7;
    const u4v v = *(const u4v*)(src + (size_t)rr * 512 + ch * 8);
    float* d = stage + rr * SST + coff + ch * 8;
    *(f4v*)d = f4v{bflo(v.x), bfhi(v.x), bflo(v.y), bfhi(v.y)};
    *(f4v*)(d + 4) = f4v{bflo(v.z), bfhi(v.z), bflo(v.w), bfhi(v.w)};
  }
}


constexpr int PST = 68;
DI void hgrn_prep_native(const Params& p, float* pl, int rb, int hh) {
  unsigned char* ws = p.ws;
  const int tid = threadIdx.x;
  float* Qp = pl; float* G = pl + 128 * PST; float* Kn = pl + 2 * 128 * PST;
  const int prow0 = rb * 128, b = prow0 >> 12, bh = b * 8 + hh, nblk0 = (prow0 & 4095) >> 5;
  const int ch = tid & 7;
  float lbv[8];
  {
    const f4v a0 = *(const f4v*)(p.lb_logits + hh * 64 + ch * 8), a1 = *(const f4v*)(p.lb_logits + hh * 64 + ch * 8 + 4);
    const f4v b0 = *(const f4v*)(p.lb_logits + 512 + hh * 64 + ch * 8), b1 = *(const f4v*)(p.lb_logits + 512 + hh * 64 + ch * 8 + 4);
    const float l0[8] = {a0.x, a0.y, a0.z, a0.w, a1.x, a1.y, a1.z, a1.w}, l1[8] = {b0.x, b0.y, b0.z, b0.w, b1.x, b1.y, b1.z, b1.w};
#pragma unroll
    for (int i = 0; i < 8; ++i) lbv[i] = 1.f / (1.f + expf(l1[i] - l0[i]));
  }
  __syncthreads();
#pragma unroll
  for (int it = 0; it < 2; ++it) {
    const int rr = (tid + 512 * it) >> 3;
    const size_t go = (size_t)(prow0 + rr) * 512 + hh * 64 + ch * 8;
    const u4v qv = *(const u4v*)((const u16*)(ws + OFF_HQ) + go), fv = *(const u4v*)((const u16*)(ws + OFF_HF) + go);
    const float q[8] = {bflo(qv.x), bfhi(qv.x), bflo(qv.y), bfhi(qv.y), bflo(qv.z), bfhi(qv.z), bflo(qv.w), bfhi(qv.w)};
    const float hf[8] = {bflo(fv.x), bfhi(fv.x), bflo(fv.y), bfhi(fv.y), bflo(fv.z), bfhi(fv.z), bflo(fv.w), bfhi(fv.w)};
    float g[8], kn[8];
#pragma unroll
    for (int i = 0; i < 8; ++i) {
      const float sg = rcpf(1.f + __builtin_amdgcn_exp2f(-1.4426950408889634f * hf[i]));
      const float f = lbv[i] + (1.f - lbv[i]) * sg;
      g[i] = __builtin_amdgcn_logf(f);
      kn[i] = 1.f - f;
    }
    float* d = Qp + rr * PST + ch * 8;
    *(f4v*)d = f4v{q[0], q[1], q[2], q[3]}; *(f4v*)(d + 4) = f4v{q[4], q[5], q[6], q[7]};
    d = G + rr * PST + ch * 8;
    *(f4v*)d = f4v{g[0], g[1], g[2], g[3]}; *(f4v*)(d + 4) = f4v{g[4], g[5], g[6], g[7]};
    d = Kn + rr * PST + ch * 8;
    *(f4v*)d = f4v{kn[0], kn[1], kn[2], kn[3]}; *(f4v*)(d + 4) = f4v{kn[4], kn[5], kn[6], kn[7]};
  }
  __syncthreads();
  if (tid < 256) {
    const int c = tid & 63, blk = tid >> 6;
    float* gp = G + (blk * 32) * PST + c;
    float v[32];
#pragma unroll
    for (int r2 = 0; r2 < 32; ++r2) v[r2] = gp[r2 * PST];
    float cum = 0.f;
#pragma unroll
    for (int r2 = 0; r2 < 32; ++r2) { cum += v[r2]; gp[r2 * PST] = cum; }
    ((float*)(ws + OFF_DECAY))[((size_t)bh * 128 + nblk0 + blk) * 64 + c] = __builtin_amdgcn_exp2f(cum);
  }
  __syncthreads();
#pragma unroll
  for (int it = 0; it < 2; ++it) {
    const int rr = (tid + 512 * it) >> 3;
    const float* s0 = Qp + rr * PST + ch * 8; const float* s1 = G + rr * PST + ch * 8; const float* s2 = Kn + rr * PST + ch * 8;
    const f4v q0 = *(const f4v*)s0, q1 = *(const f4v*)(s0 + 4), c0 = *(const f4v*)s1, c1 = *(const f4v*)(s1 + 4), k0 = *(const f4v*)s2, k1 = *(const f4v*)(s2 + 4);
    const float q[8] = {q0.x, q0.y, q0.z, q0.w, q1.x, q1.y, q1.z, q1.w}, cm[8] = {c0.x, c0.y, c0.z, c0.w, c1.x, c1.y, c1.z, c1.w}, kn[8] = {k0.x, k0.y, k0.z, k0.w, k1.x, k1.y, k1.z, k1.w};
    float qd[8], ki[8];
#pragma unroll
    for (int i = 0; i < 8; ++i) { qd[i] = q[i] * __builtin_amdgcn_exp2f(cm[i]); ki[i] = kn[i] * __builtin_amdgcn_exp2f(-cm[i]); }
    const size_t go = (size_t)(prow0 + rr) * 512 + hh * 64 + ch * 8;
    u4v o; o.x = pk2(qd[0], qd[1]); o.y = pk2(qd[2], qd[3]); o.z = pk2(qd[4], qd[5]); o.w = pk2(qd[6], qd[7]);
    *(u4v*)((u16*)(ws + OFF_QDEC) + go) = o;
    o.x = pk2(ki[0], ki[1]); o.y = pk2(ki[2], ki[3]); o.z = pk2(ki[4], ki[5]); o.w = pk2(ki[6], ki[7]);
    *(u4v*)((u16*)(ws + OFF_KINV) + go) = o;
  }
}
constexpr int VTS = 136;
DI void hi_vt_native(const Params& p, u16* img, int rb, int q2) {
  unsigned char* ws = p.ws;
  const int tid = threadIdx.x;
  const int prow0 = rb * 128, b = prow0 >> 12, nblk0 = (prow0 & 4095) >> 5;
  __syncthreads();
#pragma unroll
  for (int it = 0; it < 4; ++it) {
    const int item = tid + 512 * it, rr = item >> 4, c16 = item & 15;
    *(u4v*)(img + rr * VTS + c16 * 8) = *(const u4v*)((const u16*)(ws + OFF_HI) + (size_t)(prow0 + rr) * 512 + q2 * 128 + c16 * 8);
  }
  __syncthreads();
#pragma unroll
  for (int it = 0; it < 4; ++it) {
    const int item = tid + 512 * it, sc = item & 3, col = (item >> 2) & 127, blk = item >> 9;
    u32 w[4];
#pragma unroll
    for (int i = 0; i < 4; ++i) {
      const u32 lo = img[(blk * 32 + sc * 8 + 2 * i) * VTS + col], hi = img[(blk * 32 + sc * 8 + 2 * i + 1) * VTS + col];
      w[i] = lo | (hi << 16);
    }
    const int bh = b * 8 + q2 * 2 + (col >> 6);
    *(u4v*)((u16*)(ws + OFF_VT) + (((size_t)bh * 128 + nblk0 + blk) * 64 + (col & 63)) * 32 + sc * 8) = u4v{w[0], w[1], w[2], w[3]};
  }
}

DI void rope8(const float* x1, const float* x2, const float* rope, int spos, int j0, bool first, float scale, float (&o)[8]) {
  const f4v c0 = *(const f4v*)(rope + spos * 16 + j0), c1 = *(const f4v*)(rope + spos * 16 + j0 + 4);
  const f4v s0 = *(const f4v*)(rope + 65536 + spos * 16 + j0), s1 = *(const f4v*)(rope + 65536 + spos * 16 + j0 + 4);
  const float cs[8] = {c0.x, c0.y, c0.z, c0.w, c1.x, c1.y, c1.z, c1.w};
  const float sn[8] = {s0.x, s0.y, s0.z, s0.w, s1.x, s1.y, s1.z, s1.w};
#pragma unroll
  for (int i = 0; i < 8; ++i) o[i] = scale * (first ? (x1[i] * cs[i] - x2[i] * sn[i]) : (x1[i] * sn[i] + x2[i] * cs[i]));
}

DI void phase2(const Params& p, unsigned char* smem, u16* lds) {
  unsigned char* ws = p.ws;
  const int tid = VTID;
  float* stage = (float*)lds;
  const float* ssq_q = (const float*)(ws + OFF_SSQ);
  const float* ssq_kv = ssq_q + T;
  const float* rope = (const float*)(ws + OFF_ROPE);
  u16* Qo = (u16*)(ws + OFF_Q);
  u16* Ko = (u16*)(ws + OFF_K);
  u16* Vo = (u16*)(ws + OFF_VTT);
#pragma nounroll
  for (int rep = 0; rep < (DUP_PH == 21 ? p.ph_hi - 7 : 1); ++rep) {
    pg8::Gemm g{(const u16*)(ws + OFF_CQ), (const u16*)(ws + OFF_WUQ), T, 768, 768};
    pg8::StaticOrder S; S.init(T, 768, (int)gridDim.x, (int)blockIdx.x);
    EpiQ E{ssq_q, rope, Qo};
    pg8::gemm_phase<EpiQ, pg8::StaticOrder, false>((PG8_LAS unsigned char*)smem, g, S, E, nullptr);
  }
#pragma nounroll
  for (int rep = 0; rep < (DUP_PH == 23 ? p.ph_hi - 7 : 1); ++rep) {
    pg8::StaticOrder S; S.init(T, 512, (int)gridDim.x, (int)blockIdx.x);
    {
      int kk = 256; asm volatile("" : "+s"(kk));
      pg8::Gemm g{(const u16*)(ws + OFF_CKV), (const u16*)(ws + OFF_WUKV), T, 512, kk};
      EpiK E{ssq_kv, Ko};
      pg8::gemm_phase<EpiK, pg8::StaticOrder, false>((PG8_LAS unsigned char*)smem, g, S, E, nullptr);
    }
  }
  {
    pg8::StaticOrder S; S.init(T, 512, (int)gridDim.x, (int)blockIdx.x);
    int kk = 256; asm volatile("" : "+s"(kk));
    pg8::Gemm g{(const u16*)(ws + OFF_CKV), (const u16*)(ws + OFF_WUKV) + (size_t)512 * 256, T, 512, kk};
    EpiV E{(const float*)(ws + OFF_SSQ) + T, (u16*)(ws + OFF_VTT)};
    pg8::gemm_phase<EpiV, pg8::StaticOrder, false, true>((PG8_LAS unsigned char*)smem, g, S, E, nullptr);
  }
#pragma nounroll
  for (int rep = 0; rep < (DUP_PH == 22 ? p.ph_hi - 7 : 1); ++rep) {
    const int gtid = blockIdx.x * blockDim.x + threadIdx.x, gthreads = gridDim.x * blockDim.x;
    for (int idx = gtid; idx < T * 4; idx += gthreads) {
      const int tok = idx >> 2, wv = (idx & 3) * 8, j0 = wv & 15;
      const int b = tok >> 12, spos = tok & 4095;
      const float* kp = (const float*)(ws + OFF_KPE) + (size_t)tok * 32;
      const f4v a0 = *(const f4v*)(kp + j0), a1 = *(const f4v*)(kp + j0 + 4);
      const f4v b0 = *(const f4v*)(kp + 16 + j0), b1 = *(const f4v*)(kp + 16 + j0 + 4);
      const float x1[8] = {a0.x, a0.y, a0.z, a0.w, a1.x, a1.y, a1.z, a1.w};
      const float x2[8] = {b0.x, b0.y, b0.z, b0.w, b1.x, b1.y, b1.z, b1.w};
      float o[8];
      rope8(x1, x2, rope, spos, j0, wv < 16, 1.f, o);
      u4v ov; ov.x = pk2(o[0], o[1]); ov.y = pk2(o[2], o[3]); ov.z = pk2(o[4], o[5]); ov.w = pk2(o[6], o[7]);
#pragma unroll
      for (int head = 0; head < 8; ++head) *(u4v*)(Ko + ((size_t)(b * 8 + head) * 4096 + spos) * 96 + 64 + wv) = ov;
    }
  }
  for (int rep = 0; rep < (DUP_PH == 20 ? 2 : 1); ++rep)
  {
    const int G = (int)gridDim.x, c = (int)blockIdx.x, hG = G / 2, round = 2 * G + hG;
    for (int base = 0; base < 2048 + 1024; base += round) {
#pragma unroll 1
      for (int k = 0; k < 3; ++k) {
        if (k == 2 && c < G - hG) break;
        const int t = base + (k == 0 ? c : k == 1 ? G + c : 2 * G + (c - (G - hG)));
        if (t >= 2048 + 1024) break;
        if (t < 2048) hgrn_prep_native(p, (float*)smem, t >> 3, t & 7);
        else hi_vt_native(p, (u16*)smem, (t - 2048) >> 2, (t - 2048) & 3);
      }
    }
  }
}

DI void phase2b(const Params& p, unsigned char* smem) {
  unsigned char* ws = p.ws;
  const int tid = VTID;
}

constexpr int KST2 = 104, VST2 = 136;
constexpr int ATT_BUF2 = 128 * KST2 + 64 * VST2;
DI void att_qk(const u16* sk, const bf16x8 (&qf)[6], float nm, f32x16 (&st)[2]) {
#pragma unroll
  for (int i = 0; i < 16; ++i) { st[0][i] = nm; st[1][i] = nm; }
#pragma unroll
  for (int kb = 0; kb < 2; ++kb)
#pragma unroll
    for (int ks = 0; ks < 6; ++ks) {
      const bf16x8 kf = *(const bf16x8*)(sk + kb * 32 * KST2 + ks * 16);
      st[kb] = MFMA(kf, qf[ks], st[kb]);
    }
}
DI float att_softmax(f32x16 (&st)[2], float adj, bool adjnz, bool first, float& mref, float& l, f32x16 (&o)[2]) {
  float mx = st[0][0];
#pragma unroll
  for (int i = 1; i < 16; ++i) mx = fmaxf(mx, st[0][i]);
#pragma unroll
  for (int i = 0; i < 16; ++i) mx = fmaxf(mx, st[1][i]);
  mx = xor32_max(mx) - adj;
  f2v ps = f2v{0.f, 0.f};
  float shift_out = 0.f;
  if (first || adjnz || __builtin_amdgcn_ballot_w64(mx > 8.f) != 0ull) {
    const float shift = first ? mx : fmaxf(mx, 0.f);
    const float tot = adj + shift;
    const float alpha = first ? 0.f : __builtin_amdgcn_exp2f(-shift);
    mref += shift;
#pragma unroll
    for (int kb = 0; kb < 2; ++kb)
#pragma unroll
      for (int i = 0; i < 16; i += 2) {
        const float p0 = __builtin_amdgcn_exp2f(st[kb][i] - tot), p1 = __builtin_amdgcn_exp2f(st[kb][i + 1] - tot);
        st[kb][i] = p0; st[kb][i + 1] = p1; ps += f2v{p0, p1};
      }
    l = l * alpha + (ps.x + ps.y);
#pragma unroll
    for (int i = 0; i < 16; ++i) { o[0][i] *= alpha; o[1][i] *= alpha; }
    shift_out = shift;
  } else {
#pragma unroll
    for (int kb = 0; kb < 2; ++kb)
#pragma unroll
      for (int i = 0; i < 16; i += 2) {
        const float p0 = __builtin_amdgcn_exp2f(st[kb][i]), p1 = __builtin_amdgcn_exp2f(st[kb][i + 1]);
        st[kb][i] = p0; st[kb][i + 1] = p1; ps += f2v{p0, p1};
      }
    l += ps.x + ps.y;
  }
  return shift_out;
}
DI void att_pv(const u16* sv, const f32x16 (&st)[2], f32x16 (&o)[2]) {
#pragma unroll
  for (int s4 = 0; s4 < 4; ++s4) {
    const int kb = s4 >> 1, rb = 8 * (s4 & 1);
    u4v pu; pu.x = pk2(st[kb][rb], st[kb][rb + 1]); pu.y = pk2(st[kb][rb + 2], st[kb][rb + 3]);
    pu.z = pk2(st[kb][rb + 4], st[kb][rb + 5]); pu.w = pk2(st[kb][rb + 6], st[kb][rb + 7]);
    const bf16x8 pb = __builtin_bit_cast(bf16x8, pu);
#pragma unroll
    for (int db = 0; db < 2; ++db) {
      const s16x4 lo = *(const s16x4*)(sv + db * 32 * VST2 + 16 * s4);
      const s16x4 hi = *(const s16x4*)(sv + db * 32 * VST2 + 16 * s4 + 8);
      const bf16x8 vf = __builtin_shufflevector(lo, hi, 0, 1, 2, 3, 4, 5, 6, 7);
      o[db] = MFMA(vf, pb, o[db]);
    }
  }
}
DI void attn8_item(const Params& p, u16* lds, int bh, int qt) {
  unsigned char* ws = p.ws;
  const int tid = threadIdx.x, lane = tid & 63, w = tid >> 6, r = lane & 31, h = lane >> 5;
  const u16* Qp = (const u16*)(ws + OFF_Q) + (size_t)bh * 4096 * 96;
  const u16* Kp = (const u16*)(ws + OFF_K) + (size_t)bh * 4096 * 96;
  const u16* Vp = (const u16*)(ws + OFF_VTT) + (size_t)bh * 64 * 4096;
  const int q0 = qt * 256 + w * 32;
  bf16x8 qf[6];
#pragma unroll
  for (int ks = 0; ks < 6; ++ks) qf[ks] = *(const bf16x8*)(Qp + (size_t)(q0 + r) * 96 + ks * 16 + h * 8);
  f32x16 o[2]; o[0] = zero16(); o[1] = zero16();
  float mref = 0.f, l = 0.f;
  const int Jmax = 2 * qt + 1, jw = 4 * qt + (w >> 1);
  const u16* dsrc[6]; int dstep[6]; unsigned doff[6];
#pragma unroll
  for (int sl = 0; sl < 6; ++sl) {
    const int k = w + 8 * sl;
    if (k < 26) { const int c = 64 * k + lane, row = c / 13, col = c % 13; dsrc[sl] = Kp + (size_t)row * 96 + (col < 12 ? col : 11) * 8; dstep[sl] = 128 * 96; doff[sl] = (unsigned)k * 1024u; }
    else { const int c = 64 * (k - 26) + lane, row = c / 17, col = c % 17; dsrc[sl] = Vp + (size_t)row * 4096 + (col < 16 ? col : 15) * 8; dstep[sl] = 128; doff[sl] = 128u * KST2 * 2u + (unsigned)(k - 26) * 1024u; }
  }
  LAS unsigned char* ldsb = (LAS unsigned char*)lds;
#define ATT_DMA(BUF) do { _Pragma("unroll") for (int sl = 0; sl < 6; ++sl) if (w + 8 * sl < 43) { \
      __builtin_amdgcn_global_load_lds((const unsigned*)dsrc[sl], (LAS unsigned*)(ldsb + (BUF) * (ATT_BUF2 * 2) + doff[sl]), 16, 0, 0); dsrc[sl] += dstep[sl]; } } while (0)
  __syncthreads();
  ATT_DMA(0);
  __syncthreads();
  for (int J = 0; J <= Jmax; ++J) {
    const int cur = J & 1;
    if (J < Jmax) ATT_DMA(cur ^ 1);
    const u16* sk = lds + cur * ATT_BUF2 + r * KST2 + h * 8;
    const u16* sv = lds + cur * ATT_BUF2 + 128 * KST2 + r * VST2 + 4 * h;
    if (2 * J + 1 <= jw) {
      f32x16 s0[2], s1[2];
      const float nm = -mref;
      att_qk(sk, qf, nm, s0);
      att_qk(sk + 64 * KST2, qf, nm, s1);
      const float sh = att_softmax(s0, 0.f, false, J == 0, mref, l, o);
      const bool adjnz = __builtin_amdgcn_ballot_w64(sh != 0.f) != 0ull;
      att_pv(sv, s0, o);
      att_softmax(s1, sh, adjnz, false, mref, l, o);
      att_pv(sv + 64, s1, o);
    } else if (2 * J <= jw) {
      f32x16 s0[2];
      att_qk(sk, qf, -mref, s0);
      att_softmax(s0, 0.f, false, J == 0, mref, l, o);
      att_pv(sv, s0, o);
    }
    __syncthreads();
  }
#undef ATT_DMA
  l = xor32_add(l);
  const float inv = 1.f / l;
  const int b = bh >> 3, head = bh & 7;
  const size_t tok = (size_t)b * 4096 + q0 + r;
  const u16* sga = (const u16*)(ws + OFF_SGA) + tok * 512 + head * 64;
  u16* ya = (u16*)(ws + OFF_YA) + tok * 512 + head * 64;
#pragma unroll
  for (int db = 0; db < 2; ++db)
#pragma unroll
    for (int g = 0; g < 4; ++g) {
      const int dv0 = db * 32 + 8 * g + 4 * h;
      const u2v gt = *(const u2v*)(sga + dv0);
      u2v ov;
      ov.x = pk2(o[db][4 * g] * inv * bflo(gt.x), o[db][4 * g + 1] * inv * bfhi(gt.x));
      ov.y = pk2(o[db][4 * g + 2] * inv * bflo(gt.y), o[db][4 * g + 3] * inv * bfhi(gt.y));
      *(u2v*)(ya + dv0) = ov;
    }
}

DI void scan_item(const Params& p, int i, size_t out_off = OFF_UPD) {
  unsigned char* ws = p.ws;
  const int tid = threadIdx.x;
  const int bh = i >> 2, part = i & 3;
  const int e = part * 1024 + tid * 2, k = e & 63;
  u32* U = (u32*)((u16*)(ws + OFF_UPD) + (size_t)bh * 128 * 4096 + e);
  u32* UO = (u32*)((u16*)(ws + out_off) + (size_t)bh * 128 * 4096 + e);
  const f2v* Dc = (const f2v*)((const float*)(ws + OFF_DECAY) + (size_t)bh * 128 * 64 + k);
  float s0 = 0.f, s1 = 0.f;
  for (int n0 = 0; n0 < 128; n0 += 32) {
    u32 u[32]; f2v d[32];
#pragma unroll
    for (int q = 0; q < 32; ++q) { u[q] = U[(size_t)(n0 + q) * 2048]; d[q] = Dc[(n0 + q) * 32]; }
#pragma unroll
    for (int q = 0; q < 32; ++q) {
      UO[(size_t)(n0 + q) * 2048] = pk2(s0, s1);
      s0 = d[q].x * (s0 + bflo(u[q]));
      s1 = d[q].y * (s1 + bfhi(u[q]));
    }
  }
}

DI void hgrn_state_item(const Params& p, float* ub, int bh, int vb) {
  unsigned char* ws = p.ws;
  const int tid = threadIdx.x, lane = tid & 63, w = tid >> 6, r = lane & 31, h = lane >> 5;
  const int b = bh >> 3, head = bh & 7;
  const u16* kn_base = (const u16*)(ws + OFF_KINV) + ((size_t)b * 4096) * 512 + head * 64;
  const u16* vt_base = (const u16*)(ws + OFF_VT) + ((size_t)bh * 128) * 64 * 32;
  const float* dec = (const float*)(ws + OFF_DECAY) + (size_t)bh * 128 * 64;
  u16* up = (u16*)(ws + OFF_UPD) + (size_t)bh * 128 * 4096;
  const int vl = tid >> 4, k0 = (tid & 15) * 4;
  constexpr int KS = 68;
  f4v st = f4v{0.f, 0.f, 0.f, 0.f};
#pragma unroll 1
  for (int i = 0; i < 16; ++i) {
    const int n = i * 8 + w;
    bf16x8 a[2][2], bb[2];
    const u16* kn = kn_base + (size_t)(n * 32) * 512;
#pragma unroll
    for (int kb = 0; kb < 2; ++kb)
#pragma unroll
      for (int ks = 0; ks < 2; ++ks) {
        bf16x8 av;
#pragma unroll
        for (int j = 0; j < 8; ++j) av[j] = (short)kn[(size_t)(ks * 16 + h * 8 + j) * 512 + kb * 32 + r];
        a[kb][ks] = av;
      }
#pragma unroll
    for (int ks = 0; ks < 2; ++ks) bb[ks] = *(const bf16x8*)(vt_base + ((size_t)n * 64 + vb * 32 + r) * 32 + ks * 16 + h * 8);
    f4v d[8];
#pragma unroll
    for (int j = 0; j < 8; ++j) d[j] = *(const f4v*)(dec + (size_t)(i * 8 + j) * 64 + k0);
    __syncthreads();
#pragma unroll
    for (int kb = 0; kb < 2; ++kb) {
      f32x16 c = zero16();
      c = MFMA(a[kb][0], bb[0], c);
      c = MFMA(a[kb][1], bb[1], c);
#pragma unroll
      for (int g = 0; g < 4; ++g) *(f4v*)(ub + (w * 32 + r) * KS + kb * 32 + 8 * g + 4 * h) = f4v{c[4 * g], c[4 * g + 1], c[4 * g + 2], c[4 * g + 3]};
    }
    __syncthreads();
#pragma unroll
    for (int j = 0; j < 8; ++j) {
      const f4v u = *(const f4v*)(ub + (j * 32 + vl) * KS + k0);
      u2v o; o.x = pk2(st.x, st.y); o.y = pk2(st.z, st.w);
      *(u2v*)(up + (size_t)(i * 8 + j) * 4096 + (vb * 32 + vl) * 64 + k0) = o;
      st.x = d[j].x * (st.x + u.x); st.y = d[j].y * (st.y + u.y); st.z = d[j].z * (st.z + u.z); st.w = d[j].w * (st.w + u.w);
    }
  }
  asm volatile("s_waitcnt vmcnt(0)" ::: "memory");
  __syncthreads();
  if (threadIdx.x == 0) {
    __builtin_amdgcn_fence(__ATOMIC_RELEASE, "agent");
    asm volatile("s_waitcnt vmcnt(0)" ::: "memory");
    __hip_atomic_fetch_add((unsigned*)(ws + OFF_SSQ + (size_t)3 * T * 4) + 64 + bh, 1u, __ATOMIC_RELAXED, __HIP_MEMORY_SCOPE_AGENT);
  }
}

DI void h3_item(const Params& p, int t);
DI void phase3(const Params& p, unsigned char* smem, bool dup = false) {
  int* s_item = (int*)(smem + LDS_BYTES - 64);
  int* ctr = (int*)(p.ws + OFF_SSQ + (size_t)3 * T * 4) + (dup ? 1 : 0);
  unsigned* done = (unsigned*)(p.ws + OFF_SSQ + (size_t)3 * T * 4) + 64;
  if (!dup) for (int it = (int)blockIdx.x - ((int)gridDim.x - 128); it >= 0 && it < 128; it += 128 * 1024) hgrn_state_item(p, (float*)smem, it >> 1, it & 1);
  if (!dup && (int)gridDim.x < 128) for (int it = (int)blockIdx.x; it < 128; it += (int)gridDim.x) hgrn_state_item(p, (float*)smem, it >> 1, it & 1);
  for (;;) {
    __syncthreads();
    if (threadIdx.x == 0) *s_item = atomicAdd(ctr, 1);
    __syncthreads();
    const int item = *s_item;
    if (item >= 2048) break;
    int att = -1, h3 = -1;
    if (item < 256) att = item;
    else { const int j = item - 256, g = j / 7, pos = j % 7; if (pos == 0 || pos == 2 || pos == 4) att = 256 + 3 * g + (pos >> 1); else h3 = 4 * g + (pos == 1 ? 0 : pos == 3 ? 1 : pos == 5 ? 2 : 3); }
    if (att >= 0) attn8_item(p, (u16*)smem, att & 63, 15 - (att >> 6));
    else if (!dup) {
      const int bh = h3 >> 4;
      if (threadIdx.x == 0) {
        unsigned sp = 0;
        while (__hip_atomic_load(done + bh, __ATOMIC_RELAXED, __HIP_MEMORY_SCOPE_AGENT) < 2u) { __builtin_amdgcn_s_sleep(2); if (++sp > (1u << 22)) break; }
        __builtin_amdgcn_fence(__ATOMIC_ACQUIRE, "agent");
        asm volatile("s_waitcnt vmcnt(0)" ::: "memory");
      }
      __syncthreads();
      h3_item(p, 2 * h3 + (int)(threadIdx.x >> 8));
    }
  }
}

DI void h3_item(const Params& p, int t) {
  unsigned char* ws = p.ws;
  const int tid = VTID, lane = tid & 63, w = tid >> 6, r = lane & 31, h = lane >> 5;
  {
    const int bh = t >> 5, n = (t & 31) * 4 + w;
    const int b = bh >> 3, head = bh & 7;
    const size_t tok0 = (size_t)b * 4096 + n * 32;
    const u16* qd = (const u16*)(ws + OFF_QDEC) + (tok0 + r) * 512 + head * 64 + h * 8;
    const u16* ki = (const u16*)(ws + OFF_KINV) + (tok0 + r) * 512 + head * 64 + h * 8;
    const u16* vt = (const u16*)(ws + OFF_VT) + ((size_t)bh * 128 + n) * 64 * 32;
    const u16* sp = (const u16*)(ws + OFF_UPD) + ((size_t)bh * 128 + n) * 4096;
    bf16x8 qf[4], kf[4];
#pragma unroll
    for (int ks = 0; ks < 4; ++ks) { qf[ks] = *(const bf16x8*)(qd + ks * 16); kf[ks] = *(const bf16x8*)(ki + ks * 16); }
    f32x16 at = zero16();
#pragma unroll
    for (int ks = 0; ks < 4; ++ks) at = MFMA(kf[ks], qf[ks], at);
#pragma unroll
    for (int i = 0; i < 16; ++i) if (crow(i, h) > r) at[i] = 0.f;
    f32x16 o[2]; o[0] = zero16(); o[1] = zero16();
#pragma unroll
    for (int s2 = 0; s2 < 2; ++s2) {
      u4v pu; pu.x = pk2(at[8 * s2], at[8 * s2 + 1]); pu.y = pk2(at[8 * s2 + 2], at[8 * s2 + 3]);
      pu.z = pk2(at[8 * s2 + 4], at[8 * s2 + 5]); pu.w = pk2(at[8 * s2 + 6], at[8 * s2 + 7]);
      const bf16x8 pb = __builtin_bit_cast(bf16x8, pu);
#pragma unroll
      for (int vb = 0; vb < 2; ++vb) {
        const s16x4 lo = *(const s16x4*)(vt + (vb * 32 + r) * 32 + 16 * s2 + 4 * h);
        const s16x4 hi = *(const s16x4*)(vt + (vb * 32 + r) * 32 + 16 * s2 + 8 + 4 * h);
        const bf16x8 vf = __builtin_shufflevector(lo, hi, 0, 1, 2, 3, 4, 5, 6, 7);
        o[vb] = MFMA(vf, pb, o[vb]);
      }
    }
#pragma unroll
    for (int vb = 0; vb < 2; ++vb)
#pragma unroll
      for (int ks = 0; ks < 4; ++ks) {
        const bf16x8 sf = *(const bf16x8*)(sp + (vb * 32 + r) * 64 + ks * 16 + h * 8);
        o[vb] = MFMA(sf, qf[ks], o[vb]);
      }
    float ss = 0.f;
#pragma unroll
    for (int i = 0; i < 16; ++i) ss += o[0][i] * o[0][i] + o[1][i] * o[1][i];
    ss = xor32_add(ss);
    const float rs = rsqrtf(ss * (1.f / 64.f) + EPS);
    const u16* sgb = (const u16*)(ws + OFF_SGB) + (tok0 + r) * 512 + head * 64;
    u16* yb = (u16*)(ws + OFF_YB) + (tok0 + r) * 512 + head * 64;
#pragma unroll
    for (int vb = 0; vb < 2; ++vb)
#pragma unroll
      for (int g = 0; g < 4; ++g) {
        const int v0 = vb * 32 + 8 * g + 4 * h;
        const u2v gt = *(const u2v*)(sgb + v0);
        u2v ov;
        ov.x = pk2(o[vb][4 * g] * rs * bflo(gt.x), o[vb][4 * g + 1] * rs * bfhi(gt.x));
        ov.y = pk2(o[vb][4 * g + 2] * rs * bflo(gt.y), o[vb][4 * g + 3] * rs * bfhi(gt.y));
        *(u2v*)(yb + v0) = ov;
      }
  }
}

DI void phase5(const Params& p, unsigned char* smem) {
  unsigned char* ws = p.ws;
  pg8::StaticOrder S; S.init(T, 1024, (int)gridDim.x, (int)blockIdx.x);
  {
    pg8::Gemm g{(const u16*)(ws + OFF_YA), (const u16*)(ws + OFF_WA), T, 1024, 512};
    Epi5<false> E{(const u16*)p.out, (u16*)(ws + OFF_H), (u16*)(ws + OFF_M)};
    pg8::gemm_phase<Epi5<false>, pg8::StaticOrder, false>((PG8_LAS unsigned char*)smem, g, S, E, nullptr);
  }
  {
    pg8::Gemm g{(const u16*)(ws + OFF_YB), (const u16*)(ws + OFF_WB), T, 1024, 512};
    Epi5<true> E{(const u16*)p.out, (u16*)(ws + OFF_H), (u16*)(ws + OFF_M)};
    pg8::gemm_phase<Epi5<true>, pg8::StaticOrder, false>((PG8_LAS unsigned char*)smem, g, S, E, nullptr);
  }
}

DI void phase6(const Params& p, unsigned char* smem, bool dup = false) {
  unsigned char* ws = p.ws;
  pg8::Gemm g{(const u16*)(ws + OFF_M), (const u16*)(ws + OFF_WO), T, 1024, 1024};
  pg8::StaticOrder S; S.init(T, 1024, (int)gridDim.x, (int)blockIdx.x);
  Epi6 E{(u16*)(ws + OFF_H), (float*)(ws + OFF_SSQ) + 2 * T, dup};
  pg8::gemm_phase<Epi6, pg8::StaticOrder, false>((PG8_LAS unsigned char*)smem, g, S, E, nullptr);
}

DI void phase7(const Params& p) {
  const float* ssq_y = (const float*)(p.ws + OFF_SSQ) + 2 * T;
  const u2v* Y = (const u2v*)(p.ws + OFF_H);
  const int gtid = blockIdx.x * blockDim.x + threadIdx.x, gthreads = gridDim.x * blockDim.x;
  for (int i = gtid; i < T * 256; i += gthreads) {
    const int row = i >> 8, c4 = i & 255;
    const float rs = rsqrtf(ssq_y[row] * (1.f / 1024.f) + EPS);
    const u2v y = Y[i];
    const f4v xv = ((const f4v*)p.x)[i];
    const f4v g = ((const f4v*)p.g_post)[c4];
    f4v o;
    o.x = xv.x + bflo(y.x) * rs * g.x; o.y = xv.y + bfhi(y.x) * rs * g.y; o.z = xv.z + bflo(y.y) * rs * g.z; o.w = xv.w + bfhi(y.y) * rs * g.w;
    ((f4v*)p.out)[i] = o;
  }
}

__global__ void __launch_bounds__(512, 2) fwd_megakernel(Params p) {
  extern __shared__ __attribute__((aligned(16))) unsigned char smem[];
  u16* lds = (u16*)(smem + (threadIdx.x >> 8) * VLDS);
  cg::grid_group grid = cg::this_grid();
  volatile LAS unsigned* xst = (volatile LAS unsigned*)(smem + LDS_BYTES - 48);
  if (threadIdx.x == 0) { xst[0] = 0u; xst[1] = 0u; }
  __syncthreads();
  XcdBarrier xb = xcd_barrier_post((unsigned*)(p.ws + OFF_BAR), xst);
#define RUN_PHASE(N, CALL) if (p.ph_lo <= N && N < p.ph_hi) { if (N > p.ph_lo) xcd_barrier(xb); CALL; }
#define DUP_PHASE(N, CALL) if (DUP_PH == N) { xcd_barrier(xb); CALL; }
  RUN_PHASE(0, phase0(p))
  DUP_PHASE(0, phase0(p))
  if (p.ph_lo <= 1 && 1 < p.ph_hi) for (int rep = 0; rep < (DUP_PH == 1 ? 2 : 1); ++rep) { if (rep > 0 || 1 > p.ph_lo) xcd_barrier(xb); phase1(p, smem, rep > 0); }
  if (p.ph_lo <= 2 && 2 < p.ph_hi) for (int rep = 0; rep < (DUP_PH == 2 ? 2 : 1); ++rep) { if (rep > 0 || 2 > p.ph_lo) xcd_barrier(xb); phase2(p, smem, lds); }
  RUN_PHASE(4, phase3(p, smem))
  DUP_PHASE(4, phase3(p, smem, true))
  if (DUP_PH == 9) { xcd_barrier(xb); for (int i = blockIdx.x; i < 256; i += gridDim.x) scan_item(p, i, OFF_K); }
  RUN_PHASE(6, phase5(p, smem))
  DUP_PHASE(6, phase5(p, smem))
  RUN_PHASE(7, phase6(p, smem))
  DUP_PHASE(7, phase6(p, smem, true))
  RUN_PHASE(8, phase7(p))
  if (DUP_PH == 8) { xcd_barrier(xb); phase6(p, smem, true); xcd_barrier(xb); phase7(p); }
}

extern "C" void kernel_launch(void* const* d_in, const int* in_sizes, int n_in, void* d_out, int out_size, void* d_ws, size_t ws_size,
                              hipStream_t stream) {
  static int grid_blocks = 0;
  if (!grid_blocks) {
    int dev = 0, cus = 0, per_cu = 0;
    hipGetDevice(&dev);
    hipDeviceGetAttribute(&cus, hipDeviceAttributeMultiprocessorCount, dev);
    hipFuncSetAttribute((const void*)fwd_megakernel, hipFuncAttributeMaxDynamicSharedMemorySize, LDS_BYTES);
    hipOccupancyMaxActiveBlocksPerMultiprocessor(&per_cu, (const void*)fwd_megakernel, 512, LDS_BYTES);
    if (per_cu < 1) per_cu = 1;
    if (per_cu > 1) per_cu = 1;
    grid_blocks = cus * per_cu;
    if (ws_size < WS_NEED) fprintf(stderr, "kernel_launch: workspace too small: %zu < %zu\n", ws_size, (size_t)WS_NEED);
  }
  if (ws_size < WS_NEED) return;
  Params p{};
  p.x = (const float*)d_in[0]; p.g_pre = (const float*)d_in[1]; p.w_in = (const float*)d_in[2]; p.b_gate = (const float*)d_in[3];
  p.g_q = (const float*)d_in[4]; p.w_uq = (const float*)d_in[5]; p.g_kv = (const float*)d_in[6]; p.w_ukv = (const float*)d_in[7];
  p.lb_logits = (const float*)d_in[8]; p.g_hgrn = (const float*)d_in[9]; p.w_a = (const float*)d_in[10]; p.w_b = (const float*)d_in[11];
  p.w_out = (const float*)d_in[12]; p.g_post = (const float*)d_in[13];
  p.out = (float*)d_out; p.ws = (unsigned char*)d_ws;
#if ONE_LAUNCH
  p.ph_lo = 0; p.ph_hi = 9;
  (void)hipMemsetAsync((unsigned char*)d_ws + OFF_BAR, 0, 16384, stream);
  void* args[] = {&p};
  hipError_t e = hipLaunchCooperativeKernel((const void*)fwd_megakernel, dim3(grid_blocks), dim3(512), args, LDS_BYTES, stream);
  if (e != hipSuccess) fprintf(stderr, "cooperative launch failed: %s (grid %d)\n", hipGetErrorString(e), grid_blocks);
#else
  for (int ph = 0; ph < 9; ++ph) {
    p.ph_lo = ph; p.ph_hi = ph + 1;
    (void)hipMemsetAsync((unsigned char*)d_ws + OFF_BAR, 0, 16384, stream);
    void* args[] = {&p};
    hipError_t e = hipLaunchCooperativeKernel((const void*)fwd_megakernel, dim3(grid_blocks), dim3(512), args, LDS_BYTES, stream);
    if (e != hipSuccess) fprintf(stderr, "cooperative launch failed: %s (grid %d)\n", hipGetErrorString(e), grid_blocks);
  }
#endif
}
```

```cpp
#include <hip/hip_runtime.h>
#include <hip/hip_cooperative_groups.h>
#include <cstdio>
namespace cg = cooperative_groups;

#define DI __device__ __forceinline__
#define VTID ((int)(threadIdx.x & 255))
#define VBID ((int)(blockIdx.x * 2 + (threadIdx.x >> 8)))
#define VBN ((int)(gridDim.x * 2))
typedef unsigned short u16;
typedef unsigned int u32;
typedef __attribute__((ext_vector_type(8))) short bf16x8;
typedef __attribute__((ext_vector_type(4))) short s16x4;
typedef __attribute__((ext_vector_type(16))) float f32x16;
typedef __attribute__((ext_vector_type(2))) __bf16 bf2_t;
typedef __attribute__((ext_vector_type(2))) float f2_t;
typedef __attribute__((ext_vector_type(4))) unsigned int u4v;
typedef __attribute__((ext_vector_type(2))) unsigned int u2v;
typedef __attribute__((ext_vector_type(4))) float f4v;
typedef __attribute__((ext_vector_type(2))) float f2v;
#define MFMA(a, b, c) __builtin_amdgcn_mfma_f32_32x32x16_bf16((a), (b), (c), 0, 0, 0)

#ifndef DUP_PH
#define DUP_PH -1
#endif
#ifndef ONE_LAUNCH
#define ONE_LAUNCH 1
#endif

constexpr int T = 32768;
constexpr int SEQ = 4096;
constexpr int DIN = 5664;
constexpr int NP = 5888;
constexpr float EPS = 1e-6f;
constexpr float QSCALE = 1.4426950408889634f * 0.10206207261596575f;

constexpr size_t SZ_WIN = (size_t)NP * 1024 * 2;
constexpr size_t OFF_WIN = 0;
constexpr size_t OFF_WUQ = OFF_WIN + SZ_WIN;
constexpr size_t OFF_WUKV = OFF_WUQ + (size_t)768 * 768 * 2;
constexpr size_t OFF_WA = OFF_WUKV + (size_t)1024 * 256 * 2;
constexpr size_t OFF_WB = OFF_WA + (size_t)1024 * 512 * 2;
constexpr size_t OFF_WO = OFF_WB + (size_t)1024 * 512 * 2;
constexpr size_t OFF_ROPE = OFF_WO + (size_t)1024 * 1024 * 2;
constexpr size_t OFF_SSQ = OFF_ROPE + (size_t)4096 * 16 * 2 * 4;
constexpr size_t OFF_DECAY = OFF_SSQ + (size_t)(3 * T + 256) * 4;
constexpr size_t OFF_H = OFF_DECAY + (size_t)64 * 128 * 64 * 4;
constexpr size_t OFF_Q = OFF_H;
constexpr size_t OFF_CQ = OFF_H + (size_t)T * 1024 * 2;
constexpr size_t OFF_YA = OFF_CQ;
constexpr size_t OFF_CKV = OFF_CQ + (size_t)T * 768 * 2;
constexpr size_t OFF_KPE = OFF_CKV + (size_t)T * 256 * 2;
constexpr size_t OFF_SGA = OFF_KPE + (size_t)T * 32 * 4;
constexpr size_t OFF_SGB = OFF_SGA + (size_t)T * 512 * 2;
constexpr size_t OFF_HQ = OFF_SGB + (size_t)T * 512 * 2;
constexpr size_t OFF_UPD = OFF_HQ;
constexpr size_t OFF_HF = OFF_HQ + (size_t)T * 512 * 2;
constexpr size_t OFF_HI = OFF_HF + (size_t)T * 512 * 2;
constexpr size_t OFF_YB = OFF_HI;
constexpr size_t OFF_QDEC = OFF_HI + (size_t)T * 512 * 2;
constexpr size_t OFF_KINV = OFF_QDEC + (size_t)T * 512 * 2;
constexpr size_t OFF_VT = OFF_KINV + (size_t)T * 512 * 2;
constexpr size_t OFF_K = OFF_VT + (size_t)T * 512 * 2;
constexpr size_t OFF_M = OFF_K;
constexpr size_t OFF_VTT = OFF_K + (size_t)T * 768 * 2;
constexpr size_t OFF_BAR = OFF_VTT + (size_t)T * 512 * 2;
constexpr size_t WS_NEED = OFF_BAR + 16384;

constexpr int VLDS = 2 * 2 * 128 * 72 * 2;
constexpr int LDS_BYTES = 2 * VLDS + 64;
constexpr int SST = 132;

struct Params {
  const float *x, *g_pre, *w_in, *b_gate, *g_q, *w_uq, *g_kv, *w_ukv, *lb_logits, *g_hgrn, *w_a, *w_b, *w_out, *g_post;
  float* out;
  unsigned char* ws;
  int ph_lo, ph_hi;
};

DI u32 pk2(float a, float b) { f2_t v = {a, b}; bf2_t r = __builtin_convertvector(v, bf2_t); return __builtin_bit_cast(u32, r); }
DI float bflo(u32 u) { return __uint_as_float(u << 16); }
DI float bfhi(u32 u) { return __uint_as_float(u & 0xffff0000u); }
DI u4v pk8(f4v a, f4v b) { u4v r; r.x = pk2(a.x, a.y); r.y = pk2(a.z, a.w); r.z = pk2(b.x, b.y); r.w = pk2(b.z, b.w); return r; }
DI float rcpf(float x) { return __builtin_amdgcn_rcpf(x); }
DI float sigmoidf_(float x) { return rcpf(1.f + __expf(-x)); }
DI float siluf_(float x) { return x * sigmoidf_(x); }
DI float xor32_max(float x) { const unsigned u = __float_as_uint(x); auto r = __builtin_amdgcn_permlane32_swap(u, u, false, false); return fmaxf(__uint_as_float(r[0]), __uint_as_float(r[1])); }
DI float xor32_add(float x) { const unsigned u = __float_as_uint(x); auto r = __builtin_amdgcn_permlane32_swap(u, u, false, false); return __uint_as_float(r[0]) + __uint_as_float(r[1]); }
DI float xor16_add(float x) { const unsigned u = __float_as_uint(x); auto r = __builtin_amdgcn_permlane16_swap(u, u, false, false); return __uint_as_float(r[0]) + __uint_as_float(r[1]); }
DI int crow(int reg, int h) { return (reg & 3) + 8 * (reg >> 2) + 4 * h; }
DI f32x16 zero16() { f32x16 z;
#pragma unroll
  for (int i = 0; i < 16; ++i) z[i] = 0.f; return z; }

__constant__ float c_invfreq[16] = {1.0f, 0.5623413324356079f, 0.3162277638912201f, 0.17782793939113617f, 0.10000000149011612f,
  0.05623413249850273f, 0.03162277489900589f, 0.017782794311642647f, 0.009999999776482582f, 0.005623413249850273f,
  0.003162277629598975f, 0.0017782794311642647f, 0.0010000000474974513f, 0.000562341301701963f, 0.0003162277571391314f,
  0.00017782794020604342f};

DI void sincos_d(double a, float& sn, float& cs) {
  const double k = rint(a * 0.63661977236758134308);
  const double y = a - k * 1.57079632679489661923;
  const double y2 = y * y;
  const double s = y * (1.0 + y2 * (-1.0 / 6 + y2 * (1.0 / 120 + y2 * (-1.0 / 5040 + y2 * (1.0 / 362880 + y2 * (-1.0 / 39916800 + y2 * (1.0 / 6227020800.0)))))));
  const double c = 1.0 + y2 * (-0.5 + y2 * (1.0 / 24 + y2 * (-1.0 / 720 + y2 * (1.0 / 40320 + y2 * (-1.0 / 3628800 + y2 * (1.0 / 479001600.0 + y2 * (-1.0 / 87178291200.0)))))));
  const int q = ((int)k) & 3;
  const double ss = (q == 0) ? s : (q == 1) ? c : (q == 2) ? -s : -c;
  const double cc = (q == 0) ? c : (q == 1) ? -s : (q == 2) ? -c : s;
  sn = (float)ss; cs = (float)cc;
}

#define XB_TMO      128
#define XB_XCNT(j)  (256  + 64 * (j))
#define XB_XSUB(j)  (1280 + 64 * (j))
#define XB_XGEN(j)  (2304 + 64 * (j))
#define XB_TOP      3328
#define XB_TOPGEN   3392
#define XCD_BAR_WORDS 3456
#define XB_SPIN_CAP (1u << 22)
#define LAS __attribute__((address_space(3)))
DI unsigned xb_ld(unsigned* p)              { return __hip_atomic_load(p, __ATOMIC_RELAXED, __HIP_MEMORY_SCOPE_AGENT); }
DI unsigned xb_add(unsigned* p, unsigned v) { return __hip_atomic_fetch_add(p, v, __ATOMIC_RELAXED, __HIP_MEMORY_SCOPE_AGENT); }
DI unsigned xb_xcc_id() { return (unsigned)__builtin_amdgcn_s_getreg((3 << 11) | 20) & 0xFu; }
#define XB_SPIN(cond, bar) do { unsigned _sp = 0; while (cond) { __builtin_amdgcn_s_sleep(1); \
    if ((++_sp & 255u) == 0u) { if (xb_ld(&(bar)[XB_TMO])) break; if (_sp > XB_SPIN_CAP) { atomicAdd(&(bar)[XB_TMO], 1u); break; } } } } while (0)
struct XcdBarrier { unsigned* bar; unsigned x; volatile LAS unsigned* st; };
DI XcdBarrier xcd_barrier_post(unsigned* bar, volatile LAS unsigned* st) {
  XcdBarrier b; b.bar = bar; b.x = xb_xcc_id(); b.st = st;
  if (threadIdx.x == 0) (void)xb_add(&bar[XB_XCNT(b.x)], 1u);
  return b;
}
DI void xcd_barrier_complete(unsigned* bar, unsigned x, unsigned& nloc, unsigned& nx) {
  const unsigned G = gridDim.x * gridDim.y * gridDim.z;
  unsigned sum, cnt, mine, sp = 0u;
  for (;;) {
    sum = 0u; cnt = 0u; mine = 0u;
#pragma unroll
    for (unsigned j = 0; j < 16; ++j) { const unsigned c = xb_ld(&bar[XB_XCNT(j)]); sum += c; cnt += (c > 0u) ? 1u : 0u; mine = (j == x) ? c : mine; }
    if (sum == G) break;
    __builtin_amdgcn_s_sleep(1);
    if ((++sp & 255u) == 0u) { if (xb_ld(&bar[XB_TMO])) break; if (sp > XB_SPIN_CAP) { atomicAdd(&bar[XB_TMO], 1u); break; } }
  }
  nloc = mine > 0u ? mine : 1u; nx = cnt > 0u ? cnt : 1u;
}
DI void xcd_barrier(const XcdBarrier& b) {
  asm volatile("s_waitcnt vmcnt(0)" ::: "memory");
  __syncthreads();
  if (threadIdx.x == 0) {
    unsigned* bar = b.bar;
    __builtin_amdgcn_s_waitcnt(0);
    unsigned nloc = b.st[0], nx = b.st[1];
    if (nloc == 0u) { xcd_barrier_complete(bar, b.x, nloc, nx); b.st[0] = nloc; b.st[1] = nx; }
    const unsigned old = xb_add(&bar[XB_XSUB(b.x)], 1u);
    const unsigned gen = old / nloc;
    if (old + 1u == (gen + 1u) * nloc) {
      __builtin_amdgcn_fence(__ATOMIC_RELEASE, "agent");
      asm volatile("s_waitcnt vmcnt(0)" ::: "memory");
      const unsigned og = xb_add(&bar[XB_TOP], 1u);
      const unsigned tg = og / nx;
      if (og + 1u == (tg + 1u) * nx) xb_add(&bar[XB_TOPGEN], 1u);
      else XB_SPIN(xb_ld(&bar[XB_TOPGEN]) == tg, bar);
      __builtin_amdgcn_fence(__ATOMIC_ACQUIRE, "agent");
      xb_add(&bar[XB_XGEN(b.x)], 1u);
      asm volatile("s_waitcnt vmcnt(0)" ::: "memory");
    } else {
      XB_SPIN(xb_ld(&bar[XB_XGEN(b.x)]) == gen, bar);
      __builtin_amdgcn_fence(__ATOMIC_ACQUIRE, "agent");
      asm volatile("s_waitcnt vmcnt(0)" ::: "memory");
    }
  }
  __syncthreads();
}

template <int KIND>
DI int colmap(int n) {
  if (KIND == 0) {
    if (n < 1024) return n;
    if (n < 1536) return 1056 + (n - 1024);
    if (n < 2048) return 3104 + (n - 1536);
    if (n < 4096) return 3616 + (n - 2048);
    if (n < 4608) return 1568 + (n - 4096);
    if (n < 5120) return 2080 + (n - 4608);
    if (n < 5632) return 2592 + (n - 5120);
    if (n < 5664) return 1024 + (n - 5632);
    return -1;
  } else if (KIND == 1) {
    if (n < 512) return (n >> 6) * 96 + (n & 63);
    int i = n - 512; int w = i & 31, g = w >> 3, e = w & 7; return (i >> 5) * 96 + 64 + ((e < 4) ? (4 * g + e) : (16 + 4 * g + (e - 4)));
  } else if (KIND == 3) {
    if (n < 512) return (n >> 6) * 128 + (n & 63);
    int i = n - 512; return (i >> 6) * 128 + 64 + (i & 63);
  } else return n;
}
template <int KIND>
DI void conv_weight(u16* dst, const float* src, int ldw, int ncount, int K, const float* gain, int gmask, int gtid, int gthreads) {
  const int total = ncount * (K >> 3);
  for (int it = gtid; it < total; it += gthreads) {
    const int n = it % ncount, kc = it / ncount;
    const int sc = colmap<KIND>(n);
    float v[8];
#pragma unroll
    for (int i = 0; i < 8; ++i) {
      const int k = kc * 8 + i;
      float x = (sc >= 0) ? src[(size_t)k * ldw + sc] : 0.f;
      if (gain) x *= gain[k & gmask];
      v[i] = x;
    }
    u4v o; o.x = pk2(v[0], v[1]); o.y = pk2(v[2], v[3]); o.z = pk2(v[4], v[5]); o.w = pk2(v[6], v[7]);
    *(u4v*)(dst + (size_t)n * K + kc * 8) = o;
  }
}

DI void phase0(const Params& p) {
  unsigned char* ws = p.ws;
  const int gtid = blockIdx.x * blockDim.x + threadIdx.x, gthreads = gridDim.x * blockDim.x;
  float* ssq = (float*)(ws + OFF_SSQ);
  for (int i = gtid; i < 3 * T + 256; i += gthreads) ssq[i] = 0.f;
  float* rope = (float*)(ws + OFF_ROPE);
  for (int i = gtid; i < 4096 * 16; i += gthreads) {
    const int pos = i >> 4, j = i & 15;
    const float ang = (float)pos * c_invfreq[j];
    float sn, cs; sincos_d((double)ang, sn, cs);
    rope[i] = cs; rope[65536 + i] = sn;
  }
  conv_weight<0>((u16*)(ws + OFF_WIN), p.w_in, DIN, NP, 1024, nullptr, 0, gtid, gthreads);
  u16* H = (u16*)(ws + OFF_H);
  const int lane = threadIdx.x & 63;
  const int gw = gtid >> 6, nw = gthreads >> 6;
  for (int row = gw; row < T; row += nw) {
    const f4v* xr = (const f4v*)(p.x + (size_t)row * 1024);
    f4v v[4];
    float ss = 0.f;
#pragma unroll
    for (int i = 0; i < 4; ++i) { v[i] = xr[lane * 4 + i]; ss += v[i].x * v[i].x + v[i].y * v[i].y + v[i].z * v[i].z + v[i].w * v[i].w; }
#pragma unroll
    for (int o = 32; o >= 1; o >>= 1) ss += __shfl_xor(ss, o);
    const float rs = rsqrtf(ss * (1.f / 1024.f) + EPS);
    const f4v* gp = (const f4v*)(p.g_pre);
    f4v g[4];
#pragma unroll
    for (int i = 0; i < 4; ++i) { g[i] = gp[lane * 4 + i]; v[i].x *= rs * g[i].x; v[i].y *= rs * g[i].y; v[i].z *= rs * g[i].z; v[i].w *= rs * g[i].w; }
    u4v* hr = (u4v*)(H + (size_t)row * 1024 + lane * 16);
    hr[0] = pk8(v[0], v[1]); hr[1] = pk8(v[2], v[3]);
  }
}

constexpr int TS = 128 * 72;
DI void gemm_ld(u4v (&ra)[4], u4v (&rb)[4], const u16* ga, const u16* gb, int lda, int ldb, int ko) {
#pragma unroll
  for (int i = 0; i < 4; ++i) { ra[i] = *(const u4v*)(ga + (size_t)(32 * i) * lda + ko); rb[i] = *(const u4v*)(gb + (size_t)(32 * i) * ldb + ko); }
}
DI void gemm_st(const u4v (&ra)[4], const u4v (&rb)[4], u16* buf, int lr, int lc) {
  u16* sa = buf; u16* sb = buf + TS;
#pragma unroll
  for (int i = 0; i < 4; ++i) { *(u4v*)(sa + (lr + 32 * i) * 72 + lc * 8) = ra[i]; *(u4v*)(sb + (lr + 32 * i) * 72 + lc * 8) = rb[i]; }
}
DI void gemm_mma(const u16* buf, f32x16 (&acc)[2][2], int wm, int wn, int r, int h) {
  const u16* sa = buf + (wm * 64 + r) * 72 + h * 8;
  const u16* sb = buf + TS + (wn * 64 + r) * 72 + h * 8;
#pragma unroll
  for (int ks = 0; ks < 4; ++ks) {
    const bf16x8 a0 = *(const bf16x8*)(sa + ks * 16);
    const bf16x8 a1 = *(const bf16x8*)(sa + 32 * 72 + ks * 16);
    const bf16x8 b0 = *(const bf16x8*)(sb + ks * 16);
    const bf16x8 b1 = *(const bf16x8*)(sb + 32 * 72 + ks * 16);
    acc[0][0] = MFMA(a0, b0, acc[0][0]);
    acc[0][1] = MFMA(a0, b1, acc[0][1]);
    acc[1][0] = MFMA(a1, b0, acc[1][0]);
    acc[1][1] = MFMA(a1, b1, acc[1][1]);
  }
}
DI void gemm_core(const u16* __restrict__ A, int lda, const u16* __restrict__ B, int ldb, int K, u16* lds, f32x16 (&acc)[2][2], int tid) {
  const int lane = tid & 63, w = tid >> 6, wm = w >> 1, wn = w & 1, r = lane & 31, h = lane >> 5;
  const int lc = tid & 7, lr = tid >> 3;
  const u16* ga = A + (size_t)lr * lda + lc * 8;
  const u16* gb = B + (size_t)lr * ldb + lc * 8;
  u4v ra0[4], rb0[4], ra1[4], rb1[4];
  gemm_ld(ra0, rb0, ga, gb, lda, ldb, 0);
  gemm_ld(ra1, rb1, ga, gb, lda, ldb, 64);
#pragma unroll
  for (int i = 0; i < 2; ++i)
#pragma unroll
    for (int j = 0; j < 2; ++j) acc[i][j] = zero16();
  u16* L0 = lds; u16* L1 = lds + 2 * TS;
  __syncthreads();
  gemm_st(ra0, rb0, L0, lr, lc);
  __syncthreads();
  const int nk = K >> 6;
  int kt = 0;
  for (; kt + 2 < nk; kt += 2) {
    gemm_ld(ra0, rb0, ga, gb, lda, ldb, (kt + 2) * 64);
    __builtin_amdgcn_sched_barrier(0);
    gemm_mma(L0, acc, wm, wn, r, h);
    gemm_st(ra1, rb1, L1, lr, lc);
    __syncthreads();
    gemm_ld(ra1, rb1, ga, gb, lda, ldb, (kt + 3) * 64);
    __builtin_amdgcn_sched_barrier(0);
    gemm_mma(L1, acc, wm, wn, r, h);
    gemm_st(ra0, rb0, L0, lr, lc);
    __syncthreads();
  }
  gemm_mma(L0, acc, wm, wn, r, h);
  gemm_st(ra1, rb1, L1, lr, lc);
  __syncthreads();
  gemm_mma(L1, acc, wm, wn, r, h);
  __syncthreads();
}

DI void stage_pass(const f32x16 (&acc)[2][2], float* stage, int p, int tid) {
  const int lane = tid & 63, w = tid >> 6, wm = w >> 1, wn = w & 1, r = lane & 31, h = lane >> 5;
  __syncthreads();
  if (wm == p) {
#pragma unroll
    for (int i = 0; i < 2; ++i)
#pragma unroll
      for (int j = 0; j < 2; ++j)
#pragma unroll
        for (int reg = 0; reg < 16; ++reg) stage[(i * 32 + crow(reg, h)) * SST + wn * 64 + j * 32 + r] = acc[i][j][reg];
  }
  __syncthreads();
}

namespace pg8 {
#define PG8_LAS __attribute__((address_space(3)))
typedef unsigned short bf16_t;
typedef short bf16x8 __attribute__((ext_vector_type(8)));
typedef float f32x4 __attribute__((ext_vector_type(4)));
typedef unsigned u32x4 __attribute__((ext_vector_type(4)));
constexpr int BM = 256, BK = 64, HALF = 128, HTB = HALF * BK * 2  , STAGE_BYTES = 8 * HTB, NXCD = 8, WGM = 8;

__host__ __device__ __forceinline__ int lds_byte(int r, int c) { const int st = (r >> 4) * 2 + (c >> 5), rr = r & 15, cc = c & 31, ob = rr * 64 + cc * 2; return st * 1024 + (ob ^ (((ob >> 9) & 1) << 5)); }
__host__ __device__ __forceinline__ void stage_rc(int b, int& R, int& C) { const int st = b / 1024, sb = b % 1024, swz = sb ^ (((sb >> 9) & 1) << 5); R = (st >> 1) * 16 + swz / 64; C = (st & 1) * 32 + (swz % 64) / 2; }
__host__ __device__ __forceinline__ int perm32(int rho) { const int n = rho >> 4, i = rho & 15; return 8 * (i >> 2) + 4 * n + (i & 3); }

struct Unit { int pm, pn; };
struct Gemm { const bf16_t* A; const bf16_t* Bt; int M, N, K; };

struct StaticOrder {
    int nM, nN, nwg, G, c;
    __host__ __device__ void init(int M, int N, int G_, int c_) { nM = M / BM; nN = N / BM; nwg = nM * nN; G = G_; c = c_; }
    __host__ __device__ bool next(int i, Unit& u) const {
        const long L = (long)i * G + c; if (L >= nwg) return false;
        int wgid = (int)L; { const int q = nwg / NXCD, r = nwg % NXCD, xcd = wgid % NXCD, off = wgid / NXCD; wgid = (xcd < r ? xcd * (q + 1) : r * (q + 1) + (xcd - r) * q) + off; }
        const int nig = WGM * nN, gid = wgid / nig, fm = gid * WGM, gsz = (nM - fm) < WGM ? (nM - fm) : WGM;
        u.pm = fm + ((wgid % nig) % gsz); u.pn = (wgid % nig) / gsz; return true;
    }
    __device__ __forceinline__ void a_ready(const Unit&) const {}
    __device__ __forceinline__ void done(const Unit&) const {}
};
template <class Epi, class Sched, bool STAMP = false, bool SWAP = false>
__device__ __forceinline__ void gemm_phase(PG8_LAS unsigned char* lds, const Gemm g, const Sched& S, const Epi& E, unsigned long long* stamps) {
    const int tid = threadIdx.x, wid = __builtin_amdgcn_readfirstlane(tid >> 6), lane = tid & 63, wr = wid >> 2, wc = wid & 3, fr = lane & 15, fq = lane >> 4;
    const int K = g.K, nt = K / BK;
    int ts_lo = 0, ts_hi = 0, nts = 0; const unsigned long long rt_entry = STAMP ? (unsigned long long)wall_clock64() : 0ull;
#define PG8_STAMP() do { if (STAMP && wid == 0 && nts < 64) { const unsigned long long _c = (unsigned long long)clock64(); \
        ts_lo = (lane == nts) ? (int)(unsigned)_c : ts_lo; ts_hi = (lane == nts) ? (int)(unsigned)(_c >> 32) : ts_hi; ++nts; } } while (0)
    PG8_STAMP();
    unsigned voffA[2], voffB[2];
#pragma unroll
    for (int i = 0; i < 2; ++i) { int R, C; stage_rc(tid * 16 + i * 8192, R, C); const int Rb = Epi::PERM ? ((R & ~31) + perm32(R & 31)) : R;
        voffA[i] = (unsigned)(R * K + C) * 2u; voffB[i] = (unsigned)(Rb * K + C) * 2u; }
    const size_t kstep = (size_t)(BK * 2);
    const size_t hstep = (size_t)HALF * K * 2;
    const size_t tstep = 2 * hstep;
    const unsigned ldsw = (unsigned)wid * 1024u;
    const int aoff = lds_byte(wr * 64 + fr, fq * 8), boff = lds_byte(wc * 32 + fr, fq * 8);
#define PG8_SA(b, h) (((b) * 2 + (h)) * HTB)
#define PG8_SB(b, h) ((4 + (b) * 2 + (h)) * HTB)
#define PG8_STAGE(bufoff, gbase, voff) do { _Pragma("unroll") for (int _i = 0; _i < 2; ++_i) \
        __builtin_amdgcn_global_load_lds((const unsigned*)((const char*)(gbase) + (voff)[_i]), (PG8_LAS unsigned*)(lds + (bufoff) + ldsw + _i * 8192), 16, 0, 0); } while (0)
#define PG8_LDA(dst, b, h) do { _Pragma("unroll") for (int m = 0; m < 4; ++m) _Pragma("unroll") for (int k = 0; k < 2; ++k) dst[m][k] = *(const PG8_LAS bf16x8*)(lds + PG8_SA(b, h) + aoff + m * 2048 + k * 1024); } while (0)
#define PG8_LDB(dst, b, h) do { _Pragma("unroll") for (int n = 0; n < 2; ++n) _Pragma("unroll") for (int k = 0; k < 2; ++k) dst[n][k] = *(const PG8_LAS bf16x8*)(lds + PG8_SB(b, h) + boff + n * 2048 + k * 1024); } while (0)
#define PG8_MMA(ai, bj, At, Bt) do { __builtin_amdgcn_s_setprio(1); _Pragma("unroll") for (int m = 0; m < 4; ++m) _Pragma("unroll") for (int n = 0; n < 2; ++n) _Pragma("unroll") for (int k = 0; k < 2; ++k) \
        acc[ai][bj][m][n] = SWAP ? __builtin_amdgcn_mfma_f32_16x16x32_bf16(At[m][k], Bt[n][k], acc[ai][bj][m][n], 0, 0, 0) : __builtin_amdgcn_mfma_f32_16x16x32_bf16(Bt[n][k], At[m][k], acc[ai][bj][m][n], 0, 0, 0); __builtin_amdgcn_s_setprio(0); } while (0)
#define PG8_WAIT_V(n) asm volatile("s_waitcnt vmcnt(" #n ")" ::: "memory")
#define PG8_WAIT_L(n) asm volatile("s_waitcnt lgkmcnt(" #n ")" ::: "memory")
#define PG8_BAR __builtin_amdgcn_s_barrier()
#define PG8_SCHED __builtin_amdgcn_sched_barrier(0)
    Unit cur, nxt; int ui = 0;
    if (!S.next(0, cur)) return;
    f32x4 acc[2][2][4][2];
#pragma unroll
    for (int a = 0; a < 2; ++a)
#pragma unroll
        for (int b = 0; b < 2; ++b)
#pragma unroll
            for (int m = 0; m < 4; ++m)
#pragma unroll
                for (int n = 0; n < 2; ++n) acc[a][b][m][n] = (f32x4){0.f, 0.f, 0.f, 0.f};
    bf16x8 At[4][2], B0[2][2], B1[2][2];
    const char* cA = (const char*)g.A + (size_t)cur.pm * tstep; const char* cB = (const char*)g.Bt + (size_t)cur.pn * tstep;
    S.a_ready(cur);
    PG8_STAGE(PG8_SB(0, 0), cB, voffB); PG8_STAGE(PG8_SA(0, 0), cA, voffA); PG8_STAGE(PG8_SB(0, 1), cB + hstep, voffB); PG8_STAGE(PG8_SA(0, 1), cA + hstep, voffA);
    if (wr == 1) PG8_BAR;
    PG8_WAIT_V(4); PG8_BAR;
    PG8_STAGE(PG8_SB(1, 0), cB + kstep, voffB); PG8_STAGE(PG8_SA(1, 0), cA + kstep, voffA); PG8_STAGE(PG8_SB(1, 1), cB + hstep + kstep, voffB);
    PG8_WAIT_V(6); PG8_BAR;
    PG8_STAMP();
    for (;;) {
        const bool has_next = S.next(ui + 1, nxt);
        const char* nA = has_next ? (const char*)g.A + (size_t)nxt.pm * tstep : cA; const char* nB = has_next ? (const char*)g.Bt + (size_t)nxt.pn * tstep : cB;
        for (int t = 0; t < nt; t += 2) {
            const bool last = (t == nt - 2);
            const char* a1 = cA + (size_t)(t + 1) * kstep;
            const char* a2 = last ? nA : cA + (size_t)(t + 2) * kstep; const char* b2 = last ? nB : cB + (size_t)(t + 2) * kstep;
            const char* a3 = a2 + kstep; const char* b3 = b2 + kstep;
            if (last && has_next) S.a_ready(nxt);
            PG8_LDB(B0, 0, 0); PG8_SCHED; PG8_LDA(At, 0, 0); PG8_STAGE(PG8_SA(1, 1), a1 + hstep, voffA);
            PG8_WAIT_L(8); PG8_BAR; PG8_WAIT_L(0); PG8_MMA(0, 0, At, B0); PG8_BAR; PG8_SCHED;
            PG8_LDB(B1, 0, 1); PG8_STAGE(PG8_SB(0, 0), b2, voffB);
            PG8_BAR; PG8_WAIT_L(0); PG8_MMA(0, 1, At, B1); PG8_BAR;
            PG8_LDA(At, 0, 1); PG8_STAGE(PG8_SA(0, 0), a2, voffA);
            PG8_BAR; PG8_WAIT_L(0); PG8_MMA(1, 0, At, B0); PG8_BAR; PG8_SCHED;
            PG8_STAGE(PG8_SB(0, 1), b2 + hstep, voffB);
            PG8_WAIT_V(6); PG8_BAR; PG8_MMA(1, 1, At, B1); PG8_BAR;
            PG8_LDB(B0, 1, 0); PG8_SCHED; PG8_LDA(At, 1, 0); PG8_STAGE(PG8_SA(0, 1), a2 + hstep, voffA);
            PG8_WAIT_L(8); PG8_BAR; PG8_WAIT_L(0); PG8_MMA(0, 0, At, B0); PG8_BAR; PG8_SCHED;
            PG8_LDB(B1, 1, 1); PG8_STAGE(PG8_SB(1, 0), b3, voffB);
            PG8_BAR; PG8_WAIT_L(0); PG8_MMA(0, 1, At, B1); PG8_BAR;
            PG8_LDA(At, 1, 1); PG8_STAGE(PG8_SA(1, 0), a3, voffA);
            PG8_BAR; PG8_WAIT_L(0); PG8_MMA(1, 0, At, B0); PG8_BAR; PG8_SCHED;
            PG8_STAGE(PG8_SB(1, 1), b3 + hstep, voffB);
            PG8_WAIT_V(6); PG8_BAR; PG8_MMA(1, 1, At, B1); PG8_BAR;
        }
        PG8_STAMP();
        if constexpr (!Epi::AFTER_DRAIN) { E(acc, cur, wr, wc, fr, fq); S.done(cur); }
        PG8_STAMP();
        if (!has_next) break;
#pragma unroll
        for (int a = 0; a < 2; ++a)
#pragma unroll
            for (int b = 0; b < 2; ++b)
#pragma unroll
                for (int m = 0; m < 4; ++m)
#pragma unroll
                    for (int n = 0; n < 2; ++n) acc[a][b][m][n] = (f32x4){0.f, 0.f, 0.f, 0.f};
        cur = nxt; cA = nA; cB = nB; ++ui;
    }
    PG8_WAIT_V(0);
    if (wr == 0) PG8_BAR;
    PG8_BAR;
    if constexpr (Epi::AFTER_DRAIN) { E.fused(acc, cur, wr, wc, fr, fq, lds, wid, lane); S.done(cur); }
    PG8_STAMP();
    if (STAMP && wid == 0) { stamps[lane] = lane < nts ? (((unsigned long long)(unsigned)ts_hi << 32) | (unsigned)ts_lo) : 0ull;
        if (lane == 62) stamps[62] = rt_entry; if (lane == 63) stamps[63] = (unsigned long long)wall_clock64(); }
#undef PG8_STAMP
#undef PG8_SA
#undef PG8_SB
#undef PG8_STAGE
#undef PG8_LDA
#undef PG8_LDB
#undef PG8_MMA
#undef PG8_WAIT_V
#undef PG8_WAIT_L
#undef PG8_BAR
#undef PG8_SCHED
}
}

struct Epi1 {
  static constexpr bool PERM = true, AFTER_DRAIN = false;
  unsigned char* ws; u16* mg; const float* b_gate; bool dup;
  DI void operator()(const pg8::f32x4 (&acc)[2][2][4][2], const pg8::Unit& u, int wr, int wc, int fr, int fq) const {
    const int pn = u.pn;
    const int rowb = u.pm * 256 + wr * 64 + fr;
    const int colu = wc * 32 + 8 * fq;
    if (pn < 4) {
      u16* dst = (pn < 3) ? (u16*)(ws + OFF_CQ) + pn * 256 : (u16*)(ws + OFF_CKV);
      const int ld = (pn < 3) ? 768 : 256;
      float* ssq = (float*)(ws + OFF_SSQ) + ((pn < 3) ? 0 : T);
#pragma unroll
      for (int ai = 0; ai < 2; ++ai)
#pragma unroll
        for (int m = 0; m < 4; ++m) {
          const int row = rowb + ai * 128 + m * 16;
          float ss = 0.f;
#pragma unroll
          for (int bj = 0; bj < 2; ++bj) {
            const pg8::f32x4 v0 = acc[ai][bj][m][0], v1 = acc[ai][bj][m][1];
            ss += v0[0] * v0[0] + v0[1] * v0[1] + v0[2] * v0[2] + v0[3] * v0[3] + v1[0] * v1[0] + v1[1] * v1[1] + v1[2] * v1[2] + v1[3] * v1[3];
            u4v o; o.x = pk2(v0[0], v0[1]); o.y = pk2(v0[2], v0[3]); o.z = pk2(v1[0], v1[1]); o.w = pk2(v1[2], v1[3]);
            *(u4v*)(dst + (size_t)row * ld + bj * 128 + colu) = o;
          }
          ss = xor16_add(ss); ss = xor32_add(ss);
          if (fq == 0 && !dup) atomicAdd(ssq + row, ss);
        }
    } else if (pn < 8) {
      u16* dst = (u16*)(ws + ((pn < 6) ? OFF_SGA : OFF_SGB)) + (pn & 1) * 256;
#pragma unroll
      for (int ai = 0; ai < 2; ++ai)
#pragma unroll
        for (int m = 0; m < 4; ++m) {
          const int row = rowb + ai * 128 + m * 16;
#pragma unroll
          for (int bj = 0; bj < 2; ++bj) {
            const pg8::f32x4 v0 = acc[ai][bj][m][0], v1 = acc[ai][bj][m][1];
            u4v o; o.x = pk2(siluf_(v0[0]), siluf_(v0[1])); o.y = pk2(siluf_(v0[2]), siluf_(v0[3]));
            o.z = pk2(siluf_(v1[0]), siluf_(v1[1])); o.w = pk2(siluf_(v1[2]), siluf_(v1[3]));
            *(u4v*)(dst + (size_t)row * 512 + bj * 128 + colu) = o;
          }
        }
    } else if (pn >= 16) {
      if (pn < 22) {
        u16* dst = (u16*)(ws + ((pn < 18) ? OFF_HQ : (pn < 20) ? OFF_HF : OFF_HI)) + (pn & 1) * 256;
#pragma unroll
        for (int ai = 0; ai < 2; ++ai)
#pragma unroll
          for (int m = 0; m < 4; ++m) {
            const int row = rowb + ai * 128 + m * 16;
#pragma unroll
            for (int bj = 0; bj < 2; ++bj) {
              const pg8::f32x4 v0 = acc[ai][bj][m][0], v1 = acc[ai][bj][m][1];
              u4v o; o.x = pk2(v0[0], v0[1]); o.y = pk2(v0[2], v0[3]); o.z = pk2(v1[0], v1[1]); o.w = pk2(v1[2], v1[3]);
              *(u4v*)(dst + (size_t)row * 512 + bj * 128 + colu) = o;
            }
          }
      } else if (colu < 32) {
        float* dst = (float*)(ws + OFF_KPE);
#pragma unroll
        for (int ai = 0; ai < 2; ++ai)
#pragma unroll
          for (int m = 0; m < 4; ++m) {
            const int row = rowb + ai * 128 + m * 16;
            *(pg8::f32x4*)(dst + (size_t)row * 32 + colu) = acc[ai][0][m][0];
            *(pg8::f32x4*)(dst + (size_t)row * 32 + colu + 4) = acc[ai][0][m][1];
          }
      }
    } else {
      const int cb = (pn - 8) * 256 + colu;
      f4v b0[2], b1[2];
#pragma unroll
      for (int bj = 0; bj < 2; ++bj) { b0[bj] = *(const f4v*)(b_gate + cb + bj * 128); b1[bj] = *(const f4v*)(b_gate + cb + bj * 128 + 4); }
#pragma unroll
      for (int ai = 0; ai < 2; ++ai)
#pragma unroll
        for (int m = 0; m < 4; ++m) {
          const int row = rowb + ai * 128 + m * 16;
#pragma unroll
          for (int bj = 0; bj < 2; ++bj) {
            const pg8::f32x4 v0 = acc[ai][bj][m][0], v1 = acc[ai][bj][m][1];
            u4v o; o.x = pk2(sigmoidf_(v0[0] + b0[bj].x), sigmoidf_(v0[1] + b0[bj].y)); o.y = pk2(sigmoidf_(v0[2] + b0[bj].z), sigmoidf_(v0[3] + b0[bj].w));
            o.z = pk2(sigmoidf_(v1[0] + b1[bj].x), sigmoidf_(v1[1] + b1[bj].y)); o.w = pk2(sigmoidf_(v1[2] + b1[bj].z), sigmoidf_(v1[3] + b1[bj].w));
            *(u4v*)(mg + ((((size_t)(u.pm * 8 + (pn - 8)) * 8 + (wr * 4 + wc)) * 16 + (ai * 8 + m * 2 + bj)) * 64 + (fq * 16 + fr)) * 8) = o;
          }
        }
    }
  }
};


struct Epi6 {
  static constexpr bool PERM = true, AFTER_DRAIN = false;
  u16* out; float* ssq; bool dup;
  DI void operator()(const pg8::f32x4 (&acc)[2][2][4][2], const pg8::Unit& u, int wr, int wc, int fr, int fq) const {
    const int rowb = u.pm * 256 + wr * 64 + fr;
    const int colb = u.pn * 256 + wc * 32 + 8 * fq;
#pragma unroll
    for (int ai = 0; ai < 2; ++ai)
#pragma unroll
      for (int m = 0; m < 4; ++m) {
        const int row = rowb + ai * 128 + m * 16;
        float ss = 0.f;
#pragma unroll
        for (int bj = 0; bj < 2; ++bj) {
          const pg8::f32x4 v0 = acc[ai][bj][m][0], v1 = acc[ai][bj][m][1];
          ss += v0[0] * v0[0] + v0[1] * v0[1] + v0[2] * v0[2] + v0[3] * v0[3] + v1[0] * v1[0] + v1[1] * v1[1] + v1[2] * v1[2] + v1[3] * v1[3];
          u4v o; o.x = pk2(v0[0], v0[1]); o.y = pk2(v0[2], v0[3]); o.z = pk2(v1[0], v1[1]); o.w = pk2(v1[2], v1[3]);
          *(u4v*)(out + (size_t)row * 1024 + colb + bj * 128) = o;
        }
        ss = xor16_add(ss); ss = xor32_add(ss);
        if (fq == 0 && !dup) atomicAdd(ssq + row, ss);
      }
  }
};
template <bool SECOND> struct Epi5 {
  static constexpr bool PERM = true, AFTER_DRAIN = false;
  const u16* mg; u16* mi; u16* mo;
  DI void operator()(const pg8::f32x4 (&acc)[2][2][4][2], const pg8::Unit& u, int wr, int wc, int fr, int fq) const {
    const int rowb = u.pm * 256 + wr * 64 + fr;
    const int colb = u.pn * 256 + wc * 32 + 8 * fq;
    const size_t gbase = (((size_t)(u.pm * 8 + u.pn + (SECOND ? 4 : 0)) * 8 + (wr * 4 + wc)) * 16) * 64 + (fq * 16 + fr);
    const size_t ibase = (((size_t)(u.pm * 4 + u.pn) * 8 + (wr * 4 + wc)) * 16) * 64 + (fq * 16 + fr);
#pragma unroll
    for (int hb = 0; hb < 4; ++hb) {
      const int ai = hb >> 1, m0 = (hb & 1) * 2;
      u4v g[4], pm[4];
#pragma unroll
      for (int f4 = 0; f4 < 4; ++f4) {
        const int f = ai * 8 + (m0 + (f4 >> 1)) * 2 + (f4 & 1);
        g[f4] = *(const u4v*)(mg + (gbase + (size_t)f * 64) * 8);
        if (SECOND) pm[f4] = *(const u4v*)(mi + (ibase + (size_t)f * 64) * 8);
      }
#pragma unroll
      for (int f4 = 0; f4 < 4; ++f4) {
        const int m = m0 + (f4 >> 1), bj = f4 & 1;
        const int row = rowb + ai * 128 + m * 16;
        const pg8::f32x4 v0 = acc[ai][bj][m][0], v1 = acc[ai][bj][m][1];
        float r0 = v0[0] * bflo(g[f4].x), r1 = v0[1] * bfhi(g[f4].x), r2 = v0[2] * bflo(g[f4].y), r3 = v0[3] * bfhi(g[f4].y);
        float r4 = v1[0] * bflo(g[f4].z), r5 = v1[1] * bfhi(g[f4].z), r6 = v1[2] * bflo(g[f4].w), r7 = v1[3] * bfhi(g[f4].w);
        if (SECOND) {
          r0 += bflo(pm[f4].x); r1 += bfhi(pm[f4].x); r2 += bflo(pm[f4].y); r3 += bfhi(pm[f4].y);
          r4 += bflo(pm[f4].z); r5 += bfhi(pm[f4].z); r6 += bflo(pm[f4].w); r7 += bfhi(pm[f4].w);
        }
        u4v o; o.x = pk2(r0, r1); o.y = pk2(r2, r3); o.z = pk2(r4, r5); o.w = pk2(r6, r7);
        if (SECOND) *(u4v*)(mo + (size_t)row * 1024 + colb + bj * 128) = o;
        else *(u4v*)(mi + (ibase + (size_t)(ai * 8 + m * 2 + bj) * 64) * 8) = o;
      }
      __builtin_amdgcn_sched_barrier(0);
    }
  }
};
struct EpiQ {
  static constexpr bool PERM = true, AFTER_DRAIN = false;
  const float* ssq_q; const float* rope; u16* Qo;
  DI void operator()(const pg8::f32x4 (&acc)[2][2][4][2], const pg8::Unit& u, int wr, int wc, int fr, int fq) const {
    const int rowb = u.pm * 256 + wr * 64 + fr;
    const int colu = wc * 32 + 8 * fq;
    float sq[8];
#pragma unroll
    for (int i = 0; i < 8; ++i) sq[i] = ssq_q[rowb + (i >> 2) * 128 + (i & 3) * 16];
    if (u.pn < 2) {
#pragma unroll
      for (int ai = 0; ai < 2; ++ai)
#pragma unroll
        for (int m = 0; m < 4; ++m) {
          const int row = rowb + ai * 128 + m * 16;
          const int b = row >> 12, spos = row & 4095;
          const float sc = rsqrtf(sq[ai * 4 + m] * (1.f / 768.f) + EPS) * QSCALE;
#pragma unroll
          for (int bj = 0; bj < 2; ++bj) {
            const pg8::f32x4 v0 = acc[ai][bj][m][0], v1 = acc[ai][bj][m][1];
            const int head = u.pn * 4 + bj * 2 + (colu >> 6), d = colu & 63;
            u4v o; o.x = pk2(v0[0] * sc, v0[1] * sc); o.y = pk2(v0[2] * sc, v0[3] * sc); o.z = pk2(v1[0] * sc, v1[1] * sc); o.w = pk2(v1[2] * sc, v1[3] * sc);
            *(u4v*)(Qo + ((size_t)(b * 8 + head) * 4096 + spos) * 96 + d) = o;
          }
        }
    } else {
#pragma unroll
      for (int ai = 0; ai < 2; ++ai) {
        f4v cs[4], sn[4];
#pragma unroll
        for (int i = 0; i < 4; ++i) {
          const int spos = (rowb + ai * 128 + i * 16) & 4095;
          cs[i] = *(const f4v*)(rope + spos * 16 + 4 * fq); sn[i] = *(const f4v*)(rope + 65536 + spos * 16 + 4 * fq);
        }
#pragma unroll
        for (int m = 0; m < 4; ++m) {
          const int row = rowb + ai * 128 + m * 16;
          const int b = row >> 12, spos = row & 4095;
          const float sc = rsqrtf(sq[ai * 4 + m] * (1.f / 768.f) + EPS) * QSCALE;
          const f4v c4 = cs[m], s4 = sn[m];
#pragma unroll
          for (int bj = 0; bj < 2; ++bj) {
            const pg8::f32x4 v0 = acc[ai][bj][m][0], v1 = acc[ai][bj][m][1];
            const int head = bj * 4 + wc;
            u2v o1, o2;
            o1.x = pk2((v0[0] * c4.x - v1[0] * s4.x) * sc, (v0[1] * c4.y - v1[1] * s4.y) * sc);
            o1.y = pk2((v0[2] * c4.z - v1[2] * s4.z) * sc, (v0[3] * c4.w - v1[3] * s4.w) * sc);
            o2.x = pk2((v0[0] * s4.x + v1[0] * c4.x) * sc, (v0[1] * s4.y + v1[1] * c4.y) * sc);
            o2.y = pk2((v0[2] * s4.z + v1[2] * c4.z) * sc, (v0[3] * s4.w + v1[3] * c4.w) * sc);
            u16* qp = Qo + ((size_t)(b * 8 + head) * 4096 + spos) * 96 + 64 + 4 * fq;
            *(u2v*)qp = o1; *(u2v*)(qp + 16) = o2;
          }
        }
        __builtin_amdgcn_sched_barrier(0);
      }
    }
  }
};

struct EpiK {
  static constexpr bool PERM = true, AFTER_DRAIN = false;
  const float* ssq_kv; u16* Ko;
  DI void operator()(const pg8::f32x4 (&acc)[2][2][4][2], const pg8::Unit& u, int wr, int wc, int fr, int fq) const {
    const int rowb = u.pm * 256 + wr * 64 + fr;
    float sq[8];
#pragma unroll
    for (int i = 0; i < 8; ++i) sq[i] = ssq_kv[rowb + (i >> 2) * 128 + (i & 3) * 16];
#pragma unroll
    for (int ai = 0; ai < 2; ++ai)
#pragma unroll
      for (int m = 0; m < 4; ++m) {
        const int row = rowb + ai * 128 + m * 16;
        const int b = row >> 12, spos = row & 4095;
        const float sc = rsqrtf(sq[ai * 4 + m] * (1.f / 256.f) + EPS);
#pragma unroll
        for (int bj = 0; bj < 2; ++bj) {
          const pg8::f32x4 v0 = acc[ai][bj][m][0], v1 = acc[ai][bj][m][1];
          const int col = u.pn * 256 + bj * 128 + wc * 32 + 8 * fq;
          const int head = col >> 6, d = col & 63;
          u4v o; o.x = pk2(v0[0] * sc, v0[1] * sc); o.y = pk2(v0[2] * sc, v0[3] * sc); o.z = pk2(v1[0] * sc, v1[1] * sc); o.w = pk2(v1[2] * sc, v1[3] * sc);
          *(u4v*)(Ko + ((size_t)(b * 8 + head) * 4096 + spos) * 96 + d) = o;
        }
      }
  }
};
struct EpiV {
  static constexpr bool PERM = false, AFTER_DRAIN = false;
  const float* ssq_kv; u16* Vo;
  DI void operator()(const pg8::f32x4 (&acc)[2][2][4][2], const pg8::Unit& u, int wr, int wc, int fr, int fq) const {
    f4v sq[8];
#pragma unroll
    for (int i = 0; i < 8; ++i) sq[i] = *(const f4v*)(ssq_kv + u.pm * 256 + (i >> 2) * 128 + wr * 64 + (i & 3) * 16 + 4 * fq);
#pragma unroll
    for (int ai = 0; ai < 2; ++ai)
#pragma unroll
      for (int m = 0; m < 4; ++m) {
        const int row4 = u.pm * 256 + ai * 128 + wr * 64 + m * 16 + 4 * fq;
        const int b = row4 >> 12, spos = row4 & 4095;
        const f4v q = sq[ai * 4 + m];
        const float s0 = rsqrtf(q.x * (1.f / 256.f) + EPS), s1 = rsqrtf(q.y * (1.f / 256.f) + EPS), s2 = rsqrtf(q.z * (1.f / 256.f) + EPS), s3 = rsqrtf(q.w * (1.f / 256.f) + EPS);
#pragma unroll
        for (int bj = 0; bj < 2; ++bj)
#pragma unroll
          for (int n = 0; n < 2; ++n) {
            const pg8::f32x4 v = acc[ai][bj][m][n];
            const int col = u.pn * 256 + bj * 128 + wc * 32 + n * 16 + fr;
            const int head = col >> 6, dv = col & 63;
            u2v o; o.x = pk2(v[0] * s0, v[1] * s1); o.y = pk2(v[2] * s2, v[3] * s3);
            *(u2v*)(Vo + ((size_t)(b * 8 + head) * 64 + dv) * 4096 + spos) = o;
          }
        __builtin_amdgcn_sched_barrier(0);
      }
  }
};
DI void phase1(const Params& p, unsigned char* smem, bool dup = false) {
  unsigned char* ws = p.ws;
  pg8::Gemm g{(const u16*)(ws + OFF_H), (const u16*)(ws + OFF_WIN), T, NP, 1024};
  pg8::StaticOrder S; S.init(T, NP, (int)gridDim.x, (int)blockIdx.x);
  Epi1 E{ws, (u16*)p.out, p.b_gate, dup};
  pg8::gemm_phase<Epi1, pg8::StaticOrder, false>((PG8_LAS unsigned char*)smem, g, S, E, nullptr);
  const int nlight = (int)gridDim.x / 2;
  if (!dup && (int)blockIdx.x >= (int)gridDim.x - nlight) {
    const int gtid = ((int)blockIdx.x - ((int)gridDim.x - nlight)) * (int)blockDim.x + (int)threadIdx.x, gthreads = nlight * (int)blockDim.x;
    conv_weight<1>((u16*)(ws + OFF_WUQ), p.w_uq, 768, 768, 768, p.g_q, 1023, gtid, gthreads);
    conv_weight<3>((u16*)(ws + OFF_WUKV), p.w_ukv, 1024, 1024, 256, p.g_kv, 255, gtid, gthreads);
    conv_weight<2>((u16*)(ws + OFF_WA), p.w_a, 1024, 1024, 512, nullptr, 0, gtid, gthreads);
    conv_weight<2>((u16*)(ws + OFF_WB), p.w_b, 1024, 1024, 512, p.g_hgrn, 63, gtid, gthreads);
    conv_weight<2>((u16*)(ws + OFF_WO), p.w_out, 1024, 1024, 1024, nullptr, 0, gtid, gthreads);
  }
}

DI void hgrn_prep_tile(const Params& p, float* stage, int tid, int b, int hh, int prow0, int nblk0) {
  unsigned char* ws = p.ws;
  const int bh = b * 8 + hh;
  if (tid < 128) {
    const int c = tid & 63, blk = tid >> 6;
    const float l0 = p.lb_logits[hh * 64 + c], l1 = p.lb_logits[512 + hh * 64 + c];
    const float lbv = 1.f / (1.f + expf(l1 - l0));
    float cum = 0.f;
    for (int rr = 0; rr < 32; ++rr) {
      float* sp = stage + (blk * 32 + rr) * SST + c;
      const float q = sp[0], hf = sp[64];
      const float sg = 1.f / (1.f + expf(-hf));
      const float f = lbv + (1.f - lbv) * sg;
      cum += logf(f);
      const float e = expf(cum);
      sp[0] = q * e;
      sp[64] = (1.f - f) / e;
    }
    ((float*)(ws + OFF_DECAY))[((size_t)bh * 128 + nblk0 + blk) * 64 + c] = expf(cum);
  }
  __syncthreads();
#pragma unroll
  for (int it = 0; it < 2; ++it) {
    const int item = tid + 256 * it, rr = item >> 3, cc = (item & 7) * 8;
    const f4v a = *(const f4v*)(stage + rr * SST + cc), c = *(const f4v*)(stage + rr * SST + cc + 4);
    const f4v d = *(const f4v*)(stage + rr * SST + 64 + cc), e = *(const f4v*)(stage + rr * SST + 64 + cc + 4);
    const size_t o = (size_t)(prow0 + rr) * 512 + hh * 64 + cc;
    *(u4v*)((u16*)(ws + OFF_QDEC) + o) = pk8(a, c);
    *(u4v*)((u16*)(ws + OFF_KINV) + o) = pk8(d, e);
  }
}
DI void hi_vt_tile(const Params& p, float* stage, int tid, int b, int q2, int nblk0) {
  unsigned char* ws = p.ws;
#pragma unroll
        for (int it = 0; it < 4; ++it) {
          const int item = tid + 256 * it, sc = item & 3, col = (item >> 2) & 127, blk = item >> 9;
          float v[8];
#pragma unroll
          for (int i = 0; i < 8; ++i) v[i] = stage[(blk * 32 + sc * 8 + i) * SST + col];
          u4v o; o.x = pk2(v[0], v[1]); o.y = pk2(v[2], v[3]); o.z = pk2(v[4], v[5]); o.w = pk2(v[6], v[7]);
          const int bh = b * 8 + q2 * 2 + (col >> 6);
          *(u4v*)((u16*)(ws + OFF_VT) + (((size_t)bh * 128 + nblk0 + blk) * 64 + (col & 63)) * 32 + sc * 8) = o;
        }
}
DI void stage_load64(float* stage, const u16* src, int coff, int tid) {
#pragma unroll
  for (int it = 0; it < 2; ++it) {
    const int item = tid + 256 * it, rr = item >> 3, ch = item & 7;
    const u4v v = *(const u4v*)(src + (size_t)rr * 512 + ch * 8);
    float* d = stage + rr * SST + coff + ch * 8;
    *(f4v*)d = f4v{bflo(v.x), bfhi(v.x), bflo(v.y), bfhi(v.y)};
    *(f4v*)(d + 4) = f4v{bflo(v.z), bfhi(v.z), bflo(v.w), bfhi(v.w)};
  }
}


constexpr int PST = 68;
DI void hgrn_prep_native(const Params& p, float* pl, int rb, int hh) {
  unsigned char* ws = p.ws;
  const int tid = threadIdx.x;
  float* Qp = pl; float* G = pl + 128 * PST; float* Kn = pl + 2 * 128 * PST;
  const int prow0 = rb * 128, b = prow0 >> 12, bh = b * 8 + hh, nblk0 = (prow0 & 4095) >> 5;
  const int ch = tid & 7;
  float lbv[8];
  {
    const f4v a0 = *(const f4v*)(p.lb_logits + hh * 64 + ch * 8), a1 = *(const f4v*)(p.lb_logits + hh * 64 + ch * 8 + 4);
    const f4v b0 = *(const f4v*)(p.lb_logits + 512 + hh * 64 + ch * 8), b1 = *(const f4v*)(p.lb_logits + 512 + hh * 64 + ch * 8 + 4);
    const float l0[8] = {a0.x, a0.y, a0.z, a0.w, a1.x, a1.y, a1.z, a1.w}, l1[8] = {b0.x, b0.y, b0.z, b0.w, b1.x, b1.y, b1.z, b1.w};
#pragma unroll
    for (int i = 0; i < 8; ++i) lbv[i] = 1.f / (1.f + expf(l1[i] - l0[i]));
  }
  __syncthreads();
#pragma unroll
  for (int it = 0; it < 2; ++it) {
    const int rr = (tid + 512 * it) >> 3;
    const size_t go = (size_t)(prow0 + rr) * 512 + hh * 64 + ch * 8;
    const u4v qv = *(const u4v*)((const u16*)(ws + OFF_HQ) + go), fv = *(const u4v*)((const u16*)(ws + OFF_HF) + go);
    const float q[8] = {bflo(qv.x), bfhi(qv.x), bflo(qv.y), bfhi(qv.y), bflo(qv.z), bfhi(qv.z), bflo(qv.w), bfhi(qv.w)};
    const float hf[8] = {bflo(fv.x), bfhi(fv.x), bflo(fv.y), bfhi(fv.y), bflo(fv.z), bfhi(fv.z), bflo(fv.w), bfhi(fv.w)};
    float g[8], kn[8];
#pragma unroll
    for (int i = 0; i < 8; ++i) {
      const float sg = rcpf(1.f + __builtin_amdgcn_exp2f(-1.4426950408889634f * hf[i]));
      const float f = lbv[i] + (1.f - lbv[i]) * sg;
      g[i] = __builtin_amdgcn_logf(f);
      kn[i] = 1.f - f;
    }
    float* d = Qp + rr * PST + ch * 8;
    *(f4v*)d = f4v{q[0], q[1], q[2], q[3]}; *(f4v*)(d + 4) = f4v{q[4], q[5], q[6], q[7]};
    d = G + rr * PST + ch * 8;
    *(f4v*)d = f4v{g[0], g[1], g[2], g[3]}; *(f4v*)(d + 4) = f4v{g[4], g[5], g[6], g[7]};
    d = Kn + rr * PST + ch * 8;
    *(f4v*)d = f4v{kn[0], kn[1], kn[2], kn[3]}; *(f4v*)(d + 4) = f4v{kn[4], kn[5], kn[6], kn[7]};
  }
  __syncthreads();
  if (tid < 256) {
    const int c = tid & 63, blk = tid >> 6;
    float* gp = G + (blk * 32) * PST + c;
    float v[32];
#pragma unroll
    for (int r2 = 0; r2 < 32; ++r2) v[r2] = gp[r2 * PST];
    float cum = 0.f;
#pragma unroll
    for (int r2 = 0; r2 < 32; ++r2) { cum += v[r2]; gp[r2 * PST] = cum; }
    ((float*)(ws + OFF_DECAY))[((size_t)bh * 128 + nblk0 + blk) * 64 + c] = __builtin_amdgcn_exp2f(cum);
  }
  __syncthreads();
#pragma unroll
  for (int it = 0; it < 2; ++it) {
    const int rr = (tid + 512 * it) >> 3;
    const float* s0 = Qp + rr * PST + ch * 8; const float* s1 = G + rr * PST + ch * 8; const float* s2 = Kn + rr * PST + ch * 8;
    const f4v q0 = *(const f4v*)s0, q1 = *(const f4v*)(s0 + 4), c0 = *(const f4v*)s1, c1 = *(const f4v*)(s1 + 4), k0 = *(const f4v*)s2, k1 = *(const f4v*)(s2 + 4);
    const float q[8] = {q0.x, q0.y, q0.z, q0.w, q1.x, q1.y, q1.z, q1.w}, cm[8] = {c0.x, c0.y, c0.z, c0.w, c1.x, c1.y, c1.z, c1.w}, kn[8] = {k0.x, k0.y, k0.z, k0.w, k1.x, k1.y, k1.z, k1.w};
    float qd[8], ki[8];
#pragma unroll
    for (int i = 0; i < 8; ++i) { qd[i] = q[i] * __builtin_amdgcn_exp2f(cm[i]); ki[i] = kn[i] * __builtin_amdgcn_exp2f(-cm[i]); }
    const size_t go = (size_t)(prow0 + rr) * 512 + hh * 64 + ch * 8;
    u4v o; o.x = pk2(qd[0], qd[1]); o.y = pk2(qd[2], qd[3]); o.z = pk2(qd[4], qd[5]); o.w = pk2(qd[6], qd[7]);
    *(u4v*)((u16*)(ws + OFF_QDEC) + go) = o;
    o.x = pk2(ki[0], ki[1]); o.y = pk2(ki[2], ki[3]); o.z = pk2(ki[4], ki[5]); o.w = pk2(ki[6], ki[7]);
    *(u4v*)((u16*)(ws + OFF_KINV) + go) = o;
  }
}
constexpr int VTS = 136;
DI void hi_vt_native(const Params& p, u16* img, int rb, int q2) {
  unsigned char* ws = p.ws;
  const int tid = threadIdx.x;
  const int prow0 = rb * 128, b = prow0 >> 12, nblk0 = (prow0 & 4095) >> 5;
  __syncthreads();
#pragma unroll
  for (int it = 0; it < 4; ++it) {
    const int item = tid + 512 * it, rr = item >> 4, c16 = item & 15;
    *(u4v*)(img + rr * VTS + c16 * 8) = *(const u4v*)((const u16*)(ws + OFF_HI) + (size_t)(prow0 + rr) * 512 + q2 * 128 + c16 * 8);
  }
  __syncthreads();
#pragma unroll
  for (int it = 0; it < 4; ++it) {
    const int item = tid + 512 * it, sc = item & 3, col = (item >> 2) & 127, blk = item >> 9;
    u32 w[4];
#pragma unroll
    for (int i = 0; i < 4; ++i) {
      const u32 lo = img[(blk * 32 + sc * 8 + 2 * i) * VTS + col], hi = img[(blk * 32 + sc * 8 + 2 * i + 1) * VTS + col];
      w[i] = lo | (hi << 16);
    }
    const int bh = b * 8 + q2 * 2 + (col >> 6);
    *(u4v*)((u16*)(ws + OFF_VT) + (((size_t)bh * 128 + nblk0 + blk) * 64 + (col & 63)) * 32 + sc * 8) = u4v{w[0], w[1], w[2], w[3]};
  }
}

DI void rope8(const float* x1, const float* x2, const float* rope, int spos, int j0, bool first, float scale, float (&o)[8]) {
  const f4v c0 = *(const f4v*)(rope + spos * 16 + j0), c1 = *(const f4v*)(rope + spos * 16 + j0 + 4);
  const f4v s0 = *(const f4v*)(rope + 65536 + spos * 16 + j0), s1 = *(const f4v*)(rope + 65536 + spos * 16 + j0 + 4);
  const float cs[8] = {c0.x, c0.y, c0.z, c0.w, c1.x, c1.y, c1.z, c1.w};
  const float sn[8] = {s0.x, s0.y, s0.z, s0.w, s1.x, s1.y, s1.z, s1.w};
#pragma unroll
  for (int i = 0; i < 8; ++i) o[i] = scale * (first ? (x1[i] * cs[i] - x2[i] * sn[i]) : (x1[i] * sn[i] + x2[i] * cs[i]));
}

DI void phase2(const Params& p, unsigned char* smem, u16* lds) {
  unsigned char* ws = p.ws;
  const int tid = VTID;
  float* stage = (float*)lds;
  const float* ssq_q = (const float*)(ws + OFF_SSQ);
  const float* ssq_kv = ssq_q + T;
  const float* rope = (const float*)(ws + OFF_ROPE);
  u16* Qo = (u16*)(ws + OFF_Q);
  u16* Ko = (u16*)(ws + OFF_K);
  u16* Vo = (u16*)(ws + OFF_VTT);
#pragma nounroll
  for (int rep = 0; rep < (DUP_PH == 21 ? p.ph_hi - 7 : 1); ++rep) {
    pg8::Gemm g{(const u16*)(ws + OFF_CQ), (const u16*)(ws + OFF_WUQ), T, 768, 768};
    pg8::StaticOrder S; S.init(T, 768, (int)gridDim.x, (int)blockIdx.x);
    EpiQ E{ssq_q, rope, Qo};
    pg8::gemm_phase<EpiQ, pg8::StaticOrder, false>((PG8_LAS unsigned char*)smem, g, S, E, nullptr);
  }
#pragma nounroll
  for (int rep = 0; rep < (DUP_PH == 23 ? p.ph_hi - 7 : 1); ++rep) {
    pg8::StaticOrder S; S.init(T, 512, (int)gridDim.x, (int)blockIdx.x);
    {
      int kk = 256; asm volatile("" : "+s"(kk));
      pg8::Gemm g{(const u16*)(ws + OFF_CKV), (const u16*)(ws + OFF_WUKV), T, 512, kk};
      EpiK E{ssq_kv, Ko};
      pg8::gemm_phase<EpiK, pg8::StaticOrder, false>((PG8_LAS unsigned char*)smem, g, S, E, nullptr);
    }
  }
  {
    pg8::StaticOrder S; S.init(T, 512, (int)gridDim.x, (int)blockIdx.x);
    int kk = 256; asm volatile("" : "+s"(kk));
    pg8::Gemm g{(const u16*)(ws + OFF_CKV), (const u16*)(ws + OFF_WUKV) + (size_t)512 * 256, T, 512, kk};
    EpiV E{(const float*)(ws + OFF_SSQ) + T, (u16*)(ws + OFF_VTT)};
    pg8::gemm_phase<EpiV, pg8::StaticOrder, false, true>((PG8_LAS unsigned char*)smem, g, S, E, nullptr);
  }
#pragma nounroll
  for (int rep = 0; rep < (DUP_PH == 22 ? p.ph_hi - 7 : 1); ++rep) {
    const int gtid = blockIdx.x * blockDim.x + threadIdx.x, gthreads = gridDim.x * blockDim.x;
    for (int idx = gtid; idx < T * 4; idx += gthreads) {
      const int tok = idx >> 2, wv = (idx & 3) * 8, j0 = wv & 15;
      const int b = tok >> 12, spos = tok & 4095;
      const float* kp = (const float*)(ws + OFF_KPE) + (size_t)tok * 32;
      const f4v a0 = *(const f4v*)(kp + j0), a1 = *(const f4v*)(kp + j0 + 4);
      const f4v b0 = *(const f4v*)(kp + 16 + j0), b1 = *(const f4v*)(kp + 16 + j0 + 4);
      const float x1[8] = {a0.x, a0.y, a0.z, a0.w, a1.x, a1.y, a1.z, a1.w};
      const float x2[8] = {b0.x, b0.y, b0.z, b0.w, b1.x, b1.y, b1.z, b1.w};
      float o[8];
      rope8(x1, x2, rope, spos, j0, wv < 16, 1.f, o);
      u4v ov; ov.x = pk2(o[0], o[1]); ov.y = pk2(o[2], o[3]); ov.z = pk2(o[4], o[5]); ov.w = pk2(o[6], o[7]);
#pragma unroll
      for (int head = 0; head < 8; ++head) *(u4v*)(Ko + ((size_t)(b * 8 + head) * 4096 + spos) * 96 + 64 + wv) = ov;
    }
  }
  for (int rep = 0; rep < (DUP_PH == 20 ? 2 : 1); ++rep)
  {
    const int G = (int)gridDim.x, c = (int)blockIdx.x, hG = G / 2, round = 2 * G + hG;
    for (int base = 0; base < 2048 + 1024; base += round) {
#pragma unroll 1
      for (int k = 0; k < 3; ++k) {
        if (k == 2 && c < G - hG) break;
        const int t = base + (k == 0 ? c : k == 1 ? G + c : 2 * G + (c - (G - hG)));
        if (t >= 2048 + 1024) break;
        if (t < 2048) hgrn_prep_native(p, (float*)smem, t >> 3, t & 7);
        else hi_vt_native(p, (u16*)smem, (t - 2048) >> 2, (t - 2048) & 3);
      }
    }
  }
}

DI void phase2b(const Params& p, unsigned char* smem) {
  unsigned char* ws = p.ws;
  const int tid = VTID;
}

constexpr int KST2 = 104, VST2 = 136;
constexpr int ATT_BUF2 = 128 * KST2 + 64 * VST2;
DI void att_qk(const u16* sk, const bf16x8 (&qf)[6], float nm, f32x16 (&st)[2]) {
#pragma unroll
  for (int i = 0; i < 16; ++i) { st[0][i] = nm; st[1][i] = nm; }
#pragma unroll
  for (int kb = 0; kb < 2; ++kb)
#pragma unroll
    for (int ks = 0; ks < 6; ++ks) {
      const bf16x8 kf = *(const bf16x8*)(sk + kb * 32 * KST2 + ks * 16);
      st[kb] = MFMA(kf, qf[ks], st[kb]);
    }
}
DI float att_softmax(f32x16 (&st)[2], float adj, bool adjnz, bool first, float& mref, float& l, f32x16 (&o)[2]) {
  float mx = st[0][0];
#pragma unroll
  for (int i = 1; i < 16; ++i) mx = fmaxf(mx, st[0][i]);
#pragma unroll
  for (int i = 0; i < 16; ++i) mx = fmaxf(mx, st[1][i]);
  mx = xor32_max(mx) - adj;
  f2v ps = f2v{0.f, 0.f};
  float shift_out = 0.f;
  if (first || adjnz || __builtin_amdgcn_ballot_w64(mx > 8.f) != 0ull) {
    const float shift = first ? mx : fmaxf(mx, 0.f);
    const float tot = adj + shift;
    const float alpha = first ? 0.f : __builtin_amdgcn_exp2f(-shift);
    mref += shift;
#pragma unroll
    for (int kb = 0; kb < 2; ++kb)
#pragma unroll
      for (int i = 0; i < 16; i += 2) {
        const float p0 = __builtin_amdgcn_exp2f(st[kb][i] - tot), p1 = __builtin_amdgcn_exp2f(st[kb][i + 1] - tot);
        st[kb][i] = p0; st[kb][i + 1] = p1; ps += f2v{p0, p1};
      }
    l = l * alpha + (ps.x + ps.y);
#pragma unroll
    for (int i = 0; i < 16; ++i) { o[0][i] *= alpha; o[1][i] *= alpha; }
    shift_out = shift;
  } else {
#pragma unroll
    for (int kb = 0; kb < 2; ++kb)
#pragma unroll
      for (int i = 0; i < 16; i += 2) {
        const float p0 = __builtin_amdgcn_exp2f(st[kb][i]), p1 = __builtin_amdgcn_exp2f(st[kb][i + 1]);
        st[kb][i] = p0; st[kb][i + 1] = p1; ps += f2v{p0, p1};
      }
    l += ps.x + ps.y;
  }
  return shift_out;
}
DI void att_pv(const u16* sv, const f32x16 (&st)[2], f32x16 (&o)[2]) {
#pragma unroll
  for (int s4 = 0; s4 < 4; ++s4) {
    const int kb = s4 >> 1, rb = 8 * (s4 & 1);
    u4v pu; pu.x = pk2(st[kb][rb], st[kb][rb + 1]); pu.y = pk2(st[kb][rb + 2], st[kb][rb + 3]);
    pu.z = pk2(st[kb][rb + 4], st[kb][rb + 5]); pu.w = pk2(st[kb][rb + 6], st[kb][rb + 7]);
    const bf16x8 pb = __builtin_bit_cast(bf16x8, pu);
#pragma unroll
    for (int db = 0; db < 2; ++db) {
      const s16x4 lo = *(const s16x4*)(sv + db * 32 * VST2 + 16 * s4);
      const s16x4 hi = *(const s16x4*)(sv + db * 32 * VST2 + 16 * s4 + 8);
      const bf16x8 vf = __builtin_shufflevector(lo, hi, 0, 1, 2, 3, 4, 5, 6, 7);
      o[db] = MFMA(vf, pb, o[db]);
    }
  }
}
DI void attn8_item(const Params& p, u16* lds, int bh, int qt) {
  unsigned char* ws = p.ws;
  const int tid = threadIdx.x, lane = tid & 63, w = tid >> 6, r = lane & 31, h = lane >> 5;
  const u16* Qp = (const u16*)(ws + OFF_Q) + (size_t)bh * 4096 * 96;
  const u16* Kp = (const u16*)(ws + OFF_K) + (size_t)bh * 4096 * 96;
  const u16* Vp = (const u16*)(ws + OFF_VTT) + (size_t)bh * 64 * 4096;
  const int q0 = qt * 256 + w * 32;
  bf16x8 qf[6];
#pragma unroll
  for (int ks = 0; ks < 6; ++ks) qf[ks] = *(const bf16x8*)(Qp + (size_t)(q0 + r) * 96 + ks * 16 + h * 8);
  u2v gts[2][4];
  {
    const size_t tok_ = (size_t)(bh >> 3) * 4096 + q0 + r;
    const u16* sga_ = (const u16*)(ws + OFF_SGA) + tok_ * 512 + (bh & 7) * 64;
#pragma unroll
    for (int db = 0; db < 2; ++db)
#pragma unroll
      for (int g = 0; g < 4; ++g) gts[db][g] = *(const u2v*)(sga_ + db * 32 + 8 * g + 4 * h);
  }
  f32x16 o[2]; o[0] = zero16(); o[1] = zero16();
  float mref = 0.f, l = 0.f;
  const int Jmax = 2 * qt + 1, jw = 4 * qt + (w >> 1);
  const u16* dsrc[6]; int dstep[6]; unsigned doff[6];
#pragma unroll
  for (int sl = 0; sl < 6; ++sl) {
    const int k = w + 8 * sl;
    if (k < 26) { const int c = 64 * k + lane, row = c / 13, col = c % 13; dsrc[sl] = Kp + (size_t)row * 96 + (col < 12 ? col : 11) * 8; dstep[sl] = 128 * 96; doff[sl] = (unsigned)k * 1024u; }
    else { const int c = 64 * (k - 26) + lane, row = c / 17, col = c % 17; dsrc[sl] = Vp + (size_t)row * 4096 + (col < 16 ? col : 15) * 8; dstep[sl] = 128; doff[sl] = 128u * KST2 * 2u + (unsigned)(k - 26) * 1024u; }
  }
  LAS unsigned char* ldsb = (LAS unsigned char*)lds;
#define ATT_DMA(BUF) do { _Pragma("unroll") for (int sl = 0; sl < 6; ++sl) if (w + 8 * sl < 43) { \
      __builtin_amdgcn_global_load_lds((const unsigned*)dsrc[sl], (LAS unsigned*)(ldsb + (BUF) * (ATT_BUF2 * 2) + doff[sl]), 16, 0, 0); dsrc[sl] += dstep[sl]; } } while (0)
  __syncthreads();
  ATT_DMA(0);
  __syncthreads();
  for (int J = 0; J <= Jmax; ++J) {
    const int cur = J & 1;
    if (J < Jmax) ATT_DMA(cur ^ 1);
    const u16* sk = lds + cur * ATT_BUF2 + r * KST2 + h * 8;
    const u16* sv = lds + cur * ATT_BUF2 + 128 * KST2 + r * VST2 + 4 * h;
    if (2 * J + 1 <= jw) {
      f32x16 s0[2], s1[2];
      const float nm = -mref;
      att_qk(sk, qf, nm, s0);
      att_qk(sk + 64 * KST2, qf, nm, s1);
      const float sh = att_softmax(s0, 0.f, false, J == 0, mref, l, o);
      const bool adjnz = __builtin_amdgcn_ballot_w64(sh != 0.f) != 0ull;
      att_pv(sv, s0, o);
      att_softmax(s1, sh, adjnz, false, mref, l, o);
      att_pv(sv + 64, s1, o);
    } else if (2 * J <= jw) {
      f32x16 s0[2];
      att_qk(sk, qf, -mref, s0);
      att_softmax(s0, 0.f, false, J == 0, mref, l, o);
      att_pv(sv, s0, o);
    }
    __syncthreads();
  }
#undef ATT_DMA
  l = xor32_add(l);
  const float inv = 1.f / l;
  const int b = bh >> 3, head = bh & 7;
  const size_t tok = (size_t)b * 4096 + q0 + r;
  const u16* sga = (const u16*)(ws + OFF_SGA) + tok * 512 + head * 64;
  u16* ya = (u16*)(ws + OFF_YA) + tok * 512 + head * 64;
#pragma unroll
  for (int db = 0; db < 2; ++db)
#pragma unroll
    for (int g = 0; g < 4; ++g) {
      const int dv0 = db * 32 + 8 * g + 4 * h;
      const u2v gt = gts[db][g];
      u2v ov;
      ov.x = pk2(o[db][4 * g] * inv * bflo(gt.x), o[db][4 * g + 1] * inv * bfhi(gt.x));
      ov.y = pk2(o[db][4 * g + 2] * inv * bflo(gt.y), o[db][4 * g + 3] * inv * bfhi(gt.y));
      *(u2v*)(ya + dv0) = ov;
    }
}

DI void scan_item(const Params& p, int i, size_t out_off = OFF_UPD) {
  unsigned char* ws = p.ws;
  const int tid = threadIdx.x;
  const int bh = i >> 2, part = i & 3;
  const int e = part * 1024 + tid * 2, k = e & 63;
  u32* U = (u32*)((u16*)(ws + OFF_UPD) + (size_t)bh * 128 * 4096 + e);
  u32* UO = (u32*)((u16*)(ws + out_off) + (size_t)bh * 128 * 4096 + e);
  const f2v* Dc = (const f2v*)((const float*)(ws + OFF_DECAY) + (size_t)bh * 128 * 64 + k);
  float s0 = 0.f, s1 = 0.f;
  for (int n0 = 0; n0 < 128; n0 += 32) {
    u32 u[32]; f2v d[32];
#pragma unroll
    for (int q = 0; q < 32; ++q) { u[q] = U[(size_t)(n0 + q) * 2048]; d[q] = Dc[(n0 + q) * 32]; }
#pragma unroll
    for (int q = 0; q < 32; ++q) {
      UO[(size_t)(n0 + q) * 2048] = pk2(s0, s1);
      s0 = d[q].x * (s0 + bflo(u[q]));
      s1 = d[q].y * (s1 + bfhi(u[q]));
    }
  }
}

DI void hgrn_state_item(const Params& p, float* ub, int bh, int vb) {
  unsigned char* ws = p.ws;
  const int tid = threadIdx.x, lane = tid & 63, w = tid >> 6, r = lane & 31, h = lane >> 5;
  const int b = bh >> 3, head = bh & 7;
  const u16* kn_base = (const u16*)(ws + OFF_KINV) + ((size_t)b * 4096) * 512 + head * 64;
  const u16* vt_base = (const u16*)(ws + OFF_VT) + ((size_t)bh * 128) * 64 * 32;
  const float* dec = (const float*)(ws + OFF_DECAY) + (size_t)bh * 128 * 64;
  u16* up = (u16*)(ws + OFF_UPD) + (size_t)bh * 128 * 4096;
  const int vl = tid >> 4, k0 = (tid & 15) * 4;
  constexpr int KS = 68;
  f4v st = f4v{0.f, 0.f, 0.f, 0.f};
#pragma unroll 1
  for (int i = 0; i < 16; ++i) {
    const int n = i * 8 + w;
    bf16x8 a[2][2], bb[2];
    const u16* kn = kn_base + (size_t)(n * 32) * 512;
#pragma unroll
    for (int kb = 0; kb < 2; ++kb)
#pragma unroll
      for (int ks = 0; ks < 2; ++ks) {
        bf16x8 av;
#pragma unroll
        for (int j = 0; j < 8; ++j) av[j] = (short)kn[(size_t)(ks * 16 + h * 8 + j) * 512 + kb * 32 + r];
        a[kb][ks] = av;
      }
#pragma unroll
    for (int ks = 0; ks < 2; ++ks) bb[ks] = *(const bf16x8*)(vt_base + ((size_t)n * 64 + vb * 32 + r) * 32 + ks * 16 + h * 8);
    f4v d[8];
#pragma unroll
    for (int j = 0; j < 8; ++j) d[j] = *(const f4v*)(dec + (size_t)(i * 8 + j) * 64 + k0);
    __syncthreads();
#pragma unroll
    for (int kb = 0; kb < 2; ++kb) {
      f32x16 c = zero16();
      c = MFMA(a[kb][0], bb[0], c);
      c = MFMA(a[kb][1], bb[1], c);
#pragma unroll
      for (int g = 0; g < 4; ++g) *(f4v*)(ub + (w * 32 + r) * KS + kb * 32 + 8 * g + 4 * h) = f4v{c[4 * g], c[4 * g + 1], c[4 * g + 2], c[4 * g + 3]};
    }
    __syncthreads();
#pragma unroll
    for (int j = 0; j < 8; ++j) {
      const f4v u = *(const f4v*)(ub + (j * 32 + vl) * KS + k0);
      u2v o; o.x = pk2(st.x, st.y); o.y = pk2(st.z, st.w);
      *(u2v*)(up + (size_t)(i * 8 + j) * 4096 + (vb * 32 + vl) * 64 + k0) = o;
      st.x = d[j].x * (st.x + u.x); st.y = d[j].y * (st.y + u.y); st.z = d[j].z * (st.z + u.z); st.w = d[j].w * (st.w + u.w);
    }
  }
  asm volatile("s_waitcnt vmcnt(0)" ::: "memory");
  __syncthreads();
  if (threadIdx.x == 0) {
    __builtin_amdgcn_fence(__ATOMIC_RELEASE, "agent");
    asm volatile("s_waitcnt vmcnt(0)" ::: "memory");
    __hip_atomic_fetch_add((unsigned*)(ws + OFF_SSQ + (size_t)3 * T * 4) + 64 + bh, 1u, __ATOMIC_RELAXED, __HIP_MEMORY_SCOPE_AGENT);
  }
}

DI void h3_item(const Params& p, int t);
DI void phase3(const Params& p, unsigned char* smem, bool dup = false) {
  int* s_item = (int*)(smem + LDS_BYTES - 64);
  int* ctr = (int*)(p.ws + OFF_SSQ + (size_t)3 * T * 4) + (dup ? 1 : 0);
  unsigned* done = (unsigned*)(p.ws + OFF_SSQ + (size_t)3 * T * 4) + 64;
  if (!dup) for (int it = (int)blockIdx.x - ((int)gridDim.x - 128); it >= 0 && it < 128; it += 128 * 1024) hgrn_state_item(p, (float*)smem, it >> 1, it & 1);
  if (!dup && (int)gridDim.x < 128) for (int it = (int)blockIdx.x; it < 128; it += (int)gridDim.x) hgrn_state_item(p, (float*)smem, it >> 1, it & 1);
  for (;;) {
    __syncthreads();
    if (threadIdx.x == 0) *s_item = atomicAdd(ctr, 1);
    __syncthreads();
    const int item = *s_item;
    if (item >= 2048) break;
    int att = -1, h3 = -1;
    if (item < 256) att = item;
    else { const int j = item - 256, g = j / 7, pos = j % 7; if (pos == 0 || pos == 2 || pos == 4) att = 256 + 3 * g + (pos >> 1); else h3 = 4 * g + (pos == 1 ? 0 : pos == 3 ? 1 : pos == 5 ? 2 : 3); }
    if (att >= 0) attn8_item(p, (u16*)smem, att & 63, 15 - (att >> 6));
    else if (!dup) {
      const int bh = h3 >> 4;
      if (threadIdx.x == 0) {
        unsigned sp = 0;
        while (__hip_atomic_load(done + bh, __ATOMIC_RELAXED, __HIP_MEMORY_SCOPE_AGENT) < 2u) { __builtin_amdgcn_s_sleep(2); if (++sp > (1u << 22)) break; }
        __builtin_amdgcn_fence(__ATOMIC_ACQUIRE, "agent");
        asm volatile("s_waitcnt vmcnt(0)" ::: "memory");
      }
      __syncthreads();
      h3_item(p, 2 * h3 + (int)(threadIdx.x >> 8));
    }
  }
}

DI void h3_item(const Params& p, int t) {
  unsigned char* ws = p.ws;
  const int tid = VTID, lane = tid & 63, w = tid >> 6, r = lane & 31, h = lane >> 5;
  {
    const int bh = t >> 5, n = (t & 31) * 4 + w;
    const int b = bh >> 3, head = bh & 7;
    const size_t tok0 = (size_t)b * 4096 + n * 32;
    const u16* qd = (const u16*)(ws + OFF_QDEC) + (tok0 + r) * 512 + head * 64 + h * 8;
    const u16* ki = (const u16*)(ws + OFF_KINV) + (tok0 + r) * 512 + head * 64 + h * 8;
    const u16* vt = (const u16*)(ws + OFF_VT) + ((size_t)bh * 128 + n) * 64 * 32;
    const u16* sp = (const u16*)(ws + OFF_UPD) + ((size_t)bh * 128 + n) * 4096;
    bf16x8 qf[4], kf[4];
#pragma unroll
    for (int ks = 0; ks < 4; ++ks) { qf[ks] = *(const bf16x8*)(qd + ks * 16); kf[ks] = *(const bf16x8*)(ki + ks * 16); }
    f32x16 at = zero16();
#pragma unroll
    for (int ks = 0; ks < 4; ++ks) at = MFMA(kf[ks], qf[ks], at);
#pragma unroll
    for (int i = 0; i < 16; ++i) if (crow(i, h) > r) at[i] = 0.f;
    f32x16 o[2]; o[0] = zero16(); o[1] = zero16();
#pragma unroll
    for (int s2 = 0; s2 < 2; ++s2) {
      u4v pu; pu.x = pk2(at[8 * s2], at[8 * s2 + 1]); pu.y = pk2(at[8 * s2 + 2], at[8 * s2 + 3]);
      pu.z = pk2(at[8 * s2 + 4], at[8 * s2 + 5]); pu.w = pk2(at[8 * s2 + 6], at[8 * s2 + 7]);
      const bf16x8 pb = __builtin_bit_cast(bf16x8, pu);
#pragma unroll
      for (int vb = 0; vb < 2; ++vb) {
        const s16x4 lo = *(const s16x4*)(vt + (vb * 32 + r) * 32 + 16 * s2 + 4 * h);
        const s16x4 hi = *(const s16x4*)(vt + (vb * 32 + r) * 32 + 16 * s2 + 8 + 4 * h);
        const bf16x8 vf = __builtin_shufflevector(lo, hi, 0, 1, 2, 3, 4, 5, 6, 7);
        o[vb] = MFMA(vf, pb, o[vb]);
      }
    }
#pragma unroll
    for (int vb = 0; vb < 2; ++vb)
#pragma unroll
      for (int ks = 0; ks < 4; ++ks) {
        const bf16x8 sf = *(const bf16x8*)(sp + (vb * 32 + r) * 64 + ks * 16 + h * 8);
        o[vb] = MFMA(sf, qf[ks], o[vb]);
      }
    float ss = 0.f;
#pragma unroll
    for (int i = 0; i < 16; ++i) ss += o[0][i] * o[0][i] + o[1][i] * o[1][i];
    ss = xor32_add(ss);
    const float rs = rsqrtf(ss * (1.f / 64.f) + EPS);
    const u16* sgb = (const u16*)(ws + OFF_SGB) + (tok0 + r) * 512 + head * 64;
    u16* yb = (u16*)(ws + OFF_YB) + (tok0 + r) * 512 + head * 64;
#pragma unroll
    for (int vb = 0; vb < 2; ++vb)
#pragma unroll
      for (int g = 0; g < 4; ++g) {
        const int v0 = vb * 32 + 8 * g + 4 * h;
        const u2v gt = *(const u2v*)(sgb + v0);
        u2v ov;
        ov.x = pk2(o[vb][4 * g] * rs * bflo(gt.x), o[vb][4 * g + 1] * rs * bfhi(gt.x));
        ov.y = pk2(o[vb][4 * g + 2] * rs * bflo(gt.y), o[vb][4 * g + 3] * rs * bfhi(gt.y));
        *(u2v*)(yb + v0) = ov;
      }
  }
}

DI void phase5(const Params& p, unsigned char* smem) {
  unsigned char* ws = p.ws;
  pg8::StaticOrder S; S.init(T, 1024, (int)gridDim.x, (int)blockIdx.x);
  {
    pg8::Gemm g{(const u16*)(ws + OFF_YA), (const u16*)(ws + OFF_WA), T, 1024, 512};
    Epi5<false> E{(const u16*)p.out, (u16*)(ws + OFF_H), (u16*)(ws + OFF_M)};
    pg8::gemm_phase<Epi5<false>, pg8::StaticOrder, false>((PG8_LAS unsigned char*)smem, g, S, E, nullptr);
  }
  {
    pg8::Gemm g{(const u16*)(ws + OFF_YB), (const u16*)(ws + OFF_WB), T, 1024, 512};
    Epi5<true> E{(const u16*)p.out, (u16*)(ws + OFF_H), (u16*)(ws + OFF_M)};
    pg8::gemm_phase<Epi5<true>, pg8::StaticOrder, false>((PG8_LAS unsigned char*)smem, g, S, E, nullptr);
  }
}

DI void phase6(const Params& p, unsigned char* smem, bool dup = false) {
  unsigned char* ws = p.ws;
  pg8::Gemm g{(const u16*)(ws + OFF_M), (const u16*)(ws + OFF_WO), T, 1024, 1024};
  pg8::StaticOrder S; S.init(T, 1024, (int)gridDim.x, (int)blockIdx.x);
  Epi6 E{(u16*)(ws + OFF_H), (float*)(ws + OFF_SSQ) + 2 * T, dup};
  pg8::gemm_phase<Epi6, pg8::StaticOrder, false>((PG8_LAS unsigned char*)smem, g, S, E, nullptr);
}

DI void phase7(const Params& p) {
  const float* ssq_y = (const float*)(p.ws + OFF_SSQ) + 2 * T;
  const u2v* Y = (const u2v*)(p.ws + OFF_H);
  const int gtid = blockIdx.x * blockDim.x + threadIdx.x, gthreads = gridDim.x * blockDim.x;
  for (int i = gtid; i < T * 256; i += gthreads) {
    const int row = i >> 8, c4 = i & 255;
    const float rs = rsqrtf(ssq_y[row] * (1.f / 1024.f) + EPS);
    const u2v y = Y[i];
    const f4v xv = ((const f4v*)p.x)[i];
    const f4v g = ((const f4v*)p.g_post)[c4];
    f4v o;
    o.x = xv.x + bflo(y.x) * rs * g.x; o.y = xv.y + bfhi(y.x) * rs * g.y; o.z = xv.z + bflo(y.y) * rs * g.z; o.w = xv.w + bfhi(y.y) * rs * g.w;
    ((f4v*)p.out)[i] = o;
  }
}

__global__ void __launch_bounds__(512, 2) fwd_megakernel(Params p) {
  extern __shared__ __attribute__((aligned(16))) unsigned char smem[];
  u16* lds = (u16*)(smem + (threadIdx.x >> 8) * VLDS);
  cg::grid_group grid = cg::this_grid();
  volatile LAS unsigned* xst = (volatile LAS unsigned*)(smem + LDS_BYTES - 48);
  if (threadIdx.x == 0) { xst[0] = 0u; xst[1] = 0u; }
  __syncthreads();
  XcdBarrier xb = xcd_barrier_post((unsigned*)(p.ws + OFF_BAR), xst);
#define RUN_PHASE(N, CALL) if (p.ph_lo <= N && N < p.ph_hi) { if (N > p.ph_lo) xcd_barrier(xb); CALL; }
#define DUP_PHASE(N, CALL) if (DUP_PH == N) { xcd_barrier(xb); CALL; }
  RUN_PHASE(0, phase0(p))
  DUP_PHASE(0, phase0(p))
  if (p.ph_lo <= 1 && 1 < p.ph_hi) for (int rep = 0; rep < (DUP_PH == 1 ? 2 : 1); ++rep) { if (rep > 0 || 1 > p.ph_lo) xcd_barrier(xb); phase1(p, smem, rep > 0); }
  if (p.ph_lo <= 2 && 2 < p.ph_hi) for (int rep = 0; rep < (DUP_PH == 2 ? 2 : 1); ++rep) { if (rep > 0 || 2 > p.ph_lo) xcd_barrier(xb); phase2(p, smem, lds); }
  RUN_PHASE(4, phase3(p, smem))
  DUP_PHASE(4, phase3(p, smem, true))
  if (DUP_PH == 9) { xcd_barrier(xb); for (int i = blockIdx.x; i < 256; i += gridDim.x) scan_item(p, i, OFF_K); }
  RUN_PHASE(6, phase5(p, smem))
  DUP_PHASE(6, phase5(p, smem))
  RUN_PHASE(7, phase6(p, smem))
  DUP_PHASE(7, phase6(p, smem, true))
  RUN_PHASE(8, phase7(p))
  if (DUP_PH == 8) { xcd_barrier(xb); phase6(p, smem, true); xcd_barrier(xb); phase7(p); }
}

extern "C" void kernel_launch(void* const* d_in, const int* in_sizes, int n_in, void* d_out, int out_size, void* d_ws, size_t ws_size,
                              hipStream_t stream) {
  static int grid_blocks = 0;
  if (!grid_blocks) {
    int dev = 0, cus = 0, per_cu = 0;
    hipGetDevice(&dev);
    hipDeviceGetAttribute(&cus, hipDeviceAttributeMultiprocessorCount, dev);
    hipFuncSetAttribute((const void*)fwd_megakernel, hipFuncAttributeMaxDynamicSharedMemorySize, LDS_BYTES);
    hipOccupancyMaxActiveBlocksPerMultiprocessor(&per_cu, (const void*)fwd_megakernel, 512, LDS_BYTES);
    if (per_cu < 1) per_cu = 1;
    if (per_cu > 1) per_cu = 1;
    grid_blocks = cus * per_cu;
    if (ws_size < WS_NEED) fprintf(stderr, "kernel_launch: workspace too small: %zu < %zu\n", ws_size, (size_t)WS_NEED);
  }
  if (ws_size < WS_NEED) return;
  Params p{};
  p.x = (const float*)d_in[0]; p.g_pre = (const float*)d_in[1]; p.w_in = (const float*)d_in[2]; p.b_gate = (const float*)d_in[3];
  p.g_q = (const float*)d_in[4]; p.w_uq = (const float*)d_in[5]; p.g_kv = (const float*)d_in[6]; p.w_ukv = (const float*)d_in[7];
  p.lb_logits = (const float*)d_in[8]; p.g_hgrn = (const float*)d_in[9]; p.w_a = (const float*)d_in[10]; p.w_b = (const float*)d_in[11];
  p.w_out = (const float*)d_in[12]; p.g_post = (const float*)d_in[13];
  p.out = (float*)d_out; p.ws = (unsigned char*)d_ws;
#if ONE_LAUNCH
  p.ph_lo = 0; p.ph_hi = 9;
  (void)hipMemsetAsync((unsigned char*)d_ws + OFF_BAR, 0, 16384, stream);
  void* args[] = {&p};
  hipError_t e = hipLaunchCooperativeKernel((const void*)fwd_megakernel, dim3(grid_blocks), dim3(512), args, LDS_BYTES, stream);
  if (e != hipSuccess) fprintf(stderr, "cooperative launch failed: %s (grid %d)\n", hipGetErrorString(e), grid_blocks);
#else
  for (int ph = 0; ph < 9; ++ph) {
    p.ph_lo = ph; p.ph_hi = ph + 1;
    (void)hipMemsetAsync((unsigned char*)d_ws + OFF_BAR, 0, 16384, stream);
    void* args[] = {&p};
    hipError_t e = hipLaunchCooperativeKernel((const void*)fwd_megakernel, dim3(grid_blocks), dim3(512), args, LDS_BYTES, stream);
    if (e != hipSuccess) fprintf(stderr, "cooperative launch failed: %s (grid %d)\n", hipGetErrorString(e), grid_blocks);
  }
#endif
}
```

```cpp
#include <hip/hip_runtime.h>
#include <hip/hip_cooperative_groups.h>
#include <cstdio>
namespace cg = cooperative_groups;

#define DI __device__ __forceinline__
#define VTID ((int)(threadIdx.x & 255))
#define VBID ((int)(blockIdx.x * 2 + (threadIdx.x >> 8)))
#define VBN ((int)(gridDim.x * 2))
typedef unsigned short u16;
typedef unsigned int u32;
typedef __attribute__((ext_vector_type(8))) short bf16x8;
typedef __attribute__((ext_vector_type(4))) short s16x4;
typedef __attribute__((ext_vector_type(16))) float f32x16;
typedef __attribute__((ext_vector_type(2))) __bf16 bf2_t;
typedef __attribute__((ext_vector_type(2))) float f2_t;
typedef __attribute__((ext_vector_type(4))) unsigned int u4v;
typedef __attribute__((ext_vector_type(2))) unsigned int u2v;
typedef __attribute__((ext_vector_type(4))) float f4v;
typedef __attribute__((ext_vector_type(2))) float f2v;
#define MFMA(a, b, c) __builtin_amdgcn_mfma_f32_32x32x16_bf16((a), (b), (c), 0, 0, 0)

#ifndef DUP_PH
#define DUP_PH -1
#endif
#ifndef ONE_LAUNCH
#define ONE_LAUNCH 1
#endif

constexpr int T = 32768;
constexpr int SEQ = 4096;
constexpr int DIN = 5664;
constexpr int NP = 5888;
constexpr float EPS = 1e-6f;
constexpr float QSCALE = 1.4426950408889634f * 0.10206207261596575f;

constexpr size_t SZ_WIN = (size_t)NP * 1024 * 2;
constexpr size_t OFF_WIN = 0;
constexpr size_t OFF_WUQ = OFF_WIN + SZ_WIN;
constexpr size_t OFF_WUKV = OFF_WUQ + (size_t)768 * 768 * 2;
constexpr size_t OFF_WA = OFF_WUKV + (size_t)1024 * 256 * 2;
constexpr size_t OFF_WB = OFF_WA + (size_t)1024 * 512 * 2;
constexpr size_t OFF_WO = OFF_WB + (size_t)1024 * 512 * 2;
constexpr size_t OFF_ROPE = OFF_WO + (size_t)1024 * 1024 * 2;
constexpr size_t OFF_SSQ = OFF_ROPE + (size_t)4096 * 16 * 2 * 4;
constexpr size_t OFF_DECAY = OFF_SSQ + (size_t)(3 * T + 256) * 4;
constexpr size_t OFF_H = OFF_DECAY + (size_t)64 * 128 * 64 * 4;
constexpr size_t OFF_Q = OFF_H;
constexpr size_t OFF_CQ = OFF_H + (size_t)T * 1024 * 2;
constexpr size_t OFF_YA = OFF_CQ;
constexpr size_t OFF_CKV = OFF_CQ + (size_t)T * 768 * 2;
constexpr size_t OFF_KPE = OFF_CKV + (size_t)T * 256 * 2;
constexpr size_t OFF_SGA = OFF_KPE + (size_t)T * 32 * 4;
constexpr size_t OFF_SGB = OFF_SGA + (size_t)T * 512 * 2;
constexpr size_t OFF_HQ = OFF_SGB + (size_t)T * 512 * 2;
constexpr size_t OFF_UPD = OFF_HQ;
constexpr size_t OFF_HF = OFF_HQ + (size_t)T * 512 * 2;
constexpr size_t OFF_HI = OFF_HF + (size_t)T * 512 * 2;
constexpr size_t OFF_YB = OFF_HI;
constexpr size_t OFF_QDEC = OFF_HI + (size_t)T * 512 * 2;
constexpr size_t OFF_KINV = OFF_QDEC + (size_t)T * 512 * 2;
constexpr size_t OFF_VT = OFF_KINV + (size_t)T * 512 * 2;
constexpr size_t OFF_K = OFF_VT + (size_t)T * 512 * 2;
constexpr size_t OFF_M = OFF_K;
constexpr size_t OFF_VTT = OFF_K + (size_t)T * 768 * 2;
constexpr size_t OFF_BAR = OFF_VTT + (size_t)T * 512 * 2;
constexpr size_t WS_NEED = OFF_BAR + 16384;

constexpr int VLDS = 2 * 2 * 128 * 72 * 2;
constexpr int LDS_BYTES = 2 * VLDS + 64;
constexpr int SST = 132;

struct Params {
  const float *x, *g_pre, *w_in, *b_gate, *g_q, *w_uq, *g_kv, *w_ukv, *lb_logits, *g_hgrn, *w_a, *w_b, *w_out, *g_post;
  float* out;
  unsigned char* ws;
  int ph_lo, ph_hi;
};

DI u32 pk2(float a, float b) { f2_t v = {a, b}; bf2_t r = __builtin_convertvector(v, bf2_t); return __builtin_bit_cast(u32, r); }
DI float bflo(u32 u) { return __uint_as_float(u << 16); }
DI float bfhi(u32 u) { return __uint_as_float(u & 0xffff0000u); }
DI u4v pk8(f4v a, f4v b) { u4v r; r.x = pk2(a.x, a.y); r.y = pk2(a.z, a.w); r.z = pk2(b.x, b.y); r.w = pk2(b.z, b.w); return r; }
DI float rcpf(float x) { return __builtin_amdgcn_rcpf(x); }
DI float sigmoidf_(float x) { return rcpf(1.f + __expf(-x)); }
DI float siluf_(float x) { return x * sigmoidf_(x); }
DI float xor32_max(float x) { const unsigned u = __float_as_uint(x); auto r = __builtin_amdgcn_permlane32_swap(u, u, false, false); return fmaxf(__uint_as_float(r[0]), __uint_as_float(r[1])); }
DI float xor32_add(float x) { const unsigned u = __float_as_uint(x); auto r = __builtin_amdgcn_permlane32_swap(u, u, false, false); return __uint_as_float(r[0]) + __uint_as_float(r[1]); }
DI float xor16_add(float x) { const unsigned u = __float_as_uint(x); auto r = __builtin_amdgcn_permlane16_swap(u, u, false, false); return __uint_as_float(r[0]) + __uint_as_float(r[1]); }
DI int crow(int reg, int h) { return (reg & 3) + 8 * (reg >> 2) + 4 * h; }
DI f32x16 zero16() { f32x16 z;
#pragma unroll
  for (int i = 0; i < 16; ++i) z[i] = 0.f; return z; }

__constant__ float c_invfreq[16] = {1.0f, 0.5623413324356079f, 0.3162277638912201f, 0.17782793939113617f, 0.10000000149011612f,
  0.05623413249850273f, 0.03162277489900589f, 0.017782794311642647f, 0.009999999776482582f, 0.005623413249850273f,
  0.003162277629598975f, 0.0017782794311642647f, 0.0010000000474974513f, 0.000562341301701963f, 0.0003162277571391314f,
  0.00017782794020604342f};

DI void sincos_d(double a, float& sn, float& cs) {
  const double k = rint(a * 0.63661977236758134308);
  const double y = a - k * 1.57079632679489661923;
  const double y2 = y * y;
  const double s = y * (1.0 + y2 * (-1.0 / 6 + y2 * (1.0 / 120 + y2 * (-1.0 / 5040 + y2 * (1.0 / 362880 + y2 * (-1.0 / 39916800 + y2 * (1.0 / 6227020800.0)))))));
  const double c = 1.0 + y2 * (-0.5 + y2 * (1.0 / 24 + y2 * (-1.0 / 720 + y2 * (1.0 / 40320 + y2 * (-1.0 / 3628800 + y2 * (1.0 / 479001600.0 + y2 * (-1.0 / 87178291200.0)))))));
  const int q = ((int)k) & 3;
  const double ss = (q == 0) ? s : (q == 1) ? c : (q == 2) ? -s : -c;
  const double cc = (q == 0) ? c : (q == 1) ? -s : (q == 2) ? -c : s;
  sn = (float)ss; cs = (float)cc;
}

#define XB_TMO      128
#define XB_XCNT(j)  (256  + 64 * (j))
#define XB_XSUB(j)  (1280 + 64 * (j))
#define XB_XGEN(j)  (2304 + 64 * (j))
#define XB_TOP      3328
#define XB_TOPGEN   3392
#define XCD_BAR_WORDS 3456
#define XB_SPIN_CAP (1u << 22)
#define LAS __attribute__((address_space(3)))
DI unsigned xb_ld(unsigned* p)              { return __hip_atomic_load(p, __ATOMIC_RELAXED, __HIP_MEMORY_SCOPE_AGENT); }
DI unsigned xb_add(unsigned* p, unsigned v) { return __hip_atomic_fetch_add(p, v, __ATOMIC_RELAXED, __HIP_MEMORY_SCOPE_AGENT); }
DI unsigned xb_xcc_id() { return (unsigned)__builtin_amdgcn_s_getreg((3 << 11) | 20) & 0xFu; }
#define XB_SPIN(cond, bar) do { unsigned _sp = 0; while (cond) { __builtin_amdgcn_s_sleep(1); \
    if ((++_sp & 255u) == 0u) { if (xb_ld(&(bar)[XB_TMO])) break; if (_sp > XB_SPIN_CAP) { atomicAdd(&(bar)[XB_TMO], 1u); break; } } } } while (0)
struct XcdBarrier { unsigned* bar; unsigned x; volatile LAS unsigned* st; };
DI XcdBarrier xcd_barrier_post(unsigned* bar, volatile LAS unsigned* st) {
  XcdBarrier b; b.bar = bar; b.x = xb_xcc_id(); b.st = st;
  if (threadIdx.x == 0) (void)xb_add(&bar[XB_XCNT(b.x)], 1u);
  return b;
}
DI void xcd_barrier_complete(unsigned* bar, unsigned x, unsigned& nloc, unsigned& nx) {
  const unsigned G = gridDim.x * gridDim.y * gridDim.z;
  unsigned sum, cnt, mine, sp = 0u;
  for (;;) {
    sum = 0u; cnt = 0u; mine = 0u;
#pragma unroll
    for (unsigned j = 0; j < 16; ++j) { const unsigned c = xb_ld(&bar[XB_XCNT(j)]); sum += c; cnt += (c > 0u) ? 1u : 0u; mine = (j == x) ? c : mine; }
    if (sum == G) break;
    __builtin_amdgcn_s_sleep(1);
    if ((++sp & 255u) == 0u) { if (xb_ld(&bar[XB_TMO])) break; if (sp > XB_SPIN_CAP) { atomicAdd(&bar[XB_TMO], 1u); break; } }
  }
  nloc = mine > 0u ? mine : 1u; nx = cnt > 0u ? cnt : 1u;
}
DI void xcd_barrier(const XcdBarrier& b) {
  asm volatile("s_waitcnt vmcnt(0)" ::: "memory");
  __syncthreads();
  if (threadIdx.x == 0) {
    unsigned* bar = b.bar;
    __builtin_amdgcn_s_waitcnt(0);
    unsigned nloc = b.st[0], nx = b.st[1];
    if (nloc == 0u) { xcd_barrier_complete(bar, b.x, nloc, nx); b.st[0] = nloc; b.st[1] = nx; }
    const unsigned old = xb_add(&bar[XB_XSUB(b.x)], 1u);
    const unsigned gen = old / nloc;
    if (old + 1u == (gen + 1u) * nloc) {
      __builtin_amdgcn_fence(__ATOMIC_RELEASE, "agent");
      asm volatile("s_waitcnt vmcnt(0)" ::: "memory");
      const unsigned og = xb_add(&bar[XB_TOP], 1u);
      const unsigned tg = og / nx;
      if (og + 1u == (tg + 1u) * nx) xb_add(&bar[XB_TOPGEN], 1u);
      else XB_SPIN(xb_ld(&bar[XB_TOPGEN]) == tg, bar);
      __builtin_amdgcn_fence(__ATOMIC_ACQUIRE, "agent");
      xb_add(&bar[XB_XGEN(b.x)], 1u);
      asm volatile("s_waitcnt vmcnt(0)" ::: "memory");
    } else {
      XB_SPIN(xb_ld(&bar[XB_XGEN(b.x)]) == gen, bar);
      __builtin_amdgcn_fence(__ATOMIC_ACQUIRE, "agent");
      asm volatile("s_waitcnt vmcnt(0)" ::: "memory");
    }
  }
  __syncthreads();
}

template <int KIND>
DI int colmap(int n) {
  if (KIND == 0) {
    if (n < 1024) return n;
    if (n < 1536) return 1056 + (n - 1024);
    if (n < 2048) return 3104 + (n - 1536);
    if (n < 4096) return 3616 + (n - 2048);
    if (n < 4608) return 1568 + (n - 4096);
    if (n < 5120) return 2080 + (n - 4608);
    if (n < 5632) return 2592 + (n - 5120);
    if (n < 5664) return 1024 + (n - 5632);
    return -1;
  } else if (KIND == 1) {
    if (n < 512) return (n >> 6) * 96 + (n & 63);
    int i = n - 512; int w = i & 31, g = w >> 3, e = w & 7; return (i >> 5) * 96 + 64 + ((e < 4) ? (4 * g + e) : (16 + 4 * g + (e - 4)));
  } else if (KIND == 3) {
    if (n < 512) return (n >> 6) * 128 + (n & 63);
    int i = n - 512; return (i >> 6) * 128 + 64 + (i & 63);
  } else return n;
}
template <int KIND>
DI void conv_weight(u16* dst, const float* src, int ldw, int ncount, int K, const float* gain, int gmask, int gtid, int gthreads) {
  const int total = ncount * (K >> 3);
  for (int it = gtid; it < total; it += gthreads) {
    const int n = it % ncount, kc = it / ncount;
    const int sc = colmap<KIND>(n);
    float v[8];
#pragma unroll
    for (int i = 0; i < 8; ++i) {
      const int k = kc * 8 + i;
      float x = (sc >= 0) ? src[(size_t)k * ldw + sc] : 0.f;
      if (gain) x *= gain[k & gmask];
      v[i] = x;
    }
    u4v o; o.x = pk2(v[0], v[1]); o.y = pk2(v[2], v[3]); o.z = pk2(v[4], v[5]); o.w = pk2(v[6], v[7]);
    *(u4v*)(dst + (size_t)n * K + kc * 8) = o;
  }
}

DI void phase0(const Params& p) {
  unsigned char* ws = p.ws;
  const int gtid = blockIdx.x * blockDim.x + threadIdx.x, gthreads = gridDim.x * blockDim.x;
  float* ssq = (float*)(ws + OFF_SSQ);
  for (int i = gtid; i < 3 * T + 256; i += gthreads) ssq[i] = 0.f;
  float* rope = (float*)(ws + OFF_ROPE);
  for (int i = gtid; i < 4096 * 16; i += gthreads) {
    const int pos = i >> 4, j = i & 15;
    const float ang = (float)pos * c_invfreq[j];
    float sn, cs; sincos_d((double)ang, sn, cs);
    rope[i] = cs; rope[65536 + i] = sn;
  }
  conv_weight<0>((u16*)(ws + OFF_WIN), p.w_in, DIN, NP, 1024, nullptr, 0, gtid, gthreads);
  u16* H = (u16*)(ws + OFF_H);
  const int lane = threadIdx.x & 63;
  const int gw = gtid >> 6, nw = gthreads >> 6;
  for (int row = gw; row < T; row += nw) {
    const f4v* xr = (const f4v*)(p.x + (size_t)row * 1024);
    f4v v[4];
    float ss = 0.f;
#pragma unroll
    for (int i = 0; i < 4; ++i) { v[i] = xr[lane * 4 + i]; ss += v[i].x * v[i].x + v[i].y * v[i].y + v[i].z * v[i].z + v[i].w * v[i].w; }
#pragma unroll
    for (int o = 32; o >= 1; o >>= 1) ss += __shfl_xor(ss, o);
    const float rs = rsqrtf(ss * (1.f / 1024.f) + EPS);
    const f4v* gp = (const f4v*)(p.g_pre);
    f4v g[4];
#pragma unroll
    for (int i = 0; i < 4; ++i) { g[i] = gp[lane * 4 + i]; v[i].x *= rs * g[i].x; v[i].y *= rs * g[i].y; v[i].z *= rs * g[i].z; v[i].w *= rs * g[i].w; }
    u4v* hr = (u4v*)(H + (size_t)row * 1024 + lane * 16);
    hr[0] = pk8(v[0], v[1]); hr[1] = pk8(v[2], v[3]);
  }
}

constexpr int TS = 128 * 72;
DI void gemm_ld(u4v (&ra)[4], u4v (&rb)[4], const u16* ga, const u16* gb, int lda, int ldb, int ko) {
#pragma unroll
  for (int i = 0; i < 4; ++i) { ra[i] = *(const u4v*)(ga + (size_t)(32 * i) * lda + ko); rb[i] = *(const u4v*)(gb + (size_t)(32 * i) * ldb + ko); }
}
DI void gemm_st(const u4v (&ra)[4], const u4v (&rb)[4], u16* buf, int lr, int lc) {
  u16* sa = buf; u16* sb = buf + TS;
#pragma unroll
  for (int i = 0; i < 4; ++i) { *(u4v*)(sa + (lr + 32 * i) * 72 + lc * 8) = ra[i]; *(u4v*)(sb + (lr + 32 * i) * 72 + lc * 8) = rb[i]; }
}
DI void gemm_mma(const u16* buf, f32x16 (&acc)[2][2], int wm, int wn, int r, int h) {
  const u16* sa = buf + (wm * 64 + r) * 72 + h * 8;
  const u16* sb = buf + TS + (wn * 64 + r) * 72 + h * 8;
#pragma unroll
  for (int ks = 0; ks < 4; ++ks) {
    const bf16x8 a0 = *(const bf16x8*)(sa + ks * 16);
    const bf16x8 a1 = *(const bf16x8*)(sa + 32 * 72 + ks * 16);
    const bf16x8 b0 = *(const bf16x8*)(sb + ks * 16);
    const bf16x8 b1 = *(const bf16x8*)(sb + 32 * 72 + ks * 16);
    acc[0][0] = MFMA(a0, b0, acc[0][0]);
    acc[0][1] = MFMA(a0, b1, acc[0][1]);
    acc[1][0] = MFMA(a1, b0, acc[1][0]);
    acc[1][1] = MFMA(a1, b1, acc[1][1]);
  }
}
DI void gemm_core(const u16* __restrict__ A, int lda, const u16* __restrict__ B, int ldb, int K, u16* lds, f32x16 (&acc)[2][2], int tid) {
  const int lane = tid & 63, w = tid >> 6, wm = w >> 1, wn = w & 1, r = lane & 31, h = lane >> 5;
  const int lc = tid & 7, lr = tid >> 3;
  const u16* ga = A + (size_t)lr * lda + lc * 8;
  const u16* gb = B + (size_t)lr * ldb + lc * 8;
  u4v ra0[4], rb0[4], ra1[4], rb1[4];
  gemm_ld(ra0, rb0, ga, gb, lda, ldb, 0);
  gemm_ld(ra1, rb1, ga, gb, lda, ldb, 64);
#pragma unroll
  for (int i = 0; i < 2; ++i)
#pragma unroll
    for (int j = 0; j < 2; ++j) acc[i][j] = zero16();
  u16* L0 = lds; u16* L1 = lds + 2 * TS;
  __syncthreads();
  gemm_st(ra0, rb0, L0, lr, lc);
  __syncthreads();
  const int nk = K >> 6;
  int kt = 0;
  for (; kt + 2 < nk; kt += 2) {
    gemm_ld(ra0, rb0, ga, gb, lda, ldb, (kt + 2) * 64);
    __builtin_amdgcn_sched_barrier(0);
    gemm_mma(L0, acc, wm, wn, r, h);
    gemm_st(ra1, rb1, L1, lr, lc);
    __syncthreads();
    gemm_ld(ra1, rb1, ga, gb, lda, ldb, (kt + 3) * 64);
    __builtin_amdgcn_sched_barrier(0);
    gemm_mma(L1, acc, wm, wn, r, h);
    gemm_st(ra0, rb0, L0, lr, lc);
    __syncthreads();
  }
  gemm_mma(L0, acc, wm, wn, r, h);
  gemm_st(ra1, rb1, L1, lr, lc);
  __syncthreads();
  gemm_mma(L1, acc, wm, wn, r, h);
  __syncthreads();
}

DI void stage_pass(const f32x16 (&acc)[2][2], float* stage, int p, int tid) {
  const int lane = tid & 63, w = tid >> 6, wm = w >> 1, wn = w & 1, r = lane & 31, h = lane >> 5;
  __syncthreads();
  if (wm == p) {
#pragma unroll
    for (int i = 0; i < 2; ++i)
#pragma unroll
      for (int j = 0; j < 2; ++j)
#pragma unroll
        for (int reg = 0; reg < 16; ++reg) stage[(i * 32 + crow(reg, h)) * SST + wn * 64 + j * 32 + r] = acc[i][j][reg];
  }
  __syncthreads();
}

namespace pg8 {
#define PG8_LAS __attribute__((address_space(3)))
typedef unsigned short bf16_t;
typedef short bf16x8 __attribute__((ext_vector_type(8)));
typedef float f32x4 __attribute__((ext_vector_type(4)));
typedef unsigned u32x4 __attribute__((ext_vector_type(4)));
constexpr int BM = 256, BK = 64, HALF = 128, HTB = HALF * BK * 2  , STAGE_BYTES = 8 * HTB, NXCD = 8, WGM = 8;

__host__ __device__ __forceinline__ int lds_byte(int r, int c) { const int st = (r >> 4) * 2 + (c >> 5), rr = r & 15, cc = c & 31, ob = rr * 64 + cc * 2; return st * 1024 + (ob ^ (((ob >> 9) & 1) << 5)); }
__host__ __device__ __forceinline__ void stage_rc(int b, int& R, int& C) { const int st = b / 1024, sb = b % 1024, swz = sb ^ (((sb >> 9) & 1) << 5); R = (st >> 1) * 16 + swz / 64; C = (st & 1) * 32 + (swz % 64) / 2; }
__host__ __device__ __forceinline__ int perm32(int rho) { const int n = rho >> 4, i = rho & 15; return 8 * (i >> 2) + 4 * n + (i & 3); }

struct Unit { int pm, pn; };
struct Gemm { const bf16_t* A; const bf16_t* Bt; int M, N, K; };

struct StaticOrder {
    int nM, nN, nwg, G, c;
    __host__ __device__ void init(int M, int N, int G_, int c_) { nM = M / BM; nN = N / BM; nwg = nM * nN; G = G_; c = c_; }
    __host__ __device__ bool next(int i, Unit& u) const {
        const long L = (long)i * G + c; if (L >= nwg) return false;
        int wgid = (int)L; { const int q = nwg / NXCD, r = nwg % NXCD, xcd = wgid % NXCD, off = wgid / NXCD; wgid = (xcd < r ? xcd * (q + 1) : r * (q + 1) + (xcd - r) * q) + off; }
        const int nig = WGM * nN, gid = wgid / nig, fm = gid * WGM, gsz = (nM - fm) < WGM ? (nM - fm) : WGM;
        u.pm = fm + ((wgid % nig) % gsz); u.pn = (wgid % nig) / gsz; return true;
    }
    __device__ __forceinline__ void a_ready(const Unit&) const {}
    __device__ __forceinline__ void done(const Unit&) const {}
};
template <class Epi, class Sched, bool STAMP = false, bool SWAP = false>
__device__ __forceinline__ void gemm_phase(PG8_LAS unsigned char* lds, const Gemm g, const Sched& S, const Epi& E, unsigned long long* stamps) {
    const int tid = threadIdx.x, wid = __builtin_amdgcn_readfirstlane(tid >> 6), lane = tid & 63, wr = wid >> 2, wc = wid & 3, fr = lane & 15, fq = lane >> 4;
    const int K = g.K, nt = K / BK;
    int ts_lo = 0, ts_hi = 0, nts = 0; const unsigned long long rt_entry = STAMP ? (unsigned long long)wall_clock64() : 0ull;
#define PG8_STAMP() do { if (STAMP && wid == 0 && nts < 64) { const unsigned long long _c = (unsigned long long)clock64(); \
        ts_lo = (lane == nts) ? (int)(unsigned)_c : ts_lo; ts_hi = (lane == nts) ? (int)(unsigned)(_c >> 32) : ts_hi; ++nts; } } while (0)
    PG8_STAMP();
    unsigned voffA[2], voffB[2];
#pragma unroll
    for (int i = 0; i < 2; ++i) { int R, C; stage_rc(tid * 16 + i * 8192, R, C); const int Rb = Epi::PERM ? ((R & ~31) + perm32(R & 31)) : R;
        voffA[i] = (unsigned)(R * K + C) * 2u; voffB[i] = (unsigned)(Rb * K + C) * 2u; }
    const size_t kstep = (size_t)(BK * 2);
    const size_t hstep = (size_t)HALF * K * 2;
    const size_t tstep = 2 * hstep;
    const unsigned ldsw = (unsigned)wid * 1024u;
    const int aoff = lds_byte(wr * 64 + fr, fq * 8), boff = lds_byte(wc * 32 + fr, fq * 8);
#define PG8_SA(b, h) (((b) * 2 + (h)) * HTB)
#define PG8_SB(b, h) ((4 + (b) * 2 + (h)) * HTB)
#define PG8_STAGE(bufoff, gbase, voff) do { _Pragma("unroll") for (int _i = 0; _i < 2; ++_i) \
        __builtin_amdgcn_global_load_lds((const unsigned*)((const char*)(gbase) + (voff)[_i]), (PG8_LAS unsigned*)(lds + (bufoff) + ldsw + _i * 8192), 16, 0, 0); } while (0)
#define PG8_LDA(dst, b, h) do { _Pragma("unroll") for (int m = 0; m < 4; ++m) _Pragma("unroll") for (int k = 0; k < 2; ++k) dst[m][k] = *(const PG8_LAS bf16x8*)(lds + PG8_SA(b, h) + aoff + m * 2048 + k * 1024); } while (0)
#define PG8_LDB(dst, b, h) do { _Pragma("unroll") for (int n = 0; n < 2; ++n) _Pragma("unroll") for (int k = 0; k < 2; ++k) dst[n][k] = *(const PG8_LAS bf16x8*)(lds + PG8_SB(b, h) + boff + n * 2048 + k * 1024); } while (0)
#define PG8_MMA(ai, bj, At, Bt) do { __builtin_amdgcn_s_setprio(1); _Pragma("unroll") for (int m = 0; m < 4; ++m) _Pragma("unroll") for (int n = 0; n < 2; ++n) _Pragma("unroll") for (int k = 0; k < 2; ++k) \
        acc[ai][bj][m][n] = SWAP ? __builtin_amdgcn_mfma_f32_16x16x32_bf16(At[m][k], Bt[n][k], acc[ai][bj][m][n], 0, 0, 0) : __builtin_amdgcn_mfma_f32_16x16x32_bf16(Bt[n][k], At[m][k], acc[ai][bj][m][n], 0, 0, 0); __builtin_amdgcn_s_setprio(0); } while (0)
#define PG8_WAIT_V(n) asm volatile("s_waitcnt vmcnt(" #n ")" ::: "memory")
#define PG8_WAIT_L(n) asm volatile("s_waitcnt lgkmcnt(" #n ")" ::: "memory")
#define PG8_BAR __builtin_amdgcn_s_barrier()
#define PG8_SCHED __builtin_amdgcn_sched_barrier(0)
    Unit cur, nxt; int ui = 0;
    if (!S.next(0, cur)) return;
    f32x4 acc[2][2][4][2];
#pragma unroll
    for (int a = 0; a < 2; ++a)
#pragma unroll
        for (int b = 0; b < 2; ++b)
#pragma unroll
            for (int m = 0; m < 4; ++m)
#pragma unroll
                for (int n = 0; n < 2; ++n) acc[a][b][m][n] = (f32x4){0.f, 0.f, 0.f, 0.f};
    bf16x8 At[4][2], B0[2][2], B1[2][2];
    const char* cA = (const char*)g.A + (size_t)cur.pm * tstep; const char* cB = (const char*)g.Bt + (size_t)cur.pn * tstep;
    S.a_ready(cur);
    PG8_STAGE(PG8_SB(0, 0), cB, voffB); PG8_STAGE(PG8_SA(0, 0), cA, voffA); PG8_STAGE(PG8_SB(0, 1), cB + hstep, voffB); PG8_STAGE(PG8_SA(0, 1), cA + hstep, voffA);
    if (wr == 1) PG8_BAR;
    PG8_WAIT_V(4); PG8_BAR;
    PG8_STAGE(PG8_SB(1, 0), cB + kstep, voffB); PG8_STAGE(PG8_SA(1, 0), cA + kstep, voffA); PG8_STAGE(PG8_SB(1, 1), cB + hstep + kstep, voffB);
    PG8_WAIT_V(6); PG8_BAR;
    PG8_STAMP();
    for (;;) {
        const bool has_next = S.next(ui + 1, nxt);
        const char* nA = has_next ? (const char*)g.A + (size_t)nxt.pm * tstep : cA; const char* nB = has_next ? (const char*)g.Bt + (size_t)nxt.pn * tstep : cB;
        for (int t = 0; t < nt; t += 2) {
            const bool last = (t == nt - 2);
            const char* a1 = cA + (size_t)(t + 1) * kstep;
            const char* a2 = last ? nA : cA + (size_t)(t + 2) * kstep; const char* b2 = last ? nB : cB + (size_t)(t + 2) * kstep;
            const char* a3 = a2 + kstep; const char* b3 = b2 + kstep;
            if (last && has_next) S.a_ready(nxt);
            PG8_LDB(B0, 0, 0); PG8_SCHED; PG8_LDA(At, 0, 0); PG8_STAGE(PG8_SA(1, 1), a1 + hstep, voffA);
            PG8_WAIT_L(8); PG8_BAR; PG8_WAIT_L(0); PG8_MMA(0, 0, At, B0); PG8_BAR; PG8_SCHED;
            PG8_LDB(B1, 0, 1); PG8_STAGE(PG8_SB(0, 0), b2, voffB);
            PG8_BAR; PG8_WAIT_L(0); PG8_MMA(0, 1, At, B1); PG8_BAR;
            PG8_LDA(At, 0, 1); PG8_STAGE(PG8_SA(0, 0), a2, voffA);
            PG8_BAR; PG8_WAIT_L(0); PG8_MMA(1, 0, At, B0); PG8_BAR; PG8_SCHED;
            PG8_STAGE(PG8_SB(0, 1), b2 + hstep, voffB);
            PG8_WAIT_V(6); PG8_BAR; PG8_MMA(1, 1, At, B1); PG8_BAR;
            PG8_LDB(B0, 1, 0); PG8_SCHED; PG8_LDA(At, 1, 0); PG8_STAGE(PG8_SA(0, 1), a2 + hstep, voffA);
            PG8_WAIT_L(8); PG8_BAR; PG8_WAIT_L(0); PG8_MMA(0, 0, At, B0); PG8_BAR; PG8_SCHED;
            PG8_LDB(B1, 1, 1); PG8_STAGE(PG8_SB(1, 0), b3, voffB);
            PG8_BAR; PG8_WAIT_L(0); PG8_MMA(0, 1, At, B1); PG8_BAR;
            PG8_LDA(At, 1, 1); PG8_STAGE(PG8_SA(1, 0), a3, voffA);
            PG8_BAR; PG8_WAIT_L(0); PG8_MMA(1, 0, At, B0); PG8_BAR; PG8_SCHED;
            PG8_STAGE(PG8_SB(1, 1), b3 + hstep, voffB);
            PG8_WAIT_V(6); PG8_BAR; PG8_MMA(1, 1, At, B1); PG8_BAR;
        }
        PG8_STAMP();
        if constexpr (!Epi::AFTER_DRAIN) { E(acc, cur, wr, wc, fr, fq); S.done(cur); }
        PG8_STAMP();
        if (!has_next) break;
#pragma unroll
        for (int a = 0; a < 2; ++a)
#pragma unroll
            for (int b = 0; b < 2; ++b)
#pragma unroll
                for (int m = 0; m < 4; ++m)
#pragma unroll
                    for (int n = 0; n < 2; ++n) acc[a][b][m][n] = (f32x4){0.f, 0.f, 0.f, 0.f};
        cur = nxt; cA = nA; cB = nB; ++ui;
    }
    PG8_WAIT_V(0);
    if (wr == 0) PG8_BAR;
    PG8_BAR;
    if constexpr (Epi::AFTER_DRAIN) { E.fused(acc, cur, wr, wc, fr, fq, lds, wid, lane); S.done(cur); }
    PG8_STAMP();
    if (STAMP && wid == 0) { stamps[lane] = lane < nts ? (((unsigned long long)(unsigned)ts_hi << 32) | (unsigned)ts_lo) : 0ull;
        if (lane == 62) stamps[62] = rt_entry; if (lane == 63) stamps[63] = (unsigned long long)wall_clock64(); }
#undef PG8_STAMP
#undef PG8_SA
#undef PG8_SB
#undef PG8_STAGE
#undef PG8_LDA
#undef PG8_LDB
#undef PG8_MMA
#undef PG8_WAIT_V
#undef PG8_WAIT_L
#undef PG8_BAR
#undef PG8_SCHED
}
}

struct Epi1 {
  static constexpr bool PERM = true, AFTER_DRAIN = false;
  unsigned char* ws; u16* mg; const float* b_gate; bool dup;
  DI void operator()(const pg8::f32x4 (&acc)[2][2][4][2], const pg8::Unit& u, int wr, int wc, int fr, int fq) const {
    const int pn = u.pn;
    const int rowb = u.pm * 256 + wr * 64 + fr;
    const int colu = wc * 32 + 8 * fq;
    if (pn < 4) {
      u16* dst = (pn < 3) ? (u16*)(ws + OFF_CQ) + pn * 256 : (u16*)(ws + OFF_CKV);
      const int ld = (pn < 3) ? 768 : 256;
      float* ssq = (float*)(ws + OFF_SSQ) + ((pn < 3) ? 0 : T);
#pragma unroll
      for (int ai = 0; ai < 2; ++ai)
#pragma unroll
        for (int m = 0; m < 4; ++m) {
          const int row = rowb + ai * 128 + m * 16;
          float ss = 0.f;
#pragma unroll
          for (int bj = 0; bj < 2; ++bj) {
            const pg8::f32x4 v0 = acc[ai][bj][m][0], v1 = acc[ai][bj][m][1];
            ss += v0[0] * v0[0] + v0[1] * v0[1] + v0[2] * v0[2] + v0[3] * v0[3] + v1[0] * v1[0] + v1[1] * v1[1] + v1[2] * v1[2] + v1[3] * v1[3];
            u4v o; o.x = pk2(v0[0], v0[1]); o.y = pk2(v0[2], v0[3]); o.z = pk2(v1[0], v1[1]); o.w = pk2(v1[2], v1[3]);
            *(u4v*)(dst + (size_t)row * ld + bj * 128 + colu) = o;
          }
          ss = xor16_add(ss); ss = xor32_add(ss);
          if (fq == 0 && !dup) atomicAdd(ssq + row, ss);
        }
    } else if (pn < 8) {
      u16* dst = (u16*)(ws + ((pn < 6) ? OFF_SGA : OFF_SGB)) + (pn & 1) * 256;
#pragma unroll
      for (int ai = 0; ai < 2; ++ai)
#pragma unroll
        for (int m = 0; m < 4; ++m) {
          const int row = rowb + ai * 128 + m * 16;
#pragma unroll
          for (int bj = 0; bj < 2; ++bj) {
            const pg8::f32x4 v0 = acc[ai][bj][m][0], v1 = acc[ai][bj][m][1];
            u4v o; o.x = pk2(siluf_(v0[0]), siluf_(v0[1])); o.y = pk2(siluf_(v0[2]), siluf_(v0[3]));
            o.z = pk2(siluf_(v1[0]), siluf_(v1[1])); o.w = pk2(siluf_(v1[2]), siluf_(v1[3]));
            *(u4v*)(dst + (size_t)row * 512 + bj * 128 + colu) = o;
          }
        }
    } else if (pn >= 16) {
      if (pn < 22) {
        u16* dst = (u16*)(ws + ((pn < 18) ? OFF_HQ : (pn < 20) ? OFF_HF : OFF_HI)) + (pn & 1) * 256;
#pragma unroll
        for (int ai = 0; ai < 2; ++ai)
#pragma unroll
          for (int m = 0; m < 4; ++m) {
            const int row = rowb + ai * 128 + m * 16;
#pragma unroll
            for (int bj = 0; bj < 2; ++bj) {
              const pg8::f32x4 v0 = acc[ai][bj][m][0], v1 = acc[ai][bj][m][1];
              u4v o; o.x = pk2(v0[0], v0[1]); o.y = pk2(v0[2], v0[3]); o.z = pk2(v1[0], v1[1]); o.w = pk2(v1[2], v1[3]);
              *(u4v*)(dst + (size_t)row * 512 + bj * 128 + colu) = o;
            }
          }
      } else if (colu < 32) {
        float* dst = (float*)(ws + OFF_KPE);
#pragma unroll
        for (int ai = 0; ai < 2; ++ai)
#pragma unroll
          for (int m = 0; m < 4; ++m) {
            const int row = rowb + ai * 128 + m * 16;
            *(pg8::f32x4*)(dst + (size_t)row * 32 + colu) = acc[ai][0][m][0];
            *(pg8::f32x4*)(dst + (size_t)row * 32 + colu + 4) = acc[ai][0][m][1];
          }
      }
    } else {
      const int cb = (pn - 8) * 256 + colu;
      f4v b0[2], b1[2];
#pragma unroll
      for (int bj = 0; bj < 2; ++bj) { b0[bj] = *(const f4v*)(b_gate + cb + bj * 128); b1[bj] = *(const f4v*)(b_gate + cb + bj * 128 + 4); }
#pragma unroll
      for (int ai = 0; ai < 2; ++ai)
#pragma unroll
        for (int m = 0; m < 4; ++m) {
          const int row = rowb + ai * 128 + m * 16;
#pragma unroll
          for (int bj = 0; bj < 2; ++bj) {
            const pg8::f32x4 v0 = acc[ai][bj][m][0], v1 = acc[ai][bj][m][1];
            u4v o; o.x = pk2(sigmoidf_(v0[0] + b0[bj].x), sigmoidf_(v0[1] + b0[bj].y)); o.y = pk2(sigmoidf_(v0[2] + b0[bj].z), sigmoidf_(v0[3] + b0[bj].w));
            o.z = pk2(sigmoidf_(v1[0] + b1[bj].x), sigmoidf_(v1[1] + b1[bj].y)); o.w = pk2(sigmoidf_(v1[2] + b1[bj].z), sigmoidf_(v1[3] + b1[bj].w));
            *(u4v*)(mg + ((((size_t)(u.pm * 8 + (pn - 8)) * 8 + (wr * 4 + wc)) * 16 + (ai * 8 + m * 2 + bj)) * 64 + (fq * 16 + fr)) * 8) = o;
          }
        }
    }
  }
};


struct Epi6 {
  static constexpr bool PERM = true, AFTER_DRAIN = false;
  u16* out; float* ssq; bool dup;
  DI void operator()(const pg8::f32x4 (&acc)[2][2][4][2], const pg8::Unit& u, int wr, int wc, int fr, int fq) const {
    const int rowb = u.pm * 256 + wr * 64 + fr;
    const int colb = u.pn * 256 + wc * 32 + 8 * fq;
#pragma unroll
    for (int ai = 0; ai < 2; ++ai)
#pragma unroll
      for (int m = 0; m < 4; ++m) {
        const int row = rowb + ai * 128 + m * 16;
        float ss = 0.f;
#pragma unroll
        for (int bj = 0; bj < 2; ++bj) {
          const pg8::f32x4 v0 = acc[ai][bj][m][0], v1 = acc[ai][bj][m][1];
          ss += v0[0] * v0[0] + v0[1] * v0[1] + v0[2] * v0[2] + v0[3] * v0[3] + v1[0] * v1[0] + v1[1] * v1[1] + v1[2] * v1[2] + v1[3] * v1[3];
          u4v o; o.x = pk2(v0[0], v0[1]); o.y = pk2(v0[2], v0[3]); o.z = pk2(v1[0], v1[1]); o.w = pk2(v1[2], v1[3]);
          *(u4v*)(out + (size_t)row * 1024 + colb + bj * 128) = o;
        }
        ss = xor16_add(ss); ss = xor32_add(ss);
        if (fq == 0 && !dup) atomicAdd(ssq + row, ss);
      }
  }
};
template <bool SECOND> struct Epi5 {
  static constexpr bool PERM = true, AFTER_DRAIN = false;
  const u16* mg; u16* mi; u16* mo;
  DI void operator()(const pg8::f32x4 (&acc)[2][2][4][2], const pg8::Unit& u, int wr, int wc, int fr, int fq) const {
    const int rowb = u.pm * 256 + wr * 64 + fr;
    const int colb = u.pn * 256 + wc * 32 + 8 * fq;
    const size_t gbase = (((size_t)(u.pm * 8 + u.pn + (SECOND ? 4 : 0)) * 8 + (wr * 4 + wc)) * 16) * 64 + (fq * 16 + fr);
    const size_t ibase = (((size_t)(u.pm * 4 + u.pn) * 8 + (wr * 4 + wc)) * 16) * 64 + (fq * 16 + fr);
#pragma unroll
    for (int hb = 0; hb < 4; ++hb) {
      const int ai = hb >> 1, m0 = (hb & 1) * 2;
      u4v g[4], pm[4];
#pragma unroll
      for (int f4 = 0; f4 < 4; ++f4) {
        const int f = ai * 8 + (m0 + (f4 >> 1)) * 2 + (f4 & 1);
        g[f4] = *(const u4v*)(mg + (gbase + (size_t)f * 64) * 8);
        if (SECOND) pm[f4] = *(const u4v*)(mi + (ibase + (size_t)f * 64) * 8);
      }
#pragma unroll
      for (int f4 = 0; f4 < 4; ++f4) {
        const int m = m0 + (f4 >> 1), bj = f4 & 1;
        const int row = rowb + ai * 128 + m * 16;
        const pg8::f32x4 v0 = acc[ai][bj][m][0], v1 = acc[ai][bj][m][1];
        float r0 = v0[0] * bflo(g[f4].x), r1 = v0[1] * bfhi(g[f4].x), r2 = v0[2] * bflo(g[f4].y), r3 = v0[3] * bfhi(g[f4].y);
        float r4 = v1[0] * bflo(g[f4].z), r5 = v1[1] * bfhi(g[f4].z), r6 = v1[2] * bflo(g[f4].w), r7 = v1[3] * bfhi(g[f4].w);
        if (SECOND) {
          r0 += bflo(pm[f4].x); r1 += bfhi(pm[f4].x); r2 += bflo(pm[f4].y); r3 += bfhi(pm[f4].y);
          r4 += bflo(pm[f4].z); r5 += bfhi(pm[f4].z); r6 += bflo(pm[f4].w); r7 += bfhi(pm[f4].w);
        }
        u4v o; o.x = pk2(r0, r1); o.y = pk2(r2, r3); o.z = pk2(r4, r5); o.w = pk2(r6, r7);
        if (SECOND) *(u4v*)(mo + (size_t)row * 1024 + colb + bj * 128) = o;
        else *(u4v*)(mi + (ibase + (size_t)(ai * 8 + m * 2 + bj) * 64) * 8) = o;
      }
      __builtin_amdgcn_sched_barrier(0);
    }
  }
};
struct EpiQ {
  static constexpr bool PERM = true, AFTER_DRAIN = false;
  const float* ssq_q; const float* rope; u16* Qo;
  DI void operator()(const pg8::f32x4 (&acc)[2][2][4][2], const pg8::Unit& u, int wr, int wc, int fr, int fq) const {
    const int rowb = u.pm * 256 + wr * 64 + fr;
    const int colu = wc * 32 + 8 * fq;
    float sq[8];
#pragma unroll
    for (int i = 0; i < 8; ++i) sq[i] = ssq_q[rowb + (i >> 2) * 128 + (i & 3) * 16];
    if (u.pn < 2) {
#pragma unroll
      for (int ai = 0; ai < 2; ++ai)
#pragma unroll
        for (int m = 0; m < 4; ++m) {
          const int row = rowb + ai * 128 + m * 16;
          const int b = row >> 12, spos = row & 4095;
          const float sc = rsqrtf(sq[ai * 4 + m] * (1.f / 768.f) + EPS) * QSCALE;
#pragma unroll
          for (int bj = 0; bj < 2; ++bj) {
            const pg8::f32x4 v0 = acc[ai][bj][m][0], v1 = acc[ai][bj][m][1];
            const int head = u.pn * 4 + bj * 2 + (colu >> 6), d = colu & 63;
            u4v o; o.x = pk2(v0[0] * sc, v0[1] * sc); o.y = pk2(v0[2] * sc, v0[3] * sc); o.z = pk2(v1[0] * sc, v1[1] * sc); o.w = pk2(v1[2] * sc, v1[3] * sc);
            *(u4v*)(Qo + ((size_t)(b * 8 + head) * 4096 + spos) * 96 + d) = o;
          }
        }
    } else {
#pragma unroll
      for (int ai = 0; ai < 2; ++ai) {
        f4v cs[4], sn[4];
#pragma unroll
        for (int i = 0; i < 4; ++i) {
          const int spos = (rowb + ai * 128 + i * 16) & 4095;
          cs[i] = *(const f4v*)(rope + spos * 16 + 4 * fq); sn[i] = *(const f4v*)(rope + 65536 + spos * 16 + 4 * fq);
        }
#pragma unroll
        for (int m = 0; m < 4; ++m) {
          const int row = rowb + ai * 128 + m * 16;
          const int b = row >> 12, spos = row & 4095;
          const float sc = rsqrtf(sq[ai * 4 + m] * (1.f / 768.f) + EPS) * QSCALE;
          const f4v c4 = cs[m], s4 = sn[m];
#pragma unroll
          for (int bj = 0; bj < 2; ++bj) {
            const pg8::f32x4 v0 = acc[ai][bj][m][0], v1 = acc[ai][bj][m][1];
            const int head = bj * 4 + wc;
            u2v o1, o2;
            o1.x = pk2((v0[0] * c4.x - v1[0] * s4.x) * sc, (v0[1] * c4.y - v1[1] * s4.y) * sc);
            o1.y = pk2((v0[2] * c4.z - v1[2] * s4.z) * sc, (v0[3] * c4.w - v1[3] * s4.w) * sc);
            o2.x = pk2((v0[0] * s4.x + v1[0] * c4.x) * sc, (v0[1] * s4.y + v1[1] * c4.y) * sc);
            o2.y = pk2((v0[2] * s4.z + v1[2] * c4.z) * sc, (v0[3] * s4.w + v1[3] * c4.w) * sc);
            u16* qp = Qo + ((size_t)(b * 8 + head) * 4096 + spos) * 96 + 64 + 4 * fq;
            *(u2v*)qp = o1; *(u2v*)(qp + 16) = o2;
          }
        }
        __builtin_amdgcn_sched_barrier(0);
      }
    }
  }
};

struct EpiK {
  static constexpr bool PERM = true, AFTER_DRAIN = false;
  const float* ssq_kv; u16* Ko;
  DI void operator()(const pg8::f32x4 (&acc)[2][2][4][2], const pg8::Unit& u, int wr, int wc, int fr, int fq) const {
    const int rowb = u.pm * 256 + wr * 64 + fr;
    float sq[8];
#pragma unroll
    for (int i = 0; i < 8; ++i) sq[i] = ssq_kv[rowb + (i >> 2) * 128 + (i & 3) * 16];
#pragma unroll
    for (int ai = 0; ai < 2; ++ai)
#pragma unroll
      for (int m = 0; m < 4; ++m) {
        const int row = rowb + ai * 128 + m * 16;
        const int b = row >> 12, spos = row & 4095;
        const float sc = rsqrtf(sq[ai * 4 + m] * (1.f / 256.f) + EPS);
#pragma unroll
        for (int bj = 0; bj < 2; ++bj) {
          const pg8::f32x4 v0 = acc[ai][bj][m][0], v1 = acc[ai][bj][m][1];
          const int col = u.pn * 256 + bj * 128 + wc * 32 + 8 * fq;
          const int head = col >> 6, d = col & 63;
          u4v o; o.x = pk2(v0[0] * sc, v0[1] * sc); o.y = pk2(v0[2] * sc, v0[3] * sc); o.z = pk2(v1[0] * sc, v1[1] * sc); o.w = pk2(v1[2] * sc, v1[3] * sc);
          *(u4v*)(Ko + ((size_t)(b * 8 + head) * 4096 + spos) * 96 + d) = o;
        }
      }
  }
};
struct EpiV {
  static constexpr bool PERM = false, AFTER_DRAIN = false;
  const float* ssq_kv; u16* Vo;
  DI void operator()(const pg8::f32x4 (&acc)[2][2][4][2], const pg8::Unit& u, int wr, int wc, int fr, int fq) const {
    f4v sq[8];
#pragma unroll
    for (int i = 0; i < 8; ++i) sq[i] = *(const f4v*)(ssq_kv + u.pm * 256 + (i >> 2) * 128 + wr * 64 + (i & 3) * 16 + 4 * fq);
#pragma unroll
    for (int ai = 0; ai < 2; ++ai)
#pragma unroll
      for (int m = 0; m < 4; ++m) {
        const int row4 = u.pm * 256 + ai * 128 + wr * 64 + m * 16 + 4 * fq;
        const int b = row4 >> 12, spos = row4 & 4095;
        const f4v q = sq[ai * 4 + m];
        const float s0 = rsqrtf(q.x * (1.f / 256.f) + EPS), s1 = rsqrtf(q.y * (1.f / 256.f) + EPS), s2 = rsqrtf(q.z * (1.f / 256.f) + EPS), s3 = rsqrtf(q.w * (1.f / 256.f) + EPS);
#pragma unroll
        for (int bj = 0; bj < 2; ++bj)
#pragma unroll
          for (int n = 0; n < 2; ++n) {
            const pg8::f32x4 v = acc[ai][bj][m][n];
            const int col = u.pn * 256 + bj * 128 + wc * 32 + n * 16 + fr;
            const int head = col >> 6, dv = col & 63;
            u2v o; o.x = pk2(v[0] * s0, v[1] * s1); o.y = pk2(v[2] * s2, v[3] * s3);
            *(u2v*)(Vo + ((size_t)(b * 8 + head) * 64 + dv) * 4096 + ((spos & ~15) | (4 * (((fq & 1) << 1) | (fq >> 1))))) = o;
          }
        __builtin_amdgcn_sched_barrier(0);
      }
  }
};
DI void phase1(const Params& p, unsigned char* smem, bool dup = false) {
  unsigned char* ws = p.ws;
  pg8::Gemm g{(const u16*)(ws + OFF_H), (const u16*)(ws + OFF_WIN), T, NP, 1024};
  pg8::StaticOrder S; S.init(T, NP, (int)gridDim.x, (int)blockIdx.x);
  Epi1 E{ws, (u16*)p.out, p.b_gate, dup};
  pg8::gemm_phase<Epi1, pg8::StaticOrder, false>((PG8_LAS unsigned char*)smem, g, S, E, nullptr);
  const int nlight = (int)gridDim.x / 2;
  if (!dup && (int)blockIdx.x >= (int)gridDim.x - nlight) {
    const int gtid = ((int)blockIdx.x - ((int)gridDim.x - nlight)) * (int)blockDim.x + (int)threadIdx.x, gthreads = nlight * (int)blockDim.x;
    conv_weight<1>((u16*)(ws + OFF_WUQ), p.w_uq, 768, 768, 768, p.g_q, 1023, gtid, gthreads);
    conv_weight<3>((u16*)(ws + OFF_WUKV), p.w_ukv, 1024, 1024, 256, p.g_kv, 255, gtid, gthreads);
    conv_weight<2>((u16*)(ws + OFF_WA), p.w_a, 1024, 1024, 512, nullptr, 0, gtid, gthreads);
    conv_weight<2>((u16*)(ws + OFF_WB), p.w_b, 1024, 1024, 512, p.g_hgrn, 63, gtid, gthreads);
    conv_weight<2>((u16*)(ws + OFF_WO), p.w_out, 1024, 1024, 1024, nullptr, 0, gtid, gthreads);
  }
}

DI void hgrn_prep_tile(const Params& p, float* stage, int tid, int b, int hh, int prow0, int nblk0) {
  unsigned char* ws = p.ws;
  const int bh = b * 8 + hh;
  if (tid < 128) {
    const int c = tid & 63, blk = tid >> 6;
    const float l0 = p.lb_logits[hh * 64 + c], l1 = p.lb_logits[512 + hh * 64 + c];
    const float lbv = 1.f / (1.f + expf(l1 - l0));
    float cum = 0.f;
    for (int rr = 0; rr < 32; ++rr) {
      float* sp = stage + (blk * 32 + rr) * SST + c;
      const float q = sp[0], hf = sp[64];
      const float sg = 1.f / (1.f + expf(-hf));
      const float f = lbv + (1.f - lbv) * sg;
      cum += logf(f);
      const float e = expf(cum);
      sp[0] = q * e;
      sp[64] = (1.f - f) / e;
    }
    ((float*)(ws + OFF_DECAY))[((size_t)bh * 128 + nblk0 + blk) * 64 + c] = expf(cum);
  }
  __syncthreads();
#pragma unroll
  for (int it = 0; it < 2; ++it) {
    const int item = tid + 256 * it, rr = item >> 3, cc = (item & 7) * 8;
    const f4v a = *(const f4v*)(stage + rr * SST + cc), c = *(const f4v*)(stage + rr * SST + cc + 4);
    const f4v d = *(const f4v*)(stage + rr * SST + 64 + cc), e = *(const f4v*)(stage + rr * SST + 64 + cc + 4);
    const size_t o = (size_t)(prow0 + rr) * 512 + hh * 64 + cc;
    *(u4v*)((u16*)(ws + OFF_QDEC) + o) = pk8(a, c);
    *(u4v*)((u16*)(ws + OFF_KINV) + o) = pk8(d, e);
  }
}
DI void hi_vt_tile(const Params& p, float* stage, int tid, int b, int q2, int nblk0) {
  unsigned char* ws = p.ws;
#pragma unroll
        for (int it = 0; it < 4; ++it) {
          const int item = tid + 256 * it, sc = item & 3, col = (item >> 2) & 127, blk = item >> 9;
          float v[8];
#pragma unroll
          for (int i = 0; i < 8; ++i) v[i] = stage[(blk * 32 + sc * 8 + i) * SST + col];
          u4v o; o.x = pk2(v[0], v[1]); o.y = pk2(v[2], v[3]); o.z = pk2(v[4], v[5]); o.w = pk2(v[6], v[7]);
          const int bh = b * 8 + q2 * 2 + (col >> 6);
          *(u4v*)((u16*)(ws + OFF_VT) + (((size_t)bh * 128 + nblk0 + blk) * 64 + (col & 63)) * 32 + sc * 8) = o;
        }
}
DI void stage_load64(float* stage, const u16* src, int coff, int tid) {
#pragma unroll
  for (int it = 0; it < 2; ++it) {
    const int item = tid + 256 * it, rr = item >> 3, ch = item & 7;
    const u4v v = *(const u4v*)(src + (size_t)rr * 512 + ch * 8);
    float* d = stage + rr * SST + coff + ch * 8;
    *(f4v*)d = f4v{bflo(v.x), bfhi(v.x), bflo(v.y), bfhi(v.y)};
    *(f4v*)(d + 4) = f4v{bflo(v.z), bfhi(v.z), bflo(v.w), bfhi(v.w)};
  }
}


constexpr int PST = 68;
DI void hgrn_prep_native(const Params& p, float* pl, int rb, int hh) {
  unsigned char* ws = p.ws;
  const int tid = threadIdx.x;
  float* Qp = pl; float* G = pl + 128 * PST; float* Kn = pl + 2 * 128 * PST;
  const int prow0 = rb * 128, b = prow0 >> 12, bh = b * 8 + hh, nblk0 = (prow0 & 4095) >> 5;
  const int ch = tid & 7;
  float lbv[8];
  {
    const f4v a0 = *(const f4v*)(p.lb_logits + hh * 64 + ch * 8), a1 = *(const f4v*)(p.lb_logits + hh * 64 + ch * 8 + 4);
    const f4v b0 = *(const f4v*)(p.lb_logits + 512 + hh * 64 + ch * 8), b1 = *(const f4v*)(p.lb_logits + 512 + hh * 64 + ch * 8 + 4);
    const float l0[8] = {a0.x, a0.y, a0.z, a0.w, a1.x, a1.y, a1.z, a1.w}, l1[8] = {b0.x, b0.y, b0.z, b0.w, b1.x, b1.y, b1.z, b1.w};
#pragma unroll
    for (int i = 0; i < 8; ++i) lbv[i] = 1.f / (1.f + expf(l1[i] - l0[i]));
  }
  __syncthreads();
#pragma unroll
  for (int it = 0; it < 2; ++it) {
    const int rr = (tid + 512 * it) >> 3;
    const size_t go = (size_t)(prow0 + rr) * 512 + hh * 64 + ch * 8;
    const u4v qv = *(const u4v*)((const u16*)(ws + OFF_HQ) + go), fv = *(const u4v*)((const u16*)(ws + OFF_HF) + go);
    const float q[8] = {bflo(qv.x), bfhi(qv.x), bflo(qv.y), bfhi(qv.y), bflo(qv.z), bfhi(qv.z), bflo(qv.w), bfhi(qv.w)};
    const float hf[8] = {bflo(fv.x), bfhi(fv.x), bflo(fv.y), bfhi(fv.y), bflo(fv.z), bfhi(fv.z), bflo(fv.w), bfhi(fv.w)};
    float g[8], kn[8];
#pragma unroll
    for (int i = 0; i < 8; ++i) {
      const float sg = rcpf(1.f + __builtin_amdgcn_exp2f(-1.4426950408889634f * hf[i]));
      const float f = lbv[i] + (1.f - lbv[i]) * sg;
      g[i] = __builtin_amdgcn_logf(f);
      kn[i] = 1.f - f;
    }
    float* d = Qp + rr * PST + ch * 8;
    *(f4v*)d = f4v{q[0], q[1], q[2], q[3]}; *(f4v*)(d + 4) = f4v{q[4], q[5], q[6], q[7]};
    d = G + rr * PST + ch * 8;
    *(f4v*)d = f4v{g[0], g[1], g[2], g[3]}; *(f4v*)(d + 4) = f4v{g[4], g[5], g[6], g[7]};
    d = Kn + rr * PST + ch * 8;
    *(f4v*)d = f4v{kn[0], kn[1], kn[2], kn[3]}; *(f4v*)(d + 4) = f4v{kn[4], kn[5], kn[6], kn[7]};
  }
  __syncthreads();
  if (tid < 256) {
    const int c = tid & 63, blk = tid >> 6;
    float* gp = G + (blk * 32) * PST + c;
    float v[32];
#pragma unroll
    for (int r2 = 0; r2 < 32; ++r2) v[r2] = gp[r2 * PST];
    float cum = 0.f;
#pragma unroll
    for (int r2 = 0; r2 < 32; ++r2) { cum += v[r2]; gp[r2 * PST] = cum; }
    ((float*)(ws + OFF_DECAY))[((size_t)bh * 128 + nblk0 + blk) * 64 + c] = __builtin_amdgcn_exp2f(cum);
  }
  __syncthreads();
#pragma unroll
  for (int it = 0; it < 2; ++it) {
    const int rr = (tid + 512 * it) >> 3;
    const float* s0 = Qp + rr * PST + ch * 8; const float* s1 = G + rr * PST + ch * 8; const float* s2 = Kn + rr * PST + ch * 8;
    const f4v q0 = *(const f4v*)s0, q1 = *(const f4v*)(s0 + 4), c0 = *(const f4v*)s1, c1 = *(const f4v*)(s1 + 4), k0 = *(const f4v*)s2, k1 = *(const f4v*)(s2 + 4);
    const float q[8] = {q0.x, q0.y, q0.z, q0.w, q1.x, q1.y, q1.z, q1.w}, cm[8] = {c0.x, c0.y, c0.z, c0.w, c1.x, c1.y, c1.z, c1.w}, kn[8] = {k0.x, k0.y, k0.z, k0.w, k1.x, k1.y, k1.z, k1.w};
    float qd[8], ki[8];
#pragma unroll
    for (int i = 0; i < 8; ++i) { qd[i] = q[i] * __builtin_amdgcn_exp2f(cm[i]); ki[i] = kn[i] * __builtin_amdgcn_exp2f(-cm[i]); }
    const size_t go = (size_t)(prow0 + rr) * 512 + hh * 64 + ch * 8;
    u4v o; o.x = pk2(qd[0], qd[1]); o.y = pk2(qd[2], qd[3]); o.z = pk2(qd[4], qd[5]); o.w = pk2(qd[6], qd[7]);
    *(u4v*)((u16*)(ws + OFF_QDEC) + go) = o;
    o.x = pk2(ki[0], ki[1]); o.y = pk2(ki[2], ki[3]); o.z = pk2(ki[4], ki[5]); o.w = pk2(ki[6], ki[7]);
    *(u4v*)((u16*)(ws + OFF_KINV) + go) = o;
  }
}
constexpr int VTS = 136;
DI void hi_vt_native(const Params& p, u16* img, int rb, int q2) {
  unsigned char* ws = p.ws;
  const int tid = threadIdx.x;
  const int prow0 = rb * 128, b = prow0 >> 12, nblk0 = (prow0 & 4095) >> 5;
  __syncthreads();
#pragma unroll
  for (int it = 0; it < 4; ++it) {
    const int item = tid + 512 * it, rr = item >> 4, c16 = item & 15;
    *(u4v*)(img + rr * VTS + c16 * 8) = *(const u4v*)((const u16*)(ws + OFF_HI) + (size_t)(prow0 + rr) * 512 + q2 * 128 + c16 * 8);
  }
  __syncthreads();
#pragma unroll
  for (int it = 0; it < 4; ++it) {
    const int item = tid + 512 * it, sc = item & 3, col = (item >> 2) & 127, blk = item >> 9;
    u32 w[4];
#pragma unroll
    for (int i = 0; i < 4; ++i) {
      const u32 lo = img[(blk * 32 + sc * 8 + 2 * i) * VTS + col], hi = img[(blk * 32 + sc * 8 + 2 * i + 1) * VTS + col];
      w[i] = lo | (hi << 16);
    }
    const int bh = b * 8 + q2 * 2 + (col >> 6);
    *(u4v*)((u16*)(ws + OFF_VT) + (((size_t)bh * 128 + nblk0 + blk) * 64 + (col & 63)) * 32 + sc * 8) = u4v{w[0], w[1], w[2], w[3]};
  }
}

DI void rope8(const float* x1, const float* x2, const float* rope, int spos, int j0, bool first, float scale, float (&o)[8]) {
  const f4v c0 = *(const f4v*)(rope + spos * 16 + j0), c1 = *(const f4v*)(rope + spos * 16 + j0 + 4);
  const f4v s0 = *(const f4v*)(rope + 65536 + spos * 16 + j0), s1 = *(const f4v*)(rope + 65536 + spos * 16 + j0 + 4);
  const float cs[8] = {c0.x, c0.y, c0.z, c0.w, c1.x, c1.y, c1.z, c1.w};
  const float sn[8] = {s0.x, s0.y, s0.z, s0.w, s1.x, s1.y, s1.z, s1.w};
#pragma unroll
  for (int i = 0; i < 8; ++i) o[i] = scale * (first ? (x1[i] * cs[i] - x2[i] * sn[i]) : (x1[i] * sn[i] + x2[i] * cs[i]));
}

DI void phase2(const Params& p, unsigned char* smem, u16* lds) {
  unsigned char* ws = p.ws;
  const int tid = VTID;
  float* stage = (float*)lds;
  const float* ssq_q = (const float*)(ws + OFF_SSQ);
  const float* ssq_kv = ssq_q + T;
  const float* rope = (const float*)(ws + OFF_ROPE);
  u16* Qo = (u16*)(ws + OFF_Q);
  u16* Ko = (u16*)(ws + OFF_K);
  u16* Vo = (u16*)(ws + OFF_VTT);
#pragma nounroll
  for (int rep = 0; rep < (DUP_PH == 21 ? p.ph_hi - 7 : 1); ++rep) {
    pg8::Gemm g{(const u16*)(ws + OFF_CQ), (const u16*)(ws + OFF_WUQ), T, 768, 768};
    pg8::StaticOrder S; S.init(T, 768, (int)gridDim.x, (int)blockIdx.x);
    EpiQ E{ssq_q, rope, Qo};
    pg8::gemm_phase<EpiQ, pg8::StaticOrder, false>((PG8_LAS unsigned char*)smem, g, S, E, nullptr);
  }
#pragma nounroll
  for (int rep = 0; rep < (DUP_PH == 23 ? p.ph_hi - 7 : 1); ++rep) {
    pg8::StaticOrder S; S.init(T, 512, (int)gridDim.x, (int)blockIdx.x);
    {
      int kk = 256; asm volatile("" : "+s"(kk));
      pg8::Gemm g{(const u16*)(ws + OFF_CKV), (const u16*)(ws + OFF_WUKV), T, 512, kk};
      EpiK E{ssq_kv, Ko};
      pg8::gemm_phase<EpiK, pg8::StaticOrder, false>((PG8_LAS unsigned char*)smem, g, S, E, nullptr);
    }
  }
  {
    pg8::StaticOrder S; S.init(T, 512, (int)gridDim.x, (int)blockIdx.x);
    int kk = 256; asm volatile("" : "+s"(kk));
    pg8::Gemm g{(const u16*)(ws + OFF_CKV), (const u16*)(ws + OFF_WUKV) + (size_t)512 * 256, T, 512, kk};
    EpiV E{(const float*)(ws + OFF_SSQ) + T, (u16*)(ws + OFF_VTT)};
    pg8::gemm_phase<EpiV, pg8::StaticOrder, false, true>((PG8_LAS unsigned char*)smem, g, S, E, nullptr);
  }
#pragma nounroll
  for (int rep = 0; rep < (DUP_PH == 22 ? p.ph_hi - 7 : 1); ++rep) {
    const int gtid = blockIdx.x * blockDim.x + threadIdx.x, gthreads = gridDim.x * blockDim.x;
    for (int idx = gtid; idx < T * 4; idx += gthreads) {
      const int tok = idx >> 2, wv = (idx & 3) * 8, j0 = wv & 15;
      const int b = tok >> 12, spos = tok & 4095;
      const float* kp = (const float*)(ws + OFF_KPE) + (size_t)tok * 32;
      const f4v a0 = *(const f4v*)(kp + j0), a1 = *(const f4v*)(kp + j0 + 4);
      const f4v b0 = *(const f4v*)(kp + 16 + j0), b1 = *(const f4v*)(kp + 16 + j0 + 4);
      const float x1[8] = {a0.x, a0.y, a0.z, a0.w, a1.x, a1.y, a1.z, a1.w};
      const float x2[8] = {b0.x, b0.y, b0.z, b0.w, b1.x, b1.y, b1.z, b1.w};
      float o[8];
      rope8(x1, x2, rope, spos, j0, wv < 16, 1.f, o);
      u4v ov; ov.x = pk2(o[0], o[1]); ov.y = pk2(o[2], o[3]); ov.z = pk2(o[4], o[5]); ov.w = pk2(o[6], o[7]);
#pragma unroll
      for (int head = 0; head < 8; ++head) *(u4v*)(Ko + ((size_t)(b * 8 + head) * 4096 + spos) * 96 + 64 + wv) = ov;
    }
  }
  for (int rep = 0; rep < (DUP_PH == 20 ? 2 : 1); ++rep)
  {
    const int G = (int)gridDim.x, c = (int)blockIdx.x, hG = G / 2, round = 2 * G + hG;
    for (int base = 0; base < 2048 + 1024; base += round) {
#pragma unroll 1
      for (int k = 0; k < 3; ++k) {
        if (k == 2 && c < G - hG) break;
        const int t = base + (k == 0 ? c : k == 1 ? G + c : 2 * G + (c - (G - hG)));
        if (t >= 2048 + 1024) break;
        if (t < 2048) hgrn_prep_native(p, (float*)smem, t >> 3, t & 7);
        else hi_vt_native(p, (u16*)smem, (t - 2048) >> 2, (t - 2048) & 3);
      }
    }
  }
}

DI void phase2b(const Params& p, unsigned char* smem) {
  unsigned char* ws = p.ws;
  const int tid = VTID;
}

constexpr int KST2 = 104, VST2 = 136;
constexpr int ATT_BUF2 = 128 * KST2 + 64 * VST2;
DI void att_qk(const u16* sk, const bf16x8 (&qf)[6], float nm, f32x16 (&st)[2]) {
#pragma unroll
  for (int i = 0; i < 16; ++i) { st[0][i] = nm; st[1][i] = nm; }
#pragma unroll
  for (int kb = 0; kb < 2; ++kb)
#pragma unroll
    for (int ks = 0; ks < 6; ++ks) {
      const bf16x8 kf = *(const bf16x8*)(sk + kb * 32 * KST2 + ks * 16);
      st[kb] = MFMA(kf, qf[ks], st[kb]);
    }
}
DI float att_softmax(f32x16 (&st)[2], float adj, bool adjnz, bool first, float& mref, float& l, f32x16 (&o)[2]) {
  float mx = st[0][0];
#pragma unroll
  for (int i = 1; i < 16; ++i) mx = fmaxf(mx, st[0][i]);
#pragma unroll
  for (int i = 0; i < 16; ++i) mx = fmaxf(mx, st[1][i]);
  mx = xor32_max(mx) - adj;
  f2v ps = f2v{0.f, 0.f};
  float shift_out = 0.f;
  if (first || adjnz || __builtin_amdgcn_ballot_w64(mx > 8.f) != 0ull) {
    const float shift = first ? mx : fmaxf(mx, 0.f);
    const float tot = adj + shift;
    const float alpha = first ? 0.f : __builtin_amdgcn_exp2f(-shift);
    mref += shift;
#pragma unroll
    for (int kb = 0; kb < 2; ++kb)
#pragma unroll
      for (int i = 0; i < 16; i += 2) {
        const float p0 = __builtin_amdgcn_exp2f(st[kb][i] - tot), p1 = __builtin_amdgcn_exp2f(st[kb][i + 1] - tot);
        st[kb][i] = p0; st[kb][i + 1] = p1; ps += f2v{p0, p1};
      }
    l = l * alpha + (ps.x + ps.y);
#pragma unroll
    for (int i = 0; i < 16; ++i) { o[0][i] *= alpha; o[1][i] *= alpha; }
    shift_out = shift;
  } else {
#pragma unroll
    for (int kb = 0; kb < 2; ++kb)
#pragma unroll
      for (int i = 0; i < 16; i += 2) {
        const float p0 = __builtin_amdgcn_exp2f(st[kb][i]), p1 = __builtin_amdgcn_exp2f(st[kb][i + 1]);
        st[kb][i] = p0; st[kb][i + 1] = p1; ps += f2v{p0, p1};
      }
    l += ps.x + ps.y;
  }
  return shift_out;
}
DI void att_pv(const u16* sv, const f32x16 (&st)[2], f32x16 (&o)[2]) {
#pragma unroll
  for (int s4 = 0; s4 < 4; ++s4) {
    const int kb = s4 >> 1, rb = 8 * (s4 & 1);
    u4v pu; pu.x = pk2(st[kb][rb], st[kb][rb + 1]); pu.y = pk2(st[kb][rb + 2], st[kb][rb + 3]);
    pu.z = pk2(st[kb][rb + 4], st[kb][rb + 5]); pu.w = pk2(st[kb][rb + 6], st[kb][rb + 7]);
    const bf16x8 pb = __builtin_bit_cast(bf16x8, pu);
#pragma unroll
    for (int db = 0; db < 2; ++db) {
      const bf16x8 vf = *(const bf16x8*)(sv + db * 32 * VST2 + 16 * s4);
      o[db] = MFMA(vf, pb, o[db]);
    }
  }
}
DI void attn8_item(const Params& p, u16* lds, int bh, int qt) {
  unsigned char* ws = p.ws;
  const int tid = threadIdx.x, lane = tid & 63, w = tid >> 6, r = lane & 31, h = lane >> 5;
  const u16* Qp = (const u16*)(ws + OFF_Q) + (size_t)bh * 4096 * 96;
  const u16* Kp = (const u16*)(ws + OFF_K) + (size_t)bh * 4096 * 96;
  const u16* Vp = (const u16*)(ws + OFF_VTT) + (size_t)bh * 64 * 4096;
  const int q0 = qt * 256 + w * 32;
  bf16x8 qf[6];
#pragma unroll
  for (int ks = 0; ks < 6; ++ks) qf[ks] = *(const bf16x8*)(Qp + (size_t)(q0 + r) * 96 + ks * 16 + h * 8);
  u2v gts[2][4];
  {
    const size_t tok_ = (size_t)(bh >> 3) * 4096 + q0 + r;
    const u16* sga_ = (const u16*)(ws + OFF_SGA) + tok_ * 512 + (bh & 7) * 64;
#pragma unroll
    for (int db = 0; db < 2; ++db)
#pragma unroll
      for (int g = 0; g < 4; ++g) gts[db][g] = *(const u2v*)(sga_ + db * 32 + 8 * g + 4 * h);
  }
  f32x16 o[2]; o[0] = zero16(); o[1] = zero16();
  float mref = 0.f, l = 0.f;
  const int Jmax = 2 * qt + 1, jw = 4 * qt + (w >> 1);
  const u16* dsrc[6]; int dstep[6]; unsigned doff[6];
#pragma unroll
  for (int sl = 0; sl < 6; ++sl) {
    const int k = w + 8 * sl;
    if (k < 26) { const int c = 64 * k + lane, row = c / 13, col = c % 13; dsrc[sl] = Kp + (size_t)row * 96 + (col < 12 ? col : 11) * 8; dstep[sl] = 128 * 96; doff[sl] = (unsigned)k * 1024u; }
    else { const int c = 64 * (k - 26) + lane, row = c / 17, col = c % 17; dsrc[sl] = Vp + (size_t)row * 4096 + (col < 16 ? col : 15) * 8; dstep[sl] = 128; doff[sl] = 128u * KST2 * 2u + (unsigned)(k - 26) * 1024u; }
  }
  LAS unsigned char* ldsb = (LAS unsigned char*)lds;
#define ATT_DMA(BUF) do { _Pragma("unroll") for (int sl = 0; sl < 6; ++sl) if (w + 8 * sl < 43) { \
      __builtin_amdgcn_global_load_lds((const unsigned*)dsrc[sl], (LAS unsigned*)(ldsb + (BUF) * (ATT_BUF2 * 2) + doff[sl]), 16, 0, 0); dsrc[sl] += dstep[sl]; } } while (0)
  __syncthreads();
  ATT_DMA(0);
  __syncthreads();
  for (int J = 0; J <= Jmax; ++J) {
    const int cur = J & 1;
    if (J < Jmax) ATT_DMA(cur ^ 1);
    const u16* sk = lds + cur * ATT_BUF2 + r * KST2 + h * 8;
    const u16* sv = lds + cur * ATT_BUF2 + 128 * KST2 + r * VST2 + 8 * h;
    if (2 * J + 1 <= jw) {
      f32x16 s0[2], s1[2];
      const float nm = -mref;
      att_qk(sk, qf, nm, s0);
      att_qk(sk + 64 * KST2, qf, nm, s1);
      const float sh = att_softmax(s0, 0.f, false, J == 0, mref, l, o);
      const bool adjnz = __builtin_amdgcn_ballot_w64(sh != 0.f) != 0ull;
      att_pv(sv, s0, o);
      att_softmax(s1, sh, adjnz, false, mref, l, o);
      att_pv(sv + 64, s1, o);
    } else if (2 * J <= jw) {
      f32x16 s0[2];
      att_qk(sk, qf, -mref, s0);
      att_softmax(s0, 0.f, false, J == 0, mref, l, o);
      att_pv(sv, s0, o);
    }
    __syncthreads();
  }
#undef ATT_DMA
  l = xor32_add(l);
  const float inv = 1.f / l;
  const int b = bh >> 3, head = bh & 7;
  const size_t tok = (size_t)b * 4096 + q0 + r;
  const u16* sga = (const u16*)(ws + OFF_SGA) + tok * 512 + head * 64;
  u16* ya = (u16*)(ws + OFF_YA) + tok * 512 + head * 64;
#pragma unroll
  for (int db = 0; db < 2; ++db)
#pragma unroll
    for (int g = 0; g < 4; ++g) {
      const int dv0 = db * 32 + 8 * g + 4 * h;
      const u2v gt = gts[db][g];
      u2v ov;
      ov.x = pk2(o[db][4 * g] * inv * bflo(gt.x), o[db][4 * g + 1] * inv * bfhi(gt.x));
      ov.y = pk2(o[db][4 * g + 2] * inv * bflo(gt.y), o[db][4 * g + 3] * inv * bfhi(gt.y));
      *(u2v*)(ya + dv0) = ov;
    }
}

DI void scan_item(const Params& p, int i, size_t out_off = OFF_UPD) {
  unsigned char* ws = p.ws;
  const int tid = threadIdx.x;
  const int bh = i >> 2, part = i & 3;
  const int e = part * 1024 + tid * 2, k = e & 63;
  u32* U = (u32*)((u16*)(ws + OFF_UPD) + (size_t)bh * 128 * 4096 + e);
  u32* UO = (u32*)((u16*)(ws + out_off) + (size_t)bh * 128 * 4096 + e);
  const f2v* Dc = (const f2v*)((const float*)(ws + OFF_DECAY) + (size_t)bh * 128 * 64 + k);
  float s0 = 0.f, s1 = 0.f;
  for (int n0 = 0; n0 < 128; n0 += 32) {
    u32 u[32]; f2v d[32];
#pragma unroll
    for (int q = 0; q < 32; ++q) { u[q] = U[(size_t)(n0 + q) * 2048]; d[q] = Dc[(n0 + q) * 32]; }
#pragma unroll
    for (int q = 0; q < 32; ++q) {
      UO[(size_t)(n0 + q) * 2048] = pk2(s0, s1);
      s0 = d[q].x * (s0 + bflo(u[q]));
      s1 = d[q].y * (s1 + bfhi(u[q]));
    }
  }
}

DI void hgrn_state_item(const Params& p, float* ub, int bh, int vb) {
  unsigned char* ws = p.ws;
  const int tid = threadIdx.x, lane = tid & 63, w = tid >> 6, r = lane & 31, h = lane >> 5;
  const int b = bh >> 3, head = bh & 7;
  const u16* kn_base = (const u16*)(ws + OFF_KINV) + ((size_t)b * 4096) * 512 + head * 64;
  const u16* vt_base = (const u16*)(ws + OFF_VT) + ((size_t)bh * 128) * 64 * 32;
  const float* dec = (const float*)(ws + OFF_DECAY) + (size_t)bh * 128 * 64;
  u16* up = (u16*)(ws + OFF_UPD) + (size_t)bh * 128 * 4096;
  const int vl = tid >> 4, k0 = (tid & 15) * 4;
  constexpr int KS = 68;
  f4v st = f4v{0.f, 0.f, 0.f, 0.f};
#pragma unroll 1
  for (int i = 0; i < 16; ++i) {
    const int n = i * 8 + w;
    bf16x8 a[2][2], bb[2];
    const u16* kn = kn_base + (size_t)(n * 32) * 512;
#pragma unroll
    for (int kb = 0; kb < 2; ++kb)
#pragma unroll
      for (int ks = 0; ks < 2; ++ks) {
        bf16x8 av;
#pragma unroll
        for (int j = 0; j < 8; ++j) av[j] = (short)kn[(size_t)(ks * 16 + h * 8 + j) * 512 + kb * 32 + r];
        a[kb][ks] = av;
      }
#pragma unroll
    for (int ks = 0; ks < 2; ++ks) bb[ks] = *(const bf16x8*)(vt_base + ((size_t)n * 64 + vb * 32 + r) * 32 + ks * 16 + h * 8);
    f4v d[8];
#pragma unroll
    for (int j = 0; j < 8; ++j) d[j] = *(const f4v*)(dec + (size_t)(i * 8 + j) * 64 + k0);
    __syncthreads();
#pragma unroll
    for (int kb = 0; kb < 2; ++kb) {
      f32x16 c = zero16();
      c = MFMA(a[kb][0], bb[0], c);
      c = MFMA(a[kb][1], bb[1], c);
#pragma unroll
      for (int g = 0; g < 4; ++g) *(f4v*)(ub + (w * 32 + r) * KS + kb * 32 + 8 * g + 4 * h) = f4v{c[4 * g], c[4 * g + 1], c[4 * g + 2], c[4 * g + 3]};
    }
    __syncthreads();
#pragma unroll
    for (int j = 0; j < 8; ++j) {
      const f4v u = *(const f4v*)(ub + (j * 32 + vl) * KS + k0);
      u2v o; o.x = pk2(st.x, st.y); o.y = pk2(st.z, st.w);
      *(u2v*)(up + (size_t)(i * 8 + j) * 4096 + (vb * 32 + vl) * 64 + k0) = o;
      st.x = d[j].x * (st.x + u.x); st.y = d[j].y * (st.y + u.y); st.z = d[j].z * (st.z + u.z); st.w = d[j].w * (st.w + u.w);
    }
  }
  asm volatile("s_waitcnt vmcnt(0)" ::: "memory");
  __syncthreads();
  if (threadIdx.x == 0) {
    __builtin_amdgcn_fence(__ATOMIC_RELEASE, "agent");
    asm volatile("s_waitcnt vmcnt(0)" ::: "memory");
    __hip_atomic_fetch_add((unsigned*)(ws + OFF_SSQ + (size_t)3 * T * 4) + 64 + bh, 1u, __ATOMIC_RELAXED, __HIP_MEMORY_SCOPE_AGENT);
  }
}

DI void h3_item(const Params& p, int t);
DI void phase3(const Params& p, unsigned char* smem, bool dup = false) {
  int* s_item = (int*)(smem + LDS_BYTES - 64);
  int* ctr = (int*)(p.ws + OFF_SSQ + (size_t)3 * T * 4) + (dup ? 1 : 0);
  unsigned* done = (unsigned*)(p.ws + OFF_SSQ + (size_t)3 * T * 4) + 64;
  if (!dup) for (int it = (int)blockIdx.x - ((int)gridDim.x - 128); it >= 0 && it < 128; it += 128 * 1024) hgrn_state_item(p, (float*)smem, it >> 1, it & 1);
  if (!dup && (int)gridDim.x < 128) for (int it = (int)blockIdx.x; it < 128; it += (int)gridDim.x) hgrn_state_item(p, (float*)smem, it >> 1, it & 1);
  for (;;) {
    __syncthreads();
    if (threadIdx.x == 0) *s_item = atomicAdd(ctr, 1);
    __syncthreads();
    const int item = *s_item;
    if (item >= 2048) break;
    int att = -1, h3 = -1;
    if (item < 256) att = item;
    else { const int j = item - 256, g = j / 7, pos = j % 7; if (pos == 0 || pos == 2 || pos == 4) att = 256 + 3 * g + (pos >> 1); else h3 = 4 * g + (pos == 1 ? 0 : pos == 3 ? 1 : pos == 5 ? 2 : 3); }
    if (att >= 0) attn8_item(p, (u16*)smem, att & 63, 15 - (att >> 6));
    else if (!dup) {
      const int bh = h3 >> 4;
      if (threadIdx.x == 0) {
        unsigned sp = 0;
        while (__hip_atomic_load(done + bh, __ATOMIC_RELAXED, __HIP_MEMORY_SCOPE_AGENT) < 2u) { __builtin_amdgcn_s_sleep(2); if (++sp > (1u << 22)) break; }
        __builtin_amdgcn_fence(__ATOMIC_ACQUIRE, "agent");
        asm volatile("s_waitcnt vmcnt(0)" ::: "memory");
      }
      __syncthreads();
      h3_item(p, 2 * h3 + (int)(threadIdx.x >> 8));
    }
  }
}

DI void h3_item(const Params& p, int t) {
  unsigned char* ws = p.ws;
  const int tid = VTID, lane = tid & 63, w = tid >> 6, r = lane & 31, h = lane >> 5;
  {
    const int bh = t >> 5, n = (t & 31) * 4 + w;
    const int b = bh >> 3, head = bh & 7;
    const size_t tok0 = (size_t)b * 4096 + n * 32;
    const u16* qd = (const u16*)(ws + OFF_QDEC) + (tok0 + r) * 512 + head * 64 + h * 8;
    const u16* ki = (const u16*)(ws + OFF_KINV) + (tok0 + r) * 512 + head * 64 + h * 8;
    const u16* vt = (const u16*)(ws + OFF_VT) + ((size_t)bh * 128 + n) * 64 * 32;
    const u16* sp = (const u16*)(ws + OFF_UPD) + ((size_t)bh * 128 + n) * 4096;
    bf16x8 qf[4], kf[4];
#pragma unroll
    for (int ks = 0; ks < 4; ++ks) { qf[ks] = *(const bf16x8*)(qd + ks * 16); kf[ks] = *(const bf16x8*)(ki + ks * 16); }
    f32x16 at = zero16();
#pragma unroll
    for (int ks = 0; ks < 4; ++ks) at = MFMA(kf[ks], qf[ks], at);
#pragma unroll
    for (int i = 0; i < 16; ++i) if (crow(i, h) > r) at[i] = 0.f;
    f32x16 o[2]; o[0] = zero16(); o[1] = zero16();
#pragma unroll
    for (int s2 = 0; s2 < 2; ++s2) {
      u4v pu; pu.x = pk2(at[8 * s2], at[8 * s2 + 1]); pu.y = pk2(at[8 * s2 + 2], at[8 * s2 + 3]);
      pu.z = pk2(at[8 * s2 + 4], at[8 * s2 + 5]); pu.w = pk2(at[8 * s2 + 6], at[8 * s2 + 7]);
      const bf16x8 pb = __builtin_bit_cast(bf16x8, pu);
#pragma unroll
      for (int vb = 0; vb < 2; ++vb) {
        const s16x4 lo = *(const s16x4*)(vt + (vb * 32 + r) * 32 + 16 * s2 + 4 * h);
        const s16x4 hi = *(const s16x4*)(vt + (vb * 32 + r) * 32 + 16 * s2 + 8 + 4 * h);
        const bf16x8 vf = __builtin_shufflevector(lo, hi, 0, 1, 2, 3, 4, 5, 6, 7);
        o[vb] = MFMA(vf, pb, o[vb]);
      }
    }
#pragma unroll
    for (int vb = 0; vb < 2; ++vb)
#pragma unroll
      for (int ks = 0; ks < 4; ++ks) {
        const bf16x8 sf = *(const bf16x8*)(sp + (vb * 32 + r) * 64 + ks * 16 + h * 8);
        o[vb] = MFMA(sf, qf[ks], o[vb]);
      }
    float ss = 0.f;
#pragma unroll
    for (int i = 0; i < 16; ++i) ss += o[0][i] * o[0][i] + o[1][i] * o[1][i];
    ss = xor32_add(ss);
    const float rs = rsqrtf(ss * (1.f / 64.f) + EPS);
    const u16* sgb = (const u16*)(ws + OFF_SGB) + (tok0 + r) * 512 + head * 64;
    u16* yb = (u16*)(ws + OFF_YB) + (tok0 + r) * 512 + head * 64;
#pragma unroll
    for (int vb = 0; vb < 2; ++vb)
#pragma unroll
      for (int g = 0; g < 4; ++g) {
        const int v0 = vb * 32 + 8 * g + 4 * h;
        const u2v gt = *(const u2v*)(sgb + v0);
        u2v ov;
        ov.x = pk2(o[vb][4 * g] * rs * bflo(gt.x), o[vb][4 * g + 1] * rs * bfhi(gt.x));
        ov.y = pk2(o[vb][4 * g + 2] * rs * bflo(gt.y), o[vb][4 * g + 3] * rs * bfhi(gt.y));
        *(u2v*)(yb + v0) = ov;
      }
  }
}

DI void phase5(const Params& p, unsigned char* smem) {
  unsigned char* ws = p.ws;
  pg8::StaticOrder S; S.init(T, 1024, (int)gridDim.x, (int)blockIdx.x);
  {
    pg8::Gemm g{(const u16*)(ws + OFF_YA), (const u16*)(ws + OFF_WA), T, 1024, 512};
    Epi5<false> E{(const u16*)p.out, (u16*)(ws + OFF_H), (u16*)(ws + OFF_M)};
    pg8::gemm_phase<Epi5<false>, pg8::StaticOrder, false>((PG8_LAS unsigned char*)smem, g, S, E, nullptr);
  }
  {
    pg8::Gemm g{(const u16*)(ws + OFF_YB), (const u16*)(ws + OFF_WB), T, 1024, 512};
    Epi5<true> E{(const u16*)p.out, (u16*)(ws + OFF_H), (u16*)(ws + OFF_M)};
    pg8::gemm_phase<Epi5<true>, pg8::StaticOrder, false>((PG8_LAS unsigned char*)smem, g, S, E, nullptr);
  }
}

DI void phase6(const Params& p, unsigned char* smem, bool dup = false) {
  unsigned char* ws = p.ws;
  pg8::Gemm g{(const u16*)(ws + OFF_M), (const u16*)(ws + OFF_WO), T, 1024, 1024};
  pg8::StaticOrder S; S.init(T, 1024, (int)gridDim.x, (int)blockIdx.x);
  Epi6 E{(u16*)(ws + OFF_H), (float*)(ws + OFF_SSQ) + 2 * T, dup};
  pg8::gemm_phase<Epi6, pg8::StaticOrder, false>((PG8_LAS unsigned char*)smem, g, S, E, nullptr);
}

DI void phase7(const Params& p) {
  const float* ssq_y = (const float*)(p.ws + OFF_SSQ) + 2 * T;
  const u2v* Y = (const u2v*)(p.ws + OFF_H);
  const int gtid = blockIdx.x * blockDim.x + threadIdx.x, gthreads = gridDim.x * blockDim.x;
  for (int i = gtid; i < T * 256; i += gthreads) {
    const int row = i >> 8, c4 = i & 255;
    const float rs = rsqrtf(ssq_y[row] * (1.f / 1024.f) + EPS);
    const u2v y = Y[i];
    const f4v xv = ((const f4v*)p.x)[i];
    const f4v g = ((const f4v*)p.g_post)[c4];
    f4v o;
    o.x = xv.x + bflo(y.x) * rs * g.x; o.y = xv.y + bfhi(y.x) * rs * g.y; o.z = xv.z + bflo(y.y) * rs * g.z; o.w = xv.w + bfhi(y.y) * rs * g.w;
    ((f4v*)p.out)[i] = o;
  }
}

__global__ void __launch_bounds__(512, 2) fwd_megakernel(Params p) {
  extern __shared__ __attribute__((aligned(16))) unsigned char smem[];
  u16* lds = (u16*)(smem + (threadIdx.x >> 8) * VLDS);
  cg::grid_group grid = cg::this_grid();
  volatile LAS unsigned* xst = (volatile LAS unsigned*)(smem + LDS_BYTES - 48);
  if (threadIdx.x == 0) { xst[0] = 0u; xst[1] = 0u; }
  __syncthreads();
  XcdBarrier xb = xcd_barrier_post((unsigned*)(p.ws + OFF_BAR), xst);
#define RUN_PHASE(N, CALL) if (p.ph_lo <= N && N < p.ph_hi) { if (N > p.ph_lo) xcd_barrier(xb); CALL; }
#define DUP_PHASE(N, CALL) if (DUP_PH == N) { xcd_barrier(xb); CALL; }
  RUN_PHASE(0, phase0(p))
  DUP_PHASE(0, phase0(p))
  if (p.ph_lo <= 1 && 1 < p.ph_hi) for (int rep = 0; rep < (DUP_PH == 1 ? 2 : 1); ++rep) { if (rep > 0 || 1 > p.ph_lo) xcd_barrier(xb); phase1(p, smem, rep > 0); }
  if (p.ph_lo <= 2 && 2 < p.ph_hi) for (int rep = 0; rep < (DUP_PH == 2 ? 2 : 1); ++rep) { if (rep > 0 || 2 > p.ph_lo) xcd_barrier(xb); phase2(p, smem, lds); }
  RUN_PHASE(4, phase3(p, smem))
  DUP_PHASE(4, phase3(p, smem, true))
  if (DUP_PH == 9) { xcd_barrier(xb); for (int i = blockIdx.x; i < 256; i += gridDim.x) scan_item(p, i, OFF_K); }
  RUN_PHASE(6, phase5(p, smem))
  DUP_PHASE(6, phase5(p, smem))
  RUN_PHASE(7, phase6(p, smem))
  DUP_PHASE(7, phase6(p, smem, true))
  RUN_PHASE(8, phase7(p))
  if (DUP_PH == 8) { xcd_barrier(xb); phase6(p, smem, true); xcd_barrier(xb); phase7(p); }
}

extern "C" void kernel_launch(void* const* d_in, const int* in_sizes, int n_in, void* d_out, int out_size, void* d_ws, size_t ws_size,
                              hipStream_t stream) {
  static int grid_blocks = 0;
  if (!grid_blocks) {
    int dev = 0, cus = 0, per_cu = 0;
    hipGetDevice(&dev);
    hipDeviceGetAttribute(&cus, hipDeviceAttributeMultiprocessorCount, dev);
    hipFuncSetAttribute((const void*)fwd_megakernel, hipFuncAttributeMaxDynamicSharedMemorySize, LDS_BYTES);
    hipOccupancyMaxActiveBlocksPerMultiprocessor(&per_cu, (const void*)fwd_megakernel, 512, LDS_BYTES);
    if (per_cu < 1) per_cu = 1;
    if (per_cu > 1) per_cu = 1;
    grid_blocks = cus * per_cu;
    if (ws_size < WS_NEED) fprintf(stderr, "kernel_launch: workspace too small: %zu < %zu\n", ws_size, (size_t)WS_NEED);
  }
  if (ws_size < WS_NEED) return;
  Params p{};
  p.x = (const float*)d_in[0]; p.g_pre = (const float*)d_in[1]; p.w_in = (const float*)d_in[2]; p.b_gate = (const float*)d_in[3];
  p.g_q = (const float*)d_in[4]; p.w_uq = (const float*)d_in[5]; p.g_kv = (const float*)d_in[6]; p.w_ukv = (const float*)d_in[7];
  p.lb_logits = (const float*)d_in[8]; p.g_hgrn = (const float*)d_in[9]; p.w_a = (const float*)d_in[10]; p.w_b = (const float*)d_in[11];
  p.w_out = (const float*)d_in[12]; p.g_post = (const float*)d_in[13];
  p.out = (float*)d_out; p.ws = (unsigned char*)d_ws;
#if ONE_LAUNCH
  p.ph_lo = 0; p.ph_hi = 9;
  (void)hipMemsetAsync((unsigned char*)d_ws + OFF_BAR, 0, 16384, stream);
  void* args[] = {&p};
  hipError_t e = hipLaunchCooperativeKernel((const void*)fwd_megakernel, dim3(grid_blocks), dim3(512), args, LDS_BYTES, stream);
  if (e != hipSuccess) fprintf(stderr, "cooperative launch failed: %s (grid %d)\n", hipGetErrorString(e), grid_blocks);
#else
  for (int ph = 0; ph < 9; ++ph) {
    p.ph_lo = ph; p.ph_hi = ph + 1;
    (void)hipMemsetAsync((unsigned char*)d_ws + OFF_BAR, 0, 16384, stream);
    void* args[] = {&p};
    hipError_t e = hipLaunchCooperativeKernel((const void*)fwd_megakernel, dim3(grid_blocks), dim3(512), args, LDS_BYTES, stream);
    if (e != hipSuccess) fprintf(stderr, "cooperative launch failed: %s (grid %d)\n", hipGetErrorString(e), grid_blocks);
  }
#endif
}
```
